# Optimizing an MI355X kernel written in HIP

```python
import jax, jax.numpy as jnp
from jax import lax
import numpy as np

D_MODEL = 1024
BATCH = 2
SEQ = 8192
DEPTH = 1
DEC_BATCH = 8
DEC_SEQ = 32
PAST_LEN = 4096

CHUNK = 64
Q_BLOCK = 128
H_A = 8
NOPE = 64
ROPE = 32
DV = 64
Q_RANK = 384
KV_RANK = 256
ROPE_BASE = 10000.0
H_B = 8
D_HB = 64
D_FF = 2816
CONV_W = 3
EPS = 1e-6
NEG = -1e30
MLA_SCALE = (NOPE + ROPE) ** -0.5
SB_SCALE = D_HB ** -0.5
IN_SPLITS = [int(v) for v in np.cumsum([Q_RANK, KV_RANK, ROPE, H_B * D_HB, H_B * D_HB, H_B * D_HB, D_MODEL])]
N_IN = Q_RANK + KV_RANK + ROPE + 3 * H_B * D_HB + 2 * D_MODEL

kernel_name = "mla_stickbreaking_gated_hybrid_streaming_step"


def rms_norm(x, g):
    xf = x.astype(jnp.float32)
    y = xf * lax.rsqrt(jnp.mean(xf * xf, axis=-1, keepdims=True) + EPS)
    return (y * g.astype(jnp.float32)).astype(x.dtype)


def rope_tables(pos, dtype):
    inv = ROPE_BASE ** (-jnp.arange(0, ROPE, 2, dtype=jnp.float32) / ROPE)
    ang = pos.astype(jnp.float32)[:, None] * inv[None, :]
    return jnp.cos(ang).astype(dtype), jnp.sin(ang).astype(dtype)


def apply_rope(x, cos, sin):
    x1, x2 = x[..., :ROPE // 2], x[..., ROPE // 2:]
    return jnp.concatenate([x1 * cos - x2 * sin, x2 * cos + x1 * sin], axis=-1)


def mixer_inputs(h, pos, w_in, g_q_lat, w_uq, g_kv_lat):
    B, T, _ = h.shape
    p = h @ w_in
    q_lat, c_kv, k_r, q_b, k_b, v_b, g_a, g_b = jnp.split(p, IN_SPLITS, axis=-1)
    q = (rms_norm(q_lat, g_q_lat) @ w_uq).reshape(B, T, H_A, NOPE + ROPE)
    cos, sin = rope_tables(pos, h.dtype)
    q_nope = q[..., :NOPE]
    q_rope = apply_rope(q[..., NOPE:], cos[:, None, :], sin[:, None, :])
    k_rope = apply_rope(k_r, cos, sin)
    c_kv = rms_norm(c_kv, g_kv_lat)
    shp = (B, T, H_B, D_HB)
    return (q_nope, q_rope, c_kv, k_rope, q_b.reshape(shp), k_b.reshape(shp), v_b.reshape(shp),
            jax.nn.sigmoid(g_a), jax.nn.sigmoid(g_b))


def expand_latent(c_kv, w_uk, w_uv):
    B, S, _ = c_kv.shape
    return (c_kv @ w_uk).reshape(B, S, H_A, NOPE), (c_kv @ w_uv).reshape(B, S, H_A, DV)


def mla_attend(q_nope, q_rope, qpos, k_nope, k_rope, v, kpos):
    s = (jnp.einsum('bqhd,bshd->bhqs', q_nope, k_nope)
         + jnp.einsum('bqhr,bsr->bhqs', q_rope, k_rope)).astype(jnp.float32) * MLA_SCALE
    mask = (kpos[None, :] // CHUNK) <= (qpos[:, None] // CHUNK)
    p = jax.nn.softmax(jnp.where(mask, s, NEG), axis=-1)
    return jnp.einsum('bhqs,bshd->bqhd', p.astype(v.dtype), v)


def sb_attend(q, qpos, k, v, kpos):
    z = jnp.einsum('bqhd,bshd->bhqs', q, k).astype(jnp.float32) * SB_SCALE
    mask = kpos[None, :] < qpos[:, None]
    sp = jnp.where(mask, jax.nn.softplus(z), 0.0)
    later = lax.cumsum(sp, axis=3, reverse=True) - sp
    a = jnp.where(mask, jnp.exp(jax.nn.log_sigmoid(z) - later), 0.0)
    return jnp.einsum('bhqs,bshd->bqhd', a.astype(v.dtype), v)


def sweep_query_blocks(attend, qs, qpos, kvs, kpos):
    B, T = qs[0].shape[:2]
    nb = T // Q_BLOCK
    qs_b = tuple(jnp.moveaxis(q.reshape((B, nb, Q_BLOCK) + q.shape[2:]), 1, 0) for q in qs)
    qpos_b = qpos.reshape(nb, Q_BLOCK)

    def body(args):
        return attend(*args[:-1], args[-1], *kvs, kpos)

    out = lax.map(body, qs_b + (qpos_b,))
    return jnp.moveaxis(out, 0, 1).reshape((B, T) + out.shape[3:])


def conv_ffn(h, conv_state, w_up, conv_w, conv_b, w_down):
    T = h.shape[1]
    u = h @ w_up
    u_ext = jnp.concatenate([conv_state, u], axis=1)
    y = conv_b
    for i in range(CONV_W):
        y = y + conv_w[i] * u_ext[:, i:i + T]
    a, b = jnp.split(y, 2, axis=-1)
    return (jax.nn.gelu(a, approximate=True) * b) @ w_down, u_ext[:, T:]


def encoder_layer(x, c, pos, past, w_ada, b_ada, g_pre_mix, g_post_mix, g_pre_ffn, g_post_ffn,
                  w_in, g_q_lat, w_uq, g_kv_lat, w_uk, w_uv, w_proj_a, w_proj_b, w_out,
                  w_up, conv_w, conv_b, w_down):
    B, T, _ = x.shape
    ada = jax.nn.silu(c) @ w_ada + b_ada
    sh1, sc1, gt1, sh2, sc2, gt2 = [a[:, None, :] for a in jnp.split(ada, 6, axis=-1)]
    h = rms_norm(x, g_pre_mix) * (1 + sc1) + sh1
    q_nope, q_rope, c_kv, k_rope, q_b, k_b, v_b, g_a, g_b = mixer_inputs(h, pos, w_in, g_q_lat, w_uq, g_kv_lat)
    if past is None:
        k_nope, v_a = expand_latent(c_kv, w_uk, w_uv)
        o_a = sweep_query_blocks(mla_attend, (q_nope, q_rope), pos, (k_nope, k_rope, v_a), pos)
        o_b = sweep_query_blocks(sb_attend, (q_b,), pos, (k_b, v_b), pos)
        conv_state = jnp.zeros((B, CONV_W - 1, 2 * D_FF), x.dtype)
    else:
        past_ckv, past_krope, past_k, past_v, conv_state = past
        kpos = jnp.arange(past_ckv.shape[1] + T, dtype=jnp.int32)
        k_nope, v_a = expand_latent(jnp.concatenate([past_ckv, c_kv], axis=1), w_uk, w_uv)
        o_a = mla_attend(q_nope, q_rope, pos, k_nope, jnp.concatenate([past_krope, k_rope], axis=1), v_a, kpos)
        o_b = sb_attend(q_b, pos, jnp.concatenate([past_k, k_b], axis=1),
                        jnp.concatenate([past_v, v_b], axis=1), kpos)
    merged = (g_a * (o_a.reshape(B, T, H_A * DV) @ w_proj_a)
              + g_b * (o_b.reshape(B, T, H_B * D_HB) @ w_proj_b))
    x = x + gt1 * rms_norm(merged @ w_out, g_post_mix)
    h2 = rms_norm(x, g_pre_ffn) * (1 + sc2) + sh2
    f, new_conv = conv_ffn(h2, conv_state, w_up, conv_w, conv_b, w_down)
    x = x + gt2 * rms_norm(f, g_post_ffn)
    return x, (c_kv, k_rope, k_b, v_b, new_conv)


def setup_inputs(seed: int = 0) -> dict:
    key = jax.random.key(seed)
    ks = iter(jax.random.split(key, 40))
    nrm = lambda shape, s=1.0: jax.random.normal(next(ks), shape, jnp.float32) * s
    gain = lambda n: 1.0 + nrm((DEPTH, n), 0.05)
    L = DEPTH
    return {
        "x_prompt": nrm((BATCH, SEQ, D_MODEL)),
        "x_sample": nrm((DEC_BATCH, DEC_SEQ, D_MODEL)),
        "cache_mla_ckv": nrm((L, DEC_BATCH, PAST_LEN, KV_RANK)),
        "cache_mla_krope": nrm((L, DEC_BATCH, PAST_LEN, ROPE)),
        "cache_sb_k": nrm((L, DEC_BATCH, PAST_LEN, H_B, D_HB)),
        "cache_sb_v": nrm((L, DEC_BATCH, PAST_LEN, H_B, D_HB)),
        "state_ffn_conv": nrm((L, DEC_BATCH, CONV_W - 1, 2 * D_FF)),
        "c_prompt": nrm((BATCH, D_MODEL)),
        "c_sample": nrm((DEC_BATCH, D_MODEL)),
        "w_ada": nrm((L, D_MODEL, 6 * D_MODEL), D_MODEL ** -0.5),
        "b_ada": nrm((L, 6 * D_MODEL), 0.01),
        "g_pre_mix": gain(D_MODEL),
        "g_post_mix": gain(D_MODEL),
        "g_pre_ffn": gain(D_MODEL),
        "g_post_ffn": gain(D_MODEL),
        "w_in": nrm((L, D_MODEL, N_IN), D_MODEL ** -0.5),
        "g_q_lat": gain(Q_RANK),
        "w_uq": nrm((L, Q_RANK, H_A * (NOPE + ROPE)), Q_RANK ** -0.5),
        "g_kv_lat": gain(KV_RANK),
        "w_uk": nrm((L, KV_RANK, H_A * NOPE), KV_RANK ** -0.5),
        "w_uv": nrm((L, KV_RANK, H_A * DV), KV_RANK ** -0.5),
        "w_proj_a": nrm((L, H_A * DV, D_MODEL), (H_A * DV) ** -0.5),
        "w_proj_b": nrm((L, H_B * D_HB, D_MODEL), (H_B * D_HB) ** -0.5),
        "w_out": nrm((L, D_MODEL, D_MODEL), D_MODEL ** -0.5),
        "w_up": nrm((L, D_MODEL, 2 * D_FF), D_MODEL ** -0.5),
        "conv_w": nrm((L, CONV_W, 2 * D_FF), CONV_W ** -0.5),
        "conv_b": nrm((L, 2 * D_FF), 0.01),
        "w_down": nrm((L, D_FF, D_MODEL), D_FF ** -0.5),
    }


def reference(x_prompt, x_sample, cache_mla_ckv, cache_mla_krope, cache_sb_k, cache_sb_v, state_ffn_conv,
              c_prompt, c_sample, w_ada, b_ada, g_pre_mix, g_post_mix, g_pre_ffn, g_post_ffn,
              w_in, g_q_lat, w_uq, g_kv_lat, w_uk, w_uv, w_proj_a, w_proj_b, w_out,
              w_up, conv_w, conv_b, w_down):
    past_len = cache_mla_ckv.shape[2]
    pos_p = jnp.arange(x_prompt.shape[1], dtype=jnp.int32)
    pos_s = past_len + jnp.arange(x_sample.shape[1], dtype=jnp.int32)
    xp, xs = x_prompt, x_sample
    st_p = [[] for _ in range(5)]
    st_s = [[] for _ in range(5)]
    for l in range(DEPTH):
        w = (w_ada[l], b_ada[l], g_pre_mix[l], g_post_mix[l], g_pre_ffn[l], g_post_ffn[l],
             w_in[l], g_q_lat[l], w_uq[l], g_kv_lat[l], w_uk[l], w_uv[l], w_proj_a[l], w_proj_b[l], w_out[l],
             w_up[l], conv_w[l], conv_b[l], w_down[l])
        xp, sp = encoder_layer(xp, c_prompt, pos_p, None, *w)
        past = (cache_mla_ckv[l], cache_mla_krope[l], cache_sb_k[l], cache_sb_v[l], state_ffn_conv[l])
        xs, ss = encoder_layer(xs, c_sample, pos_s, past, *w)
        for i in range(5):
            st_p[i].append(sp[i])
            st_s[i].append(ss[i])
    p_ckv, p_kr, p_k, p_v, p_conv = [jnp.stack(a, axis=0) for a in st_p]
    s_ckv, s_kr, s_k, s_v, s_conv = [jnp.stack(a, axis=0) for a in st_s]
    return (xp, xs, p_ckv, p_kr, p_k, p_v, p_conv, s_ckv, s_kr, s_k, s_v, s_conv)
```

```cpp
#include <hip/hip_runtime.h>
#include <hip/hip_cooperative_groups.h>
#include <stdint.h>
#include <stdio.h>
#include <string.h>
namespace cg = cooperative_groups;

typedef unsigned short bf16_t;
typedef short bf16x8 __attribute__((ext_vector_type(8)));
typedef short s16x4 __attribute__((ext_vector_type(4)));
typedef float f32x2 __attribute__((ext_vector_type(2)));
typedef float f32x4 __attribute__((ext_vector_type(4)));
typedef float f32x16 __attribute__((ext_vector_type(16)));
typedef unsigned u32x2 __attribute__((ext_vector_type(2)));
typedef unsigned u32x4 __attribute__((ext_vector_type(4)));
typedef __bf16 bf2_t __attribute__((ext_vector_type(2)));
#define DI __device__ __forceinline__

constexpr int DM = 1024, TP = 8192, MP = 16384, MS = 256, MT = 16640, PAST = 4096, SKEYS = 4128, SKP = 4160;
constexpr int KVROWS = MP + 8 * SKEYS;
constexpr int KVROWS_PAD = KVROWS + 64;
constexpr int DFF = 2816, DFF2 = 5632;
constexpr float EPS = 1e-6f;
constexpr float LOG2E = 1.4426950408889634f, LN2 = 0.6931471805599453f;
constexpr int NTHREADS = 512;
constexpr int LDS_BYTES = 131072 + 4096;
constexpr long O_Y = 0, O_CKV_P = 17039360, O_KR_P = 21233664, O_SBK_P = 21757952, O_SBV_P = 30146560, O_CONV_P = 38535168,
               O_CKV_S = 38557696, O_KR_S = 38623232, O_SBK_S = 38631424, O_SBV_S = 38762496, O_CONV_S = 38893568;

struct TJob { const float* src; const float* kscale; bf16_t* dst; int lds, coff, ldd, Klen, Nlen, zero, tile0, pad; };
constexpr int NTJ = 22;

struct Params {
    const float *x_p, *x_s, *c_ckv, *c_kr, *c_sbk, *c_sbv, *c_conv, *c_p, *c_s;
    const float *w_ada, *b_ada, *g_pre_mix, *g_post_mix, *g_pre_ffn, *g_post_ffn, *g_kv, *conv_w, *conv_b;
    float* out;
    bf16_t *WupT, *WdownT, *WinT, *WgT, *WuqT, *WukvT, *WpaT, *WpbT, *WoutT;
    float* ropeT; float* ada; unsigned* ctr;
    bf16_t *h, *o, *qlat, *latent, *krope, *kb, *vbT_p, *vbT_s, *qb, *q, *kva, *vaT_p, *vaT_s, *gates, *merged, *m2, *h2, *u, *g, *f;
    TJob tj[NTJ]; int ntj_tiles; int phase_lo, phase_hi, pad0;
};

typedef const Params __attribute__((address_space(4))) * KP;
DI KP kparams() { KP p = (KP)__builtin_amdgcn_kernarg_segment_ptr(); asm volatile("" : "+s"(p)); return p; }
DI int otid() { int t = threadIdx.x; asm volatile("" : "+v"(t)); return t; }
DI int obid() { int b = blockIdx.x; asm volatile("" : "+s"(b)); return b; }
DI int ogrid() { int g = gridDim.x; asm volatile("" : "+s"(g)); return g; }
DI unsigned pk2(float a, float b) { f32x2 f = {a, b}; bf2_t r = __builtin_convertvector(f, bf2_t); return __builtin_bit_cast(unsigned, r); }
DI float bf_lo(unsigned u) { return __uint_as_float(u << 16); }
DI float bf_hi(unsigned u) { return __uint_as_float(u & 0xffff0000u); }
DI int kvrow_of(int row) { if (row < MP) return row; const int r = row - MP; return MP + (r >> 5) * SKEYS + PAST + (r & 31); }
DI int pos_of(int row) { return row < MP ? (row & (TP - 1)) : PAST + ((row - MP) & 31); }
DI int ada_b(int row) { return row < MP ? (row >> 13) : 2 + ((row - MP) >> 5); }
DI float sigmoidf_(float x) { return 1.0f / (1.0f + __expf(-x)); }

constexpr int BM = 256, BK = 64, HALF = 128, HT = HALF * BK;
DI int lds_byte(int r, int c) { int st = (r >> 4) * 2 + (c >> 5), rr = r & 15, cc = c & 31, ob = rr * 64 + cc * 2; return st * 1024 + (ob ^ (((ob >> 9) & 1) << 5)); }
DI void stage_rc(int b, int& R, int& C) { int st = b / 1024, sb = b % 1024, swz = sb ^ (((sb >> 9) & 1) << 5); R = (st >> 1) * 16 + swz / 64; C = (st & 1) * 32 + (swz % 64) / 2; }

enum { E_INPROJ = 0, E_GATE, E_UQ, E_UKV, E_PROJA, E_PROJB, E_PLAIN, E_UP };
struct GemmDesc { const bf16_t* A; const bf16_t* Bt; bf16_t* C; int lda, ldb, ldc, K, nM, nN, epi, start; };

#define LAS __attribute__((address_space(3)))
DI void gemm_kloop(const char* cA, const char* cB, unsigned lda2, unsigned ldb2, int nt, LAS char* lds, f32x4 (&acc)[2][2][4][2]) {
    const int tid = otid(), wid = __builtin_amdgcn_readfirstlane(tid >> 6), lane = tid & 63, wr = wid >> 2, wc = wid & 3, fr = lane & 15, fq = lane >> 4;
    unsigned voffA[2], voffB[2];
#pragma unroll
    for (int i = 0; i < 2; ++i) { int R, C; stage_rc(tid * 16 + i * 8192, R, C); voffA[i] = (unsigned)R * lda2 + (unsigned)C * 2u; voffB[i] = (unsigned)R * ldb2 + (unsigned)C * 2u; }
    const size_t kstep = 128, hA = (size_t)HALF * lda2, hB = (size_t)HALF * ldb2;
    const unsigned ldsw = (unsigned)wid * 1024u;
    const int aoff = lds_byte(wr * 64 + fr, fq * 8), boff = lds_byte(wc * 32 + fr, fq * 8);
    constexpr int HTB = HT * 2;
#define SA(b, h) (((b) * 2 + (h)) * HTB)
#define SB(b, h) ((4 + (b) * 2 + (h)) * HTB)
#define STAGE(bufoff, gbase, voff) do { _Pragma("unroll") for (int _i = 0; _i < 2; ++_i) \
    __builtin_amdgcn_global_load_lds((const unsigned*)((const char*)(gbase) + (voff)[_i]), (LAS unsigned*)(lds + (bufoff) + ldsw + _i * 8192), 16, 0, 0); } while (0)
#define LDA(dst, b, h) do { _Pragma("unroll") for (int m = 0; m < 4; ++m) _Pragma("unroll") for (int k = 0; k < 2; ++k) dst[m][k] = *(const LAS bf16x8*)(lds + SA(b, h) + aoff + m * 2048 + k * 1024); } while (0)
#define LDB(dst, b, h) do { _Pragma("unroll") for (int n = 0; n < 2; ++n) _Pragma("unroll") for (int k = 0; k < 2; ++k) dst[n][k] = *(const LAS bf16x8*)(lds + SB(b, h) + boff + n * 2048 + k * 1024); } while (0)
#define MMA(ai, bj, At, Bt_) do { __builtin_amdgcn_s_setprio(1); _Pragma("unroll") for (int m = 0; m < 4; ++m) _Pragma("unroll") for (int n = 0; n < 2; ++n) _Pragma("unroll") for (int k = 0; k < 2; ++k) \
      acc[ai][bj][m][n] = __builtin_amdgcn_mfma_f32_16x16x32_bf16(Bt_[n][k], At[m][k], acc[ai][bj][m][n], 0, 0, 0); \
    __builtin_amdgcn_s_setprio(0); } while (0)
#define WAIT_V(n) asm volatile("s_waitcnt vmcnt(" #n ")" ::: "memory")
#define WAIT_L(n) asm volatile("s_waitcnt lgkmcnt(" #n ")" ::: "memory")
#define BAR __builtin_amdgcn_s_barrier()
#define SCHED __builtin_amdgcn_sched_barrier(0)
#pragma unroll
    for (int a = 0; a < 2; ++a)
#pragma unroll
        for (int b = 0; b < 2; ++b)
#pragma unroll
            for (int m = 0; m < 4; ++m)
#pragma unroll
                for (int n = 0; n < 2; ++n) acc[a][b][m][n] = (f32x4){0.f, 0.f, 0.f, 0.f};
    bf16x8 At[4][2], B0[2][2], B1[2][2];
    STAGE(SB(0, 0), cB, voffB); STAGE(SA(0, 0), cA, voffA); STAGE(SB(0, 1), cB + hB, voffB); STAGE(SA(0, 1), cA + hA, voffA);
    if (wr == 1) BAR;
    WAIT_V(4); BAR;
    STAGE(SB(1, 0), cB + kstep, voffB); STAGE(SA(1, 0), cA + kstep, voffA); STAGE(SB(1, 1), cB + hB + kstep, voffB);
    WAIT_V(6); BAR;
    for (int t = 0; t < nt - 2; t += 2) {
        const char* a1 = cA + (size_t)(t + 1) * kstep; const char* a2 = a1 + kstep; const char* a3 = a2 + kstep;
        const char* b2 = cB + (size_t)(t + 2) * kstep; const char* b3 = b2 + kstep;
        LDB(B0, 0, 0); SCHED; LDA(At, 0, 0); STAGE(SA(1, 1), a1 + hA, voffA);
        WAIT_L(8); BAR; WAIT_L(0); MMA(0, 0, At, B0); BAR; SCHED;
        LDB(B1, 0, 1); STAGE(SB(0, 0), b2, voffB);
        BAR; WAIT_L(0); MMA(0, 1, At, B1); BAR;
        LDA(At, 0, 1); STAGE(SA(0, 0), a2, voffA);
        BAR; WAIT_L(0); MMA(1, 0, At, B0); BAR; SCHED;
        STAGE(SB(0, 1), b2 + hB, voffB);
        WAIT_V(6); BAR; MMA(1, 1, At, B1); BAR;
        LDB(B0, 1, 0); SCHED; LDA(At, 1, 0); STAGE(SA(0, 1), a2 + hA, voffA);
        WAIT_L(8); BAR; WAIT_L(0); MMA(0, 0, At, B0); BAR; SCHED;
        LDB(B1, 1, 1); STAGE(SB(1, 0), b3, voffB);
        BAR; WAIT_L(0); MMA(0, 1, At, B1); BAR;
        LDA(At, 1, 1); STAGE(SA(1, 0), a3, voffA);
        BAR; WAIT_L(0); MMA(1, 0, At, B0); BAR; SCHED;
        STAGE(SB(1, 1), b3 + hB, voffB);
        WAIT_V(6); BAR; MMA(1, 1, At, B1); BAR;
    }
    { LDB(B0, 0, 0); LDA(At, 0, 0); STAGE(SA(1, 1), cA + (size_t)(nt - 1) * kstep + hA, voffA);
      BAR; WAIT_L(0); MMA(0, 0, At, B0); BAR;
      LDB(B1, 0, 1); BAR; WAIT_L(0); MMA(0, 1, At, B1); BAR;
      LDA(At, 0, 1); WAIT_V(4); BAR; WAIT_L(0); MMA(1, 0, At, B0); MMA(1, 1, At, B1); BAR; }
    { LDB(B0, 1, 0); LDA(At, 1, 0); WAIT_V(2); BAR; WAIT_L(0); MMA(0, 0, At, B0); BAR;
      LDB(B1, 1, 1); WAIT_V(0); BAR; WAIT_L(0); MMA(0, 1, At, B1); BAR;
      LDA(At, 1, 1); BAR; WAIT_L(0); MMA(1, 0, At, B0); MMA(1, 1, At, B1); BAR; }
    if (wr == 0) BAR;
}

#define EPI_ROWS for (int ai = 0; ai < 2; ++ai) for (int m = 0; m < 4; ++m, ({ asm volatile("" ::: "memory"); }))
#define EPI_COLS for (int bj = 0; bj < 2; ++bj) for (int n = 0; n < 2; ++n)

DI void store_bf4(bf16_t* p, f32x4 v) { u32x2 w; w.x = pk2(v[0], v[1]); w.y = pk2(v[2], v[3]); *(u32x2*)p = w; }

DI void gemm_run(const GemmDesc& d, char* lds) {
    float* xl = (float*)(lds + 131072);
    const int G = ogrid(), nun = d.nM * d.nN;
    const int wid = __builtin_amdgcn_readfirstlane(otid() >> 6), wr = wid >> 2, wc = wid & 3;
    for (int u = (int)((obid() + G - (d.start % G)) % G); u < nun; u += G) {
        const int pm = u / d.nN, pn = u % d.nN, brow = pm * BM, bcol = pn * BM;
        if (d.epi == E_UQ) {
            const int tq_ = otid(), r = tq_ >> 1, hf = tq_ & 1;
            const u32x4* src = (const u32x4*)(d.A + (long)(brow + r) * 384 + hf * 192);
            float s = 0.f;
#pragma unroll 4
            for (int i = 0; i < 24; ++i) { u32x4 v = src[i];
                for (int e = 0; e < 4; ++e) { float a = bf_lo(v[e]), b = bf_hi(v[e]); s += a * a + b * b; } }
            s += __shfl_xor(s, 1);
            if (hf == 0) xl[r] = rsqrtf(s * (1.0f / 384.0f) + EPS);
        }
        f32x4 acc[2][2][4][2];
        gemm_kloop((const char*)(d.A + (size_t)brow * d.lda), (const char*)(d.Bt + (size_t)bcol * d.ldb), (unsigned)d.lda * 2u, (unsigned)d.ldb * 2u, d.K / BK, (LAS char*)lds, acc);
        __syncthreads();
        int lane_e = threadIdx.x & 63; asm volatile("" : "+v"(lane_e));
        const int fr = lane_e & 15, fq = lane_e >> 4;
        KP P = kparams();
        const int rbase = brow + wr * 64 + fr, cbase = bcol + wc * 32 + fq * 4;
        switch (d.epi) {
        case E_INPROJ: {
            if (pn == 0) {
#pragma unroll
                EPI_ROWS { const int row = rbase + ai * 128 + m * 16;
#pragma unroll
                    EPI_COLS store_bf4(P->qlat + (long)row * 384 + (cbase + bj * 128 + n * 16), acc[ai][bj][m][n]); }
            } else if (pn == 1) {
#pragma unroll
                EPI_ROWS { const int row = rbase + ai * 128 + m * 16;
#pragma unroll
                    for (int n = 0; n < 2; ++n) store_bf4(P->qlat + (long)row * 384 + 256 + (wc * 32 + fq * 4 + n * 16), acc[ai][0][m][n]);
                    if (wc == 0) {
                        const int pos = pos_of(row);
                        const f32x4 cs0 = *(const f32x4*)(P->ropeT + (long)pos * 32 + fq * 8), cs1 = *(const f32x4*)(P->ropeT + (long)pos * 32 + fq * 8 + 4);
                        const f32x4 x1 = acc[ai][1][m][0], x2 = acc[ai][1][m][1];
                        f32x4 co = {cs0[0], cs0[2], cs1[0], cs1[2]}, si = {cs0[1], cs0[3], cs1[1], cs1[3]};
                        f32x4 o1 = x1 * co - x2 * si, o2 = x2 * co + x1 * si;
                        float* of = P->out + (row < MP ? O_KR_P + (long)row * 32 : O_KR_S + (long)(row - MP) * 32);
                        *(f32x4*)(of + fq * 4) = o1; *(f32x4*)(of + 16 + fq * 4) = o2;
                        bf16_t* ob = P->krope + (long)kvrow_of(row) * 32;
                        store_bf4(ob + fq * 4, o1); store_bf4(ob + 16 + fq * 4, o2);
                    } }
            } else if (pn == 2) {
                float ss[2][4];
#pragma unroll
                EPI_ROWS { float s = 0.f;
#pragma unroll
                    EPI_COLS { const f32x4 v = acc[ai][bj][m][n]; s += v[0] * v[0] + v[1] * v[1] + v[2] * v[2] + v[3] * v[3]; }
                    s += __shfl_xor(s, 16); s += __shfl_xor(s, 32); ss[ai][m] = s;
                    if (fq == 0) ((float*)lds)[(ai * 128 + wr * 64 + m * 16 + fr) * 4 + wc] = s; }
                __syncthreads();
#pragma unroll
                EPI_ROWS { const int rl = ai * 128 + wr * 64 + m * 16 + fr, row = brow + rl;
                    const f32x4 pp = *(const f32x4*)((float*)lds + rl * 4);
                    const float rstd = rsqrtf((pp[0] + pp[1] + pp[2] + pp[3]) * (1.0f / 256.0f) + EPS);
                    float* of = P->out + (row < MP ? O_CKV_P + (long)row * 256 : O_CKV_S + (long)(row - MP) * 256);
                    bf16_t* ob = P->latent + (long)kvrow_of(row) * 256;
#pragma unroll
                    EPI_COLS { const int c = wc * 32 + fq * 4 + bj * 128 + n * 16;
                        const f32x4 gv = *(const f32x4*)(P->g_kv + c); const f32x4 o = acc[ai][bj][m][n] * rstd * gv;
                        *(f32x4*)(of + c) = o; store_bf4(ob + c, o); } }
            } else if (pn <= 4) {
#pragma unroll
                EPI_ROWS { const int row = rbase + ai * 128 + m * 16;
#pragma unroll
                    EPI_COLS store_bf4(P->qb + (long)row * 512 + (cbase - 768 + bj * 128 + n * 16), acc[ai][bj][m][n] * 0.125f); }
            } else if (pn <= 6) {
#pragma unroll
                EPI_ROWS { const int row = rbase + ai * 128 + m * 16;
                    float* of = P->out + (row < MP ? O_SBK_P + (long)row * 512 : O_SBK_S + (long)(row - MP) * 512);
                    bf16_t* ob = P->kb + (long)kvrow_of(row) * 512;
#pragma unroll
                    EPI_COLS { const int c = cbase - 1280 + bj * 128 + n * 16; *(f32x4*)(of + c) = acc[ai][bj][m][n]; store_bf4(ob + c, acc[ai][bj][m][n]); } }
            } else {
#pragma unroll
                EPI_ROWS { const int row = rbase + ai * 128 + m * 16;
                    float* of = P->out + (row < MP ? O_SBV_P + (long)row * 512 : O_SBV_S + (long)(row - MP) * 512);
                    bf16_t* vt; int ldv;
                    if (row < MP) { vt = P->vbT_p + (long)(row >> 13) * 512 * TP + (row & (TP - 1)); ldv = TP; }
                    else { const int r = row - MP; vt = P->vbT_s + (long)(r >> 5) * 512 * SKP + PAST + (r & 31); ldv = SKP; }
#pragma unroll
                    EPI_COLS { const int c = cbase - 1792 + bj * 128 + n * 16; const f32x4 v = acc[ai][bj][m][n]; *(f32x4*)(of + c) = v;
                        const unsigned w0 = pk2(v[0], v[1]), w1 = pk2(v[2], v[3]);
                        vt[(long)(c + 0) * ldv] = (bf16_t)(w0 & 0xffff); vt[(long)(c + 1) * ldv] = (bf16_t)(w0 >> 16);
                        vt[(long)(c + 2) * ldv] = (bf16_t)(w1 & 0xffff); vt[(long)(c + 3) * ldv] = (bf16_t)(w1 >> 16); } }
            }
        } break;
        case E_GATE: {
#pragma unroll
            EPI_ROWS { const int row = rbase + ai * 128 + m * 16;
#pragma unroll
                EPI_COLS { const f32x4 v = acc[ai][bj][m][n]; f32x4 s = {sigmoidf_(v[0]), sigmoidf_(v[1]), sigmoidf_(v[2]), sigmoidf_(v[3])};
                    store_bf4(P->gates + (long)row * 2048 + (cbase + bj * 128 + n * 16), s); } }
        } break;
        case E_UQ: {
            const float qs = 0.10206207261596577f * LOG2E;
#pragma unroll
            EPI_ROWS { const int rl = ai * 128 + wr * 64 + m * 16 + fr, row = brow + rl; const float rs = xl[rl] * qs;
#pragma unroll
                for (int bj = 0; bj < 2; ++bj) { const int grp = pn * 8 + bj * 4 + wc; bf16_t* dst = P->q + (long)row * 768 + grp * 32 + fq * 4;
                    f32x4 v0 = acc[ai][bj][m][0] * rs, v1 = acc[ai][bj][m][1] * rs;
                    if (grp % 3 == 2) {
                        const int pos = pos_of(row);
                        const f32x4 cs0 = *(const f32x4*)(P->ropeT + (long)pos * 32 + fq * 8), cs1 = *(const f32x4*)(P->ropeT + (long)pos * 32 + fq * 8 + 4);
                        f32x4 co = {cs0[0], cs0[2], cs1[0], cs1[2]}, si = {cs0[1], cs0[3], cs1[1], cs1[3]};
                        const f32x4 o1 = v0 * co - v1 * si, o2 = v1 * co + v0 * si; v0 = o1; v1 = o2;
                    }
                    store_bf4(dst, v0); store_bf4(dst + 16, v1); } }
        } break;
        case E_UKV: {
#pragma unroll
            EPI_ROWS { const int row = rbase + ai * 128 + m * 16;
                if (pn < 2) {
#pragma unroll
                    EPI_COLS store_bf4(P->kva + (long)row * 512 + (cbase + bj * 128 + n * 16), acc[ai][bj][m][n]);
                } else {
                    bf16_t* vt; int ldv;
                    if (row < MP) { vt = P->vaT_p + (long)(row >> 13) * 512 * TP + (row & (TP - 1)); ldv = TP; }
                    else { const int r = row - MP, b = r / SKEYS; vt = P->vaT_s + (long)b * 512 * SKP + (r - b * SKEYS); ldv = SKP; }
                    if (row < KVROWS) {
#pragma unroll
                        EPI_COLS { const int c = cbase - 512 + bj * 128 + n * 16; const f32x4 v = acc[ai][bj][m][n];
                            const unsigned w0 = pk2(v[0], v[1]), w1 = pk2(v[2], v[3]);
                            vt[(long)(c + 0) * ldv] = (bf16_t)(w0 & 0xffff); vt[(long)(c + 1) * ldv] = (bf16_t)(w0 >> 16);
                            vt[(long)(c + 2) * ldv] = (bf16_t)(w1 & 0xffff); vt[(long)(c + 3) * ldv] = (bf16_t)(w1 >> 16); }
                    }
                } }
        } break;
        case E_PROJA: case E_PROJB: {
            const int goff = d.epi == E_PROJA ? 0 : 1024;
#pragma unroll
            EPI_ROWS { const int row = rbase + ai * 128 + m * 16;
#pragma unroll
                EPI_COLS { const int c = cbase + bj * 128 + n * 16; const u32x2 gw = *(const u32x2*)(P->gates + (long)row * 2048 + goff + c);
                    f32x4 gv = {bf_lo(gw.x), bf_hi(gw.x), bf_lo(gw.y), bf_hi(gw.y)}; f32x4 v = acc[ai][bj][m][n] * gv;
                    bf16_t* dst = P->merged + (long)row * 1024 + c;
                    if (d.epi == E_PROJB) { const u32x2 pw = *(const u32x2*)dst; f32x4 pv = {bf_lo(pw.x), bf_hi(pw.x), bf_lo(pw.y), bf_hi(pw.y)}; v += pv; }
                    store_bf4(dst, v); } }
        } break;
        case E_PLAIN: {
#pragma unroll
            EPI_ROWS { const int row = rbase + ai * 128 + m * 16;
#pragma unroll
                EPI_COLS store_bf4(d.C + (long)row * d.ldc + (cbase + bj * 128 + n * 16), acc[ai][bj][m][n]); }
        } break;
        case E_UP: {
#pragma unroll
            EPI_ROWS { const int row = rbase + ai * 128 + m * 16;
                float* cf = nullptr;
                if (row < MP) { const int t = row & (TP - 1); if (t >= TP - 2) cf = P->out + O_CONV_P + (long)((row >> 13) * 2 + (t - (TP - 2))) * DFF2; }
                else { const int r = row - MP, t = r & 31; if (t >= 30) cf = P->out + O_CONV_S + (long)((r >> 5) * 2 + (t - 30)) * DFF2; }
#pragma unroll
                EPI_COLS { const int c = cbase + bj * 128 + n * 16; store_bf4(P->u + (long)row * DFF2 + c, acc[ai][bj][m][n]);
                    if (cf) *(f32x4*)(cf + c) = acc[ai][bj][m][n]; } }
        } break;
        }
        __syncthreads();
    }
}

#define MFMA32(a, b, c) __builtin_amdgcn_mfma_f32_32x32x16_bf16((a), (b), (c), 0, 0, 0)
DI int crow(int i, int h) { return (i & 3) + 8 * (i >> 2) + 4 * h; }

template <int MODE>
DI void attn_unit(KP P, char* lds, bool sample, int b, int h, int ublk) {
    constexpr int DQK = MODE == 0 ? 96 : 64, KS = DQK * 2 + 16, VS = 144, NS = DQK / 16;
    constexpr int KBYTES = 64 * KS, BUF = KBYTES + 64 * VS;
    const int tid = otid(), w = tid >> 6, lane = tid & 63, ql = lane & 31, hh = lane >> 5;
    const int kvrow0 = sample ? MP + b * SKEYS : b * TP;
    const int qrow0 = sample ? MP + b * 32 : b * TP + ublk * 256;
    const int ntiles = sample ? 65 : 4 * (ublk + 1);
    const int t0 = sample ? 0 : ublk * 256 + w * 32, tq = t0 + ql;
    int klim, wmax, wmin;
    if (MODE == 0) { if (sample) { klim = wmax = wmin = SKEYS; } else { klim = ((tq >> 6) + 1) << 6; wmax = (((t0 + 31) >> 6) + 1) << 6; wmin = ((t0 >> 6) + 1) << 6; } }
    else { if (sample) { klim = PAST + tq; wmax = PAST + 31; wmin = PAST; } else { klim = tq; wmax = t0 + 31; wmin = t0; } }
    const bool wactive = sample ? (w == 0) : true;
    const bf16_t* Kp; const bf16_t* Qp; const bf16_t* VT; int ldq; long ldv;
    if (MODE == 0) { Kp = P->kva + (long)kvrow0 * 512 + h * 64; Qp = P->q + (long)qrow0 * 768 + h * 96; ldq = 768;
        VT = sample ? P->vaT_s + (long)(b * 512 + h * 64) * SKP : P->vaT_p + (long)(b * 512 + h * 64) * TP; }
    else { Kp = P->kb + (long)kvrow0 * 512 + h * 64; Qp = P->qb + (long)qrow0 * 512 + h * 64; ldq = 512;
        VT = sample ? P->vbT_s + (long)(b * 512 + h * 64) * SKP : P->vbT_p + (long)(b * 512 + h * 64) * TP; }
    ldv = sample ? SKP : TP;
    const bf16_t* Kr = P->krope + (long)kvrow0 * 32;

    bf16x8 qf[NS];
    if (wactive) {
        const bf16_t* qp = Qp + (long)(w * 32 + ql) * ldq + 8 * hh;
#pragma unroll
        for (int s = 0; s < NS; ++s) qf[s] = *(const bf16x8*)(qp + 16 * s);
    } else {
#pragma unroll
        for (int s = 0; s < NS; ++s) qf[s] = (bf16x8){0, 0, 0, 0, 0, 0, 0, 0};
    }
    f32x16 O0, O1;
#pragma unroll
    for (int i = 0; i < 16; ++i) { O0[i] = 0.f; O1[i] = 0.f; }
    float mrun = -INFINITY, lrun = 0.f, carry = 0.f;

    u32x4 rk0, rk1, rv;
    const int krow_s = tid >> 3, kc_s = tid & 7, rrow_s = tid >> 2, rc_s = tid & 3;
    auto load_tile = [&](int kt) {
        rk0 = *(const u32x4*)(Kp + (long)(kt * 64 + krow_s) * 512 + kc_s * 8);
        if (MODE == 0 && tid < 256) rk1 = *(const u32x4*)(Kr + (long)(kt * 64 + rrow_s) * 32 + rc_s * 8);
        rv = *(const u32x4*)(VT + (long)krow_s * ldv + kt * 64 + kc_s * 8);
    };
    auto store_tile = [&](int buf) {
        char* kb_ = lds + buf * BUF; char* vb_ = kb_ + KBYTES;
        *(u32x4*)(kb_ + krow_s * KS + kc_s * 16) = rk0;
        if (MODE == 0 && tid < 256) *(u32x4*)(kb_ + rrow_s * KS + 128 + rc_s * 16) = rk1;
        *(u32x4*)(vb_ + krow_s * VS + kc_s * 16) = rv;
    };
    load_tile(ntiles - 1); store_tile(0);
    __syncthreads();
    for (int it = 0; it < ntiles; ++it) {
        const int kt = ntiles - 1 - it, cur = it & 1;
        if (it + 1 < ntiles) load_tile(kt - 1);
        if (wactive && kt * 64 < wmax) {
            const char* kb_ = lds + cur * BUF; const char* vb_ = kb_ + KBYTES;
            f32x16 S0, S1;
#pragma unroll
            for (int i = 0; i < 16; ++i) { S0[i] = 0.f; S1[i] = 0.f; }
#pragma unroll
            for (int s = 0; s < NS; ++s) {
                const bf16x8 k0 = *(const bf16x8*)(kb_ + ql * KS + (16 * s + 8 * hh) * 2);
                const bf16x8 k1 = *(const bf16x8*)(kb_ + (32 + ql) * KS + (16 * s + 8 * hh) * 2);
                S0 = MFMA32(k0, qf[s], S0); S1 = MFMA32(k1, qf[s], S1);
            }
            const bool need_mask = (kt * 64 + 64 > wmin);
            const int kbase = kt * 64 + 4 * hh;
            if (MODE == 0) {
                if (need_mask) {
#pragma unroll
                    for (int i = 0; i < 16; ++i) { const int key = kbase + (i & 3) + 8 * (i >> 2);
                        if (key >= klim) S0[i] = -INFINITY; if (key + 32 >= klim) S1[i] = -INFINITY; }
                }
                float mx = S0[0];
#pragma unroll
                for (int i = 1; i < 16; ++i) mx = fmaxf(mx, S0[i]);
#pragma unroll
                for (int i = 0; i < 16; ++i) mx = fmaxf(mx, S1[i]);
                mx = fmaxf(mx, __shfl_xor(mx, 32));
                const float mnew = fmaxf(mrun, mx);
                const float alpha = exp2f(mrun - mnew);
                mrun = mnew;
                float ps = 0.f;
#pragma unroll
                for (int i = 0; i < 16; ++i) { S0[i] = exp2f(S0[i] - mnew); S1[i] = exp2f(S1[i] - mnew); ps += S0[i] + S1[i]; }
                lrun = lrun * alpha + ps;
#pragma unroll
                for (int i = 0; i < 16; ++i) { O0[i] *= alpha; O1[i] *= alpha; }
            } else {
                float gs[2][4], gp[2][4];
                f32x16 SP0, SP1;
#pragma unroll
                for (int i = 0; i < 16; ++i) { const int key = kbase + (i & 3) + 8 * (i >> 2);
                    { const float z = S0[i]; const float t = exp2f(-fabsf(z) * LOG2E); float sp = fmaxf(z, 0.f) + LN2 * __log2f(1.0f + t);
                      if (need_mask && key >= klim) sp = 0.f; SP0[i] = sp; }
                    { const float z = S1[i]; const float t = exp2f(-fabsf(z) * LOG2E); float sp = fmaxf(z, 0.f) + LN2 * __log2f(1.0f + t);
                      if (need_mask && key + 32 >= klim) sp = 0.f; SP1[i] = sp; } }
#pragma unroll
                for (int g = 0; g < 4; ++g) { gs[0][g] = (SP0[4 * g] + SP0[4 * g + 1]) + (SP0[4 * g + 2] + SP0[4 * g + 3]);
                    gs[1][g] = (SP1[4 * g] + SP1[4 * g + 1]) + (SP1[4 * g + 2] + SP1[4 * g + 3]); }
#pragma unroll
                for (int g = 0; g < 4; ++g) { gp[0][g] = __shfl_xor(gs[0][g], 32); gp[1][g] = __shfl_xor(gs[1][g], 32); }
                float running = carry;
#pragma unroll
                for (int blk = 1; blk >= 0; --blk)
#pragma unroll
                    for (int g = 3; g >= 0; --g) {
                        const float sum1 = hh ? gs[blk][g] : gp[blk][g], sum0 = hh ? gp[blk][g] : gs[blk][g];
                        const float mybase = hh ? running : running + sum1;
                        running += sum0 + sum1;
                        float later = mybase;
#pragma unroll
                        for (int j = 3; j >= 0; --j) { const int i = 4 * g + j; const int key = kbase + j + 8 * g + 32 * blk;
                            const float z = blk ? S1[i] : S0[i], sp = blk ? SP1[i] : SP0[i];
                            float a = exp2f((z - sp - later) * LOG2E);
                            if (need_mask && key >= klim) a = 0.f;
                            later += sp;
                            if (blk) S1[i] = a; else S0[i] = a; }
                    }
                carry = running;
            }
            bf16x8 pf[2][2];
#pragma unroll
            for (int s = 0; s < 2; ++s) {
                u32x4 a, c;
                a.x = pk2(S0[8 * s], S0[8 * s + 1]); a.y = pk2(S0[8 * s + 2], S0[8 * s + 3]); a.z = pk2(S0[8 * s + 4], S0[8 * s + 5]); a.w = pk2(S0[8 * s + 6], S0[8 * s + 7]);
                c.x = pk2(S1[8 * s], S1[8 * s + 1]); c.y = pk2(S1[8 * s + 2], S1[8 * s + 3]); c.z = pk2(S1[8 * s + 4], S1[8 * s + 5]); c.w = pk2(S1[8 * s + 6], S1[8 * s + 7]);
                pf[0][s] = __builtin_bit_cast(bf16x8, a); pf[1][s] = __builtin_bit_cast(bf16x8, c);
            }
#pragma unroll
            for (int blk = 0; blk < 2; ++blk)
#pragma unroll
                for (int s = 0; s < 2; ++s) {
                    const int koff = (32 * blk + 16 * s + 4 * hh) * 2;
                    const s16x4 lo0 = *(const s16x4*)(vb_ + ql * VS + koff), hi0 = *(const s16x4*)(vb_ + ql * VS + koff + 16);
                    const s16x4 lo1 = *(const s16x4*)(vb_ + (32 + ql) * VS + koff), hi1 = *(const s16x4*)(vb_ + (32 + ql) * VS + koff + 16);
                    const bf16x8 v0 = __builtin_shufflevector(lo0, hi0, 0, 1, 2, 3, 4, 5, 6, 7), v1 = __builtin_shufflevector(lo1, hi1, 0, 1, 2, 3, 4, 5, 6, 7);
                    O0 = MFMA32(v0, pf[blk][s], O0); O1 = MFMA32(v1, pf[blk][s], O1);
                }
        }
        if (it + 1 < ntiles) store_tile(cur ^ 1);
        __syncthreads();
    }
    if (wactive) {
        float inv = 1.0f;
        if (MODE == 0) { const float lt = lrun + __shfl_xor(lrun, 32); inv = 1.0f / lt; }
        bf16_t* op = P->o + (long)(qrow0 + w * 32 + ql) * 1024 + (MODE == 0 ? 0 : 512) + h * 64 + 4 * hh;
#pragma unroll
        for (int g = 0; g < 4; ++g) {
            f32x4 a = {O0[4 * g] * inv, O0[4 * g + 1] * inv, O0[4 * g + 2] * inv, O0[4 * g + 3] * inv};
            f32x4 c = {O1[4 * g] * inv, O1[4 * g + 1] * inv, O1[4 * g + 2] * inv, O1[4 * g + 3] * inv};
            store_bf4(op + 8 * g, a); store_bf4(op + 32 + 8 * g, c);
        }
    }
}

DI void attn_phase(KP P, char* lds) {
    unsigned* slot = (unsigned*)(lds + 65536);
    for (;;) {
        if (threadIdx.x == 0) *slot = atomicAdd(P->ctr, 1u);
        __syncthreads();
        const unsigned idx = *slot;
        __syncthreads();
        if (idx >= 1152u) break;
        bool sample; int mode, b, h, ublk = 0;
        if (idx < 128u) { sample = true; mode = idx >> 6; b = (idx >> 3) & 7; h = idx & 7; }
        else { const int j = idx - 128; sample = false; ublk = 31 - (j >> 5); const int r = j & 31; mode = r >> 4; b = (r >> 3) & 1; h = r & 7; }
        if (mode == 0) attn_unit<0>(P, lds, sample, b, h, ublk); else attn_unit<1>(P, lds, sample, b, h, ublk);
    }
}

DI void phase0(KP P, char* lds) {
    const int tid = otid(), G = ogrid(), bid = obid(), w = tid >> 6, lane = tid & 63;
    for (int item = bid; item < 96; item += G) {
        float* sc = (float*)lds; float* red = (float*)(lds + 40960);
        for (int i = tid; i < 10240; i += NTHREADS) { const int bb = i >> 10, k = i & 1023; const float cv = bb < 2 ? P->c_p[bb * 1024 + k] : P->c_s[(bb - 2) * 1024 + k]; sc[i] = cv / (1.0f + __expf(-cv)); }
        __syncthreads();
        const int col = item * 64 + lane;
        float a0 = 0, a1 = 0, a2 = 0, a3 = 0, a4 = 0, a5 = 0, a6 = 0, a7 = 0, a8 = 0, a9 = 0;
        for (int k = w * 128; k < w * 128 + 128; ++k) { const float wv = P->w_ada[(long)k * 6144 + col];
            a0 += sc[k] * wv; a1 += sc[1024 + k] * wv; a2 += sc[2048 + k] * wv; a3 += sc[3072 + k] * wv; a4 += sc[4096 + k] * wv;
            a5 += sc[5120 + k] * wv; a6 += sc[6144 + k] * wv; a7 += sc[7168 + k] * wv; a8 += sc[8192 + k] * wv; a9 += sc[9216 + k] * wv; }
        float* rr = red + w * 640 + lane;
        rr[0] = a0; rr[64] = a1; rr[128] = a2; rr[192] = a3; rr[256] = a4; rr[320] = a5; rr[384] = a6; rr[448] = a7; rr[512] = a8; rr[576] = a9;
        __syncthreads();
        for (int i = tid; i < 640; i += NTHREADS) { float s = 0.f; for (int ww = 0; ww < 8; ++ww) s += red[ww * 640 + i];
            const int bb = i >> 6, l = i & 63; P->ada[bb * 6144 + item * 64 + l] = s + P->b_ada[item * 64 + l]; }
        __syncthreads();
    }
    {
        float* tile = (float*)lds;
        for (int it = bid; it < P->ntj_tiles; it += G) {
            int j = 0;
#pragma unroll 1
            for (int q = 1; q < NTJ; ++q) if (it >= P->tj[q].tile0) j = q;
            TJob J; J.src = P->tj[j].src; J.kscale = P->tj[j].kscale; J.dst = P->tj[j].dst; J.lds = P->tj[j].lds; J.coff = P->tj[j].coff; J.ldd = P->tj[j].ldd;
            J.Klen = P->tj[j].Klen; J.Nlen = P->tj[j].Nlen; J.zero = P->tj[j].zero; J.tile0 = P->tj[j].tile0;
            const int lt = it - J.tile0, nk = J.Klen >> 6, tk = lt % nk, tn = lt / nk, k0 = tk * 64, n0 = tn * 64;
            for (int e = tid; e < 4096; e += NTHREADS) { const int kk = e >> 6, nn = e & 63; float v = 0.f;
                if (!J.zero && n0 + nn < J.Nlen) { v = J.src[(long)(k0 + kk) * J.lds + J.coff + n0 + nn]; if (J.kscale) v *= J.kscale[k0 + kk]; }
                tile[kk * 65 + nn] = v; }
            __syncthreads();
            for (int e = tid; e < 2048; e += NTHREADS) { const int nn = e >> 5, kp = e & 31;
                if (n0 + nn < J.Nlen) *(unsigned*)(J.dst + (long)(n0 + nn) * J.ldd + k0 + 2 * kp) = pk2(tile[(2 * kp) * 65 + nn], tile[(2 * kp + 1) * 65 + nn]); }
            __syncthreads();
        }
    }
    const long gt = (long)bid * NTHREADS + tid, gn = (long)G * NTHREADS;
    for (long i = gt; i < 8L * PAST * 64; i += gn) { const long row = i >> 6; const int c = (int)(i & 63) * 4; const int bb = (int)(row >> 12), s = (int)(row & 4095);
        const f32x4 v = *(const f32x4*)(P->c_ckv + row * 256 + c); store_bf4(P->latent + (long)(MP + bb * SKEYS + s) * 256 + c, v); }
    for (long i = gt; i < 8L * PAST * 8; i += gn) { const long row = i >> 3; const int c = (int)(i & 7) * 4; const int bb = (int)(row >> 12), s = (int)(row & 4095);
        const f32x4 v = *(const f32x4*)(P->c_kr + row * 32 + c); store_bf4(P->krope + (long)(MP + bb * SKEYS + s) * 32 + c, v); }
    for (long i = gt; i < 8L * PAST * 128; i += gn) { const long row = i >> 7; const int c = (int)(i & 127) * 4; const int bb = (int)(row >> 12), s = (int)(row & 4095);
        const f32x4 v = *(const f32x4*)(P->c_sbk + row * 512 + c); store_bf4(P->kb + (long)(MP + bb * SKEYS + s) * 512 + c, v); }
    for (long i = gt; i < 8L * 512 * 8; i += gn) { const long r = i >> 3; const int c = (int)(i & 7) * 4; const u32x2 z = {0u, 0u};
        *(u32x2*)(P->vaT_s + r * SKP + SKEYS + c) = z; *(u32x2*)(P->vbT_s + r * SKP + SKEYS + c) = z; }
    for (long i = gt; i < (long)TP * 16; i += gn) { const int pos = (int)(i >> 4), fi = (int)(i & 15);
        const float inv = exp2f(-(float)fi * (13.287712379549449f / 16.0f));
        const float ang = (float)pos * inv;
        const double rev = (double)ang * 0.15915494309189535; const float fr_ = (float)(rev - floor(rev));
        P->ropeT[i * 2] = __builtin_amdgcn_cosf(fr_); P->ropeT[i * 2 + 1] = __builtin_amdgcn_sinf(fr_); }
}

DI void phase_h(KP P) {
    const int tid_ = otid(), lane = tid_ & 63, gw = obid() * 8 + (tid_ >> 6), nw = ogrid() * 8;
    for (int row = gw; row < MT; row += nw) {
        const float* xr = row < MP ? P->x_p + (long)row * DM : P->x_s + (long)(row - MP) * DM;
        const float* ad = P->ada + ada_b(row) * 6144;
        f32x4 v[4]; float s = 0.f;
#pragma unroll
        for (int i = 0; i < 4; ++i) { v[i] = *(const f32x4*)(xr + i * 256 + lane * 4); s += v[i][0] * v[i][0] + v[i][1] * v[i][1] + v[i][2] * v[i][2] + v[i][3] * v[i][3]; }
#pragma unroll
        for (int o = 1; o < 64; o <<= 1) s += __shfl_xor(s, o);
        const float rstd = rsqrtf(s * (1.0f / DM) + EPS);
#pragma unroll
        for (int i = 0; i < 4; ++i) { const int c = i * 256 + lane * 4;
            const f32x4 g = *(const f32x4*)(P->g_pre_mix + c), sh = *(const f32x4*)(ad + c), scl = *(const f32x4*)(ad + 1024 + c);
            store_bf4(P->h + (long)row * DM + c, v[i] * rstd * g * (1.0f + scl) + sh); }
    }
}

DI void phase_mid(KP P) {
    const int tid_ = otid(), lane = tid_ & 63, gw = obid() * 8 + (tid_ >> 6), nw = ogrid() * 8;
    for (int row = gw; row < MT; row += nw) {
        const float* xr = row < MP ? P->x_p + (long)row * DM : P->x_s + (long)(row - MP) * DM;
        const float* ad = P->ada + ada_b(row) * 6144;
        f32x4 mv[4]; float s = 0.f;
#pragma unroll
        for (int i = 0; i < 4; ++i) { const u32x2 wv = *(const u32x2*)(P->m2 + (long)row * DM + i * 256 + lane * 4);
            mv[i] = (f32x4){bf_lo(wv.x), bf_hi(wv.x), bf_lo(wv.y), bf_hi(wv.y)}; s += mv[i][0] * mv[i][0] + mv[i][1] * mv[i][1] + mv[i][2] * mv[i][2] + mv[i][3] * mv[i][3]; }
#pragma unroll
        for (int o = 1; o < 64; o <<= 1) s += __shfl_xor(s, o);
        const float rstd = rsqrtf(s * (1.0f / DM) + EPS);
        float s2 = 0.f;
#pragma unroll
        for (int i = 0; i < 4; ++i) { const int c = i * 256 + lane * 4;
            const f32x4 xv = *(const f32x4*)(xr + c), g = *(const f32x4*)(P->g_post_mix + c), gt = *(const f32x4*)(ad + 2048 + c);
            mv[i] = xv + gt * (mv[i] * rstd * g);
            *(f32x4*)(P->out + O_Y + (long)row * DM + c) = mv[i];
            s2 += mv[i][0] * mv[i][0] + mv[i][1] * mv[i][1] + mv[i][2] * mv[i][2] + mv[i][3] * mv[i][3]; }
#pragma unroll
        for (int o = 1; o < 64; o <<= 1) s2 += __shfl_xor(s2, o);
        const float rstd2 = rsqrtf(s2 * (1.0f / DM) + EPS);
#pragma unroll
        for (int i = 0; i < 4; ++i) { const int c = i * 256 + lane * 4;
            const f32x4 g = *(const f32x4*)(P->g_pre_ffn + c), sh = *(const f32x4*)(ad + 3072 + c), scl = *(const f32x4*)(ad + 4096 + c);
            store_bf4(P->h2 + (long)row * DM + c, mv[i] * rstd2 * g * (1.0f + scl) + sh); }
    }
}

DI void phase_final(KP P) {
    const int tid_ = otid(), lane = tid_ & 63, gw = obid() * 8 + (tid_ >> 6), nw = ogrid() * 8;
    for (int row = gw; row < MT; row += nw) {
        const float* ad = P->ada + ada_b(row) * 6144;
        f32x4 fv[4]; float s = 0.f;
#pragma unroll
        for (int i = 0; i < 4; ++i) { const u32x2 wv = *(const u32x2*)(P->f + (long)row * DM + i * 256 + lane * 4);
            fv[i] = (f32x4){bf_lo(wv.x), bf_hi(wv.x), bf_lo(wv.y), bf_hi(wv.y)}; s += fv[i][0] * fv[i][0] + fv[i][1] * fv[i][1] + fv[i][2] * fv[i][2] + fv[i][3] * fv[i][3]; }
#pragma unroll
        for (int o = 1; o < 64; o <<= 1) s += __shfl_xor(s, o);
        const float rstd = rsqrtf(s * (1.0f / DM) + EPS);
#pragma unroll
        for (int i = 0; i < 4; ++i) { const int c = i * 256 + lane * 4; float* yp = P->out + O_Y + (long)row * DM + c;
            const f32x4 xv = *(const f32x4*)yp, g = *(const f32x4*)(P->g_post_ffn + c), gt = *(const f32x4*)(ad + 5120 + c);
            *(f32x4*)yp = xv + gt * (fv[i] * rstd * g); }
    }
}

DI float gelu_tanh(float a) { const float t = 0.7978845608028654f * (a + 0.044715f * a * a * a); const float e = __expf(2.0f * t); return 0.5f * a * (2.0f - 2.0f / (1.0f + e)); }

DI void phase_conv(KP P) {
    const long gt = (long)obid() * NTHREADS + otid(), gn = (long)ogrid() * NTHREADS;
    for (long i = gt; i < (long)MT * 352; i += gn) {
        const int row = (int)(i / 352), c = (int)(i % 352) * 8;
        int t, bs = -1; if (row < MP) t = row & (TP - 1); else { t = (row - MP) & 31; bs = (row - MP) >> 5; }
        float res[2][8];
#pragma unroll
        for (int hf = 0; hf < 2; ++hf) { const int cc = c + hf * DFF;
            float y[8];
#pragma unroll
            for (int e = 0; e < 8; ++e) y[e] = P->conv_b[cc + e];
#pragma unroll
            for (int tap = 0; tap < 3; ++tap) { const int tt = t + tap - 2;
                float uv[8];
                if (tt >= 0) { const u32x4 wv = *(const u32x4*)(P->u + (long)(row + tap - 2) * DFF2 + cc);
#pragma unroll
                    for (int e = 0; e < 4; ++e) { uv[2 * e] = bf_lo(wv[e]); uv[2 * e + 1] = bf_hi(wv[e]); } }
                else if (bs >= 0) { const float* sp = P->c_conv + (long)(bs * 2 + (tt + 2)) * DFF2 + cc;
#pragma unroll
                    for (int e = 0; e < 8; ++e) uv[e] = sp[e]; }
                else {
#pragma unroll
                    for (int e = 0; e < 8; ++e) uv[e] = 0.f; }
#pragma unroll
                for (int e = 0; e < 8; ++e) y[e] += P->conv_w[tap * DFF2 + cc + e] * uv[e]; }
#pragma unroll
            for (int e = 0; e < 8; ++e) res[hf][e] = y[e]; }
        u32x4 ov;
#pragma unroll
        for (int e = 0; e < 4; ++e) ov[e] = pk2(gelu_tanh(res[0][2 * e]) * res[1][2 * e], gelu_tanh(res[0][2 * e + 1]) * res[1][2 * e + 1]);
        *(u32x4*)(P->g + (long)row * DFF + c) = ov;
    }
}

__global__ void __launch_bounds__(NTHREADS) fwd_megakernel(Params Pval) {
    extern __shared__ __attribute__((aligned(16))) char lds[];
    cg::grid_group grid = cg::this_grid();
    const int lo = kparams()->phase_lo, hi = kparams()->phase_hi;
#define PH(n) if (lo <= (n) && (n) < hi)
#define SYNC(n) if (lo <= (n) && (n) + 1 < hi) grid.sync()
    PH(0) phase0(kparams(), lds);
    SYNC(0);
    PH(1) phase_h(kparams());
    SYNC(1);
    for (int ph = 2; ph <= 12; ++ph) {
        if (ph == 4) { PH(4) attn_phase(kparams(), lds); SYNC(4); continue; }
        if (ph == 8) { PH(8) phase_mid(kparams()); SYNC(8); continue; }
        if (ph == 10) { PH(10) phase_conv(kparams()); SYNC(10); continue; }
        if (ph == 12) { PH(12) phase_final(kparams()); continue; }
        if (lo <= ph && ph < hi) {
            const int npass = (ph == 3 || ph == 6) ? 2 : 1;
            for (int pass = 0; pass < npass; ++pass) {
                GemmDesc d; d.C = nullptr; d.ldc = 0; d.start = 0; KP P = kparams();
                switch (ph) {
                case 2: d.A = P->h; d.lda = DM; d.Bt = P->WinT; d.ldb = DM; d.K = DM; d.nM = 65; d.nN = 9; d.epi = E_INPROJ; break;
                case 3: if (pass == 0) { d.A = P->qlat; d.lda = 384; d.Bt = P->WuqT; d.ldb = 384; d.K = 384; d.nM = 65; d.nN = 3; d.epi = E_UQ; }
                        else { d.A = P->latent; d.lda = 256; d.Bt = P->WukvT; d.ldb = 256; d.K = 256; d.nM = 193; d.nN = 4; d.epi = E_UKV; d.start = 195; } break;
                case 5: d.A = P->h; d.lda = DM; d.Bt = P->WgT; d.ldb = DM; d.K = DM; d.nM = 65; d.nN = 8; d.epi = E_GATE; break;
                case 6: d.A = P->o + pass * 512; d.lda = DM; d.Bt = pass ? P->WpbT : P->WpaT; d.ldb = 512; d.K = 512; d.nM = 65; d.nN = 4; d.epi = pass ? E_PROJB : E_PROJA; break;
                case 7: d.A = P->merged; d.lda = DM; d.Bt = P->WoutT; d.ldb = DM; d.K = DM; d.nM = 65; d.nN = 4; d.epi = E_PLAIN; d.C = P->m2; d.ldc = DM; break;
                case 9: d.A = P->h2; d.lda = DM; d.Bt = P->WupT; d.ldb = DM; d.K = DM; d.nM = 65; d.nN = 22; d.epi = E_UP; break;
                default: d.A = P->g; d.lda = DFF; d.Bt = P->WdownT; d.ldb = DFF; d.K = DFF; d.nM = 65; d.nN = 4; d.epi = E_PLAIN; d.C = P->f; d.ldc = DM; break;
                }
                gemm_run(d, lds);
            }
        }
        SYNC(ph);
    }
}

static size_t bump(size_t& off, size_t bytes) { size_t r = off; off += (bytes + 255) & ~(size_t)255; return r; }

extern "C" void kernel_launch(void* const* d_in, const int* in_sizes, int n_in, void* d_out, int out_size, void* d_ws, size_t ws_size, hipStream_t stream) {
    Params P; memset(&P, 0, sizeof(P));
    const float* const* in = (const float* const*)d_in;
    P.x_p = in[0]; P.x_s = in[1]; P.c_ckv = in[2]; P.c_kr = in[3]; P.c_sbk = in[4]; P.c_sbv = in[5]; P.c_conv = in[6]; P.c_p = in[7]; P.c_s = in[8];
    P.w_ada = in[9]; P.b_ada = in[10]; P.g_pre_mix = in[11]; P.g_post_mix = in[12]; P.g_pre_ffn = in[13]; P.g_post_ffn = in[14];
    const float* w_in = in[15]; const float* g_q = in[16]; const float* w_uq = in[17]; P.g_kv = in[18]; const float* w_uk = in[19]; const float* w_uv = in[20];
    const float* w_pa = in[21]; const float* w_pb = in[22]; const float* w_out = in[23]; const float* w_up = in[24]; P.conv_w = in[25]; P.conv_b = in[26]; const float* w_down = in[27];
    P.out = (float*)d_out;
    char* ws = (char*)d_ws; size_t off = 0;
    P.WupT = (bf16_t*)(ws + bump(off, (size_t)DFF2 * DM * 2));
    P.WdownT = (bf16_t*)(ws + bump(off, (size_t)DM * DFF * 2));
    P.ropeT = (float*)(ws + bump(off, (size_t)TP * 32 * 4));
    P.ada = (float*)(ws + bump(off, 10 * 6144 * 4));
    P.ctr = (unsigned*)(ws + bump(off, 256));
    const size_t R0 = off;
    P.WinT = (bf16_t*)(ws + bump(off, (size_t)2304 * DM * 2));
    P.WgT = (bf16_t*)(ws + bump(off, (size_t)2048 * DM * 2));
    P.WuqT = (bf16_t*)(ws + bump(off, (size_t)768 * 384 * 2));
    P.WukvT = (bf16_t*)(ws + bump(off, (size_t)1024 * 256 * 2));
    P.WpaT = (bf16_t*)(ws + bump(off, (size_t)1024 * 512 * 2));
    P.WpbT = (bf16_t*)(ws + bump(off, (size_t)1024 * 512 * 2));
    P.WoutT = (bf16_t*)(ws + bump(off, (size_t)1024 * 1024 * 2));
    const size_t o_kva = off;
    P.kva = (bf16_t*)(ws + bump(off, (size_t)KVROWS_PAD * 512 * 2));
    P.vaT_p = (bf16_t*)(ws + bump(off, (size_t)2 * 512 * TP * 2));
    P.vaT_s = (bf16_t*)(ws + bump(off, (size_t)8 * 512 * SKP * 2));
    const size_t o_kb = off;
    P.kb = (bf16_t*)(ws + bump(off, (size_t)KVROWS_PAD * 512 * 2));
    const size_t o_vbT = off;
    P.vbT_p = (bf16_t*)(ws + bump(off, (size_t)2 * 512 * TP * 2));
    P.vbT_s = (bf16_t*)(ws + bump(off, (size_t)8 * 512 * SKP * 2));
    const size_t o_kr = off;
    P.krope = (bf16_t*)(ws + bump(off, (size_t)KVROWS_PAD * 32 * 2));
    P.qb = (bf16_t*)(ws + bump(off, (size_t)MT * 512 * 2));
    P.q = (bf16_t*)(ws + bump(off, (size_t)MT * 768 * 2));
    P.latent = (bf16_t*)(ws + bump(off, (size_t)KVROWS_PAD * 256 * 2));
    size_t need = off;
    P.gates = (bf16_t*)(ws + o_kva);
    P.merged = (bf16_t*)(ws + o_kb);
    P.m2 = (bf16_t*)(ws + o_vbT);
    P.u = (bf16_t*)(ws + R0);
    const size_t o_g = R0 + (size_t)MT * DFF2 * 2;
    P.g = (bf16_t*)(ws + o_g);
    P.f = (bf16_t*)(ws + R0);
    size_t o_h2 = o_kr > o_g ? o_kr : o_g;
    P.h2 = (bf16_t*)(ws + o_h2);
    if (o_g + (size_t)MT * DFF * 2 > need) need = o_g + (size_t)MT * DFF * 2;
    if (o_h2 + (size_t)MT * DM * 2 > need) need = o_h2 + (size_t)MT * DM * 2;
    P.h = (bf16_t*)d_out;
    P.o = (bf16_t*)d_out + (size_t)MT * DM;
    P.qlat = P.o;
    if (need > ws_size) { fprintf(stderr, "workspace too small: need %zu have %zu\n", need, ws_size); return; }

    int nj = 0, tiles = 0;
    auto job = [&](const float* src, int lds, int coff, bf16_t* dst, int ldd, int Klen, int Nlen, const float* ks, int zero) {
        TJob& J = P.tj[nj++]; J.src = src; J.kscale = ks; J.dst = dst; J.lds = lds; J.coff = coff; J.ldd = ldd; J.Klen = Klen; J.Nlen = Nlen; J.zero = zero; J.tile0 = tiles; J.pad = 0;
        tiles += (Klen / 64) * ((Nlen + 63) / 64); };
    job(w_up, DFF2, 0, P.WupT, DM, DM, DFF2, nullptr, 0);
    job(w_down, DM, 0, P.WdownT, DFF, DFF, DM, nullptr, 0);
    job(w_in, 4256, 0, P.WinT, DM, DM, 384, nullptr, 0);
    job(w_in, 4256, 640, P.WinT + (size_t)384 * DM, DM, DM, 32, nullptr, 0);
    job(w_in, 4256, 0, P.WinT + (size_t)416 * DM, DM, DM, 96, nullptr, 1);
    job(w_in, 4256, 384, P.WinT + (size_t)512 * DM, DM, DM, 256, nullptr, 0);
    job(w_in, 4256, 672, P.WinT + (size_t)768 * DM, DM, DM, 1536, nullptr, 0);
    job(w_in, 4256, 2208, P.WgT, DM, DM, 2048, nullptr, 0);
    job(w_uq, 768, 0, P.WuqT, 384, 384, 768, g_q, 0);
    job(w_uk, 512, 0, P.WukvT, 256, 256, 512, nullptr, 0);
    job(w_uv, 512, 0, P.WukvT + (size_t)512 * 256, 256, 256, 512, nullptr, 0);
    job(w_pa, DM, 0, P.WpaT, 512, 512, DM, nullptr, 0);
    job(w_pb, DM, 0, P.WpbT, 512, 512, DM, nullptr, 0);
    job(w_out, DM, 0, P.WoutT, DM, DM, DM, nullptr, 0);
    for (int b = 0; b < 8; ++b) job(P.c_sbv + (size_t)b * PAST * 512, 512, 0, P.vbT_s + (size_t)b * 512 * SKP, SKP, PAST, 512, nullptr, 0);
    P.ntj_tiles = tiles;
    P.phase_lo = 0; P.phase_hi = 13;

    static int grid_blocks = 0;
    if (!grid_blocks) {
        (void)hipFuncSetAttribute((const void*)fwd_megakernel, hipFuncAttributeMaxDynamicSharedMemorySize, LDS_BYTES);
        int dev = 0, cus = 0, per_cu = 0;
        (void)hipGetDevice(&dev);
        (void)hipDeviceGetAttribute(&cus, hipDeviceAttributeMultiprocessorCount, dev);
        (void)hipOccupancyMaxActiveBlocksPerMultiprocessor(&per_cu, fwd_megakernel, NTHREADS, LDS_BYTES);
        if (per_cu > 1) per_cu = 1;
        grid_blocks = cus * per_cu;
    }
    (void)hipMemsetAsync(P.ctr, 0, 256, stream);
    void* args[] = {&P};
    hipError_t e = hipLaunchCooperativeKernel((const void*)fwd_megakernel, dim3(grid_blocks), dim3(NTHREADS), args, LDS_BYTES, stream);
    if (e != hipSuccess) fprintf(stderr, "cooperative launch failed: %s (grid %d)\n", hipGetErrorString(e), grid_blocks);
}
```

```cpp
#include <hip/hip_runtime.h>
#include <hip/hip_cooperative_groups.h>
#include <stdint.h>
#include <stdio.h>
#include <string.h>
namespace cg = cooperative_groups;

typedef unsigned short bf16_t;
typedef short bf16x8 __attribute__((ext_vector_type(8)));
typedef short s16x4 __attribute__((ext_vector_type(4)));
typedef float f32x2 __attribute__((ext_vector_type(2)));
typedef float f32x4 __attribute__((ext_vector_type(4)));
typedef float f32x16 __attribute__((ext_vector_type(16)));
typedef unsigned u32x2 __attribute__((ext_vector_type(2)));
typedef unsigned u32x4 __attribute__((ext_vector_type(4)));
typedef __bf16 bf2_t __attribute__((ext_vector_type(2)));
#define DI __device__ __forceinline__

constexpr int DM = 1024, TP = 8192, MP = 16384, MS = 256, MT = 16640, PAST = 4096, SKEYS = 4128, SKP = 4160;
constexpr int KVROWS = MP + 8 * SKEYS;
constexpr int KVROWS_PAD = KVROWS + 64;
constexpr int DFF = 2816, DFF2 = 5632;
constexpr float EPS = 1e-6f;
constexpr float LOG2E = 1.4426950408889634f, LN2 = 0.6931471805599453f;
constexpr int NTHREADS = 512;
constexpr int LDS_BYTES = 131072 + 4096;
constexpr long O_Y = 0, O_CKV_P = 17039360, O_KR_P = 21233664, O_SBK_P = 21757952, O_SBV_P = 30146560, O_CONV_P = 38535168,
               O_CKV_S = 38557696, O_KR_S = 38623232, O_SBK_S = 38631424, O_SBV_S = 38762496, O_CONV_S = 38893568;

struct TJob { const float* src; const float* kscale; bf16_t* dst; int lds, coff, ldd, Klen, Nlen, zero, tile0, pad; };
constexpr int NTJ = 22;

struct Params {
    const float *x_p, *x_s, *c_ckv, *c_kr, *c_sbk, *c_sbv, *c_conv, *c_p, *c_s;
    const float *w_ada, *b_ada, *g_pre_mix, *g_post_mix, *g_pre_ffn, *g_post_ffn, *g_kv, *conv_w, *conv_b;
    float* out;
    bf16_t *WupT, *WdownT, *WinT, *WgT, *WuqT, *WukvT, *WpaT, *WpbT, *WoutT;
    float* ropeT; float* ada; unsigned* ctr;
    bf16_t *h, *o, *qlat, *latent, *krope, *kb, *vbT_p, *vbT_s, *qb, *q, *kva, *vaT_p, *vaT_s, *gates, *merged, *m2, *h2, *u, *g, *f;
    TJob tj[NTJ]; int ntj_tiles; int phase_lo, phase_hi, pad0;
};

typedef const Params __attribute__((address_space(4))) * KP;
DI KP kparams() { KP p = (KP)__builtin_amdgcn_kernarg_segment_ptr(); asm volatile("" : "+s"(p)); return p; }
DI int otid() { int t = threadIdx.x; asm volatile("" : "+v"(t)); return t; }
DI int obid() { int b = blockIdx.x; asm volatile("" : "+s"(b)); return b; }
DI int ogrid() { int g = gridDim.x; asm volatile("" : "+s"(g)); return g; }
DI unsigned pk2(float a, float b) { f32x2 f = {a, b}; bf2_t r = __builtin_convertvector(f, bf2_t); return __builtin_bit_cast(unsigned, r); }
DI float bf_lo(unsigned u) { return __uint_as_float(u << 16); }
DI float bf_hi(unsigned u) { return __uint_as_float(u & 0xffff0000u); }
DI int kvrow_of(int row) { if (row < MP) return row; const int r = row - MP; return MP + (r >> 5) * SKEYS + PAST + (r & 31); }
DI int pos_of(int row) { return row < MP ? (row & (TP - 1)) : PAST + ((row - MP) & 31); }
DI int ada_b(int row) { return row < MP ? (row >> 13) : 2 + ((row - MP) >> 5); }
DI float sigmoidf_(float x) { return 1.0f / (1.0f + __expf(-x)); }

constexpr int BM = 256, BK = 64, HALF = 128, HT = HALF * BK;
DI int lds_byte(int r, int c) { int st = (r >> 4) * 2 + (c >> 5), rr = r & 15, cc = c & 31, ob = rr * 64 + cc * 2; return st * 1024 + (ob ^ (((ob >> 9) & 1) << 5)); }
DI void stage_rc(int b, int& R, int& C) { int st = b / 1024, sb = b % 1024, swz = sb ^ (((sb >> 9) & 1) << 5); R = (st >> 1) * 16 + swz / 64; C = (st & 1) * 32 + (swz % 64) / 2; }

enum { E_INPROJ = 0, E_GATE, E_UQ, E_UKV, E_PROJA, E_PROJB, E_PLAIN, E_UP };
struct GemmDesc { const bf16_t* A; const bf16_t* Bt; bf16_t* C; int lda, ldb, ldc, K, nM, nN, epi, start; };

#define LAS __attribute__((address_space(3)))
DI void gemm_kloop(const char* cA, const char* cB, unsigned lda2, unsigned ldb2, int nt, LAS char* lds, f32x4 (&acc)[2][2][4][2]) {
    const int tid = otid(), wid = __builtin_amdgcn_readfirstlane(tid >> 6), lane = tid & 63, wr = wid >> 2, wc = wid & 3, fr = lane & 15, fq = lane >> 4;
    unsigned voffA[2], voffB[2];
#pragma unroll
    for (int i = 0; i < 2; ++i) { int R, C; stage_rc(tid * 16 + i * 8192, R, C); voffA[i] = (unsigned)R * lda2 + (unsigned)C * 2u; voffB[i] = (unsigned)R * ldb2 + (unsigned)C * 2u; }
    const size_t kstep = 128, hA = (size_t)HALF * lda2, hB = (size_t)HALF * ldb2;
    const unsigned ldsw = (unsigned)wid * 1024u;
    const int aoff = lds_byte(wr * 64 + fr, fq * 8), boff = lds_byte(wc * 32 + fr, fq * 8);
    constexpr int HTB = HT * 2;
#define SA(b, h) (((b) * 2 + (h)) * HTB)
#define SB(b, h) ((4 + (b) * 2 + (h)) * HTB)
#define STAGE(bufoff, gbase, voff) do { _Pragma("unroll") for (int _i = 0; _i < 2; ++_i) \
    __builtin_amdgcn_global_load_lds((const unsigned*)((const char*)(gbase) + (voff)[_i]), (LAS unsigned*)(lds + (bufoff) + ldsw + _i * 8192), 16, 0, 0); } while (0)
#define LDA(dst, b, h) do { _Pragma("unroll") for (int m = 0; m < 4; ++m) _Pragma("unroll") for (int k = 0; k < 2; ++k) dst[m][k] = *(const LAS bf16x8*)(lds + SA(b, h) + aoff + m * 2048 + k * 1024); } while (0)
#define LDB(dst, b, h) do { _Pragma("unroll") for (int n = 0; n < 2; ++n) _Pragma("unroll") for (int k = 0; k < 2; ++k) dst[n][k] = *(const LAS bf16x8*)(lds + SB(b, h) + boff + n * 2048 + k * 1024); } while (0)
#define MMA(ai, bj, At, Bt_) do { __builtin_amdgcn_s_setprio(1); _Pragma("unroll") for (int m = 0; m < 4; ++m) _Pragma("unroll") for (int n = 0; n < 2; ++n) _Pragma("unroll") for (int k = 0; k < 2; ++k) \
      acc[ai][bj][m][n] = __builtin_amdgcn_mfma_f32_16x16x32_bf16(Bt_[n][k], At[m][k], acc[ai][bj][m][n], 0, 0, 0); \
    __builtin_amdgcn_s_setprio(0); } while (0)
#define WAIT_V(n) asm volatile("s_waitcnt vmcnt(" #n ")" ::: "memory")
#define WAIT_L(n) asm volatile("s_waitcnt lgkmcnt(" #n ")" ::: "memory")
#define BAR __builtin_amdgcn_s_barrier()
#define SCHED __builtin_amdgcn_sched_barrier(0)
#pragma unroll
    for (int a = 0; a < 2; ++a)
#pragma unroll
        for (int b = 0; b < 2; ++b)
#pragma unroll
            for (int m = 0; m < 4; ++m)
#pragma unroll
                for (int n = 0; n < 2; ++n) acc[a][b][m][n] = (f32x4){0.f, 0.f, 0.f, 0.f};
    bf16x8 At[4][2], B0[2][2], B1[2][2];
    STAGE(SB(0, 0), cB, voffB); STAGE(SA(0, 0), cA, voffA); STAGE(SB(0, 1), cB + hB, voffB); STAGE(SA(0, 1), cA + hA, voffA);
    if (wr == 1) BAR;
    WAIT_V(4); BAR;
    STAGE(SB(1, 0), cB + kstep, voffB); STAGE(SA(1, 0), cA + kstep, voffA); STAGE(SB(1, 1), cB + hB + kstep, voffB);
    WAIT_V(6); BAR;
    for (int t = 0; t < nt - 2; t += 2) {
        const char* a1 = cA + (size_t)(t + 1) * kstep; const char* a2 = a1 + kstep; const char* a3 = a2 + kstep;
        const char* b2 = cB + (size_t)(t + 2) * kstep; const char* b3 = b2 + kstep;
        LDB(B0, 0, 0); SCHED; LDA(At, 0, 0); STAGE(SA(1, 1), a1 + hA, voffA);
        WAIT_L(8); BAR; WAIT_L(0); MMA(0, 0, At, B0); BAR; SCHED;
        LDB(B1, 0, 1); STAGE(SB(0, 0), b2, voffB);
        BAR; WAIT_L(0); MMA(0, 1, At, B1); BAR;
        LDA(At, 0, 1); STAGE(SA(0, 0), a2, voffA);
        BAR; WAIT_L(0); MMA(1, 0, At, B0); BAR; SCHED;
        STAGE(SB(0, 1), b2 + hB, voffB);
        WAIT_V(6); BAR; MMA(1, 1, At, B1); BAR;
        LDB(B0, 1, 0); SCHED; LDA(At, 1, 0); STAGE(SA(0, 1), a2 + hA, voffA);
        WAIT_L(8); BAR; WAIT_L(0); MMA(0, 0, At, B0); BAR; SCHED;
        LDB(B1, 1, 1); STAGE(SB(1, 0), b3, voffB);
        BAR; WAIT_L(0); MMA(0, 1, At, B1); BAR;
        LDA(At, 1, 1); STAGE(SA(1, 0), a3, voffA);
        BAR; WAIT_L(0); MMA(1, 0, At, B0); BAR; SCHED;
        STAGE(SB(1, 1), b3 + hB, voffB);
        WAIT_V(6); BAR; MMA(1, 1, At, B1); BAR;
    }
    { LDB(B0, 0, 0); LDA(At, 0, 0); STAGE(SA(1, 1), cA + (size_t)(nt - 1) * kstep + hA, voffA);
      BAR; WAIT_L(0); MMA(0, 0, At, B0); BAR;
      LDB(B1, 0, 1); BAR; WAIT_L(0); MMA(0, 1, At, B1); BAR;
      LDA(At, 0, 1); WAIT_V(4); BAR; WAIT_L(0); MMA(1, 0, At, B0); MMA(1, 1, At, B1); BAR; }
    { LDB(B0, 1, 0); LDA(At, 1, 0); WAIT_V(2); BAR; WAIT_L(0); MMA(0, 0, At, B0); BAR;
      LDB(B1, 1, 1); WAIT_V(0); BAR; WAIT_L(0); MMA(0, 1, At, B1); BAR;
      LDA(At, 1, 1); BAR; WAIT_L(0); MMA(1, 0, At, B0); MMA(1, 1, At, B1); BAR; }
    if (wr == 0) BAR;
}

#define EPI_ROWS for (int ai = 0; ai < 2; ++ai) for (int m = 0; m < 4; ++m, ({ asm volatile("" ::: "memory"); }))
#define EPI_COLS for (int bj = 0; bj < 2; ++bj) for (int n = 0; n < 2; ++n)

DI void store_bf4(bf16_t* p, f32x4 v) { u32x2 w; w.x = pk2(v[0], v[1]); w.y = pk2(v[2], v[3]); *(u32x2*)p = w; }

DI void gemm_run(const GemmDesc& d, char* lds) {
    float* xl = (float*)(lds + 131072);
    const int G = ogrid(), nun = d.nM * d.nN;
    const int wid = __builtin_amdgcn_readfirstlane(otid() >> 6), wr = wid >> 2, wc = wid & 3;
    for (int u = (int)((obid() + G - (d.start % G)) % G); u < nun; u += G) {
        const int pm = u / d.nN, pn = u % d.nN, brow = pm * BM, bcol = pn * BM;
        if (d.epi == E_UQ) {
            const int tq_ = otid(), r = tq_ >> 1, hf = tq_ & 1;
            const u32x4* src = (const u32x4*)(d.A + (long)(brow + r) * 384 + hf * 192);
            float s = 0.f;
#pragma unroll 4
            for (int i = 0; i < 24; ++i) { u32x4 v = src[i];
                for (int e = 0; e < 4; ++e) { float a = bf_lo(v[e]), b = bf_hi(v[e]); s += a * a + b * b; } }
            s += __shfl_xor(s, 1);
            if (hf == 0) xl[r] = rsqrtf(s * (1.0f / 384.0f) + EPS);
        }
        f32x4 acc[2][2][4][2];
        gemm_kloop((const char*)(d.A + (size_t)brow * d.lda), (const char*)(d.Bt + (size_t)bcol * d.ldb), (unsigned)d.lda * 2u, (unsigned)d.ldb * 2u, d.K / BK, (LAS char*)lds, acc);
        __syncthreads();
        int lane_e = threadIdx.x & 63; asm volatile("" : "+v"(lane_e));
        const int fr = lane_e & 15, fq = lane_e >> 4;
        KP P = kparams();
        const int rbase = brow + wr * 64 + fr, cbase = bcol + wc * 32 + fq * 4;
        switch (d.epi) {
        case E_INPROJ: {
            if (pn == 0) {
#pragma unroll
                EPI_ROWS { const int row = rbase + ai * 128 + m * 16;
#pragma unroll
                    EPI_COLS store_bf4(P->qlat + (long)row * 384 + (cbase + bj * 128 + n * 16), acc[ai][bj][m][n]); }
            } else if (pn == 1) {
#pragma unroll
                EPI_ROWS { const int row = rbase + ai * 128 + m * 16;
#pragma unroll
                    for (int n = 0; n < 2; ++n) store_bf4(P->qlat + (long)row * 384 + 256 + (wc * 32 + fq * 4 + n * 16), acc[ai][0][m][n]);
                    if (wc == 0) {
                        const int pos = pos_of(row);
                        const f32x4 cs0 = *(const f32x4*)(P->ropeT + (long)pos * 32 + fq * 8), cs1 = *(const f32x4*)(P->ropeT + (long)pos * 32 + fq * 8 + 4);
                        const f32x4 x1 = acc[ai][1][m][0], x2 = acc[ai][1][m][1];
                        f32x4 co = {cs0[0], cs0[2], cs1[0], cs1[2]}, si = {cs0[1], cs0[3], cs1[1], cs1[3]};
                        f32x4 o1 = x1 * co - x2 * si, o2 = x2 * co + x1 * si;
                        float* of = P->out + (row < MP ? O_KR_P + (long)row * 32 : O_KR_S + (long)(row - MP) * 32);
                        *(f32x4*)(of + fq * 4) = o1; *(f32x4*)(of + 16 + fq * 4) = o2;
                        bf16_t* ob = P->krope + (long)kvrow_of(row) * 32;
                        store_bf4(ob + fq * 4, o1); store_bf4(ob + 16 + fq * 4, o2);
                    } }
            } else if (pn == 2) {
                float ss[2][4];
#pragma unroll
                EPI_ROWS { float s = 0.f;
#pragma unroll
                    EPI_COLS { const f32x4 v = acc[ai][bj][m][n]; s += v[0] * v[0] + v[1] * v[1] + v[2] * v[2] + v[3] * v[3]; }
                    s += __shfl_xor(s, 16); s += __shfl_xor(s, 32); ss[ai][m] = s;
                    if (fq == 0) ((float*)lds)[(ai * 128 + wr * 64 + m * 16 + fr) * 4 + wc] = s; }
                __syncthreads();
#pragma unroll
                EPI_ROWS { const int rl = ai * 128 + wr * 64 + m * 16 + fr, row = brow + rl;
                    const f32x4 pp = *(const f32x4*)((float*)lds + rl * 4);
                    const float rstd = rsqrtf((pp[0] + pp[1] + pp[2] + pp[3]) * (1.0f / 256.0f) + EPS);
                    float* of = P->out + (row < MP ? O_CKV_P + (long)row * 256 : O_CKV_S + (long)(row - MP) * 256);
                    bf16_t* ob = P->latent + (long)kvrow_of(row) * 256;
#pragma unroll
                    EPI_COLS { const int c = wc * 32 + fq * 4 + bj * 128 + n * 16;
                        const f32x4 gv = *(const f32x4*)(P->g_kv + c); const f32x4 o = acc[ai][bj][m][n] * rstd * gv;
                        *(f32x4*)(of + c) = o; store_bf4(ob + c, o); } }
            } else if (pn <= 4) {
#pragma unroll
                EPI_ROWS { const int row = rbase + ai * 128 + m * 16;
#pragma unroll
                    EPI_COLS store_bf4(P->qb + (long)row * 512 + (cbase - 768 + bj * 128 + n * 16), acc[ai][bj][m][n] * 0.125f); }
            } else if (pn <= 6) {
#pragma unroll
                EPI_ROWS { const int row = rbase + ai * 128 + m * 16;
                    float* of = P->out + (row < MP ? O_SBK_P + (long)row * 512 : O_SBK_S + (long)(row - MP) * 512);
                    bf16_t* ob = P->kb + (long)kvrow_of(row) * 512;
#pragma unroll
                    EPI_COLS { const int c = cbase - 1280 + bj * 128 + n * 16; *(f32x4*)(of + c) = acc[ai][bj][m][n]; store_bf4(ob + c, acc[ai][bj][m][n]); } }
            } else {
#pragma unroll
                EPI_ROWS { const int row = rbase + ai * 128 + m * 16;
                    float* of = P->out + (row < MP ? O_SBV_P + (long)row * 512 : O_SBV_S + (long)(row - MP) * 512);
                    bf16_t* vt; int ldv;
                    if (row < MP) { vt = P->vbT_p + (long)(row >> 13) * 512 * TP + (row & (TP - 1)); ldv = TP; }
                    else { const int r = row - MP; vt = P->vbT_s + (long)(r >> 5) * 512 * SKP + PAST + (r & 31); ldv = SKP; }
#pragma unroll
                    EPI_COLS { const int c = cbase - 1792 + bj * 128 + n * 16; const f32x4 v = acc[ai][bj][m][n]; *(f32x4*)(of + c) = v;
                        const unsigned w0 = pk2(v[0], v[1]), w1 = pk2(v[2], v[3]);
                        vt[(long)(c + 0) * ldv] = (bf16_t)(w0 & 0xffff); vt[(long)(c + 1) * ldv] = (bf16_t)(w0 >> 16);
                        vt[(long)(c + 2) * ldv] = (bf16_t)(w1 & 0xffff); vt[(long)(c + 3) * ldv] = (bf16_t)(w1 >> 16); } }
            }
        } break;
        case E_GATE: {
#pragma unroll
            EPI_ROWS { const int row = rbase + ai * 128 + m * 16;
#pragma unroll
                EPI_COLS { const f32x4 v = acc[ai][bj][m][n]; f32x4 s = {sigmoidf_(v[0]), sigmoidf_(v[1]), sigmoidf_(v[2]), sigmoidf_(v[3])};
                    store_bf4(P->gates + (long)row * 2048 + (cbase + bj * 128 + n * 16), s); } }
        } break;
        case E_UQ: {
            const float qs = 0.10206207261596577f * LOG2E;
#pragma unroll
            EPI_ROWS { const int rl = ai * 128 + wr * 64 + m * 16 + fr, row = brow + rl; const float rs = xl[rl] * qs;
#pragma unroll
                for (int bj = 0; bj < 2; ++bj) { const int grp = pn * 8 + bj * 4 + wc; bf16_t* dst = P->q + (long)row * 768 + grp * 32 + fq * 4;
                    f32x4 v0 = acc[ai][bj][m][0] * rs, v1 = acc[ai][bj][m][1] * rs;
                    if (grp % 3 == 2) {
                        const int pos = pos_of(row);
                        const f32x4 cs0 = *(const f32x4*)(P->ropeT + (long)pos * 32 + fq * 8), cs1 = *(const f32x4*)(P->ropeT + (long)pos * 32 + fq * 8 + 4);
                        f32x4 co = {cs0[0], cs0[2], cs1[0], cs1[2]}, si = {cs0[1], cs0[3], cs1[1], cs1[3]};
                        const f32x4 o1 = v0 * co - v1 * si, o2 = v1 * co + v0 * si; v0 = o1; v1 = o2;
                    }
                    store_bf4(dst, v0); store_bf4(dst + 16, v1); } }
        } break;
        case E_UKV: {
#pragma unroll
            EPI_ROWS { const int row = rbase + ai * 128 + m * 16;
                if (pn < 2) {
#pragma unroll
                    EPI_COLS store_bf4(P->kva + (long)row * 512 + (cbase + bj * 128 + n * 16), acc[ai][bj][m][n]);
                } else {
                    bf16_t* vt; int ldv;
                    if (row < MP) { vt = P->vaT_p + (long)(row >> 13) * 512 * TP + (row & (TP - 1)); ldv = TP; }
                    else { const int r = row - MP, b = r / SKEYS; vt = P->vaT_s + (long)b * 512 * SKP + (r - b * SKEYS); ldv = SKP; }
                    if (row < KVROWS) {
#pragma unroll
                        EPI_COLS { const int c = cbase - 512 + bj * 128 + n * 16; const f32x4 v = acc[ai][bj][m][n];
                            const unsigned w0 = pk2(v[0], v[1]), w1 = pk2(v[2], v[3]);
                            vt[(long)(c + 0) * ldv] = (bf16_t)(w0 & 0xffff); vt[(long)(c + 1) * ldv] = (bf16_t)(w0 >> 16);
                            vt[(long)(c + 2) * ldv] = (bf16_t)(w1 & 0xffff); vt[(long)(c + 3) * ldv] = (bf16_t)(w1 >> 16); }
                    }
                } }
        } break;
        case E_PROJA: case E_PROJB: {
            const int goff = d.epi == E_PROJA ? 0 : 1024;
#pragma unroll
            EPI_ROWS { const int row = rbase + ai * 128 + m * 16;
#pragma unroll
                EPI_COLS { const int c = cbase + bj * 128 + n * 16; const u32x2 gw = *(const u32x2*)(P->gates + (long)row * 2048 + goff + c);
                    f32x4 gv = {bf_lo(gw.x), bf_hi(gw.x), bf_lo(gw.y), bf_hi(gw.y)}; f32x4 v = acc[ai][bj][m][n] * gv;
                    bf16_t* dst = P->merged + (long)row * 1024 + c;
                    if (d.epi == E_PROJB) { const u32x2 pw = *(const u32x2*)dst; f32x4 pv = {bf_lo(pw.x), bf_hi(pw.x), bf_lo(pw.y), bf_hi(pw.y)}; v += pv; }
                    store_bf4(dst, v); } }
        } break;
        case E_PLAIN: {
#pragma unroll
            EPI_ROWS { const int row = rbase + ai * 128 + m * 16;
#pragma unroll
                EPI_COLS store_bf4(d.C + (long)row * d.ldc + (cbase + bj * 128 + n * 16), acc[ai][bj][m][n]); }
        } break;
        case E_UP: {
#pragma unroll
            EPI_ROWS { const int row = rbase + ai * 128 + m * 16;
                float* cf = nullptr;
                if (row < MP) { const int t = row & (TP - 1); if (t >= TP - 2) cf = P->out + O_CONV_P + (long)((row >> 13) * 2 + (t - (TP - 2))) * DFF2; }
                else { const int r = row - MP, t = r & 31; if (t >= 30) cf = P->out + O_CONV_S + (long)((r >> 5) * 2 + (t - 30)) * DFF2; }
#pragma unroll
                EPI_COLS { const int c = cbase + bj * 128 + n * 16; store_bf4(P->u + (long)row * DFF2 + c, acc[ai][bj][m][n]);
                    if (cf) *(f32x4*)(cf + c) = acc[ai][bj][m][n]; } }
        } break;
        }
        __syncthreads();
    }
}

#define MFMA32(a, b, c) __builtin_amdgcn_mfma_f32_32x32x16_bf16((a), (b), (c), 0, 0, 0)
DI int crow(int i, int h) { return (i & 3) + 8 * (i >> 2) + 4 * h; }

template <int MODE>
DI void attn_unit(KP P, char* lds, bool sample, int b, int h, int ublk) {
    constexpr int DQK = MODE == 0 ? 96 : 64, KS = DQK * 2 + 16, VS = 144, NS = DQK / 16;
    constexpr int KBYTES = 64 * KS, BUF = KBYTES + 64 * VS;
    const int tid = otid(), w = tid >> 6, lane = tid & 63, ql = lane & 31, hh = lane >> 5;
    const int kvrow0 = sample ? MP + b * SKEYS : b * TP;
    const int qrow0 = sample ? MP + b * 32 : b * TP + ublk * 256;
    const int ntiles = sample ? 65 : 4 * (ublk + 1);
    const int t0 = sample ? 0 : ublk * 256 + w * 32, tq = t0 + ql;
    int klim, wmax, wmin;
    if (MODE == 0) { if (sample) { klim = wmax = wmin = SKEYS; } else { klim = ((tq >> 6) + 1) << 6; wmax = (((t0 + 31) >> 6) + 1) << 6; wmin = ((t0 >> 6) + 1) << 6; } }
    else { if (sample) { klim = PAST + tq; wmax = PAST + 31; wmin = PAST; } else { klim = tq; wmax = t0 + 31; wmin = t0; } }
    const bool wactive = sample ? (w == 0) : true;
    const bf16_t* Kp; const bf16_t* Qp; const bf16_t* VT; int ldq; long ldv;
    if (MODE == 0) { Kp = P->kva + (long)kvrow0 * 512 + h * 64; Qp = P->q + (long)qrow0 * 768 + h * 96; ldq = 768;
        VT = sample ? P->vaT_s + (long)(b * 512 + h * 64) * SKP : P->vaT_p + (long)(b * 512 + h * 64) * TP; }
    else { Kp = P->kb + (long)kvrow0 * 512 + h * 64; Qp = P->qb + (long)qrow0 * 512 + h * 64; ldq = 512;
        VT = sample ? P->vbT_s + (long)(b * 512 + h * 64) * SKP : P->vbT_p + (long)(b * 512 + h * 64) * TP; }
    ldv = sample ? SKP : TP;
    const bf16_t* Kr = P->krope + (long)kvrow0 * 32;

    bf16x8 qf[NS];
    if (wactive) {
        const bf16_t* qp = Qp + (long)(w * 32 + ql) * ldq + 8 * hh;
#pragma unroll
        for (int s = 0; s < NS; ++s) qf[s] = *(const bf16x8*)(qp + 16 * s);
    } else {
#pragma unroll
        for (int s = 0; s < NS; ++s) qf[s] = (bf16x8){0, 0, 0, 0, 0, 0, 0, 0};
    }
    f32x16 O0, O1;
#pragma unroll
    for (int i = 0; i < 16; ++i) { O0[i] = 0.f; O1[i] = 0.f; }
    float mrun = -INFINITY, lrun = 0.f, carry = 0.f;
    bool wdone = !wactive;
    volatile int* flags = (volatile int*)(lds + 65536 + 64);

    u32x4 rk0, rk1, rv;
    const int krow_s = tid >> 3, kc_s = tid & 7, rrow_s = tid >> 2, rc_s = tid & 3;
    auto load_tile = [&](int kt) {
        rk0 = *(const u32x4*)(Kp + (long)(kt * 64 + krow_s) * 512 + kc_s * 8);
        if (MODE == 0 && tid < 256) rk1 = *(const u32x4*)(Kr + (long)(kt * 64 + rrow_s) * 32 + rc_s * 8);
        rv = *(const u32x4*)(VT + (long)krow_s * ldv + kt * 64 + kc_s * 8);
    };
    auto store_tile = [&](int buf) {
        char* kb_ = lds + buf * BUF; char* vb_ = kb_ + KBYTES;
        *(u32x4*)(kb_ + krow_s * KS + kc_s * 16) = rk0;
        if (MODE == 0 && tid < 256) *(u32x4*)(kb_ + rrow_s * KS + 128 + rc_s * 16) = rk1;
        *(u32x4*)(vb_ + krow_s * VS + kc_s * 16) = rv;
    };
    load_tile(ntiles - 1); store_tile(0);
    __syncthreads();
    for (int it = 0; it < ntiles; ++it) {
        const int kt = ntiles - 1 - it, cur = it & 1;
        if (it + 1 < ntiles) load_tile(kt - 1);
        if (wactive && !wdone && kt * 64 < wmax) {
            const char* kb_ = lds + cur * BUF; const char* vb_ = kb_ + KBYTES;
            f32x16 S0, S1;
#pragma unroll
            for (int i = 0; i < 16; ++i) { S0[i] = 0.f; S1[i] = 0.f; }
#pragma unroll
            for (int s = 0; s < NS; ++s) {
                const bf16x8 k0 = *(const bf16x8*)(kb_ + ql * KS + (16 * s + 8 * hh) * 2);
                const bf16x8 k1 = *(const bf16x8*)(kb_ + (32 + ql) * KS + (16 * s + 8 * hh) * 2);
                S0 = MFMA32(k0, qf[s], S0); S1 = MFMA32(k1, qf[s], S1);
            }
            const bool need_mask = (kt * 64 + 64 > wmin);
            const int kbase = kt * 64 + 4 * hh;
            if (MODE == 0) {
                if (need_mask) {
#pragma unroll
                    for (int i = 0; i < 16; ++i) { const int key = kbase + (i & 3) + 8 * (i >> 2);
                        if (key >= klim) S0[i] = -INFINITY; if (key + 32 >= klim) S1[i] = -INFINITY; }
                }
                float mx = S0[0];
#pragma unroll
                for (int i = 1; i < 16; ++i) mx = fmaxf(mx, S0[i]);
#pragma unroll
                for (int i = 0; i < 16; ++i) mx = fmaxf(mx, S1[i]);
                mx = fmaxf(mx, __shfl_xor(mx, 32));
                const float mnew = fmaxf(mrun, mx);
                const float alpha = __builtin_amdgcn_exp2f(mrun - mnew);
                mrun = mnew;
                float ps = 0.f;
#pragma unroll
                for (int i = 0; i < 16; ++i) { S0[i] = __builtin_amdgcn_exp2f(S0[i] - mnew); S1[i] = __builtin_amdgcn_exp2f(S1[i] - mnew); ps += S0[i] + S1[i]; }
                lrun = lrun * alpha + ps;
#pragma unroll
                for (int i = 0; i < 16; ++i) { O0[i] *= alpha; O1[i] *= alpha; }
            } else {
                float gs[2][4], gp[2][4];
                f32x16 SP0, SP1;
#pragma unroll
                for (int i = 0; i < 16; ++i) { const int key = kbase + (i & 3) + 8 * (i >> 2);
                    { const float z = S0[i]; const float t = __builtin_amdgcn_exp2f(-fabsf(z) * LOG2E); float sp = fmaxf(z, 0.f) + LN2 * __builtin_amdgcn_logf(1.0f + t);
                      if (need_mask && key >= klim) sp = 0.f; SP0[i] = sp; }
                    { const float z = S1[i]; const float t = __builtin_amdgcn_exp2f(-fabsf(z) * LOG2E); float sp = fmaxf(z, 0.f) + LN2 * __builtin_amdgcn_logf(1.0f + t);
                      if (need_mask && key + 32 >= klim) sp = 0.f; SP1[i] = sp; } }
#pragma unroll
                for (int g = 0; g < 4; ++g) { gs[0][g] = (SP0[4 * g] + SP0[4 * g + 1]) + (SP0[4 * g + 2] + SP0[4 * g + 3]);
                    gs[1][g] = (SP1[4 * g] + SP1[4 * g + 1]) + (SP1[4 * g + 2] + SP1[4 * g + 3]); }
#pragma unroll
                for (int g = 0; g < 4; ++g) { gp[0][g] = __shfl_xor(gs[0][g], 32); gp[1][g] = __shfl_xor(gs[1][g], 32); }
                float running = carry;
#pragma unroll
                for (int blk = 1; blk >= 0; --blk)
#pragma unroll
                    for (int g = 3; g >= 0; --g) {
                        const float sum1 = hh ? gs[blk][g] : gp[blk][g], sum0 = hh ? gp[blk][g] : gs[blk][g];
                        const float mybase = hh ? running : running + sum1;
                        running += sum0 + sum1;
                        float later = mybase;
#pragma unroll
                        for (int j = 3; j >= 0; --j) { const int i = 4 * g + j; const int key = kbase + j + 8 * g + 32 * blk;
                            const float z = blk ? S1[i] : S0[i], sp = blk ? SP1[i] : SP0[i];
                            float a = __builtin_amdgcn_exp2f((z - sp - later) * LOG2E);
                            if (need_mask && key >= klim) a = 0.f;
                            later += sp;
                            if (blk) S1[i] = a; else S0[i] = a; }
                    }
                carry = running;
                wdone = __all((carry > 104.0f) || (klim <= 0));
            }
            bf16x8 pf[2][2];
#pragma unroll
            for (int s = 0; s < 2; ++s) {
                u32x4 a, c;
                a.x = pk2(S0[8 * s], S0[8 * s + 1]); a.y = pk2(S0[8 * s + 2], S0[8 * s + 3]); a.z = pk2(S0[8 * s + 4], S0[8 * s + 5]); a.w = pk2(S0[8 * s + 6], S0[8 * s + 7]);
                c.x = pk2(S1[8 * s], S1[8 * s + 1]); c.y = pk2(S1[8 * s + 2], S1[8 * s + 3]); c.z = pk2(S1[8 * s + 4], S1[8 * s + 5]); c.w = pk2(S1[8 * s + 6], S1[8 * s + 7]);
                pf[0][s] = __builtin_bit_cast(bf16x8, a); pf[1][s] = __builtin_bit_cast(bf16x8, c);
            }
#pragma unroll
            for (int blk = 0; blk < 2; ++blk)
#pragma unroll
                for (int s = 0; s < 2; ++s) {
                    const int koff = (32 * blk + 16 * s + 4 * hh) * 2;
                    const s16x4 lo0 = *(const s16x4*)(vb_ + ql * VS + koff), hi0 = *(const s16x4*)(vb_ + ql * VS + koff + 16);
                    const s16x4 lo1 = *(const s16x4*)(vb_ + (32 + ql) * VS + koff), hi1 = *(const s16x4*)(vb_ + (32 + ql) * VS + koff + 16);
                    const bf16x8 v0 = __builtin_shufflevector(lo0, hi0, 0, 1, 2, 3, 4, 5, 6, 7), v1 = __builtin_shufflevector(lo1, hi1, 0, 1, 2, 3, 4, 5, 6, 7);
                    O0 = MFMA32(v0, pf[blk][s], O0); O1 = MFMA32(v1, pf[blk][s], O1);
                }
        }
        if (it + 1 < ntiles) store_tile(cur ^ 1);
        if (MODE == 1 && lane == 0) flags[(it & 1) * 8 + w] = wdone ? 1 : 0;
        __syncthreads();
        if (MODE == 1) { int alld = 1;
#pragma unroll
            for (int ww = 0; ww < 8; ++ww) alld &= flags[(it & 1) * 8 + ww];
            if (alld) break; }
    }
    if (wactive) {
        float inv = 1.0f;
        if (MODE == 0) { const float lt = lrun + __shfl_xor(lrun, 32); inv = 1.0f / lt; }
        bf16_t* op = P->o + (long)(qrow0 + w * 32 + ql) * 1024 + (MODE == 0 ? 0 : 512) + h * 64 + 4 * hh;
#pragma unroll
        for (int g = 0; g < 4; ++g) {
            f32x4 a = {O0[4 * g] * inv, O0[4 * g + 1] * inv, O0[4 * g + 2] * inv, O0[4 * g + 3] * inv};
            f32x4 c = {O1[4 * g] * inv, O1[4 * g + 1] * inv, O1[4 * g + 2] * inv, O1[4 * g + 3] * inv};
            store_bf4(op + 8 * g, a); store_bf4(op + 32 + 8 * g, c);
        }
    }
}

DI void attn_phase(KP P, char* lds, int cidx) {
    unsigned* slot = (unsigned*)(lds + 65536);
    for (;;) {
        if (threadIdx.x == 0) *slot = atomicAdd(P->ctr + cidx, 1u);
        __syncthreads();
        const unsigned idx = *slot;
        __syncthreads();
        if (idx >= 1152u) break;
        bool sample; int mode, b, h, ublk = 0;
        if (idx < 128u) { sample = true; mode = idx >> 6; b = (idx >> 3) & 7; h = idx & 7; }
        else { const int j = idx - 128; sample = false; ublk = 31 - (j >> 5); const int r = j & 31; mode = r >> 4; b = (r >> 3) & 1; h = r & 7; }
        if (mode == 0) attn_unit<0>(P, lds, sample, b, h, ublk); else attn_unit<1>(P, lds, sample, b, h, ublk);
    }
}

DI void phase0(KP P, char* lds) {
    const int tid = otid(), G = ogrid(), bid = obid(), w = tid >> 6, lane = tid & 63;
    for (int item = bid; item < 96; item += G) {
        float* sc = (float*)lds; float* red = (float*)(lds + 40960);
        for (int i = tid; i < 10240; i += NTHREADS) { const int bb = i >> 10, k = i & 1023; const float cv = bb < 2 ? P->c_p[bb * 1024 + k] : P->c_s[(bb - 2) * 1024 + k]; sc[i] = cv / (1.0f + __expf(-cv)); }
        __syncthreads();
        const int col = item * 64 + lane;
        float a0 = 0, a1 = 0, a2 = 0, a3 = 0, a4 = 0, a5 = 0, a6 = 0, a7 = 0, a8 = 0, a9 = 0;
        for (int k0 = w * 128; k0 < w * 128 + 128; k0 += 16) {
            float wv[16];
#pragma unroll
            for (int j = 0; j < 16; ++j) wv[j] = P->w_ada[(long)(k0 + j) * 6144 + col];
#pragma unroll
            for (int j = 0; j < 16; ++j) { const int k = k0 + j;
                a0 += sc[k] * wv[j]; a1 += sc[1024 + k] * wv[j]; a2 += sc[2048 + k] * wv[j]; a3 += sc[3072 + k] * wv[j]; a4 += sc[4096 + k] * wv[j];
                a5 += sc[5120 + k] * wv[j]; a6 += sc[6144 + k] * wv[j]; a7 += sc[7168 + k] * wv[j]; a8 += sc[8192 + k] * wv[j]; a9 += sc[9216 + k] * wv[j]; }
        }
        float* rr = red + w * 640 + lane;
        rr[0] = a0; rr[64] = a1; rr[128] = a2; rr[192] = a3; rr[256] = a4; rr[320] = a5; rr[384] = a6; rr[448] = a7; rr[512] = a8; rr[576] = a9;
        __syncthreads();
        for (int i = tid; i < 640; i += NTHREADS) { float s = 0.f; for (int ww = 0; ww < 8; ++ww) s += red[ww * 640 + i];
            const int bb = i >> 6, l = i & 63; P->ada[bb * 6144 + item * 64 + l] = s + P->b_ada[item * 64 + l]; }
        __syncthreads();
    }
    {
        float* tile = (float*)lds;
        for (int it = (bid + 96) % G; it < P->ntj_tiles; it += G) {
            int j = 0;
#pragma unroll 1
            for (int q = 1; q < NTJ; ++q) if (it >= P->tj[q].tile0) j = q;
            TJob J; J.src = P->tj[j].src; J.kscale = P->tj[j].kscale; J.dst = P->tj[j].dst; J.lds = P->tj[j].lds; J.coff = P->tj[j].coff; J.ldd = P->tj[j].ldd;
            J.Klen = P->tj[j].Klen; J.Nlen = P->tj[j].Nlen; J.zero = P->tj[j].zero; J.tile0 = P->tj[j].tile0;
            const int lt = it - J.tile0, nk = J.Klen >> 6, tk = lt % nk, tn = lt / nk, k0 = tk * 64, n0 = tn * 256;
            f32x4 lv[8];
#pragma unroll
            for (int r = 0; r < 8; ++r) { const int e = tid + r * NTHREADS, kk = e >> 6, n4 = (e & 63) * 4;
                lv[r] = (f32x4){0.f, 0.f, 0.f, 0.f};
                if (!J.zero && n0 + n4 < J.Nlen) lv[r] = *(const f32x4*)(J.src + (long)(k0 + kk) * J.lds + J.coff + n0 + n4); }
#pragma unroll
            for (int r = 0; r < 8; ++r) { const int e = tid + r * NTHREADS, kk = e >> 6, n4 = (e & 63) * 4;
                f32x4 v = lv[r]; if (J.kscale) v *= J.kscale[k0 + kk];
                float* tp = tile + kk * 257 + n4; tp[0] = v[0]; tp[1] = v[1]; tp[2] = v[2]; tp[3] = v[3]; }
            __syncthreads();
#pragma unroll
            for (int r = 0; r < 4; ++r) { const int e = tid + r * NTHREADS, nn = e >> 3, kc = (e & 7) * 8;
                if (n0 + nn < J.Nlen) { const float* tp = tile + kc * 257 + nn; u32x4 o;
                    o.x = pk2(tp[0], tp[257]); o.y = pk2(tp[2 * 257], tp[3 * 257]); o.z = pk2(tp[4 * 257], tp[5 * 257]); o.w = pk2(tp[6 * 257], tp[7 * 257]);
                    *(u32x4*)(J.dst + (long)(n0 + nn) * J.ldd + k0 + kc) = o; } }
            __syncthreads();
        }
    }
    const long gt = (long)bid * NTHREADS + tid, gn = (long)G * NTHREADS;
    for (long i0 = gt; i0 < 8L * PAST * 64; i0 += 4 * gn) { f32x4 v[4];
#pragma unroll
        for (int r = 0; r < 4; ++r) { const long i = i0 + r * gn; if (i < 8L * PAST * 64) v[r] = *(const f32x4*)(P->c_ckv + i * 4); }
#pragma unroll
        for (int r = 0; r < 4; ++r) { const long i = i0 + r * gn; if (i < 8L * PAST * 64) { const long row = i >> 6; const int c = (int)(i & 63) * 4; const int bb = (int)(row >> 12), sq = (int)(row & 4095);
            store_bf4(P->latent + (long)(MP + bb * SKEYS + sq) * 256 + c, v[r]); } } }
    for (long i0 = gt; i0 < 8L * PAST * 8; i0 += 4 * gn) { f32x4 v[4];
#pragma unroll
        for (int r = 0; r < 4; ++r) { const long i = i0 + r * gn; if (i < 8L * PAST * 8) v[r] = *(const f32x4*)(P->c_kr + i * 4); }
#pragma unroll
        for (int r = 0; r < 4; ++r) { const long i = i0 + r * gn; if (i < 8L * PAST * 8) { const long row = i >> 3; const int c = (int)(i & 7) * 4; const int bb = (int)(row >> 12), sq = (int)(row & 4095);
            store_bf4(P->krope + (long)(MP + bb * SKEYS + sq) * 32 + c, v[r]); } } }
    for (long i0 = gt; i0 < 8L * PAST * 128; i0 += 4 * gn) { f32x4 v[4];
#pragma unroll
        for (int r = 0; r < 4; ++r) { const long i = i0 + r * gn; if (i < 8L * PAST * 128) v[r] = *(const f32x4*)(P->c_sbk + i * 4); }
#pragma unroll
        for (int r = 0; r < 4; ++r) { const long i = i0 + r * gn; if (i < 8L * PAST * 128) { const long row = i >> 7; const int c = (int)(i & 127) * 4; const int bb = (int)(row >> 12), sq = (int)(row & 4095);
            store_bf4(P->kb + (long)(MP + bb * SKEYS + sq) * 512 + c, v[r]); } } }
    for (long i = gt; i < 8L * 512 * 8; i += gn) { const long r = i >> 3; const int c = (int)(i & 7) * 4; const u32x2 z = {0u, 0u};
        *(u32x2*)(P->vaT_s + r * SKP + SKEYS + c) = z; *(u32x2*)(P->vbT_s + r * SKP + SKEYS + c) = z; }
    for (long i = gt; i < (long)TP * 16; i += gn) { const int pos = (int)(i >> 4), fi = (int)(i & 15);
        const float inv = exp2f(-(float)fi * (13.287712379549449f / 16.0f));
        const float ang = (float)pos * inv;
        const double rev = (double)ang * 0.15915494309189535; const float fr_ = (float)(rev - floor(rev));
        P->ropeT[i * 2] = __builtin_amdgcn_cosf(fr_); P->ropeT[i * 2 + 1] = __builtin_amdgcn_sinf(fr_); }
}

DI void phase_h(KP P) {
    const int tid_ = otid(), lane = tid_ & 63, gw = obid() * 8 + (tid_ >> 6), nw = ogrid() * 8;
    for (int row = gw; row < MT; row += nw) {
        const float* xr = row < MP ? P->x_p + (long)row * DM : P->x_s + (long)(row - MP) * DM;
        const float* ad = P->ada + ada_b(row) * 6144;
        f32x4 v[4]; float s = 0.f;
#pragma unroll
        for (int i = 0; i < 4; ++i) { v[i] = *(const f32x4*)(xr + i * 256 + lane * 4); s += v[i][0] * v[i][0] + v[i][1] * v[i][1] + v[i][2] * v[i][2] + v[i][3] * v[i][3]; }
#pragma unroll
        for (int o = 1; o < 64; o <<= 1) s += __shfl_xor(s, o);
        const float rstd = rsqrtf(s * (1.0f / DM) + EPS);
#pragma unroll
        for (int i = 0; i < 4; ++i) { const int c = i * 256 + lane * 4;
            const f32x4 g = *(const f32x4*)(P->g_pre_mix + c), sh = *(const f32x4*)(ad + c), scl = *(const f32x4*)(ad + 1024 + c);
            store_bf4(P->h + (long)row * DM + c, v[i] * rstd * g * (1.0f + scl) + sh); }
    }
}

DI void phase_mid(KP P) {
    const int tid_ = otid(), lane = tid_ & 63, gw = obid() * 8 + (tid_ >> 6), nw = ogrid() * 8;
    for (int row = gw; row < MT; row += nw) {
        const float* xr = row < MP ? P->x_p + (long)row * DM : P->x_s + (long)(row - MP) * DM;
        const float* ad = P->ada + ada_b(row) * 6144;
        f32x4 mv[4]; float s = 0.f;
#pragma unroll
        for (int i = 0; i < 4; ++i) { const u32x2 wv = *(const u32x2*)(P->m2 + (long)row * DM + i * 256 + lane * 4);
            mv[i] = (f32x4){bf_lo(wv.x), bf_hi(wv.x), bf_lo(wv.y), bf_hi(wv.y)}; s += mv[i][0] * mv[i][0] + mv[i][1] * mv[i][1] + mv[i][2] * mv[i][2] + mv[i][3] * mv[i][3]; }
#pragma unroll
        for (int o = 1; o < 64; o <<= 1) s += __shfl_xor(s, o);
        const float rstd = rsqrtf(s * (1.0f / DM) + EPS);
        float s2 = 0.f;
#pragma unroll
        for (int i = 0; i < 4; ++i) { const int c = i * 256 + lane * 4;
            const f32x4 xv = *(const f32x4*)(xr + c), g = *(const f32x4*)(P->g_post_mix + c), gt = *(const f32x4*)(ad + 2048 + c);
            mv[i] = xv + gt * (mv[i] * rstd * g);
            *(f32x4*)(P->out + O_Y + (long)row * DM + c) = mv[i];
            s2 += mv[i][0] * mv[i][0] + mv[i][1] * mv[i][1] + mv[i][2] * mv[i][2] + mv[i][3] * mv[i][3]; }
#pragma unroll
        for (int o = 1; o < 64; o <<= 1) s2 += __shfl_xor(s2, o);
        const float rstd2 = rsqrtf(s2 * (1.0f / DM) + EPS);
#pragma unroll
        for (int i = 0; i < 4; ++i) { const int c = i * 256 + lane * 4;
            const f32x4 g = *(const f32x4*)(P->g_pre_ffn + c), sh = *(const f32x4*)(ad + 3072 + c), scl = *(const f32x4*)(ad + 4096 + c);
            store_bf4(P->h2 + (long)row * DM + c, mv[i] * rstd2 * g * (1.0f + scl) + sh); }
    }
}

DI void phase_final(KP P) {
    const int tid_ = otid(), lane = tid_ & 63, gw = obid() * 8 + (tid_ >> 6), nw = ogrid() * 8;
    for (int row = gw; row < MT; row += nw) {
        const float* ad = P->ada + ada_b(row) * 6144;
        f32x4 fv[4]; float s = 0.f;
#pragma unroll
        for (int i = 0; i < 4; ++i) { const u32x2 wv = *(const u32x2*)(P->f + (long)row * DM + i * 256 + lane * 4);
            fv[i] = (f32x4){bf_lo(wv.x), bf_hi(wv.x), bf_lo(wv.y), bf_hi(wv.y)}; s += fv[i][0] * fv[i][0] + fv[i][1] * fv[i][1] + fv[i][2] * fv[i][2] + fv[i][3] * fv[i][3]; }
#pragma unroll
        for (int o = 1; o < 64; o <<= 1) s += __shfl_xor(s, o);
        const float rstd = rsqrtf(s * (1.0f / DM) + EPS);
#pragma unroll
        for (int i = 0; i < 4; ++i) { const int c = i * 256 + lane * 4; float* yp = P->out + O_Y + (long)row * DM + c;
            const f32x4 xv = *(const f32x4*)yp, g = *(const f32x4*)(P->g_post_ffn + c), gt = *(const f32x4*)(ad + 5120 + c);
            *(f32x4*)yp = xv + gt * (fv[i] * rstd * g); }
    }
}

DI float gelu_tanh(float a) { const float t = 0.7978845608028654f * (a + 0.044715f * a * a * a); const float e = __expf(2.0f * t); return 0.5f * a * (2.0f - 2.0f / (1.0f + e)); }

DI void phase_conv(KP P) {
    const long gt = (long)obid() * NTHREADS + otid(), gn = (long)ogrid() * NTHREADS;
    for (long i = gt; i < (long)(MT / 8) * 352; i += gn) {
        const int rg = (int)(i / 352), c = (int)(i % 352) * 8, row0 = rg * 8;
        int t0, bs = -1; if (row0 < MP) t0 = row0 & (TP - 1); else { t0 = (row0 - MP) & 31; bs = (row0 - MP) >> 5; }
        u32x4 ua[10], ub[10];
#pragma unroll
        for (int r = 0; r < 10; ++r) { const int rr = (t0 == 0 && r < 2) ? row0 : row0 + r - 2;
            ua[r] = *(const u32x4*)(P->u + (long)rr * DFF2 + c); ub[r] = *(const u32x4*)(P->u + (long)rr * DFF2 + DFF + c); }
        float wa[3][8], wb[3][8], ba[8], bb[8];
#pragma unroll
        for (int tap = 0; tap < 3; ++tap) { const f32x4 x0 = *(const f32x4*)(P->conv_w + tap * DFF2 + c), x1 = *(const f32x4*)(P->conv_w + tap * DFF2 + c + 4);
            const f32x4 y0 = *(const f32x4*)(P->conv_w + tap * DFF2 + DFF + c), y1 = *(const f32x4*)(P->conv_w + tap * DFF2 + DFF + c + 4);
#pragma unroll
            for (int e = 0; e < 4; ++e) { wa[tap][e] = x0[e]; wa[tap][4 + e] = x1[e]; wb[tap][e] = y0[e]; wb[tap][4 + e] = y1[e]; } }
        { const f32x4 x0 = *(const f32x4*)(P->conv_b + c), x1 = *(const f32x4*)(P->conv_b + c + 4), y0 = *(const f32x4*)(P->conv_b + DFF + c), y1 = *(const f32x4*)(P->conv_b + DFF + c + 4);
#pragma unroll
          for (int e = 0; e < 4; ++e) { ba[e] = x0[e]; ba[4 + e] = x1[e]; bb[e] = y0[e]; bb[4 + e] = y1[e]; } }
        float ha[2][8], hb[2][8];
#pragma unroll
        for (int r = 0; r < 2; ++r)
#pragma unroll
            for (int e = 0; e < 4; ++e) { ha[r][2 * e] = bf_lo(ua[r][e]); ha[r][2 * e + 1] = bf_hi(ua[r][e]); hb[r][2 * e] = bf_lo(ub[r][e]); hb[r][2 * e + 1] = bf_hi(ub[r][e]); }
        if (t0 == 0) {
            if (bs >= 0) {
#pragma unroll
                for (int r = 0; r < 2; ++r) { const float* sp = P->c_conv + (long)(bs * 2 + r) * DFF2 + c;
#pragma unroll
                    for (int e = 0; e < 8; ++e) { ha[r][e] = sp[e]; hb[r][e] = sp[DFF + e]; } }
            } else {
#pragma unroll
                for (int r = 0; r < 2; ++r)
#pragma unroll
                    for (int e = 0; e < 8; ++e) { ha[r][e] = 0.f; hb[r][e] = 0.f; }
            }
        }
        float pa2[8], pa1[8], pb2[8], pb1[8];
#pragma unroll
        for (int e = 0; e < 8; ++e) { pa2[e] = ha[0][e]; pa1[e] = ha[1][e]; pb2[e] = hb[0][e]; pb1[e] = hb[1][e]; }
#pragma unroll
        for (int r = 0; r < 8; ++r) {
            float ca[8], cb[8];
#pragma unroll
            for (int e = 0; e < 4; ++e) { ca[2 * e] = bf_lo(ua[r + 2][e]); ca[2 * e + 1] = bf_hi(ua[r + 2][e]); cb[2 * e] = bf_lo(ub[r + 2][e]); cb[2 * e + 1] = bf_hi(ub[r + 2][e]); }
            u32x4 ov;
#pragma unroll
            for (int e = 0; e < 4; ++e) {
                const float ya0 = ba[2 * e] + wa[0][2 * e] * pa2[2 * e] + wa[1][2 * e] * pa1[2 * e] + wa[2][2 * e] * ca[2 * e];
                const float ya1 = ba[2 * e + 1] + wa[0][2 * e + 1] * pa2[2 * e + 1] + wa[1][2 * e + 1] * pa1[2 * e + 1] + wa[2][2 * e + 1] * ca[2 * e + 1];
                const float yb0 = bb[2 * e] + wb[0][2 * e] * pb2[2 * e] + wb[1][2 * e] * pb1[2 * e] + wb[2][2 * e] * cb[2 * e];
                const float yb1 = bb[2 * e + 1] + wb[0][2 * e + 1] * pb2[2 * e + 1] + wb[1][2 * e + 1] * pb1[2 * e + 1] + wb[2][2 * e + 1] * cb[2 * e + 1];
                ov[e] = pk2(gelu_tanh(ya0) * yb0, gelu_tanh(ya1) * yb1); }
            *(u32x4*)(P->g + (long)(row0 + r) * DFF + c) = ov;
#pragma unroll
            for (int e = 0; e < 8; ++e) { pa2[e] = pa1[e]; pa1[e] = ca[e]; pb2[e] = pb1[e]; pb1[e] = cb[e]; }
        }
    }
}

__global__ void __launch_bounds__(NTHREADS) fwd_megakernel(Params Pval) {
    extern __shared__ __attribute__((aligned(16))) char lds[];
    cg::grid_group grid = cg::this_grid();
    const int lo = kparams()->phase_lo, hi = kparams()->phase_hi;
#define PH(n) if (lo <= (n) && (n) < hi)
#define SYNC(n) if (lo <= (n) && (n) + 1 < hi) grid.sync()
    PH(0) phase0(kparams(), lds);
    SYNC(0);
    PH(1) phase_h(kparams());
    SYNC(1);
    for (int ph = 2; ph <= 12; ++ph) {
        if (ph == 4) { PH(4) attn_phase(kparams(), lds, 0);
#ifdef PROBE_ATTN2
            __syncthreads(); attn_phase(kparams(), lds, 1);
#endif
            SYNC(4); continue; }
        if (ph == 8) { PH(8) phase_mid(kparams()); SYNC(8); continue; }
        if (ph == 10) { PH(10) phase_conv(kparams()); SYNC(10); continue; }
        if (ph == 12) { PH(12) phase_final(kparams()); continue; }
        if (lo <= ph && ph < hi) {
            const int npass = (ph == 3 || ph == 6) ? 2 : 1;
            for (int pass = 0; pass < npass; ++pass) {
                GemmDesc d; d.C = nullptr; d.ldc = 0; d.start = 0; KP P = kparams();
                switch (ph) {
                case 2: d.A = P->h; d.lda = DM; d.Bt = P->WinT; d.ldb = DM; d.K = DM; d.nM = 65; d.nN = 9; d.epi = E_INPROJ; break;
                case 3: if (pass == 0) { d.A = P->qlat; d.lda = 384; d.Bt = P->WuqT; d.ldb = 384; d.K = 384; d.nM = 65; d.nN = 3; d.epi = E_UQ; }
                        else { d.A = P->latent; d.lda = 256; d.Bt = P->WukvT; d.ldb = 256; d.K = 256; d.nM = 193; d.nN = 4; d.epi = E_UKV; d.start = 195; } break;
                case 5: d.A = P->h; d.lda = DM; d.Bt = P->WgT; d.ldb = DM; d.K = DM; d.nM = 65; d.nN = 8; d.epi = E_GATE; break;
                case 6: d.A = P->o + pass * 512; d.lda = DM; d.Bt = pass ? P->WpbT : P->WpaT; d.ldb = 512; d.K = 512; d.nM = 65; d.nN = 4; d.epi = pass ? E_PROJB : E_PROJA; break;
                case 7: d.A = P->merged; d.lda = DM; d.Bt = P->WoutT; d.ldb = DM; d.K = DM; d.nM = 65; d.nN = 4; d.epi = E_PLAIN; d.C = P->m2; d.ldc = DM; break;
                case 9: d.A = P->h2; d.lda = DM; d.Bt = P->WupT; d.ldb = DM; d.K = DM; d.nM = 65; d.nN = 22; d.epi = E_UP; break;
                default: d.A = P->g; d.lda = DFF; d.Bt = P->WdownT; d.ldb = DFF; d.K = DFF; d.nM = 65; d.nN = 4; d.epi = E_PLAIN; d.C = P->f; d.ldc = DM; break;
                }
                gemm_run(d, lds);
#ifdef PROBE_GEMM2
                if (!(ph == 6 && pass == 0)) { __syncthreads(); if (ph == 6) { GemmDesc d0 = d; d0.A = P->o; d0.Bt = P->WpaT; d0.epi = E_PROJA; gemm_run(d0, lds); } gemm_run(d, lds); }
#endif
            }
        }
        SYNC(ph);
    }
}

static size_t bump(size_t& off, size_t bytes) { size_t r = off; off += (bytes + 255) & ~(size_t)255; return r; }

extern "C" void kernel_launch(void* const* d_in, const int* in_sizes, int n_in, void* d_out, int out_size, void* d_ws, size_t ws_size, hipStream_t stream) {
    Params P; memset(&P, 0, sizeof(P));
    const float* const* in = (const float* const*)d_in;
    P.x_p = in[0]; P.x_s = in[1]; P.c_ckv = in[2]; P.c_kr = in[3]; P.c_sbk = in[4]; P.c_sbv = in[5]; P.c_conv = in[6]; P.c_p = in[7]; P.c_s = in[8];
    P.w_ada = in[9]; P.b_ada = in[10]; P.g_pre_mix = in[11]; P.g_post_mix = in[12]; P.g_pre_ffn = in[13]; P.g_post_ffn = in[14];
    const float* w_in = in[15]; const float* g_q = in[16]; const float* w_uq = in[17]; P.g_kv = in[18]; const float* w_uk = in[19]; const float* w_uv = in[20];
    const float* w_pa = in[21]; const float* w_pb = in[22]; const float* w_out = in[23]; const float* w_up = in[24]; P.conv_w = in[25]; P.conv_b = in[26]; const float* w_down = in[27];
    P.out = (float*)d_out;
    char* ws = (char*)d_ws; size_t off = 0;
    P.WupT = (bf16_t*)(ws + bump(off, (size_t)DFF2 * DM * 2));
    P.WdownT = (bf16_t*)(ws + bump(off, (size_t)DM * DFF * 2));
    P.ropeT = (float*)(ws + bump(off, (size_t)TP * 32 * 4));
    P.ada = (float*)(ws + bump(off, 10 * 6144 * 4));
    P.ctr = (unsigned*)(ws + bump(off, 256));
    const size_t R0 = off;
    P.WinT = (bf16_t*)(ws + bump(off, (size_t)2304 * DM * 2));
    P.WgT = (bf16_t*)(ws + bump(off, (size_t)2048 * DM * 2));
    P.WuqT = (bf16_t*)(ws + bump(off, (size_t)768 * 384 * 2));
    P.WukvT = (bf16_t*)(ws + bump(off, (size_t)1024 * 256 * 2));
    P.WpaT = (bf16_t*)(ws + bump(off, (size_t)1024 * 512 * 2));
    P.WpbT = (bf16_t*)(ws + bump(off, (size_t)1024 * 512 * 2));
    P.WoutT = (bf16_t*)(ws + bump(off, (size_t)1024 * 1024 * 2));
    const size_t o_kva = off;
    P.kva = (bf16_t*)(ws + bump(off, (size_t)KVROWS_PAD * 512 * 2));
    P.vaT_p = (bf16_t*)(ws + bump(off, (size_t)2 * 512 * TP * 2));
    P.vaT_s = (bf16_t*)(ws + bump(off, (size_t)8 * 512 * SKP * 2));
    const size_t o_kb = off;
    P.kb = (bf16_t*)(ws + bump(off, (size_t)KVROWS_PAD * 512 * 2));
    const size_t o_vbT = off;
    P.vbT_p = (bf16_t*)(ws + bump(off, (size_t)2 * 512 * TP * 2));
    P.vbT_s = (bf16_t*)(ws + bump(off, (size_t)8 * 512 * SKP * 2));
    const size_t o_kr = off;
    P.krope = (bf16_t*)(ws + bump(off, (size_t)KVROWS_PAD * 32 * 2));
    P.qb = (bf16_t*)(ws + bump(off, (size_t)MT * 512 * 2));
    P.q = (bf16_t*)(ws + bump(off, (size_t)MT * 768 * 2));
    P.latent = (bf16_t*)(ws + bump(off, (size_t)KVROWS_PAD * 256 * 2));
    size_t need = off;
    P.gates = (bf16_t*)(ws + o_kva);
    P.merged = (bf16_t*)(ws + o_kb);
    P.m2 = (bf16_t*)(ws + o_vbT);
    P.u = (bf16_t*)(ws + R0);
    const size_t o_g = R0 + (size_t)MT * DFF2 * 2;
    P.g = (bf16_t*)(ws + o_g);
    P.f = (bf16_t*)(ws + R0);
    size_t o_h2 = o_kr > o_g ? o_kr : o_g;
    P.h2 = (bf16_t*)(ws + o_h2);
    if (o_g + (size_t)MT * DFF * 2 > need) need = o_g + (size_t)MT * DFF * 2;
    if (o_h2 + (size_t)MT * DM * 2 > need) need = o_h2 + (size_t)MT * DM * 2;
    P.h = (bf16_t*)d_out;
    P.o = (bf16_t*)d_out + (size_t)MT * DM;
    P.qlat = P.o;
    if (need > ws_size) { fprintf(stderr, "workspace too small: need %zu have %zu\n", need, ws_size); return; }

    int nj = 0, tiles = 0;
    auto job = [&](const float* src, int lds, int coff, bf16_t* dst, int ldd, int Klen, int Nlen, const float* ks, int zero) {
        TJob& J = P.tj[nj++]; J.src = src; J.kscale = ks; J.dst = dst; J.lds = lds; J.coff = coff; J.ldd = ldd; J.Klen = Klen; J.Nlen = Nlen; J.zero = zero; J.tile0 = tiles; J.pad = 0;
        tiles += (Klen / 64) * ((Nlen + 255) / 256); };
    job(w_up, DFF2, 0, P.WupT, DM, DM, DFF2, nullptr, 0);
    job(w_down, DM, 0, P.WdownT, DFF, DFF, DM, nullptr, 0);
    job(w_in, 4256, 0, P.WinT, DM, DM, 384, nullptr, 0);
    job(w_in, 4256, 640, P.WinT + (size_t)384 * DM, DM, DM, 32, nullptr, 0);
    job(w_in, 4256, 0, P.WinT + (size_t)416 * DM, DM, DM, 96, nullptr, 1);
    job(w_in, 4256, 384, P.WinT + (size_t)512 * DM, DM, DM, 256, nullptr, 0);
    job(w_in, 4256, 672, P.WinT + (size_t)768 * DM, DM, DM, 1536, nullptr, 0);
    job(w_in, 4256, 2208, P.WgT, DM, DM, 2048, nullptr, 0);
    job(w_uq, 768, 0, P.WuqT, 384, 384, 768, g_q, 0);
    job(w_uk, 512, 0, P.WukvT, 256, 256, 512, nullptr, 0);
    job(w_uv, 512, 0, P.WukvT + (size_t)512 * 256, 256, 256, 512, nullptr, 0);
    job(w_pa, DM, 0, P.WpaT, 512, 512, DM, nullptr, 0);
    job(w_pb, DM, 0, P.WpbT, 512, 512, DM, nullptr, 0);
    job(w_out, DM, 0, P.WoutT, DM, DM, DM, nullptr, 0);
    for (int b = 0; b < 8; ++b) job(P.c_sbv + (size_t)b * PAST * 512, 512, 0, P.vbT_s + (size_t)b * 512 * SKP, SKP, PAST, 512, nullptr, 0);
    P.ntj_tiles = tiles;
    P.phase_lo = 0; P.phase_hi = 13;

    static int grid_blocks = 0;
    if (!grid_blocks) {
        (void)hipFuncSetAttribute((const void*)fwd_megakernel, hipFuncAttributeMaxDynamicSharedMemorySize, LDS_BYTES);
        int dev = 0, cus = 0, per_cu = 0;
        (void)hipGetDevice(&dev);
        (void)hipDeviceGetAttribute(&cus, hipDeviceAttributeMultiprocessorCount, dev);
        (void)hipOccupancyMaxActiveBlocksPerMultiprocessor(&per_cu, fwd_megakernel, NTHREADS, LDS_BYTES);
        if (per_cu > 1) per_cu = 1;
        grid_blocks = cus * per_cu;
    }
    (void)hipMemsetAsync(P.ctr, 0, 256, stream);
    void* args[] = {&P};
    hipError_t e = hipLaunchCooperativeKernel((const void*)fwd_megakernel, dim3(grid_blocks), dim3(NTHREADS), args, LDS_BYTES, stream);
    if (e != hipSuccess) fprintf(stderr, "cooperative launch failed: %s (grid %d)\n", hipGetErrorString(e), grid_blocks);
}
```

```cpp
#include <hip/hip_runtime.h>
#include <hip/hip_cooperative_groups.h>
#include <stdint.h>
#include <stdio.h>
#include <string.h>
namespace cg = cooperative_groups;

typedef unsigned short bf16_t;
typedef short bf16x8 __attribute__((ext_vector_type(8)));
typedef short s16x4 __attribute__((ext_vector_type(4)));
typedef float f32x2 __attribute__((ext_vector_type(2)));
typedef float f32x4 __attribute__((ext_vector_type(4)));
typedef float f32x16 __attribute__((ext_vector_type(16)));
typedef unsigned u32x2 __attribute__((ext_vector_type(2)));
typedef unsigned u32x4 __attribute__((ext_vector_type(4)));
typedef __bf16 bf2_t __attribute__((ext_vector_type(2)));
#define DI __device__ __forceinline__

constexpr int DM = 1024, TP = 8192, MP = 16384, MS = 256, MT = 16640, PAST = 4096, SKEYS = 4128, SKP = 4160;
constexpr int KVROWS = MP + 8 * SKEYS;
constexpr int KVROWS_PAD = KVROWS + 64;
constexpr int DFF = 2816, DFF2 = 5632;
constexpr float EPS = 1e-6f;
constexpr float LOG2E = 1.4426950408889634f, LN2 = 0.6931471805599453f;
constexpr int NTHREADS = 512;
constexpr int LDS_BYTES = 131072 + 4096;
constexpr long O_Y = 0, O_CKV_P = 17039360, O_KR_P = 21233664, O_SBK_P = 21757952, O_SBV_P = 30146560, O_CONV_P = 38535168,
               O_CKV_S = 38557696, O_KR_S = 38623232, O_SBK_S = 38631424, O_SBV_S = 38762496, O_CONV_S = 38893568;

struct TJob { const float* src; const float* kscale; bf16_t* dst; int lds, coff, ldd, Klen, Nlen, zero, tile0, pad; };
constexpr int NTJ = 22;

struct Params {
    const float *x_p, *x_s, *c_ckv, *c_kr, *c_sbk, *c_sbv, *c_conv, *c_p, *c_s;
    const float *w_ada, *b_ada, *g_pre_mix, *g_post_mix, *g_pre_ffn, *g_post_ffn, *g_kv, *conv_w, *conv_b;
    float* out;
    bf16_t *WupT, *WdownT, *WinT, *WgT, *WuqT, *WukvT, *WpaT, *WpbT, *WoutT;
    float* ropeT; float* ada; unsigned* ctr; unsigned* bar;
    bf16_t *h, *o, *qlat, *latent, *krope, *kb, *vbT_p, *vbT_s, *qb, *q, *kva, *vaT_p, *vaT_s, *gates, *merged, *m2, *h2, *u, *g, *f;
    TJob tj[NTJ]; int ntj_tiles; int phase_lo, phase_hi, pad0;
};

#define LAS __attribute__((address_space(3)))
typedef const Params __attribute__((address_space(4))) * KP;
DI KP kparams() { KP p = (KP)__builtin_amdgcn_kernarg_segment_ptr(); asm volatile("" : "+s"(p)); return p; }
DI int otid() { int t = threadIdx.x; asm volatile("" : "+v"(t)); return t; }
DI int obid() { int b = blockIdx.x; asm volatile("" : "+s"(b)); return b; }
DI int ogrid() { int g = gridDim.x; asm volatile("" : "+s"(g)); return g; }
DI unsigned pk2(float a, float b) { f32x2 f = {a, b}; bf2_t r = __builtin_convertvector(f, bf2_t); return __builtin_bit_cast(unsigned, r); }
DI float bf_lo(unsigned u) { return __uint_as_float(u << 16); }
DI float bf_hi(unsigned u) { return __uint_as_float(u & 0xffff0000u); }
DI int kvrow_of(int row) { if (row < MP) return row; const int r = row - MP; return MP + (r >> 5) * SKEYS + PAST + (r & 31); }
DI int pos_of(int row) { return row < MP ? (row & (TP - 1)) : PAST + ((row - MP) & 31); }
DI int ada_b(int row) { return row < MP ? (row >> 13) : 2 + ((row - MP) >> 5); }
DI float sigmoidf_(float x) { return 1.0f / (1.0f + __expf(-x)); }

constexpr int BM = 256, BK = 64, HALF = 128, HT = HALF * BK;
DI int lds_byte(int r, int c) { int st = (r >> 4) * 2 + (c >> 5), rr = r & 15, cc = c & 31, ob = rr * 64 + cc * 2; return st * 1024 + (ob ^ (((ob >> 9) & 1) << 5)); }
DI void stage_rc(int b, int& R, int& C) { int st = b / 1024, sb = b % 1024, swz = sb ^ (((sb >> 9) & 1) << 5); R = (st >> 1) * 16 + swz / 64; C = (st & 1) * 32 + (swz % 64) / 2; }

enum { E_INPROJ = 0, E_GATE, E_UQ, E_UKV, E_PROJA, E_PROJB, E_PLAIN, E_UP };
struct GemmDesc { const bf16_t* A; const bf16_t* Bt; bf16_t* C; int lda, ldb, ldc, K, nM, nN, epi, start; };

DI void gemm_kloop(const char* cA, const char* cB, unsigned lda2, unsigned ldb2, int nt, LAS char* lds, f32x4 (&acc)[2][2][4][2]) {
    const int tid = otid(), wid = __builtin_amdgcn_readfirstlane(tid >> 6), lane = tid & 63, wr = wid >> 2, wc = wid & 3, fr = lane & 15, fq = lane >> 4;
    unsigned voffA[2], voffB[2];
#pragma unroll
    for (int i = 0; i < 2; ++i) { int R, C; stage_rc(tid * 16 + i * 8192, R, C); voffA[i] = (unsigned)R * lda2 + (unsigned)C * 2u; voffB[i] = (unsigned)R * ldb2 + (unsigned)C * 2u; }
    const size_t kstep = 128, hA = (size_t)HALF * lda2, hB = (size_t)HALF * ldb2;
    const unsigned ldsw = (unsigned)wid * 1024u;
    const int aoff = lds_byte(wr * 64 + fr, fq * 8), boff = lds_byte(wc * 32 + fr, fq * 8);
    constexpr int HTB = HT * 2;
#define SA(b, h) (((b) * 2 + (h)) * HTB)
#define SB(b, h) ((4 + (b) * 2 + (h)) * HTB)
#define STAGE(bufoff, gbase, voff) do { _Pragma("unroll") for (int _i = 0; _i < 2; ++_i) \
    __builtin_amdgcn_global_load_lds((const unsigned*)((const char*)(gbase) + (voff)[_i]), (LAS unsigned*)(lds + (bufoff) + ldsw + _i * 8192), 16, 0, 0); } while (0)
#define LDA(dst, b, h) do { _Pragma("unroll") for (int m = 0; m < 4; ++m) _Pragma("unroll") for (int k = 0; k < 2; ++k) dst[m][k] = *(const LAS bf16x8*)(lds + SA(b, h) + aoff + m * 2048 + k * 1024); } while (0)
#define LDB(dst, b, h) do { _Pragma("unroll") for (int n = 0; n < 2; ++n) _Pragma("unroll") for (int k = 0; k < 2; ++k) dst[n][k] = *(const LAS bf16x8*)(lds + SB(b, h) + boff + n * 2048 + k * 1024); } while (0)
#define MMA(ai, bj, At, Bt_) do { __builtin_amdgcn_s_setprio(1); _Pragma("unroll") for (int m = 0; m < 4; ++m) _Pragma("unroll") for (int n = 0; n < 2; ++n) _Pragma("unroll") for (int k = 0; k < 2; ++k) \
      acc[ai][bj][m][n] = __builtin_amdgcn_mfma_f32_16x16x32_bf16(Bt_[n][k], At[m][k], acc[ai][bj][m][n], 0, 0, 0); \
    __builtin_amdgcn_s_setprio(0); } while (0)
#define WAIT_V(n) asm volatile("s_waitcnt vmcnt(" #n ")" ::: "memory")
#define WAIT_L(n) asm volatile("s_waitcnt lgkmcnt(" #n ")" ::: "memory")
#define BAR __builtin_amdgcn_s_barrier()
#define SCHED __builtin_amdgcn_sched_barrier(0)
#pragma unroll
    for (int a = 0; a < 2; ++a)
#pragma unroll
        for (int b = 0; b < 2; ++b)
#pragma unroll
            for (int m = 0; m < 4; ++m)
#pragma unroll
                for (int n = 0; n < 2; ++n) acc[a][b][m][n] = (f32x4){0.f, 0.f, 0.f, 0.f};
    bf16x8 At[4][2], B0[2][2], B1[2][2];
    STAGE(SB(0, 0), cB, voffB); STAGE(SA(0, 0), cA, voffA); STAGE(SB(0, 1), cB + hB, voffB); STAGE(SA(0, 1), cA + hA, voffA);
    if (wr == 1) BAR;
    WAIT_V(4); BAR;
    STAGE(SB(1, 0), cB + kstep, voffB); STAGE(SA(1, 0), cA + kstep, voffA); STAGE(SB(1, 1), cB + hB + kstep, voffB);
    WAIT_V(6); BAR;
    for (int t = 0; t < nt - 2; t += 2) {
        const char* a1 = cA + (size_t)(t + 1) * kstep; const char* a2 = a1 + kstep; const char* a3 = a2 + kstep;
        const char* b2 = cB + (size_t)(t + 2) * kstep; const char* b3 = b2 + kstep;
        LDB(B0, 0, 0); SCHED; LDA(At, 0, 0); STAGE(SA(1, 1), a1 + hA, voffA);
        WAIT_L(8); BAR; WAIT_L(0); MMA(0, 0, At, B0); BAR; SCHED;
        LDB(B1, 0, 1); STAGE(SB(0, 0), b2, voffB);
        BAR; WAIT_L(0); MMA(0, 1, At, B1); BAR;
        LDA(At, 0, 1); STAGE(SA(0, 0), a2, voffA);
        BAR; WAIT_L(0); MMA(1, 0, At, B0); BAR; SCHED;
        STAGE(SB(0, 1), b2 + hB, voffB);
        WAIT_V(6); BAR; MMA(1, 1, At, B1); BAR;
        LDB(B0, 1, 0); SCHED; LDA(At, 1, 0); STAGE(SA(0, 1), a2 + hA, voffA);
        WAIT_L(8); BAR; WAIT_L(0); MMA(0, 0, At, B0); BAR; SCHED;
        LDB(B1, 1, 1); STAGE(SB(1, 0), b3, voffB);
        BAR; WAIT_L(0); MMA(0, 1, At, B1); BAR;
        LDA(At, 1, 1); STAGE(SA(1, 0), a3, voffA);
        BAR; WAIT_L(0); MMA(1, 0, At, B0); BAR; SCHED;
        STAGE(SB(1, 1), b3 + hB, voffB);
        WAIT_V(6); BAR; MMA(1, 1, At, B1); BAR;
    }
    { LDB(B0, 0, 0); LDA(At, 0, 0); STAGE(SA(1, 1), cA + (size_t)(nt - 1) * kstep + hA, voffA);
      BAR; WAIT_L(0); MMA(0, 0, At, B0); BAR;
      LDB(B1, 0, 1); BAR; WAIT_L(0); MMA(0, 1, At, B1); BAR;
      LDA(At, 0, 1); WAIT_V(4); BAR; WAIT_L(0); MMA(1, 0, At, B0); MMA(1, 1, At, B1); BAR; }
    { LDB(B0, 1, 0); LDA(At, 1, 0); WAIT_V(2); BAR; WAIT_L(0); MMA(0, 0, At, B0); BAR;
      LDB(B1, 1, 1); WAIT_V(0); BAR; WAIT_L(0); MMA(0, 1, At, B1); BAR;
      LDA(At, 1, 1); BAR; WAIT_L(0); MMA(1, 0, At, B0); MMA(1, 1, At, B1); BAR; }
    if (wr == 0) BAR;
}

#define EPI_ROWS for (int ai = 0; ai < 2; ++ai) for (int m = 0; m < 4; ++m, ({ asm volatile("" ::: "memory"); }))
#define EPI_COLS for (int bj = 0; bj < 2; ++bj) for (int n = 0; n < 2; ++n)

DI void store_bf4(bf16_t* p, f32x4 v) { u32x2 w; w.x = pk2(v[0], v[1]); w.y = pk2(v[2], v[3]); *(u32x2*)p = w; }

DI void gemm_run(const GemmDesc& d, char* lds) {
    float* xl = (float*)(lds + 131072);
    const int G = ogrid(), nun = d.nM * d.nN;
    const int wid = __builtin_amdgcn_readfirstlane(otid() >> 6), wr = wid >> 2, wc = wid & 3;
    for (int u = (int)((obid() + G - (d.start % G)) % G); u < nun; u += G) {
        const int pm = u / d.nN, pn = u % d.nN, brow = pm * BM, bcol = pn * BM;
        if (d.epi == E_UQ) {
            const int tq_ = otid(), r = tq_ >> 1, hf = tq_ & 1;
            const u32x4* src = (const u32x4*)(d.A + (long)(brow + r) * 384 + hf * 192);
            float s = 0.f;
#pragma unroll 4
            for (int i = 0; i < 24; ++i) { u32x4 v = src[i];
                for (int e = 0; e < 4; ++e) { float a = bf_lo(v[e]), b = bf_hi(v[e]); s += a * a + b * b; } }
            s += __shfl_xor(s, 1);
            if (hf == 0) xl[r] = rsqrtf(s * (1.0f / 384.0f) + EPS);
        }
        f32x4 acc[2][2][4][2];
        gemm_kloop((const char*)(d.A + (size_t)brow * d.lda), (const char*)(d.Bt + (size_t)bcol * d.ldb), (unsigned)d.lda * 2u, (unsigned)d.ldb * 2u, d.K / BK, (LAS char*)lds, acc);
        __syncthreads();
        int lane_e = threadIdx.x & 63; asm volatile("" : "+v"(lane_e));
        const int fr = lane_e & 15, fq = lane_e >> 4;
        KP P = kparams();
        const int rbase = brow + wr * 64 + fr, cbase = bcol + wc * 32 + fq * 4;
        switch (d.epi) {
        case E_INPROJ: {
            if (pn == 0) {
#pragma unroll
                EPI_ROWS { const int row = rbase + ai * 128 + m * 16;
#pragma unroll
                    EPI_COLS store_bf4(P->qlat + (long)row * 384 + (cbase + bj * 128 + n * 16), acc[ai][bj][m][n]); }
            } else if (pn == 1) {
#pragma unroll
                EPI_ROWS { const int row = rbase + ai * 128 + m * 16;
#pragma unroll
                    for (int n = 0; n < 2; ++n) store_bf4(P->qlat + (long)row * 384 + 256 + (wc * 32 + fq * 4 + n * 16), acc[ai][0][m][n]);
                    if (wc == 0) {
                        const int pos = pos_of(row);
                        const f32x4 cs0 = *(const f32x4*)(P->ropeT + (long)pos * 32 + fq * 8), cs1 = *(const f32x4*)(P->ropeT + (long)pos * 32 + fq * 8 + 4);
                        const f32x4 x1 = acc[ai][1][m][0], x2 = acc[ai][1][m][1];
                        f32x4 co = {cs0[0], cs0[2], cs1[0], cs1[2]}, si = {cs0[1], cs0[3], cs1[1], cs1[3]};
                        f32x4 o1 = x1 * co - x2 * si, o2 = x2 * co + x1 * si;
                        float* of = P->out + (row < MP ? O_KR_P + (long)row * 32 : O_KR_S + (long)(row - MP) * 32);
                        *(f32x4*)(of + fq * 4) = o1; *(f32x4*)(of + 16 + fq * 4) = o2;
                        bf16_t* ob = P->krope + (long)kvrow_of(row) * 32;
                        store_bf4(ob + fq * 4, o1); store_bf4(ob + 16 + fq * 4, o2);
                    } }
            } else if (pn == 2) {
                float ss[2][4];
#pragma unroll
                EPI_ROWS { float s = 0.f;
#pragma unroll
                    EPI_COLS { const f32x4 v = acc[ai][bj][m][n]; s += v[0] * v[0] + v[1] * v[1] + v[2] * v[2] + v[3] * v[3]; }
                    s += __shfl_xor(s, 16); s += __shfl_xor(s, 32); ss[ai][m] = s;
                    if (fq == 0) ((float*)lds)[(ai * 128 + wr * 64 + m * 16 + fr) * 4 + wc] = s; }
                __syncthreads();
#pragma unroll
                EPI_ROWS { const int rl = ai * 128 + wr * 64 + m * 16 + fr, row = brow + rl;
                    const f32x4 pp = *(const f32x4*)((float*)lds + rl * 4);
                    const float rstd = rsqrtf((pp[0] + pp[1] + pp[2] + pp[3]) * (1.0f / 256.0f) + EPS);
                    float* of = P->out + (row < MP ? O_CKV_P + (long)row * 256 : O_CKV_S + (long)(row - MP) * 256);
                    bf16_t* ob = P->latent + (long)kvrow_of(row) * 256;
#pragma unroll
                    EPI_COLS { const int c = wc * 32 + fq * 4 + bj * 128 + n * 16;
                        const f32x4 gv = *(const f32x4*)(P->g_kv + c); const f32x4 o = acc[ai][bj][m][n] * rstd * gv;
                        *(f32x4*)(of + c) = o; store_bf4(ob + c, o); } }
            } else if (pn <= 4) {
#pragma unroll
                EPI_ROWS { const int row = rbase + ai * 128 + m * 16;
#pragma unroll
                    EPI_COLS store_bf4(P->qb + (long)row * 512 + (cbase - 768 + bj * 128 + n * 16), acc[ai][bj][m][n] * 0.125f); }
            } else if (pn <= 6) {
#pragma unroll
                EPI_ROWS { const int row = rbase + ai * 128 + m * 16;
                    float* of = P->out + (row < MP ? O_SBK_P + (long)row * 512 : O_SBK_S + (long)(row - MP) * 512);
                    bf16_t* ob = P->kb + (long)kvrow_of(row) * 512;
#pragma unroll
                    EPI_COLS { const int c = cbase - 1280 + bj * 128 + n * 16; *(f32x4*)(of + c) = acc[ai][bj][m][n]; store_bf4(ob + c, acc[ai][bj][m][n]); } }
            } else {
#pragma unroll
                EPI_ROWS { const int row = rbase + ai * 128 + m * 16;
                    float* of = P->out + (row < MP ? O_SBV_P + (long)row * 512 : O_SBV_S + (long)(row - MP) * 512);
                    bf16_t* vt; int ldv;
                    if (row < MP) { vt = P->vbT_p + (long)(row >> 13) * 512 * TP + (row & (TP - 1)); ldv = TP; }
                    else { const int r = row - MP; vt = P->vbT_s + (long)(r >> 5) * 512 * SKP + PAST + (r & 31); ldv = SKP; }
#pragma unroll
                    EPI_COLS { const int c = cbase - 1792 + bj * 128 + n * 16; const f32x4 v = acc[ai][bj][m][n]; *(f32x4*)(of + c) = v;
                        const unsigned w0 = pk2(v[0], v[1]), w1 = pk2(v[2], v[3]);
                        vt[(long)(c + 0) * ldv] = (bf16_t)(w0 & 0xffff); vt[(long)(c + 1) * ldv] = (bf16_t)(w0 >> 16);
                        vt[(long)(c + 2) * ldv] = (bf16_t)(w1 & 0xffff); vt[(long)(c + 3) * ldv] = (bf16_t)(w1 >> 16); } }
            }
        } break;
        case E_GATE: {
#pragma unroll
            EPI_ROWS { const int row = rbase + ai * 128 + m * 16;
#pragma unroll
                EPI_COLS { const f32x4 v = acc[ai][bj][m][n]; f32x4 s = {sigmoidf_(v[0]), sigmoidf_(v[1]), sigmoidf_(v[2]), sigmoidf_(v[3])};
                    store_bf4(P->gates + (long)row * 2048 + (cbase + bj * 128 + n * 16), s); } }
        } break;
        case E_UQ: {
            const float qs = 0.10206207261596577f * LOG2E;
#pragma unroll
            EPI_ROWS { const int rl = ai * 128 + wr * 64 + m * 16 + fr, row = brow + rl; const float rs = xl[rl] * qs;
#pragma unroll
                for (int bj = 0; bj < 2; ++bj) { const int grp = pn * 8 + bj * 4 + wc; bf16_t* dst = P->q + (long)row * 768 + grp * 32 + fq * 4;
                    f32x4 v0 = acc[ai][bj][m][0] * rs, v1 = acc[ai][bj][m][1] * rs;
                    if (grp % 3 == 2) {
                        const int pos = pos_of(row);
                        const f32x4 cs0 = *(const f32x4*)(P->ropeT + (long)pos * 32 + fq * 8), cs1 = *(const f32x4*)(P->ropeT + (long)pos * 32 + fq * 8 + 4);
                        f32x4 co = {cs0[0], cs0[2], cs1[0], cs1[2]}, si = {cs0[1], cs0[3], cs1[1], cs1[3]};
                        const f32x4 o1 = v0 * co - v1 * si, o2 = v1 * co + v0 * si; v0 = o1; v1 = o2;
                    }
                    store_bf4(dst, v0); store_bf4(dst + 16, v1); } }
        } break;
        case E_UKV: {
#pragma unroll
            EPI_ROWS { const int row = rbase + ai * 128 + m * 16;
                if (pn < 2) {
#pragma unroll
                    EPI_COLS store_bf4(P->kva + (long)row * 512 + (cbase + bj * 128 + n * 16), acc[ai][bj][m][n]);
                } else {
                    bf16_t* vt; int ldv;
                    if (row < MP) { vt = P->vaT_p + (long)(row >> 13) * 512 * TP + (row & (TP - 1)); ldv = TP; }
                    else { const int r = row - MP, b = r / SKEYS; vt = P->vaT_s + (long)b * 512 * SKP + (r - b * SKEYS); ldv = SKP; }
                    if (row < KVROWS) {
#pragma unroll
                        EPI_COLS { const int c = cbase - 512 + bj * 128 + n * 16; const f32x4 v = acc[ai][bj][m][n];
                            const unsigned w0 = pk2(v[0], v[1]), w1 = pk2(v[2], v[3]);
                            vt[(long)(c + 0) * ldv] = (bf16_t)(w0 & 0xffff); vt[(long)(c + 1) * ldv] = (bf16_t)(w0 >> 16);
                            vt[(long)(c + 2) * ldv] = (bf16_t)(w1 & 0xffff); vt[(long)(c + 3) * ldv] = (bf16_t)(w1 >> 16); }
                    }
                } }
        } break;
        case E_PROJA: case E_PROJB: {
            const int goff = d.epi == E_PROJA ? 0 : 1024;
#pragma unroll
            EPI_ROWS { const int row = rbase + ai * 128 + m * 16;
#pragma unroll
                EPI_COLS { const int c = cbase + bj * 128 + n * 16; const u32x2 gw = *(const u32x2*)(P->gates + (long)row * 2048 + goff + c);
                    f32x4 gv = {bf_lo(gw.x), bf_hi(gw.x), bf_lo(gw.y), bf_hi(gw.y)}; f32x4 v = acc[ai][bj][m][n] * gv;
                    bf16_t* dst = P->merged + (long)row * 1024 + c;
                    if (d.epi == E_PROJB) { const u32x2 pw = *(const u32x2*)dst; f32x4 pv = {bf_lo(pw.x), bf_hi(pw.x), bf_lo(pw.y), bf_hi(pw.y)}; v += pv; }
                    store_bf4(dst, v); } }
        } break;
        case E_PLAIN: {
#pragma unroll
            EPI_ROWS { const int row = rbase + ai * 128 + m * 16;
#pragma unroll
                EPI_COLS store_bf4(d.C + (long)row * d.ldc + (cbase + bj * 128 + n * 16), acc[ai][bj][m][n]); }
        } break;
        case E_UP: {
#pragma unroll
            EPI_ROWS { const int row = rbase + ai * 128 + m * 16;
                float* cf = nullptr;
                if (row < MP) { const int t = row & (TP - 1); if (t >= TP - 2) cf = P->out + O_CONV_P + (long)((row >> 13) * 2 + (t - (TP - 2))) * DFF2; }
                else { const int r = row - MP, t = r & 31; if (t >= 30) cf = P->out + O_CONV_S + (long)((r >> 5) * 2 + (t - 30)) * DFF2; }
#pragma unroll
                EPI_COLS { const int c = cbase + bj * 128 + n * 16; store_bf4(P->u + (long)row * DFF2 + c, acc[ai][bj][m][n]);
                    if (cf) *(f32x4*)(cf + c) = acc[ai][bj][m][n]; } }
        } break;
        }
        __syncthreads();
    }
}

#define MFMA32(a, b, c) __builtin_amdgcn_mfma_f32_32x32x16_bf16((a), (b), (c), 0, 0, 0)
DI int crow(int i, int h) { return (i & 3) + 8 * (i >> 2) + 4 * h; }

template <int MODE>
DI void attn_unit(KP P, char* lds, bool sample, int b, int h, int ublk) {
    constexpr int DQK = MODE == 0 ? 96 : 64, KS = DQK * 2 + 16, VS = 144, NS = DQK / 16;
    constexpr int KBYTES = 64 * KS, BUF = KBYTES + 64 * VS;
    const int tid = otid(), w = tid >> 6, lane = tid & 63, ql = lane & 31, hh = lane >> 5;
    const int kvrow0 = sample ? MP + b * SKEYS : b * TP;
    const int qrow0 = sample ? MP + b * 32 : b * TP + ublk * 256;
    const int ntiles = sample ? 65 : 4 * (ublk + 1);
    const int t0 = sample ? 0 : ublk * 256 + w * 32, tq = t0 + ql;
    int klim, wmax, wmin;
    if (MODE == 0) { if (sample) { klim = wmax = wmin = SKEYS; } else { klim = ((tq >> 6) + 1) << 6; wmax = (((t0 + 31) >> 6) + 1) << 6; wmin = ((t0 >> 6) + 1) << 6; } }
    else { if (sample) { klim = PAST + tq; wmax = PAST + 31; wmin = PAST; } else { klim = tq; wmax = t0 + 31; wmin = t0; } }
    const bool wactive = sample ? (w == 0) : true;
    const bf16_t* Kp; const bf16_t* Qp; const bf16_t* VT; int ldq; long ldv;
    if (MODE == 0) { Kp = P->kva + (long)kvrow0 * 512 + h * 64; Qp = P->q + (long)qrow0 * 768 + h * 96; ldq = 768;
        VT = sample ? P->vaT_s + (long)(b * 512 + h * 64) * SKP : P->vaT_p + (long)(b * 512 + h * 64) * TP; }
    else { Kp = P->kb + (long)kvrow0 * 512 + h * 64; Qp = P->qb + (long)qrow0 * 512 + h * 64; ldq = 512;
        VT = sample ? P->vbT_s + (long)(b * 512 + h * 64) * SKP : P->vbT_p + (long)(b * 512 + h * 64) * TP; }
    ldv = sample ? SKP : TP;
    const bf16_t* Kr = P->krope + (long)kvrow0 * 32;

    bf16x8 qf[NS];
    if (wactive) {
        const bf16_t* qp = Qp + (long)(w * 32 + ql) * ldq + 8 * hh;
#pragma unroll
        for (int s = 0; s < NS; ++s) qf[s] = *(const bf16x8*)(qp + 16 * s);
    } else {
#pragma unroll
        for (int s = 0; s < NS; ++s) qf[s] = (bf16x8){0, 0, 0, 0, 0, 0, 0, 0};
    }
    f32x16 O0, O1;
#pragma unroll
    for (int i = 0; i < 16; ++i) { O0[i] = 0.f; O1[i] = 0.f; }
    float mrun = -INFINITY, lrun = 0.f, carry = 0.f;
    bool wdone = !wactive;
    volatile int* flags = (volatile int*)(lds + 65536 + 64);

    u32x4 rk0, rk1, rv;
    const int krow_s = tid >> 3, kc_s = tid & 7, rrow_s = tid >> 2, rc_s = tid & 3;
    auto load_tile = [&](int kt) {
        rk0 = *(const u32x4*)(Kp + (long)(kt * 64 + krow_s) * 512 + kc_s * 8);
        if (MODE == 0 && tid < 256) rk1 = *(const u32x4*)(Kr + (long)(kt * 64 + rrow_s) * 32 + rc_s * 8);
        rv = *(const u32x4*)(VT + (long)krow_s * ldv + kt * 64 + kc_s * 8);
    };
    auto store_tile = [&](int buf) {
        char* kb_ = lds + buf * BUF; char* vb_ = kb_ + KBYTES;
        *(u32x4*)(kb_ + krow_s * KS + kc_s * 16) = rk0;
        if (MODE == 0 && tid < 256) *(u32x4*)(kb_ + rrow_s * KS + 128 + rc_s * 16) = rk1;
        *(u32x4*)(vb_ + krow_s * VS + kc_s * 16) = rv;
    };
    load_tile(ntiles - 1); store_tile(0);
    __syncthreads();
    for (int it = 0; it < ntiles; ++it) {
        const int kt = ntiles - 1 - it, cur = it & 1;
        if (it + 1 < ntiles) load_tile(kt - 1);
        if (wactive && !wdone && kt * 64 < wmax) {
            const char* kb_ = lds + cur * BUF; const char* vb_ = kb_ + KBYTES;
            f32x16 S0, S1;
#pragma unroll
            for (int i = 0; i < 16; ++i) { S0[i] = 0.f; S1[i] = 0.f; }
#pragma unroll
            for (int s = 0; s < NS; ++s) {
                const bf16x8 k0 = *(const bf16x8*)(kb_ + ql * KS + (16 * s + 8 * hh) * 2);
                const bf16x8 k1 = *(const bf16x8*)(kb_ + (32 + ql) * KS + (16 * s + 8 * hh) * 2);
                S0 = MFMA32(k0, qf[s], S0); S1 = MFMA32(k1, qf[s], S1);
            }
            const bool need_mask = (kt * 64 + 64 > wmin);
            const int kbase = kt * 64 + 4 * hh;
            if (MODE == 0) {
                if (need_mask) {
#pragma unroll
                    for (int i = 0; i < 16; ++i) { const int key = kbase + (i & 3) + 8 * (i >> 2);
                        if (key >= klim) S0[i] = -INFINITY; if (key + 32 >= klim) S1[i] = -INFINITY; }
                }
                float mx = S0[0];
#pragma unroll
                for (int i = 1; i < 16; ++i) mx = fmaxf(mx, S0[i]);
#pragma unroll
                for (int i = 0; i < 16; ++i) mx = fmaxf(mx, S1[i]);
                mx = fmaxf(mx, __shfl_xor(mx, 32));
                const float mnew = fmaxf(mrun, mx);
                const float alpha = __builtin_amdgcn_exp2f(mrun - mnew);
                mrun = mnew;
                float ps = 0.f;
#pragma unroll
                for (int i = 0; i < 16; ++i) { S0[i] = __builtin_amdgcn_exp2f(S0[i] - mnew); S1[i] = __builtin_amdgcn_exp2f(S1[i] - mnew); ps += S0[i] + S1[i]; }
                lrun = lrun * alpha + ps;
#pragma unroll
                for (int i = 0; i < 16; ++i) { O0[i] *= alpha; O1[i] *= alpha; }
            } else {
                float gs[2][4], gp[2][4];
                f32x16 SP0, SP1;
#pragma unroll
                for (int i = 0; i < 16; ++i) { const int key = kbase + (i & 3) + 8 * (i >> 2);
                    { const float z = S0[i]; const float t = __builtin_amdgcn_exp2f(-fabsf(z) * LOG2E); float sp = fmaxf(z, 0.f) + LN2 * __builtin_amdgcn_logf(1.0f + t);
                      if (need_mask && key >= klim) sp = 0.f; SP0[i] = sp; }
                    { const float z = S1[i]; const float t = __builtin_amdgcn_exp2f(-fabsf(z) * LOG2E); float sp = fmaxf(z, 0.f) + LN2 * __builtin_amdgcn_logf(1.0f + t);
                      if (need_mask && key + 32 >= klim) sp = 0.f; SP1[i] = sp; } }
#pragma unroll
                for (int g = 0; g < 4; ++g) { gs[0][g] = (SP0[4 * g] + SP0[4 * g + 1]) + (SP0[4 * g + 2] + SP0[4 * g + 3]);
                    gs[1][g] = (SP1[4 * g] + SP1[4 * g + 1]) + (SP1[4 * g + 2] + SP1[4 * g + 3]); }
#pragma unroll
                for (int g = 0; g < 4; ++g) { gp[0][g] = __shfl_xor(gs[0][g], 32); gp[1][g] = __shfl_xor(gs[1][g], 32); }
                float running = carry;
#pragma unroll
                for (int blk = 1; blk >= 0; --blk)
#pragma unroll
                    for (int g = 3; g >= 0; --g) {
                        const float sum1 = hh ? gs[blk][g] : gp[blk][g], sum0 = hh ? gp[blk][g] : gs[blk][g];
                        const float mybase = hh ? running : running + sum1;
                        running += sum0 + sum1;
                        float later = mybase;
#pragma unroll
                        for (int j = 3; j >= 0; --j) { const int i = 4 * g + j; const int key = kbase + j + 8 * g + 32 * blk;
                            const float z = blk ? S1[i] : S0[i], sp = blk ? SP1[i] : SP0[i];
                            float a = __builtin_amdgcn_exp2f((z - sp - later) * LOG2E);
                            if (need_mask && key >= klim) a = 0.f;
                            later += sp;
                            if (blk) S1[i] = a; else S0[i] = a; }
                    }
                carry = running;
                wdone = __all((carry > 104.0f) || (klim <= 0));
            }
            bf16x8 pf[2][2];
#pragma unroll
            for (int s = 0; s < 2; ++s) {
                u32x4 a, c;
                a.x = pk2(S0[8 * s], S0[8 * s + 1]); a.y = pk2(S0[8 * s + 2], S0[8 * s + 3]); a.z = pk2(S0[8 * s + 4], S0[8 * s + 5]); a.w = pk2(S0[8 * s + 6], S0[8 * s + 7]);
                c.x = pk2(S1[8 * s], S1[8 * s + 1]); c.y = pk2(S1[8 * s + 2], S1[8 * s + 3]); c.z = pk2(S1[8 * s + 4], S1[8 * s + 5]); c.w = pk2(S1[8 * s + 6], S1[8 * s + 7]);
                pf[0][s] = __builtin_bit_cast(bf16x8, a); pf[1][s] = __builtin_bit_cast(bf16x8, c);
            }
#pragma unroll
            for (int blk = 0; blk < 2; ++blk)
#pragma unroll
                for (int s = 0; s < 2; ++s) {
                    const int koff = (32 * blk + 16 * s + 4 * hh) * 2;
                    const s16x4 lo0 = *(const s16x4*)(vb_ + ql * VS + koff), hi0 = *(const s16x4*)(vb_ + ql * VS + koff + 16);
                    const s16x4 lo1 = *(const s16x4*)(vb_ + (32 + ql) * VS + koff), hi1 = *(const s16x4*)(vb_ + (32 + ql) * VS + koff + 16);
                    const bf16x8 v0 = __builtin_shufflevector(lo0, hi0, 0, 1, 2, 3, 4, 5, 6, 7), v1 = __builtin_shufflevector(lo1, hi1, 0, 1, 2, 3, 4, 5, 6, 7);
                    O0 = MFMA32(v0, pf[blk][s], O0); O1 = MFMA32(v1, pf[blk][s], O1);
                }
        }
        if (it + 1 < ntiles) store_tile(cur ^ 1);
        if (MODE == 1 && lane == 0) flags[(it & 1) * 8 + w] = wdone ? 1 : 0;
        __syncthreads();
        if (MODE == 1) { int alld = 1;
#pragma unroll
            for (int ww = 0; ww < 8; ++ww) alld &= flags[(it & 1) * 8 + ww];
            if (alld) break; }
    }
    if (wactive) {
        float inv = 1.0f;
        if (MODE == 0) { const float lt = lrun + __shfl_xor(lrun, 32); inv = 1.0f / lt; }
        bf16_t* op = P->o + (long)(qrow0 + w * 32 + ql) * 1024 + (MODE == 0 ? 0 : 512) + h * 64 + 4 * hh;
#pragma unroll
        for (int g = 0; g < 4; ++g) {
            f32x4 a = {O0[4 * g] * inv, O0[4 * g + 1] * inv, O0[4 * g + 2] * inv, O0[4 * g + 3] * inv};
            f32x4 c = {O1[4 * g] * inv, O1[4 * g + 1] * inv, O1[4 * g + 2] * inv, O1[4 * g + 3] * inv};
            store_bf4(op + 8 * g, a); store_bf4(op + 32 + 8 * g, c);
        }
    }
}

DI void attn_phase(KP P, char* lds, int cidx) {
    unsigned* slot = (unsigned*)(lds + 65536);
    for (;;) {
        if (threadIdx.x == 0) *slot = atomicAdd(P->ctr + cidx, 1u);
        __syncthreads();
        const unsigned idx = *slot;
        __syncthreads();
        if (idx >= 1152u) break;
        bool sample; int mode, b, h, ublk = 0;
        if (idx < 128u) { sample = true; mode = idx >> 6; b = (idx >> 3) & 7; h = idx & 7; }
        else { const int j = idx - 128; sample = false; ublk = 31 - (j >> 5); const int r = j & 31; mode = r >> 4; b = (r >> 3) & 1; h = r & 7; }
        if (mode == 0) attn_unit<0>(P, lds, sample, b, h, ublk); else attn_unit<1>(P, lds, sample, b, h, ublk);
    }
}

DI void phase0(KP P, char* lds) {
    const int tid = otid(), G = ogrid(), bid = obid(), w = tid >> 6, lane = tid & 63;
    for (int item = bid; item < 96; item += G) {
        float* sc = (float*)lds; float* red = (float*)(lds + 40960);
        for (int i = tid; i < 10240; i += NTHREADS) { const int bb = i >> 10, k = i & 1023; const float cv = bb < 2 ? P->c_p[bb * 1024 + k] : P->c_s[(bb - 2) * 1024 + k]; sc[i] = cv / (1.0f + __expf(-cv)); }
        __syncthreads();
        const int col = item * 64 + lane;
        float a0 = 0, a1 = 0, a2 = 0, a3 = 0, a4 = 0, a5 = 0, a6 = 0, a7 = 0, a8 = 0, a9 = 0;
        for (int k0 = w * 128; k0 < w * 128 + 128; k0 += 16) {
            float wv[16];
#pragma unroll
            for (int j = 0; j < 16; ++j) wv[j] = P->w_ada[(long)(k0 + j) * 6144 + col];
#pragma unroll
            for (int j = 0; j < 16; ++j) { const int k = k0 + j;
                a0 += sc[k] * wv[j]; a1 += sc[1024 + k] * wv[j]; a2 += sc[2048 + k] * wv[j]; a3 += sc[3072 + k] * wv[j]; a4 += sc[4096 + k] * wv[j];
                a5 += sc[5120 + k] * wv[j]; a6 += sc[6144 + k] * wv[j]; a7 += sc[7168 + k] * wv[j]; a8 += sc[8192 + k] * wv[j]; a9 += sc[9216 + k] * wv[j]; }
        }
        float* rr = red + w * 640 + lane;
        rr[0] = a0; rr[64] = a1; rr[128] = a2; rr[192] = a3; rr[256] = a4; rr[320] = a5; rr[384] = a6; rr[448] = a7; rr[512] = a8; rr[576] = a9;
        __syncthreads();
        for (int i = tid; i < 640; i += NTHREADS) { float s = 0.f; for (int ww = 0; ww < 8; ++ww) s += red[ww * 640 + i];
            const int bb = i >> 6, l = i & 63; P->ada[bb * 6144 + item * 64 + l] = s + P->b_ada[item * 64 + l]; }
        __syncthreads();
    }
    {
        float* tile = (float*)lds;
        for (int it = (bid + 96) % G; it < P->ntj_tiles; it += G) {
            int j = 0;
#pragma unroll 1
            for (int q = 1; q < NTJ; ++q) if (it >= P->tj[q].tile0) j = q;
            TJob J; J.src = P->tj[j].src; J.kscale = P->tj[j].kscale; J.dst = P->tj[j].dst; J.lds = P->tj[j].lds; J.coff = P->tj[j].coff; J.ldd = P->tj[j].ldd;
            J.Klen = P->tj[j].Klen; J.Nlen = P->tj[j].Nlen; J.zero = P->tj[j].zero; J.tile0 = P->tj[j].tile0;
            const int lt = it - J.tile0, nk = J.Klen >> 6, tk = lt % nk, tn = lt / nk, k0 = tk * 64, n0 = tn * 256;
            f32x4 lv[8];
#pragma unroll
            for (int r = 0; r < 8; ++r) { const int e = tid + r * NTHREADS, kk = e >> 6, n4 = (e & 63) * 4;
                lv[r] = (f32x4){0.f, 0.f, 0.f, 0.f};
                if (!J.zero && n0 + n4 < J.Nlen) lv[r] = *(const f32x4*)(J.src + (long)(k0 + kk) * J.lds + J.coff + n0 + n4); }
#pragma unroll
            for (int r = 0; r < 8; ++r) { const int e = tid + r * NTHREADS, kk = e >> 6, n4 = (e & 63) * 4;
                f32x4 v = lv[r]; if (J.kscale) v *= J.kscale[k0 + kk];
                float* tp = tile + kk * 257 + n4; tp[0] = v[0]; tp[1] = v[1]; tp[2] = v[2]; tp[3] = v[3]; }
            __syncthreads();
#pragma unroll
            for (int r = 0; r < 4; ++r) { const int e = tid + r * NTHREADS, nn = e >> 3, kc = (e & 7) * 8;
                if (n0 + nn < J.Nlen) { const float* tp = tile + kc * 257 + nn; u32x4 o;
                    o.x = pk2(tp[0], tp[257]); o.y = pk2(tp[2 * 257], tp[3 * 257]); o.z = pk2(tp[4 * 257], tp[5 * 257]); o.w = pk2(tp[6 * 257], tp[7 * 257]);
                    *(u32x4*)(J.dst + (long)(n0 + nn) * J.ldd + k0 + kc) = o; } }
            __syncthreads();
        }
    }
    const long gt = (long)bid * NTHREADS + tid, gn = (long)G * NTHREADS;
    for (long i0 = gt; i0 < 8L * PAST * 64; i0 += 4 * gn) { f32x4 v[4];
#pragma unroll
        for (int r = 0; r < 4; ++r) { const long i = i0 + r * gn; if (i < 8L * PAST * 64) v[r] = *(const f32x4*)(P->c_ckv + i * 4); }
#pragma unroll
        for (int r = 0; r < 4; ++r) { const long i = i0 + r * gn; if (i < 8L * PAST * 64) { const long row = i >> 6; const int c = (int)(i & 63) * 4; const int bb = (int)(row >> 12), sq = (int)(row & 4095);
            store_bf4(P->latent + (long)(MP + bb * SKEYS + sq) * 256 + c, v[r]); } } }
    for (long i0 = gt; i0 < 8L * PAST * 8; i0 += 4 * gn) { f32x4 v[4];
#pragma unroll
        for (int r = 0; r < 4; ++r) { const long i = i0 + r * gn; if (i < 8L * PAST * 8) v[r] = *(const f32x4*)(P->c_kr + i * 4); }
#pragma unroll
        for (int r = 0; r < 4; ++r) { const long i = i0 + r * gn; if (i < 8L * PAST * 8) { const long row = i >> 3; const int c = (int)(i & 7) * 4; const int bb = (int)(row >> 12), sq = (int)(row & 4095);
            store_bf4(P->krope + (long)(MP + bb * SKEYS + sq) * 32 + c, v[r]); } } }
    for (long i0 = gt; i0 < 8L * PAST * 128; i0 += 4 * gn) { f32x4 v[4];
#pragma unroll
        for (int r = 0; r < 4; ++r) { const long i = i0 + r * gn; if (i < 8L * PAST * 128) v[r] = *(const f32x4*)(P->c_sbk + i * 4); }
#pragma unroll
        for (int r = 0; r < 4; ++r) { const long i = i0 + r * gn; if (i < 8L * PAST * 128) { const long row = i >> 7; const int c = (int)(i & 127) * 4; const int bb = (int)(row >> 12), sq = (int)(row & 4095);
            store_bf4(P->kb + (long)(MP + bb * SKEYS + sq) * 512 + c, v[r]); } } }
    for (long i = gt; i < 8L * 512 * 8; i += gn) { const long r = i >> 3; const int c = (int)(i & 7) * 4; const u32x2 z = {0u, 0u};
        *(u32x2*)(P->vaT_s + r * SKP + SKEYS + c) = z; *(u32x2*)(P->vbT_s + r * SKP + SKEYS + c) = z; }
    for (long i = gt; i < (long)TP * 16; i += gn) { const int pos = (int)(i >> 4), fi = (int)(i & 15);
        const float inv = exp2f(-(float)fi * (13.287712379549449f / 16.0f));
        const float ang = (float)pos * inv;
        const double rev = (double)ang * 0.15915494309189535; const float fr_ = (float)(rev - floor(rev));
        P->ropeT[i * 2] = __builtin_amdgcn_cosf(fr_); P->ropeT[i * 2 + 1] = __builtin_amdgcn_sinf(fr_); }
}

DI void phase_h(KP P) {
    const int tid_ = otid(), lane = tid_ & 63, gw = obid() * 8 + (tid_ >> 6), nw = ogrid() * 8;
    for (int row = gw; row < MT; row += nw) {
        const float* xr = row < MP ? P->x_p + (long)row * DM : P->x_s + (long)(row - MP) * DM;
        const float* ad = P->ada + ada_b(row) * 6144;
        f32x4 v[4]; float s = 0.f;
#pragma unroll
        for (int i = 0; i < 4; ++i) { v[i] = *(const f32x4*)(xr + i * 256 + lane * 4); s += v[i][0] * v[i][0] + v[i][1] * v[i][1] + v[i][2] * v[i][2] + v[i][3] * v[i][3]; }
#pragma unroll
        for (int o = 1; o < 64; o <<= 1) s += __shfl_xor(s, o);
        const float rstd = rsqrtf(s * (1.0f / DM) + EPS);
#pragma unroll
        for (int i = 0; i < 4; ++i) { const int c = i * 256 + lane * 4;
            const f32x4 g = *(const f32x4*)(P->g_pre_mix + c), sh = *(const f32x4*)(ad + c), scl = *(const f32x4*)(ad + 1024 + c);
            store_bf4(P->h + (long)row * DM + c, v[i] * rstd * g * (1.0f + scl) + sh); }
    }
}

DI void phase_mid(KP P) {
    const int tid_ = otid(), lane = tid_ & 63, gw = obid() * 8 + (tid_ >> 6), nw = ogrid() * 8;
    for (int row = gw; row < MT; row += nw) {
        const float* xr = row < MP ? P->x_p + (long)row * DM : P->x_s + (long)(row - MP) * DM;
        const float* ad = P->ada + ada_b(row) * 6144;
        f32x4 mv[4]; float s = 0.f;
#pragma unroll
        for (int i = 0; i < 4; ++i) { const u32x2 wv = *(const u32x2*)(P->m2 + (long)row * DM + i * 256 + lane * 4);
            mv[i] = (f32x4){bf_lo(wv.x), bf_hi(wv.x), bf_lo(wv.y), bf_hi(wv.y)}; s += mv[i][0] * mv[i][0] + mv[i][1] * mv[i][1] + mv[i][2] * mv[i][2] + mv[i][3] * mv[i][3]; }
#pragma unroll
        for (int o = 1; o < 64; o <<= 1) s += __shfl_xor(s, o);
        const float rstd = rsqrtf(s * (1.0f / DM) + EPS);
        float s2 = 0.f;
#pragma unroll
        for (int i = 0; i < 4; ++i) { const int c = i * 256 + lane * 4;
            const f32x4 xv = *(const f32x4*)(xr + c), g = *(const f32x4*)(P->g_post_mix + c), gt = *(const f32x4*)(ad + 2048 + c);
            mv[i] = xv + gt * (mv[i] * rstd * g);
            *(f32x4*)(P->out + O_Y + (long)row * DM + c) = mv[i];
            s2 += mv[i][0] * mv[i][0] + mv[i][1] * mv[i][1] + mv[i][2] * mv[i][2] + mv[i][3] * mv[i][3]; }
#pragma unroll
        for (int o = 1; o < 64; o <<= 1) s2 += __shfl_xor(s2, o);
        const float rstd2 = rsqrtf(s2 * (1.0f / DM) + EPS);
#pragma unroll
        for (int i = 0; i < 4; ++i) { const int c = i * 256 + lane * 4;
            const f32x4 g = *(const f32x4*)(P->g_pre_ffn + c), sh = *(const f32x4*)(ad + 3072 + c), scl = *(const f32x4*)(ad + 4096 + c);
            store_bf4(P->h2 + (long)row * DM + c, mv[i] * rstd2 * g * (1.0f + scl) + sh); }
    }
}

DI void phase_final(KP P) {
    const int tid_ = otid(), lane = tid_ & 63, gw = obid() * 8 + (tid_ >> 6), nw = ogrid() * 8;
    for (int row = gw; row < MT; row += nw) {
        const float* ad = P->ada + ada_b(row) * 6144;
        f32x4 fv[4]; float s = 0.f;
#pragma unroll
        for (int i = 0; i < 4; ++i) { const u32x2 wv = *(const u32x2*)(P->f + (long)row * DM + i * 256 + lane * 4);
            fv[i] = (f32x4){bf_lo(wv.x), bf_hi(wv.x), bf_lo(wv.y), bf_hi(wv.y)}; s += fv[i][0] * fv[i][0] + fv[i][1] * fv[i][1] + fv[i][2] * fv[i][2] + fv[i][3] * fv[i][3]; }
#pragma unroll
        for (int o = 1; o < 64; o <<= 1) s += __shfl_xor(s, o);
        const float rstd = rsqrtf(s * (1.0f / DM) + EPS);
#pragma unroll
        for (int i = 0; i < 4; ++i) { const int c = i * 256 + lane * 4; float* yp = P->out + O_Y + (long)row * DM + c;
            const f32x4 xv = *(const f32x4*)yp, g = *(const f32x4*)(P->g_post_ffn + c), gt = *(const f32x4*)(ad + 5120 + c);
            *(f32x4*)yp = xv + gt * (fv[i] * rstd * g); }
    }
}

DI float gelu_tanh(float a) { const float t = 0.7978845608028654f * (a + 0.044715f * a * a * a); const float e = __expf(2.0f * t); return 0.5f * a * (2.0f - 2.0f / (1.0f + e)); }

DI void phase_conv(KP P) {
    const long gt = (long)obid() * NTHREADS + otid(), gn = (long)ogrid() * NTHREADS;
    for (long i = gt; i < (long)(MT / 8) * 352; i += gn) {
        const int rg = (int)(i / 352), c = (int)(i % 352) * 8, row0 = rg * 8;
        int t0, bs = -1; if (row0 < MP) t0 = row0 & (TP - 1); else { t0 = (row0 - MP) & 31; bs = (row0 - MP) >> 5; }
        u32x4 ua[10], ub[10];
#pragma unroll
        for (int r = 0; r < 10; ++r) { const int rr = (t0 == 0 && r < 2) ? row0 : row0 + r - 2;
            ua[r] = *(const u32x4*)(P->u + (long)rr * DFF2 + c); ub[r] = *(const u32x4*)(P->u + (long)rr * DFF2 + DFF + c); }
        float wa[3][8], wb[3][8], ba[8], bb[8];
#pragma unroll
        for (int tap = 0; tap < 3; ++tap) { const f32x4 x0 = *(const f32x4*)(P->conv_w + tap * DFF2 + c), x1 = *(const f32x4*)(P->conv_w + tap * DFF2 + c + 4);
            const f32x4 y0 = *(const f32x4*)(P->conv_w + tap * DFF2 + DFF + c), y1 = *(const f32x4*)(P->conv_w + tap * DFF2 + DFF + c + 4);
#pragma unroll
            for (int e = 0; e < 4; ++e) { wa[tap][e] = x0[e]; wa[tap][4 + e] = x1[e]; wb[tap][e] = y0[e]; wb[tap][4 + e] = y1[e]; } }
        { const f32x4 x0 = *(const f32x4*)(P->conv_b + c), x1 = *(const f32x4*)(P->conv_b + c + 4), y0 = *(const f32x4*)(P->conv_b + DFF + c), y1 = *(const f32x4*)(P->conv_b + DFF + c + 4);
#pragma unroll
          for (int e = 0; e < 4; ++e) { ba[e] = x0[e]; ba[4 + e] = x1[e]; bb[e] = y0[e]; bb[4 + e] = y1[e]; } }
        float ha[2][8], hb[2][8];
#pragma unroll
        for (int r = 0; r < 2; ++r)
#pragma unroll
            for (int e = 0; e < 4; ++e) { ha[r][2 * e] = bf_lo(ua[r][e]); ha[r][2 * e + 1] = bf_hi(ua[r][e]); hb[r][2 * e] = bf_lo(ub[r][e]); hb[r][2 * e + 1] = bf_hi(ub[r][e]); }
        if (t0 == 0) {
            if (bs >= 0) {
#pragma unroll
                for (int r = 0; r < 2; ++r) { const float* sp = P->c_conv + (long)(bs * 2 + r) * DFF2 + c;
#pragma unroll
                    for (int e = 0; e < 8; ++e) { ha[r][e] = sp[e]; hb[r][e] = sp[DFF + e]; } }
            } else {
#pragma unroll
                for (int r = 0; r < 2; ++r)
#pragma unroll
                    for (int e = 0; e < 8; ++e) { ha[r][e] = 0.f; hb[r][e] = 0.f; }
            }
        }
        float pa2[8], pa1[8], pb2[8], pb1[8];
#pragma unroll
        for (int e = 0; e < 8; ++e) { pa2[e] = ha[0][e]; pa1[e] = ha[1][e]; pb2[e] = hb[0][e]; pb1[e] = hb[1][e]; }
#pragma unroll
        for (int r = 0; r < 8; ++r) {
            float ca[8], cb[8];
#pragma unroll
            for (int e = 0; e < 4; ++e) { ca[2 * e] = bf_lo(ua[r + 2][e]); ca[2 * e + 1] = bf_hi(ua[r + 2][e]); cb[2 * e] = bf_lo(ub[r + 2][e]); cb[2 * e + 1] = bf_hi(ub[r + 2][e]); }
            u32x4 ov;
#pragma unroll
            for (int e = 0; e < 4; ++e) {
                const float ya0 = ba[2 * e] + wa[0][2 * e] * pa2[2 * e] + wa[1][2 * e] * pa1[2 * e] + wa[2][2 * e] * ca[2 * e];
                const float ya1 = ba[2 * e + 1] + wa[0][2 * e + 1] * pa2[2 * e + 1] + wa[1][2 * e + 1] * pa1[2 * e + 1] + wa[2][2 * e + 1] * ca[2 * e + 1];
                const float yb0 = bb[2 * e] + wb[0][2 * e] * pb2[2 * e] + wb[1][2 * e] * pb1[2 * e] + wb[2][2 * e] * cb[2 * e];
                const float yb1 = bb[2 * e + 1] + wb[0][2 * e + 1] * pb2[2 * e + 1] + wb[1][2 * e + 1] * pb1[2 * e + 1] + wb[2][2 * e + 1] * cb[2 * e + 1];
                ov[e] = pk2(gelu_tanh(ya0) * yb0, gelu_tanh(ya1) * yb1); }
            *(u32x4*)(P->g + (long)(row0 + r) * DFF + c) = ov;
#pragma unroll
            for (int e = 0; e < 8; ++e) { pa2[e] = pa1[e]; pa1[e] = ca[e]; pb2[e] = pb1[e]; pb1[e] = cb[e]; }
        }
    }
}

#define XB_TMO      128
#define XB_XCNT(j)  (256  + 64 * (j))
#define XB_XSUB(j)  (1280 + 64 * (j))
#define XB_XGEN(j)  (2304 + 64 * (j))
#define XB_TOP      3328
#define XB_TOPGEN   3392
#define XCD_BAR_WORDS 3456
#define XB_SPIN_CAP (1u << 18)
DI unsigned xb_ld(unsigned* p)              { return __hip_atomic_load(p, __ATOMIC_RELAXED, __HIP_MEMORY_SCOPE_AGENT); }
DI unsigned xb_add(unsigned* p, unsigned v) { return __hip_atomic_fetch_add(p, v, __ATOMIC_RELAXED, __HIP_MEMORY_SCOPE_AGENT); }
DI unsigned xb_xcc_id() { return (unsigned)__builtin_amdgcn_s_getreg((3 << 11) | 20) & 0xFu; }
#define XB_SPIN(cond, bar) do { unsigned _sp = 0; while (cond) { __builtin_amdgcn_s_sleep(1); \
    if ((++_sp & 255u) == 0u) { if (xb_ld(&(bar)[XB_TMO])) break; if (_sp > XB_SPIN_CAP) { atomicAdd(&(bar)[XB_TMO], 1u); break; } } } } while (0)
DI void xcd_barrier_complete(unsigned* bar, unsigned x, unsigned& nloc, unsigned& nx) {
    const unsigned G = gridDim.x;
    unsigned sum, cnt, mine, sp = 0u;
    for (;;) {
        sum = 0u; cnt = 0u; mine = 0u;
#pragma unroll
        for (unsigned j = 0; j < 16; ++j) { const unsigned c = xb_ld(&bar[XB_XCNT(j)]); sum += c; cnt += (c > 0u) ? 1u : 0u; mine = (j == x) ? c : mine; }
        if (sum == G) break;
        __builtin_amdgcn_s_sleep(1);
        if ((++sp & 255u) == 0u) { if (xb_ld(&bar[XB_TMO])) break; if (sp > XB_SPIN_CAP) { atomicAdd(&bar[XB_TMO], 1u); break; } }
    }
    nloc = mine > 0u ? mine : 1u; nx = cnt > 0u ? cnt : 1u;
}
DI void grid_barrier(char* lds) {
    asm volatile("s_waitcnt vmcnt(0)" ::: "memory");
    __syncthreads();
    if (threadIdx.x == 0) {
        unsigned* bar = kparams()->bar; const unsigned x = xb_xcc_id();
        volatile LAS unsigned* st = (volatile LAS unsigned*)(lds + 131072 + 2048);
        __builtin_amdgcn_s_waitcnt(0);
        unsigned nloc = st[0], nx = st[1];
        if (nloc == 0u) { xcd_barrier_complete(bar, x, nloc, nx); st[0] = nloc; st[1] = nx; }
        const unsigned old = xb_add(&bar[XB_XSUB(x)], 1u);
        const unsigned gen = old / nloc;
        if (old + 1u == (gen + 1u) * nloc) {
            __builtin_amdgcn_fence(__ATOMIC_RELEASE, "agent");
            asm volatile("s_waitcnt vmcnt(0)" ::: "memory");
            const unsigned og = xb_add(&bar[XB_TOP], 1u);
            const unsigned tg = og / nx;
            if (og + 1u == (tg + 1u) * nx) xb_add(&bar[XB_TOPGEN], 1u);
            else XB_SPIN(xb_ld(&bar[XB_TOPGEN]) == tg, bar);
            __builtin_amdgcn_fence(__ATOMIC_ACQUIRE, "agent");
            xb_add(&bar[XB_XGEN(x)], 1u);
            asm volatile("s_waitcnt vmcnt(0)" ::: "memory");
        } else {
            XB_SPIN(xb_ld(&bar[XB_XGEN(x)]) == gen, bar);
            __builtin_amdgcn_fence(__ATOMIC_ACQUIRE, "agent");
            asm volatile("s_waitcnt vmcnt(0)" ::: "memory");
        }
    }
    __syncthreads();
}

__global__ void __launch_bounds__(NTHREADS) fwd_megakernel(Params Pval) {
    extern __shared__ __attribute__((aligned(16))) char lds[];
    cg::grid_group grid = cg::this_grid();
    const int lo = kparams()->phase_lo, hi = kparams()->phase_hi;
#define PH(n) if (lo <= (n) && (n) < hi)
#define SYNC(n) if (lo <= (n) && (n) + 1 < hi) grid_barrier(lds)
    if (hi > 1000) grid.sync();
    { volatile LAS unsigned* st = (volatile LAS unsigned*)(lds + 131072 + 2048);
      if (threadIdx.x == 0) { st[0] = 0u; st[1] = 0u; }
      __syncthreads();
      if (threadIdx.x == 0) (void)xb_add(&kparams()->bar[XB_XCNT(xb_xcc_id())], 1u); }
    PH(0) phase0(kparams(), lds);
#ifdef PROBE_P0
    __syncthreads(); phase0(kparams(), lds);
#endif
#ifdef PROBE_SYNC
    for (int i = 0; i < 24; ++i) grid_barrier(lds);
#endif
    SYNC(0);
    PH(1) phase_h(kparams());
    SYNC(1);
    for (int ph = 2; ph <= 12; ++ph) {
        if (ph == 4) { PH(4) attn_phase(kparams(), lds, 0);
#ifdef PROBE_ATTN2
            __syncthreads(); attn_phase(kparams(), lds, 1);
#endif
            SYNC(4); continue; }
        if (ph == 8) { PH(8) phase_mid(kparams());
#ifdef PROBE_ROWS
            phase_mid(kparams()); phase_h(kparams());
#endif
            SYNC(8); continue; }
        if (ph == 10) { PH(10) phase_conv(kparams());
#ifdef PROBE_CONV
            phase_conv(kparams());
#endif
            SYNC(10); continue; }
        if (ph == 12) { PH(12) phase_final(kparams()); continue; }
        if (lo <= ph && ph < hi) {
            const int npass = (ph == 3 || ph == 6) ? 2 : 1;
            for (int pass = 0; pass < npass; ++pass) {
                GemmDesc d; d.C = nullptr; d.ldc = 0; d.start = 0; KP P = kparams();
                switch (ph) {
                case 2: d.A = P->h; d.lda = DM; d.Bt = P->WinT; d.ldb = DM; d.K = DM; d.nM = 65; d.nN = 9; d.epi = E_INPROJ; break;
                case 3: if (pass == 0) { d.A = P->qlat; d.lda = 384; d.Bt = P->WuqT; d.ldb = 384; d.K = 384; d.nM = 65; d.nN = 3; d.epi = E_UQ; }
                        else { d.A = P->latent; d.lda = 256; d.Bt = P->WukvT; d.ldb = 256; d.K = 256; d.nM = 193; d.nN = 4; d.epi = E_UKV; d.start = 195; } break;
                case 5: d.A = P->h; d.lda = DM; d.Bt = P->WgT; d.ldb = DM; d.K = DM; d.nM = 65; d.nN = 8; d.epi = E_GATE; break;
                case 6: d.A = P->o + pass * 512; d.lda = DM; d.Bt = pass ? P->WpbT : P->WpaT; d.ldb = 512; d.K = 512; d.nM = 65; d.nN = 4; d.epi = pass ? E_PROJB : E_PROJA; break;
                case 7: d.A = P->merged; d.lda = DM; d.Bt = P->WoutT; d.ldb = DM; d.K = DM; d.nM = 65; d.nN = 4; d.epi = E_PLAIN; d.C = P->m2; d.ldc = DM; break;
                case 9: d.A = P->h2; d.lda = DM; d.Bt = P->WupT; d.ldb = DM; d.K = DM; d.nM = 65; d.nN = 22; d.epi = E_UP; break;
                default: d.A = P->g; d.lda = DFF; d.Bt = P->WdownT; d.ldb = DFF; d.K = DFF; d.nM = 65; d.nN = 4; d.epi = E_PLAIN; d.C = P->f; d.ldc = DM; break;
                }
                gemm_run(d, lds);
#ifdef PROBE_GEMM2
                if (!(ph == 6 && pass == 0)) { __syncthreads(); if (ph == 6) { GemmDesc d0 = d; d0.A = P->o; d0.Bt = P->WpaT; d0.epi = E_PROJA; gemm_run(d0, lds); } gemm_run(d, lds); }
#endif
            }
        }
        SYNC(ph);
    }
}

static size_t bump(size_t& off, size_t bytes) { size_t r = off; off += (bytes + 255) & ~(size_t)255; return r; }

extern "C" void kernel_launch(void* const* d_in, const int* in_sizes, int n_in, void* d_out, int out_size, void* d_ws, size_t ws_size, hipStream_t stream) {
    Params P; memset(&P, 0, sizeof(P));
    const float* const* in = (const float* const*)d_in;
    P.x_p = in[0]; P.x_s = in[1]; P.c_ckv = in[2]; P.c_kr = in[3]; P.c_sbk = in[4]; P.c_sbv = in[5]; P.c_conv = in[6]; P.c_p = in[7]; P.c_s = in[8];
    P.w_ada = in[9]; P.b_ada = in[10]; P.g_pre_mix = in[11]; P.g_post_mix = in[12]; P.g_pre_ffn = in[13]; P.g_post_ffn = in[14];
    const float* w_in = in[15]; const float* g_q = in[16]; const float* w_uq = in[17]; P.g_kv = in[18]; const float* w_uk = in[19]; const float* w_uv = in[20];
    const float* w_pa = in[21]; const float* w_pb = in[22]; const float* w_out = in[23]; const float* w_up = in[24]; P.conv_w = in[25]; P.conv_b = in[26]; const float* w_down = in[27];
    P.out = (float*)d_out;
    char* ws = (char*)d_ws; size_t off = 0;
    P.WupT = (bf16_t*)(ws + bump(off, (size_t)DFF2 * DM * 2));
    P.WdownT = (bf16_t*)(ws + bump(off, (size_t)DM * DFF * 2));
    P.ropeT = (float*)(ws + bump(off, (size_t)TP * 32 * 4));
    P.ada = (float*)(ws + bump(off, 10 * 6144 * 4));
    P.ctr = (unsigned*)(ws + bump(off, 256));
    P.bar = (unsigned*)(ws + bump(off, XCD_BAR_WORDS * 4));
    const size_t R0 = off;
    P.WinT = (bf16_t*)(ws + bump(off, (size_t)2304 * DM * 2));
    P.WgT = (bf16_t*)(ws + bump(off, (size_t)2048 * DM * 2));
    P.WuqT = (bf16_t*)(ws + bump(off, (size_t)768 * 384 * 2));
    P.WukvT = (bf16_t*)(ws + bump(off, (size_t)1024 * 256 * 2));
    P.WpaT = (bf16_t*)(ws + bump(off, (size_t)1024 * 512 * 2));
    P.WpbT = (bf16_t*)(ws + bump(off, (size_t)1024 * 512 * 2));
    P.WoutT = (bf16_t*)(ws + bump(off, (size_t)1024 * 1024 * 2));
    const size_t o_kva = off;
    P.kva = (bf16_t*)(ws + bump(off, (size_t)KVROWS_PAD * 512 * 2));
    P.vaT_p = (bf16_t*)(ws + bump(off, (size_t)2 * 512 * TP * 2));
    P.vaT_s = (bf16_t*)(ws + bump(off, (size_t)8 * 512 * SKP * 2));
    const size_t o_kb = off;
    P.kb = (bf16_t*)(ws + bump(off, (size_t)KVROWS_PAD * 512 * 2));
    const size_t o_vbT = off;
    P.vbT_p = (bf16_t*)(ws + bump(off, (size_t)2 * 512 * TP * 2));
    P.vbT_s = (bf16_t*)(ws + bump(off, (size_t)8 * 512 * SKP * 2));
    const size_t o_kr = off;
    P.krope = (bf16_t*)(ws + bump(off, (size_t)KVROWS_PAD * 32 * 2));
    P.qb = (bf16_t*)(ws + bump(off, (size_t)MT * 512 * 2));
    P.q = (bf16_t*)(ws + bump(off, (size_t)MT * 768 * 2));
    P.latent = (bf16_t*)(ws + bump(off, (size_t)KVROWS_PAD * 256 * 2));
    size_t need = off;
    P.gates = (bf16_t*)(ws + o_kva);
    P.merged = (bf16_t*)(ws + o_kb);
    P.m2 = (bf16_t*)(ws + o_vbT);
    P.u = (bf16_t*)(ws + R0);
    const size_t o_g = R0 + (size_t)MT * DFF2 * 2;
    P.g = (bf16_t*)(ws + o_g);
    P.f = (bf16_t*)(ws + R0);
    size_t o_h2 = o_kr > o_g ? o_kr : o_g;
    P.h2 = (bf16_t*)(ws + o_h2);
    if (o_g + (size_t)MT * DFF * 2 > need) need = o_g + (size_t)MT * DFF * 2;
    if (o_h2 + (size_t)MT * DM * 2 > need) need = o_h2 + (size_t)MT * DM * 2;
    P.h = (bf16_t*)d_out;
    P.o = (bf16_t*)d_out + (size_t)MT * DM;
    P.qlat = P.o;
    if (need > ws_size) { fprintf(stderr, "workspace too small: need %zu have %zu\n", need, ws_size); return; }

    int nj = 0, tiles = 0;
    auto job = [&](const float* src, int lds, int coff, bf16_t* dst, int ldd, int Klen, int Nlen, const float* ks, int zero) {
        TJob& J = P.tj[nj++]; J.src = src; J.kscale = ks; J.dst = dst; J.lds = lds; J.coff = coff; J.ldd = ldd; J.Klen = Klen; J.Nlen = Nlen; J.zero = zero; J.tile0 = tiles; J.pad = 0;
        tiles += (Klen / 64) * ((Nlen + 255) / 256); };
    job(w_up, DFF2, 0, P.WupT, DM, DM, DFF2, nullptr, 0);
    job(w_down, DM, 0, P.WdownT, DFF, DFF, DM, nullptr, 0);
    job(w_in, 4256, 0, P.WinT, DM, DM, 384, nullptr, 0);
    job(w_in, 4256, 640, P.WinT + (size_t)384 * DM, DM, DM, 32, nullptr, 0);
    job(w_in, 4256, 0, P.WinT + (size_t)416 * DM, DM, DM, 96, nullptr, 1);
    job(w_in, 4256, 384, P.WinT + (size_t)512 * DM, DM, DM, 256, nullptr, 0);
    job(w_in, 4256, 672, P.WinT + (size_t)768 * DM, DM, DM, 1536, nullptr, 0);
    job(w_in, 4256, 2208, P.WgT, DM, DM, 2048, nullptr, 0);
    job(w_uq, 768, 0, P.WuqT, 384, 384, 768, g_q, 0);
    job(w_uk, 512, 0, P.WukvT, 256, 256, 512, nullptr, 0);
    job(w_uv, 512, 0, P.WukvT + (size_t)512 * 256, 256, 256, 512, nullptr, 0);
    job(w_pa, DM, 0, P.WpaT, 512, 512, DM, nullptr, 0);
    job(w_pb, DM, 0, P.WpbT, 512, 512, DM, nullptr, 0);
    job(w_out, DM, 0, P.WoutT, DM, DM, DM, nullptr, 0);
    for (int b = 0; b < 8; ++b) job(P.c_sbv + (size_t)b * PAST * 512, 512, 0, P.vbT_s + (size_t)b * 512 * SKP, SKP, PAST, 512, nullptr, 0);
    P.ntj_tiles = tiles;
    P.phase_lo = 0; P.phase_hi = 13;

    static int grid_blocks = 0;
    if (!grid_blocks) {
        (void)hipFuncSetAttribute((const void*)fwd_megakernel, hipFuncAttributeMaxDynamicSharedMemorySize, LDS_BYTES);
        int dev = 0, cus = 0, per_cu = 0;
        (void)hipGetDevice(&dev);
        (void)hipDeviceGetAttribute(&cus, hipDeviceAttributeMultiprocessorCount, dev);
        (void)hipOccupancyMaxActiveBlocksPerMultiprocessor(&per_cu, fwd_megakernel, NTHREADS, LDS_BYTES);
        if (per_cu > 1) per_cu = 1;
        grid_blocks = cus * per_cu;
    }
    (void)hipMemsetAsync(P.ctr, 0, 256 + XCD_BAR_WORDS * 4, stream);
    void* args[] = {&P};
    hipError_t e = hipLaunchCooperativeKernel((const void*)fwd_megakernel, dim3(grid_blocks), dim3(NTHREADS), args, LDS_BYTES, stream);
    if (e != hipSuccess) fprintf(stderr, "cooperative launch failed: %s (grid %d)\n", hipGetErrorString(e), grid_blocks);
}
```

```cpp
#include <hip/hip_runtime.h>
#include <hip/hip_cooperative_groups.h>
#include <stdint.h>
#include <stdio.h>
#include <string.h>
namespace cg = cooperative_groups;

typedef unsigned short bf16_t;
typedef short bf16x8 __attribute__((ext_vector_type(8)));
typedef short s16x4 __attribute__((ext_vector_type(4)));
typedef float f32x2 __attribute__((ext_vector_type(2)));
typedef float f32x4 __attribute__((ext_vector_type(4)));
typedef float f32x16 __attribute__((ext_vector_type(16)));
typedef unsigned u32x2 __attribute__((ext_vector_type(2)));
typedef unsigned u32x4 __attribute__((ext_vector_type(4)));
typedef __bf16 bf2_t __attribute__((ext_vector_type(2)));
#define DI __device__ __forceinline__

constexpr int DM = 1024, TP = 8192, MP = 16384, MS = 256, MT = 16640, PAST = 4096, SKEYS = 4128, SKP = 4160;
constexpr int KVROWS = MP + 8 * SKEYS;
constexpr int KVROWS_PAD = KVROWS + 64;
constexpr int DFF = 2816, DFF2 = 5632;
constexpr float EPS = 1e-6f;
constexpr float LOG2E = 1.4426950408889634f, LN2 = 0.6931471805599453f;
constexpr int NTHREADS = 512;
constexpr int LDS_BYTES = 131072 + 4096;
constexpr long O_Y = 0, O_CKV_P = 17039360, O_KR_P = 21233664, O_SBK_P = 21757952, O_SBV_P = 30146560, O_CONV_P = 38535168,
               O_CKV_S = 38557696, O_KR_S = 38623232, O_SBK_S = 38631424, O_SBV_S = 38762496, O_CONV_S = 38893568;

struct TJob { const float* src; const float* kscale; bf16_t* dst; int lds, coff, ldd, Klen, Nlen, zero, tile0, pad; };
constexpr int NTJ = 22;

struct Params {
    const float *x_p, *x_s, *c_ckv, *c_kr, *c_sbk, *c_sbv, *c_conv, *c_p, *c_s;
    const float *w_ada, *b_ada, *g_pre_mix, *g_post_mix, *g_pre_ffn, *g_post_ffn, *g_kv, *conv_w, *conv_b;
    float* out;
    bf16_t *WupT, *WdownT, *WinT, *WgT, *WuqT, *WukvT, *WpaT, *WpbT, *WoutT;
    float* ropeT; float* ada; unsigned* ctr; unsigned* bar;
    bf16_t *h, *o, *qlat, *latent, *krope, *kb, *vbT_p, *vbT_s, *qb, *q, *kva, *vaT_p, *vaT_s, *gates, *merged, *m2, *h2, *u, *g, *f;
    TJob tj[NTJ]; int ntj_tiles; int phase_lo, phase_hi, pad0;
};

#define LAS __attribute__((address_space(3)))
typedef const Params __attribute__((address_space(4))) * KP;
DI KP kparams() { KP p = (KP)__builtin_amdgcn_kernarg_segment_ptr(); asm volatile("" : "+s"(p)); return p; }
DI int otid() { int t = threadIdx.x; asm volatile("" : "+v"(t)); return t; }
DI int obid() { int b = blockIdx.x; asm volatile("" : "+s"(b)); return b; }
DI int ogrid() { int g = gridDim.x; asm volatile("" : "+s"(g)); return g; }
DI unsigned pk2(float a, float b) { f32x2 f = {a, b}; bf2_t r = __builtin_convertvector(f, bf2_t); return __builtin_bit_cast(unsigned, r); }
DI float bf_lo(unsigned u) { return __uint_as_float(u << 16); }
DI float bf_hi(unsigned u) { return __uint_as_float(u & 0xffff0000u); }
DI int kvrow_of(int row) { if (row < MP) return row; const int r = row - MP; return MP + (r >> 5) * SKEYS + PAST + (r & 31); }
DI int pos_of(int row) { return row < MP ? (row & (TP - 1)) : PAST + ((row - MP) & 31); }
DI int ada_b(int row) { return row < MP ? (row >> 13) : 2 + ((row - MP) >> 5); }
DI float sigmoidf_(float x) { return 1.0f / (1.0f + __expf(-x)); }

constexpr int BM = 256, BK = 64, HALF = 128, HT = HALF * BK;
DI int lds_byte(int r, int c) { int st = (r >> 4) * 2 + (c >> 5), rr = r & 15, cc = c & 31, ob = rr * 64 + cc * 2; return st * 1024 + (ob ^ (((ob >> 9) & 1) << 5)); }
DI void stage_rc(int b, int& R, int& C) { int st = b / 1024, sb = b % 1024, swz = sb ^ (((sb >> 9) & 1) << 5); R = (st >> 1) * 16 + swz / 64; C = (st & 1) * 32 + (swz % 64) / 2; }

enum { E_INPROJ = 0, E_GATE, E_UQ, E_UKV, E_PROJA, E_PROJB, E_PLAIN, E_UP };
struct GemmDesc { const bf16_t* A; const bf16_t* Bt; bf16_t* C; int lda, ldb, ldc, K, nM, nN, epi, start; };

DI void gemm_kloop(const char* cA, const char* cB, unsigned lda2, unsigned ldb2, int nt, LAS char* lds, f32x4 (&acc)[2][2][4][2]) {
    const int tid = otid(), wid = __builtin_amdgcn_readfirstlane(tid >> 6), lane = tid & 63, wr = wid >> 2, wc = wid & 3, fr = lane & 15, fq = lane >> 4;
    unsigned voffA[2], voffB[2];
#pragma unroll
    for (int i = 0; i < 2; ++i) { int R, C; stage_rc(tid * 16 + i * 8192, R, C); voffA[i] = (unsigned)R * lda2 + (unsigned)C * 2u; voffB[i] = (unsigned)R * ldb2 + (unsigned)C * 2u; }
    const size_t kstep = 128, hA = (size_t)HALF * lda2, hB = (size_t)HALF * ldb2;
    const unsigned ldsw = (unsigned)wid * 1024u;
    const int aoff = lds_byte(wr * 64 + fr, fq * 8), boff = lds_byte(wc * 32 + fr, fq * 8);
    constexpr int HTB = HT * 2;
#define SA(b, h) (((b) * 2 + (h)) * HTB)
#define SB(b, h) ((4 + (b) * 2 + (h)) * HTB)
#define STAGE(bufoff, gbase, voff) do { _Pragma("unroll") for (int _i = 0; _i < 2; ++_i) \
    __builtin_amdgcn_global_load_lds((const unsigned*)((const char*)(gbase) + (voff)[_i]), (LAS unsigned*)(lds + (bufoff) + ldsw + _i * 8192), 16, 0, 0); } while (0)
#define LDA(dst, b, h) do { _Pragma("unroll") for (int m = 0; m < 4; ++m) _Pragma("unroll") for (int k = 0; k < 2; ++k) dst[m][k] = *(const LAS bf16x8*)(lds + SA(b, h) + aoff + m * 2048 + k * 1024); } while (0)
#define LDB(dst, b, h) do { _Pragma("unroll") for (int n = 0; n < 2; ++n) _Pragma("unroll") for (int k = 0; k < 2; ++k) dst[n][k] = *(const LAS bf16x8*)(lds + SB(b, h) + boff + n * 2048 + k * 1024); } while (0)
#define MMA(ai, bj, At, Bt_) do { __builtin_amdgcn_s_setprio(1); _Pragma("unroll") for (int m = 0; m < 4; ++m) _Pragma("unroll") for (int n = 0; n < 2; ++n) _Pragma("unroll") for (int k = 0; k < 2; ++k) \
      acc[ai][bj][m][n] = __builtin_amdgcn_mfma_f32_16x16x32_bf16(Bt_[n][k], At[m][k], acc[ai][bj][m][n], 0, 0, 0); \
    __builtin_amdgcn_s_setprio(0); } while (0)
#define WAIT_V(n) asm volatile("s_waitcnt vmcnt(" #n ")" ::: "memory")
#define WAIT_L(n) asm volatile("s_waitcnt lgkmcnt(" #n ")" ::: "memory")
#define BAR __builtin_amdgcn_s_barrier()
#define SCHED __builtin_amdgcn_sched_barrier(0)
#pragma unroll
    for (int a = 0; a < 2; ++a)
#pragma unroll
        for (int b = 0; b < 2; ++b)
#pragma unroll
            for (int m = 0; m < 4; ++m)
#pragma unroll
                for (int n = 0; n < 2; ++n) acc[a][b][m][n] = (f32x4){0.f, 0.f, 0.f, 0.f};
    bf16x8 At[4][2], B0[2][2], B1[2][2];
    STAGE(SB(0, 0), cB, voffB); STAGE(SA(0, 0), cA, voffA); STAGE(SB(0, 1), cB + hB, voffB); STAGE(SA(0, 1), cA + hA, voffA);
    if (wr == 1) BAR;
    WAIT_V(4); BAR;
    STAGE(SB(1, 0), cB + kstep, voffB); STAGE(SA(1, 0), cA + kstep, voffA); STAGE(SB(1, 1), cB + hB + kstep, voffB);
    WAIT_V(6); BAR;
    for (int t = 0; t < nt - 2; t += 2) {
        const char* a1 = cA + (size_t)(t + 1) * kstep; const char* a2 = a1 + kstep; const char* a3 = a2 + kstep;
        const char* b2 = cB + (size_t)(t + 2) * kstep; const char* b3 = b2 + kstep;
        LDB(B0, 0, 0); SCHED; LDA(At, 0, 0); STAGE(SA(1, 1), a1 + hA, voffA);
        WAIT_L(8); BAR; WAIT_L(0); MMA(0, 0, At, B0); BAR; SCHED;
        LDB(B1, 0, 1); STAGE(SB(0, 0), b2, voffB);
        BAR; WAIT_L(0); MMA(0, 1, At, B1); BAR;
        LDA(At, 0, 1); STAGE(SA(0, 0), a2, voffA);
        BAR; WAIT_L(0); MMA(1, 0, At, B0); BAR; SCHED;
        STAGE(SB(0, 1), b2 + hB, voffB);
        WAIT_V(6); BAR; MMA(1, 1, At, B1); BAR;
        LDB(B0, 1, 0); SCHED; LDA(At, 1, 0); STAGE(SA(0, 1), a2 + hA, voffA);
        WAIT_L(8); BAR; WAIT_L(0); MMA(0, 0, At, B0); BAR; SCHED;
        LDB(B1, 1, 1); STAGE(SB(1, 0), b3, voffB);
        BAR; WAIT_L(0); MMA(0, 1, At, B1); BAR;
        LDA(At, 1, 1); STAGE(SA(1, 0), a3, voffA);
        BAR; WAIT_L(0); MMA(1, 0, At, B0); BAR; SCHED;
        STAGE(SB(1, 1), b3 + hB, voffB);
        WAIT_V(6); BAR; MMA(1, 1, At, B1); BAR;
    }
    { LDB(B0, 0, 0); LDA(At, 0, 0); STAGE(SA(1, 1), cA + (size_t)(nt - 1) * kstep + hA, voffA);
      BAR; WAIT_L(0); MMA(0, 0, At, B0); BAR;
      LDB(B1, 0, 1); BAR; WAIT_L(0); MMA(0, 1, At, B1); BAR;
      LDA(At, 0, 1); WAIT_V(4); BAR; WAIT_L(0); MMA(1, 0, At, B0); MMA(1, 1, At, B1); BAR; }
    { LDB(B0, 1, 0); LDA(At, 1, 0); WAIT_V(2); BAR; WAIT_L(0); MMA(0, 0, At, B0); BAR;
      LDB(B1, 1, 1); WAIT_V(0); BAR; WAIT_L(0); MMA(0, 1, At, B1); BAR;
      LDA(At, 1, 1); BAR; WAIT_L(0); MMA(1, 0, At, B0); MMA(1, 1, At, B1); BAR; }
    if (wr == 0) BAR;
}

#define EPI_ROWS for (int ai = 0; ai < 2; ++ai) for (int m = 0; m < 4; ++m, ({ asm volatile("" ::: "memory"); }))
#define EPI_COLS for (int bj = 0; bj < 2; ++bj) for (int n = 0; n < 2; ++n)

DI void store_bf4(bf16_t* p, f32x4 v) { u32x2 w; w.x = pk2(v[0], v[1]); w.y = pk2(v[2], v[3]); *(u32x2*)p = w; }

DI void gemm_run(const GemmDesc& d, char* lds) {
    float* xl = (float*)(lds + 131072);
    const int G = ogrid(), nun = d.nM * d.nN;
    const int wid = __builtin_amdgcn_readfirstlane(otid() >> 6), wr = wid >> 2, wc = wid & 3;
    for (int u = (int)((obid() + G - (d.start % G)) % G); u < nun; u += G) {
        const int pm = u / d.nN, pn = u % d.nN, brow = pm * BM, bcol = pn * BM;
        if (d.epi == E_UQ) {
            const int tq_ = otid(), r = tq_ >> 1, hf = tq_ & 1;
            const u32x4* src = (const u32x4*)(d.A + (long)(brow + r) * 384 + hf * 192);
            float s = 0.f;
#pragma unroll 4
            for (int i = 0; i < 24; ++i) { u32x4 v = src[i];
                for (int e = 0; e < 4; ++e) { float a = bf_lo(v[e]), b = bf_hi(v[e]); s += a * a + b * b; } }
            s += __shfl_xor(s, 1);
            if (hf == 0) xl[r] = rsqrtf(s * (1.0f / 384.0f) + EPS);
        }
        f32x4 acc[2][2][4][2];
        gemm_kloop((const char*)(d.A + (size_t)brow * d.lda), (const char*)(d.Bt + (size_t)bcol * d.ldb), (unsigned)d.lda * 2u, (unsigned)d.ldb * 2u, d.K / BK, (LAS char*)lds, acc);
        __syncthreads();
        int lane_e = threadIdx.x & 63; asm volatile("" : "+v"(lane_e));
        const int fr = lane_e & 15, fq = lane_e >> 4;
        KP P = kparams();
        const int rbase = brow + wr * 64 + fr, cbase = bcol + wc * 32 + fq * 4;
        switch (d.epi) {
        case E_INPROJ: {
            if (pn == 0) {
#pragma unroll
                EPI_ROWS { const int row = rbase + ai * 128 + m * 16;
#pragma unroll
                    EPI_COLS store_bf4(P->qlat + (long)row * 384 + (cbase + bj * 128 + n * 16), acc[ai][bj][m][n]); }
            } else if (pn == 1) {
#pragma unroll
                EPI_ROWS { const int row = rbase + ai * 128 + m * 16;
#pragma unroll
                    for (int n = 0; n < 2; ++n) store_bf4(P->qlat + (long)row * 384 + 256 + (wc * 32 + fq * 4 + n * 16), acc[ai][0][m][n]);
                    if (wc == 0) {
                        const int pos = pos_of(row);
                        const f32x4 cs0 = *(const f32x4*)(P->ropeT + (long)pos * 32 + fq * 8), cs1 = *(const f32x4*)(P->ropeT + (long)pos * 32 + fq * 8 + 4);
                        const f32x4 x1 = acc[ai][1][m][0], x2 = acc[ai][1][m][1];
                        f32x4 co = {cs0[0], cs0[2], cs1[0], cs1[2]}, si = {cs0[1], cs0[3], cs1[1], cs1[3]};
                        f32x4 o1 = x1 * co - x2 * si, o2 = x2 * co + x1 * si;
                        float* of = P->out + (row < MP ? O_KR_P + (long)row * 32 : O_KR_S + (long)(row - MP) * 32);
                        *(f32x4*)(of + fq * 4) = o1; *(f32x4*)(of + 16 + fq * 4) = o2;
                        bf16_t* ob = P->krope + (long)kvrow_of(row) * 32;
                        store_bf4(ob + fq * 4, o1); store_bf4(ob + 16 + fq * 4, o2);
                    } }
            } else if (pn == 2) {
                float ss[2][4];
#pragma unroll
                EPI_ROWS { float s = 0.f;
#pragma unroll
                    EPI_COLS { const f32x4 v = acc[ai][bj][m][n]; s += v[0] * v[0] + v[1] * v[1] + v[2] * v[2] + v[3] * v[3]; }
                    s += __shfl_xor(s, 16); s += __shfl_xor(s, 32); ss[ai][m] = s;
                    if (fq == 0) ((float*)lds)[(ai * 128 + wr * 64 + m * 16 + fr) * 4 + wc] = s; }
                __syncthreads();
#pragma unroll
                EPI_ROWS { const int rl = ai * 128 + wr * 64 + m * 16 + fr, row = brow + rl;
                    const f32x4 pp = *(const f32x4*)((float*)lds + rl * 4);
                    const float rstd = rsqrtf((pp[0] + pp[1] + pp[2] + pp[3]) * (1.0f / 256.0f) + EPS);
                    float* of = P->out + (row < MP ? O_CKV_P + (long)row * 256 : O_CKV_S + (long)(row - MP) * 256);
                    bf16_t* ob = P->latent + (long)kvrow_of(row) * 256;
#pragma unroll
                    EPI_COLS { const int c = wc * 32 + fq * 4 + bj * 128 + n * 16;
                        const f32x4 gv = *(const f32x4*)(P->g_kv + c); const f32x4 o = acc[ai][bj][m][n] * rstd * gv;
                        *(f32x4*)(of + c) = o; store_bf4(ob + c, o); } }
            } else if (pn <= 4) {
#pragma unroll
                EPI_ROWS { const int row = rbase + ai * 128 + m * 16;
#pragma unroll
                    EPI_COLS store_bf4(P->qb + (long)row * 512 + (cbase - 768 + bj * 128 + n * 16), acc[ai][bj][m][n] * 0.125f); }
            } else if (pn <= 6) {
#pragma unroll
                EPI_ROWS { const int row = rbase + ai * 128 + m * 16;
                    float* of = P->out + (row < MP ? O_SBK_P + (long)row * 512 : O_SBK_S + (long)(row - MP) * 512);
                    bf16_t* ob = P->kb + (long)kvrow_of(row) * 512;
#pragma unroll
                    EPI_COLS { const int c = cbase - 1280 + bj * 128 + n * 16; *(f32x4*)(of + c) = acc[ai][bj][m][n]; store_bf4(ob + c, acc[ai][bj][m][n]); } }
            } else {
#pragma unroll
                EPI_ROWS { const int row = rbase + ai * 128 + m * 16;
                    float* of = P->out + (row < MP ? O_SBV_P + (long)row * 512 : O_SBV_S + (long)(row - MP) * 512);
                    bf16_t* vt; int ldv;
                    if (row < MP) { vt = P->vbT_p + (long)(row >> 13) * 512 * TP + (row & (TP - 1)); ldv = TP; }
                    else { const int r = row - MP; vt = P->vbT_s + (long)(r >> 5) * 512 * SKP + PAST + (r & 31); ldv = SKP; }
#pragma unroll
                    EPI_COLS { const int c = cbase - 1792 + bj * 128 + n * 16; const f32x4 v = acc[ai][bj][m][n]; *(f32x4*)(of + c) = v;
                        const unsigned w0 = pk2(v[0], v[1]), w1 = pk2(v[2], v[3]);
                        vt[(long)(c + 0) * ldv] = (bf16_t)(w0 & 0xffff); vt[(long)(c + 1) * ldv] = (bf16_t)(w0 >> 16);
                        vt[(long)(c + 2) * ldv] = (bf16_t)(w1 & 0xffff); vt[(long)(c + 3) * ldv] = (bf16_t)(w1 >> 16); } }
            }
        } break;
        case E_GATE: {
#pragma unroll
            EPI_ROWS { const int row = rbase + ai * 128 + m * 16;
#pragma unroll
                EPI_COLS { const f32x4 v = acc[ai][bj][m][n]; f32x4 s = {sigmoidf_(v[0]), sigmoidf_(v[1]), sigmoidf_(v[2]), sigmoidf_(v[3])};
                    store_bf4(P->gates + (long)row * 2048 + (cbase + bj * 128 + n * 16), s); } }
        } break;
        case E_UQ: {
            const float qs = 0.10206207261596577f * LOG2E;
#pragma unroll
            EPI_ROWS { const int rl = ai * 128 + wr * 64 + m * 16 + fr, row = brow + rl; const float rs = xl[rl] * qs;
#pragma unroll
                for (int bj = 0; bj < 2; ++bj) { const int grp = pn * 8 + bj * 4 + wc; bf16_t* dst = P->q + (long)row * 768 + grp * 32 + fq * 4;
                    f32x4 v0 = acc[ai][bj][m][0] * rs, v1 = acc[ai][bj][m][1] * rs;
                    if (grp % 3 == 2) {
                        const int pos = pos_of(row);
                        const f32x4 cs0 = *(const f32x4*)(P->ropeT + (long)pos * 32 + fq * 8), cs1 = *(const f32x4*)(P->ropeT + (long)pos * 32 + fq * 8 + 4);
                        f32x4 co = {cs0[0], cs0[2], cs1[0], cs1[2]}, si = {cs0[1], cs0[3], cs1[1], cs1[3]};
                        const f32x4 o1 = v0 * co - v1 * si, o2 = v1 * co + v0 * si; v0 = o1; v1 = o2;
                    }
                    store_bf4(dst, v0); store_bf4(dst + 16, v1); } }
        } break;
        case E_UKV: {
#pragma unroll
            EPI_ROWS { const int row = rbase + ai * 128 + m * 16;
                if (pn < 2) {
#pragma unroll
                    EPI_COLS store_bf4(P->kva + (long)row * 512 + (cbase + bj * 128 + n * 16), acc[ai][bj][m][n]);
                } else {
                    bf16_t* vt; int ldv;
                    if (row < MP) { vt = P->vaT_p + (long)(row >> 13) * 512 * TP + (row & (TP - 1)); ldv = TP; }
                    else { const int r = row - MP, b = r / SKEYS; vt = P->vaT_s + (long)b * 512 * SKP + (r - b * SKEYS); ldv = SKP; }
                    if (row < KVROWS) {
#pragma unroll
                        EPI_COLS { const int c = cbase - 512 + bj * 128 + n * 16; const f32x4 v = acc[ai][bj][m][n];
                            const unsigned w0 = pk2(v[0], v[1]), w1 = pk2(v[2], v[3]);
                            vt[(long)(c + 0) * ldv] = (bf16_t)(w0 & 0xffff); vt[(long)(c + 1) * ldv] = (bf16_t)(w0 >> 16);
                            vt[(long)(c + 2) * ldv] = (bf16_t)(w1 & 0xffff); vt[(long)(c + 3) * ldv] = (bf16_t)(w1 >> 16); }
                    }
                } }
        } break;
        case E_PROJA: case E_PROJB: {
            const int goff = d.epi == E_PROJA ? 0 : 1024;
#pragma unroll
            EPI_ROWS { const int row = rbase + ai * 128 + m * 16;
#pragma unroll
                EPI_COLS { const int c = cbase + bj * 128 + n * 16; const u32x2 gw = *(const u32x2*)(P->gates + (long)row * 2048 + goff + c);
                    f32x4 gv = {bf_lo(gw.x), bf_hi(gw.x), bf_lo(gw.y), bf_hi(gw.y)}; f32x4 v = acc[ai][bj][m][n] * gv;
                    bf16_t* dst = P->merged + (long)row * 1024 + c;
                    if (d.epi == E_PROJB) { const u32x2 pw = *(const u32x2*)dst; f32x4 pv = {bf_lo(pw.x), bf_hi(pw.x), bf_lo(pw.y), bf_hi(pw.y)}; v += pv; }
                    store_bf4(dst, v); } }
        } break;
        case E_PLAIN: {
#pragma unroll
            EPI_ROWS { const int row = rbase + ai * 128 + m * 16;
#pragma unroll
                EPI_COLS store_bf4(d.C + (long)row * d.ldc + (cbase + bj * 128 + n * 16), acc[ai][bj][m][n]); }
        } break;
        case E_UP: {
#pragma unroll
            EPI_ROWS { const int row = rbase + ai * 128 + m * 16;
                float* cf = nullptr;
                if (row < MP) { const int t = row & (TP - 1); if (t >= TP - 2) cf = P->out + O_CONV_P + (long)((row >> 13) * 2 + (t - (TP - 2))) * DFF2; }
                else { const int r = row - MP, t = r & 31; if (t >= 30) cf = P->out + O_CONV_S + (long)((r >> 5) * 2 + (t - 30)) * DFF2; }
#pragma unroll
                EPI_COLS { const int c = cbase + bj * 128 + n * 16; store_bf4(P->u + (long)row * DFF2 + c, acc[ai][bj][m][n]);
                    if (cf) *(f32x4*)(cf + c) = acc[ai][bj][m][n]; } }
        } break;
        }
        __syncthreads();
    }
}

template <int KIND>
DI void gemm_small(KP P, const bf16_t* A, int lda, const bf16_t* Bt, int ldb, int K, int N, bf16_t* C, int ldc) {
    const int tid = otid(), lane = tid & 63, gw = obid() * 8 + (tid >> 6), nw = ogrid() * 8;
    const int ntask = 16 * (N >> 4), fr = lane & 15, fq = lane >> 4;
    for (int task = gw; task < ntask; task += nw) {
        const int rb = task & 15, cb = task >> 4, row = MP + rb * 16 + fr, col = cb * 16 + fq * 4;
        f32x4 acc = {0.f, 0.f, 0.f, 0.f};
        {
            const bf16_t* ap = A + (long)row * lda + fq * 8; const bf16_t* bp = Bt + (long)(cb * 16 + fr) * ldb + fq * 8;
#pragma unroll 8
            for (int k0 = 0; k0 < K; k0 += 32) { const bf16x8 af = *(const bf16x8*)(ap + k0), bf = *(const bf16x8*)(bp + k0);
                acc = __builtin_amdgcn_mfma_f32_16x16x32_bf16(bf, af, acc, 0, 0, 0); }
        }
        if (KIND == 0) store_bf4(C + (long)row * ldc + col, acc);
        else if (KIND == 1) { f32x4 sg = {sigmoidf_(acc[0]), sigmoidf_(acc[1]), sigmoidf_(acc[2]), sigmoidf_(acc[3])}; store_bf4(C + (long)row * ldc + col, sg); }
        else {
            f32x4 acc2 = {0.f, 0.f, 0.f, 0.f};
            const bf16_t* ap = A + 512 + (long)row * lda + fq * 8; const bf16_t* bp = P->WpbT + (long)(cb * 16 + fr) * ldb + fq * 8;
#pragma unroll 8
            for (int k0 = 0; k0 < K; k0 += 32) { const bf16x8 af = *(const bf16x8*)(ap + k0), bf = *(const bf16x8*)(bp + k0);
                acc2 = __builtin_amdgcn_mfma_f32_16x16x32_bf16(bf, af, acc2, 0, 0, 0); }
            const u32x2 ga = *(const u32x2*)(P->gates + (long)row * 2048 + col), gb = *(const u32x2*)(P->gates + (long)row * 2048 + 1024 + col);
            f32x4 gav = {bf_lo(ga.x), bf_hi(ga.x), bf_lo(ga.y), bf_hi(ga.y)}, gbv = {bf_lo(gb.x), bf_hi(gb.x), bf_lo(gb.y), bf_hi(gb.y)};
            store_bf4(C + (long)row * ldc + col, acc * gav + acc2 * gbv);
        }
    }
}

#define MFMA32(a, b, c) __builtin_amdgcn_mfma_f32_32x32x16_bf16((a), (b), (c), 0, 0, 0)
DI int crow(int i, int h) { return (i & 3) + 8 * (i >> 2) + 4 * h; }

template <int MODE>
DI void attn_unit(KP P, char* lds, bool sample, int b, int h, int ublk) {
    constexpr int DQK = MODE == 0 ? 96 : 64, KS = DQK * 2 + 16, VS = 144, NS = DQK / 16;
    constexpr int KBYTES = 64 * KS, BUF = KBYTES + 64 * VS;
    const int tid = otid(), w = tid >> 6, lane = tid & 63, ql = lane & 31, hh = lane >> 5;
    const int kvrow0 = sample ? MP + b * SKEYS : b * TP;
    const int qrow0 = sample ? MP + b * 32 : b * TP + ublk * 256;
    const int ntiles = sample ? 65 : 4 * (ublk + 1);
    const int t0 = sample ? 0 : ublk * 256 + w * 32, tq = t0 + ql;
    int klim, wmax, wmin;
    if (MODE == 0) { if (sample) { klim = wmax = wmin = SKEYS; } else { klim = ((tq >> 6) + 1) << 6; wmax = (((t0 + 31) >> 6) + 1) << 6; wmin = ((t0 >> 6) + 1) << 6; } }
    else { if (sample) { klim = PAST + tq; wmax = PAST + 31; wmin = PAST; } else { klim = tq; wmax = t0 + 31; wmin = t0; } }
    const bool wactive = sample ? (w == 0) : true;
    const bf16_t* Kp; const bf16_t* Qp; const bf16_t* VT; int ldq; long ldv;
    if (MODE == 0) { Kp = P->kva + (long)kvrow0 * 512 + h * 64; Qp = P->q + (long)qrow0 * 768 + h * 96; ldq = 768;
        VT = sample ? P->vaT_s + (long)(b * 512 + h * 64) * SKP : P->vaT_p + (long)(b * 512 + h * 64) * TP; }
    else { Kp = P->kb + (long)kvrow0 * 512 + h * 64; Qp = P->qb + (long)qrow0 * 512 + h * 64; ldq = 512;
        VT = sample ? P->vbT_s + (long)(b * 512 + h * 64) * SKP : P->vbT_p + (long)(b * 512 + h * 64) * TP; }
    ldv = sample ? SKP : TP;
    const bf16_t* Kr = P->krope + (long)kvrow0 * 32;

    bf16x8 qf[NS];
    if (wactive) {
        const bf16_t* qp = Qp + (long)(w * 32 + ql) * ldq + 8 * hh;
#pragma unroll
        for (int s = 0; s < NS; ++s) qf[s] = *(const bf16x8*)(qp + 16 * s);
    } else {
#pragma unroll
        for (int s = 0; s < NS; ++s) qf[s] = (bf16x8){0, 0, 0, 0, 0, 0, 0, 0};
    }
    f32x16 O0, O1;
#pragma unroll
    for (int i = 0; i < 16; ++i) { O0[i] = 0.f; O1[i] = 0.f; }
    float mrun = -INFINITY, lrun = 0.f, carry = 0.f;
    bool wdone = !wactive;
    volatile int* flags = (volatile int*)(lds + 65536 + 64);

    u32x4 rk0, rk1, rv;
    const int krow_s = tid >> 3, kc_s = tid & 7, rrow_s = tid >> 2, rc_s = tid & 3;
    auto load_tile = [&](int kt) {
        rk0 = *(const u32x4*)(Kp + (long)(kt * 64 + krow_s) * 512 + kc_s * 8);
        if (MODE == 0 && tid < 256) rk1 = *(const u32x4*)(Kr + (long)(kt * 64 + rrow_s) * 32 + rc_s * 8);
        rv = *(const u32x4*)(VT + (long)krow_s * ldv + kt * 64 + kc_s * 8);
    };
    auto store_tile = [&](int buf) {
        char* kb_ = lds + buf * BUF; char* vb_ = kb_ + KBYTES;
        *(u32x4*)(kb_ + krow_s * KS + kc_s * 16) = rk0;
        if (MODE == 0 && tid < 256) *(u32x4*)(kb_ + rrow_s * KS + 128 + rc_s * 16) = rk1;
        *(u32x4*)(vb_ + krow_s * VS + kc_s * 16) = rv;
    };
    load_tile(ntiles - 1); store_tile(0);
    __syncthreads();
    for (int it = 0; it < ntiles; ++it) {
        const int kt = ntiles - 1 - it, cur = it & 1;
        if (it + 1 < ntiles) load_tile(kt - 1);
        if (wactive && !wdone && kt * 64 < wmax) {
            const char* kb_ = lds + cur * BUF; const char* vb_ = kb_ + KBYTES;
            f32x16 S0, S1;
#pragma unroll
            for (int i = 0; i < 16; ++i) { S0[i] = 0.f; S1[i] = 0.f; }
#pragma unroll
            for (int s = 0; s < NS; ++s) {
                const bf16x8 k0 = *(const bf16x8*)(kb_ + ql * KS + (16 * s + 8 * hh) * 2);
                const bf16x8 k1 = *(const bf16x8*)(kb_ + (32 + ql) * KS + (16 * s + 8 * hh) * 2);
                S0 = MFMA32(k0, qf[s], S0); S1 = MFMA32(k1, qf[s], S1);
            }
            const bool need_mask = (kt * 64 + 64 > wmin);
            const int kbase = kt * 64 + 4 * hh;
            if (MODE == 0) {
                if (need_mask) {
#pragma unroll
                    for (int i = 0; i < 16; ++i) { const int key = kbase + (i & 3) + 8 * (i >> 2);
                        if (key >= klim) S0[i] = -INFINITY; if (key + 32 >= klim) S1[i] = -INFINITY; }
                }
                float mx = S0[0];
#pragma unroll
                for (int i = 1; i < 16; ++i) mx = fmaxf(mx, S0[i]);
#pragma unroll
                for (int i = 0; i < 16; ++i) mx = fmaxf(mx, S1[i]);
                mx = fmaxf(mx, __shfl_xor(mx, 32));
                const float mnew = fmaxf(mrun, mx);
                const float alpha = __builtin_amdgcn_exp2f(mrun - mnew);
                mrun = mnew;
                float ps = 0.f;
#pragma unroll
                for (int i = 0; i < 16; ++i) { S0[i] = __builtin_amdgcn_exp2f(S0[i] - mnew); S1[i] = __builtin_amdgcn_exp2f(S1[i] - mnew); ps += S0[i] + S1[i]; }
                lrun = lrun * alpha + ps;
#pragma unroll
                for (int i = 0; i < 16; ++i) { O0[i] *= alpha; O1[i] *= alpha; }
            } else {
                float gs[2][4], gp[2][4];
                f32x16 SP0, SP1;
#pragma unroll
                for (int i = 0; i < 16; ++i) { const int key = kbase + (i & 3) + 8 * (i >> 2);
                    { const float z = S0[i]; const float t = __builtin_amdgcn_exp2f(-fabsf(z) * LOG2E); float sp = fmaxf(z, 0.f) + LN2 * __builtin_amdgcn_logf(1.0f + t);
                      if (need_mask && key >= klim) sp = 0.f; SP0[i] = sp; }
                    { const float z = S1[i]; const float t = __builtin_amdgcn_exp2f(-fabsf(z) * LOG2E); float sp = fmaxf(z, 0.f) + LN2 * __builtin_amdgcn_logf(1.0f + t);
                      if (need_mask && key + 32 >= klim) sp = 0.f; SP1[i] = sp; } }
#pragma unroll
                for (int g = 0; g < 4; ++g) { gs[0][g] = (SP0[4 * g] + SP0[4 * g + 1]) + (SP0[4 * g + 2] + SP0[4 * g + 3]);
                    gs[1][g] = (SP1[4 * g] + SP1[4 * g + 1]) + (SP1[4 * g + 2] + SP1[4 * g + 3]); }
#pragma unroll
                for (int g = 0; g < 4; ++g) { gp[0][g] = __shfl_xor(gs[0][g], 32); gp[1][g] = __shfl_xor(gs[1][g], 32); }
                float running = carry;
#pragma unroll
                for (int blk = 1; blk >= 0; --blk)
#pragma unroll
                    for (int g = 3; g >= 0; --g) {
                        const float sum1 = hh ? gs[blk][g] : gp[blk][g], sum0 = hh ? gp[blk][g] : gs[blk][g];
                        const float mybase = hh ? running : running + sum1;
                        running += sum0 + sum1;
                        float later = mybase;
#pragma unroll
                        for (int j = 3; j >= 0; --j) { const int i = 4 * g + j; const int key = kbase + j + 8 * g + 32 * blk;
                            const float z = blk ? S1[i] : S0[i], sp = blk ? SP1[i] : SP0[i];
                            float a = __builtin_amdgcn_exp2f((z - sp - later) * LOG2E);
                            if (need_mask && key >= klim) a = 0.f;
                            later += sp;
                            if (blk) S1[i] = a; else S0[i] = a; }
                    }
                carry = running;
                wdone = __all((carry > 104.0f) || (klim <= 0));
            }
            bf16x8 pf[2][2];
#pragma unroll
            for (int s = 0; s < 2; ++s) {
                u32x4 a, c;
                a.x = pk2(S0[8 * s], S0[8 * s + 1]); a.y = pk2(S0[8 * s + 2], S0[8 * s + 3]); a.z = pk2(S0[8 * s + 4], S0[8 * s + 5]); a.w = pk2(S0[8 * s + 6], S0[8 * s + 7]);
                c.x = pk2(S1[8 * s], S1[8 * s + 1]); c.y = pk2(S1[8 * s + 2], S1[8 * s + 3]); c.z = pk2(S1[8 * s + 4], S1[8 * s + 5]); c.w = pk2(S1[8 * s + 6], S1[8 * s + 7]);
                pf[0][s] = __builtin_bit_cast(bf16x8, a); pf[1][s] = __builtin_bit_cast(bf16x8, c);
            }
#pragma unroll
            for (int blk = 0; blk < 2; ++blk)
#pragma unroll
                for (int s = 0; s < 2; ++s) {
                    const int koff = (32 * blk + 16 * s + 4 * hh) * 2;
                    const s16x4 lo0 = *(const s16x4*)(vb_ + ql * VS + koff), hi0 = *(const s16x4*)(vb_ + ql * VS + koff + 16);
                    const s16x4 lo1 = *(const s16x4*)(vb_ + (32 + ql) * VS + koff), hi1 = *(const s16x4*)(vb_ + (32 + ql) * VS + koff + 16);
                    const bf16x8 v0 = __builtin_shufflevector(lo0, hi0, 0, 1, 2, 3, 4, 5, 6, 7), v1 = __builtin_shufflevector(lo1, hi1, 0, 1, 2, 3, 4, 5, 6, 7);
                    O0 = MFMA32(v0, pf[blk][s], O0); O1 = MFMA32(v1, pf[blk][s], O1);
                }
        }
        if (it + 1 < ntiles) store_tile(cur ^ 1);
        if (MODE == 1 && lane == 0) flags[(it & 1) * 8 + w] = wdone ? 1 : 0;
        __syncthreads();
        if (MODE == 1) { int alld = 1;
#pragma unroll
            for (int ww = 0; ww < 8; ++ww) alld &= flags[(it & 1) * 8 + ww];
            if (alld) break; }
    }
    if (wactive) {
        float inv = 1.0f;
        if (MODE == 0) { const float lt = lrun + __shfl_xor(lrun, 32); inv = 1.0f / lt; }
        bf16_t* op = P->o + (long)(qrow0 + w * 32 + ql) * 1024 + (MODE == 0 ? 0 : 512) + h * 64 + 4 * hh;
#pragma unroll
        for (int g = 0; g < 4; ++g) {
            f32x4 a = {O0[4 * g] * inv, O0[4 * g + 1] * inv, O0[4 * g + 2] * inv, O0[4 * g + 3] * inv};
            f32x4 c = {O1[4 * g] * inv, O1[4 * g + 1] * inv, O1[4 * g + 2] * inv, O1[4 * g + 3] * inv};
            store_bf4(op + 8 * g, a); store_bf4(op + 32 + 8 * g, c);
        }
    }
}

DI void attn_phase(KP P, char* lds, int cidx) {
    unsigned* slot = (unsigned*)(lds + 65536);
    for (;;) {
        if (threadIdx.x == 0) *slot = atomicAdd(P->ctr + cidx, 1u);
        __syncthreads();
        const unsigned idx = *slot;
        __syncthreads();
        if (idx >= 1152u) break;
        bool sample; int mode, b, h, ublk = 0;
        if (idx < 128u) { sample = true; mode = idx >> 6; b = (idx >> 3) & 7; h = idx & 7; }
        else { const int j = idx - 128; sample = false; ublk = 31 - (j >> 5); const int r = j & 31; mode = r >> 4; b = (r >> 3) & 1; h = r & 7; }
        if (mode == 0) attn_unit<0>(P, lds, sample, b, h, ublk); else attn_unit<1>(P, lds, sample, b, h, ublk);
    }
}

DI void phase0(KP P, char* lds) {
    const int tid = otid(), G = ogrid(), bid = obid(), w = tid >> 6, lane = tid & 63;
    for (int item = bid; item < 96; item += G) {
        float* sc = (float*)lds; float* red = (float*)(lds + 40960);
        for (int i = tid; i < 10240; i += NTHREADS) { const int bb = i >> 10, k = i & 1023; const float cv = bb < 2 ? P->c_p[bb * 1024 + k] : P->c_s[(bb - 2) * 1024 + k]; sc[i] = cv / (1.0f + __expf(-cv)); }
        __syncthreads();
        const int col = item * 64 + lane;
        float a0 = 0, a1 = 0, a2 = 0, a3 = 0, a4 = 0, a5 = 0, a6 = 0, a7 = 0, a8 = 0, a9 = 0;
        for (int k0 = w * 128; k0 < w * 128 + 128; k0 += 16) {
            float wv[16];
#pragma unroll
            for (int j = 0; j < 16; ++j) wv[j] = P->w_ada[(long)(k0 + j) * 6144 + col];
#pragma unroll
            for (int j = 0; j < 16; ++j) { const int k = k0 + j;
                a0 += sc[k] * wv[j]; a1 += sc[1024 + k] * wv[j]; a2 += sc[2048 + k] * wv[j]; a3 += sc[3072 + k] * wv[j]; a4 += sc[4096 + k] * wv[j];
                a5 += sc[5120 + k] * wv[j]; a6 += sc[6144 + k] * wv[j]; a7 += sc[7168 + k] * wv[j]; a8 += sc[8192 + k] * wv[j]; a9 += sc[9216 + k] * wv[j]; }
        }
        float* rr = red + w * 640 + lane;
        rr[0] = a0; rr[64] = a1; rr[128] = a2; rr[192] = a3; rr[256] = a4; rr[320] = a5; rr[384] = a6; rr[448] = a7; rr[512] = a8; rr[576] = a9;
        __syncthreads();
        for (int i = tid; i < 640; i += NTHREADS) { float s = 0.f; for (int ww = 0; ww < 8; ++ww) s += red[ww * 640 + i];
            const int bb = i >> 6, l = i & 63; P->ada[bb * 6144 + item * 64 + l] = s + P->b_ada[item * 64 + l]; }
        __syncthreads();
    }
    {
        float* tile = (float*)lds;
        for (int it = (bid + 96) % G; it < P->ntj_tiles; it += G) {
            int j = 0;
#pragma unroll 1
            for (int q = 1; q < NTJ; ++q) if (it >= P->tj[q].tile0) j = q;
            TJob J; J.src = P->tj[j].src; J.kscale = P->tj[j].kscale; J.dst = P->tj[j].dst; J.lds = P->tj[j].lds; J.coff = P->tj[j].coff; J.ldd = P->tj[j].ldd;
            J.Klen = P->tj[j].Klen; J.Nlen = P->tj[j].Nlen; J.zero = P->tj[j].zero; J.tile0 = P->tj[j].tile0;
            const int lt = it - J.tile0, nk = J.Klen >> 6, tk = lt % nk, tn = lt / nk, k0 = tk * 64, n0 = tn * 256;
            f32x4 lv[8];
#pragma unroll
            for (int r = 0; r < 8; ++r) { const int e = tid + r * NTHREADS, kk = e >> 6, n4 = (e & 63) * 4;
                lv[r] = (f32x4){0.f, 0.f, 0.f, 0.f};
                if (!J.zero && n0 + n4 < J.Nlen) lv[r] = *(const f32x4*)(J.src + (long)(k0 + kk) * J.lds + J.coff + n0 + n4); }
#pragma unroll
            for (int r = 0; r < 8; ++r) { const int e = tid + r * NTHREADS, kk = e >> 6, n4 = (e & 63) * 4;
                f32x4 v = lv[r]; if (J.kscale) v *= J.kscale[k0 + kk];
                float* tp = tile + kk * 257 + n4; tp[0] = v[0]; tp[1] = v[1]; tp[2] = v[2]; tp[3] = v[3]; }
            __syncthreads();
#pragma unroll
            for (int r = 0; r < 4; ++r) { const int e = tid + r * NTHREADS, nn = e >> 3, kc = (e & 7) * 8;
                if (n0 + nn < J.Nlen) { const float* tp = tile + kc * 257 + nn; u32x4 o;
                    o.x = pk2(tp[0], tp[257]); o.y = pk2(tp[2 * 257], tp[3 * 257]); o.z = pk2(tp[4 * 257], tp[5 * 257]); o.w = pk2(tp[6 * 257], tp[7 * 257]);
                    *(u32x4*)(J.dst + (long)(n0 + nn) * J.ldd + k0 + kc) = o; } }
            __syncthreads();
        }
    }
    const long gt = (long)bid * NTHREADS + tid, gn = (long)G * NTHREADS;
    for (long i0 = gt; i0 < 8L * PAST * 64; i0 += 4 * gn) { f32x4 v[4];
#pragma unroll
        for (int r = 0; r < 4; ++r) { const long i = i0 + r * gn; if (i < 8L * PAST * 64) v[r] = *(const f32x4*)(P->c_ckv + i * 4); }
#pragma unroll
        for (int r = 0; r < 4; ++r) { const long i = i0 + r * gn; if (i < 8L * PAST * 64) { const long row = i >> 6; const int c = (int)(i & 63) * 4; const int bb = (int)(row >> 12), sq = (int)(row & 4095);
            store_bf4(P->latent + (long)(MP + bb * SKEYS + sq) * 256 + c, v[r]); } } }
    for (long i0 = gt; i0 < 8L * PAST * 8; i0 += 4 * gn) { f32x4 v[4];
#pragma unroll
        for (int r = 0; r < 4; ++r) { const long i = i0 + r * gn; if (i < 8L * PAST * 8) v[r] = *(const f32x4*)(P->c_kr + i * 4); }
#pragma unroll
        for (int r = 0; r < 4; ++r) { const long i = i0 + r * gn; if (i < 8L * PAST * 8) { const long row = i >> 3; const int c = (int)(i & 7) * 4; const int bb = (int)(row >> 12), sq = (int)(row & 4095);
            store_bf4(P->krope + (long)(MP + bb * SKEYS + sq) * 32 + c, v[r]); } } }
    for (long i0 = gt; i0 < 8L * PAST * 128; i0 += 4 * gn) { f32x4 v[4];
#pragma unroll
        for (int r = 0; r < 4; ++r) { const long i = i0 + r * gn; if (i < 8L * PAST * 128) v[r] = *(const f32x4*)(P->c_sbk + i * 4); }
#pragma unroll
        for (int r = 0; r < 4; ++r) { const long i = i0 + r * gn; if (i < 8L * PAST * 128) { const long row = i >> 7; const int c = (int)(i & 127) * 4; const int bb = (int)(row >> 12), sq = (int)(row & 4095);
            store_bf4(P->kb + (long)(MP + bb * SKEYS + sq) * 512 + c, v[r]); } } }
    for (long i = gt; i < 8L * 512 * 8; i += gn) { const long r = i >> 3; const int c = (int)(i & 7) * 4; const u32x2 z = {0u, 0u};
        *(u32x2*)(P->vaT_s + r * SKP + SKEYS + c) = z; *(u32x2*)(P->vbT_s + r * SKP + SKEYS + c) = z; }
    for (long i = gt; i < (long)TP * 16; i += gn) { const int pos = (int)(i >> 4), fi = (int)(i & 15);
        const float inv = exp2f(-(float)fi * (13.287712379549449f / 16.0f));
        const float ang = (float)pos * inv;
        const double rev = (double)ang * 0.15915494309189535; const float fr_ = (float)(rev - floor(rev));
        P->ropeT[i * 2] = __builtin_amdgcn_cosf(fr_); P->ropeT[i * 2 + 1] = __builtin_amdgcn_sinf(fr_); }
}

DI void phase_h(KP P) {
    const int tid_ = otid(), lane = tid_ & 63, gw = obid() * 8 + (tid_ >> 6), nw = ogrid() * 8;
    for (int row = gw; row < MT; row += nw) {
        const float* xr = row < MP ? P->x_p + (long)row * DM : P->x_s + (long)(row - MP) * DM;
        const float* ad = P->ada + ada_b(row) * 6144;
        f32x4 v[4]; float s = 0.f;
#pragma unroll
        for (int i = 0; i < 4; ++i) { v[i] = *(const f32x4*)(xr + i * 256 + lane * 4); s += v[i][0] * v[i][0] + v[i][1] * v[i][1] + v[i][2] * v[i][2] + v[i][3] * v[i][3]; }
#pragma unroll
        for (int o = 1; o < 64; o <<= 1) s += __shfl_xor(s, o);
        const float rstd = rsqrtf(s * (1.0f / DM) + EPS);
#pragma unroll
        for (int i = 0; i < 4; ++i) { const int c = i * 256 + lane * 4;
            const f32x4 g = *(const f32x4*)(P->g_pre_mix + c), sh = *(const f32x4*)(ad + c), scl = *(const f32x4*)(ad + 1024 + c);
            store_bf4(P->h + (long)row * DM + c, v[i] * rstd * g * (1.0f + scl) + sh); }
    }
}

DI void phase_mid(KP P) {
    const int tid_ = otid(), lane = tid_ & 63, gw = obid() * 8 + (tid_ >> 6), nw = ogrid() * 8;
    for (int row = gw; row < MT; row += nw) {
        const float* xr = row < MP ? P->x_p + (long)row * DM : P->x_s + (long)(row - MP) * DM;
        const float* ad = P->ada + ada_b(row) * 6144;
        f32x4 mv[4]; float s = 0.f;
#pragma unroll
        for (int i = 0; i < 4; ++i) { const u32x2 wv = *(const u32x2*)(P->m2 + (long)row * DM + i * 256 + lane * 4);
            mv[i] = (f32x4){bf_lo(wv.x), bf_hi(wv.x), bf_lo(wv.y), bf_hi(wv.y)}; s += mv[i][0] * mv[i][0] + mv[i][1] * mv[i][1] + mv[i][2] * mv[i][2] + mv[i][3] * mv[i][3]; }
#pragma unroll
        for (int o = 1; o < 64; o <<= 1) s += __shfl_xor(s, o);
        const float rstd = rsqrtf(s * (1.0f / DM) + EPS);
        float s2 = 0.f;
#pragma unroll
        for (int i = 0; i < 4; ++i) { const int c = i * 256 + lane * 4;
            const f32x4 xv = *(const f32x4*)(xr + c), g = *(const f32x4*)(P->g_post_mix + c), gt = *(const f32x4*)(ad + 2048 + c);
            mv[i] = xv + gt * (mv[i] * rstd * g);
            *(f32x4*)(P->out + O_Y + (long)row * DM + c) = mv[i];
            s2 += mv[i][0] * mv[i][0] + mv[i][1] * mv[i][1] + mv[i][2] * mv[i][2] + mv[i][3] * mv[i][3]; }
#pragma unroll
        for (int o = 1; o < 64; o <<= 1) s2 += __shfl_xor(s2, o);
        const float rstd2 = rsqrtf(s2 * (1.0f / DM) + EPS);
#pragma unroll
        for (int i = 0; i < 4; ++i) { const int c = i * 256 + lane * 4;
            const f32x4 g = *(const f32x4*)(P->g_pre_ffn + c), sh = *(const f32x4*)(ad + 3072 + c), scl = *(const f32x4*)(ad + 4096 + c);
            store_bf4(P->h2 + (long)row * DM + c, mv[i] * rstd2 * g * (1.0f + scl) + sh); }
    }
}

DI void phase_final(KP P) {
    const int tid_ = otid(), lane = tid_ & 63, gw = obid() * 8 + (tid_ >> 6), nw = ogrid() * 8;
    for (int row = gw; row < MT; row += nw) {
        const float* ad = P->ada + ada_b(row) * 6144;
        f32x4 fv[4]; float s = 0.f;
#pragma unroll
        for (int i = 0; i < 4; ++i) { const u32x2 wv = *(const u32x2*)(P->f + (long)row * DM + i * 256 + lane * 4);
            fv[i] = (f32x4){bf_lo(wv.x), bf_hi(wv.x), bf_lo(wv.y), bf_hi(wv.y)}; s += fv[i][0] * fv[i][0] + fv[i][1] * fv[i][1] + fv[i][2] * fv[i][2] + fv[i][3] * fv[i][3]; }
#pragma unroll
        for (int o = 1; o < 64; o <<= 1) s += __shfl_xor(s, o);
        const float rstd = rsqrtf(s * (1.0f / DM) + EPS);
#pragma unroll
        for (int i = 0; i < 4; ++i) { const int c = i * 256 + lane * 4; float* yp = P->out + O_Y + (long)row * DM + c;
            const f32x4 xv = *(const f32x4*)yp, g = *(const f32x4*)(P->g_post_ffn + c), gt = *(const f32x4*)(ad + 5120 + c);
            *(f32x4*)yp = xv + gt * (fv[i] * rstd * g); }
    }
}

DI float gelu_tanh(float a) { const float t = 0.7978845608028654f * (a + 0.044715f * a * a * a); const float e = __expf(2.0f * t); return 0.5f * a * (2.0f - 2.0f / (1.0f + e)); }

DI void phase_conv(KP P) {
    const long gt = (long)obid() * NTHREADS + otid(), gn = (long)ogrid() * NTHREADS;
    for (long i = gt; i < (long)(MT / 8) * 352; i += gn) {
        const int rg = (int)(i / 352), c = (int)(i % 352) * 8, row0 = rg * 8;
        int t0, bs = -1; if (row0 < MP) t0 = row0 & (TP - 1); else { t0 = (row0 - MP) & 31; bs = (row0 - MP) >> 5; }
        u32x4 ua[10], ub[10];
#pragma unroll
        for (int r = 0; r < 10; ++r) { const int rr = (t0 == 0 && r < 2) ? row0 : row0 + r - 2;
            ua[r] = *(const u32x4*)(P->u + (long)rr * DFF2 + c); ub[r] = *(const u32x4*)(P->u + (long)rr * DFF2 + DFF + c); }
        float wa[3][8], wb[3][8], ba[8], bb[8];
#pragma unroll
        for (int tap = 0; tap < 3; ++tap) { const f32x4 x0 = *(const f32x4*)(P->conv_w + tap * DFF2 + c), x1 = *(const f32x4*)(P->conv_w + tap * DFF2 + c + 4);
            const f32x4 y0 = *(const f32x4*)(P->conv_w + tap * DFF2 + DFF + c), y1 = *(const f32x4*)(P->conv_w + tap * DFF2 + DFF + c + 4);
#pragma unroll
            for (int e = 0; e < 4; ++e) { wa[tap][e] = x0[e]; wa[tap][4 + e] = x1[e]; wb[tap][e] = y0[e]; wb[tap][4 + e] = y1[e]; } }
        { const f32x4 x0 = *(const f32x4*)(P->conv_b + c), x1 = *(const f32x4*)(P->conv_b + c + 4), y0 = *(const f32x4*)(P->conv_b + DFF + c), y1 = *(const f32x4*)(P->conv_b + DFF + c + 4);
#pragma unroll
          for (int e = 0; e < 4; ++e) { ba[e] = x0[e]; ba[4 + e] = x1[e]; bb[e] = y0[e]; bb[4 + e] = y1[e]; } }
        float ha[2][8], hb[2][8];
#pragma unroll
        for (int r = 0; r < 2; ++r)
#pragma unroll
            for (int e = 0; e < 4; ++e) { ha[r][2 * e] = bf_lo(ua[r][e]); ha[r][2 * e + 1] = bf_hi(ua[r][e]); hb[r][2 * e] = bf_lo(ub[r][e]); hb[r][2 * e + 1] = bf_hi(ub[r][e]); }
        if (t0 == 0) {
            if (bs >= 0) {
#pragma unroll
                for (int r = 0; r < 2; ++r) { const float* sp = P->c_conv + (long)(bs * 2 + r) * DFF2 + c;
#pragma unroll
                    for (int e = 0; e < 8; ++e) { ha[r][e] = sp[e]; hb[r][e] = sp[DFF + e]; } }
            } else {
#pragma unroll
                for (int r = 0; r < 2; ++r)
#pragma unroll
                    for (int e = 0; e < 8; ++e) { ha[r][e] = 0.f; hb[r][e] = 0.f; }
            }
        }
        float pa2[8], pa1[8], pb2[8], pb1[8];
#pragma unroll
        for (int e = 0; e < 8; ++e) { pa2[e] = ha[0][e]; pa1[e] = ha[1][e]; pb2[e] = hb[0][e]; pb1[e] = hb[1][e]; }
#pragma unroll
        for (int r = 0; r < 8; ++r) {
            float ca[8], cb[8];
#pragma unroll
            for (int e = 0; e < 4; ++e) { ca[2 * e] = bf_lo(ua[r + 2][e]); ca[2 * e + 1] = bf_hi(ua[r + 2][e]); cb[2 * e] = bf_lo(ub[r + 2][e]); cb[2 * e + 1] = bf_hi(ub[r + 2][e]); }
            u32x4 ov;
#pragma unroll
            for (int e = 0; e < 4; ++e) {
                const float ya0 = ba[2 * e] + wa[0][2 * e] * pa2[2 * e] + wa[1][2 * e] * pa1[2 * e] + wa[2][2 * e] * ca[2 * e];
                const float ya1 = ba[2 * e + 1] + wa[0][2 * e + 1] * pa2[2 * e + 1] + wa[1][2 * e + 1] * pa1[2 * e + 1] + wa[2][2 * e + 1] * ca[2 * e + 1];
                const float yb0 = bb[2 * e] + wb[0][2 * e] * pb2[2 * e] + wb[1][2 * e] * pb1[2 * e] + wb[2][2 * e] * cb[2 * e];
                const float yb1 = bb[2 * e + 1] + wb[0][2 * e + 1] * pb2[2 * e + 1] + wb[1][2 * e + 1] * pb1[2 * e + 1] + wb[2][2 * e + 1] * cb[2 * e + 1];
                ov[e] = pk2(gelu_tanh(ya0) * yb0, gelu_tanh(ya1) * yb1); }
            *(u32x4*)(P->g + (long)(row0 + r) * DFF + c) = ov;
#pragma unroll
            for (int e = 0; e < 8; ++e) { pa2[e] = pa1[e]; pa1[e] = ca[e]; pb2[e] = pb1[e]; pb1[e] = cb[e]; }
        }
    }
}

#define XB_TMO      128
#define XB_XCNT(j)  (256  + 64 * (j))
#define XB_XSUB(j)  (1280 + 64 * (j))
#define XB_XGEN(j)  (2304 + 64 * (j))
#define XB_TOP      3328
#define XB_TOPGEN   3392
#define XCD_BAR_WORDS 3456
#define XB_SPIN_CAP (1u << 18)
DI unsigned xb_ld(unsigned* p)              { return __hip_atomic_load(p, __ATOMIC_RELAXED, __HIP_MEMORY_SCOPE_AGENT); }
DI unsigned xb_add(unsigned* p, unsigned v) { return __hip_atomic_fetch_add(p, v, __ATOMIC_RELAXED, __HIP_MEMORY_SCOPE_AGENT); }
DI unsigned xb_xcc_id() { return (unsigned)__builtin_amdgcn_s_getreg((3 << 11) | 20) & 0xFu; }
#define XB_SPIN(cond, bar) do { unsigned _sp = 0; while (cond) { __builtin_amdgcn_s_sleep(1); \
    if ((++_sp & 255u) == 0u) { if (xb_ld(&(bar)[XB_TMO])) break; if (_sp > XB_SPIN_CAP) { atomicAdd(&(bar)[XB_TMO], 1u); break; } } } } while (0)
DI void xcd_barrier_complete(unsigned* bar, unsigned x, unsigned& nloc, unsigned& nx) {
    const unsigned G = gridDim.x;
    unsigned sum, cnt, mine, sp = 0u;
    for (;;) {
        sum = 0u; cnt = 0u; mine = 0u;
#pragma unroll
        for (unsigned j = 0; j < 16; ++j) { const unsigned c = xb_ld(&bar[XB_XCNT(j)]); sum += c; cnt += (c > 0u) ? 1u : 0u; mine = (j == x) ? c : mine; }
        if (sum == G) break;
        __builtin_amdgcn_s_sleep(1);
        if ((++sp & 255u) == 0u) { if (xb_ld(&bar[XB_TMO])) break; if (sp > XB_SPIN_CAP) { atomicAdd(&bar[XB_TMO], 1u); break; } }
    }
    nloc = mine > 0u ? mine : 1u; nx = cnt > 0u ? cnt : 1u;
}
DI void grid_barrier(char* lds) {
    asm volatile("s_waitcnt vmcnt(0)" ::: "memory");
    __syncthreads();
    if (threadIdx.x == 0) {
        unsigned* bar = kparams()->bar; const unsigned x = xb_xcc_id();
        volatile LAS unsigned* st = (volatile LAS unsigned*)(lds + 131072 + 2048);
        __builtin_amdgcn_s_waitcnt(0);
        unsigned nloc = st[0], nx = st[1];
        if (nloc == 0u) { xcd_barrier_complete(bar, x, nloc, nx); st[0] = nloc; st[1] = nx; }
        const unsigned old = xb_add(&bar[XB_XSUB(x)], 1u);
        const unsigned gen = old / nloc;
        if (old + 1u == (gen + 1u) * nloc) {
            __builtin_amdgcn_fence(__ATOMIC_RELEASE, "agent");
            asm volatile("s_waitcnt vmcnt(0)" ::: "memory");
            const unsigned og = xb_add(&bar[XB_TOP], 1u);
            const unsigned tg = og / nx;
            if (og + 1u == (tg + 1u) * nx) xb_add(&bar[XB_TOPGEN], 1u);
            else XB_SPIN(xb_ld(&bar[XB_TOPGEN]) == tg, bar);
            __builtin_amdgcn_fence(__ATOMIC_ACQUIRE, "agent");
            xb_add(&bar[XB_XGEN(x)], 1u);
            asm volatile("s_waitcnt vmcnt(0)" ::: "memory");
        } else {
            XB_SPIN(xb_ld(&bar[XB_XGEN(x)]) == gen, bar);
            __builtin_amdgcn_fence(__ATOMIC_ACQUIRE, "agent");
            asm volatile("s_waitcnt vmcnt(0)" ::: "memory");
        }
    }
    __syncthreads();
}

__global__ void __launch_bounds__(NTHREADS) fwd_megakernel(Params Pval) {
    extern __shared__ __attribute__((aligned(16))) char lds[];
    cg::grid_group grid = cg::this_grid();
    const int lo = kparams()->phase_lo, hi = kparams()->phase_hi;
#define PH(n) if (lo <= (n) && (n) < hi)
#define SYNC(n) if (lo <= (n) && (n) + 1 < hi) grid_barrier(lds)
    if (hi > 1000) grid.sync();
    { volatile LAS unsigned* st = (volatile LAS unsigned*)(lds + 131072 + 2048);
      if (threadIdx.x == 0) { st[0] = 0u; st[1] = 0u; }
      __syncthreads();
      if (threadIdx.x == 0) (void)xb_add(&kparams()->bar[XB_XCNT(xb_xcc_id())], 1u); }
    PH(0) phase0(kparams(), lds);
#ifdef PROBE_P0
    __syncthreads(); phase0(kparams(), lds);
#endif
#ifdef PROBE_SYNC
    for (int i = 0; i < 24; ++i) grid_barrier(lds);
#endif
    SYNC(0);
    PH(1) phase_h(kparams());
    SYNC(1);
    for (int ph = 2; ph <= 12; ++ph) {
        if (ph == 4) { PH(4) attn_phase(kparams(), lds, 0);
#ifdef PROBE_ATTN2
            __syncthreads(); attn_phase(kparams(), lds, 1);
#endif
            SYNC(4); continue; }
        if (ph == 8) { PH(8) phase_mid(kparams());
#ifdef PROBE_ROWS
            phase_mid(kparams()); phase_h(kparams());
#endif
            SYNC(8); continue; }
        if (ph == 10) { PH(10) phase_conv(kparams());
#ifdef PROBE_CONV
            phase_conv(kparams());
#endif
            SYNC(10); continue; }
        if (ph == 12) { PH(12) phase_final(kparams()); continue; }
        if (lo <= ph && ph < hi) {
            const int npass = (ph == 3 || ph == 6) ? 2 : 1;
            for (int pass = 0; pass < npass; ++pass) {
                GemmDesc d; d.C = nullptr; d.ldc = 0; d.start = 0; KP P = kparams();
                switch (ph) {
                case 2: d.A = P->h; d.lda = DM; d.Bt = P->WinT; d.ldb = DM; d.K = DM; d.nM = 65; d.nN = 9; d.epi = E_INPROJ; break;
                case 3: if (pass == 0) { d.A = P->qlat; d.lda = 384; d.Bt = P->WuqT; d.ldb = 384; d.K = 384; d.nM = 65; d.nN = 3; d.epi = E_UQ; }
                        else { d.A = P->latent; d.lda = 256; d.Bt = P->WukvT; d.ldb = 256; d.K = 256; d.nM = 193; d.nN = 4; d.epi = E_UKV; d.start = 195; } break;
                case 5: d.A = P->h; d.lda = DM; d.Bt = P->WgT; d.ldb = DM; d.K = DM; d.nM = 64; d.nN = 8; d.epi = E_GATE; break;
                case 6: d.A = P->o + pass * 512; d.lda = DM; d.Bt = pass ? P->WpbT : P->WpaT; d.ldb = 512; d.K = 512; d.nM = 64; d.nN = 4; d.epi = pass ? E_PROJB : E_PROJA; break;
                case 7: d.A = P->merged; d.lda = DM; d.Bt = P->WoutT; d.ldb = DM; d.K = DM; d.nM = 64; d.nN = 4; d.epi = E_PLAIN; d.C = P->m2; d.ldc = DM; break;
                case 9: d.A = P->h2; d.lda = DM; d.Bt = P->WupT; d.ldb = DM; d.K = DM; d.nM = 65; d.nN = 22; d.epi = E_UP; break;
                default: d.A = P->g; d.lda = DFF; d.Bt = P->WdownT; d.ldb = DFF; d.K = DFF; d.nM = 64; d.nN = 4; d.epi = E_PLAIN; d.C = P->f; d.ldc = DM; break;
                }
                gemm_run(d, lds);
#ifdef PROBE_GEMM2
                if (!(ph == 6 && pass == 0)) { __syncthreads(); if (ph == 6) { GemmDesc d0 = d; d0.A = P->o; d0.Bt = P->WpaT; d0.epi = E_PROJA; gemm_run(d0, lds); } gemm_run(d, lds); }
#endif
            }
        }
        if (lo <= ph && ph < hi) {
            KP P = kparams();
            if (ph == 5) gemm_small<1>(P, P->h, DM, P->WgT, DM, DM, 2048, P->gates, 2048);
            else if (ph == 6) gemm_small<2>(P, P->o, DM, P->WpaT, 512, 512, 1024, P->merged, DM);
            else if (ph == 7) gemm_small<0>(P, P->merged, DM, P->WoutT, DM, DM, 1024, P->m2, DM);
            else if (ph == 11) gemm_small<0>(P, P->g, DFF, P->WdownT, DFF, DFF, 1024, P->f, DM);
        }
        SYNC(ph);
    }
}

static size_t bump(size_t& off, size_t bytes) { size_t r = off; off += (bytes + 255) & ~(size_t)255; return r; }

extern "C" void kernel_launch(void* const* d_in, const int* in_sizes, int n_in, void* d_out, int out_size, void* d_ws, size_t ws_size, hipStream_t stream) {
    Params P; memset(&P, 0, sizeof(P));
    const float* const* in = (const float* const*)d_in;
    P.x_p = in[0]; P.x_s = in[1]; P.c_ckv = in[2]; P.c_kr = in[3]; P.c_sbk = in[4]; P.c_sbv = in[5]; P.c_conv = in[6]; P.c_p = in[7]; P.c_s = in[8];
    P.w_ada = in[9]; P.b_ada = in[10]; P.g_pre_mix = in[11]; P.g_post_mix = in[12]; P.g_pre_ffn = in[13]; P.g_post_ffn = in[14];
    const float* w_in = in[15]; const float* g_q = in[16]; const float* w_uq = in[17]; P.g_kv = in[18]; const float* w_uk = in[19]; const float* w_uv = in[20];
    const float* w_pa = in[21]; const float* w_pb = in[22]; const float* w_out = in[23]; const float* w_up = in[24]; P.conv_w = in[25]; P.conv_b = in[26]; const float* w_down = in[27];
    P.out = (float*)d_out;
    char* ws = (char*)d_ws; size_t off = 0;
    P.WupT = (bf16_t*)(ws + bump(off, (size_t)DFF2 * DM * 2));
    P.WdownT = (bf16_t*)(ws + bump(off, (size_t)DM * DFF * 2));
    P.ropeT = (float*)(ws + bump(off, (size_t)TP * 32 * 4));
    P.ada = (float*)(ws + bump(off, 10 * 6144 * 4));
    P.ctr = (unsigned*)(ws + bump(off, 256));
    P.bar = (unsigned*)(ws + bump(off, XCD_BAR_WORDS * 4));
    const size_t R0 = off;
    P.WinT = (bf16_t*)(ws + bump(off, (size_t)2304 * DM * 2));
    P.WgT = (bf16_t*)(ws + bump(off, (size_t)2048 * DM * 2));
    P.WuqT = (bf16_t*)(ws + bump(off, (size_t)768 * 384 * 2));
    P.WukvT = (bf16_t*)(ws + bump(off, (size_t)1024 * 256 * 2));
    P.WpaT = (bf16_t*)(ws + bump(off, (size_t)1024 * 512 * 2));
    P.WpbT = (bf16_t*)(ws + bump(off, (size_t)1024 * 512 * 2));
    P.WoutT = (bf16_t*)(ws + bump(off, (size_t)1024 * 1024 * 2));
    const size_t o_kva = off;
    P.kva = (bf16_t*)(ws + bump(off, (size_t)KVROWS_PAD * 512 * 2));
    P.vaT_p = (bf16_t*)(ws + bump(off, (size_t)2 * 512 * TP * 2));
    P.vaT_s = (bf16_t*)(ws + bump(off, (size_t)8 * 512 * SKP * 2));
    const size_t o_kb = off;
    P.kb = (bf16_t*)(ws + bump(off, (size_t)KVROWS_PAD * 512 * 2));
    const size_t o_vbT = off;
    P.vbT_p = (bf16_t*)(ws + bump(off, (size_t)2 * 512 * TP * 2));
    P.vbT_s = (bf16_t*)(ws + bump(off, (size_t)8 * 512 * SKP * 2));
    const size_t o_kr = off;
    P.krope = (bf16_t*)(ws + bump(off, (size_t)KVROWS_PAD * 32 * 2));
    P.qb = (bf16_t*)(ws + bump(off, (size_t)MT * 512 * 2));
    P.q = (bf16_t*)(ws + bump(off, (size_t)MT * 768 * 2));
    P.latent = (bf16_t*)(ws + bump(off, (size_t)KVROWS_PAD * 256 * 2));
    size_t need = off;
    P.gates = (bf16_t*)(ws + o_kva);
    P.merged = (bf16_t*)(ws + o_kb);
    P.m2 = (bf16_t*)(ws + o_vbT);
    P.u = (bf16_t*)(ws + R0);
    const size_t o_g = R0 + (size_t)MT * DFF2 * 2;
    P.g = (bf16_t*)(ws + o_g);
    P.f = (bf16_t*)(ws + R0);
    size_t o_h2 = o_kr > o_g ? o_kr : o_g;
    P.h2 = (bf16_t*)(ws + o_h2);
    if (o_g + (size_t)MT * DFF * 2 > need) need = o_g + (size_t)MT * DFF * 2;
    if (o_h2 + (size_t)MT * DM * 2 > need) need = o_h2 + (size_t)MT * DM * 2;
    P.h = (bf16_t*)d_out;
    P.o = (bf16_t*)d_out + (size_t)MT * DM;
    P.qlat = P.o;
    if (need > ws_size) { fprintf(stderr, "workspace too small: need %zu have %zu\n", need, ws_size); return; }

    int nj = 0, tiles = 0;
    auto job = [&](const float* src, int lds, int coff, bf16_t* dst, int ldd, int Klen, int Nlen, const float* ks, int zero) {
        TJob& J = P.tj[nj++]; J.src = src; J.kscale = ks; J.dst = dst; J.lds = lds; J.coff = coff; J.ldd = ldd; J.Klen = Klen; J.Nlen = Nlen; J.zero = zero; J.tile0 = tiles; J.pad = 0;
        tiles += (Klen / 64) * ((Nlen + 255) / 256); };
    job(w_up, DFF2, 0, P.WupT, DM, DM, DFF2, nullptr, 0);
    job(w_down, DM, 0, P.WdownT, DFF, DFF, DM, nullptr, 0);
    job(w_in, 4256, 0, P.WinT, DM, DM, 384, nullptr, 0);
    job(w_in, 4256, 640, P.WinT + (size_t)384 * DM, DM, DM, 32, nullptr, 0);
    job(w_in, 4256, 0, P.WinT + (size_t)416 * DM, DM, DM, 96, nullptr, 1);
    job(w_in, 4256, 384, P.WinT + (size_t)512 * DM, DM, DM, 256, nullptr, 0);
    job(w_in, 4256, 672, P.WinT + (size_t)768 * DM, DM, DM, 1536, nullptr, 0);
    job(w_in, 4256, 2208, P.WgT, DM, DM, 2048, nullptr, 0);
    job(w_uq, 768, 0, P.WuqT, 384, 384, 768, g_q, 0);
    job(w_uk, 512, 0, P.WukvT, 256, 256, 512, nullptr, 0);
    job(w_uv, 512, 0, P.WukvT + (size_t)512 * 256, 256, 256, 512, nullptr, 0);
    job(w_pa, DM, 0, P.WpaT, 512, 512, DM, nullptr, 0);
    job(w_pb, DM, 0, P.WpbT, 512, 512, DM, nullptr, 0);
    job(w_out, DM, 0, P.WoutT, DM, DM, DM, nullptr, 0);
    for (int b = 0; b < 8; ++b) job(P.c_sbv + (size_t)b * PAST * 512, 512, 0, P.vbT_s + (size_t)b * 512 * SKP, SKP, PAST, 512, nullptr, 0);
    P.ntj_tiles = tiles;
    P.phase_lo = 0; P.phase_hi = 13;

    static int grid_blocks = 0;
    if (!grid_blocks) {
        (void)hipFuncSetAttribute((const void*)fwd_megakernel, hipFuncAttributeMaxDynamicSharedMemorySize, LDS_BYTES);
        int dev = 0, cus = 0, per_cu = 0;
        (void)hipGetDevice(&dev);
        (void)hipDeviceGetAttribute(&cus, hipDeviceAttributeMultiprocessorCount, dev);
        (void)hipOccupancyMaxActiveBlocksPerMultiprocessor(&per_cu, fwd_megakernel, NTHREADS, LDS_BYTES);
        if (per_cu > 1) per_cu = 1;
        grid_blocks = cus * per_cu;
    }
    (void)hipMemsetAsync(P.ctr, 0, 256 + XCD_BAR_WORDS * 4, stream);
    void* args[] = {&P};
    hipError_t e = hipLaunchCooperativeKernel((const void*)fwd_megakernel, dim3(grid_blocks), dim3(NTHREADS), args, LDS_BYTES, stream);
    if (e != hipSuccess) fprintf(stderr, "cooperative launch failed: %s (grid %d)\n", hipGetErrorString(e), grid_blocks);
}
```

```cpp
#include <hip/hip_runtime.h>
#include <hip/hip_cooperative_groups.h>
#include <stdint.h>
#include <stdio.h>
#include <string.h>
namespace cg = cooperative_groups;

typedef unsigned short bf16_t;
typedef short bf16x8 __attribute__((ext_vector_type(8)));
typedef short s16x4 __attribute__((ext_vector_type(4)));
typedef float f32x2 __attribute__((ext_vector_type(2)));
typedef float f32x4 __attribute__((ext_vector_type(4)));
typedef float f32x16 __attribute__((ext_vector_type(16)));
typedef unsigned u32x2 __attribute__((ext_vector_type(2)));
typedef unsigned u32x4 __attribute__((ext_vector_type(4)));
typedef __bf16 bf2_t __attribute__((ext_vector_type(2)));
#define DI __device__ __forceinline__

constexpr int DM = 1024, TP = 8192, MP = 16384, MS = 256, MT = 16640, PAST = 4096, SKEYS = 4128, SKP = 4160;
constexpr int KVROWS = MP + 8 * SKEYS;
constexpr int KVROWS_PAD = KVROWS + 64;
constexpr int DFF = 2816, DFF2 = 5632;
constexpr float EPS = 1e-6f;
constexpr float LOG2E = 1.4426950408889634f, LN2 = 0.6931471805599453f;
constexpr int NTHREADS = 512;
constexpr int LDS_BYTES = 131072 + 4096;
constexpr long O_Y = 0, O_CKV_P = 17039360, O_KR_P = 21233664, O_SBK_P = 21757952, O_SBV_P = 30146560, O_CONV_P = 38535168,
               O_CKV_S = 38557696, O_KR_S = 38623232, O_SBK_S = 38631424, O_SBV_S = 38762496, O_CONV_S = 38893568;

struct TJob { const float* src; const float* kscale; bf16_t* dst; int lds, coff, ldd, Klen, Nlen, zero, tile0, pad; };
constexpr int NTJ = 22;

struct Params {
    const float *x_p, *x_s, *c_ckv, *c_kr, *c_sbk, *c_sbv, *c_conv, *c_p, *c_s;
    const float *w_ada, *b_ada, *g_pre_mix, *g_post_mix, *g_pre_ffn, *g_post_ffn, *g_kv, *conv_w, *conv_b;
    float* out;
    bf16_t *WupT, *WdownT, *WinT, *WgT, *WuqT, *WukvT, *WpaT, *WpbT, *WoutT;
    float* ropeT; float* ada; unsigned* ctr; unsigned* bar;
    bf16_t *h, *o, *qlat, *latent, *krope, *kb, *vbT_p, *vbT_s, *qb, *q, *kva, *vaT_p, *vaT_s, *gates, *merged, *m2, *h2, *u, *g, *f;
    TJob tj[NTJ]; int ntj_tiles; int phase_lo, phase_hi, pad0;
};

#define LAS __attribute__((address_space(3)))
typedef const Params __attribute__((address_space(4))) * KP;
DI KP kparams() { KP p = (KP)__builtin_amdgcn_kernarg_segment_ptr(); asm volatile("" : "+s"(p)); return p; }
DI int otid() { int t = threadIdx.x; asm volatile("" : "+v"(t)); return t; }
DI int obid() { int b = blockIdx.x; asm volatile("" : "+s"(b)); return b; }
DI int ogrid() { int g = gridDim.x; asm volatile("" : "+s"(g)); return g; }
DI unsigned pk2(float a, float b) { f32x2 f = {a, b}; bf2_t r = __builtin_convertvector(f, bf2_t); return __builtin_bit_cast(unsigned, r); }
DI float bf_lo(unsigned u) { return __uint_as_float(u << 16); }
DI float bf_hi(unsigned u) { return __uint_as_float(u & 0xffff0000u); }
DI int kvrow_of(int row) { if (row < MP) return row; const int r = row - MP; return MP + (r >> 5) * SKEYS + PAST + (r & 31); }
DI int pos_of(int row) { return row < MP ? (row & (TP - 1)) : PAST + ((row - MP) & 31); }
DI int ada_b(int row) { return row < MP ? (row >> 13) : 2 + ((row - MP) >> 5); }
DI float sigmoidf_(float x) { return 1.0f / (1.0f + __expf(-x)); }

constexpr int BM = 256, BK = 64, HALF = 128, HT = HALF * BK;
DI int lds_byte(int r, int c) { int st = (r >> 4) * 2 + (c >> 5), rr = r & 15, cc = c & 31, ob = rr * 64 + cc * 2; return st * 1024 + (ob ^ (((ob >> 9) & 1) << 5)); }
DI void stage_rc(int b, int& R, int& C) { int st = b / 1024, sb = b % 1024, swz = sb ^ (((sb >> 9) & 1) << 5); R = (st >> 1) * 16 + swz / 64; C = (st & 1) * 32 + (swz % 64) / 2; }

enum { E_INPROJ = 0, E_GATE, E_UQ, E_UKV, E_PROJA, E_PROJB, E_PLAIN, E_UP };
struct GemmDesc { const bf16_t* A; const bf16_t* Bt; bf16_t* C; int lda, ldb, ldc, K, nM, nN, epi, start; };

DI void gemm_kloop(const char* cA, const char* cB, unsigned lda2, unsigned ldb2, int nt, LAS char* lds, f32x4 (&acc)[2][2][4][2]) {
    const int tid = otid(), wid = __builtin_amdgcn_readfirstlane(tid >> 6), lane = tid & 63, wr = wid >> 2, wc = wid & 3, fr = lane & 15, fq = lane >> 4;
    unsigned voffA[2], voffB[2];
#pragma unroll
    for (int i = 0; i < 2; ++i) { int R, C; stage_rc(tid * 16 + i * 8192, R, C); voffA[i] = (unsigned)R * lda2 + (unsigned)C * 2u; voffB[i] = (unsigned)R * ldb2 + (unsigned)C * 2u; }
    const size_t kstep = 128, hA = (size_t)HALF * lda2, hB = (size_t)HALF * ldb2;
    const unsigned ldsw = (unsigned)wid * 1024u;
    const int aoff = lds_byte(wr * 64 + fr, fq * 8), boff = lds_byte(wc * 32 + fr, fq * 8);
    constexpr int HTB = HT * 2;
#define SA(b, h) (((b) * 2 + (h)) * HTB)
#define SB(b, h) ((4 + (b) * 2 + (h)) * HTB)
#define STAGE(bufoff, gbase, voff) do { _Pragma("unroll") for (int _i = 0; _i < 2; ++_i) \
    __builtin_amdgcn_global_load_lds((const unsigned*)((const char*)(gbase) + (voff)[_i]), (LAS unsigned*)(lds + (bufoff) + ldsw + _i * 8192), 16, 0, 0); } while (0)
#define LDA(dst, b, h) do { _Pragma("unroll") for (int m = 0; m < 4; ++m) _Pragma("unroll") for (int k = 0; k < 2; ++k) dst[m][k] = *(const LAS bf16x8*)(lds + SA(b, h) + aoff + m * 2048 + k * 1024); } while (0)
#define LDB(dst, b, h) do { _Pragma("unroll") for (int n = 0; n < 2; ++n) _Pragma("unroll") for (int k = 0; k < 2; ++k) dst[n][k] = *(const LAS bf16x8*)(lds + SB(b, h) + boff + n * 2048 + k * 1024); } while (0)
#define MMA(ai, bj, At, Bt_) do { __builtin_amdgcn_s_setprio(1); _Pragma("unroll") for (int m = 0; m < 4; ++m) _Pragma("unroll") for (int n = 0; n < 2; ++n) _Pragma("unroll") for (int k = 0; k < 2; ++k) \
      acc[ai][bj][m][n] = __builtin_amdgcn_mfma_f32_16x16x32_bf16(Bt_[n][k], At[m][k], acc[ai][bj][m][n], 0, 0, 0); \
    __builtin_amdgcn_s_setprio(0); } while (0)
#define WAIT_V(n) asm volatile("s_waitcnt vmcnt(" #n ")" ::: "memory")
#define WAIT_L(n) asm volatile("s_waitcnt lgkmcnt(" #n ")" ::: "memory")
#define BAR __builtin_amdgcn_s_barrier()
#define SCHED __builtin_amdgcn_sched_barrier(0)
#pragma unroll
    for (int a = 0; a < 2; ++a)
#pragma unroll
        for (int b = 0; b < 2; ++b)
#pragma unroll
            for (int m = 0; m < 4; ++m)
#pragma unroll
                for (int n = 0; n < 2; ++n) acc[a][b][m][n] = (f32x4){0.f, 0.f, 0.f, 0.f};
    bf16x8 At[4][2], B0[2][2], B1[2][2];
    STAGE(SB(0, 0), cB, voffB); STAGE(SA(0, 0), cA, voffA); STAGE(SB(0, 1), cB + hB, voffB); STAGE(SA(0, 1), cA + hA, voffA);
    if (wr == 1) BAR;
    WAIT_V(4); BAR;
    STAGE(SB(1, 0), cB + kstep, voffB); STAGE(SA(1, 0), cA + kstep, voffA); STAGE(SB(1, 1), cB + hB + kstep, voffB);
    WAIT_V(6); BAR;
    for (int t = 0; t < nt - 2; t += 2) {
        const char* a1 = cA + (size_t)(t + 1) * kstep; const char* a2 = a1 + kstep; const char* a3 = a2 + kstep;
        const char* b2 = cB + (size_t)(t + 2) * kstep; const char* b3 = b2 + kstep;
        LDB(B0, 0, 0); SCHED; LDA(At, 0, 0); STAGE(SA(1, 1), a1 + hA, voffA);
        WAIT_L(8); BAR; WAIT_L(0); MMA(0, 0, At, B0); BAR; SCHED;
        LDB(B1, 0, 1); STAGE(SB(0, 0), b2, voffB);
        BAR; WAIT_L(0); MMA(0, 1, At, B1); BAR;
        LDA(At, 0, 1); STAGE(SA(0, 0), a2, voffA);
        BAR; WAIT_L(0); MMA(1, 0, At, B0); BAR; SCHED;
        STAGE(SB(0, 1), b2 + hB, voffB);
        WAIT_V(6); BAR; MMA(1, 1, At, B1); BAR;
        LDB(B0, 1, 0); SCHED; LDA(At, 1, 0); STAGE(SA(0, 1), a2 + hA, voffA);
        WAIT_L(8); BAR; WAIT_L(0); MMA(0, 0, At, B0); BAR; SCHED;
        LDB(B1, 1, 1); STAGE(SB(1, 0), b3, voffB);
        BAR; WAIT_L(0); MMA(0, 1, At, B1); BAR;
        LDA(At, 1, 1); STAGE(SA(1, 0), a3, voffA);
        BAR; WAIT_L(0); MMA(1, 0, At, B0); BAR; SCHED;
        STAGE(SB(1, 1), b3 + hB, voffB);
        WAIT_V(6); BAR; MMA(1, 1, At, B1); BAR;
    }
    { LDB(B0, 0, 0); LDA(At, 0, 0); STAGE(SA(1, 1), cA + (size_t)(nt - 1) * kstep + hA, voffA);
      BAR; WAIT_L(0); MMA(0, 0, At, B0); BAR;
      LDB(B1, 0, 1); BAR; WAIT_L(0); MMA(0, 1, At, B1); BAR;
      LDA(At, 0, 1); WAIT_V(4); BAR; WAIT_L(0); MMA(1, 0, At, B0); MMA(1, 1, At, B1); BAR; }
    { LDB(B0, 1, 0); LDA(At, 1, 0); WAIT_V(2); BAR; WAIT_L(0); MMA(0, 0, At, B0); BAR;
      LDB(B1, 1, 1); WAIT_V(0); BAR; WAIT_L(0); MMA(0, 1, At, B1); BAR;
      LDA(At, 1, 1); BAR; WAIT_L(0); MMA(1, 0, At, B0); MMA(1, 1, At, B1); BAR; }
    if (wr == 0) BAR;
}

#define EPI_ROWS for (int ai = 0; ai < 2; ++ai) for (int m = 0; m < 4; ++m, ({ asm volatile("" ::: "memory"); }))
#define EPI_COLS for (int bj = 0; bj < 2; ++bj) for (int n = 0; n < 2; ++n)

DI void store_bf4(bf16_t* p, f32x4 v) { u32x2 w; w.x = pk2(v[0], v[1]); w.y = pk2(v[2], v[3]); *(u32x2*)p = w; }

DI void gemm_run(const GemmDesc& d, char* lds) {
    float* xl = (float*)(lds + 131072);
    const int G = ogrid(), nun = d.nM * d.nN;
    const int wid = __builtin_amdgcn_readfirstlane(otid() >> 6), wr = wid >> 2, wc = wid & 3;
    for (int u = (int)((obid() + G - (d.start % G)) % G); u < nun; u += G) {
        const int pm = u / d.nN, pn = u % d.nN, brow = pm * BM, bcol = pn * BM;
        if (d.epi == E_UQ) {
            const int tq_ = otid(), r = tq_ >> 1, hf = tq_ & 1;
            const u32x4* src = (const u32x4*)(d.A + (long)(brow + r) * 384 + hf * 192);
            float s = 0.f;
#pragma unroll 4
            for (int i = 0; i < 24; ++i) { u32x4 v = src[i];
                for (int e = 0; e < 4; ++e) { float a = bf_lo(v[e]), b = bf_hi(v[e]); s += a * a + b * b; } }
            s += __shfl_xor(s, 1);
            if (hf == 0) xl[r] = rsqrtf(s * (1.0f / 384.0f) + EPS);
        }
        f32x4 acc[2][2][4][2];
        gemm_kloop((const char*)(d.A + (size_t)brow * d.lda), (const char*)(d.Bt + (size_t)bcol * d.ldb), (unsigned)d.lda * 2u, (unsigned)d.ldb * 2u, d.K / BK, (LAS char*)lds, acc);
        __syncthreads();
        int lane_e = threadIdx.x & 63; asm volatile("" : "+v"(lane_e));
        const int fr = lane_e & 15, fq = lane_e >> 4;
        KP P = kparams();
        const int rbase = brow + wr * 64 + fr, cbase = bcol + wc * 32 + fq * 4;
        switch (d.epi) {
        case E_INPROJ: {
            if (pn == 0) {
#pragma unroll
                EPI_ROWS { const int row = rbase + ai * 128 + m * 16;
#pragma unroll
                    EPI_COLS store_bf4(P->qlat + (long)row * 384 + (cbase + bj * 128 + n * 16), acc[ai][bj][m][n]); }
            } else if (pn == 1) {
#pragma unroll
                EPI_ROWS { const int row = rbase + ai * 128 + m * 16;
#pragma unroll
                    for (int n = 0; n < 2; ++n) store_bf4(P->qlat + (long)row * 384 + 256 + (wc * 32 + fq * 4 + n * 16), acc[ai][0][m][n]);
                    if (wc == 0) {
                        const int pos = pos_of(row);
                        const f32x4 cs0 = *(const f32x4*)(P->ropeT + (long)pos * 32 + fq * 8), cs1 = *(const f32x4*)(P->ropeT + (long)pos * 32 + fq * 8 + 4);
                        const f32x4 x1 = acc[ai][1][m][0], x2 = acc[ai][1][m][1];
                        f32x4 co = {cs0[0], cs0[2], cs1[0], cs1[2]}, si = {cs0[1], cs0[3], cs1[1], cs1[3]};
                        f32x4 o1 = x1 * co - x2 * si, o2 = x2 * co + x1 * si;
                        float* of = P->out + (row < MP ? O_KR_P + (long)row * 32 : O_KR_S + (long)(row - MP) * 32);
                        *(f32x4*)(of + fq * 4) = o1; *(f32x4*)(of + 16 + fq * 4) = o2;
                        bf16_t* ob = P->krope + (long)kvrow_of(row) * 32;
                        store_bf4(ob + fq * 4, o1); store_bf4(ob + 16 + fq * 4, o2);
                    } }
            } else if (pn == 2) {
                float ss[2][4];
#pragma unroll
                EPI_ROWS { float s = 0.f;
#pragma unroll
                    EPI_COLS { const f32x4 v = acc[ai][bj][m][n]; s += v[0] * v[0] + v[1] * v[1] + v[2] * v[2] + v[3] * v[3]; }
                    s += __shfl_xor(s, 16); s += __shfl_xor(s, 32); ss[ai][m] = s;
                    if (fq == 0) ((float*)lds)[(ai * 128 + wr * 64 + m * 16 + fr) * 4 + wc] = s; }
                __syncthreads();
#pragma unroll
                EPI_ROWS { const int rl = ai * 128 + wr * 64 + m * 16 + fr, row = brow + rl;
                    const f32x4 pp = *(const f32x4*)((float*)lds + rl * 4);
                    const float rstd = rsqrtf((pp[0] + pp[1] + pp[2] + pp[3]) * (1.0f / 256.0f) + EPS);
                    float* of = P->out + (row < MP ? O_CKV_P + (long)row * 256 : O_CKV_S + (long)(row - MP) * 256);
                    bf16_t* ob = P->latent + (long)kvrow_of(row) * 256;
#pragma unroll
                    EPI_COLS { const int c = wc * 32 + fq * 4 + bj * 128 + n * 16;
                        const f32x4 gv = *(const f32x4*)(P->g_kv + c); const f32x4 o = acc[ai][bj][m][n] * rstd * gv;
                        *(f32x4*)(of + c) = o; store_bf4(ob + c, o); } }
            } else if (pn <= 4) {
#pragma unroll
                EPI_ROWS { const int row = rbase + ai * 128 + m * 16;
#pragma unroll
                    EPI_COLS store_bf4(P->qb + (long)row * 512 + (cbase - 768 + bj * 128 + n * 16), acc[ai][bj][m][n] * 0.125f); }
            } else if (pn <= 6) {
#pragma unroll
                EPI_ROWS { const int row = rbase + ai * 128 + m * 16;
                    float* of = P->out + (row < MP ? O_SBK_P + (long)row * 512 : O_SBK_S + (long)(row - MP) * 512);
                    bf16_t* ob = P->kb + (long)kvrow_of(row) * 512;
#pragma unroll
                    EPI_COLS { const int c = cbase - 1280 + bj * 128 + n * 16; *(f32x4*)(of + c) = acc[ai][bj][m][n]; store_bf4(ob + c, acc[ai][bj][m][n]); } }
            } else {
#pragma unroll
                EPI_ROWS { const int row = rbase + ai * 128 + m * 16;
                    float* of = P->out + (row < MP ? O_SBV_P + (long)row * 512 : O_SBV_S + (long)(row - MP) * 512);
                    bf16_t* vt; int ldv;
                    if (row < MP) { vt = P->vbT_p + (long)(row >> 13) * 512 * TP + (row & (TP - 1)); ldv = TP; }
                    else { const int r = row - MP; vt = P->vbT_s + (long)(r >> 5) * 512 * SKP + PAST + (r & 31); ldv = SKP; }
#pragma unroll
                    EPI_COLS { const int c = cbase - 1792 + bj * 128 + n * 16; const f32x4 v = acc[ai][bj][m][n]; *(f32x4*)(of + c) = v;
                        const unsigned w0 = pk2(v[0], v[1]), w1 = pk2(v[2], v[3]);
                        vt[(long)(c + 0) * ldv] = (bf16_t)(w0 & 0xffff); vt[(long)(c + 1) * ldv] = (bf16_t)(w0 >> 16);
                        vt[(long)(c + 2) * ldv] = (bf16_t)(w1 & 0xffff); vt[(long)(c + 3) * ldv] = (bf16_t)(w1 >> 16); } }
            }
        } break;
        case E_GATE: {
#pragma unroll
            EPI_ROWS { const int row = rbase + ai * 128 + m * 16;
#pragma unroll
                EPI_COLS { const f32x4 v = acc[ai][bj][m][n]; f32x4 s = {sigmoidf_(v[0]), sigmoidf_(v[1]), sigmoidf_(v[2]), sigmoidf_(v[3])};
                    store_bf4(P->gates + (long)row * 2048 + (cbase + bj * 128 + n * 16), s); } }
        } break;
        case E_UQ: {
            const float qs = 0.10206207261596577f * LOG2E;
#pragma unroll
            EPI_ROWS { const int rl = ai * 128 + wr * 64 + m * 16 + fr, row = brow + rl; const float rs = xl[rl] * qs;
#pragma unroll
                for (int bj = 0; bj < 2; ++bj) { const int grp = pn * 8 + bj * 4 + wc; bf16_t* dst = P->q + (long)row * 768 + grp * 32 + fq * 4;
                    f32x4 v0 = acc[ai][bj][m][0] * rs, v1 = acc[ai][bj][m][1] * rs;
                    if (grp % 3 == 2) {
                        const int pos = pos_of(row);
                        const f32x4 cs0 = *(const f32x4*)(P->ropeT + (long)pos * 32 + fq * 8), cs1 = *(const f32x4*)(P->ropeT + (long)pos * 32 + fq * 8 + 4);
                        f32x4 co = {cs0[0], cs0[2], cs1[0], cs1[2]}, si = {cs0[1], cs0[3], cs1[1], cs1[3]};
                        const f32x4 o1 = v0 * co - v1 * si, o2 = v1 * co + v0 * si; v0 = o1; v1 = o2;
                    }
                    store_bf4(dst, v0); store_bf4(dst + 16, v1); } }
        } break;
        case E_UKV: {
#pragma unroll
            EPI_ROWS { const int row = rbase + ai * 128 + m * 16;
                if (pn < 2) {
#pragma unroll
                    EPI_COLS store_bf4(P->kva + (long)row * 512 + (cbase + bj * 128 + n * 16), acc[ai][bj][m][n]);
                } else {
                    bf16_t* vt; int ldv;
                    if (row < MP) { vt = P->vaT_p + (long)(row >> 13) * 512 * TP + (row & (TP - 1)); ldv = TP; }
                    else { const int r = row - MP, b = r / SKEYS; vt = P->vaT_s + (long)b * 512 * SKP + (r - b * SKEYS); ldv = SKP; }
                    if (row < KVROWS) {
#pragma unroll
                        EPI_COLS { const int c = cbase - 512 + bj * 128 + n * 16; const f32x4 v = acc[ai][bj][m][n];
                            const unsigned w0 = pk2(v[0], v[1]), w1 = pk2(v[2], v[3]);
                            vt[(long)(c + 0) * ldv] = (bf16_t)(w0 & 0xffff); vt[(long)(c + 1) * ldv] = (bf16_t)(w0 >> 16);
                            vt[(long)(c + 2) * ldv] = (bf16_t)(w1 & 0xffff); vt[(long)(c + 3) * ldv] = (bf16_t)(w1 >> 16); }
                    }
                } }
        } break;
        case E_PROJA: case E_PROJB: {
            const int goff = d.epi == E_PROJA ? 0 : 1024;
#pragma unroll
            EPI_ROWS { const int row = rbase + ai * 128 + m * 16;
#pragma unroll
                EPI_COLS { const int c = cbase + bj * 128 + n * 16; const u32x2 gw = *(const u32x2*)(P->gates + (long)row * 2048 + goff + c);
                    f32x4 gv = {bf_lo(gw.x), bf_hi(gw.x), bf_lo(gw.y), bf_hi(gw.y)}; f32x4 v = acc[ai][bj][m][n] * gv;
                    bf16_t* dst = P->merged + (long)row * 1024 + c;
                    if (d.epi == E_PROJB) { const u32x2 pw = *(const u32x2*)dst; f32x4 pv = {bf_lo(pw.x), bf_hi(pw.x), bf_lo(pw.y), bf_hi(pw.y)}; v += pv; }
                    store_bf4(dst, v); } }
        } break;
        case E_PLAIN: {
#pragma unroll
            EPI_ROWS { const int row = rbase + ai * 128 + m * 16;
#pragma unroll
                EPI_COLS store_bf4(d.C + (long)row * d.ldc + (cbase + bj * 128 + n * 16), acc[ai][bj][m][n]); }
        } break;
        case E_UP: {
#pragma unroll
            EPI_ROWS { const int row = rbase + ai * 128 + m * 16;
                float* cf = nullptr;
                if (row < MP) { const int t = row & (TP - 1); if (t >= TP - 2) cf = P->out + O_CONV_P + (long)((row >> 13) * 2 + (t - (TP - 2))) * DFF2; }
                else { const int r = row - MP, t = r & 31; if (t >= 30) cf = P->out + O_CONV_S + (long)((r >> 5) * 2 + (t - 30)) * DFF2; }
#pragma unroll
                EPI_COLS { const int c = cbase + bj * 128 + n * 16; store_bf4(P->u + (long)row * DFF2 + c, acc[ai][bj][m][n]);
                    if (cf) *(f32x4*)(cf + c) = acc[ai][bj][m][n]; } }
        } break;
        }
        __syncthreads();
    }
}

#define MFMA32(a, b, c) __builtin_amdgcn_mfma_f32_32x32x16_bf16((a), (b), (c), 0, 0, 0)
template <int KIND, int KSTEPS  >
DI void gemm_small(KP P, const bf16_t* A, int lda, const bf16_t* Bt, int ldb, int N, bf16_t* C, int ldc, char* lds) {
    const int tid = otid(), lane = tid & 63, w = tid >> 6, r = lane & 31, hh = lane >> 5, G = ogrid();
    const int ntask = 8 * (N >> 5);
    float* part = (float*)lds;
    for (int task = obid(); task < ntask; task += G) {
        const int rb = task & 7, cb = task >> 3, row0 = MP + rb * 32, col0 = cb * 32;
#pragma unroll
        for (int pass = 0; pass < (KIND == 2 ? 2 : 1); ++pass) {
            const bf16_t* ap = A + pass * 512 + (long)(row0 + r) * lda + w * (KSTEPS * 16) + 8 * hh;
            const bf16_t* bp = (pass ? P->WpbT : Bt) + (long)(col0 + r) * ldb + w * (KSTEPS * 16) + 8 * hh;
            f32x16 acc;
#pragma unroll
            for (int i = 0; i < 16; ++i) acc[i] = 0.f;
            constexpr int UN = KSTEPS > 11 ? 11 : KSTEPS;
#pragma unroll 1
            for (int s0 = 0; s0 < KSTEPS; s0 += UN) {
                bf16x8 af[UN], bf[UN];
#pragma unroll
                for (int s = 0; s < UN; ++s) { af[s] = *(const bf16x8*)(ap + (s0 + s) * 16); bf[s] = *(const bf16x8*)(bp + (s0 + s) * 16); }
#pragma unroll
                for (int s = 0; s < UN; ++s) acc = MFMA32(bf[s], af[s], acc);
            }
            float* pp = part + ((pass * 8 + w) * 32 + r) * 32 + 4 * hh;
#pragma unroll
            for (int g = 0; g < 4; ++g) *(f32x4*)(pp + 8 * g) = (f32x4){acc[4 * g], acc[4 * g + 1], acc[4 * g + 2], acc[4 * g + 3]};
        }
        __syncthreads();
        {
            const int e = tid * 2, rr = e >> 5, cc = e & 31;
            f32x2 s1 = {0.f, 0.f}, s2 = {0.f, 0.f};
#pragma unroll
            for (int ww = 0; ww < 8; ++ww) { s1 += *(const f32x2*)(part + (ww * 32 + rr) * 32 + cc); if (KIND == 2) s2 += *(const f32x2*)(part + ((8 + ww) * 32 + rr) * 32 + cc); }
            const long row = row0 + rr; const int col = col0 + cc;
            if (KIND == 1) { s1[0] = sigmoidf_(s1[0]); s1[1] = sigmoidf_(s1[1]); }
            if (KIND == 2) { const unsigned ga = *(const unsigned*)(P->gates + row * 2048 + col), gb = *(const unsigned*)(P->gates + row * 2048 + 1024 + col);
                s1[0] = s1[0] * bf_lo(ga) + s2[0] * bf_lo(gb); s1[1] = s1[1] * bf_hi(ga) + s2[1] * bf_hi(gb); }
            *(unsigned*)(C + row * ldc + col) = pk2(s1[0], s1[1]);
        }
        __syncthreads();
    }
}

DI int crow(int i, int h) { return (i & 3) + 8 * (i >> 2) + 4 * h; }

template <int MODE>
DI void attn_unit(KP P, char* lds, bool sample, int b, int h, int ublk) {
    constexpr int DQK = MODE == 0 ? 96 : 64, KS = DQK * 2 + 16, VS = 144, NS = DQK / 16;
    constexpr int KBYTES = 64 * KS, BUF = KBYTES + 64 * VS;
    const int tid = otid(), w = tid >> 6, lane = tid & 63, ql = lane & 31, hh = lane >> 5;
    const int kvrow0 = sample ? MP + b * SKEYS : b * TP;
    const int qrow0 = sample ? MP + b * 32 : b * TP + ublk * 256;
    const int ntiles = sample ? 65 : 4 * (ublk + 1);
    const int t0 = sample ? 0 : ublk * 256 + w * 32, tq = t0 + ql;
    int klim, wmax, wmin;
    if (MODE == 0) { if (sample) { klim = wmax = wmin = SKEYS; } else { klim = ((tq >> 6) + 1) << 6; wmax = (((t0 + 31) >> 6) + 1) << 6; wmin = ((t0 >> 6) + 1) << 6; } }
    else { if (sample) { klim = PAST + tq; wmax = PAST + 31; wmin = PAST; } else { klim = tq; wmax = t0 + 31; wmin = t0; } }
    const bool wactive = sample ? (w == 0) : true;
    const bf16_t* Kp; const bf16_t* Qp; const bf16_t* VT; int ldq; long ldv;
    if (MODE == 0) { Kp = P->kva + (long)kvrow0 * 512 + h * 64; Qp = P->q + (long)qrow0 * 768 + h * 96; ldq = 768;
        VT = sample ? P->vaT_s + (long)(b * 512 + h * 64) * SKP : P->vaT_p + (long)(b * 512 + h * 64) * TP; }
    else { Kp = P->kb + (long)kvrow0 * 512 + h * 64; Qp = P->qb + (long)qrow0 * 512 + h * 64; ldq = 512;
        VT = sample ? P->vbT_s + (long)(b * 512 + h * 64) * SKP : P->vbT_p + (long)(b * 512 + h * 64) * TP; }
    ldv = sample ? SKP : TP;
    const bf16_t* Kr = P->krope + (long)kvrow0 * 32;

    bf16x8 qf[NS];
    if (wactive) {
        const bf16_t* qp = Qp + (long)(w * 32 + ql) * ldq + 8 * hh;
#pragma unroll
        for (int s = 0; s < NS; ++s) qf[s] = *(const bf16x8*)(qp + 16 * s);
    } else {
#pragma unroll
        for (int s = 0; s < NS; ++s) qf[s] = (bf16x8){0, 0, 0, 0, 0, 0, 0, 0};
    }
    f32x16 O0, O1;
#pragma unroll
    for (int i = 0; i < 16; ++i) { O0[i] = 0.f; O1[i] = 0.f; }
    float mrun = -INFINITY, lrun = 0.f, carry = 0.f;
    bool wdone = !wactive;
    volatile int* flags = (volatile int*)(lds + 65536 + 64);

    u32x4 rk0, rk1, rv;
    const int krow_s = tid >> 3, kc_s = tid & 7, rrow_s = tid >> 2, rc_s = tid & 3;
    const bool f32path = (MODE == 1) && sample;
    const float* Kf = P->c_sbk + ((long)b * PAST * 512 + h * 64); const float* Vf = P->c_sbv + ((long)b * PAST * 512 + h * 64);
    auto load_tile = [&](int kt) {
        if (f32path && kt < 64) {
            const float* kp_ = Kf + (long)(kt * 64 + krow_s) * 512 + kc_s * 8; const float* vp_ = Vf + (long)(kt * 64 + krow_s) * 512 + kc_s * 8;
            const f32x4 a0 = *(const f32x4*)kp_, a1 = *(const f32x4*)(kp_ + 4), c0 = *(const f32x4*)vp_, c1 = *(const f32x4*)(vp_ + 4);
            rk0.x = pk2(a0[0], a0[1]); rk0.y = pk2(a0[2], a0[3]); rk0.z = pk2(a1[0], a1[1]); rk0.w = pk2(a1[2], a1[3]);
            rv.x = pk2(c0[0], c0[1]); rv.y = pk2(c0[2], c0[3]); rv.z = pk2(c1[0], c1[1]); rv.w = pk2(c1[2], c1[3]);
            return;
        }
        rk0 = *(const u32x4*)(Kp + (long)(kt * 64 + krow_s) * 512 + kc_s * 8);
        if (MODE == 0 && tid < 256) rk1 = *(const u32x4*)(Kr + (long)(kt * 64 + rrow_s) * 32 + rc_s * 8);
        rv = *(const u32x4*)(VT + (long)krow_s * ldv + kt * 64 + kc_s * 8);
    };
    auto store_tile = [&](int buf, int kt) {
        char* kb_ = lds + buf * BUF; char* vb_ = kb_ + KBYTES;
        *(u32x4*)(kb_ + krow_s * KS + kc_s * 16) = rk0;
        if (f32path && kt < 64) {
#pragma unroll
            for (int e = 0; e < 4; ++e) { *(bf16_t*)(vb_ + (kc_s * 8 + 2 * e) * VS + krow_s * 2) = (bf16_t)(rv[e] & 0xffff); *(bf16_t*)(vb_ + (kc_s * 8 + 2 * e + 1) * VS + krow_s * 2) = (bf16_t)(rv[e] >> 16); }
            return;
        }
        if (MODE == 0 && tid < 256) *(u32x4*)(kb_ + rrow_s * KS + 128 + rc_s * 16) = rk1;
        *(u32x4*)(vb_ + krow_s * VS + kc_s * 16) = rv;
    };
    load_tile(ntiles - 1); store_tile(0, ntiles - 1);
    __syncthreads();
    for (int it = 0; it < ntiles; ++it) {
        const int kt = ntiles - 1 - it, cur = it & 1;
        if (it + 1 < ntiles) load_tile(kt - 1);
        if (wactive && !wdone && kt * 64 < wmax) {
            const char* kb_ = lds + cur * BUF; const char* vb_ = kb_ + KBYTES;
            f32x16 S0, S1;
#pragma unroll
            for (int i = 0; i < 16; ++i) { S0[i] = 0.f; S1[i] = 0.f; }
#pragma unroll
            for (int s = 0; s < NS; ++s) {
                const bf16x8 k0 = *(const bf16x8*)(kb_ + ql * KS + (16 * s + 8 * hh) * 2);
                const bf16x8 k1 = *(const bf16x8*)(kb_ + (32 + ql) * KS + (16 * s + 8 * hh) * 2);
                S0 = MFMA32(k0, qf[s], S0); S1 = MFMA32(k1, qf[s], S1);
            }
            const bool need_mask = (kt * 64 + 64 > wmin);
            const int kbase = kt * 64 + 4 * hh;
            if (MODE == 0) {
                if (need_mask) {
#pragma unroll
                    for (int i = 0; i < 16; ++i) { const int key = kbase + (i & 3) + 8 * (i >> 2);
                        if (key >= klim) S0[i] = -INFINITY; if (key + 32 >= klim) S1[i] = -INFINITY; }
                }
                float mx = S0[0];
#pragma unroll
                for (int i = 1; i < 16; ++i) mx = fmaxf(mx, S0[i]);
#pragma unroll
                for (int i = 0; i < 16; ++i) mx = fmaxf(mx, S1[i]);
                mx = fmaxf(mx, __shfl_xor(mx, 32));
                const float mnew = fmaxf(mrun, mx);
                const float alpha = __builtin_amdgcn_exp2f(mrun - mnew);
                mrun = mnew;
                float ps = 0.f;
#pragma unroll
                for (int i = 0; i < 16; ++i) { S0[i] = __builtin_amdgcn_exp2f(S0[i] - mnew); S1[i] = __builtin_amdgcn_exp2f(S1[i] - mnew); ps += S0[i] + S1[i]; }
                lrun = lrun * alpha + ps;
#pragma unroll
                for (int i = 0; i < 16; ++i) { O0[i] *= alpha; O1[i] *= alpha; }
            } else {
                float gs[2][4], gp[2][4];
                f32x16 SP0, SP1;
#pragma unroll
                for (int i = 0; i < 16; ++i) { const int key = kbase + (i & 3) + 8 * (i >> 2);
                    { const float z = S0[i]; const float t = __builtin_amdgcn_exp2f(-fabsf(z) * LOG2E); float sp = fmaxf(z, 0.f) + LN2 * __builtin_amdgcn_logf(1.0f + t);
                      if (need_mask && key >= klim) sp = 0.f; SP0[i] = sp; }
                    { const float z = S1[i]; const float t = __builtin_amdgcn_exp2f(-fabsf(z) * LOG2E); float sp = fmaxf(z, 0.f) + LN2 * __builtin_amdgcn_logf(1.0f + t);
                      if (need_mask && key + 32 >= klim) sp = 0.f; SP1[i] = sp; } }
#pragma unroll
                for (int g = 0; g < 4; ++g) { gs[0][g] = (SP0[4 * g] + SP0[4 * g + 1]) + (SP0[4 * g + 2] + SP0[4 * g + 3]);
                    gs[1][g] = (SP1[4 * g] + SP1[4 * g + 1]) + (SP1[4 * g + 2] + SP1[4 * g + 3]); }
#pragma unroll
                for (int g = 0; g < 4; ++g) { gp[0][g] = __shfl_xor(gs[0][g], 32); gp[1][g] = __shfl_xor(gs[1][g], 32); }
                float running = carry;
#pragma unroll
                for (int blk = 1; blk >= 0; --blk)
#pragma unroll
                    for (int g = 3; g >= 0; --g) {
                        const float sum1 = hh ? gs[blk][g] : gp[blk][g], sum0 = hh ? gp[blk][g] : gs[blk][g];
                        const float mybase = hh ? running : running + sum1;
                        running += sum0 + sum1;
                        float later = mybase;
#pragma unroll
                        for (int j = 3; j >= 0; --j) { const int i = 4 * g + j; const int key = kbase + j + 8 * g + 32 * blk;
                            const float z = blk ? S1[i] : S0[i], sp = blk ? SP1[i] : SP0[i];
                            float a = __builtin_amdgcn_exp2f((z - sp - later) * LOG2E);
                            if (need_mask && key >= klim) a = 0.f;
                            later += sp;
                            if (blk) S1[i] = a; else S0[i] = a; }
                    }
                carry = running;
                wdone = __all((carry > 104.0f) || (klim <= 0));
            }
            bf16x8 pf[2][2];
#pragma unroll
            for (int s = 0; s < 2; ++s) {
                u32x4 a, c;
                a.x = pk2(S0[8 * s], S0[8 * s + 1]); a.y = pk2(S0[8 * s + 2], S0[8 * s + 3]); a.z = pk2(S0[8 * s + 4], S0[8 * s + 5]); a.w = pk2(S0[8 * s + 6], S0[8 * s + 7]);
                c.x = pk2(S1[8 * s], S1[8 * s + 1]); c.y = pk2(S1[8 * s + 2], S1[8 * s + 3]); c.z = pk2(S1[8 * s + 4], S1[8 * s + 5]); c.w = pk2(S1[8 * s + 6], S1[8 * s + 7]);
                pf[0][s] = __builtin_bit_cast(bf16x8, a); pf[1][s] = __builtin_bit_cast(bf16x8, c);
            }
#pragma unroll
            for (int blk = 0; blk < 2; ++blk)
#pragma unroll
                for (int s = 0; s < 2; ++s) {
                    const int koff = (32 * blk + 16 * s + 4 * hh) * 2;
                    const s16x4 lo0 = *(const s16x4*)(vb_ + ql * VS + koff), hi0 = *(const s16x4*)(vb_ + ql * VS + koff + 16);
                    const s16x4 lo1 = *(const s16x4*)(vb_ + (32 + ql) * VS + koff), hi1 = *(const s16x4*)(vb_ + (32 + ql) * VS + koff + 16);
                    const bf16x8 v0 = __builtin_shufflevector(lo0, hi0, 0, 1, 2, 3, 4, 5, 6, 7), v1 = __builtin_shufflevector(lo1, hi1, 0, 1, 2, 3, 4, 5, 6, 7);
                    O0 = MFMA32(v0, pf[blk][s], O0); O1 = MFMA32(v1, pf[blk][s], O1);
                }
        }
        if (it + 1 < ntiles) store_tile(cur ^ 1, kt - 1);
        if (MODE == 1 && lane == 0) flags[(it & 1) * 8 + w] = wdone ? 1 : 0;
        __syncthreads();
        if (MODE == 1) { int alld = 1;
#pragma unroll
            for (int ww = 0; ww < 8; ++ww) alld &= flags[(it & 1) * 8 + ww];
            if (alld) break; }
    }
    if (wactive) {
        float inv = 1.0f;
        if (MODE == 0) { const float lt = lrun + __shfl_xor(lrun, 32); inv = 1.0f / lt; }
        bf16_t* op = P->o + (long)(qrow0 + w * 32 + ql) * 1024 + (MODE == 0 ? 0 : 512) + h * 64 + 4 * hh;
#pragma unroll
        for (int g = 0; g < 4; ++g) {
            f32x4 a = {O0[4 * g] * inv, O0[4 * g + 1] * inv, O0[4 * g + 2] * inv, O0[4 * g + 3] * inv};
            f32x4 c = {O1[4 * g] * inv, O1[4 * g + 1] * inv, O1[4 * g + 2] * inv, O1[4 * g + 3] * inv};
            store_bf4(op + 8 * g, a); store_bf4(op + 32 + 8 * g, c);
        }
    }
}

DI void attn_phase(KP P, char* lds, int cidx) {
    unsigned* slot = (unsigned*)(lds + 65536);
    for (;;) {
        if (threadIdx.x == 0) *slot = atomicAdd(P->ctr + cidx, 1u);
        __syncthreads();
        const unsigned idx = *slot;
        __syncthreads();
        if (idx >= 1152u) break;
        bool sample; int mode, b, h, ublk = 0;
        if (idx < 128u) { sample = true; mode = idx >> 6; b = (idx >> 3) & 7; h = idx & 7; }
        else { const int j = idx - 128; sample = false; ublk = 31 - (j >> 5); const int r = j & 31; mode = r >> 4; b = (r >> 3) & 1; h = r & 7; }
        if (mode == 0) attn_unit<0>(P, lds, sample, b, h, ublk); else attn_unit<1>(P, lds, sample, b, h, ublk);
    }
}

DI void phase0(KP P, char* lds) {
    const int tid = otid(), G = ogrid(), bid = obid(), w = tid >> 6, lane = tid & 63;
    for (int item = bid; item < 96; item += G) {
        float* sc = (float*)lds; float* red = (float*)(lds + 40960);
        for (int i = tid; i < 10240; i += NTHREADS) { const int bb = i >> 10, k = i & 1023; const float cv = bb < 2 ? P->c_p[bb * 1024 + k] : P->c_s[(bb - 2) * 1024 + k]; sc[i] = cv / (1.0f + __expf(-cv)); }
        __syncthreads();
        const int col = item * 64 + lane;
        float a0 = 0, a1 = 0, a2 = 0, a3 = 0, a4 = 0, a5 = 0, a6 = 0, a7 = 0, a8 = 0, a9 = 0;
        for (int k0 = w * 128; k0 < w * 128 + 128; k0 += 16) {
            float wv[16];
#pragma unroll
            for (int j = 0; j < 16; ++j) wv[j] = P->w_ada[(long)(k0 + j) * 6144 + col];
#pragma unroll
            for (int j = 0; j < 16; ++j) { const int k = k0 + j;
                a0 += sc[k] * wv[j]; a1 += sc[1024 + k] * wv[j]; a2 += sc[2048 + k] * wv[j]; a3 += sc[3072 + k] * wv[j]; a4 += sc[4096 + k] * wv[j];
                a5 += sc[5120 + k] * wv[j]; a6 += sc[6144 + k] * wv[j]; a7 += sc[7168 + k] * wv[j]; a8 += sc[8192 + k] * wv[j]; a9 += sc[9216 + k] * wv[j]; }
        }
        float* rr = red + w * 640 + lane;
        rr[0] = a0; rr[64] = a1; rr[128] = a2; rr[192] = a3; rr[256] = a4; rr[320] = a5; rr[384] = a6; rr[448] = a7; rr[512] = a8; rr[576] = a9;
        __syncthreads();
        for (int i = tid; i < 640; i += NTHREADS) { float s = 0.f; for (int ww = 0; ww < 8; ++ww) s += red[ww * 640 + i];
            const int bb = i >> 6, l = i & 63; P->ada[bb * 6144 + item * 64 + l] = s + P->b_ada[item * 64 + l]; }
        __syncthreads();
    }
    {
        float* tile = (float*)lds;
        for (int it = (bid + 96) % G; it < P->ntj_tiles; it += G) {
            int j = 0;
#pragma unroll 1
            for (int q = 1; q < P->pad0; ++q) if (it >= P->tj[q].tile0) j = q;
            TJob J; J.src = P->tj[j].src; J.kscale = P->tj[j].kscale; J.dst = P->tj[j].dst; J.lds = P->tj[j].lds; J.coff = P->tj[j].coff; J.ldd = P->tj[j].ldd;
            J.Klen = P->tj[j].Klen; J.Nlen = P->tj[j].Nlen; J.zero = P->tj[j].zero; J.tile0 = P->tj[j].tile0;
            const int lt = it - J.tile0, nk = J.Klen >> 6, tk = lt % nk, tn = lt / nk, k0 = tk * 64, n0 = tn * 256;
            f32x4 lv[8];
#pragma unroll
            for (int r = 0; r < 8; ++r) { const int e = tid + r * NTHREADS, kk = e >> 6, n4 = (e & 63) * 4;
                lv[r] = (f32x4){0.f, 0.f, 0.f, 0.f};
                if (!J.zero && n0 + n4 < J.Nlen) lv[r] = *(const f32x4*)(J.src + (long)(k0 + kk) * J.lds + J.coff + n0 + n4); }
#pragma unroll
            for (int r = 0; r < 8; ++r) { const int e = tid + r * NTHREADS, kk = e >> 6, n4 = (e & 63) * 4;
                f32x4 v = lv[r]; if (J.kscale) v *= J.kscale[k0 + kk];
                float* tp = tile + kk * 257 + n4; tp[0] = v[0]; tp[1] = v[1]; tp[2] = v[2]; tp[3] = v[3]; }
            __syncthreads();
#pragma unroll
            for (int r = 0; r < 4; ++r) { const int e = tid + r * NTHREADS, nn = e >> 3, kc = (e & 7) * 8;
                if (n0 + nn < J.Nlen) { const float* tp = tile + kc * 257 + nn; u32x4 o;
                    o.x = pk2(tp[0], tp[257]); o.y = pk2(tp[2 * 257], tp[3 * 257]); o.z = pk2(tp[4 * 257], tp[5 * 257]); o.w = pk2(tp[6 * 257], tp[7 * 257]);
                    *(u32x4*)(J.dst + (long)(n0 + nn) * J.ldd + k0 + kc) = o; } }
            __syncthreads();
        }
    }
    const long gt = (long)bid * NTHREADS + tid, gn = (long)G * NTHREADS;
    for (long i0 = gt; i0 < 8L * PAST * 64; i0 += 4 * gn) { f32x4 v[4];
#pragma unroll
        for (int r = 0; r < 4; ++r) { const long i = i0 + r * gn; if (i < 8L * PAST * 64) v[r] = *(const f32x4*)(P->c_ckv + i * 4); }
#pragma unroll
        for (int r = 0; r < 4; ++r) { const long i = i0 + r * gn; if (i < 8L * PAST * 64) { const long row = i >> 6; const int c = (int)(i & 63) * 4; const int bb = (int)(row >> 12), sq = (int)(row & 4095);
            store_bf4(P->latent + (long)(MP + bb * SKEYS + sq) * 256 + c, v[r]); } } }
    for (long i0 = gt; i0 < 8L * PAST * 8; i0 += 4 * gn) { f32x4 v[4];
#pragma unroll
        for (int r = 0; r < 4; ++r) { const long i = i0 + r * gn; if (i < 8L * PAST * 8) v[r] = *(const f32x4*)(P->c_kr + i * 4); }
#pragma unroll
        for (int r = 0; r < 4; ++r) { const long i = i0 + r * gn; if (i < 8L * PAST * 8) { const long row = i >> 3; const int c = (int)(i & 7) * 4; const int bb = (int)(row >> 12), sq = (int)(row & 4095);
            store_bf4(P->krope + (long)(MP + bb * SKEYS + sq) * 32 + c, v[r]); } } }
    for (long i = gt; i < 8L * 512 * 8; i += gn) { const long r = i >> 3; const int c = (int)(i & 7) * 4; const u32x2 z = {0u, 0u};
        *(u32x2*)(P->vaT_s + r * SKP + SKEYS + c) = z; *(u32x2*)(P->vbT_s + r * SKP + SKEYS + c) = z; }
    for (long i = gt; i < (long)TP * 16; i += gn) { const int pos = (int)(i >> 4), fi = (int)(i & 15);
        const float inv = exp2f(-(float)fi * (13.287712379549449f / 16.0f));
        const float ang = (float)pos * inv;
        const double rev = (double)ang * 0.15915494309189535; const float fr_ = (float)(rev - floor(rev));
        P->ropeT[i * 2] = __builtin_amdgcn_cosf(fr_); P->ropeT[i * 2 + 1] = __builtin_amdgcn_sinf(fr_); }
}

DI void phase_h(KP P) {
    const int tid_ = otid(), lane = tid_ & 63, gw = obid() * 8 + (tid_ >> 6), nw = ogrid() * 8;
    for (int row = gw; row < MT; row += nw) {
        const float* xr = row < MP ? P->x_p + (long)row * DM : P->x_s + (long)(row - MP) * DM;
        const float* ad = P->ada + ada_b(row) * 6144;
        f32x4 v[4]; float s = 0.f;
#pragma unroll
        for (int i = 0; i < 4; ++i) { v[i] = *(const f32x4*)(xr + i * 256 + lane * 4); s += v[i][0] * v[i][0] + v[i][1] * v[i][1] + v[i][2] * v[i][2] + v[i][3] * v[i][3]; }
#pragma unroll
        for (int o = 1; o < 64; o <<= 1) s += __shfl_xor(s, o);
        const float rstd = rsqrtf(s * (1.0f / DM) + EPS);
#pragma unroll
        for (int i = 0; i < 4; ++i) { const int c = i * 256 + lane * 4;
            const f32x4 g = *(const f32x4*)(P->g_pre_mix + c), sh = *(const f32x4*)(ad + c), scl = *(const f32x4*)(ad + 1024 + c);
            store_bf4(P->h + (long)row * DM + c, v[i] * rstd * g * (1.0f + scl) + sh); }
    }
}

DI void phase_mid(KP P) {
    const int tid_ = otid(), lane = tid_ & 63, gw = obid() * 8 + (tid_ >> 6), nw = ogrid() * 8;
    for (int row = gw; row < MT; row += nw) {
        const float* xr = row < MP ? P->x_p + (long)row * DM : P->x_s + (long)(row - MP) * DM;
        const float* ad = P->ada + ada_b(row) * 6144;
        f32x4 mv[4]; float s = 0.f;
#pragma unroll
        for (int i = 0; i < 4; ++i) { const u32x2 wv = *(const u32x2*)(P->m2 + (long)row * DM + i * 256 + lane * 4);
            mv[i] = (f32x4){bf_lo(wv.x), bf_hi(wv.x), bf_lo(wv.y), bf_hi(wv.y)}; s += mv[i][0] * mv[i][0] + mv[i][1] * mv[i][1] + mv[i][2] * mv[i][2] + mv[i][3] * mv[i][3]; }
#pragma unroll
        for (int o = 1; o < 64; o <<= 1) s += __shfl_xor(s, o);
        const float rstd = rsqrtf(s * (1.0f / DM) + EPS);
        float s2 = 0.f;
#pragma unroll
        for (int i = 0; i < 4; ++i) { const int c = i * 256 + lane * 4;
            const f32x4 xv = *(const f32x4*)(xr + c), g = *(const f32x4*)(P->g_post_mix + c), gt = *(const f32x4*)(ad + 2048 + c);
            mv[i] = xv + gt * (mv[i] * rstd * g);
            *(f32x4*)(P->out + O_Y + (long)row * DM + c) = mv[i];
            s2 += mv[i][0] * mv[i][0] + mv[i][1] * mv[i][1] + mv[i][2] * mv[i][2] + mv[i][3] * mv[i][3]; }
#pragma unroll
        for (int o = 1; o < 64; o <<= 1) s2 += __shfl_xor(s2, o);
        const float rstd2 = rsqrtf(s2 * (1.0f / DM) + EPS);
#pragma unroll
        for (int i = 0; i < 4; ++i) { const int c = i * 256 + lane * 4;
            const f32x4 g = *(const f32x4*)(P->g_pre_ffn + c), sh = *(const f32x4*)(ad + 3072 + c), scl = *(const f32x4*)(ad + 4096 + c);
            store_bf4(P->h2 + (long)row * DM + c, mv[i] * rstd2 * g * (1.0f + scl) + sh); }
    }
}

DI void phase_final(KP P) {
    const int tid_ = otid(), lane = tid_ & 63, gw = obid() * 8 + (tid_ >> 6), nw = ogrid() * 8;
    for (int row = gw; row < MT; row += nw) {
        const float* ad = P->ada + ada_b(row) * 6144;
        f32x4 fv[4]; float s = 0.f;
#pragma unroll
        for (int i = 0; i < 4; ++i) { const u32x2 wv = *(const u32x2*)(P->f + (long)row * DM + i * 256 + lane * 4);
            fv[i] = (f32x4){bf_lo(wv.x), bf_hi(wv.x), bf_lo(wv.y), bf_hi(wv.y)}; s += fv[i][0] * fv[i][0] + fv[i][1] * fv[i][1] + fv[i][2] * fv[i][2] + fv[i][3] * fv[i][3]; }
#pragma unroll
        for (int o = 1; o < 64; o <<= 1) s += __shfl_xor(s, o);
        const float rstd = rsqrtf(s * (1.0f / DM) + EPS);
#pragma unroll
        for (int i = 0; i < 4; ++i) { const int c = i * 256 + lane * 4; float* yp = P->out + O_Y + (long)row * DM + c;
            const f32x4 xv = *(const f32x4*)yp, g = *(const f32x4*)(P->g_post_ffn + c), gt = *(const f32x4*)(ad + 5120 + c);
            *(f32x4*)yp = xv + gt * (fv[i] * rstd * g); }
    }
}

DI float gelu_tanh(float a) { const float t = 0.7978845608028654f * (a + 0.044715f * a * a * a); const float e = __expf(2.0f * t); return 0.5f * a * (2.0f - 2.0f / (1.0f + e)); }

DI void phase_conv(KP P) {
    const long gt = (long)obid() * NTHREADS + otid(), gn = (long)ogrid() * NTHREADS;
    for (long i = gt; i < (long)(MT / 8) * 352; i += gn) {
        const int rg = (int)(i / 352), c = (int)(i % 352) * 8, row0 = rg * 8;
        int t0, bs = -1; if (row0 < MP) t0 = row0 & (TP - 1); else { t0 = (row0 - MP) & 31; bs = (row0 - MP) >> 5; }
        u32x4 ua[10], ub[10];
#pragma unroll
        for (int r = 0; r < 10; ++r) { const int rr = (t0 == 0 && r < 2) ? row0 : row0 + r - 2;
            ua[r] = *(const u32x4*)(P->u + (long)rr * DFF2 + c); ub[r] = *(const u32x4*)(P->u + (long)rr * DFF2 + DFF + c); }
        float wa[3][8], wb[3][8], ba[8], bb[8];
#pragma unroll
        for (int tap = 0; tap < 3; ++tap) { const f32x4 x0 = *(const f32x4*)(P->conv_w + tap * DFF2 + c), x1 = *(const f32x4*)(P->conv_w + tap * DFF2 + c + 4);
            const f32x4 y0 = *(const f32x4*)(P->conv_w + tap * DFF2 + DFF + c), y1 = *(const f32x4*)(P->conv_w + tap * DFF2 + DFF + c + 4);
#pragma unroll
            for (int e = 0; e < 4; ++e) { wa[tap][e] = x0[e]; wa[tap][4 + e] = x1[e]; wb[tap][e] = y0[e]; wb[tap][4 + e] = y1[e]; } }
        { const f32x4 x0 = *(const f32x4*)(P->conv_b + c), x1 = *(const f32x4*)(P->conv_b + c + 4), y0 = *(const f32x4*)(P->conv_b + DFF + c), y1 = *(const f32x4*)(P->conv_b + DFF + c + 4);
#pragma unroll
          for (int e = 0; e < 4; ++e) { ba[e] = x0[e]; ba[4 + e] = x1[e]; bb[e] = y0[e]; bb[4 + e] = y1[e]; } }
        float ha[2][8], hb[2][8];
#pragma unroll
        for (int r = 0; r < 2; ++r)
#pragma unroll
            for (int e = 0; e < 4; ++e) { ha[r][2 * e] = bf_lo(ua[r][e]); ha[r][2 * e + 1] = bf_hi(ua[r][e]); hb[r][2 * e] = bf_lo(ub[r][e]); hb[r][2 * e + 1] = bf_hi(ub[r][e]); }
        if (t0 == 0) {
            if (bs >= 0) {
#pragma unroll
                for (int r = 0; r < 2; ++r) { const float* sp = P->c_conv + (long)(bs * 2 + r) * DFF2 + c;
#pragma unroll
                    for (int e = 0; e < 8; ++e) { ha[r][e] = sp[e]; hb[r][e] = sp[DFF + e]; } }
            } else {
#pragma unroll
                for (int r = 0; r < 2; ++r)
#pragma unroll
                    for (int e = 0; e < 8; ++e) { ha[r][e] = 0.f; hb[r][e] = 0.f; }
            }
        }
        float pa2[8], pa1[8], pb2[8], pb1[8];
#pragma unroll
        for (int e = 0; e < 8; ++e) { pa2[e] = ha[0][e]; pa1[e] = ha[1][e]; pb2[e] = hb[0][e]; pb1[e] = hb[1][e]; }
#pragma unroll
        for (int r = 0; r < 8; ++r) {
            float ca[8], cb[8];
#pragma unroll
            for (int e = 0; e < 4; ++e) { ca[2 * e] = bf_lo(ua[r + 2][e]); ca[2 * e + 1] = bf_hi(ua[r + 2][e]); cb[2 * e] = bf_lo(ub[r + 2][e]); cb[2 * e + 1] = bf_hi(ub[r + 2][e]); }
            u32x4 ov;
#pragma unroll
            for (int e = 0; e < 4; ++e) {
                const float ya0 = ba[2 * e] + wa[0][2 * e] * pa2[2 * e] + wa[1][2 * e] * pa1[2 * e] + wa[2][2 * e] * ca[2 * e];
                const float ya1 = ba[2 * e + 1] + wa[0][2 * e + 1] * pa2[2 * e + 1] + wa[1][2 * e + 1] * pa1[2 * e + 1] + wa[2][2 * e + 1] * ca[2 * e + 1];
                const float yb0 = bb[2 * e] + wb[0][2 * e] * pb2[2 * e] + wb[1][2 * e] * pb1[2 * e] + wb[2][2 * e] * cb[2 * e];
                const float yb1 = bb[2 * e + 1] + wb[0][2 * e + 1] * pb2[2 * e + 1] + wb[1][2 * e + 1] * pb1[2 * e + 1] + wb[2][2 * e + 1] * cb[2 * e + 1];
                ov[e] = pk2(gelu_tanh(ya0) * yb0, gelu_tanh(ya1) * yb1); }
            *(u32x4*)(P->g + (long)(row0 + r) * DFF + c) = ov;
#pragma unroll
            for (int e = 0; e < 8; ++e) { pa2[e] = pa1[e]; pa1[e] = ca[e]; pb2[e] = pb1[e]; pb1[e] = cb[e]; }
        }
    }
}

#define XB_TMO      128
#define XB_XCNT(j)  (256  + 64 * (j))
#define XB_XSUB(j)  (1280 + 64 * (j))
#define XB_XGEN(j)  (2304 + 64 * (j))
#define XB_TOP      3328
#define XB_TOPGEN   3392
#define XCD_BAR_WORDS 3456
#define XB_SPIN_CAP (1u << 18)
DI unsigned xb_ld(unsigned* p)              { return __hip_atomic_load(p, __ATOMIC_RELAXED, __HIP_MEMORY_SCOPE_AGENT); }
DI unsigned xb_add(unsigned* p, unsigned v) { return __hip_atomic_fetch_add(p, v, __ATOMIC_RELAXED, __HIP_MEMORY_SCOPE_AGENT); }
DI unsigned xb_xcc_id() { return (unsigned)__builtin_amdgcn_s_getreg((3 << 11) | 20) & 0xFu; }
#define XB_SPIN(cond, bar) do { unsigned _sp = 0; while (cond) { __builtin_amdgcn_s_sleep(1); \
    if ((++_sp & 255u) == 0u) { if (xb_ld(&(bar)[XB_TMO])) break; if (_sp > XB_SPIN_CAP) { atomicAdd(&(bar)[XB_TMO], 1u); break; } } } } while (0)
DI void xcd_barrier_complete(unsigned* bar, unsigned x, unsigned& nloc, unsigned& nx) {
    const unsigned G = gridDim.x;
    unsigned sum, cnt, mine, sp = 0u;
    for (;;) {
        sum = 0u; cnt = 0u; mine = 0u;
#pragma unroll
        for (unsigned j = 0; j < 16; ++j) { const unsigned c = xb_ld(&bar[XB_XCNT(j)]); sum += c; cnt += (c > 0u) ? 1u : 0u; mine = (j == x) ? c : mine; }
        if (sum == G) break;
        __builtin_amdgcn_s_sleep(1);
        if ((++sp & 255u) == 0u) { if (xb_ld(&bar[XB_TMO])) break; if (sp > XB_SPIN_CAP) { atomicAdd(&bar[XB_TMO], 1u); break; } }
    }
    nloc = mine > 0u ? mine : 1u; nx = cnt > 0u ? cnt : 1u;
}
DI void grid_barrier(char* lds) {
    asm volatile("s_waitcnt vmcnt(0)" ::: "memory");
    __syncthreads();
    if (threadIdx.x == 0) {
        unsigned* bar = kparams()->bar; const unsigned x = xb_xcc_id();
        volatile LAS unsigned* st = (volatile LAS unsigned*)(lds + 131072 + 2048);
        __builtin_amdgcn_s_waitcnt(0);
        unsigned nloc = st[0], nx = st[1];
        if (nloc == 0u) { xcd_barrier_complete(bar, x, nloc, nx); st[0] = nloc; st[1] = nx; }
        const unsigned old = xb_add(&bar[XB_XSUB(x)], 1u);
        const unsigned gen = old / nloc;
        if (old + 1u == (gen + 1u) * nloc) {
            __builtin_amdgcn_fence(__ATOMIC_RELEASE, "agent");
            asm volatile("s_waitcnt vmcnt(0)" ::: "memory");
            const unsigned og = xb_add(&bar[XB_TOP], 1u);
            const unsigned tg = og / nx;
            if (og + 1u == (tg + 1u) * nx) xb_add(&bar[XB_TOPGEN], 1u);
            else XB_SPIN(xb_ld(&bar[XB_TOPGEN]) == tg, bar);
            __builtin_amdgcn_fence(__ATOMIC_ACQUIRE, "agent");
            xb_add(&bar[XB_XGEN(x)], 1u);
            asm volatile("s_waitcnt vmcnt(0)" ::: "memory");
        } else {
            XB_SPIN(xb_ld(&bar[XB_XGEN(x)]) == gen, bar);
            __builtin_amdgcn_fence(__ATOMIC_ACQUIRE, "agent");
            asm volatile("s_waitcnt vmcnt(0)" ::: "memory");
        }
    }
    __syncthreads();
}

__global__ void __launch_bounds__(NTHREADS) fwd_megakernel(Params Pval) {
    extern __shared__ __attribute__((aligned(16))) char lds[];
    cg::grid_group grid = cg::this_grid();
    const int lo = kparams()->phase_lo, hi = kparams()->phase_hi;
#define PH(n) if (lo <= (n) && (n) < hi)
#define SYNC(n) if (lo <= (n) && (n) + 1 < hi) grid_barrier(lds)
    if (hi > 1000) grid.sync();
    { volatile LAS unsigned* st = (volatile LAS unsigned*)(lds + 131072 + 2048);
      if (threadIdx.x == 0) { st[0] = 0u; st[1] = 0u; }
      __syncthreads();
      if (threadIdx.x == 0) (void)xb_add(&kparams()->bar[XB_XCNT(xb_xcc_id())], 1u); }
    PH(0) phase0(kparams(), lds);
#ifdef PROBE_P0
    __syncthreads(); phase0(kparams(), lds);
#endif
#ifdef PROBE_SYNC
    for (int i = 0; i < 24; ++i) grid_barrier(lds);
#endif
    SYNC(0);
    PH(1) phase_h(kparams());
#ifdef PROBE_ROWS
    phase_h(kparams());
#endif
    SYNC(1);
    for (int ph = 2; ph <= 12; ++ph) {
        if (ph == 4) { PH(4) attn_phase(kparams(), lds, 0);
#ifdef PROBE_ATTN2
            __syncthreads(); attn_phase(kparams(), lds, 1);
#endif
            SYNC(4); continue; }
        if (ph == 8) { PH(8) phase_mid(kparams());
#ifdef PROBE_ROWS
            phase_mid(kparams());
#endif
            SYNC(8); continue; }
        if (ph == 10) { PH(10) phase_conv(kparams());
#ifdef PROBE_CONV
            phase_conv(kparams());
#endif
            SYNC(10); continue; }
        if (ph == 12) { PH(12) phase_final(kparams()); continue; }
        if (lo <= ph && ph < hi) {
            const int npass = (ph == 3 || ph == 6) ? 2 : 1;
            for (int pass = 0; pass < npass; ++pass) {
                GemmDesc d; d.C = nullptr; d.ldc = 0; d.start = 0; KP P = kparams();
                switch (ph) {
                case 2: d.A = P->h; d.lda = DM; d.Bt = P->WinT; d.ldb = DM; d.K = DM; d.nM = 65; d.nN = 9; d.epi = E_INPROJ; break;
                case 3: if (pass == 0) { d.A = P->qlat; d.lda = 384; d.Bt = P->WuqT; d.ldb = 384; d.K = 384; d.nM = 65; d.nN = 3; d.epi = E_UQ; }
                        else { d.A = P->latent; d.lda = 256; d.Bt = P->WukvT; d.ldb = 256; d.K = 256; d.nM = 193; d.nN = 4; d.epi = E_UKV; d.start = 195; } break;
                case 5: d.A = P->h; d.lda = DM; d.Bt = P->WgT; d.ldb = DM; d.K = DM; d.nM = 64; d.nN = 8; d.epi = E_GATE; break;
                case 6: d.A = P->o + pass * 512; d.lda = DM; d.Bt = pass ? P->WpbT : P->WpaT; d.ldb = 512; d.K = 512; d.nM = 64; d.nN = 4; d.epi = pass ? E_PROJB : E_PROJA; break;
                case 7: d.A = P->merged; d.lda = DM; d.Bt = P->WoutT; d.ldb = DM; d.K = DM; d.nM = 64; d.nN = 4; d.epi = E_PLAIN; d.C = P->m2; d.ldc = DM; break;
                case 9: d.A = P->h2; d.lda = DM; d.Bt = P->WupT; d.ldb = DM; d.K = DM; d.nM = 65; d.nN = 22; d.epi = E_UP; break;
                default: d.A = P->g; d.lda = DFF; d.Bt = P->WdownT; d.ldb = DFF; d.K = DFF; d.nM = 64; d.nN = 4; d.epi = E_PLAIN; d.C = P->f; d.ldc = DM; break;
                }
                gemm_run(d, lds);
#ifdef PROBE_GEMM2
                if (ph == PROBE_GEMM2 && !(ph == 6 && pass == 0)) { __syncthreads(); if (ph == 6) { GemmDesc d0 = d; d0.A = P->o; d0.Bt = P->WpaT; d0.epi = E_PROJA; gemm_run(d0, lds); } gemm_run(d, lds); }
#endif
            }
        }
        if (lo <= ph && ph < hi) {
            KP P = kparams();
            if (ph == 5) gemm_small<1, 8>(P, P->h, DM, P->WgT, DM, 2048, P->gates, 2048, lds);
            else if (ph == 6) gemm_small<2, 4>(P, P->o, DM, P->WpaT, 512, 1024, P->merged, DM, lds);
            else if (ph == 7) gemm_small<0, 8>(P, P->merged, DM, P->WoutT, DM, 1024, P->m2, DM, lds);
            else if (ph == 11) gemm_small<0, 22>(P, P->g, DFF, P->WdownT, DFF, 1024, P->f, DM, lds);
#ifdef PROBE_SMALL
            if (ph == 5) gemm_small<1, 8>(P, P->h, DM, P->WgT, DM, 2048, P->gates, 2048, lds);
            else if (ph == 6) gemm_small<2, 4>(P, P->o, DM, P->WpaT, 512, 1024, P->merged, DM, lds);
            else if (ph == 7) gemm_small<0, 8>(P, P->merged, DM, P->WoutT, DM, 1024, P->m2, DM, lds);
            else if (ph == 11) gemm_small<0, 22>(P, P->g, DFF, P->WdownT, DFF, 1024, P->f, DM, lds);
#endif
        }
        SYNC(ph);
    }
}

static size_t bump(size_t& off, size_t bytes) { size_t r = off; off += (bytes + 255) & ~(size_t)255; return r; }

extern "C" void kernel_launch(void* const* d_in, const int* in_sizes, int n_in, void* d_out, int out_size, void* d_ws, size_t ws_size, hipStream_t stream) {
    Params P; memset(&P, 0, sizeof(P));
    const float* const* in = (const float* const*)d_in;
    P.x_p = in[0]; P.x_s = in[1]; P.c_ckv = in[2]; P.c_kr = in[3]; P.c_sbk = in[4]; P.c_sbv = in[5]; P.c_conv = in[6]; P.c_p = in[7]; P.c_s = in[8];
    P.w_ada = in[9]; P.b_ada = in[10]; P.g_pre_mix = in[11]; P.g_post_mix = in[12]; P.g_pre_ffn = in[13]; P.g_post_ffn = in[14];
    const float* w_in = in[15]; const float* g_q = in[16]; const float* w_uq = in[17]; P.g_kv = in[18]; const float* w_uk = in[19]; const float* w_uv = in[20];
    const float* w_pa = in[21]; const float* w_pb = in[22]; const float* w_out = in[23]; const float* w_up = in[24]; P.conv_w = in[25]; P.conv_b = in[26]; const float* w_down = in[27];
    P.out = (float*)d_out;
    char* ws = (char*)d_ws; size_t off = 0;
    P.WupT = (bf16_t*)(ws + bump(off, (size_t)DFF2 * DM * 2));
    P.WdownT = (bf16_t*)(ws + bump(off, (size_t)DM * DFF * 2));
    P.ropeT = (float*)(ws + bump(off, (size_t)TP * 32 * 4));
    P.ada = (float*)(ws + bump(off, 10 * 6144 * 4));
    P.ctr = (unsigned*)(ws + bump(off, 256));
    P.bar = (unsigned*)(ws + bump(off, XCD_BAR_WORDS * 4));
    const size_t R0 = off;
    P.WinT = (bf16_t*)(ws + bump(off, (size_t)2304 * DM * 2));
    P.WgT = (bf16_t*)(ws + bump(off, (size_t)2048 * DM * 2));
    P.WuqT = (bf16_t*)(ws + bump(off, (size_t)768 * 384 * 2));
    P.WukvT = (bf16_t*)(ws + bump(off, (size_t)1024 * 256 * 2));
    P.WpaT = (bf16_t*)(ws + bump(off, (size_t)1024 * 512 * 2));
    P.WpbT = (bf16_t*)(ws + bump(off, (size_t)1024 * 512 * 2));
    P.WoutT = (bf16_t*)(ws + bump(off, (size_t)1024 * 1024 * 2));
    const size_t o_kva = off;
    P.kva = (bf16_t*)(ws + bump(off, (size_t)KVROWS_PAD * 512 * 2));
    P.vaT_p = (bf16_t*)(ws + bump(off, (size_t)2 * 512 * TP * 2));
    P.vaT_s = (bf16_t*)(ws + bump(off, (size_t)8 * 512 * SKP * 2));
    const size_t o_kb = off;
    P.kb = (bf16_t*)(ws + bump(off, (size_t)KVROWS_PAD * 512 * 2));
    const size_t o_vbT = off;
    P.vbT_p = (bf16_t*)(ws + bump(off, (size_t)2 * 512 * TP * 2));
    P.vbT_s = (bf16_t*)(ws + bump(off, (size_t)8 * 512 * SKP * 2));
    const size_t o_kr = off;
    P.krope = (bf16_t*)(ws + bump(off, (size_t)KVROWS_PAD * 32 * 2));
    P.qb = (bf16_t*)(ws + bump(off, (size_t)MT * 512 * 2));
    P.q = (bf16_t*)(ws + bump(off, (size_t)MT * 768 * 2));
    P.latent = (bf16_t*)(ws + bump(off, (size_t)KVROWS_PAD * 256 * 2));
    size_t need = off;
    P.gates = (bf16_t*)(ws + o_kva);
    P.merged = (bf16_t*)(ws + o_kb);
    P.m2 = (bf16_t*)(ws + o_vbT);
    P.u = (bf16_t*)(ws + R0);
    const size_t o_g = R0 + (size_t)MT * DFF2 * 2;
    P.g = (bf16_t*)(ws + o_g);
    P.f = (bf16_t*)(ws + R0);
    size_t o_h2 = o_kr > o_g ? o_kr : o_g;
    P.h2 = (bf16_t*)(ws + o_h2);
    if (o_g + (size_t)MT * DFF * 2 > need) need = o_g + (size_t)MT * DFF * 2;
    if (o_h2 + (size_t)MT * DM * 2 > need) need = o_h2 + (size_t)MT * DM * 2;
    P.h = (bf16_t*)d_out;
    P.o = (bf16_t*)d_out + (size_t)MT * DM;
    P.qlat = P.o;
    if (need > ws_size) { fprintf(stderr, "workspace too small: need %zu have %zu\n", need, ws_size); return; }

    int nj = 0, tiles = 0;
    auto job = [&](const float* src, int lds, int coff, bf16_t* dst, int ldd, int Klen, int Nlen, const float* ks, int zero) {
        TJob& J = P.tj[nj++]; J.src = src; J.kscale = ks; J.dst = dst; J.lds = lds; J.coff = coff; J.ldd = ldd; J.Klen = Klen; J.Nlen = Nlen; J.zero = zero; J.tile0 = tiles; J.pad = 0;
        tiles += (Klen / 64) * ((Nlen + 255) / 256); };
    job(w_up, DFF2, 0, P.WupT, DM, DM, DFF2, nullptr, 0);
    job(w_down, DM, 0, P.WdownT, DFF, DFF, DM, nullptr, 0);
    job(w_in, 4256, 0, P.WinT, DM, DM, 384, nullptr, 0);
    job(w_in, 4256, 640, P.WinT + (size_t)384 * DM, DM, DM, 32, nullptr, 0);
    job(w_in, 4256, 0, P.WinT + (size_t)416 * DM, DM, DM, 96, nullptr, 1);
    job(w_in, 4256, 384, P.WinT + (size_t)512 * DM, DM, DM, 256, nullptr, 0);
    job(w_in, 4256, 672, P.WinT + (size_t)768 * DM, DM, DM, 1536, nullptr, 0);
    job(w_in, 4256, 2208, P.WgT, DM, DM, 2048, nullptr, 0);
    job(w_uq, 768, 0, P.WuqT, 384, 384, 768, g_q, 0);
    job(w_uk, 512, 0, P.WukvT, 256, 256, 512, nullptr, 0);
    job(w_uv, 512, 0, P.WukvT + (size_t)512 * 256, 256, 256, 512, nullptr, 0);
    job(w_pa, DM, 0, P.WpaT, 512, 512, DM, nullptr, 0);
    job(w_pb, DM, 0, P.WpbT, 512, 512, DM, nullptr, 0);
    job(w_out, DM, 0, P.WoutT, DM, DM, DM, nullptr, 0);
    P.ntj_tiles = tiles; P.pad0 = nj;
    P.phase_lo = 0; P.phase_hi = 13;

    static int grid_blocks = 0;
    if (!grid_blocks) {
        (void)hipFuncSetAttribute((const void*)fwd_megakernel, hipFuncAttributeMaxDynamicSharedMemorySize, LDS_BYTES);
        int dev = 0, cus = 0, per_cu = 0;
        (void)hipGetDevice(&dev);
        (void)hipDeviceGetAttribute(&cus, hipDeviceAttributeMultiprocessorCount, dev);
        (void)hipOccupancyMaxActiveBlocksPerMultiprocessor(&per_cu, fwd_megakernel, NTHREADS, LDS_BYTES);
        if (per_cu > 1) per_cu = 1;
        grid_blocks = cus * per_cu;
    }
    (void)hipMemsetAsync(P.ctr, 0, 256 + XCD_BAR_WORDS * 4, stream);
    void* args[] = {&P};
    hipError_t e = hipLaunchCooperativeKernel((const void*)fwd_megakernel, dim3(grid_blocks), dim3(NTHREADS), args, LDS_BYTES, stream);
    if (e != hipSuccess) fprintf(stderr, "cooperative launch failed: %s (grid %d)\n", hipGetErrorString(e), grid_blocks);
}
```

```cpp
#include <hip/hip_runtime.h>
#include <hip/hip_cooperative_groups.h>
#include <stdint.h>
#include <stdio.h>
#include <string.h>
namespace cg = cooperative_groups;

typedef unsigned short bf16_t;
typedef short bf16x8 __attribute__((ext_vector_type(8)));
typedef short s16x4 __attribute__((ext_vector_type(4)));
typedef float f32x2 __attribute__((ext_vector_type(2)));
typedef float f32x4 __attribute__((ext_vector_type(4)));
typedef float f32x16 __attribute__((ext_vector_type(16)));
typedef unsigned u32x2 __attribute__((ext_vector_type(2)));
typedef unsigned u32x4 __attribute__((ext_vector_type(4)));
typedef __bf16 bf2_t __attribute__((ext_vector_type(2)));
#define DI __device__ __forceinline__

constexpr int DM = 1024, TP = 8192, MP = 16384, MS = 256, MT = 16640, PAST = 4096, SKEYS = 4128, SKP = 4160;
constexpr int KVROWS = MP + 8 * SKEYS;
constexpr int KVROWS_PAD = KVROWS + 64;
constexpr int DFF = 2816, DFF2 = 5632;
constexpr float EPS = 1e-6f;
constexpr float LOG2E = 1.4426950408889634f, LN2 = 0.6931471805599453f;
constexpr int NTHREADS = 512;
constexpr int LDS_BYTES = 131072 + 8192;
constexpr long O_Y = 0, O_CKV_P = 17039360, O_KR_P = 21233664, O_SBK_P = 21757952, O_SBV_P = 30146560, O_CONV_P = 38535168,
               O_CKV_S = 38557696, O_KR_S = 38623232, O_SBK_S = 38631424, O_SBV_S = 38762496, O_CONV_S = 38893568;

struct TJob { const float* src; const float* kscale; bf16_t* dst; int lds, coff, ldd, Klen, Nlen, zero, tile0, pad; };
constexpr int NTJ = 22;

struct Params {
    const float *x_p, *x_s, *c_ckv, *c_kr, *c_sbk, *c_sbv, *c_conv, *c_p, *c_s;
    const float *w_ada, *b_ada, *g_pre_mix, *g_post_mix, *g_pre_ffn, *g_post_ffn, *g_kv, *conv_w, *conv_b;
    float* out;
    bf16_t *WupT, *WdownT, *WinT, *WgT, *WuqT, *WukvT, *WpaT, *WpbT, *WoutT;
    float* ropeT; float* ada; unsigned* ctr; unsigned* bar;
    bf16_t *h, *o, *qlat, *latent, *krope, *kb, *vbT_p, *vbT_s, *qb, *q, *kva, *vaT_p, *vaT_s, *gates, *merged, *m2, *h2, *u, *g, *f;
    TJob tj[NTJ]; int ntj_tiles; int phase_lo, phase_hi, pad0;
};

#define LAS __attribute__((address_space(3)))
typedef const Params __attribute__((address_space(4))) * KP;
DI KP kparams() { KP p = (KP)__builtin_amdgcn_kernarg_segment_ptr(); asm volatile("" : "+s"(p)); return p; }
DI int otid() { int t = threadIdx.x; asm volatile("" : "+v"(t)); return t; }
DI int obid() { int b = blockIdx.x; asm volatile("" : "+s"(b)); return b; }
DI int ogrid() { int g = gridDim.x; asm volatile("" : "+s"(g)); return g; }
DI unsigned pk2(float a, float b) { f32x2 f = {a, b}; bf2_t r = __builtin_convertvector(f, bf2_t); return __builtin_bit_cast(unsigned, r); }
DI float bf_lo(unsigned u) { return __uint_as_float(u << 16); }
DI float bf_hi(unsigned u) { return __uint_as_float(u & 0xffff0000u); }
DI int kvrow_of(int row) { if (row < MP) return row; const int r = row - MP; return MP + (r >> 5) * SKEYS + PAST + (r & 31); }
DI int pos_of(int row) { return row < MP ? (row & (TP - 1)) : PAST + ((row - MP) & 31); }
DI int ada_b(int row) { return row < MP ? (row >> 13) : 2 + ((row - MP) >> 5); }
DI float sigmoidf_(float x) { return 1.0f / (1.0f + __expf(-x)); }

constexpr int BM = 256, BK = 64, HALF = 128, HT = HALF * BK;
DI int lds_byte(int r, int c) { int st = (r >> 4) * 2 + (c >> 5), rr = r & 15, cc = c & 31, ob = rr * 64 + cc * 2; return st * 1024 + (ob ^ (((ob >> 9) & 1) << 5)); }
DI void stage_rc(int b, int& R, int& C) { int st = b / 1024, sb = b % 1024, swz = sb ^ (((sb >> 9) & 1) << 5); R = (st >> 1) * 16 + swz / 64; C = (st & 1) * 32 + (swz % 64) / 2; }

enum { E_INPROJ = 0, E_GATE, E_UQ, E_UKV, E_PROJA, E_PROJB, E_PLAIN, E_UP };
struct GemmDesc { const bf16_t* A; const bf16_t* Bt; bf16_t* C; int lda, ldb, ldc, K, nM, nN, epi, start; };

constexpr int HTB = HT * 2;
#define SA(b, h) (((b) * 2 + (h)) * HTB)
#define SB(b, h) ((4 + (b) * 2 + (h)) * HTB)
#define STAGE(bufoff, gbase, voff) do { _Pragma("unroll") for (int _i = 0; _i < 2; ++_i) \
    __builtin_amdgcn_global_load_lds((const unsigned*)((const char*)(gbase) + (voff)[_i]), (LAS unsigned*)(ldsl + (bufoff) + ldsw + _i * 8192), 16, 0, 0); } while (0)
#define LDA(dst, b, h) do { _Pragma("unroll") for (int m = 0; m < 4; ++m) _Pragma("unroll") for (int k = 0; k < 2; ++k) dst[m][k] = *(const LAS bf16x8*)(ldsl + SA(b, h) + aoff + m * 2048 + k * 1024); } while (0)
#define LDB(dst, b, h) do { _Pragma("unroll") for (int n = 0; n < 2; ++n) _Pragma("unroll") for (int k = 0; k < 2; ++k) dst[n][k] = *(const LAS bf16x8*)(ldsl + SB(b, h) + boff + n * 2048 + k * 1024); } while (0)
#define MMA(ai, bj, At, Bt_) do { __builtin_amdgcn_s_setprio(1); _Pragma("unroll") for (int m = 0; m < 4; ++m) _Pragma("unroll") for (int n = 0; n < 2; ++n) _Pragma("unroll") for (int k = 0; k < 2; ++k) \
      acc[ai][bj][m][n] = __builtin_amdgcn_mfma_f32_16x16x32_bf16(Bt_[n][k], At[m][k], acc[ai][bj][m][n], 0, 0, 0); \
    __builtin_amdgcn_s_setprio(0); } while (0)
#define WAIT_V(n) asm volatile("s_waitcnt vmcnt(" #n ")" ::: "memory")
#define WAIT_L(n) asm volatile("s_waitcnt lgkmcnt(" #n ")" ::: "memory")
#define BAR __builtin_amdgcn_s_barrier()
#define SCHED __builtin_amdgcn_sched_barrier(0)
#define ZERO_ACC do { _Pragma("unroll") for (int a_ = 0; a_ < 2; ++a_) _Pragma("unroll") for (int b_ = 0; b_ < 2; ++b_) _Pragma("unroll") for (int m_ = 0; m_ < 4; ++m_) _Pragma("unroll") for (int n_ = 0; n_ < 2; ++n_) \
    acc[a_][b_][m_][n_] = (f32x4){0.f, 0.f, 0.f, 0.f}; } while (0)

#define EPI_ROWS for (int ai = 0; ai < 2; ++ai) for (int m = 0; m < 4; ++m, ({ asm volatile("" ::: "memory"); }))
#define EPI_COLS for (int bj = 0; bj < 2; ++bj) for (int n = 0; n < 2; ++n)

DI void store_bf4(bf16_t* p, f32x4 v) { u32x2 w; w.x = pk2(v[0], v[1]); w.y = pk2(v[2], v[3]); *(u32x2*)p = w; }

DI void gemm_run(const GemmDesc& d, char* lds) {
    LAS char* ldsl = (LAS char*)lds;
    float* xl = (float*)(lds + 131072);
    float* xp = (float*)(lds + 131072 + 4096);
    const int G = ogrid(), nun = d.nM * d.nN, first = (int)((obid() + G - (d.start % G)) % G);
    if (first >= nun) return;
    const int tid = otid(), wid = __builtin_amdgcn_readfirstlane(tid >> 6), wr = wid >> 2, wc = wid & 3;
    const unsigned lda2 = (unsigned)d.lda * 2u, ldb2 = (unsigned)d.ldb * 2u;
    unsigned voffA[2], voffB[2];
    { const int lane = tid & 63;
#pragma unroll
      for (int i = 0; i < 2; ++i) { int R, C; stage_rc(tid * 16 + i * 8192, R, C); voffA[i] = (unsigned)R * lda2 + (unsigned)C * 2u; voffB[i] = (unsigned)R * ldb2 + (unsigned)C * 2u; }
      (void)lane; }
    const size_t kstep = 128, hA = (size_t)HALF * lda2, hB = (size_t)HALF * ldb2;
    const unsigned ldsw = (unsigned)wid * 1024u;
    const int aoff = lds_byte(wr * 64 + (tid & 15), ((tid & 63) >> 4) * 8), boff = lds_byte(wc * 32 + (tid & 15), ((tid & 63) >> 4) * 8);
    const int nt = d.K / BK;
    int u = first;
    const char* cA = (const char*)d.A + (size_t)(u / d.nN) * 2 * hA; const char* cB = (const char*)d.Bt + (size_t)(u % d.nN) * 2 * hB;
    f32x4 acc[2][2][4][2];
    ZERO_ACC;
    bf16x8 At[4][2], B0[2][2], B1[2][2];
    STAGE(SB(0, 0), cB, voffB); STAGE(SA(0, 0), cA, voffA); STAGE(SB(0, 1), cB + hB, voffB); STAGE(SA(0, 1), cA + hA, voffA);
    if (wr == 1) BAR;
    WAIT_V(4); BAR;
    STAGE(SB(1, 0), cB + kstep, voffB); STAGE(SA(1, 0), cA + kstep, voffA); STAGE(SB(1, 1), cB + hB + kstep, voffB);
    WAIT_V(6); BAR;
    for (;;) {
        const int un = u + G; const bool has_next = un < nun;
        const char* nA = has_next ? (const char*)d.A + (size_t)(un / d.nN) * 2 * hA : cA; const char* nB = has_next ? (const char*)d.Bt + (size_t)(un % d.nN) * 2 * hB : cB;
        for (int t = 0; t < nt; t += 2) {
            const bool last = (t == nt - 2);
            const char* a1 = cA + (size_t)(t + 1) * kstep;
            const char* a2 = last ? nA : cA + (size_t)(t + 2) * kstep; const char* b2 = last ? nB : cB + (size_t)(t + 2) * kstep;
            const char* a3 = a2 + kstep; const char* b3 = b2 + kstep;
            LDB(B0, 0, 0); SCHED; LDA(At, 0, 0); STAGE(SA(1, 1), a1 + hA, voffA);
            WAIT_L(8); BAR; WAIT_L(0); MMA(0, 0, At, B0); BAR; SCHED;
            LDB(B1, 0, 1); STAGE(SB(0, 0), b2, voffB);
            BAR; WAIT_L(0); MMA(0, 1, At, B1); BAR;
            LDA(At, 0, 1); STAGE(SA(0, 0), a2, voffA);
            BAR; WAIT_L(0); MMA(1, 0, At, B0); BAR; SCHED;
            STAGE(SB(0, 1), b2 + hB, voffB);
            WAIT_V(6); BAR; MMA(1, 1, At, B1); BAR;
            LDB(B0, 1, 0); SCHED; LDA(At, 1, 0); STAGE(SA(0, 1), a2 + hA, voffA);
            WAIT_L(8); BAR; WAIT_L(0); MMA(0, 0, At, B0); BAR; SCHED;
            LDB(B1, 1, 1); STAGE(SB(1, 0), b3, voffB);
            BAR; WAIT_L(0); MMA(0, 1, At, B1); BAR;
            LDA(At, 1, 1); STAGE(SA(1, 0), a3, voffA);
            BAR; WAIT_L(0); MMA(1, 0, At, B0); BAR; SCHED;
            STAGE(SB(1, 1), b3 + hB, voffB);
            WAIT_V(6); BAR; MMA(1, 1, At, B1); BAR;
        }
        if (wr == 0) BAR;
        {
        const int pm = u / d.nN, pn = u % d.nN, brow = pm * BM, bcol = pn * BM;
        if (d.epi == E_UQ) {
            const int tq_ = otid(), r = tq_ >> 1, hf = tq_ & 1;
            const u32x4* src = (const u32x4*)(d.A + (long)(brow + r) * 384 + hf * 192);
            float sq = 0.f;
#pragma unroll 4
            for (int i = 0; i < 24; ++i) { u32x4 v = src[i];
                for (int e = 0; e < 4; ++e) { float a_ = bf_lo(v[e]), b_ = bf_hi(v[e]); sq += a_ * a_ + b_ * b_; } }
            sq += __shfl_xor(sq, 1);
            if (hf == 0) xl[r] = rsqrtf(sq * (1.0f / 384.0f) + EPS);
            WAIT_L(0); BAR; asm volatile("" ::: "memory");
        }
        int lane_e = threadIdx.x & 63; asm volatile("" : "+v"(lane_e));
        const int fr = lane_e & 15, fq = lane_e >> 4;
        KP P = kparams();
        const int rbase = brow + wr * 64 + fr, cbase = bcol + wc * 32 + fq * 4;
        switch (d.epi) {
        case E_INPROJ: {
            if (pn == 0) {
#pragma unroll
                EPI_ROWS { const int row = rbase + ai * 128 + m * 16;
#pragma unroll
                    EPI_COLS store_bf4(P->qlat + (long)row * 384 + (cbase + bj * 128 + n * 16), acc[ai][bj][m][n]); }
            } else if (pn == 1) {
#pragma unroll
                EPI_ROWS { const int row = rbase + ai * 128 + m * 16;
#pragma unroll
                    for (int n = 0; n < 2; ++n) store_bf4(P->qlat + (long)row * 384 + 256 + (wc * 32 + fq * 4 + n * 16), acc[ai][0][m][n]);
                    if (wc == 0) {
                        const int pos = pos_of(row);
                        const f32x4 cs0 = *(const f32x4*)(P->ropeT + (long)pos * 32 + fq * 8), cs1 = *(const f32x4*)(P->ropeT + (long)pos * 32 + fq * 8 + 4);
                        const f32x4 x1 = acc[ai][1][m][0], x2 = acc[ai][1][m][1];
                        f32x4 co = {cs0[0], cs0[2], cs1[0], cs1[2]}, si = {cs0[1], cs0[3], cs1[1], cs1[3]};
                        f32x4 o1 = x1 * co - x2 * si, o2 = x2 * co + x1 * si;
                        float* of = P->out + (row < MP ? O_KR_P + (long)row * 32 : O_KR_S + (long)(row - MP) * 32);
                        *(f32x4*)(of + fq * 4) = o1; *(f32x4*)(of + 16 + fq * 4) = o2;
                        bf16_t* ob = P->krope + (long)kvrow_of(row) * 32;
                        store_bf4(ob + fq * 4, o1); store_bf4(ob + 16 + fq * 4, o2);
                    } }
            } else if (pn == 2) {
                float ss[2][4];
#pragma unroll
                EPI_ROWS { float s = 0.f;
#pragma unroll
                    EPI_COLS { const f32x4 v = acc[ai][bj][m][n]; s += v[0] * v[0] + v[1] * v[1] + v[2] * v[2] + v[3] * v[3]; }
                    s += __shfl_xor(s, 16); s += __shfl_xor(s, 32); ss[ai][m] = s;
                    if (fq == 0) xp[(ai * 128 + wr * 64 + m * 16 + fr) * 4 + wc] = s; }
                WAIT_L(0); BAR; asm volatile("" ::: "memory");
#pragma unroll
                EPI_ROWS { const int rl = ai * 128 + wr * 64 + m * 16 + fr, row = brow + rl;
                    const f32x4 pp = *(const f32x4*)(xp + rl * 4);
                    const float rstd = rsqrtf((pp[0] + pp[1] + pp[2] + pp[3]) * (1.0f / 256.0f) + EPS);
                    float* of = P->out + (row < MP ? O_CKV_P + (long)row * 256 : O_CKV_S + (long)(row - MP) * 256);
                    bf16_t* ob = P->latent + (long)kvrow_of(row) * 256;
#pragma unroll
                    EPI_COLS { const int c = wc * 32 + fq * 4 + bj * 128 + n * 16;
                        const f32x4 gv = *(const f32x4*)(P->g_kv + c); const f32x4 o = acc[ai][bj][m][n] * rstd * gv;
                        *(f32x4*)(of + c) = o; store_bf4(ob + c, o); } }
            } else if (pn <= 4) {
#pragma unroll
                EPI_ROWS { const int row = rbase + ai * 128 + m * 16;
#pragma unroll
                    EPI_COLS store_bf4(P->qb + (long)row * 512 + (cbase - 768 + bj * 128 + n * 16), acc[ai][bj][m][n] * 0.125f); }
            } else if (pn <= 6) {
#pragma unroll
                EPI_ROWS { const int row = rbase + ai * 128 + m * 16;
                    float* of = P->out + (row < MP ? O_SBK_P + (long)row * 512 : O_SBK_S + (long)(row - MP) * 512);
                    bf16_t* ob = P->kb + (long)kvrow_of(row) * 512;
#pragma unroll
                    EPI_COLS { const int c = cbase - 1280 + bj * 128 + n * 16; *(f32x4*)(of + c) = acc[ai][bj][m][n]; store_bf4(ob + c, acc[ai][bj][m][n]); } }
            } else {
#pragma unroll
                EPI_ROWS { const int row = rbase + ai * 128 + m * 16;
                    float* of = P->out + (row < MP ? O_SBV_P + (long)row * 512 : O_SBV_S + (long)(row - MP) * 512);
                    bf16_t* vt; int ldv;
                    if (row < MP) { vt = P->vbT_p + (long)(row >> 13) * 512 * TP + (row & (TP - 1)); ldv = TP; }
                    else { const int r = row - MP; vt = P->vbT_s + (long)(r >> 5) * 512 * SKP + PAST + (r & 31); ldv = SKP; }
#pragma unroll
                    EPI_COLS { const int c = cbase - 1792 + bj * 128 + n * 16; const f32x4 v = acc[ai][bj][m][n]; *(f32x4*)(of + c) = v;
                        const unsigned w0 = pk2(v[0], v[1]), w1 = pk2(v[2], v[3]);
                        vt[(long)(c + 0) * ldv] = (bf16_t)(w0 & 0xffff); vt[(long)(c + 1) * ldv] = (bf16_t)(w0 >> 16);
                        vt[(long)(c + 2) * ldv] = (bf16_t)(w1 & 0xffff); vt[(long)(c + 3) * ldv] = (bf16_t)(w1 >> 16); } }
            }
        } break;
        case E_GATE: {
#pragma unroll
            EPI_ROWS { const int row = rbase + ai * 128 + m * 16;
#pragma unroll
                EPI_COLS { const f32x4 v = acc[ai][bj][m][n]; f32x4 s = {sigmoidf_(v[0]), sigmoidf_(v[1]), sigmoidf_(v[2]), sigmoidf_(v[3])};
                    store_bf4(P->gates + (long)row * 2048 + (cbase + bj * 128 + n * 16), s); } }
        } break;
        case E_UQ: {
            const float qs = 0.10206207261596577f * LOG2E;
#pragma unroll
            EPI_ROWS { const int rl = ai * 128 + wr * 64 + m * 16 + fr, row = brow + rl; const float rs = xl[rl] * qs;
#pragma unroll
                for (int bj = 0; bj < 2; ++bj) { const int grp = pn * 8 + bj * 4 + wc; bf16_t* dst = P->q + (long)row * 768 + grp * 32 + fq * 4;
                    f32x4 v0 = acc[ai][bj][m][0] * rs, v1 = acc[ai][bj][m][1] * rs;
                    if (grp % 3 == 2) {
                        const int pos = pos_of(row);
                        const f32x4 cs0 = *(const f32x4*)(P->ropeT + (long)pos * 32 + fq * 8), cs1 = *(const f32x4*)(P->ropeT + (long)pos * 32 + fq * 8 + 4);
                        f32x4 co = {cs0[0], cs0[2], cs1[0], cs1[2]}, si = {cs0[1], cs0[3], cs1[1], cs1[3]};
                        const f32x4 o1 = v0 * co - v1 * si, o2 = v1 * co + v0 * si; v0 = o1; v1 = o2;
                    }
                    store_bf4(dst, v0); store_bf4(dst + 16, v1); } }
        } break;
        case E_UKV: {
#pragma unroll
            EPI_ROWS { const int row = rbase + ai * 128 + m * 16;
                if (pn < 2) {
#pragma unroll
                    EPI_COLS store_bf4(P->kva + (long)row * 512 + (cbase + bj * 128 + n * 16), acc[ai][bj][m][n]);
                } else {
                    bf16_t* vt; int ldv;
                    if (row < MP) { vt = P->vaT_p + (long)(row >> 13) * 512 * TP + (row & (TP - 1)); ldv = TP; }
                    else { const int r = row - MP, b = r / SKEYS; vt = P->vaT_s + (long)b * 512 * SKP + (r - b * SKEYS); ldv = SKP; }
                    if (row < KVROWS) {
#pragma unroll
                        EPI_COLS { const int c = cbase - 512 + bj * 128 + n * 16; const f32x4 v = acc[ai][bj][m][n];
                            const unsigned w0 = pk2(v[0], v[1]), w1 = pk2(v[2], v[3]);
                            vt[(long)(c + 0) * ldv] = (bf16_t)(w0 & 0xffff); vt[(long)(c + 1) * ldv] = (bf16_t)(w0 >> 16);
                            vt[(long)(c + 2) * ldv] = (bf16_t)(w1 & 0xffff); vt[(long)(c + 3) * ldv] = (bf16_t)(w1 >> 16); }
                    }
                } }
        } break;
        case E_PROJA: case E_PROJB: {
            const int goff = d.epi == E_PROJA ? 0 : 1024;
#pragma unroll
            EPI_ROWS { const int row = rbase + ai * 128 + m * 16;
#pragma unroll
                EPI_COLS { const int c = cbase + bj * 128 + n * 16; const u32x2 gw = *(const u32x2*)(P->gates + (long)row * 2048 + goff + c);
                    f32x4 gv = {bf_lo(gw.x), bf_hi(gw.x), bf_lo(gw.y), bf_hi(gw.y)}; f32x4 v = acc[ai][bj][m][n] * gv;
                    bf16_t* dst = P->merged + (long)row * 1024 + c;
                    if (d.epi == E_PROJB) { const u32x2 pw = *(const u32x2*)dst; f32x4 pv = {bf_lo(pw.x), bf_hi(pw.x), bf_lo(pw.y), bf_hi(pw.y)}; v += pv; }
                    store_bf4(dst, v); } }
        } break;
        case E_PLAIN: {
#pragma unroll
            EPI_ROWS { const int row = rbase + ai * 128 + m * 16;
#pragma unroll
                EPI_COLS store_bf4(d.C + (long)row * d.ldc + (cbase + bj * 128 + n * 16), acc[ai][bj][m][n]); }
        } break;
        case E_UP: {
#pragma unroll
            EPI_ROWS { const int row = rbase + ai * 128 + m * 16;
                float* cf = nullptr;
                if (row < MP) { const int t = row & (TP - 1); if (t >= TP - 2) cf = P->out + O_CONV_P + (long)((row >> 13) * 2 + (t - (TP - 2))) * DFF2; }
                else { const int r = row - MP, t = r & 31; if (t >= 30) cf = P->out + O_CONV_S + (long)((r >> 5) * 2 + (t - 30)) * DFF2; }
#pragma unroll
                EPI_COLS { const int c = cbase + bj * 128 + n * 16; store_bf4(P->u + (long)row * DFF2 + c, acc[ai][bj][m][n]);
                    if (cf) *(f32x4*)(cf + c) = acc[ai][bj][m][n]; } }
        } break;
        }
        }
        if (!has_next) break;
        ZERO_ACC;
        u = un; cA = nA; cB = nB;
        if (wr == 1) BAR;
    }
    WAIT_V(0);
    BAR;
}

#define MFMA32(a, b, c) __builtin_amdgcn_mfma_f32_32x32x16_bf16((a), (b), (c), 0, 0, 0)
template <int KIND, int KSTEPS  >
DI void gemm_small(KP P, const bf16_t* A, int lda, const bf16_t* Bt, int ldb, int N, bf16_t* C, int ldc, char* lds) {
    const int tid = otid(), lane = tid & 63, w = tid >> 6, r = lane & 31, hh = lane >> 5, G = ogrid();
    const int ntask = 8 * (N >> 5);
    float* part = (float*)lds;
    for (int task = obid(); task < ntask; task += G) {
        const int rb = task & 7, cb = task >> 3, row0 = MP + rb * 32, col0 = cb * 32;
#pragma unroll
        for (int pass = 0; pass < (KIND == 2 ? 2 : 1); ++pass) {
            const bf16_t* ap = A + pass * 512 + (long)(row0 + r) * lda + w * (KSTEPS * 16) + 8 * hh;
            const bf16_t* bp = (pass ? P->WpbT : Bt) + (long)(col0 + r) * ldb + w * (KSTEPS * 16) + 8 * hh;
            f32x16 acc;
#pragma unroll
            for (int i = 0; i < 16; ++i) acc[i] = 0.f;
            constexpr int UN = KSTEPS > 11 ? 11 : KSTEPS;
#pragma unroll 1
            for (int s0 = 0; s0 < KSTEPS; s0 += UN) {
                bf16x8 af[UN], bf[UN];
#pragma unroll
                for (int s = 0; s < UN; ++s) { af[s] = *(const bf16x8*)(ap + (s0 + s) * 16); bf[s] = *(const bf16x8*)(bp + (s0 + s) * 16); }
#pragma unroll
                for (int s = 0; s < UN; ++s) acc = MFMA32(bf[s], af[s], acc);
            }
            float* pp = part + ((pass * 8 + w) * 32 + r) * 32 + 4 * hh;
#pragma unroll
            for (int g = 0; g < 4; ++g) *(f32x4*)(pp + 8 * g) = (f32x4){acc[4 * g], acc[4 * g + 1], acc[4 * g + 2], acc[4 * g + 3]};
        }
        __syncthreads();
        {
            const int e = tid * 2, rr = e >> 5, cc = e & 31;
            f32x2 s1 = {0.f, 0.f}, s2 = {0.f, 0.f};
#pragma unroll
            for (int ww = 0; ww < 8; ++ww) { s1 += *(const f32x2*)(part + (ww * 32 + rr) * 32 + cc); if (KIND == 2) s2 += *(const f32x2*)(part + ((8 + ww) * 32 + rr) * 32 + cc); }
            const long row = row0 + rr; const int col = col0 + cc;
            if (KIND == 1) { s1[0] = sigmoidf_(s1[0]); s1[1] = sigmoidf_(s1[1]); }
            if (KIND == 2) { const unsigned ga = *(const unsigned*)(P->gates + row * 2048 + col), gb = *(const unsigned*)(P->gates + row * 2048 + 1024 + col);
                s1[0] = s1[0] * bf_lo(ga) + s2[0] * bf_lo(gb); s1[1] = s1[1] * bf_hi(ga) + s2[1] * bf_hi(gb); }
            *(unsigned*)(C + row * ldc + col) = pk2(s1[0], s1[1]);
        }
        __syncthreads();
    }
}

DI int crow(int i, int h) { return (i & 3) + 8 * (i >> 2) + 4 * h; }

template <int MODE>
DI void attn_unit(KP P, char* lds, bool sample, int b, int h, int ublk) {
    constexpr int DQK = MODE == 0 ? 96 : 64, KS = DQK * 2 + 16, VS = 144, NS = DQK / 16;
    constexpr int KBYTES = 64 * KS, BUF = KBYTES + 64 * VS;
    const int tid = otid(), w = tid >> 6, lane = tid & 63, ql = lane & 31, hh = lane >> 5;
    const int kvrow0 = sample ? MP + b * SKEYS : b * TP;
    const int qrow0 = sample ? MP + b * 32 : b * TP + ublk * 256;
    const int ntiles = sample ? 65 : 4 * (ublk + 1);
    const int t0 = sample ? 0 : ublk * 256 + w * 32, tq = t0 + ql;
    int klim, wmax, wmin;
    if (MODE == 0) { if (sample) { klim = wmax = wmin = SKEYS; } else { klim = ((tq >> 6) + 1) << 6; wmax = (((t0 + 31) >> 6) + 1) << 6; wmin = ((t0 >> 6) + 1) << 6; } }
    else { if (sample) { klim = PAST + tq; wmax = PAST + 31; wmin = PAST; } else { klim = tq; wmax = t0 + 31; wmin = t0; } }
    const bool wactive = sample ? (w == 0) : true;
    const bf16_t* Kp; const bf16_t* Qp; const bf16_t* VT; int ldq; long ldv;
    if (MODE == 0) { Kp = P->kva + (long)kvrow0 * 512 + h * 64; Qp = P->q + (long)qrow0 * 768 + h * 96; ldq = 768;
        VT = sample ? P->vaT_s + (long)(b * 512 + h * 64) * SKP : P->vaT_p + (long)(b * 512 + h * 64) * TP; }
    else { Kp = P->kb + (long)kvrow0 * 512 + h * 64; Qp = P->qb + (long)qrow0 * 512 + h * 64; ldq = 512;
        VT = sample ? P->vbT_s + (long)(b * 512 + h * 64) * SKP : P->vbT_p + (long)(b * 512 + h * 64) * TP; }
    ldv = sample ? SKP : TP;
    const bf16_t* Kr = P->krope + (long)kvrow0 * 32;

    bf16x8 qf[NS];
    if (wactive) {
        const bf16_t* qp = Qp + (long)(w * 32 + ql) * ldq + 8 * hh;
#pragma unroll
        for (int s = 0; s < NS; ++s) qf[s] = *(const bf16x8*)(qp + 16 * s);
    } else {
#pragma unroll
        for (int s = 0; s < NS; ++s) qf[s] = (bf16x8){0, 0, 0, 0, 0, 0, 0, 0};
    }
    f32x16 O0, O1;
#pragma unroll
    for (int i = 0; i < 16; ++i) { O0[i] = 0.f; O1[i] = 0.f; }
    float mrun = -INFINITY, lrun = 0.f, carry = 0.f;
    bool wdone = !wactive;
    volatile int* flags = (volatile int*)(lds + 65536 + 64);

    u32x4 rk0, rk1, rv;
    const int krow_s = tid >> 3, kc_s = tid & 7, rrow_s = tid >> 2, rc_s = tid & 3;
    const bool f32path = (MODE == 1) && sample;
    const float* Kf = P->c_sbk + ((long)b * PAST * 512 + h * 64); const float* Vf = P->c_sbv + ((long)b * PAST * 512 + h * 64);
    auto load_tile = [&](int kt) {
        if (f32path && kt < 64) {
            const float* kp_ = Kf + (long)(kt * 64 + krow_s) * 512 + kc_s * 8; const float* vp_ = Vf + (long)(kt * 64 + krow_s) * 512 + kc_s * 8;
            const f32x4 a0 = *(const f32x4*)kp_, a1 = *(const f32x4*)(kp_ + 4), c0 = *(const f32x4*)vp_, c1 = *(const f32x4*)(vp_ + 4);
            rk0.x = pk2(a0[0], a0[1]); rk0.y = pk2(a0[2], a0[3]); rk0.z = pk2(a1[0], a1[1]); rk0.w = pk2(a1[2], a1[3]);
            rv.x = pk2(c0[0], c0[1]); rv.y = pk2(c0[2], c0[3]); rv.z = pk2(c1[0], c1[1]); rv.w = pk2(c1[2], c1[3]);
            return;
        }
        rk0 = *(const u32x4*)(Kp + (long)(kt * 64 + krow_s) * 512 + kc_s * 8);
        if (MODE == 0 && tid < 256) rk1 = *(const u32x4*)(Kr + (long)(kt * 64 + rrow_s) * 32 + rc_s * 8);
        rv = *(const u32x4*)(VT + (long)krow_s * ldv + kt * 64 + kc_s * 8);
    };
    auto store_tile = [&](int buf, int kt) {
        char* kb_ = lds + buf * BUF; char* vb_ = kb_ + KBYTES;
        *(u32x4*)(kb_ + krow_s * KS + kc_s * 16) = rk0;
        if (f32path && kt < 64) {
#pragma unroll
            for (int e = 0; e < 4; ++e) { *(bf16_t*)(vb_ + (kc_s * 8 + 2 * e) * VS + krow_s * 2) = (bf16_t)(rv[e] & 0xffff); *(bf16_t*)(vb_ + (kc_s * 8 + 2 * e + 1) * VS + krow_s * 2) = (bf16_t)(rv[e] >> 16); }
            return;
        }
        if (MODE == 0 && tid < 256) *(u32x4*)(kb_ + rrow_s * KS + 128 + rc_s * 16) = rk1;
        *(u32x4*)(vb_ + krow_s * VS + kc_s * 16) = rv;
    };
    load_tile(ntiles - 1); store_tile(0, ntiles - 1);
    __syncthreads();
    for (int it = 0; it < ntiles; ++it) {
        const int kt = ntiles - 1 - it, cur = it & 1;
        if (it + 1 < ntiles) load_tile(kt - 1);
        if (wactive && !wdone && kt * 64 < wmax) {
            const char* kb_ = lds + cur * BUF; const char* vb_ = kb_ + KBYTES;
            f32x16 S0, S1;
#pragma unroll
            for (int i = 0; i < 16; ++i) { S0[i] = 0.f; S1[i] = 0.f; }
#pragma unroll
            for (int s = 0; s < NS; ++s) {
                const bf16x8 k0 = *(const bf16x8*)(kb_ + ql * KS + (16 * s + 8 * hh) * 2);
                const bf16x8 k1 = *(const bf16x8*)(kb_ + (32 + ql) * KS + (16 * s + 8 * hh) * 2);
                S0 = MFMA32(k0, qf[s], S0); S1 = MFMA32(k1, qf[s], S1);
            }
            const bool need_mask = (kt * 64 + 64 > wmin);
            const int kbase = kt * 64 + 4 * hh;
            if (MODE == 0) {
                if (need_mask) {
#pragma unroll
                    for (int i = 0; i < 16; ++i) { const int key = kbase + (i & 3) + 8 * (i >> 2);
                        if (key >= klim) S0[i] = -INFINITY; if (key + 32 >= klim) S1[i] = -INFINITY; }
                }
                float mx = S0[0];
#pragma unroll
                for (int i = 1; i < 16; ++i) mx = fmaxf(mx, S0[i]);
#pragma unroll
                for (int i = 0; i < 16; ++i) mx = fmaxf(mx, S1[i]);
                mx = fmaxf(mx, __shfl_xor(mx, 32));
                const float mnew = fmaxf(mrun, mx);
                const float alpha = __builtin_amdgcn_exp2f(mrun - mnew);
                mrun = mnew;
                float ps = 0.f;
#pragma unroll
                for (int i = 0; i < 16; ++i) { S0[i] = __builtin_amdgcn_exp2f(S0[i] - mnew); S1[i] = __builtin_amdgcn_exp2f(S1[i] - mnew); ps += S0[i] + S1[i]; }
                lrun = lrun * alpha + ps;
#pragma unroll
                for (int i = 0; i < 16; ++i) { O0[i] *= alpha; O1[i] *= alpha; }
            } else {
                float gs[2][4], gp[2][4];
                f32x16 SP0, SP1;
#pragma unroll
                for (int i = 0; i < 16; ++i) { const int key = kbase + (i & 3) + 8 * (i >> 2);
                    { const float z = S0[i]; const float t = __builtin_amdgcn_exp2f(-fabsf(z) * LOG2E); float sp = fmaxf(z, 0.f) + LN2 * __builtin_amdgcn_logf(1.0f + t);
                      if (need_mask && key >= klim) sp = 0.f; SP0[i] = sp; }
                    { const float z = S1[i]; const float t = __builtin_amdgcn_exp2f(-fabsf(z) * LOG2E); float sp = fmaxf(z, 0.f) + LN2 * __builtin_amdgcn_logf(1.0f + t);
                      if (need_mask && key + 32 >= klim) sp = 0.f; SP1[i] = sp; } }
#pragma unroll
                for (int g = 0; g < 4; ++g) { gs[0][g] = (SP0[4 * g] + SP0[4 * g + 1]) + (SP0[4 * g + 2] + SP0[4 * g + 3]);
                    gs[1][g] = (SP1[4 * g] + SP1[4 * g + 1]) + (SP1[4 * g + 2] + SP1[4 * g + 3]); }
#pragma unroll
                for (int g = 0; g < 4; ++g) { gp[0][g] = __shfl_xor(gs[0][g], 32); gp[1][g] = __shfl_xor(gs[1][g], 32); }
                float running = carry;
#pragma unroll
                for (int blk = 1; blk >= 0; --blk)
#pragma unroll
                    for (int g = 3; g >= 0; --g) {
                        const float sum1 = hh ? gs[blk][g] : gp[blk][g], sum0 = hh ? gp[blk][g] : gs[blk][g];
                        const float mybase = hh ? running : running + sum1;
                        running += sum0 + sum1;
                        float later = mybase;
#pragma unroll
                        for (int j = 3; j >= 0; --j) { const int i = 4 * g + j; const int key = kbase + j + 8 * g + 32 * blk;
                            const float z = blk ? S1[i] : S0[i], sp = blk ? SP1[i] : SP0[i];
                            float a = __builtin_amdgcn_exp2f((z - sp - later) * LOG2E);
                            if (need_mask && key >= klim) a = 0.f;
                            later += sp;
                            if (blk) S1[i] = a; else S0[i] = a; }
                    }
                carry = running;
                wdone = __all((carry > 104.0f) || (klim <= 0));
            }
            bf16x8 pf[2][2];
#pragma unroll
            for (int s = 0; s < 2; ++s) {
                u32x4 a, c;
                a.x = pk2(S0[8 * s], S0[8 * s + 1]); a.y = pk2(S0[8 * s + 2], S0[8 * s + 3]); a.z = pk2(S0[8 * s + 4], S0[8 * s + 5]); a.w = pk2(S0[8 * s + 6], S0[8 * s + 7]);
                c.x = pk2(S1[8 * s], S1[8 * s + 1]); c.y = pk2(S1[8 * s + 2], S1[8 * s + 3]); c.z = pk2(S1[8 * s + 4], S1[8 * s + 5]); c.w = pk2(S1[8 * s + 6], S1[8 * s + 7]);
                pf[0][s] = __builtin_bit_cast(bf16x8, a); pf[1][s] = __builtin_bit_cast(bf16x8, c);
            }
#pragma unroll
            for (int blk = 0; blk < 2; ++blk)
#pragma unroll
                for (int s = 0; s < 2; ++s) {
                    const int koff = (32 * blk + 16 * s + 4 * hh) * 2;
                    const s16x4 lo0 = *(const s16x4*)(vb_ + ql * VS + koff), hi0 = *(const s16x4*)(vb_ + ql * VS + koff + 16);
                    const s16x4 lo1 = *(const s16x4*)(vb_ + (32 + ql) * VS + koff), hi1 = *(const s16x4*)(vb_ + (32 + ql) * VS + koff + 16);
                    const bf16x8 v0 = __builtin_shufflevector(lo0, hi0, 0, 1, 2, 3, 4, 5, 6, 7), v1 = __builtin_shufflevector(lo1, hi1, 0, 1, 2, 3, 4, 5, 6, 7);
                    O0 = MFMA32(v0, pf[blk][s], O0); O1 = MFMA32(v1, pf[blk][s], O1);
                }
        }
        if (it + 1 < ntiles) store_tile(cur ^ 1, kt - 1);
        if (MODE == 1 && lane == 0) flags[(it & 1) * 8 + w] = wdone ? 1 : 0;
        __syncthreads();
        if (MODE == 1) { int alld = 1;
#pragma unroll
            for (int ww = 0; ww < 8; ++ww) alld &= flags[(it & 1) * 8 + ww];
            if (alld) break; }
    }
    if (wactive) {
        float inv = 1.0f;
        if (MODE == 0) { const float lt = lrun + __shfl_xor(lrun, 32); inv = 1.0f / lt; }
        bf16_t* op = P->o + (long)(qrow0 + w * 32 + ql) * 1024 + (MODE == 0 ? 0 : 512) + h * 64 + 4 * hh;
#pragma unroll
        for (int g = 0; g < 4; ++g) {
            f32x4 a = {O0[4 * g] * inv, O0[4 * g + 1] * inv, O0[4 * g + 2] * inv, O0[4 * g + 3] * inv};
            f32x4 c = {O1[4 * g] * inv, O1[4 * g + 1] * inv, O1[4 * g + 2] * inv, O1[4 * g + 3] * inv};
            store_bf4(op + 8 * g, a); store_bf4(op + 32 + 8 * g, c);
        }
    }
}

DI void attn_phase(KP P, char* lds, int cidx) {
    unsigned* slot = (unsigned*)(lds + 65536);
    for (;;) {
        if (threadIdx.x == 0) *slot = atomicAdd(P->ctr + cidx, 1u);
        __syncthreads();
        const unsigned idx = *slot;
        __syncthreads();
        if (idx >= 1152u) break;
        bool sample; int mode, b, h, ublk = 0;
        if (idx < 128u) { sample = true; mode = idx >> 6; b = (idx >> 3) & 7; h = idx & 7; }
        else { const int j = idx - 128; sample = false; ublk = 31 - (j >> 5); const int r = j & 31; mode = r >> 4; b = (r >> 3) & 1; h = r & 7; }
        if (mode == 0) attn_unit<0>(P, lds, sample, b, h, ublk); else attn_unit<1>(P, lds, sample, b, h, ublk);
    }
}

DI void phase0(KP P, char* lds) {
    const int tid = otid(), G = ogrid(), bid = obid(), w = tid >> 6, lane = tid & 63;
    for (int item = bid; item < 96; item += G) {
        float* sc = (float*)lds; float* red = (float*)(lds + 40960);
        for (int i = tid; i < 10240; i += NTHREADS) { const int bb = i >> 10, k = i & 1023; const float cv = bb < 2 ? P->c_p[bb * 1024 + k] : P->c_s[(bb - 2) * 1024 + k]; sc[i] = cv / (1.0f + __expf(-cv)); }
        __syncthreads();
        const int col = item * 64 + lane;
        float a0 = 0, a1 = 0, a2 = 0, a3 = 0, a4 = 0, a5 = 0, a6 = 0, a7 = 0, a8 = 0, a9 = 0;
        for (int k0 = w * 128; k0 < w * 128 + 128; k0 += 16) {
            float wv[16];
#pragma unroll
            for (int j = 0; j < 16; ++j) wv[j] = P->w_ada[(long)(k0 + j) * 6144 + col];
#pragma unroll
            for (int j = 0; j < 16; ++j) { const int k = k0 + j;
                a0 += sc[k] * wv[j]; a1 += sc[1024 + k] * wv[j]; a2 += sc[2048 + k] * wv[j]; a3 += sc[3072 + k] * wv[j]; a4 += sc[4096 + k] * wv[j];
                a5 += sc[5120 + k] * wv[j]; a6 += sc[6144 + k] * wv[j]; a7 += sc[7168 + k] * wv[j]; a8 += sc[8192 + k] * wv[j]; a9 += sc[9216 + k] * wv[j]; }
        }
        float* rr = red + w * 640 + lane;
        rr[0] = a0; rr[64] = a1; rr[128] = a2; rr[192] = a3; rr[256] = a4; rr[320] = a5; rr[384] = a6; rr[448] = a7; rr[512] = a8; rr[576] = a9;
        __syncthreads();
        for (int i = tid; i < 640; i += NTHREADS) { float s = 0.f; for (int ww = 0; ww < 8; ++ww) s += red[ww * 640 + i];
            const int bb = i >> 6, l = i & 63; P->ada[bb * 6144 + item * 64 + l] = s + P->b_ada[item * 64 + l]; }
        __syncthreads();
    }
    {
        float* tile = (float*)lds;
        for (int it = (bid + 96) % G; it < P->ntj_tiles; it += G) {
            int j = 0;
#pragma unroll 1
            for (int q = 1; q < P->pad0; ++q) if (it >= P->tj[q].tile0) j = q;
            TJob J; J.src = P->tj[j].src; J.kscale = P->tj[j].kscale; J.dst = P->tj[j].dst; J.lds = P->tj[j].lds; J.coff = P->tj[j].coff; J.ldd = P->tj[j].ldd;
            J.Klen = P->tj[j].Klen; J.Nlen = P->tj[j].Nlen; J.zero = P->tj[j].zero; J.tile0 = P->tj[j].tile0;
            const int lt = it - J.tile0, nk = J.Klen >> 6, tk = lt % nk, tn = lt / nk, k0 = tk * 64, n0 = tn * 256;
            f32x4 lv[8];
#pragma unroll
            for (int r = 0; r < 8; ++r) { const int e = tid + r * NTHREADS, kk = e >> 6, n4 = (e & 63) * 4;
                lv[r] = (f32x4){0.f, 0.f, 0.f, 0.f};
                if (!J.zero && n0 + n4 < J.Nlen) lv[r] = *(const f32x4*)(J.src + (long)(k0 + kk) * J.lds + J.coff + n0 + n4); }
#pragma unroll
            for (int r = 0; r < 8; ++r) { const int e = tid + r * NTHREADS, kk = e >> 6, n4 = (e & 63) * 4;
                f32x4 v = lv[r]; if (J.kscale) v *= J.kscale[k0 + kk];
                float* tp = tile + kk * 257 + n4; tp[0] = v[0]; tp[1] = v[1]; tp[2] = v[2]; tp[3] = v[3]; }
            __syncthreads();
#pragma unroll
            for (int r = 0; r < 4; ++r) { const int e = tid + r * NTHREADS, nn = e >> 3, kc = (e & 7) * 8;
                if (n0 + nn < J.Nlen) { const float* tp = tile + kc * 257 + nn; u32x4 o;
                    o.x = pk2(tp[0], tp[257]); o.y = pk2(tp[2 * 257], tp[3 * 257]); o.z = pk2(tp[4 * 257], tp[5 * 257]); o.w = pk2(tp[6 * 257], tp[7 * 257]);
                    *(u32x4*)(J.dst + (long)(n0 + nn) * J.ldd + k0 + kc) = o; } }
            __syncthreads();
        }
    }
    const long gt = (long)bid * NTHREADS + tid, gn = (long)G * NTHREADS;
    for (long i0 = gt; i0 < 8L * PAST * 64; i0 += 4 * gn) { f32x4 v[4];
#pragma unroll
        for (int r = 0; r < 4; ++r) { const long i = i0 + r * gn; if (i < 8L * PAST * 64) v[r] = *(const f32x4*)(P->c_ckv + i * 4); }
#pragma unroll
        for (int r = 0; r < 4; ++r) { const long i = i0 + r * gn; if (i < 8L * PAST * 64) { const long row = i >> 6; const int c = (int)(i & 63) * 4; const int bb = (int)(row >> 12), sq = (int)(row & 4095);
            store_bf4(P->latent + (long)(MP + bb * SKEYS + sq) * 256 + c, v[r]); } } }
    for (long i0 = gt; i0 < 8L * PAST * 8; i0 += 4 * gn) { f32x4 v[4];
#pragma unroll
        for (int r = 0; r < 4; ++r) { const long i = i0 + r * gn; if (i < 8L * PAST * 8) v[r] = *(const f32x4*)(P->c_kr + i * 4); }
#pragma unroll
        for (int r = 0; r < 4; ++r) { const long i = i0 + r * gn; if (i < 8L * PAST * 8) { const long row = i >> 3; const int c = (int)(i & 7) * 4; const int bb = (int)(row >> 12), sq = (int)(row & 4095);
            store_bf4(P->krope + (long)(MP + bb * SKEYS + sq) * 32 + c, v[r]); } } }
    for (long i = gt; i < 8L * 512 * 8; i += gn) { const long r = i >> 3; const int c = (int)(i & 7) * 4; const u32x2 z = {0u, 0u};
        *(u32x2*)(P->vaT_s + r * SKP + SKEYS + c) = z; *(u32x2*)(P->vbT_s + r * SKP + SKEYS + c) = z; }
    for (long i = gt; i < (long)TP * 16; i += gn) { const int pos = (int)(i >> 4), fi = (int)(i & 15);
        const float inv = exp2f(-(float)fi * (13.287712379549449f / 16.0f));
        const float ang = (float)pos * inv;
        const double rev = (double)ang * 0.15915494309189535; const float fr_ = (float)(rev - floor(rev));
        P->ropeT[i * 2] = __builtin_amdgcn_cosf(fr_); P->ropeT[i * 2 + 1] = __builtin_amdgcn_sinf(fr_); }
}

DI void phase_h(KP P) {
    const int tid_ = otid(), lane = tid_ & 63, gw = obid() * 8 + (tid_ >> 6), nw = ogrid() * 8;
    for (int row = gw; row < MT; row += nw) {
        const float* xr = row < MP ? P->x_p + (long)row * DM : P->x_s + (long)(row - MP) * DM;
        const float* ad = P->ada + ada_b(row) * 6144;
        f32x4 v[4]; float s = 0.f;
#pragma unroll
        for (int i = 0; i < 4; ++i) { v[i] = *(const f32x4*)(xr + i * 256 + lane * 4); s += v[i][0] * v[i][0] + v[i][1] * v[i][1] + v[i][2] * v[i][2] + v[i][3] * v[i][3]; }
#pragma unroll
        for (int o = 1; o < 64; o <<= 1) s += __shfl_xor(s, o);
        const float rstd = rsqrtf(s * (1.0f / DM) + EPS);
#pragma unroll
        for (int i = 0; i < 4; ++i) { const int c = i * 256 + lane * 4;
            const f32x4 g = *(const f32x4*)(P->g_pre_mix + c), sh = *(const f32x4*)(ad + c), scl = *(const f32x4*)(ad + 1024 + c);
            store_bf4(P->h + (long)row * DM + c, v[i] * rstd * g * (1.0f + scl) + sh); }
    }
}

DI void phase_mid(KP P) {
    const int tid_ = otid(), lane = tid_ & 63, gw = obid() * 8 + (tid_ >> 6), nw = ogrid() * 8;
    for (int row = gw; row < MT; row += nw) {
        const float* xr = row < MP ? P->x_p + (long)row * DM : P->x_s + (long)(row - MP) * DM;
        const float* ad = P->ada + ada_b(row) * 6144;
        f32x4 mv[4]; float s = 0.f;
#pragma unroll
        for (int i = 0; i < 4; ++i) { const u32x2 wv = *(const u32x2*)(P->m2 + (long)row * DM + i * 256 + lane * 4);
            mv[i] = (f32x4){bf_lo(wv.x), bf_hi(wv.x), bf_lo(wv.y), bf_hi(wv.y)}; s += mv[i][0] * mv[i][0] + mv[i][1] * mv[i][1] + mv[i][2] * mv[i][2] + mv[i][3] * mv[i][3]; }
#pragma unroll
        for (int o = 1; o < 64; o <<= 1) s += __shfl_xor(s, o);
        const float rstd = rsqrtf(s * (1.0f / DM) + EPS);
        float s2 = 0.f;
#pragma unroll
        for (int i = 0; i < 4; ++i) { const int c = i * 256 + lane * 4;
            const f32x4 xv = *(const f32x4*)(xr + c), g = *(const f32x4*)(P->g_post_mix + c), gt = *(const f32x4*)(ad + 2048 + c);
            mv[i] = xv + gt * (mv[i] * rstd * g);
            *(f32x4*)(P->out + O_Y + (long)row * DM + c) = mv[i];
            s2 += mv[i][0] * mv[i][0] + mv[i][1] * mv[i][1] + mv[i][2] * mv[i][2] + mv[i][3] * mv[i][3]; }
#pragma unroll
        for (int o = 1; o < 64; o <<= 1) s2 += __shfl_xor(s2, o);
        const float rstd2 = rsqrtf(s2 * (1.0f / DM) + EPS);
#pragma unroll
        for (int i = 0; i < 4; ++i) { const int c = i * 256 + lane * 4;
            const f32x4 g = *(const f32x4*)(P->g_pre_ffn + c), sh = *(const f32x4*)(ad + 3072 + c), scl = *(const f32x4*)(ad + 4096 + c);
            store_bf4(P->h2 + (long)row * DM + c, mv[i] * rstd2 * g * (1.0f + scl) + sh); }
    }
}

DI void phase_final(KP P) {
    const int tid_ = otid(), lane = tid_ & 63, gw = obid() * 8 + (tid_ >> 6), nw = ogrid() * 8;
    for (int row = gw; row < MT; row += nw) {
        const float* ad = P->ada + ada_b(row) * 6144;
        f32x4 fv[4]; float s = 0.f;
#pragma unroll
        for (int i = 0; i < 4; ++i) { const u32x2 wv = *(const u32x2*)(P->f + (long)row * DM + i * 256 + lane * 4);
            fv[i] = (f32x4){bf_lo(wv.x), bf_hi(wv.x), bf_lo(wv.y), bf_hi(wv.y)}; s += fv[i][0] * fv[i][0] + fv[i][1] * fv[i][1] + fv[i][2] * fv[i][2] + fv[i][3] * fv[i][3]; }
#pragma unroll
        for (int o = 1; o < 64; o <<= 1) s += __shfl_xor(s, o);
        const float rstd = rsqrtf(s * (1.0f / DM) + EPS);
#pragma unroll
        for (int i = 0; i < 4; ++i) { const int c = i * 256 + lane * 4; float* yp = P->out + O_Y + (long)row * DM + c;
            const f32x4 xv = *(const f32x4*)yp, g = *(const f32x4*)(P->g_post_ffn + c), gt = *(const f32x4*)(ad + 5120 + c);
            *(f32x4*)yp = xv + gt * (fv[i] * rstd * g); }
    }
}

DI float gelu_tanh(float a) { const float t = 0.7978845608028654f * (a + 0.044715f * a * a * a); const float e = __expf(2.0f * t); return 0.5f * a * (2.0f - 2.0f / (1.0f + e)); }

DI void phase_conv(KP P) {
    const long gt = (long)obid() * NTHREADS + otid(), gn = (long)ogrid() * NTHREADS;
    for (long i = gt; i < (long)(MT / 8) * 352; i += gn) {
        const int rg = (int)(i / 352), c = (int)(i % 352) * 8, row0 = rg * 8;
        int t0, bs = -1; if (row0 < MP) t0 = row0 & (TP - 1); else { t0 = (row0 - MP) & 31; bs = (row0 - MP) >> 5; }
        u32x4 ua[10], ub[10];
#pragma unroll
        for (int r = 0; r < 10; ++r) { const int rr = (t0 == 0 && r < 2) ? row0 : row0 + r - 2;
            ua[r] = *(const u32x4*)(P->u + (long)rr * DFF2 + c); ub[r] = *(const u32x4*)(P->u + (long)rr * DFF2 + DFF + c); }
        float wa[3][8], wb[3][8], ba[8], bb[8];
#pragma unroll
        for (int tap = 0; tap < 3; ++tap) { const f32x4 x0 = *(const f32x4*)(P->conv_w + tap * DFF2 + c), x1 = *(const f32x4*)(P->conv_w + tap * DFF2 + c + 4);
            const f32x4 y0 = *(const f32x4*)(P->conv_w + tap * DFF2 + DFF + c), y1 = *(const f32x4*)(P->conv_w + tap * DFF2 + DFF + c + 4);
#pragma unroll
            for (int e = 0; e < 4; ++e) { wa[tap][e] = x0[e]; wa[tap][4 + e] = x1[e]; wb[tap][e] = y0[e]; wb[tap][4 + e] = y1[e]; } }
        { const f32x4 x0 = *(const f32x4*)(P->conv_b + c), x1 = *(const f32x4*)(P->conv_b + c + 4), y0 = *(const f32x4*)(P->conv_b + DFF + c), y1 = *(const f32x4*)(P->conv_b + DFF + c + 4);
#pragma unroll
          for (int e = 0; e < 4; ++e) { ba[e] = x0[e]; ba[4 + e] = x1[e]; bb[e] = y0[e]; bb[4 + e] = y1[e]; } }
        float ha[2][8], hb[2][8];
#pragma unroll
        for (int r = 0; r < 2; ++r)
#pragma unroll
            for (int e = 0; e < 4; ++e) { ha[r][2 * e] = bf_lo(ua[r][e]); ha[r][2 * e + 1] = bf_hi(ua[r][e]); hb[r][2 * e] = bf_lo(ub[r][e]); hb[r][2 * e + 1] = bf_hi(ub[r][e]); }
        if (t0 == 0) {
            if (bs >= 0) {
#pragma unroll
                for (int r = 0; r < 2; ++r) { const float* sp = P->c_conv + (long)(bs * 2 + r) * DFF2 + c;
#pragma unroll
                    for (int e = 0; e < 8; ++e) { ha[r][e] = sp[e]; hb[r][e] = sp[DFF + e]; } }
            } else {
#pragma unroll
                for (int r = 0; r < 2; ++r)
#pragma unroll
                    for (int e = 0; e < 8; ++e) { ha[r][e] = 0.f; hb[r][e] = 0.f; }
            }
        }
        float pa2[8], pa1[8], pb2[8], pb1[8];
#pragma unroll
        for (int e = 0; e < 8; ++e) { pa2[e] = ha[0][e]; pa1[e] = ha[1][e]; pb2[e] = hb[0][e]; pb1[e] = hb[1][e]; }
#pragma unroll
        for (int r = 0; r < 8; ++r) {
            float ca[8], cb[8];
#pragma unroll
            for (int e = 0; e < 4; ++e) { ca[2 * e] = bf_lo(ua[r + 2][e]); ca[2 * e + 1] = bf_hi(ua[r + 2][e]); cb[2 * e] = bf_lo(ub[r + 2][e]); cb[2 * e + 1] = bf_hi(ub[r + 2][e]); }
            u32x4 ov;
#pragma unroll
            for (int e = 0; e < 4; ++e) {
                const float ya0 = ba[2 * e] + wa[0][2 * e] * pa2[2 * e] + wa[1][2 * e] * pa1[2 * e] + wa[2][2 * e] * ca[2 * e];
                const float ya1 = ba[2 * e + 1] + wa[0][2 * e + 1] * pa2[2 * e + 1] + wa[1][2 * e + 1] * pa1[2 * e + 1] + wa[2][2 * e + 1] * ca[2 * e + 1];
                const float yb0 = bb[2 * e] + wb[0][2 * e] * pb2[2 * e] + wb[1][2 * e] * pb1[2 * e] + wb[2][2 * e] * cb[2 * e];
                const float yb1 = bb[2 * e + 1] + wb[0][2 * e + 1] * pb2[2 * e + 1] + wb[1][2 * e + 1] * pb1[2 * e + 1] + wb[2][2 * e + 1] * cb[2 * e + 1];
                ov[e] = pk2(gelu_tanh(ya0) * yb0, gelu_tanh(ya1) * yb1); }
            *(u32x4*)(P->g + (long)(row0 + r) * DFF + c) = ov;
#pragma unroll
            for (int e = 0; e < 8; ++e) { pa2[e] = pa1[e]; pa1[e] = ca[e]; pb2[e] = pb1[e]; pb1[e] = cb[e]; }
        }
    }
}

#define XB_TMO      128
#define XB_XCNT(j)  (256  + 64 * (j))
#define XB_XSUB(j)  (1280 + 64 * (j))
#define XB_XGEN(j)  (2304 + 64 * (j))
#define XB_TOP      3328
#define XB_TOPGEN   3392
#define XCD_BAR_WORDS 3456
#define XB_SPIN_CAP (1u << 18)
DI unsigned xb_ld(unsigned* p)              { return __hip_atomic_load(p, __ATOMIC_RELAXED, __HIP_MEMORY_SCOPE_AGENT); }
DI unsigned xb_add(unsigned* p, unsigned v) { return __hip_atomic_fetch_add(p, v, __ATOMIC_RELAXED, __HIP_MEMORY_SCOPE_AGENT); }
DI unsigned xb_xcc_id() { return (unsigned)__builtin_amdgcn_s_getreg((3 << 11) | 20) & 0xFu; }
#define XB_SPIN(cond, bar) do { unsigned _sp = 0; while (cond) { __builtin_amdgcn_s_sleep(1); \
    if ((++_sp & 255u) == 0u) { if (xb_ld(&(bar)[XB_TMO])) break; if (_sp > XB_SPIN_CAP) { atomicAdd(&(bar)[XB_TMO], 1u); break; } } } } while (0)
DI void xcd_barrier_complete(unsigned* bar, unsigned x, unsigned& nloc, unsigned& nx) {
    const unsigned G = gridDim.x;
    unsigned sum, cnt, mine, sp = 0u;
    for (;;) {
        sum = 0u; cnt = 0u; mine = 0u;
#pragma unroll
        for (unsigned j = 0; j < 16; ++j) { const unsigned c = xb_ld(&bar[XB_XCNT(j)]); sum += c; cnt += (c > 0u) ? 1u : 0u; mine = (j == x) ? c : mine; }
        if (sum == G) break;
        __builtin_amdgcn_s_sleep(1);
        if ((++sp & 255u) == 0u) { if (xb_ld(&bar[XB_TMO])) break; if (sp > XB_SPIN_CAP) { atomicAdd(&bar[XB_TMO], 1u); break; } }
    }
    nloc = mine > 0u ? mine : 1u; nx = cnt > 0u ? cnt : 1u;
}
DI void grid_barrier(char* lds) {
    asm volatile("s_waitcnt vmcnt(0)" ::: "memory");
    __syncthreads();
    if (threadIdx.x == 0) {
        unsigned* bar = kparams()->bar; const unsigned x = xb_xcc_id();
        volatile LAS unsigned* st = (volatile LAS unsigned*)(lds + 131072 + 2048);
        __builtin_amdgcn_s_waitcnt(0);
        unsigned nloc = st[0], nx = st[1];
        if (nloc == 0u) { xcd_barrier_complete(bar, x, nloc, nx); st[0] = nloc; st[1] = nx; }
        const unsigned old = xb_add(&bar[XB_XSUB(x)], 1u);
        const unsigned gen = old / nloc;
        if (old + 1u == (gen + 1u) * nloc) {
            __builtin_amdgcn_fence(__ATOMIC_RELEASE, "agent");
            asm volatile("s_waitcnt vmcnt(0)" ::: "memory");
            const unsigned og = xb_add(&bar[XB_TOP], 1u);
            const unsigned tg = og / nx;
            if (og + 1u == (tg + 1u) * nx) xb_add(&bar[XB_TOPGEN], 1u);
            else XB_SPIN(xb_ld(&bar[XB_TOPGEN]) == tg, bar);
            __builtin_amdgcn_fence(__ATOMIC_ACQUIRE, "agent");
            xb_add(&bar[XB_XGEN(x)], 1u);
            asm volatile("s_waitcnt vmcnt(0)" ::: "memory");
        } else {
            XB_SPIN(xb_ld(&bar[XB_XGEN(x)]) == gen, bar);
            __builtin_amdgcn_fence(__ATOMIC_ACQUIRE, "agent");
            asm volatile("s_waitcnt vmcnt(0)" ::: "memory");
        }
    }
    __syncthreads();
}

__global__ void __launch_bounds__(NTHREADS) fwd_megakernel(Params Pval) {
    extern __shared__ __attribute__((aligned(16))) char lds[];
    cg::grid_group grid = cg::this_grid();
    const int lo = kparams()->phase_lo, hi = kparams()->phase_hi;
#define PH(n) if (lo <= (n) && (n) < hi)
#define SYNC(n) if (lo <= (n) && (n) + 1 < hi) grid_barrier(lds)
    if (hi > 1000) grid.sync();
    { volatile LAS unsigned* st = (volatile LAS unsigned*)(lds + 131072 + 2048);
      if (threadIdx.x == 0) { st[0] = 0u; st[1] = 0u; }
      __syncthreads();
      if (threadIdx.x == 0) (void)xb_add(&kparams()->bar[XB_XCNT(xb_xcc_id())], 1u); }
    PH(0) phase0(kparams(), lds);
#ifdef PROBE_P0
    __syncthreads(); phase0(kparams(), lds);
#endif
#ifdef PROBE_SYNC
    for (int i = 0; i < 24; ++i) grid_barrier(lds);
#endif
    SYNC(0);
    PH(1) phase_h(kparams());
#ifdef PROBE_ROWS
    phase_h(kparams());
#endif
    SYNC(1);
    for (int ph = 2; ph <= 12; ++ph) {
        if (ph == 4) { PH(4) attn_phase(kparams(), lds, 0);
#ifdef PROBE_ATTN2
            __syncthreads(); attn_phase(kparams(), lds, 1);
#endif
            SYNC(4); continue; }
        if (ph == 8) { PH(8) phase_mid(kparams());
#ifdef PROBE_ROWS
            phase_mid(kparams());
#endif
            SYNC(8); continue; }
        if (ph == 10) { PH(10) phase_conv(kparams());
#ifdef PROBE_CONV
            phase_conv(kparams());
#endif
            SYNC(10); continue; }
        if (ph == 12) { PH(12) phase_final(kparams()); continue; }
        if (lo <= ph && ph < hi) {
            const int npass = (ph == 3 || ph == 6) ? 2 : 1;
            for (int pass = 0; pass < npass; ++pass) {
                GemmDesc d; d.C = nullptr; d.ldc = 0; d.start = 0; KP P = kparams();
                switch (ph) {
                case 2: d.A = P->h; d.lda = DM; d.Bt = P->WinT; d.ldb = DM; d.K = DM; d.nM = 65; d.nN = 9; d.epi = E_INPROJ; break;
                case 3: if (pass == 0) { d.A = P->qlat; d.lda = 384; d.Bt = P->WuqT; d.ldb = 384; d.K = 384; d.nM = 65; d.nN = 3; d.epi = E_UQ; }
                        else { d.A = P->latent; d.lda = 256; d.Bt = P->WukvT; d.ldb = 256; d.K = 256; d.nM = 193; d.nN = 4; d.epi = E_UKV; d.start = 195; } break;
                case 5: d.A = P->h; d.lda = DM; d.Bt = P->WgT; d.ldb = DM; d.K = DM; d.nM = 64; d.nN = 8; d.epi = E_GATE; break;
                case 6: d.A = P->o + pass * 512; d.lda = DM; d.Bt = pass ? P->WpbT : P->WpaT; d.ldb = 512; d.K = 512; d.nM = 64; d.nN = 4; d.epi = pass ? E_PROJB : E_PROJA; break;
                case 7: d.A = P->merged; d.lda = DM; d.Bt = P->WoutT; d.ldb = DM; d.K = DM; d.nM = 64; d.nN = 4; d.epi = E_PLAIN; d.C = P->m2; d.ldc = DM; break;
                case 9: d.A = P->h2; d.lda = DM; d.Bt = P->WupT; d.ldb = DM; d.K = DM; d.nM = 65; d.nN = 22; d.epi = E_UP; break;
                default: d.A = P->g; d.lda = DFF; d.Bt = P->WdownT; d.ldb = DFF; d.K = DFF; d.nM = 64; d.nN = 4; d.epi = E_PLAIN; d.C = P->f; d.ldc = DM; break;
                }
                gemm_run(d, lds);
#ifdef PROBE_GEMM2
                if (ph == PROBE_GEMM2 && !(ph == 6 && pass == 0)) { __syncthreads(); if (ph == 6) { GemmDesc d0 = d; d0.A = P->o; d0.Bt = P->WpaT; d0.epi = E_PROJA; gemm_run(d0, lds); } gemm_run(d, lds); }
#endif
            }
        }
        if (lo <= ph && ph < hi) {
            KP P = kparams();
            if (ph == 5) gemm_small<1, 8>(P, P->h, DM, P->WgT, DM, 2048, P->gates, 2048, lds);
            else if (ph == 6) gemm_small<2, 4>(P, P->o, DM, P->WpaT, 512, 1024, P->merged, DM, lds);
            else if (ph == 7) gemm_small<0, 8>(P, P->merged, DM, P->WoutT, DM, 1024, P->m2, DM, lds);
            else if (ph == 11) gemm_small<0, 22>(P, P->g, DFF, P->WdownT, DFF, 1024, P->f, DM, lds);
#ifdef PROBE_SMALL
            if (ph == 5) gemm_small<1, 8>(P, P->h, DM, P->WgT, DM, 2048, P->gates, 2048, lds);
            else if (ph == 6) gemm_small<2, 4>(P, P->o, DM, P->WpaT, 512, 1024, P->merged, DM, lds);
            else if (ph == 7) gemm_small<0, 8>(P, P->merged, DM, P->WoutT, DM, 1024, P->m2, DM, lds);
            else if (ph == 11) gemm_small<0, 22>(P, P->g, DFF, P->WdownT, DFF, 1024, P->f, DM, lds);
#endif
        }
        SYNC(ph);
    }
}

static size_t bump(size_t& off, size_t bytes) { size_t r = off; off += (bytes + 255) & ~(size_t)255; return r; }

extern "C" void kernel_launch(void* const* d_in, const int* in_sizes, int n_in, void* d_out, int out_size, void* d_ws, size_t ws_size, hipStream_t stream) {
    Params P; memset(&P, 0, sizeof(P));
    const float* const* in = (const float* const*)d_in;
    P.x_p = in[0]; P.x_s = in[1]; P.c_ckv = in[2]; P.c_kr = in[3]; P.c_sbk = in[4]; P.c_sbv = in[5]; P.c_conv = in[6]; P.c_p = in[7]; P.c_s = in[8];
    P.w_ada = in[9]; P.b_ada = in[10]; P.g_pre_mix = in[11]; P.g_post_mix = in[12]; P.g_pre_ffn = in[13]; P.g_post_ffn = in[14];
    const float* w_in = in[15]; const float* g_q = in[16]; const float* w_uq = in[17]; P.g_kv = in[18]; const float* w_uk = in[19]; const float* w_uv = in[20];
    const float* w_pa = in[21]; const float* w_pb = in[22]; const float* w_out = in[23]; const float* w_up = in[24]; P.conv_w = in[25]; P.conv_b = in[26]; const float* w_down = in[27];
    P.out = (float*)d_out;
    char* ws = (char*)d_ws; size_t off = 0;
    P.WupT = (bf16_t*)(ws + bump(off, (size_t)DFF2 * DM * 2));
    P.WdownT = (bf16_t*)(ws + bump(off, (size_t)DM * DFF * 2));
    P.ropeT = (float*)(ws + bump(off, (size_t)TP * 32 * 4));
    P.ada = (float*)(ws + bump(off, 10 * 6144 * 4));
    P.ctr = (unsigned*)(ws + bump(off, 256));
    P.bar = (unsigned*)(ws + bump(off, XCD_BAR_WORDS * 4));
    const size_t R0 = off;
    P.WinT = (bf16_t*)(ws + bump(off, (size_t)2304 * DM * 2));
    P.WgT = (bf16_t*)(ws + bump(off, (size_t)2048 * DM * 2));
    P.WuqT = (bf16_t*)(ws + bump(off, (size_t)768 * 384 * 2));
    P.WukvT = (bf16_t*)(ws + bump(off, (size_t)1024 * 256 * 2));
    P.WpaT = (bf16_t*)(ws + bump(off, (size_t)1024 * 512 * 2));
    P.WpbT = (bf16_t*)(ws + bump(off, (size_t)1024 * 512 * 2));
    P.WoutT = (bf16_t*)(ws + bump(off, (size_t)1024 * 1024 * 2));
    const size_t o_kva = off;
    P.kva = (bf16_t*)(ws + bump(off, (size_t)KVROWS_PAD * 512 * 2));
    P.vaT_p = (bf16_t*)(ws + bump(off, (size_t)2 * 512 * TP * 2));
    P.vaT_s = (bf16_t*)(ws + bump(off, (size_t)8 * 512 * SKP * 2));
    const size_t o_kb = off;
    P.kb = (bf16_t*)(ws + bump(off, (size_t)KVROWS_PAD * 512 * 2));
    const size_t o_vbT = off;
    P.vbT_p = (bf16_t*)(ws + bump(off, (size_t)2 * 512 * TP * 2));
    P.vbT_s = (bf16_t*)(ws + bump(off, (size_t)8 * 512 * SKP * 2));
    const size_t o_kr = off;
    P.krope = (bf16_t*)(ws + bump(off, (size_t)KVROWS_PAD * 32 * 2));
    P.qb = (bf16_t*)(ws + bump(off, (size_t)MT * 512 * 2));
    P.q = (bf16_t*)(ws + bump(off, (size_t)MT * 768 * 2));
    P.latent = (bf16_t*)(ws + bump(off, (size_t)KVROWS_PAD * 256 * 2));
    size_t need = off;
    P.gates = (bf16_t*)(ws + o_kva);
    P.merged = (bf16_t*)(ws + o_kb);
    P.m2 = (bf16_t*)(ws + o_vbT);
    P.u = (bf16_t*)(ws + R0);
    const size_t o_g = R0 + (size_t)MT * DFF2 * 2;
    P.g = (bf16_t*)(ws + o_g);
    P.f = (bf16_t*)(ws + R0);
    size_t o_h2 = o_kr > o_g ? o_kr : o_g;
    P.h2 = (bf16_t*)(ws + o_h2);
    if (o_g + (size_t)MT * DFF * 2 > need) need = o_g + (size_t)MT * DFF * 2;
    if (o_h2 + (size_t)MT * DM * 2 > need) need = o_h2 + (size_t)MT * DM * 2;
    P.h = (bf16_t*)d_out;
    P.o = (bf16_t*)d_out + (size_t)MT * DM;
    P.qlat = P.o;
    if (need > ws_size) { fprintf(stderr, "workspace too small: need %zu have %zu\n", need, ws_size); return; }

    int nj = 0, tiles = 0;
    auto job = [&](const float* src, int lds, int coff, bf16_t* dst, int ldd, int Klen, int Nlen, const float* ks, int zero) {
        TJob& J = P.tj[nj++]; J.src = src; J.kscale = ks; J.dst = dst; J.lds = lds; J.coff = coff; J.ldd = ldd; J.Klen = Klen; J.Nlen = Nlen; J.zero = zero; J.tile0 = tiles; J.pad = 0;
        tiles += (Klen / 64) * ((Nlen + 255) / 256); };
    job(w_up, DFF2, 0, P.WupT, DM, DM, DFF2, nullptr, 0);
    job(w_down, DM, 0, P.WdownT, DFF, DFF, DM, nullptr, 0);
    job(w_in, 4256, 0, P.WinT, DM, DM, 384, nullptr, 0);
    job(w_in, 4256, 640, P.WinT + (size_t)384 * DM, DM, DM, 32, nullptr, 0);
    job(w_in, 4256, 0, P.WinT + (size_t)416 * DM, DM, DM, 96, nullptr, 1);
    job(w_in, 4256, 384, P.WinT + (size_t)512 * DM, DM, DM, 256, nullptr, 0);
    job(w_in, 4256, 672, P.WinT + (size_t)768 * DM, DM, DM, 1536, nullptr, 0);
    job(w_in, 4256, 2208, P.WgT, DM, DM, 2048, nullptr, 0);
    job(w_uq, 768, 0, P.WuqT, 384, 384, 768, g_q, 0);
    job(w_uk, 512, 0, P.WukvT, 256, 256, 512, nullptr, 0);
    job(w_uv, 512, 0, P.WukvT + (size_t)512 * 256, 256, 256, 512, nullptr, 0);
    job(w_pa, DM, 0, P.WpaT, 512, 512, DM, nullptr, 0);
    job(w_pb, DM, 0, P.WpbT, 512, 512, DM, nullptr, 0);
    job(w_out, DM, 0, P.WoutT, DM, DM, DM, nullptr, 0);
    P.ntj_tiles = tiles; P.pad0 = nj;
    P.phase_lo = 0; P.phase_hi = 13;

    static int grid_blocks = 0;
    if (!grid_blocks) {
        (void)hipFuncSetAttribute((const void*)fwd_megakernel, hipFuncAttributeMaxDynamicSharedMemorySize, LDS_BYTES);
        int dev = 0, cus = 0, per_cu = 0;
        (void)hipGetDevice(&dev);
        (void)hipDeviceGetAttribute(&cus, hipDeviceAttributeMultiprocessorCount, dev);
        (void)hipOccupancyMaxActiveBlocksPerMultiprocessor(&per_cu, fwd_megakernel, NTHREADS, LDS_BYTES);
        if (per_cu > 1) per_cu = 1;
        grid_blocks = cus * per_cu;
    }
    (void)hipMemsetAsync(P.ctr, 0, 256 + XCD_BAR_WORDS * 4, stream);
    void* args[] = {&P};
    hipError_t e = hipLaunchCooperativeKernel((const void*)fwd_megakernel, dim3(grid_blocks), dim3(NTHREADS), args, LDS_BYTES, stream);
    if (e != hipSuccess) fprintf(stderr, "cooperative launch failed: %s (grid %d)\n", hipGetErrorString(e), grid_blocks);
}
```

```cpp
#include <hip/hip_runtime.h>
#include <hip/hip_cooperative_groups.h>
#include <stdint.h>
#include <stdio.h>
#include <string.h>
namespace cg = cooperative_groups;

typedef unsigned short bf16_t;
typedef short bf16x8 __attribute__((ext_vector_type(8)));
typedef short s16x4 __attribute__((ext_vector_type(4)));
typedef float f32x2 __attribute__((ext_vector_type(2)));
typedef float f32x4 __attribute__((ext_vector_type(4)));
typedef float f32x16 __attribute__((ext_vector_type(16)));
typedef unsigned u32x2 __attribute__((ext_vector_type(2)));
typedef unsigned u32x4 __attribute__((ext_vector_type(4)));
typedef __bf16 bf2_t __attribute__((ext_vector_type(2)));
#define DI __device__ __forceinline__

constexpr int DM = 1024, TP = 8192, MP = 16384, MS = 256, MT = 16640, PAST = 4096, SKEYS = 4128, SKP = 4160;
constexpr int KVROWS = MP + 8 * SKEYS;
constexpr int KVROWS_PAD = KVROWS + 64;
constexpr int DFF = 2816, DFF2 = 5632;
constexpr float EPS = 1e-6f;
constexpr float LOG2E = 1.4426950408889634f, LN2 = 0.6931471805599453f;
constexpr int NTHREADS = 512;
constexpr int LDS_BYTES = 131072 + 8192;
constexpr long O_Y = 0, O_CKV_P = 17039360, O_KR_P = 21233664, O_SBK_P = 21757952, O_SBV_P = 30146560, O_CONV_P = 38535168,
               O_CKV_S = 38557696, O_KR_S = 38623232, O_SBK_S = 38631424, O_SBV_S = 38762496, O_CONV_S = 38893568;

struct TJob { const float* src; const float* kscale; bf16_t* dst; int lds, coff, ldd, Klen, Nlen, zero, tile0, pad; };
constexpr int NTJ = 22;

struct Params {
    const float *x_p, *x_s, *c_ckv, *c_kr, *c_sbk, *c_sbv, *c_conv, *c_p, *c_s;
    const float *w_ada, *b_ada, *g_pre_mix, *g_post_mix, *g_pre_ffn, *g_post_ffn, *g_kv, *conv_w, *conv_b;
    float* out;
    bf16_t *WupT, *WdownT, *WinT, *WgT, *WuqT, *WukvT, *WpaT, *WpbT, *WoutT;
    float* ropeT; float* ada; unsigned* ctr; unsigned* bar;
    bf16_t *h, *o, *qlat, *latent, *krope, *kb, *vbT_p, *vbT_s, *qb, *q, *kva, *vaT_p, *vaT_s, *gates, *merged, *m2, *h2, *u, *g, *f;
    TJob tj[NTJ]; int ntj_tiles; int phase_lo, phase_hi, pad0;
};

#define LAS __attribute__((address_space(3)))
typedef const Params __attribute__((address_space(4))) * KP;
DI KP kparams() { KP p = (KP)__builtin_amdgcn_kernarg_segment_ptr(); asm volatile("" : "+s"(p)); return p; }
DI int otid() { int t = threadIdx.x; asm volatile("" : "+v"(t)); return t; }
DI int obid() { int b = blockIdx.x; asm volatile("" : "+s"(b)); return b; }
DI int ogrid() { int g = gridDim.x; asm volatile("" : "+s"(g)); return g; }
DI unsigned pk2(float a, float b) { f32x2 f = {a, b}; bf2_t r = __builtin_convertvector(f, bf2_t); return __builtin_bit_cast(unsigned, r); }
DI float bf_lo(unsigned u) { return __uint_as_float(u << 16); }
DI float bf_hi(unsigned u) { return __uint_as_float(u & 0xffff0000u); }
DI int kvrow_of(int row) { if (row < MP) return row; const int r = row - MP; return MP + (r >> 5) * SKEYS + PAST + (r & 31); }
DI int pos_of(int row) { return row < MP ? (row & (TP - 1)) : PAST + ((row - MP) & 31); }
DI int ada_b(int row) { return row < MP ? (row >> 13) : 2 + ((row - MP) >> 5); }
DI float sigmoidf_(float x) { return 1.0f / (1.0f + __expf(-x)); }

constexpr int BM = 256, BK = 64, HALF = 128, HT = HALF * BK;
DI int lds_byte(int r, int c) { int st = (r >> 4) * 2 + (c >> 5), rr = r & 15, cc = c & 31, ob = rr * 64 + cc * 2; return st * 1024 + (ob ^ (((ob >> 9) & 1) << 5)); }
DI void stage_rc(int b, int& R, int& C) { int st = b / 1024, sb = b % 1024, swz = sb ^ (((sb >> 9) & 1) << 5); R = (st >> 1) * 16 + swz / 64; C = (st & 1) * 32 + (swz % 64) / 2; }

enum { E_INPROJ = 0, E_GATE, E_UQ, E_UKV, E_PROJA, E_PROJB, E_PLAIN, E_UP };
struct GemmDesc { const bf16_t* A; const bf16_t* Bt; bf16_t* C; int lda, ldb, ldc, K, nM, nN, epi, start; };

constexpr int HTB = HT * 2;
#define SA(b, h) (((b) * 2 + (h)) * HTB)
#define SB(b, h) ((4 + (b) * 2 + (h)) * HTB)
#define STAGE(bufoff, gbase, voff) do { _Pragma("unroll") for (int _i = 0; _i < 2; ++_i) \
    __builtin_amdgcn_global_load_lds((const unsigned*)((const char*)(gbase) + (voff)[_i]), (LAS unsigned*)(ldsl + (bufoff) + ldsw + _i * 8192), 16, 0, 0); } while (0)
#define LDA(dst, b, h) do { _Pragma("unroll") for (int m = 0; m < 4; ++m) _Pragma("unroll") for (int k = 0; k < 2; ++k) dst[m][k] = *(const LAS bf16x8*)(ldsl + SA(b, h) + aoff + m * 2048 + k * 1024); } while (0)
#define LDB(dst, b, h) do { _Pragma("unroll") for (int n = 0; n < 2; ++n) _Pragma("unroll") for (int k = 0; k < 2; ++k) dst[n][k] = *(const LAS bf16x8*)(ldsl + SB(b, h) + boff + n * 2048 + k * 1024); } while (0)
#define MMA(ai, bj, At, Bt_) do { __builtin_amdgcn_s_setprio(1); _Pragma("unroll") for (int m = 0; m < 4; ++m) _Pragma("unroll") for (int n = 0; n < 2; ++n) _Pragma("unroll") for (int k = 0; k < 2; ++k) \
      acc[ai][bj][m][n] = __builtin_amdgcn_mfma_f32_16x16x32_bf16(Bt_[n][k], At[m][k], acc[ai][bj][m][n], 0, 0, 0); \
    __builtin_amdgcn_s_setprio(0); } while (0)
#define WAIT_V(n) asm volatile("s_waitcnt vmcnt(" #n ")" ::: "memory")
#define WAIT_L(n) asm volatile("s_waitcnt lgkmcnt(" #n ")" ::: "memory")
#define BAR __builtin_amdgcn_s_barrier()
#define SCHED __builtin_amdgcn_sched_barrier(0)
#define ZERO_ACC do { _Pragma("unroll") for (int a_ = 0; a_ < 2; ++a_) _Pragma("unroll") for (int b_ = 0; b_ < 2; ++b_) _Pragma("unroll") for (int m_ = 0; m_ < 4; ++m_) _Pragma("unroll") for (int n_ = 0; n_ < 2; ++n_) \
    acc[a_][b_][m_][n_] = (f32x4){0.f, 0.f, 0.f, 0.f}; } while (0)

#define EPI_ROWS for (int ai = 0; ai < 2; ++ai) for (int m = 0; m < 4; ++m, ({ asm volatile("" ::: "memory"); }))
#define EPI_COLS for (int bj = 0; bj < 2; ++bj) for (int n = 0; n < 2; ++n)

DI float dpp_xor1(float x) { return __int_as_float(__builtin_amdgcn_mov_dpp(__float_as_int(x), 0xB1, 0xF, 0xF, true)); }
DI float dpp_xor2(float x) { return __int_as_float(__builtin_amdgcn_mov_dpp(__float_as_int(x), 0x4E, 0xF, 0xF, true)); }
DI f32x4 quad_transpose(f32x4 v, int i) {
    { const float a = (i & 1) ? v[0] : v[1], c = (i & 1) ? v[2] : v[3]; const float ra = dpp_xor1(a), rc = dpp_xor1(c);
      if (i & 1) { v[0] = ra; v[2] = rc; } else { v[1] = ra; v[3] = rc; } }
    { const float a = (i & 2) ? v[0] : v[2], c = (i & 2) ? v[1] : v[3]; const float ra = dpp_xor2(a), rc = dpp_xor2(c);
      if (i & 2) { v[0] = ra; v[1] = rc; } else { v[2] = ra; v[3] = rc; } }
    return v;
}
DI void store_bf4(bf16_t* p, f32x4 v) { u32x2 w; w.x = pk2(v[0], v[1]); w.y = pk2(v[2], v[3]); *(u32x2*)p = w; }

DI void gemm_run(const GemmDesc& d, char* lds) {
    LAS char* ldsl = (LAS char*)lds;
    float* xl = (float*)(lds + 131072);
    float* xp = (float*)(lds + 131072 + 4096);
    const int G = ogrid(), nun = d.nM * d.nN, first = (int)((obid() + G - (d.start % G)) % G);
    if (first >= nun) return;
    const int tid = otid(), wid = __builtin_amdgcn_readfirstlane(tid >> 6), wr = wid >> 2, wc = wid & 3;
    const unsigned lda2 = (unsigned)d.lda * 2u, ldb2 = (unsigned)d.ldb * 2u;
    unsigned voffA[2], voffB[2];
    { const int lane = tid & 63;
#pragma unroll
      for (int i = 0; i < 2; ++i) { int R, C; stage_rc(tid * 16 + i * 8192, R, C); voffA[i] = (unsigned)R * lda2 + (unsigned)C * 2u; voffB[i] = (unsigned)R * ldb2 + (unsigned)C * 2u; }
      (void)lane; }
    const size_t kstep = 128, hA = (size_t)HALF * lda2, hB = (size_t)HALF * ldb2;
    const unsigned ldsw = (unsigned)wid * 1024u;
    const int aoff = lds_byte(wr * 64 + (tid & 15), ((tid & 63) >> 4) * 8), boff = lds_byte(wc * 32 + (tid & 15), ((tid & 63) >> 4) * 8);
    const int nt = d.K / BK;
    int u = first;
    const char* cA = (const char*)d.A + (size_t)(u / d.nN) * 2 * hA; const char* cB = (const char*)d.Bt + (size_t)(u % d.nN) * 2 * hB;
    f32x4 acc[2][2][4][2];
    ZERO_ACC;
    bf16x8 At[4][2], B0[2][2], B1[2][2];
    STAGE(SB(0, 0), cB, voffB); STAGE(SB(0, 1), cB + hB, voffB); STAGE(SA(0, 0), cA, voffA); STAGE(SA(0, 1), cA + hA, voffA);
    if (wr == 1) BAR;
    WAIT_V(2); BAR;
    STAGE(SB(1, 0), cB + kstep, voffB); STAGE(SA(1, 0), cA + kstep, voffA); STAGE(SB(1, 1), cB + hB + kstep, voffB);
    WAIT_V(6); BAR;
    for (;;) {
        const int un = u + G; const bool has_next = un < nun;
        const char* nA = has_next ? (const char*)d.A + (size_t)(un / d.nN) * 2 * hA : cA; const char* nB = has_next ? (const char*)d.Bt + (size_t)(un % d.nN) * 2 * hB : cB;
        for (int t = 0; t < nt; t += 2) {
            const bool last = (t == nt - 2);
            const char* a1 = cA + (size_t)(t + 1) * kstep;
            const char* a2 = last ? nA : cA + (size_t)(t + 2) * kstep; const char* b2 = last ? nB : cB + (size_t)(t + 2) * kstep;
            const char* a3 = a2 + kstep; const char* b3 = b2 + kstep;
            LDB(B0, 0, 0); LDB(B1, 0, 1); SCHED; LDA(At, 0, 0); STAGE(SA(1, 1), a1 + hA, voffA);
            WAIT_V(8); WAIT_L(0); BAR; MMA(0, 0, At, B0); MMA(0, 1, At, B1); BAR; SCHED;
            LDA(At, 0, 1); STAGE(SB(0, 0), b2, voffB); STAGE(SB(0, 1), b2 + hB, voffB); STAGE(SA(0, 0), a2, voffA);
            WAIT_V(8); WAIT_L(0); BAR; MMA(1, 0, At, B0); MMA(1, 1, At, B1); BAR; SCHED;
            LDB(B0, 1, 0); LDB(B1, 1, 1); SCHED; LDA(At, 1, 0); STAGE(SA(0, 1), a2 + hA, voffA);
            WAIT_V(8); WAIT_L(0); BAR; MMA(0, 0, At, B0); MMA(0, 1, At, B1); BAR; SCHED;
            LDA(At, 1, 1); STAGE(SB(1, 0), b3, voffB); STAGE(SB(1, 1), b3 + hB, voffB); STAGE(SA(1, 0), a3, voffA);
            WAIT_V(8); WAIT_L(0); BAR; MMA(1, 0, At, B0); MMA(1, 1, At, B1); BAR; SCHED;
        }
        if (wr == 0) BAR;
        {
        const int pm = u / d.nN, pn = u % d.nN, brow = pm * BM, bcol = pn * BM;
        if (d.epi == E_UQ) {
            const int tq_ = otid(), r = tq_ >> 1, hf = tq_ & 1;
            const u32x4* src = (const u32x4*)(d.A + (long)(brow + r) * 384 + hf * 192);
            float sq = 0.f;
#pragma unroll 4
            for (int i = 0; i < 24; ++i) { u32x4 v = src[i];
                for (int e = 0; e < 4; ++e) { float a_ = bf_lo(v[e]), b_ = bf_hi(v[e]); sq += a_ * a_ + b_ * b_; } }
            sq += __shfl_xor(sq, 1);
            if (hf == 0) xl[r] = rsqrtf(sq * (1.0f / 384.0f) + EPS);
            WAIT_L(0); BAR; asm volatile("" ::: "memory");
        }
        int lane_e = threadIdx.x & 63; asm volatile("" : "+v"(lane_e));
        const int fr = lane_e & 15, fq = lane_e >> 4;
        KP P = kparams();
        const int rbase = brow + wr * 64 + fr, cbase = bcol + wc * 32 + fq * 4;
        switch (d.epi) {
        case E_INPROJ: {
            if (pn == 0) {
#pragma unroll
                EPI_ROWS { const int row = rbase + ai * 128 + m * 16;
#pragma unroll
                    EPI_COLS store_bf4(P->qlat + (long)row * 384 + (cbase + bj * 128 + n * 16), acc[ai][bj][m][n]); }
            } else if (pn == 1) {
#pragma unroll
                EPI_ROWS { const int row = rbase + ai * 128 + m * 16;
#pragma unroll
                    for (int n = 0; n < 2; ++n) store_bf4(P->qlat + (long)row * 384 + 256 + (wc * 32 + fq * 4 + n * 16), acc[ai][0][m][n]);
                    if (wc == 0) {
                        const int pos = pos_of(row);
                        const f32x4 cs0 = *(const f32x4*)(P->ropeT + (long)pos * 32 + fq * 8), cs1 = *(const f32x4*)(P->ropeT + (long)pos * 32 + fq * 8 + 4);
                        const f32x4 x1 = acc[ai][1][m][0], x2 = acc[ai][1][m][1];
                        f32x4 co = {cs0[0], cs0[2], cs1[0], cs1[2]}, si = {cs0[1], cs0[3], cs1[1], cs1[3]};
                        f32x4 o1 = x1 * co - x2 * si, o2 = x2 * co + x1 * si;
                        float* of = P->out + (row < MP ? O_KR_P + (long)row * 32 : O_KR_S + (long)(row - MP) * 32);
                        *(f32x4*)(of + fq * 4) = o1; *(f32x4*)(of + 16 + fq * 4) = o2;
                        bf16_t* ob = P->krope + (long)kvrow_of(row) * 32;
                        store_bf4(ob + fq * 4, o1); store_bf4(ob + 16 + fq * 4, o2);
                    } }
            } else if (pn == 2) {
                float ss[2][4];
#pragma unroll
                EPI_ROWS { float s = 0.f;
#pragma unroll
                    EPI_COLS { const f32x4 v = acc[ai][bj][m][n]; s += v[0] * v[0] + v[1] * v[1] + v[2] * v[2] + v[3] * v[3]; }
                    s += __shfl_xor(s, 16); s += __shfl_xor(s, 32); ss[ai][m] = s;
                    if (fq == 0) xp[(ai * 128 + wr * 64 + m * 16 + fr) * 4 + wc] = s; }
                WAIT_L(0); BAR; asm volatile("" ::: "memory");
#pragma unroll
                EPI_ROWS { const int rl = ai * 128 + wr * 64 + m * 16 + fr, row = brow + rl;
                    const f32x4 pp = *(const f32x4*)(xp + rl * 4);
                    const float rstd = rsqrtf((pp[0] + pp[1] + pp[2] + pp[3]) * (1.0f / 256.0f) + EPS);
                    float* of = P->out + (row < MP ? O_CKV_P + (long)row * 256 : O_CKV_S + (long)(row - MP) * 256);
                    bf16_t* ob = P->latent + (long)kvrow_of(row) * 256;
#pragma unroll
                    EPI_COLS { const int c = wc * 32 + fq * 4 + bj * 128 + n * 16;
                        const f32x4 gv = *(const f32x4*)(P->g_kv + c); const f32x4 o = acc[ai][bj][m][n] * rstd * gv;
                        *(f32x4*)(of + c) = o; store_bf4(ob + c, o); } }
            } else if (pn <= 4) {
#pragma unroll
                EPI_ROWS { const int row = rbase + ai * 128 + m * 16;
#pragma unroll
                    EPI_COLS store_bf4(P->qb + (long)row * 512 + (cbase - 768 + bj * 128 + n * 16), acc[ai][bj][m][n] * 0.125f); }
            } else if (pn <= 6) {
#pragma unroll
                EPI_ROWS { const int row = rbase + ai * 128 + m * 16;
                    float* of = P->out + (row < MP ? O_SBK_P + (long)row * 512 : O_SBK_S + (long)(row - MP) * 512);
                    bf16_t* ob = P->kb + (long)kvrow_of(row) * 512;
#pragma unroll
                    EPI_COLS { const int c = cbase - 1280 + bj * 128 + n * 16; *(f32x4*)(of + c) = acc[ai][bj][m][n]; store_bf4(ob + c, acc[ai][bj][m][n]); } }
            } else {
#pragma unroll
                EPI_ROWS { const int row = rbase + ai * 128 + m * 16;
                    float* of = P->out + (row < MP ? O_SBV_P + (long)row * 512 : O_SBV_S + (long)(row - MP) * 512);
                    const int qi = fr & 3, row4 = row - qi;
                    bf16_t* vt; int ldv;
                    if (row4 < MP) { vt = P->vbT_p + (long)(row4 >> 13) * 512 * TP + (row4 & (TP - 1)); ldv = TP; }
                    else { const int r = row4 - MP; vt = P->vbT_s + (long)(r >> 5) * 512 * SKP + PAST + (r & 31); ldv = SKP; }
#pragma unroll
                    EPI_COLS { const int c = cbase - 1792 + bj * 128 + n * 16; const f32x4 v = acc[ai][bj][m][n]; *(f32x4*)(of + c) = v;
                        store_bf4(vt + (long)(c + qi) * ldv, quad_transpose(v, qi)); } }
            }
        } break;
        case E_GATE: {
#pragma unroll
            EPI_ROWS { const int row = rbase + ai * 128 + m * 16;
#pragma unroll
                EPI_COLS { const f32x4 v = acc[ai][bj][m][n]; f32x4 s = {sigmoidf_(v[0]), sigmoidf_(v[1]), sigmoidf_(v[2]), sigmoidf_(v[3])};
                    store_bf4(P->gates + (long)row * 2048 + (cbase + bj * 128 + n * 16), s); } }
        } break;
        case E_UQ: {
            const float qs = 0.10206207261596577f * LOG2E;
#pragma unroll
            EPI_ROWS { const int rl = ai * 128 + wr * 64 + m * 16 + fr, row = brow + rl; const float rs = xl[rl] * qs;
#pragma unroll
                for (int bj = 0; bj < 2; ++bj) { const int grp = pn * 8 + bj * 4 + wc; bf16_t* dst = P->q + (long)row * 768 + grp * 32 + fq * 4;
                    f32x4 v0 = acc[ai][bj][m][0] * rs, v1 = acc[ai][bj][m][1] * rs;
                    if (grp % 3 == 2) {
                        const int pos = pos_of(row);
                        const f32x4 cs0 = *(const f32x4*)(P->ropeT + (long)pos * 32 + fq * 8), cs1 = *(const f32x4*)(P->ropeT + (long)pos * 32 + fq * 8 + 4);
                        f32x4 co = {cs0[0], cs0[2], cs1[0], cs1[2]}, si = {cs0[1], cs0[3], cs1[1], cs1[3]};
                        const f32x4 o1 = v0 * co - v1 * si, o2 = v1 * co + v0 * si; v0 = o1; v1 = o2;
                    }
                    store_bf4(dst, v0); store_bf4(dst + 16, v1); } }
        } break;
        case E_UKV: {
#pragma unroll
            EPI_ROWS { const int row = rbase + ai * 128 + m * 16;
                if (pn < 2) {
#pragma unroll
                    EPI_COLS store_bf4(P->kva + (long)row * 512 + (cbase + bj * 128 + n * 16), acc[ai][bj][m][n]);
                } else {
                    const int qi = fr & 3, row4 = row - qi;
                    bf16_t* vt; int ldv;
                    if (row4 < MP) { vt = P->vaT_p + (long)(row4 >> 13) * 512 * TP + (row4 & (TP - 1)); ldv = TP; }
                    else { const int r = row4 - MP, b = r / SKEYS; vt = P->vaT_s + (long)b * 512 * SKP + (r - b * SKEYS); ldv = SKP; }
#pragma unroll
                    EPI_COLS { const int c = cbase - 512 + bj * 128 + n * 16; const f32x4 vtr = quad_transpose(acc[ai][bj][m][n], qi);
                        if (row4 < KVROWS) store_bf4(vt + (long)(c + qi) * ldv, vtr); }
                } }
        } break;
        case E_PROJA: case E_PROJB: {
            const int goff = d.epi == E_PROJA ? 0 : 1024;
#pragma unroll
            EPI_ROWS { const int row = rbase + ai * 128 + m * 16;
#pragma unroll
                EPI_COLS { const int c = cbase + bj * 128 + n * 16; const u32x2 gw = *(const u32x2*)(P->gates + (long)row * 2048 + goff + c);
                    f32x4 gv = {bf_lo(gw.x), bf_hi(gw.x), bf_lo(gw.y), bf_hi(gw.y)}; f32x4 v = acc[ai][bj][m][n] * gv;
                    bf16_t* dst = P->merged + (long)row * 1024 + c;
                    if (d.epi == E_PROJB) { const u32x2 pw = *(const u32x2*)dst; f32x4 pv = {bf_lo(pw.x), bf_hi(pw.x), bf_lo(pw.y), bf_hi(pw.y)}; v += pv; }
                    store_bf4(dst, v); } }
        } break;
        case E_PLAIN: {
#pragma unroll
            EPI_ROWS { const int row = rbase + ai * 128 + m * 16;
#pragma unroll
                EPI_COLS store_bf4(d.C + (long)row * d.ldc + (cbase + bj * 128 + n * 16), acc[ai][bj][m][n]); }
        } break;
        case E_UP: {
#pragma unroll
            EPI_ROWS { const int row = rbase + ai * 128 + m * 16;
                float* cf = nullptr;
                if (row < MP) { const int t = row & (TP - 1); if (t >= TP - 2) cf = P->out + O_CONV_P + (long)((row >> 13) * 2 + (t - (TP - 2))) * DFF2; }
                else { const int r = row - MP, t = r & 31; if (t >= 30) cf = P->out + O_CONV_S + (long)((r >> 5) * 2 + (t - 30)) * DFF2; }
#pragma unroll
                EPI_COLS { const int c = cbase + bj * 128 + n * 16; store_bf4(P->u + (long)row * DFF2 + c, acc[ai][bj][m][n]);
                    if (cf) *(f32x4*)(cf + c) = acc[ai][bj][m][n]; } }
        } break;
        }
        }
        if (!has_next) break;
        ZERO_ACC;
        u = un; cA = nA; cB = nB;
        if (wr == 1) BAR;
    }
    WAIT_V(0);
    BAR;
}

#define MFMA32(a, b, c) __builtin_amdgcn_mfma_f32_32x32x16_bf16((a), (b), (c), 0, 0, 0)
template <int KIND, int KSTEPS  >
DI void gemm_small(KP P, const bf16_t* A, int lda, const bf16_t* Bt, int ldb, int N, bf16_t* C, int ldc, char* lds) {
    const int tid = otid(), lane = tid & 63, w = tid >> 6, r = lane & 31, hh = lane >> 5, G = ogrid();
    const int ntask = 8 * (N >> 5);
    float* part = (float*)lds;
    for (int task = obid(); task < ntask; task += G) {
        const int rb = task & 7, cb = task >> 3, row0 = MP + rb * 32, col0 = cb * 32;
#pragma unroll
        for (int pass = 0; pass < (KIND == 2 ? 2 : 1); ++pass) {
            const bf16_t* ap = A + pass * 512 + (long)(row0 + r) * lda + w * (KSTEPS * 16) + 8 * hh;
            const bf16_t* bp = (pass ? P->WpbT : Bt) + (long)(col0 + r) * ldb + w * (KSTEPS * 16) + 8 * hh;
            f32x16 acc;
#pragma unroll
            for (int i = 0; i < 16; ++i) acc[i] = 0.f;
            constexpr int UN = KSTEPS > 11 ? 11 : KSTEPS;
#pragma unroll 1
            for (int s0 = 0; s0 < KSTEPS; s0 += UN) {
                bf16x8 af[UN], bf[UN];
#pragma unroll
                for (int s = 0; s < UN; ++s) { af[s] = *(const bf16x8*)(ap + (s0 + s) * 16); bf[s] = *(const bf16x8*)(bp + (s0 + s) * 16); }
#pragma unroll
                for (int s = 0; s < UN; ++s) acc = MFMA32(bf[s], af[s], acc);
            }
            float* pp = part + ((pass * 8 + w) * 32 + r) * 32 + 4 * hh;
#pragma unroll
            for (int g = 0; g < 4; ++g) *(f32x4*)(pp + 8 * g) = (f32x4){acc[4 * g], acc[4 * g + 1], acc[4 * g + 2], acc[4 * g + 3]};
        }
        __syncthreads();
        {
            const int e = tid * 2, rr = e >> 5, cc = e & 31;
            f32x2 s1 = {0.f, 0.f}, s2 = {0.f, 0.f};
#pragma unroll
            for (int ww = 0; ww < 8; ++ww) { s1 += *(const f32x2*)(part + (ww * 32 + rr) * 32 + cc); if (KIND == 2) s2 += *(const f32x2*)(part + ((8 + ww) * 32 + rr) * 32 + cc); }
            const long row = row0 + rr; const int col = col0 + cc;
            if (KIND == 1) { s1[0] = sigmoidf_(s1[0]); s1[1] = sigmoidf_(s1[1]); }
            if (KIND == 2) { const unsigned ga = *(const unsigned*)(P->gates + row * 2048 + col), gb = *(const unsigned*)(P->gates + row * 2048 + 1024 + col);
                s1[0] = s1[0] * bf_lo(ga) + s2[0] * bf_lo(gb); s1[1] = s1[1] * bf_hi(ga) + s2[1] * bf_hi(gb); }
            *(unsigned*)(C + row * ldc + col) = pk2(s1[0], s1[1]);
        }
        __syncthreads();
    }
}

DI int crow(int i, int h) { return (i & 3) + 8 * (i >> 2) + 4 * h; }

template <int MODE>
DI void attn_unit(KP P, char* lds, bool sample, int b, int h, int ublk) {
    constexpr int DQK = MODE == 0 ? 96 : 64, KS = DQK * 2 + 16, VS = 144, NS = DQK / 16;
    constexpr int KBYTES = 64 * KS, BUF = KBYTES + 64 * VS;
    const int tid = otid(), w = tid >> 6, lane = tid & 63, ql = lane & 31, hh = lane >> 5;
    const int kvrow0 = sample ? MP + b * SKEYS : b * TP;
    const int qrow0 = sample ? MP + b * 32 : b * TP + ublk * 256;
    const int ntiles = sample ? 65 : 4 * (ublk + 1);
    const int t0 = sample ? 0 : ublk * 256 + w * 32, tq = t0 + ql;
    int klim, wmax, wmin;
    if (MODE == 0) { if (sample) { klim = wmax = wmin = SKEYS; } else { klim = ((tq >> 6) + 1) << 6; wmax = (((t0 + 31) >> 6) + 1) << 6; wmin = ((t0 >> 6) + 1) << 6; } }
    else { if (sample) { klim = PAST + tq; wmax = PAST + 31; wmin = PAST; } else { klim = tq; wmax = t0 + 31; wmin = t0; } }
    const bool wactive = sample ? (w == 0) : true;
    const bf16_t* Kp; const bf16_t* Qp; const bf16_t* VT; int ldq; long ldv;
    if (MODE == 0) { Kp = P->kva + (long)kvrow0 * 512 + h * 64; Qp = P->q + (long)qrow0 * 768 + h * 96; ldq = 768;
        VT = sample ? P->vaT_s + (long)(b * 512 + h * 64) * SKP : P->vaT_p + (long)(b * 512 + h * 64) * TP; }
    else { Kp = P->kb + (long)kvrow0 * 512 + h * 64; Qp = P->qb + (long)qrow0 * 512 + h * 64; ldq = 512;
        VT = sample ? P->vbT_s + (long)(b * 512 + h * 64) * SKP : P->vbT_p + (long)(b * 512 + h * 64) * TP; }
    ldv = sample ? SKP : TP;
    const bf16_t* Kr = P->krope + (long)kvrow0 * 32;

    bf16x8 qf[NS];
    if (wactive) {
        const bf16_t* qp = Qp + (long)(w * 32 + ql) * ldq + 8 * hh;
#pragma unroll
        for (int s = 0; s < NS; ++s) qf[s] = *(const bf16x8*)(qp + 16 * s);
    } else {
#pragma unroll
        for (int s = 0; s < NS; ++s) qf[s] = (bf16x8){0, 0, 0, 0, 0, 0, 0, 0};
    }
    f32x16 O0, O1;
#pragma unroll
    for (int i = 0; i < 16; ++i) { O0[i] = 0.f; O1[i] = 0.f; }
    float mrun = -INFINITY, lrun = 0.f, carry = 0.f;
    bool wdone = !wactive;
    volatile int* flags = (volatile int*)(lds + 65536 + 64);

    u32x4 rk0, rk1, rv;
    const int krow_s = tid >> 3, kc_s = tid & 7, rrow_s = tid >> 2, rc_s = tid & 3;
    const bool f32path = (MODE == 1) && sample;
    const float* Kf = P->c_sbk + ((long)b * PAST * 512 + h * 64); const float* Vf = P->c_sbv + ((long)b * PAST * 512 + h * 64);
    auto load_tile = [&](int kt) {
        if (f32path && kt < 64) {
            const float* kp_ = Kf + (long)(kt * 64 + krow_s) * 512 + kc_s * 8; const float* vp_ = Vf + (long)(kt * 64 + krow_s) * 512 + kc_s * 8;
            const f32x4 a0 = *(const f32x4*)kp_, a1 = *(const f32x4*)(kp_ + 4), c0 = *(const f32x4*)vp_, c1 = *(const f32x4*)(vp_ + 4);
            rk0.x = pk2(a0[0], a0[1]); rk0.y = pk2(a0[2], a0[3]); rk0.z = pk2(a1[0], a1[1]); rk0.w = pk2(a1[2], a1[3]);
            rv.x = pk2(c0[0], c0[1]); rv.y = pk2(c0[2], c0[3]); rv.z = pk2(c1[0], c1[1]); rv.w = pk2(c1[2], c1[3]);
            return;
        }
        rk0 = *(const u32x4*)(Kp + (long)(kt * 64 + krow_s) * 512 + kc_s * 8);
        if (MODE == 0 && tid < 256) rk1 = *(const u32x4*)(Kr + (long)(kt * 64 + rrow_s) * 32 + rc_s * 8);
        rv = *(const u32x4*)(VT + (long)krow_s * ldv + kt * 64 + kc_s * 8);
    };
    auto store_tile = [&](int buf, int kt) {
        char* kb_ = lds + buf * BUF; char* vb_ = kb_ + KBYTES;
        *(u32x4*)(kb_ + krow_s * KS + kc_s * 16) = rk0;
        if (f32path && kt < 64) {
#pragma unroll
            for (int e = 0; e < 4; ++e) { *(bf16_t*)(vb_ + (kc_s * 8 + 2 * e) * VS + krow_s * 2) = (bf16_t)(rv[e] & 0xffff); *(bf16_t*)(vb_ + (kc_s * 8 + 2 * e + 1) * VS + krow_s * 2) = (bf16_t)(rv[e] >> 16); }
            return;
        }
        if (MODE == 0 && tid < 256) *(u32x4*)(kb_ + rrow_s * KS + 128 + rc_s * 16) = rk1;
        *(u32x4*)(vb_ + krow_s * VS + kc_s * 16) = rv;
    };
    load_tile(ntiles - 1); store_tile(0, ntiles - 1);
    __syncthreads();
    for (int it = 0; it < ntiles; ++it) {
        const int kt = ntiles - 1 - it, cur = it & 1;
        if (it + 1 < ntiles) load_tile(kt - 1);
        if (wactive && !wdone && kt * 64 < wmax) {
            const char* kb_ = lds + cur * BUF; const char* vb_ = kb_ + KBYTES;
            f32x16 S0, S1;
#pragma unroll
            for (int i = 0; i < 16; ++i) { S0[i] = 0.f; S1[i] = 0.f; }
#pragma unroll
            for (int s = 0; s < NS; ++s) {
                const bf16x8 k0 = *(const bf16x8*)(kb_ + ql * KS + (16 * s + 8 * hh) * 2);
                const bf16x8 k1 = *(const bf16x8*)(kb_ + (32 + ql) * KS + (16 * s + 8 * hh) * 2);
                S0 = MFMA32(k0, qf[s], S0); S1 = MFMA32(k1, qf[s], S1);
            }
            const bool need_mask = (kt * 64 + 64 > wmin);
            const int kbase = kt * 64 + 4 * hh;
            if (MODE == 0) {
                if (need_mask) {
#pragma unroll
                    for (int i = 0; i < 16; ++i) { const int key = kbase + (i & 3) + 8 * (i >> 2);
                        if (key >= klim) S0[i] = -INFINITY; if (key + 32 >= klim) S1[i] = -INFINITY; }
                }
                float mx = S0[0];
#pragma unroll
                for (int i = 1; i < 16; ++i) mx = fmaxf(mx, S0[i]);
#pragma unroll
                for (int i = 0; i < 16; ++i) mx = fmaxf(mx, S1[i]);
                mx = fmaxf(mx, __shfl_xor(mx, 32));
                const float mnew = fmaxf(mrun, mx);
                const float alpha = __builtin_amdgcn_exp2f(mrun - mnew);
                mrun = mnew;
                float ps = 0.f;
#pragma unroll
                for (int i = 0; i < 16; ++i) { S0[i] = __builtin_amdgcn_exp2f(S0[i] - mnew); S1[i] = __builtin_amdgcn_exp2f(S1[i] - mnew); ps += S0[i] + S1[i]; }
                lrun = lrun * alpha + ps;
#pragma unroll
                for (int i = 0; i < 16; ++i) { O0[i] *= alpha; O1[i] *= alpha; }
            } else {
                float gs[2][4], gp[2][4];
                f32x16 SP0, SP1;
#pragma unroll
                for (int i = 0; i < 16; ++i) { const int key = kbase + (i & 3) + 8 * (i >> 2);
                    { const float z = S0[i]; const float t = __builtin_amdgcn_exp2f(-fabsf(z) * LOG2E); float sp = fmaxf(z, 0.f) + LN2 * __builtin_amdgcn_logf(1.0f + t);
                      if (need_mask && key >= klim) sp = 0.f; SP0[i] = sp; }
                    { const float z = S1[i]; const float t = __builtin_amdgcn_exp2f(-fabsf(z) * LOG2E); float sp = fmaxf(z, 0.f) + LN2 * __builtin_amdgcn_logf(1.0f + t);
                      if (need_mask && key + 32 >= klim) sp = 0.f; SP1[i] = sp; } }
#pragma unroll
                for (int g = 0; g < 4; ++g) { gs[0][g] = (SP0[4 * g] + SP0[4 * g + 1]) + (SP0[4 * g + 2] + SP0[4 * g + 3]);
                    gs[1][g] = (SP1[4 * g] + SP1[4 * g + 1]) + (SP1[4 * g + 2] + SP1[4 * g + 3]); }
#pragma unroll
                for (int g = 0; g < 4; ++g) { gp[0][g] = __shfl_xor(gs[0][g], 32); gp[1][g] = __shfl_xor(gs[1][g], 32); }
                float running = carry;
#pragma unroll
                for (int blk = 1; blk >= 0; --blk)
#pragma unroll
                    for (int g = 3; g >= 0; --g) {
                        const float sum1 = hh ? gs[blk][g] : gp[blk][g], sum0 = hh ? gp[blk][g] : gs[blk][g];
                        const float mybase = hh ? running : running + sum1;
                        running += sum0 + sum1;
                        float later = mybase;
#pragma unroll
                        for (int j = 3; j >= 0; --j) { const int i = 4 * g + j; const int key = kbase + j + 8 * g + 32 * blk;
                            const float z = blk ? S1[i] : S0[i], sp = blk ? SP1[i] : SP0[i];
                            float a = __builtin_amdgcn_exp2f((z - sp - later) * LOG2E);
                            if (need_mask && key >= klim) a = 0.f;
                            later += sp;
                            if (blk) S1[i] = a; else S0[i] = a; }
                    }
                carry = running;
                wdone = __all((carry > 104.0f) || (klim <= 0));
            }
            bf16x8 pf[2][2];
#pragma unroll
            for (int s = 0; s < 2; ++s) {
                u32x4 a, c;
                a.x = pk2(S0[8 * s], S0[8 * s + 1]); a.y = pk2(S0[8 * s + 2], S0[8 * s + 3]); a.z = pk2(S0[8 * s + 4], S0[8 * s + 5]); a.w = pk2(S0[8 * s + 6], S0[8 * s + 7]);
                c.x = pk2(S1[8 * s], S1[8 * s + 1]); c.y = pk2(S1[8 * s + 2], S1[8 * s + 3]); c.z = pk2(S1[8 * s + 4], S1[8 * s + 5]); c.w = pk2(S1[8 * s + 6], S1[8 * s + 7]);
                pf[0][s] = __builtin_bit_cast(bf16x8, a); pf[1][s] = __builtin_bit_cast(bf16x8, c);
            }
#pragma unroll
            for (int blk = 0; blk < 2; ++blk)
#pragma unroll
                for (int s = 0; s < 2; ++s) {
                    const int koff = (32 * blk + 16 * s + 4 * hh) * 2;
                    const s16x4 lo0 = *(const s16x4*)(vb_ + ql * VS + koff), hi0 = *(const s16x4*)(vb_ + ql * VS + koff + 16);
                    const s16x4 lo1 = *(const s16x4*)(vb_ + (32 + ql) * VS + koff), hi1 = *(const s16x4*)(vb_ + (32 + ql) * VS + koff + 16);
                    const bf16x8 v0 = __builtin_shufflevector(lo0, hi0, 0, 1, 2, 3, 4, 5, 6, 7), v1 = __builtin_shufflevector(lo1, hi1, 0, 1, 2, 3, 4, 5, 6, 7);
                    O0 = MFMA32(v0, pf[blk][s], O0); O1 = MFMA32(v1, pf[blk][s], O1);
                }
        }
        if (it + 1 < ntiles) store_tile(cur ^ 1, kt - 1);
        if (MODE == 1 && lane == 0) flags[(it & 1) * 8 + w] = wdone ? 1 : 0;
        __syncthreads();
        if (MODE == 1) { int alld = 1;
#pragma unroll
            for (int ww = 0; ww < 8; ++ww) alld &= flags[(it & 1) * 8 + ww];
            if (alld) break; }
    }
    if (wactive) {
        float inv = 1.0f;
        if (MODE == 0) { const float lt = lrun + __shfl_xor(lrun, 32); inv = 1.0f / lt; }
        bf16_t* op = P->o + (long)(qrow0 + w * 32 + ql) * 1024 + (MODE == 0 ? 0 : 512) + h * 64 + 4 * hh;
#pragma unroll
        for (int g = 0; g < 4; ++g) {
            f32x4 a = {O0[4 * g] * inv, O0[4 * g + 1] * inv, O0[4 * g + 2] * inv, O0[4 * g + 3] * inv};
            f32x4 c = {O1[4 * g] * inv, O1[4 * g + 1] * inv, O1[4 * g + 2] * inv, O1[4 * g + 3] * inv};
            store_bf4(op + 8 * g, a); store_bf4(op + 32 + 8 * g, c);
        }
    }
}

DI void attn_phase(KP P, char* lds, int cidx) {
    unsigned* slot = (unsigned*)(lds + 65536);
    for (;;) {
        if (threadIdx.x == 0) *slot = atomicAdd(P->ctr + cidx, 1u);
        __syncthreads();
        const unsigned idx = *slot;
        __syncthreads();
        if (idx >= 1152u) break;
        bool sample; int mode, b, h, ublk = 0;
        if (idx < 128u) { sample = true; mode = idx >> 6; b = (idx >> 3) & 7; h = idx & 7; }
        else { const int j = idx - 128; sample = false; ublk = 31 - (j >> 5); const int r = j & 31; mode = r >> 4; b = (r >> 3) & 1; h = r & 7; }
        if (mode == 0) attn_unit<0>(P, lds, sample, b, h, ublk); else attn_unit<1>(P, lds, sample, b, h, ublk);
    }
}

DI void phase0(KP P, char* lds) {
    const int tid = otid(), G = ogrid(), bid = obid(), w = tid >> 6, lane = tid & 63;
    for (int item = bid; item < 96; item += G) {
        float* sc = (float*)lds; float* red = (float*)(lds + 40960);
        for (int i = tid; i < 10240; i += NTHREADS) { const int bb = i >> 10, k = i & 1023; const float cv = bb < 2 ? P->c_p[bb * 1024 + k] : P->c_s[(bb - 2) * 1024 + k]; sc[i] = cv / (1.0f + __expf(-cv)); }
        __syncthreads();
        const int col = item * 64 + lane;
        float a0 = 0, a1 = 0, a2 = 0, a3 = 0, a4 = 0, a5 = 0, a6 = 0, a7 = 0, a8 = 0, a9 = 0;
        for (int k0 = w * 128; k0 < w * 128 + 128; k0 += 16) {
            float wv[16];
#pragma unroll
            for (int j = 0; j < 16; ++j) wv[j] = P->w_ada[(long)(k0 + j) * 6144 + col];
#pragma unroll
            for (int j = 0; j < 16; ++j) { const int k = k0 + j;
                a0 += sc[k] * wv[j]; a1 += sc[1024 + k] * wv[j]; a2 += sc[2048 + k] * wv[j]; a3 += sc[3072 + k] * wv[j]; a4 += sc[4096 + k] * wv[j];
                a5 += sc[5120 + k] * wv[j]; a6 += sc[6144 + k] * wv[j]; a7 += sc[7168 + k] * wv[j]; a8 += sc[8192 + k] * wv[j]; a9 += sc[9216 + k] * wv[j]; }
        }
        float* rr = red + w * 640 + lane;
        rr[0] = a0; rr[64] = a1; rr[128] = a2; rr[192] = a3; rr[256] = a4; rr[320] = a5; rr[384] = a6; rr[448] = a7; rr[512] = a8; rr[576] = a9;
        __syncthreads();
        for (int i = tid; i < 640; i += NTHREADS) { float s = 0.f; for (int ww = 0; ww < 8; ++ww) s += red[ww * 640 + i];
            const int bb = i >> 6, l = i & 63; P->ada[bb * 6144 + item * 64 + l] = s + P->b_ada[item * 64 + l]; }
        __syncthreads();
    }
    {
        float* tile = (float*)lds;
        for (int it = (bid + 96) % G; it < P->ntj_tiles; it += G) {
            int j = 0;
#pragma unroll 1
            for (int q = 1; q < P->pad0; ++q) if (it >= P->tj[q].tile0) j = q;
            TJob J; J.src = P->tj[j].src; J.kscale = P->tj[j].kscale; J.dst = P->tj[j].dst; J.lds = P->tj[j].lds; J.coff = P->tj[j].coff; J.ldd = P->tj[j].ldd;
            J.Klen = P->tj[j].Klen; J.Nlen = P->tj[j].Nlen; J.zero = P->tj[j].zero; J.tile0 = P->tj[j].tile0;
            const int lt = it - J.tile0, nk = J.Klen >> 6, tk = lt % nk, tn = lt / nk, k0 = tk * 64, n0 = tn * 256;
            f32x4 lv[8];
#pragma unroll
            for (int r = 0; r < 8; ++r) { const int e = tid + r * NTHREADS, kk = e >> 6, n4 = (e & 63) * 4;
                lv[r] = (f32x4){0.f, 0.f, 0.f, 0.f};
                if (!J.zero && n0 + n4 < J.Nlen) lv[r] = *(const f32x4*)(J.src + (long)(k0 + kk) * J.lds + J.coff + n0 + n4); }
#pragma unroll
            for (int r = 0; r < 8; ++r) { const int e = tid + r * NTHREADS, kk = e >> 6, n4 = (e & 63) * 4;
                f32x4 v = lv[r]; if (J.kscale) v *= J.kscale[k0 + kk];
                float* tp = tile + kk * 257 + n4; tp[0] = v[0]; tp[1] = v[1]; tp[2] = v[2]; tp[3] = v[3]; }
            __syncthreads();
#pragma unroll
            for (int r = 0; r < 4; ++r) { const int e = tid + r * NTHREADS, nn = e >> 3, kc = (e & 7) * 8;
                if (n0 + nn < J.Nlen) { const float* tp = tile + kc * 257 + nn; u32x4 o;
                    o.x = pk2(tp[0], tp[257]); o.y = pk2(tp[2 * 257], tp[3 * 257]); o.z = pk2(tp[4 * 257], tp[5 * 257]); o.w = pk2(tp[6 * 257], tp[7 * 257]);
                    *(u32x4*)(J.dst + (long)(n0 + nn) * J.ldd + k0 + kc) = o; } }
            __syncthreads();
        }
    }
    const long gt = (long)bid * NTHREADS + tid, gn = (long)G * NTHREADS;
    for (long i0 = gt; i0 < 8L * PAST * 64; i0 += 4 * gn) { f32x4 v[4];
#pragma unroll
        for (int r = 0; r < 4; ++r) { const long i = i0 + r * gn; if (i < 8L * PAST * 64) v[r] = *(const f32x4*)(P->c_ckv + i * 4); }
#pragma unroll
        for (int r = 0; r < 4; ++r) { const long i = i0 + r * gn; if (i < 8L * PAST * 64) { const long row = i >> 6; const int c = (int)(i & 63) * 4; const int bb = (int)(row >> 12), sq = (int)(row & 4095);
            store_bf4(P->latent + (long)(MP + bb * SKEYS + sq) * 256 + c, v[r]); } } }
    for (long i0 = gt; i0 < 8L * PAST * 8; i0 += 4 * gn) { f32x4 v[4];
#pragma unroll
        for (int r = 0; r < 4; ++r) { const long i = i0 + r * gn; if (i < 8L * PAST * 8) v[r] = *(const f32x4*)(P->c_kr + i * 4); }
#pragma unroll
        for (int r = 0; r < 4; ++r) { const long i = i0 + r * gn; if (i < 8L * PAST * 8) { const long row = i >> 3; const int c = (int)(i & 7) * 4; const int bb = (int)(row >> 12), sq = (int)(row & 4095);
            store_bf4(P->krope + (long)(MP + bb * SKEYS + sq) * 32 + c, v[r]); } } }
    for (long i = gt; i < 8L * 512 * 8; i += gn) { const long r = i >> 3; const int c = (int)(i & 7) * 4; const u32x2 z = {0u, 0u};
        *(u32x2*)(P->vaT_s + r * SKP + SKEYS + c) = z; *(u32x2*)(P->vbT_s + r * SKP + SKEYS + c) = z; }
    for (long i = gt; i < (long)TP * 16; i += gn) { const int pos = (int)(i >> 4), fi = (int)(i & 15);
        const float inv = exp2f(-(float)fi * (13.287712379549449f / 16.0f));
        const float ang = (float)pos * inv;
        const double rev = (double)ang * 0.15915494309189535; const float fr_ = (float)(rev - floor(rev));
        P->ropeT[i * 2] = __builtin_amdgcn_cosf(fr_); P->ropeT[i * 2 + 1] = __builtin_amdgcn_sinf(fr_); }
}

DI void phase_h(KP P) {
    const int tid_ = otid(), lane = tid_ & 63, gw = obid() * 8 + (tid_ >> 6), nw = ogrid() * 8;
    for (int row = gw; row < MT; row += nw) {
        const float* xr = row < MP ? P->x_p + (long)row * DM : P->x_s + (long)(row - MP) * DM;
        const float* ad = P->ada + ada_b(row) * 6144;
        f32x4 v[4]; float s = 0.f;
#pragma unroll
        for (int i = 0; i < 4; ++i) { v[i] = *(const f32x4*)(xr + i * 256 + lane * 4); s += v[i][0] * v[i][0] + v[i][1] * v[i][1] + v[i][2] * v[i][2] + v[i][3] * v[i][3]; }
#pragma unroll
        for (int o = 1; o < 64; o <<= 1) s += __shfl_xor(s, o);
        const float rstd = rsqrtf(s * (1.0f / DM) + EPS);
#pragma unroll
        for (int i = 0; i < 4; ++i) { const int c = i * 256 + lane * 4;
            const f32x4 g = *(const f32x4*)(P->g_pre_mix + c), sh = *(const f32x4*)(ad + c), scl = *(const f32x4*)(ad + 1024 + c);
            store_bf4(P->h + (long)row * DM + c, v[i] * rstd * g * (1.0f + scl) + sh); }
    }
}

DI void phase_mid(KP P) {
    const int tid_ = otid(), lane = tid_ & 63, gw = obid() * 8 + (tid_ >> 6), nw = ogrid() * 8;
    for (int row = gw; row < MT; row += nw) {
        const float* xr = row < MP ? P->x_p + (long)row * DM : P->x_s + (long)(row - MP) * DM;
        const float* ad = P->ada + ada_b(row) * 6144;
        f32x4 mv[4]; float s = 0.f;
#pragma unroll
        for (int i = 0; i < 4; ++i) { const u32x2 wv = *(const u32x2*)(P->m2 + (long)row * DM + i * 256 + lane * 4);
            mv[i] = (f32x4){bf_lo(wv.x), bf_hi(wv.x), bf_lo(wv.y), bf_hi(wv.y)}; s += mv[i][0] * mv[i][0] + mv[i][1] * mv[i][1] + mv[i][2] * mv[i][2] + mv[i][3] * mv[i][3]; }
#pragma unroll
        for (int o = 1; o < 64; o <<= 1) s += __shfl_xor(s, o);
        const float rstd = rsqrtf(s * (1.0f / DM) + EPS);
        float s2 = 0.f;
#pragma unroll
        for (int i = 0; i < 4; ++i) { const int c = i * 256 + lane * 4;
            const f32x4 xv = *(const f32x4*)(xr + c), g = *(const f32x4*)(P->g_post_mix + c), gt = *(const f32x4*)(ad + 2048 + c);
            mv[i] = xv + gt * (mv[i] * rstd * g);
            *(f32x4*)(P->out + O_Y + (long)row * DM + c) = mv[i];
            s2 += mv[i][0] * mv[i][0] + mv[i][1] * mv[i][1] + mv[i][2] * mv[i][2] + mv[i][3] * mv[i][3]; }
#pragma unroll
        for (int o = 1; o < 64; o <<= 1) s2 += __shfl_xor(s2, o);
        const float rstd2 = rsqrtf(s2 * (1.0f / DM) + EPS);
#pragma unroll
        for (int i = 0; i < 4; ++i) { const int c = i * 256 + lane * 4;
            const f32x4 g = *(const f32x4*)(P->g_pre_ffn + c), sh = *(const f32x4*)(ad + 3072 + c), scl = *(const f32x4*)(ad + 4096 + c);
            store_bf4(P->h2 + (long)row * DM + c, mv[i] * rstd2 * g * (1.0f + scl) + sh); }
    }
}

DI void phase_final(KP P) {
    const int tid_ = otid(), lane = tid_ & 63, gw = obid() * 8 + (tid_ >> 6), nw = ogrid() * 8;
    for (int row = gw; row < MT; row += nw) {
        const float* ad = P->ada + ada_b(row) * 6144;
        f32x4 fv[4]; float s = 0.f;
#pragma unroll
        for (int i = 0; i < 4; ++i) { const u32x2 wv = *(const u32x2*)(P->f + (long)row * DM + i * 256 + lane * 4);
            fv[i] = (f32x4){bf_lo(wv.x), bf_hi(wv.x), bf_lo(wv.y), bf_hi(wv.y)}; s += fv[i][0] * fv[i][0] + fv[i][1] * fv[i][1] + fv[i][2] * fv[i][2] + fv[i][3] * fv[i][3]; }
#pragma unroll
        for (int o = 1; o < 64; o <<= 1) s += __shfl_xor(s, o);
        const float rstd = rsqrtf(s * (1.0f / DM) + EPS);
#pragma unroll
        for (int i = 0; i < 4; ++i) { const int c = i * 256 + lane * 4; float* yp = P->out + O_Y + (long)row * DM + c;
            const f32x4 xv = *(const f32x4*)yp, g = *(const f32x4*)(P->g_post_ffn + c), gt = *(const f32x4*)(ad + 5120 + c);
            *(f32x4*)yp = xv + gt * (fv[i] * rstd * g); }
    }
}

DI float gelu_tanh(float a) { const float t = 0.7978845608028654f * (a + 0.044715f * a * a * a); const float e = __expf(2.0f * t); return 0.5f * a * (2.0f - 2.0f / (1.0f + e)); }

DI void phase_conv(KP P) {
    const long gt = (long)obid() * NTHREADS + otid(), gn = (long)ogrid() * NTHREADS;
    for (long i = gt; i < (long)(MT / 8) * 352; i += gn) {
        const int rg = (int)(i / 352), c = (int)(i % 352) * 8, row0 = rg * 8;
        int t0, bs = -1; if (row0 < MP) t0 = row0 & (TP - 1); else { t0 = (row0 - MP) & 31; bs = (row0 - MP) >> 5; }
        u32x4 ua[10], ub[10];
#pragma unroll
        for (int r = 0; r < 10; ++r) { const int rr = (t0 == 0 && r < 2) ? row0 : row0 + r - 2;
            ua[r] = *(const u32x4*)(P->u + (long)rr * DFF2 + c); ub[r] = *(const u32x4*)(P->u + (long)rr * DFF2 + DFF + c); }
        float wa[3][8], wb[3][8], ba[8], bb[8];
#pragma unroll
        for (int tap = 0; tap < 3; ++tap) { const f32x4 x0 = *(const f32x4*)(P->conv_w + tap * DFF2 + c), x1 = *(const f32x4*)(P->conv_w + tap * DFF2 + c + 4);
            const f32x4 y0 = *(const f32x4*)(P->conv_w + tap * DFF2 + DFF + c), y1 = *(const f32x4*)(P->conv_w + tap * DFF2 + DFF + c + 4);
#pragma unroll
            for (int e = 0; e < 4; ++e) { wa[tap][e] = x0[e]; wa[tap][4 + e] = x1[e]; wb[tap][e] = y0[e]; wb[tap][4 + e] = y1[e]; } }
        { const f32x4 x0 = *(const f32x4*)(P->conv_b + c), x1 = *(const f32x4*)(P->conv_b + c + 4), y0 = *(const f32x4*)(P->conv_b + DFF + c), y1 = *(const f32x4*)(P->conv_b + DFF + c + 4);
#pragma unroll
          for (int e = 0; e < 4; ++e) { ba[e] = x0[e]; ba[4 + e] = x1[e]; bb[e] = y0[e]; bb[4 + e] = y1[e]; } }
        float ha[2][8], hb[2][8];
#pragma unroll
        for (int r = 0; r < 2; ++r)
#pragma unroll
            for (int e = 0; e < 4; ++e) { ha[r][2 * e] = bf_lo(ua[r][e]); ha[r][2 * e + 1] = bf_hi(ua[r][e]); hb[r][2 * e] = bf_lo(ub[r][e]); hb[r][2 * e + 1] = bf_hi(ub[r][e]); }
        if (t0 == 0) {
            if (bs >= 0) {
#pragma unroll
                for (int r = 0; r < 2; ++r) { const float* sp = P->c_conv + (long)(bs * 2 + r) * DFF2 + c;
#pragma unroll
                    for (int e = 0; e < 8; ++e) { ha[r][e] = sp[e]; hb[r][e] = sp[DFF + e]; } }
            } else {
#pragma unroll
                for (int r = 0; r < 2; ++r)
#pragma unroll
                    for (int e = 0; e < 8; ++e) { ha[r][e] = 0.f; hb[r][e] = 0.f; }
            }
        }
        float pa2[8], pa1[8], pb2[8], pb1[8];
#pragma unroll
        for (int e = 0; e < 8; ++e) { pa2[e] = ha[0][e]; pa1[e] = ha[1][e]; pb2[e] = hb[0][e]; pb1[e] = hb[1][e]; }
#pragma unroll
        for (int r = 0; r < 8; ++r) {
            float ca[8], cb[8];
#pragma unroll
            for (int e = 0; e < 4; ++e) { ca[2 * e] = bf_lo(ua[r + 2][e]); ca[2 * e + 1] = bf_hi(ua[r + 2][e]); cb[2 * e] = bf_lo(ub[r + 2][e]); cb[2 * e + 1] = bf_hi(ub[r + 2][e]); }
            u32x4 ov;
#pragma unroll
            for (int e = 0; e < 4; ++e) {
                const float ya0 = ba[2 * e] + wa[0][2 * e] * pa2[2 * e] + wa[1][2 * e] * pa1[2 * e] + wa[2][2 * e] * ca[2 * e];
                const float ya1 = ba[2 * e + 1] + wa[0][2 * e + 1] * pa2[2 * e + 1] + wa[1][2 * e + 1] * pa1[2 * e + 1] + wa[2][2 * e + 1] * ca[2 * e + 1];
                const float yb0 = bb[2 * e] + wb[0][2 * e] * pb2[2 * e] + wb[1][2 * e] * pb1[2 * e] + wb[2][2 * e] * cb[2 * e];
                const float yb1 = bb[2 * e + 1] + wb[0][2 * e + 1] * pb2[2 * e + 1] + wb[1][2 * e + 1] * pb1[2 * e + 1] + wb[2][2 * e + 1] * cb[2 * e + 1];
                ov[e] = pk2(gelu_tanh(ya0) * yb0, gelu_tanh(ya1) * yb1); }
            *(u32x4*)(P->g + (long)(row0 + r) * DFF + c) = ov;
#pragma unroll
            for (int e = 0; e < 8; ++e) { pa2[e] = pa1[e]; pa1[e] = ca[e]; pb2[e] = pb1[e]; pb1[e] = cb[e]; }
        }
    }
}

#define XB_TMO      128
#define XB_XCNT(j)  (256  + 64 * (j))
#define XB_XSUB(j)  (1280 + 64 * (j))
#define XB_XGEN(j)  (2304 + 64 * (j))
#define XB_TOP      3328
#define XB_TOPGEN   3392
#define XCD_BAR_WORDS 3456
#define XB_SPIN_CAP (1u << 18)
DI unsigned xb_ld(unsigned* p)              { return __hip_atomic_load(p, __ATOMIC_RELAXED, __HIP_MEMORY_SCOPE_AGENT); }
DI unsigned xb_add(unsigned* p, unsigned v) { return __hip_atomic_fetch_add(p, v, __ATOMIC_RELAXED, __HIP_MEMORY_SCOPE_AGENT); }
DI unsigned xb_xcc_id() { return (unsigned)__builtin_amdgcn_s_getreg((3 << 11) | 20) & 0xFu; }
#define XB_SPIN(cond, bar) do { unsigned _sp = 0; while (cond) { __builtin_amdgcn_s_sleep(1); \
    if ((++_sp & 255u) == 0u) { if (xb_ld(&(bar)[XB_TMO])) break; if (_sp > XB_SPIN_CAP) { atomicAdd(&(bar)[XB_TMO], 1u); break; } } } } while (0)
DI void xcd_barrier_complete(unsigned* bar, unsigned x, unsigned& nloc, unsigned& nx) {
    const unsigned G = gridDim.x;
    unsigned sum, cnt, mine, sp = 0u;
    for (;;) {
        sum = 0u; cnt = 0u; mine = 0u;
#pragma unroll
        for (unsigned j = 0; j < 16; ++j) { const unsigned c = xb_ld(&bar[XB_XCNT(j)]); sum += c; cnt += (c > 0u) ? 1u : 0u; mine = (j == x) ? c : mine; }
        if (sum == G) break;
        __builtin_amdgcn_s_sleep(1);
        if ((++sp & 255u) == 0u) { if (xb_ld(&bar[XB_TMO])) break; if (sp > XB_SPIN_CAP) { atomicAdd(&bar[XB_TMO], 1u); break; } }
    }
    nloc = mine > 0u ? mine : 1u; nx = cnt > 0u ? cnt : 1u;
}
DI void grid_barrier(char* lds) {
    asm volatile("s_waitcnt vmcnt(0)" ::: "memory");
    __syncthreads();
    if (threadIdx.x == 0) {
        unsigned* bar = kparams()->bar; const unsigned x = xb_xcc_id();
        volatile LAS unsigned* st = (volatile LAS unsigned*)(lds + 131072 + 2048);
        __builtin_amdgcn_s_waitcnt(0);
        unsigned nloc = st[0], nx = st[1];
        if (nloc == 0u) { xcd_barrier_complete(bar, x, nloc, nx); st[0] = nloc; st[1] = nx; }
        const unsigned old = xb_add(&bar[XB_XSUB(x)], 1u);
        const unsigned gen = old / nloc;
        if (old + 1u == (gen + 1u) * nloc) {
            __builtin_amdgcn_fence(__ATOMIC_RELEASE, "agent");
            asm volatile("s_waitcnt vmcnt(0)" ::: "memory");
            const unsigned og = xb_add(&bar[XB_TOP], 1u);
            const unsigned tg = og / nx;
            if (og + 1u == (tg + 1u) * nx) xb_add(&bar[XB_TOPGEN], 1u);
            else XB_SPIN(xb_ld(&bar[XB_TOPGEN]) == tg, bar);
            __builtin_amdgcn_fence(__ATOMIC_ACQUIRE, "agent");
            xb_add(&bar[XB_XGEN(x)], 1u);
            asm volatile("s_waitcnt vmcnt(0)" ::: "memory");
        } else {
            XB_SPIN(xb_ld(&bar[XB_XGEN(x)]) == gen, bar);
            __builtin_amdgcn_fence(__ATOMIC_ACQUIRE, "agent");
            asm volatile("s_waitcnt vmcnt(0)" ::: "memory");
        }
    }
    __syncthreads();
}

__global__ void __launch_bounds__(NTHREADS) fwd_megakernel(Params Pval) {
    extern __shared__ __attribute__((aligned(16))) char lds[];
    cg::grid_group grid = cg::this_grid();
    const int lo = kparams()->phase_lo, hi = kparams()->phase_hi;
#define PH(n) if (lo <= (n) && (n) < hi)
#define SYNC(n) if (lo <= (n) && (n) + 1 < hi) grid_barrier(lds)
    if (hi > 1000) grid.sync();
    { volatile LAS unsigned* st = (volatile LAS unsigned*)(lds + 131072 + 2048);
      if (threadIdx.x == 0) { st[0] = 0u; st[1] = 0u; }
      __syncthreads();
      if (threadIdx.x == 0) (void)xb_add(&kparams()->bar[XB_XCNT(xb_xcc_id())], 1u); }
    PH(0) phase0(kparams(), lds);
#ifdef PROBE_P0
    __syncthreads(); phase0(kparams(), lds);
#endif
#ifdef PROBE_SYNC
    for (int i = 0; i < 24; ++i) grid_barrier(lds);
#endif
    SYNC(0);
    PH(1) phase_h(kparams());
#ifdef PROBE_ROWS
    phase_h(kparams());
#endif
    SYNC(1);
    for (int ph = 2; ph <= 12; ++ph) {
        if (ph == 4) { PH(4) attn_phase(kparams(), lds, 0);
#ifdef PROBE_ATTN2
            __syncthreads(); attn_phase(kparams(), lds, 1);
#endif
            SYNC(4); continue; }
        if (ph == 8) { PH(8) phase_mid(kparams());
#ifdef PROBE_ROWS
            phase_mid(kparams());
#endif
            SYNC(8); continue; }
        if (ph == 10) { PH(10) phase_conv(kparams());
#ifdef PROBE_CONV
            phase_conv(kparams());
#endif
            SYNC(10); continue; }
        if (ph == 12) { PH(12) phase_final(kparams()); continue; }
        if (lo <= ph && ph < hi) {
            const int npass = (ph == 3 || ph == 6) ? 2 : 1;
            for (int pass = 0; pass < npass; ++pass) {
                GemmDesc d; d.C = nullptr; d.ldc = 0; d.start = 0; KP P = kparams();
                switch (ph) {
                case 2: d.A = P->h; d.lda = DM; d.Bt = P->WinT; d.ldb = DM; d.K = DM; d.nM = 65; d.nN = 9; d.epi = E_INPROJ; break;
                case 3: if (pass == 0) { d.A = P->qlat; d.lda = 384; d.Bt = P->WuqT; d.ldb = 384; d.K = 384; d.nM = 65; d.nN = 3; d.epi = E_UQ; }
                        else { d.A = P->latent; d.lda = 256; d.Bt = P->WukvT; d.ldb = 256; d.K = 256; d.nM = 193; d.nN = 4; d.epi = E_UKV; d.start = 195; } break;
                case 5: d.A = P->h; d.lda = DM; d.Bt = P->WgT; d.ldb = DM; d.K = DM; d.nM = 64; d.nN = 8; d.epi = E_GATE; break;
                case 6: d.A = P->o + pass * 512; d.lda = DM; d.Bt = pass ? P->WpbT : P->WpaT; d.ldb = 512; d.K = 512; d.nM = 64; d.nN = 4; d.epi = pass ? E_PROJB : E_PROJA; break;
                case 7: d.A = P->merged; d.lda = DM; d.Bt = P->WoutT; d.ldb = DM; d.K = DM; d.nM = 64; d.nN = 4; d.epi = E_PLAIN; d.C = P->m2; d.ldc = DM; break;
                case 9: d.A = P->h2; d.lda = DM; d.Bt = P->WupT; d.ldb = DM; d.K = DM; d.nM = 65; d.nN = 22; d.epi = E_UP; break;
                default: d.A = P->g; d.lda = DFF; d.Bt = P->WdownT; d.ldb = DFF; d.K = DFF; d.nM = 64; d.nN = 4; d.epi = E_PLAIN; d.C = P->f; d.ldc = DM; break;
                }
                gemm_run(d, lds);
#ifdef PROBE_GEMM2
                if (ph == PROBE_GEMM2 && !(ph == 6 && pass == 0)) { __syncthreads(); if (ph == 6) { GemmDesc d0 = d; d0.A = P->o; d0.Bt = P->WpaT; d0.epi = E_PROJA; gemm_run(d0, lds); } gemm_run(d, lds); }
#endif
            }
        }
        if (lo <= ph && ph < hi) {
            KP P = kparams();
            if (ph == 5) gemm_small<1, 8>(P, P->h, DM, P->WgT, DM, 2048, P->gates, 2048, lds);
            else if (ph == 6) gemm_small<2, 4>(P, P->o, DM, P->WpaT, 512, 1024, P->merged, DM, lds);
            else if (ph == 7) gemm_small<0, 8>(P, P->merged, DM, P->WoutT, DM, 1024, P->m2, DM, lds);
            else if (ph == 11) gemm_small<0, 22>(P, P->g, DFF, P->WdownT, DFF, 1024, P->f, DM, lds);
#ifdef PROBE_SMALL
            if (ph == 5) gemm_small<1, 8>(P, P->h, DM, P->WgT, DM, 2048, P->gates, 2048, lds);
            else if (ph == 6) gemm_small<2, 4>(P, P->o, DM, P->WpaT, 512, 1024, P->merged, DM, lds);
            else if (ph == 7) gemm_small<0, 8>(P, P->merged, DM, P->WoutT, DM, 1024, P->m2, DM, lds);
            else if (ph == 11) gemm_small<0, 22>(P, P->g, DFF, P->WdownT, DFF, 1024, P->f, DM, lds);
#endif
        }
        SYNC(ph);
    }
}

static size_t bump(size_t& off, size_t bytes) { size_t r = off; off += (bytes + 255) & ~(size_t)255; return r; }

extern "C" void kernel_launch(void* const* d_in, const int* in_sizes, int n_in, void* d_out, int out_size, void* d_ws, size_t ws_size, hipStream_t stream) {
    Params P; memset(&P, 0, sizeof(P));
    const float* const* in = (const float* const*)d_in;
    P.x_p = in[0]; P.x_s = in[1]; P.c_ckv = in[2]; P.c_kr = in[3]; P.c_sbk = in[4]; P.c_sbv = in[5]; P.c_conv = in[6]; P.c_p = in[7]; P.c_s = in[8];
    P.w_ada = in[9]; P.b_ada = in[10]; P.g_pre_mix = in[11]; P.g_post_mix = in[12]; P.g_pre_ffn = in[13]; P.g_post_ffn = in[14];
    const float* w_in = in[15]; const float* g_q = in[16]; const float* w_uq = in[17]; P.g_kv = in[18]; const float* w_uk = in[19]; const float* w_uv = in[20];
    const float* w_pa = in[21]; const float* w_pb = in[22]; const float* w_out = in[23]; const float* w_up = in[24]; P.conv_w = in[25]; P.conv_b = in[26]; const float* w_down = in[27];
    P.out = (float*)d_out;
    char* ws = (char*)d_ws; size_t off = 0;
    P.WupT = (bf16_t*)(ws + bump(off, (size_t)DFF2 * DM * 2));
    P.WdownT = (bf16_t*)(ws + bump(off, (size_t)DM * DFF * 2));
    P.ropeT = (float*)(ws + bump(off, (size_t)TP * 32 * 4));
    P.ada = (float*)(ws + bump(off, 10 * 6144 * 4));
    P.ctr = (unsigned*)(ws + bump(off, 256));
    P.bar = (unsigned*)(ws + bump(off, XCD_BAR_WORDS * 4));
    const size_t R0 = off;
    P.WinT = (bf16_t*)(ws + bump(off, (size_t)2304 * DM * 2));
    P.WgT = (bf16_t*)(ws + bump(off, (size_t)2048 * DM * 2));
    P.WuqT = (bf16_t*)(ws + bump(off, (size_t)768 * 384 * 2));
    P.WukvT = (bf16_t*)(ws + bump(off, (size_t)1024 * 256 * 2));
    P.WpaT = (bf16_t*)(ws + bump(off, (size_t)1024 * 512 * 2));
    P.WpbT = (bf16_t*)(ws + bump(off, (size_t)1024 * 512 * 2));
    P.WoutT = (bf16_t*)(ws + bump(off, (size_t)1024 * 1024 * 2));
    const size_t o_kva = off;
    P.kva = (bf16_t*)(ws + bump(off, (size_t)KVROWS_PAD * 512 * 2));
    P.vaT_p = (bf16_t*)(ws + bump(off, (size_t)2 * 512 * TP * 2));
    P.vaT_s = (bf16_t*)(ws + bump(off, (size_t)8 * 512 * SKP * 2));
    const size_t o_kb = off;
    P.kb = (bf16_t*)(ws + bump(off, (size_t)KVROWS_PAD * 512 * 2));
    const size_t o_vbT = off;
    P.vbT_p = (bf16_t*)(ws + bump(off, (size_t)2 * 512 * TP * 2));
    P.vbT_s = (bf16_t*)(ws + bump(off, (size_t)8 * 512 * SKP * 2));
    const size_t o_kr = off;
    P.krope = (bf16_t*)(ws + bump(off, (size_t)KVROWS_PAD * 32 * 2));
    P.qb = (bf16_t*)(ws + bump(off, (size_t)MT * 512 * 2));
    P.q = (bf16_t*)(ws + bump(off, (size_t)MT * 768 * 2));
    P.latent = (bf16_t*)(ws + bump(off, (size_t)KVROWS_PAD * 256 * 2));
    size_t need = off;
    P.gates = (bf16_t*)(ws + o_kva);
    P.merged = (bf16_t*)(ws + o_kb);
    P.m2 = (bf16_t*)(ws + o_vbT);
    P.u = (bf16_t*)(ws + R0);
    const size_t o_g = R0 + (size_t)MT * DFF2 * 2;
    P.g = (bf16_t*)(ws + o_g);
    P.f = (bf16_t*)(ws + R0);
    size_t o_h2 = o_kr > o_g ? o_kr : o_g;
    P.h2 = (bf16_t*)(ws + o_h2);
    if (o_g + (size_t)MT * DFF * 2 > need) need = o_g + (size_t)MT * DFF * 2;
    if (o_h2 + (size_t)MT * DM * 2 > need) need = o_h2 + (size_t)MT * DM * 2;
    P.h = (bf16_t*)d_out;
    P.o = (bf16_t*)d_out + (size_t)MT * DM;
    P.qlat = P.o;
    if (need > ws_size) { fprintf(stderr, "workspace too small: need %zu have %zu\n", need, ws_size); return; }

    int nj = 0, tiles = 0;
    auto job = [&](const float* src, int lds, int coff, bf16_t* dst, int ldd, int Klen, int Nlen, const float* ks, int zero) {
        TJob& J = P.tj[nj++]; J.src = src; J.kscale = ks; J.dst = dst; J.lds = lds; J.coff = coff; J.ldd = ldd; J.Klen = Klen; J.Nlen = Nlen; J.zero = zero; J.tile0 = tiles; J.pad = 0;
        tiles += (Klen / 64) * ((Nlen + 255) / 256); };
    job(w_up, DFF2, 0, P.WupT, DM, DM, DFF2, nullptr, 0);
    job(w_down, DM, 0, P.WdownT, DFF, DFF, DM, nullptr, 0);
    job(w_in, 4256, 0, P.WinT, DM, DM, 384, nullptr, 0);
    job(w_in, 4256, 640, P.WinT + (size_t)384 * DM, DM, DM, 32, nullptr, 0);
    job(w_in, 4256, 0, P.WinT + (size_t)416 * DM, DM, DM, 96, nullptr, 1);
    job(w_in, 4256, 384, P.WinT + (size_t)512 * DM, DM, DM, 256, nullptr, 0);
    job(w_in, 4256, 672, P.WinT + (size_t)768 * DM, DM, DM, 1536, nullptr, 0);
    job(w_in, 4256, 2208, P.WgT, DM, DM, 2048, nullptr, 0);
    job(w_uq, 768, 0, P.WuqT, 384, 384, 768, g_q, 0);
    job(w_uk, 512, 0, P.WukvT, 256, 256, 512, nullptr, 0);
    job(w_uv, 512, 0, P.WukvT + (size_t)512 * 256, 256, 256, 512, nullptr, 0);
    job(w_pa, DM, 0, P.WpaT, 512, 512, DM, nullptr, 0);
    job(w_pb, DM, 0, P.WpbT, 512, 512, DM, nullptr, 0);
    job(w_out, DM, 0, P.WoutT, DM, DM, DM, nullptr, 0);
    P.ntj_tiles = tiles; P.pad0 = nj;
    P.phase_lo = 0; P.phase_hi = 13;

    static int grid_blocks = 0;
    if (!grid_blocks) {
        (void)hipFuncSetAttribute((const void*)fwd_megakernel, hipFuncAttributeMaxDynamicSharedMemorySize, LDS_BYTES);
        int dev = 0, cus = 0, per_cu = 0;
        (void)hipGetDevice(&dev);
        (void)hipDeviceGetAttribute(&cus, hipDeviceAttributeMultiprocessorCount, dev);
        (void)hipOccupancyMaxActiveBlocksPerMultiprocessor(&per_cu, fwd_megakernel, NTHREADS, LDS_BYTES);
        if (per_cu > 1) per_cu = 1;
        grid_blocks = cus * per_cu;
    }
    (void)hipMemsetAsync(P.ctr, 0, 256 + XCD_BAR_WORDS * 4, stream);
    void* args[] = {&P};
    hipError_t e = hipLaunchCooperativeKernel((const void*)fwd_megakernel, dim3(grid_blocks), dim3(NTHREADS), args, LDS_BYTES, stream);
    if (e != hipSuccess) fprintf(stderr, "cooperative launch failed: %s (grid %d)\n", hipGetErrorString(e), grid_blocks);
}
```

```cpp
#include <hip/hip_runtime.h>
#include <hip/hip_cooperative_groups.h>
#include <stdint.h>
#include <stdio.h>
#include <string.h>
namespace cg = cooperative_groups;

typedef unsigned short bf16_t;
typedef short bf16x8 __attribute__((ext_vector_type(8)));
typedef short s16x4 __attribute__((ext_vector_type(4)));
typedef float f32x2 __attribute__((ext_vector_type(2)));
typedef float f32x4 __attribute__((ext_vector_type(4)));
typedef float f32x16 __attribute__((ext_vector_type(16)));
typedef unsigned u32x2 __attribute__((ext_vector_type(2)));
typedef unsigned u32x4 __attribute__((ext_vector_type(4)));
typedef __bf16 bf2_t __attribute__((ext_vector_type(2)));
#define DI __device__ __forceinline__

constexpr int DM = 1024, TP = 8192, MP = 16384, MS = 256, MT = 16640, PAST = 4096, SKEYS = 4128, SKP = 4160;
constexpr int KVROWS = MP + 8 * SKEYS;
constexpr int KVROWS_PAD = KVROWS + 64;
constexpr int DFF = 2816, DFF2 = 5632;
constexpr float EPS = 1e-6f;
constexpr float LOG2E = 1.4426950408889634f, LN2 = 0.6931471805599453f;
constexpr int NTHREADS = 512;
constexpr int LDS_BYTES = 131072 + 8192;
constexpr long O_Y = 0, O_CKV_P = 17039360, O_KR_P = 21233664, O_SBK_P = 21757952, O_SBV_P = 30146560, O_CONV_P = 38535168,
               O_CKV_S = 38557696, O_KR_S = 38623232, O_SBK_S = 38631424, O_SBV_S = 38762496, O_CONV_S = 38893568;

struct TJob { const float* src; const float* kscale; bf16_t* dst; int lds, coff, ldd, Klen, Nlen, zero, tile0, pad; };
constexpr int NTJ = 22;

struct Params {
    const float *x_p, *x_s, *c_ckv, *c_kr, *c_sbk, *c_sbv, *c_conv, *c_p, *c_s;
    const float *w_ada, *b_ada, *g_pre_mix, *g_post_mix, *g_pre_ffn, *g_post_ffn, *g_kv, *conv_w, *conv_b;
    float* out;
    bf16_t *WupT, *WdownT, *WinT, *WgT, *WuqT, *WukvT, *WpaT, *WpbT, *WoutT;
    float* ropeT; float* ada; unsigned* ctr; unsigned* bar;
    bf16_t *h, *o, *qlat, *latent, *krope, *kb, *vbT_p, *vbT_s, *qb, *q, *kva, *vaT_p, *vaT_s, *gates, *merged, *m2, *h2, *u, *g, *f;
    TJob tj[NTJ]; int ntj_tiles; int phase_lo, phase_hi, pad0;
};

#define LAS __attribute__((address_space(3)))
typedef const Params __attribute__((address_space(4))) * KP;
DI KP kparams() { KP p = (KP)__builtin_amdgcn_kernarg_segment_ptr(); asm volatile("" : "+s"(p)); return p; }
DI int otid() { int t = threadIdx.x; asm volatile("" : "+v"(t)); return t; }
DI int obid() { int b = blockIdx.x; asm volatile("" : "+s"(b)); return b; }
DI int ogrid() { int g = gridDim.x; asm volatile("" : "+s"(g)); return g; }
DI unsigned pk2(float a, float b) { f32x2 f = {a, b}; bf2_t r = __builtin_convertvector(f, bf2_t); return __builtin_bit_cast(unsigned, r); }
DI float bf_lo(unsigned u) { return __uint_as_float(u << 16); }
DI float bf_hi(unsigned u) { return __uint_as_float(u & 0xffff0000u); }
DI int kvrow_of(int row) { if (row < MP) return row; const int r = row - MP; return MP + (r >> 5) * SKEYS + PAST + (r & 31); }
DI int pos_of(int row) { return row < MP ? (row & (TP - 1)) : PAST + ((row - MP) & 31); }
DI int ada_b(int row) { return row < MP ? (row >> 13) : 2 + ((row - MP) >> 5); }
DI float sigmoidf_(float x) { return 1.0f / (1.0f + __expf(-x)); }

constexpr int BM = 256, BK = 64, HALF = 128, HT = HALF * BK;
DI int lds_byte(int r, int c) { int st = (r >> 4) * 2 + (c >> 5), rr = r & 15, cc = c & 31, ob = rr * 64 + cc * 2; return st * 1024 + (ob ^ (((ob >> 9) & 1) << 5)); }
DI void stage_rc(int b, int& R, int& C) { int st = b / 1024, sb = b % 1024, swz = sb ^ (((sb >> 9) & 1) << 5); R = (st >> 1) * 16 + swz / 64; C = (st & 1) * 32 + (swz % 64) / 2; }

enum { E_INPROJ = 0, E_GATE, E_UQ, E_UKV, E_PROJA, E_PROJB, E_PLAIN, E_UP };
struct GemmDesc { const bf16_t* A; const bf16_t* Bt; bf16_t* C; int lda, ldb, ldc, K, nM, nN, epi, start; };

constexpr int HTB = HT * 2;
#define SA(b, h) (((b) * 2 + (h)) * HTB)
#define SB(b, h) ((4 + (b) * 2 + (h)) * HTB)
#define STAGE(bufoff, gbase, voff) do { _Pragma("unroll") for (int _i = 0; _i < 2; ++_i) \
    __builtin_amdgcn_global_load_lds((const unsigned*)((const char*)(gbase) + (voff)[_i]), (LAS unsigned*)(ldsl + (bufoff) + ldsw + _i * 8192), 16, 0, 0); } while (0)
#define LDA(dst, b, h) do { _Pragma("unroll") for (int m = 0; m < 4; ++m) _Pragma("unroll") for (int k = 0; k < 2; ++k) dst[m][k] = *(const LAS bf16x8*)(ldsl + SA(b, h) + aoff + m * 2048 + k * 1024); } while (0)
#define LDB(dst, b, h) do { _Pragma("unroll") for (int n = 0; n < 2; ++n) _Pragma("unroll") for (int k = 0; k < 2; ++k) dst[n][k] = *(const LAS bf16x8*)(ldsl + SB(b, h) + boff + n * 2048 + k * 1024); } while (0)
#define MMA(ai, bj, At, Bt_) do { __builtin_amdgcn_s_setprio(1); _Pragma("unroll") for (int m = 0; m < 4; ++m) _Pragma("unroll") for (int n = 0; n < 2; ++n) _Pragma("unroll") for (int k = 0; k < 2; ++k) \
      acc[ai][bj][m][n] = __builtin_amdgcn_mfma_f32_16x16x32_bf16(Bt_[n][k], At[m][k], acc[ai][bj][m][n], 0, 0, 0); \
    __builtin_amdgcn_s_setprio(0); } while (0)
#define WAIT_V(n) asm volatile("s_waitcnt vmcnt(" #n ")" ::: "memory")
#define WAIT_L(n) asm volatile("s_waitcnt lgkmcnt(" #n ")" ::: "memory")
#define BAR __builtin_amdgcn_s_barrier()
#define SCHED __builtin_amdgcn_sched_barrier(0)
#define ZERO_ACC do { _Pragma("unroll") for (int a_ = 0; a_ < 2; ++a_) _Pragma("unroll") for (int b_ = 0; b_ < 2; ++b_) _Pragma("unroll") for (int m_ = 0; m_ < 4; ++m_) _Pragma("unroll") for (int n_ = 0; n_ < 2; ++n_) \
    acc[a_][b_][m_][n_] = (f32x4){0.f, 0.f, 0.f, 0.f}; } while (0)

#define EPI_ROWS for (int ai = 0; ai < 2; ++ai) for (int m = 0; m < 4; ++m, ({ asm volatile("" ::: "memory"); }))
#define EPI_COLS for (int bj = 0; bj < 2; ++bj) for (int n = 0; n < 2; ++n)

DI float dpp_xor1(float x) { return __int_as_float(__builtin_amdgcn_mov_dpp(__float_as_int(x), 0xB1, 0xF, 0xF, true)); }
DI float dpp_xor2(float x) { return __int_as_float(__builtin_amdgcn_mov_dpp(__float_as_int(x), 0x4E, 0xF, 0xF, true)); }
DI f32x4 quad_transpose(f32x4 v, int i) {
    { const float a = (i & 1) ? v[0] : v[1], c = (i & 1) ? v[2] : v[3]; const float ra = dpp_xor1(a), rc = dpp_xor1(c);
      if (i & 1) { v[0] = ra; v[2] = rc; } else { v[1] = ra; v[3] = rc; } }
    { const float a = (i & 2) ? v[0] : v[2], c = (i & 2) ? v[1] : v[3]; const float ra = dpp_xor2(a), rc = dpp_xor2(c);
      if (i & 2) { v[0] = ra; v[1] = rc; } else { v[2] = ra; v[3] = rc; } }
    return v;
}
DI void store_bf4(bf16_t* p, f32x4 v) { u32x2 w; w.x = pk2(v[0], v[1]); w.y = pk2(v[2], v[3]); *(u32x2*)p = w; }

DI int unit_at(int k, int bid, int G, int nM, int nN, int start) {
    if (G != 256) { const int u = (bid + G - (start % G)) % G + k * G; return u < nM * nN ? u : -1; }
    const int x = bid & 7, l = ((bid >> 3) + start) & 31, cnt = nM >> 3, mainn = cnt * nN, j = l + 32 * k;
    if (j < mainn) { const int pn = j / cnt, rm = j - pn * cnt; return (x + 8 * rm) * nN + pn; }
    const int idx = x + 8 * (j - mainn);
    if (idx < (nM & 7) * nN) return (8 * cnt + idx / nN) * nN + idx % nN;
    return -1;
}

DI void gemm_run(const GemmDesc& d, char* lds) {
    LAS char* ldsl = (LAS char*)lds;
    float* xl = (float*)(lds + 131072);
    float* xp = (float*)(lds + 131072 + 4096);
    const int G = ogrid(), bid_ = obid(), first = unit_at(0, bid_, G, d.nM, d.nN, d.start);
    if (first < 0) return;
    int kun = 0;
    const int tid = otid(), wid = __builtin_amdgcn_readfirstlane(tid >> 6), wr = wid >> 2, wc = wid & 3;
    const unsigned lda2 = (unsigned)d.lda * 2u, ldb2 = (unsigned)d.ldb * 2u;
    unsigned voffA[2], voffB[2];
    { const int lane = tid & 63;
#pragma unroll
      for (int i = 0; i < 2; ++i) { int R, C; stage_rc(tid * 16 + i * 8192, R, C); voffA[i] = (unsigned)R * lda2 + (unsigned)C * 2u; voffB[i] = (unsigned)R * ldb2 + (unsigned)C * 2u; }
      (void)lane; }
    const size_t kstep = 128, hA = (size_t)HALF * lda2, hB = (size_t)HALF * ldb2;
    const unsigned ldsw = (unsigned)wid * 1024u;
    const int aoff = lds_byte(wr * 64 + (tid & 15), ((tid & 63) >> 4) * 8), boff = lds_byte(wc * 32 + (tid & 15), ((tid & 63) >> 4) * 8);
    const int nt = d.K / BK;
    int u = first;
    const char* cA = (const char*)d.A + (size_t)(u / d.nN) * 2 * hA; const char* cB = (const char*)d.Bt + (size_t)(u % d.nN) * 2 * hB;
    f32x4 acc[2][2][4][2];
    ZERO_ACC;
    bf16x8 At[4][2], B0[2][2], B1[2][2];
    STAGE(SB(0, 0), cB, voffB); STAGE(SB(0, 1), cB + hB, voffB); STAGE(SA(0, 0), cA, voffA); STAGE(SA(0, 1), cA + hA, voffA);
    if (wr == 1) BAR;
    WAIT_V(2); BAR;
    STAGE(SB(1, 0), cB + kstep, voffB); STAGE(SA(1, 0), cA + kstep, voffA); STAGE(SB(1, 1), cB + hB + kstep, voffB);
    WAIT_V(6); BAR;
    for (;;) {
        const int un = unit_at(kun + 1, bid_, G, d.nM, d.nN, d.start); const bool has_next = un >= 0;
        const char* nA = has_next ? (const char*)d.A + (size_t)(un / d.nN) * 2 * hA : cA; const char* nB = has_next ? (const char*)d.Bt + (size_t)(un % d.nN) * 2 * hB : cB;
        for (int t = 0; t < nt; t += 2) {
            const bool last = (t == nt - 2);
            const char* a1 = cA + (size_t)(t + 1) * kstep;
            const char* a2 = last ? nA : cA + (size_t)(t + 2) * kstep; const char* b2 = last ? nB : cB + (size_t)(t + 2) * kstep;
            const char* a3 = a2 + kstep; const char* b3 = b2 + kstep;
            LDB(B0, 0, 0); LDB(B1, 0, 1); SCHED; LDA(At, 0, 0); STAGE(SA(1, 1), a1 + hA, voffA);
            WAIT_V(8); WAIT_L(0); BAR; MMA(0, 0, At, B0); MMA(0, 1, At, B1); BAR; SCHED;
            LDA(At, 0, 1); STAGE(SB(0, 0), b2, voffB); STAGE(SB(0, 1), b2 + hB, voffB); STAGE(SA(0, 0), a2, voffA);
            WAIT_V(8); WAIT_L(0); BAR; MMA(1, 0, At, B0); MMA(1, 1, At, B1); BAR; SCHED;
            LDB(B0, 1, 0); LDB(B1, 1, 1); SCHED; LDA(At, 1, 0); STAGE(SA(0, 1), a2 + hA, voffA);
            WAIT_V(8); WAIT_L(0); BAR; MMA(0, 0, At, B0); MMA(0, 1, At, B1); BAR; SCHED;
            LDA(At, 1, 1); STAGE(SB(1, 0), b3, voffB); STAGE(SB(1, 1), b3 + hB, voffB); STAGE(SA(1, 0), a3, voffA);
            WAIT_V(8); WAIT_L(0); BAR; MMA(1, 0, At, B0); MMA(1, 1, At, B1); BAR; SCHED;
        }
        if (wr == 0) BAR;
        {
        const int pm = u / d.nN, pn = u % d.nN, brow = pm * BM, bcol = pn * BM;
        if (d.epi == E_UQ) {
            const int tq_ = otid(), r = tq_ >> 1, hf = tq_ & 1;
            const u32x4* src = (const u32x4*)(d.A + (long)(brow + r) * 384 + hf * 192);
            float sq = 0.f;
#pragma unroll 4
            for (int i = 0; i < 24; ++i) { u32x4 v = src[i];
                for (int e = 0; e < 4; ++e) { float a_ = bf_lo(v[e]), b_ = bf_hi(v[e]); sq += a_ * a_ + b_ * b_; } }
            sq += __shfl_xor(sq, 1);
            if (hf == 0) xl[r] = rsqrtf(sq * (1.0f / 384.0f) + EPS);
            WAIT_L(0); BAR; asm volatile("" ::: "memory");
        }
        int lane_e = threadIdx.x & 63; asm volatile("" : "+v"(lane_e));
        const int fr = lane_e & 15, fq = lane_e >> 4;
        KP P = kparams();
        const int rbase = brow + wr * 64 + fr, cbase = bcol + wc * 32 + fq * 4;
        switch (d.epi) {
        case E_INPROJ: {
            if (pn == 0) {
#pragma unroll
                EPI_ROWS { const int row = rbase + ai * 128 + m * 16;
#pragma unroll
                    EPI_COLS store_bf4(P->qlat + (long)row * 384 + (cbase + bj * 128 + n * 16), acc[ai][bj][m][n]); }
            } else if (pn == 1) {
#pragma unroll
                EPI_ROWS { const int row = rbase + ai * 128 + m * 16;
#pragma unroll
                    for (int n = 0; n < 2; ++n) store_bf4(P->qlat + (long)row * 384 + 256 + (wc * 32 + fq * 4 + n * 16), acc[ai][0][m][n]);
                    if (wc == 0) {
                        const int pos = pos_of(row);
                        const f32x4 cs0 = *(const f32x4*)(P->ropeT + (long)pos * 32 + fq * 8), cs1 = *(const f32x4*)(P->ropeT + (long)pos * 32 + fq * 8 + 4);
                        const f32x4 x1 = acc[ai][1][m][0], x2 = acc[ai][1][m][1];
                        f32x4 co = {cs0[0], cs0[2], cs1[0], cs1[2]}, si = {cs0[1], cs0[3], cs1[1], cs1[3]};
                        f32x4 o1 = x1 * co - x2 * si, o2 = x2 * co + x1 * si;
                        float* of = P->out + (row < MP ? O_KR_P + (long)row * 32 : O_KR_S + (long)(row - MP) * 32);
                        *(f32x4*)(of + fq * 4) = o1; *(f32x4*)(of + 16 + fq * 4) = o2;
                        bf16_t* ob = P->krope + (long)kvrow_of(row) * 32;
                        store_bf4(ob + fq * 4, o1); store_bf4(ob + 16 + fq * 4, o2);
                    } }
            } else if (pn == 2) {
                float ss[2][4];
#pragma unroll
                EPI_ROWS { float s = 0.f;
#pragma unroll
                    EPI_COLS { const f32x4 v = acc[ai][bj][m][n]; s += v[0] * v[0] + v[1] * v[1] + v[2] * v[2] + v[3] * v[3]; }
                    s += __shfl_xor(s, 16); s += __shfl_xor(s, 32); ss[ai][m] = s;
                    if (fq == 0) xp[(ai * 128 + wr * 64 + m * 16 + fr) * 4 + wc] = s; }
                WAIT_L(0); BAR; asm volatile("" ::: "memory");
#pragma unroll
                EPI_ROWS { const int rl = ai * 128 + wr * 64 + m * 16 + fr, row = brow + rl;
                    const f32x4 pp = *(const f32x4*)(xp + rl * 4);
                    const float rstd = rsqrtf((pp[0] + pp[1] + pp[2] + pp[3]) * (1.0f / 256.0f) + EPS);
                    float* of = P->out + (row < MP ? O_CKV_P + (long)row * 256 : O_CKV_S + (long)(row - MP) * 256);
                    bf16_t* ob = P->latent + (long)kvrow_of(row) * 256;
#pragma unroll
                    EPI_COLS { const int c = wc * 32 + fq * 4 + bj * 128 + n * 16;
                        const f32x4 gv = *(const f32x4*)(P->g_kv + c); const f32x4 o = acc[ai][bj][m][n] * rstd * gv;
                        *(f32x4*)(of + c) = o; store_bf4(ob + c, o); } }
            } else if (pn <= 4) {
#pragma unroll
                EPI_ROWS { const int row = rbase + ai * 128 + m * 16;
#pragma unroll
                    EPI_COLS store_bf4(P->qb + (long)row * 512 + (cbase - 768 + bj * 128 + n * 16), acc[ai][bj][m][n] * 0.125f); }
            } else if (pn <= 6) {
#pragma unroll
                EPI_ROWS { const int row = rbase + ai * 128 + m * 16;
                    float* of = P->out + (row < MP ? O_SBK_P + (long)row * 512 : O_SBK_S + (long)(row - MP) * 512);
                    bf16_t* ob = P->kb + (long)kvrow_of(row) * 512;
#pragma unroll
                    EPI_COLS { const int c = cbase - 1280 + bj * 128 + n * 16; *(f32x4*)(of + c) = acc[ai][bj][m][n]; store_bf4(ob + c, acc[ai][bj][m][n]); } }
            } else {
#pragma unroll
                EPI_ROWS { const int row = rbase + ai * 128 + m * 16;
                    float* of = P->out + (row < MP ? O_SBV_P + (long)row * 512 : O_SBV_S + (long)(row - MP) * 512);
                    const int qi = fr & 3, row4 = row - qi;
                    bf16_t* vt; int ldv;
                    if (row4 < MP) { vt = P->vbT_p + (long)(row4 >> 13) * 512 * TP + (row4 & (TP - 1)); ldv = TP; }
                    else { const int r = row4 - MP; vt = P->vbT_s + (long)(r >> 5) * 512 * SKP + PAST + (r & 31); ldv = SKP; }
#pragma unroll
                    EPI_COLS { const int c = cbase - 1792 + bj * 128 + n * 16; const f32x4 v = acc[ai][bj][m][n]; *(f32x4*)(of + c) = v;
                        store_bf4(vt + (long)(c + qi) * ldv, quad_transpose(v, qi)); } }
            }
        } break;
        case E_GATE: {
#pragma unroll
            EPI_ROWS { const int row = rbase + ai * 128 + m * 16;
#pragma unroll
                EPI_COLS { const f32x4 v = acc[ai][bj][m][n]; f32x4 s = {sigmoidf_(v[0]), sigmoidf_(v[1]), sigmoidf_(v[2]), sigmoidf_(v[3])};
                    store_bf4(P->gates + (long)row * 2048 + (cbase + bj * 128 + n * 16), s); } }
        } break;
        case E_UQ: {
            const float qs = 0.10206207261596577f * LOG2E;
#pragma unroll
            EPI_ROWS { const int rl = ai * 128 + wr * 64 + m * 16 + fr, row = brow + rl; const float rs = xl[rl] * qs;
#pragma unroll
                for (int bj = 0; bj < 2; ++bj) { const int grp = pn * 8 + bj * 4 + wc; bf16_t* dst = P->q + (long)row * 768 + grp * 32 + fq * 4;
                    f32x4 v0 = acc[ai][bj][m][0] * rs, v1 = acc[ai][bj][m][1] * rs;
                    if (grp % 3 == 2) {
                        const int pos = pos_of(row);
                        const f32x4 cs0 = *(const f32x4*)(P->ropeT + (long)pos * 32 + fq * 8), cs1 = *(const f32x4*)(P->ropeT + (long)pos * 32 + fq * 8 + 4);
                        f32x4 co = {cs0[0], cs0[2], cs1[0], cs1[2]}, si = {cs0[1], cs0[3], cs1[1], cs1[3]};
                        const f32x4 o1 = v0 * co - v1 * si, o2 = v1 * co + v0 * si; v0 = o1; v1 = o2;
                    }
                    store_bf4(dst, v0); store_bf4(dst + 16, v1); } }
        } break;
        case E_UKV: {
#pragma unroll
            EPI_ROWS { const int row = rbase + ai * 128 + m * 16;
                if (pn < 2) {
#pragma unroll
                    EPI_COLS store_bf4(P->kva + (long)row * 512 + (cbase + bj * 128 + n * 16), acc[ai][bj][m][n]);
                } else {
                    const int qi = fr & 3, row4 = row - qi;
                    bf16_t* vt; int ldv;
                    if (row4 < MP) { vt = P->vaT_p + (long)(row4 >> 13) * 512 * TP + (row4 & (TP - 1)); ldv = TP; }
                    else { const int r = row4 - MP, b = r / SKEYS; vt = P->vaT_s + (long)b * 512 * SKP + (r - b * SKEYS); ldv = SKP; }
#pragma unroll
                    EPI_COLS { const int c = cbase - 512 + bj * 128 + n * 16; const f32x4 vtr = quad_transpose(acc[ai][bj][m][n], qi);
                        if (row4 < KVROWS) store_bf4(vt + (long)(c + qi) * ldv, vtr); }
                } }
        } break;
        case E_PROJA: case E_PROJB: {
            const int goff = d.epi == E_PROJA ? 0 : 1024;
#pragma unroll
            EPI_ROWS { const int row = rbase + ai * 128 + m * 16;
#pragma unroll
                EPI_COLS { const int c = cbase + bj * 128 + n * 16; const u32x2 gw = *(const u32x2*)(P->gates + (long)row * 2048 + goff + c);
                    f32x4 gv = {bf_lo(gw.x), bf_hi(gw.x), bf_lo(gw.y), bf_hi(gw.y)}; f32x4 v = acc[ai][bj][m][n] * gv;
                    bf16_t* dst = P->merged + (long)row * 1024 + c;
                    if (d.epi == E_PROJB) { const u32x2 pw = *(const u32x2*)dst; f32x4 pv = {bf_lo(pw.x), bf_hi(pw.x), bf_lo(pw.y), bf_hi(pw.y)}; v += pv; }
                    store_bf4(dst, v); } }
        } break;
        case E_PLAIN: {
#pragma unroll
            EPI_ROWS { const int row = rbase + ai * 128 + m * 16;
#pragma unroll
                EPI_COLS store_bf4(d.C + (long)row * d.ldc + (cbase + bj * 128 + n * 16), acc[ai][bj][m][n]); }
        } break;
        case E_UP: {
#pragma unroll
            EPI_ROWS { const int row = rbase + ai * 128 + m * 16;
                float* cf = nullptr;
                if (row < MP) { const int t = row & (TP - 1); if (t >= TP - 2) cf = P->out + O_CONV_P + (long)((row >> 13) * 2 + (t - (TP - 2))) * DFF2; }
                else { const int r = row - MP, t = r & 31; if (t >= 30) cf = P->out + O_CONV_S + (long)((r >> 5) * 2 + (t - 30)) * DFF2; }
#pragma unroll
                EPI_COLS { const int c = cbase + bj * 128 + n * 16; store_bf4(P->u + (long)row * DFF2 + c, acc[ai][bj][m][n]);
                    if (cf) *(f32x4*)(cf + c) = acc[ai][bj][m][n]; } }
        } break;
        }
        }
        if (!has_next) break;
        ZERO_ACC;
        u = un; cA = nA; cB = nB; ++kun;
        if (wr == 1) BAR;
    }
    WAIT_V(0);
    BAR;
}

#define MFMA32(a, b, c) __builtin_amdgcn_mfma_f32_32x32x16_bf16((a), (b), (c), 0, 0, 0)
template <int KIND, int KSTEPS  >
DI void gemm_small(KP P, const bf16_t* A, int lda, const bf16_t* Bt, int ldb, int N, bf16_t* C, int ldc, char* lds) {
    const int tid = otid(), lane = tid & 63, w = tid >> 6, r = lane & 31, hh = lane >> 5, G = ogrid();
    const int ntask = 8 * (N >> 5);
    float* part = (float*)lds;
    for (int task = obid(); task < ntask; task += G) {
        const int rb = task & 7, cb = task >> 3, row0 = MP + rb * 32, col0 = cb * 32;
#pragma unroll
        for (int pass = 0; pass < (KIND == 2 ? 2 : 1); ++pass) {
            const bf16_t* ap = A + pass * 512 + (long)(row0 + r) * lda + w * (KSTEPS * 16) + 8 * hh;
            const bf16_t* bp = (pass ? P->WpbT : Bt) + (long)(col0 + r) * ldb + w * (KSTEPS * 16) + 8 * hh;
            f32x16 acc;
#pragma unroll
            for (int i = 0; i < 16; ++i) acc[i] = 0.f;
            constexpr int UN = KSTEPS > 11 ? 11 : KSTEPS;
#pragma unroll 1
            for (int s0 = 0; s0 < KSTEPS; s0 += UN) {
                bf16x8 af[UN], bf[UN];
#pragma unroll
                for (int s = 0; s < UN; ++s) { af[s] = *(const bf16x8*)(ap + (s0 + s) * 16); bf[s] = *(const bf16x8*)(bp + (s0 + s) * 16); }
#pragma unroll
                for (int s = 0; s < UN; ++s) acc = MFMA32(bf[s], af[s], acc);
            }
            float* pp = part + ((pass * 8 + w) * 32 + r) * 32 + 4 * hh;
#pragma unroll
            for (int g = 0; g < 4; ++g) *(f32x4*)(pp + 8 * g) = (f32x4){acc[4 * g], acc[4 * g + 1], acc[4 * g + 2], acc[4 * g + 3]};
        }
        __syncthreads();
        {
            const int e = tid * 2, rr = e >> 5, cc = e & 31;
            f32x2 s1 = {0.f, 0.f}, s2 = {0.f, 0.f};
#pragma unroll
            for (int ww = 0; ww < 8; ++ww) { s1 += *(const f32x2*)(part + (ww * 32 + rr) * 32 + cc); if (KIND == 2) s2 += *(const f32x2*)(part + ((8 + ww) * 32 + rr) * 32 + cc); }
            const long row = row0 + rr; const int col = col0 + cc;
            if (KIND == 1) { s1[0] = sigmoidf_(s1[0]); s1[1] = sigmoidf_(s1[1]); }
            if (KIND == 2) { const unsigned ga = *(const unsigned*)(P->gates + row * 2048 + col), gb = *(const unsigned*)(P->gates + row * 2048 + 1024 + col);
                s1[0] = s1[0] * bf_lo(ga) + s2[0] * bf_lo(gb); s1[1] = s1[1] * bf_hi(ga) + s2[1] * bf_hi(gb); }
            *(unsigned*)(C + row * ldc + col) = pk2(s1[0], s1[1]);
        }
        __syncthreads();
    }
}

DI int crow(int i, int h) { return (i & 3) + 8 * (i >> 2) + 4 * h; }

template <int MODE>
DI void attn_unit(KP P, char* lds, bool sample, int b, int h, int ublk) {
    constexpr int DQK = MODE == 0 ? 96 : 64, KS = DQK * 2 + 16, VS = 144, NS = DQK / 16;
    constexpr int KBYTES = 64 * KS, BUF = KBYTES + 64 * VS;
    const int tid = otid(), w = tid >> 6, lane = tid & 63, ql = lane & 31, hh = lane >> 5;
    const int kvrow0 = sample ? MP + b * SKEYS : b * TP;
    const int qrow0 = sample ? MP + b * 32 : b * TP + ublk * 256;
    const int ntiles = sample ? 65 : 4 * (ublk + 1);
    const int t0 = sample ? 0 : ublk * 256 + w * 32, tq = t0 + ql;
    int klim, wmax, wmin;
    if (MODE == 0) { if (sample) { klim = wmax = wmin = SKEYS; } else { klim = ((tq >> 6) + 1) << 6; wmax = (((t0 + 31) >> 6) + 1) << 6; wmin = ((t0 >> 6) + 1) << 6; } }
    else { if (sample) { klim = PAST + tq; wmax = PAST + 31; wmin = PAST; } else { klim = tq; wmax = t0 + 31; wmin = t0; } }
    const bool wactive = sample ? (w == 0) : true;
    const bf16_t* Kp; const bf16_t* Qp; const bf16_t* VT; int ldq; long ldv;
    if (MODE == 0) { Kp = P->kva + (long)kvrow0 * 512 + h * 64; Qp = P->q + (long)qrow0 * 768 + h * 96; ldq = 768;
        VT = sample ? P->vaT_s + (long)(b * 512 + h * 64) * SKP : P->vaT_p + (long)(b * 512 + h * 64) * TP; }
    else { Kp = P->kb + (long)kvrow0 * 512 + h * 64; Qp = P->qb + (long)qrow0 * 512 + h * 64; ldq = 512;
        VT = sample ? P->vbT_s + (long)(b * 512 + h * 64) * SKP : P->vbT_p + (long)(b * 512 + h * 64) * TP; }
    ldv = sample ? SKP : TP;
    const bf16_t* Kr = P->krope + (long)kvrow0 * 32;

    bf16x8 qf[NS];
    if (wactive) {
        const bf16_t* qp = Qp + (long)(w * 32 + ql) * ldq + 8 * hh;
#pragma unroll
        for (int s = 0; s < NS; ++s) qf[s] = *(const bf16x8*)(qp + 16 * s);
    } else {
#pragma unroll
        for (int s = 0; s < NS; ++s) qf[s] = (bf16x8){0, 0, 0, 0, 0, 0, 0, 0};
    }
    f32x16 O0, O1;
#pragma unroll
    for (int i = 0; i < 16; ++i) { O0[i] = 0.f; O1[i] = 0.f; }
    float mrun = -INFINITY, lrun = 0.f, carry = 0.f;
    bool wdone = !wactive;
    volatile int* flags = (volatile int*)(lds + 65536 + 64);

    u32x4 rk0, rk1, rv;
    const int krow_s = tid >> 3, kc_s = tid & 7, rrow_s = tid >> 2, rc_s = tid & 3;
    const bool f32path = (MODE == 1) && sample;
    const float* Kf = P->c_sbk + ((long)b * PAST * 512 + h * 64); const float* Vf = P->c_sbv + ((long)b * PAST * 512 + h * 64);
    auto load_tile = [&](int kt) {
        if (f32path && kt < 64) {
            const float* kp_ = Kf + (long)(kt * 64 + krow_s) * 512 + kc_s * 8; const float* vp_ = Vf + (long)(kt * 64 + krow_s) * 512 + kc_s * 8;
            const f32x4 a0 = *(const f32x4*)kp_, a1 = *(const f32x4*)(kp_ + 4), c0 = *(const f32x4*)vp_, c1 = *(const f32x4*)(vp_ + 4);
            rk0.x = pk2(a0[0], a0[1]); rk0.y = pk2(a0[2], a0[3]); rk0.z = pk2(a1[0], a1[1]); rk0.w = pk2(a1[2], a1[3]);
            rv.x = pk2(c0[0], c0[1]); rv.y = pk2(c0[2], c0[3]); rv.z = pk2(c1[0], c1[1]); rv.w = pk2(c1[2], c1[3]);
            return;
        }
        rk0 = *(const u32x4*)(Kp + (long)(kt * 64 + krow_s) * 512 + kc_s * 8);
        if (MODE == 0 && tid < 256) rk1 = *(const u32x4*)(Kr + (long)(kt * 64 + rrow_s) * 32 + rc_s * 8);
        rv = *(const u32x4*)(VT + (long)krow_s * ldv + kt * 64 + kc_s * 8);
    };
    auto store_tile = [&](int buf, int kt) {
        char* kb_ = lds + buf * BUF; char* vb_ = kb_ + KBYTES;
        *(u32x4*)(kb_ + krow_s * KS + kc_s * 16) = rk0;
        if (f32path && kt < 64) {
#pragma unroll
            for (int e = 0; e < 4; ++e) { *(bf16_t*)(vb_ + (kc_s * 8 + 2 * e) * VS + krow_s * 2) = (bf16_t)(rv[e] & 0xffff); *(bf16_t*)(vb_ + (kc_s * 8 + 2 * e + 1) * VS + krow_s * 2) = (bf16_t)(rv[e] >> 16); }
            return;
        }
        if (MODE == 0 && tid < 256) *(u32x4*)(kb_ + rrow_s * KS + 128 + rc_s * 16) = rk1;
        *(u32x4*)(vb_ + krow_s * VS + kc_s * 16) = rv;
    };
    load_tile(ntiles - 1); store_tile(0, ntiles - 1);
    __syncthreads();
    for (int it = 0; it < ntiles; ++it) {
        const int kt = ntiles - 1 - it, cur = it & 1;
        if (it + 1 < ntiles) load_tile(kt - 1);
        if (wactive && !wdone && kt * 64 < wmax) {
            const char* kb_ = lds + cur * BUF; const char* vb_ = kb_ + KBYTES;
            f32x16 S0, S1;
#pragma unroll
            for (int i = 0; i < 16; ++i) { S0[i] = 0.f; S1[i] = 0.f; }
#pragma unroll
            for (int s = 0; s < NS; ++s) {
                const bf16x8 k0 = *(const bf16x8*)(kb_ + ql * KS + (16 * s + 8 * hh) * 2);
                const bf16x8 k1 = *(const bf16x8*)(kb_ + (32 + ql) * KS + (16 * s + 8 * hh) * 2);
                S0 = MFMA32(k0, qf[s], S0); S1 = MFMA32(k1, qf[s], S1);
            }
            const bool need_mask = (kt * 64 + 64 > wmin);
            const int kbase = kt * 64 + 4 * hh;
            if (MODE == 0) {
                if (need_mask) {
#pragma unroll
                    for (int i = 0; i < 16; ++i) { const int key = kbase + (i & 3) + 8 * (i >> 2);
                        if (key >= klim) S0[i] = -INFINITY; if (key + 32 >= klim) S1[i] = -INFINITY; }
                }
                float mx = S0[0];
#pragma unroll
                for (int i = 1; i < 16; ++i) mx = fmaxf(mx, S0[i]);
#pragma unroll
                for (int i = 0; i < 16; ++i) mx = fmaxf(mx, S1[i]);
                mx = fmaxf(mx, __shfl_xor(mx, 32));
                const float mnew = fmaxf(mrun, mx);
                const float alpha = __builtin_amdgcn_exp2f(mrun - mnew);
                mrun = mnew;
                float ps = 0.f;
#pragma unroll
                for (int i = 0; i < 16; ++i) { S0[i] = __builtin_amdgcn_exp2f(S0[i] - mnew); S1[i] = __builtin_amdgcn_exp2f(S1[i] - mnew); ps += S0[i] + S1[i]; }
                lrun = lrun * alpha + ps;
#pragma unroll
                for (int i = 0; i < 16; ++i) { O0[i] *= alpha; O1[i] *= alpha; }
            } else {
                float gs[2][4], gp[2][4];
                f32x16 SP0, SP1;
#pragma unroll
                for (int i = 0; i < 16; ++i) { const int key = kbase + (i & 3) + 8 * (i >> 2);
                    { const float z = S0[i]; const float t = __builtin_amdgcn_exp2f(-fabsf(z) * LOG2E); float sp = fmaxf(z, 0.f) + LN2 * __builtin_amdgcn_logf(1.0f + t);
                      if (need_mask && key >= klim) sp = 0.f; SP0[i] = sp; }
                    { const float z = S1[i]; const float t = __builtin_amdgcn_exp2f(-fabsf(z) * LOG2E); float sp = fmaxf(z, 0.f) + LN2 * __builtin_amdgcn_logf(1.0f + t);
                      if (need_mask && key + 32 >= klim) sp = 0.f; SP1[i] = sp; } }
#pragma unroll
                for (int g = 0; g < 4; ++g) { gs[0][g] = (SP0[4 * g] + SP0[4 * g + 1]) + (SP0[4 * g + 2] + SP0[4 * g + 3]);
                    gs[1][g] = (SP1[4 * g] + SP1[4 * g + 1]) + (SP1[4 * g + 2] + SP1[4 * g + 3]); }
#pragma unroll
                for (int g = 0; g < 4; ++g) { gp[0][g] = __shfl_xor(gs[0][g], 32); gp[1][g] = __shfl_xor(gs[1][g], 32); }
                float running = carry;
#pragma unroll
                for (int blk = 1; blk >= 0; --blk)
#pragma unroll
                    for (int g = 3; g >= 0; --g) {
                        const float sum1 = hh ? gs[blk][g] : gp[blk][g], sum0 = hh ? gp[blk][g] : gs[blk][g];
                        const float mybase = hh ? running : running + sum1;
                        running += sum0 + sum1;
                        float later = mybase;
#pragma unroll
                        for (int j = 3; j >= 0; --j) { const int i = 4 * g + j; const int key = kbase + j + 8 * g + 32 * blk;
                            const float z = blk ? S1[i] : S0[i], sp = blk ? SP1[i] : SP0[i];
                            float a = __builtin_amdgcn_exp2f((z - sp - later) * LOG2E);
                            if (need_mask && key >= klim) a = 0.f;
                            later += sp;
                            if (blk) S1[i] = a; else S0[i] = a; }
                    }
                carry = running;
                wdone = __all((carry > 104.0f) || (klim <= 0));
            }
            bf16x8 pf[2][2];
#pragma unroll
            for (int s = 0; s < 2; ++s) {
                u32x4 a, c;
                a.x = pk2(S0[8 * s], S0[8 * s + 1]); a.y = pk2(S0[8 * s + 2], S0[8 * s + 3]); a.z = pk2(S0[8 * s + 4], S0[8 * s + 5]); a.w = pk2(S0[8 * s + 6], S0[8 * s + 7]);
                c.x = pk2(S1[8 * s], S1[8 * s + 1]); c.y = pk2(S1[8 * s + 2], S1[8 * s + 3]); c.z = pk2(S1[8 * s + 4], S1[8 * s + 5]); c.w = pk2(S1[8 * s + 6], S1[8 * s + 7]);
                pf[0][s] = __builtin_bit_cast(bf16x8, a); pf[1][s] = __builtin_bit_cast(bf16x8, c);
            }
#pragma unroll
            for (int blk = 0; blk < 2; ++blk)
#pragma unroll
                for (int s = 0; s < 2; ++s) {
                    const int koff = (32 * blk + 16 * s + 4 * hh) * 2;
                    const s16x4 lo0 = *(const s16x4*)(vb_ + ql * VS + koff), hi0 = *(const s16x4*)(vb_ + ql * VS + koff + 16);
                    const s16x4 lo1 = *(const s16x4*)(vb_ + (32 + ql) * VS + koff), hi1 = *(const s16x4*)(vb_ + (32 + ql) * VS + koff + 16);
                    const bf16x8 v0 = __builtin_shufflevector(lo0, hi0, 0, 1, 2, 3, 4, 5, 6, 7), v1 = __builtin_shufflevector(lo1, hi1, 0, 1, 2, 3, 4, 5, 6, 7);
                    O0 = MFMA32(v0, pf[blk][s], O0); O1 = MFMA32(v1, pf[blk][s], O1);
                }
        }
        if (it + 1 < ntiles) store_tile(cur ^ 1, kt - 1);
        if (MODE == 1 && lane == 0) flags[(it & 1) * 8 + w] = wdone ? 1 : 0;
        __syncthreads();
        if (MODE == 1) { int alld = 1;
#pragma unroll
            for (int ww = 0; ww < 8; ++ww) alld &= flags[(it & 1) * 8 + ww];
            if (alld) break; }
    }
    if (wactive) {
        float inv = 1.0f;
        if (MODE == 0) { const float lt = lrun + __shfl_xor(lrun, 32); inv = 1.0f / lt; }
        bf16_t* op = P->o + (long)(qrow0 + w * 32 + ql) * 1024 + (MODE == 0 ? 0 : 512) + h * 64 + 4 * hh;
#pragma unroll
        for (int g = 0; g < 4; ++g) {
            f32x4 a = {O0[4 * g] * inv, O0[4 * g + 1] * inv, O0[4 * g + 2] * inv, O0[4 * g + 3] * inv};
            f32x4 c = {O1[4 * g] * inv, O1[4 * g + 1] * inv, O1[4 * g + 2] * inv, O1[4 * g + 3] * inv};
            store_bf4(op + 8 * g, a); store_bf4(op + 32 + 8 * g, c);
        }
    }
}

DI void attn_phase(KP P, char* lds, int cidx) {
    unsigned* slot = (unsigned*)(lds + 65536);
    for (;;) {
        if (threadIdx.x == 0) *slot = atomicAdd(P->ctr + cidx, 1u);
        __syncthreads();
        const unsigned idx = *slot;
        __syncthreads();
        if (idx >= 1152u) break;
        bool sample; int mode, b, h, ublk = 0;
        if (idx < 128u) { sample = true; mode = idx >> 6; b = (idx >> 3) & 7; h = idx & 7; }
        else { const int j = idx - 128; sample = false; ublk = 31 - (j >> 5); const int r = j & 31; mode = r >> 4; b = (r >> 3) & 1; h = r & 7; }
        if (mode == 0) attn_unit<0>(P, lds, sample, b, h, ublk); else attn_unit<1>(P, lds, sample, b, h, ublk);
    }
}

DI void phase0(KP P, char* lds) {
    const int tid = otid(), G = ogrid(), bid = obid(), w = tid >> 6, lane = tid & 63;
    for (int item = bid; item < 96; item += G) {
        float* sc = (float*)lds; float* red = (float*)(lds + 40960);
        for (int i = tid; i < 10240; i += NTHREADS) { const int bb = i >> 10, k = i & 1023; const float cv = bb < 2 ? P->c_p[bb * 1024 + k] : P->c_s[(bb - 2) * 1024 + k]; sc[i] = cv / (1.0f + __expf(-cv)); }
        __syncthreads();
        const int col = item * 64 + lane;
        float a0 = 0, a1 = 0, a2 = 0, a3 = 0, a4 = 0, a5 = 0, a6 = 0, a7 = 0, a8 = 0, a9 = 0;
        for (int k0 = w * 128; k0 < w * 128 + 128; k0 += 16) {
            float wv[16];
#pragma unroll
            for (int j = 0; j < 16; ++j) wv[j] = P->w_ada[(long)(k0 + j) * 6144 + col];
#pragma unroll
            for (int j = 0; j < 16; ++j) { const int k = k0 + j;
                a0 += sc[k] * wv[j]; a1 += sc[1024 + k] * wv[j]; a2 += sc[2048 + k] * wv[j]; a3 += sc[3072 + k] * wv[j]; a4 += sc[4096 + k] * wv[j];
                a5 += sc[5120 + k] * wv[j]; a6 += sc[6144 + k] * wv[j]; a7 += sc[7168 + k] * wv[j]; a8 += sc[8192 + k] * wv[j]; a9 += sc[9216 + k] * wv[j]; }
        }
        float* rr = red + w * 640 + lane;
        rr[0] = a0; rr[64] = a1; rr[128] = a2; rr[192] = a3; rr[256] = a4; rr[320] = a5; rr[384] = a6; rr[448] = a7; rr[512] = a8; rr[576] = a9;
        __syncthreads();
        for (int i = tid; i < 640; i += NTHREADS) { float s = 0.f; for (int ww = 0; ww < 8; ++ww) s += red[ww * 640 + i];
            const int bb = i >> 6, l = i & 63; P->ada[bb * 6144 + item * 64 + l] = s + P->b_ada[item * 64 + l]; }
        __syncthreads();
    }
    {
        float* tile = (float*)lds;
        for (int it = (bid + 96) % G; it < P->ntj_tiles; it += G) {
            int j = 0;
#pragma unroll 1
            for (int q = 1; q < P->pad0; ++q) if (it >= P->tj[q].tile0) j = q;
            TJob J; J.src = P->tj[j].src; J.kscale = P->tj[j].kscale; J.dst = P->tj[j].dst; J.lds = P->tj[j].lds; J.coff = P->tj[j].coff; J.ldd = P->tj[j].ldd;
            J.Klen = P->tj[j].Klen; J.Nlen = P->tj[j].Nlen; J.zero = P->tj[j].zero; J.tile0 = P->tj[j].tile0;
            const int lt = it - J.tile0, nk = J.Klen >> 6, tk = lt % nk, tn = lt / nk, k0 = tk * 64, n0 = tn * 256;
            f32x4 lv[8];
#pragma unroll
            for (int r = 0; r < 8; ++r) { const int e = tid + r * NTHREADS, kk = e >> 6, n4 = (e & 63) * 4;
                lv[r] = (f32x4){0.f, 0.f, 0.f, 0.f};
                if (!J.zero && n0 + n4 < J.Nlen) lv[r] = *(const f32x4*)(J.src + (long)(k0 + kk) * J.lds + J.coff + n0 + n4); }
#pragma unroll
            for (int r = 0; r < 8; ++r) { const int e = tid + r * NTHREADS, kk = e >> 6, n4 = (e & 63) * 4;
                f32x4 v = lv[r]; if (J.kscale) v *= J.kscale[k0 + kk];
                float* tp = tile + kk * 257 + n4; tp[0] = v[0]; tp[1] = v[1]; tp[2] = v[2]; tp[3] = v[3]; }
            __syncthreads();
#pragma unroll
            for (int r = 0; r < 4; ++r) { const int e = tid + r * NTHREADS, nn = e >> 3, kc = (e & 7) * 8;
                if (n0 + nn < J.Nlen) { const float* tp = tile + kc * 257 + nn; u32x4 o;
                    o.x = pk2(tp[0], tp[257]); o.y = pk2(tp[2 * 257], tp[3 * 257]); o.z = pk2(tp[4 * 257], tp[5 * 257]); o.w = pk2(tp[6 * 257], tp[7 * 257]);
                    *(u32x4*)(J.dst + (long)(n0 + nn) * J.ldd + k0 + kc) = o; } }
            __syncthreads();
        }
    }
    const long gt = (long)bid * NTHREADS + tid, gn = (long)G * NTHREADS;
    for (long i0 = gt; i0 < 8L * PAST * 64; i0 += 4 * gn) { f32x4 v[4];
#pragma unroll
        for (int r = 0; r < 4; ++r) { const long i = i0 + r * gn; if (i < 8L * PAST * 64) v[r] = *(const f32x4*)(P->c_ckv + i * 4); }
#pragma unroll
        for (int r = 0; r < 4; ++r) { const long i = i0 + r * gn; if (i < 8L * PAST * 64) { const long row = i >> 6; const int c = (int)(i & 63) * 4; const int bb = (int)(row >> 12), sq = (int)(row & 4095);
            store_bf4(P->latent + (long)(MP + bb * SKEYS + sq) * 256 + c, v[r]); } } }
    for (long i0 = gt; i0 < 8L * PAST * 8; i0 += 4 * gn) { f32x4 v[4];
#pragma unroll
        for (int r = 0; r < 4; ++r) { const long i = i0 + r * gn; if (i < 8L * PAST * 8) v[r] = *(const f32x4*)(P->c_kr + i * 4); }
#pragma unroll
        for (int r = 0; r < 4; ++r) { const long i = i0 + r * gn; if (i < 8L * PAST * 8) { const long row = i >> 3; const int c = (int)(i & 7) * 4; const int bb = (int)(row >> 12), sq = (int)(row & 4095);
            store_bf4(P->krope + (long)(MP + bb * SKEYS + sq) * 32 + c, v[r]); } } }
    for (long i = gt; i < 8L * 512 * 8; i += gn) { const long r = i >> 3; const int c = (int)(i & 7) * 4; const u32x2 z = {0u, 0u};
        *(u32x2*)(P->vaT_s + r * SKP + SKEYS + c) = z; *(u32x2*)(P->vbT_s + r * SKP + SKEYS + c) = z; }
    for (long i = gt; i < (long)TP * 16; i += gn) { const int pos = (int)(i >> 4), fi = (int)(i & 15);
        const float inv = exp2f(-(float)fi * (13.287712379549449f / 16.0f));
        const float ang = (float)pos * inv;
        const double rev = (double)ang * 0.15915494309189535; const float fr_ = (float)(rev - floor(rev));
        P->ropeT[i * 2] = __builtin_amdgcn_cosf(fr_); P->ropeT[i * 2 + 1] = __builtin_amdgcn_sinf(fr_); }
}

DI void phase_h(KP P) {
    const int tid_ = otid(), lane = tid_ & 63, gw = obid() * 8 + (tid_ >> 6), nw = ogrid() * 8;
    for (int row = gw; row < MT; row += nw) {
        const float* xr = row < MP ? P->x_p + (long)row * DM : P->x_s + (long)(row - MP) * DM;
        const float* ad = P->ada + ada_b(row) * 6144;
        f32x4 v[4]; float s = 0.f;
#pragma unroll
        for (int i = 0; i < 4; ++i) { v[i] = *(const f32x4*)(xr + i * 256 + lane * 4); s += v[i][0] * v[i][0] + v[i][1] * v[i][1] + v[i][2] * v[i][2] + v[i][3] * v[i][3]; }
#pragma unroll
        for (int o = 1; o < 64; o <<= 1) s += __shfl_xor(s, o);
        const float rstd = rsqrtf(s * (1.0f / DM) + EPS);
#pragma unroll
        for (int i = 0; i < 4; ++i) { const int c = i * 256 + lane * 4;
            const f32x4 g = *(const f32x4*)(P->g_pre_mix + c), sh = *(const f32x4*)(ad + c), scl = *(const f32x4*)(ad + 1024 + c);
            store_bf4(P->h + (long)row * DM + c, v[i] * rstd * g * (1.0f + scl) + sh); }
    }
}

DI void phase_mid(KP P) {
    const int tid_ = otid(), lane = tid_ & 63, gw = obid() * 8 + (tid_ >> 6), nw = ogrid() * 8;
    for (int row = gw; row < MT; row += nw) {
        const float* xr = row < MP ? P->x_p + (long)row * DM : P->x_s + (long)(row - MP) * DM;
        const float* ad = P->ada + ada_b(row) * 6144;
        f32x4 mv[4]; float s = 0.f;
#pragma unroll
        for (int i = 0; i < 4; ++i) { const u32x2 wv = *(const u32x2*)(P->m2 + (long)row * DM + i * 256 + lane * 4);
            mv[i] = (f32x4){bf_lo(wv.x), bf_hi(wv.x), bf_lo(wv.y), bf_hi(wv.y)}; s += mv[i][0] * mv[i][0] + mv[i][1] * mv[i][1] + mv[i][2] * mv[i][2] + mv[i][3] * mv[i][3]; }
#pragma unroll
        for (int o = 1; o < 64; o <<= 1) s += __shfl_xor(s, o);
        const float rstd = rsqrtf(s * (1.0f / DM) + EPS);
        float s2 = 0.f;
#pragma unroll
        for (int i = 0; i < 4; ++i) { const int c = i * 256 + lane * 4;
            const f32x4 xv = *(const f32x4*)(xr + c), g = *(const f32x4*)(P->g_post_mix + c), gt = *(const f32x4*)(ad + 2048 + c);
            mv[i] = xv + gt * (mv[i] * rstd * g);
            *(f32x4*)(P->out + O_Y + (long)row * DM + c) = mv[i];
            s2 += mv[i][0] * mv[i][0] + mv[i][1] * mv[i][1] + mv[i][2] * mv[i][2] + mv[i][3] * mv[i][3]; }
#pragma unroll
        for (int o = 1; o < 64; o <<= 1) s2 += __shfl_xor(s2, o);
        const float rstd2 = rsqrtf(s2 * (1.0f / DM) + EPS);
#pragma unroll
        for (int i = 0; i < 4; ++i) { const int c = i * 256 + lane * 4;
            const f32x4 g = *(const f32x4*)(P->g_pre_ffn + c), sh = *(const f32x4*)(ad + 3072 + c), scl = *(const f32x4*)(ad + 4096 + c);
            store_bf4(P->h2 + (long)row * DM + c, mv[i] * rstd2 * g * (1.0f + scl) + sh); }
    }
}

DI void phase_final(KP P) {
    const int tid_ = otid(), lane = tid_ & 63, gw = obid() * 8 + (tid_ >> 6), nw = ogrid() * 8;
    for (int row = gw; row < MT; row += nw) {
        const float* ad = P->ada + ada_b(row) * 6144;
        f32x4 fv[4]; float s = 0.f;
#pragma unroll
        for (int i = 0; i < 4; ++i) { const u32x2 wv = *(const u32x2*)(P->f + (long)row * DM + i * 256 + lane * 4);
            fv[i] = (f32x4){bf_lo(wv.x), bf_hi(wv.x), bf_lo(wv.y), bf_hi(wv.y)}; s += fv[i][0] * fv[i][0] + fv[i][1] * fv[i][1] + fv[i][2] * fv[i][2] + fv[i][3] * fv[i][3]; }
#pragma unroll
        for (int o = 1; o < 64; o <<= 1) s += __shfl_xor(s, o);
        const float rstd = rsqrtf(s * (1.0f / DM) + EPS);
#pragma unroll
        for (int i = 0; i < 4; ++i) { const int c = i * 256 + lane * 4; float* yp = P->out + O_Y + (long)row * DM + c;
            const f32x4 xv = *(const f32x4*)yp, g = *(const f32x4*)(P->g_post_ffn + c), gt = *(const f32x4*)(ad + 5120 + c);
            *(f32x4*)yp = xv + gt * (fv[i] * rstd * g); }
    }
}

DI float gelu_tanh(float a) { const float t = 0.7978845608028654f * (a + 0.044715f * a * a * a); const float e = __expf(2.0f * t); return 0.5f * a * (2.0f - 2.0f / (1.0f + e)); }

DI void phase_conv(KP P) {
    const long gt = (long)obid() * NTHREADS + otid(), gn = (long)ogrid() * NTHREADS;
    for (long i = gt; i < (long)(MT / 8) * 352; i += gn) {
        const int rg = (int)(i / 352), c = (int)(i % 352) * 8, row0 = rg * 8;
        int t0, bs = -1; if (row0 < MP) t0 = row0 & (TP - 1); else { t0 = (row0 - MP) & 31; bs = (row0 - MP) >> 5; }
        u32x4 ua[10], ub[10];
#pragma unroll
        for (int r = 0; r < 10; ++r) { const int rr = (t0 == 0 && r < 2) ? row0 : row0 + r - 2;
            ua[r] = *(const u32x4*)(P->u + (long)rr * DFF2 + c); ub[r] = *(const u32x4*)(P->u + (long)rr * DFF2 + DFF + c); }
        float wa[3][8], wb[3][8], ba[8], bb[8];
#pragma unroll
        for (int tap = 0; tap < 3; ++tap) { const f32x4 x0 = *(const f32x4*)(P->conv_w + tap * DFF2 + c), x1 = *(const f32x4*)(P->conv_w + tap * DFF2 + c + 4);
            const f32x4 y0 = *(const f32x4*)(P->conv_w + tap * DFF2 + DFF + c), y1 = *(const f32x4*)(P->conv_w + tap * DFF2 + DFF + c + 4);
#pragma unroll
            for (int e = 0; e < 4; ++e) { wa[tap][e] = x0[e]; wa[tap][4 + e] = x1[e]; wb[tap][e] = y0[e]; wb[tap][4 + e] = y1[e]; } }
        { const f32x4 x0 = *(const f32x4*)(P->conv_b + c), x1 = *(const f32x4*)(P->conv_b + c + 4), y0 = *(const f32x4*)(P->conv_b + DFF + c), y1 = *(const f32x4*)(P->conv_b + DFF + c + 4);
#pragma unroll
          for (int e = 0; e < 4; ++e) { ba[e] = x0[e]; ba[4 + e] = x1[e]; bb[e] = y0[e]; bb[4 + e] = y1[e]; } }
        float ha[2][8], hb[2][8];
#pragma unroll
        for (int r = 0; r < 2; ++r)
#pragma unroll
            for (int e = 0; e < 4; ++e) { ha[r][2 * e] = bf_lo(ua[r][e]); ha[r][2 * e + 1] = bf_hi(ua[r][e]); hb[r][2 * e] = bf_lo(ub[r][e]); hb[r][2 * e + 1] = bf_hi(ub[r][e]); }
        if (t0 == 0) {
            if (bs >= 0) {
#pragma unroll
                for (int r = 0; r < 2; ++r) { const float* sp = P->c_conv + (long)(bs * 2 + r) * DFF2 + c;
#pragma unroll
                    for (int e = 0; e < 8; ++e) { ha[r][e] = sp[e]; hb[r][e] = sp[DFF + e]; } }
            } else {
#pragma unroll
                for (int r = 0; r < 2; ++r)
#pragma unroll
                    for (int e = 0; e < 8; ++e) { ha[r][e] = 0.f; hb[r][e] = 0.f; }
            }
        }
        float pa2[8], pa1[8], pb2[8], pb1[8];
#pragma unroll
        for (int e = 0; e < 8; ++e) { pa2[e] = ha[0][e]; pa1[e] = ha[1][e]; pb2[e] = hb[0][e]; pb1[e] = hb[1][e]; }
#pragma unroll
        for (int r = 0; r < 8; ++r) {
            float ca[8], cb[8];
#pragma unroll
            for (int e = 0; e < 4; ++e) { ca[2 * e] = bf_lo(ua[r + 2][e]); ca[2 * e + 1] = bf_hi(ua[r + 2][e]); cb[2 * e] = bf_lo(ub[r + 2][e]); cb[2 * e + 1] = bf_hi(ub[r + 2][e]); }
            u32x4 ov;
#pragma unroll
            for (int e = 0; e < 4; ++e) {
                const float ya0 = ba[2 * e] + wa[0][2 * e] * pa2[2 * e] + wa[1][2 * e] * pa1[2 * e] + wa[2][2 * e] * ca[2 * e];
                const float ya1 = ba[2 * e + 1] + wa[0][2 * e + 1] * pa2[2 * e + 1] + wa[1][2 * e + 1] * pa1[2 * e + 1] + wa[2][2 * e + 1] * ca[2 * e + 1];
                const float yb0 = bb[2 * e] + wb[0][2 * e] * pb2[2 * e] + wb[1][2 * e] * pb1[2 * e] + wb[2][2 * e] * cb[2 * e];
                const float yb1 = bb[2 * e + 1] + wb[0][2 * e + 1] * pb2[2 * e + 1] + wb[1][2 * e + 1] * pb1[2 * e + 1] + wb[2][2 * e + 1] * cb[2 * e + 1];
                ov[e] = pk2(gelu_tanh(ya0) * yb0, gelu_tanh(ya1) * yb1); }
            *(u32x4*)(P->g + (long)(row0 + r) * DFF + c) = ov;
#pragma unroll
            for (int e = 0; e < 8; ++e) { pa2[e] = pa1[e]; pa1[e] = ca[e]; pb2[e] = pb1[e]; pb1[e] = cb[e]; }
        }
    }
}

#define XB_TMO      128
#define XB_XCNT(j)  (256  + 64 * (j))
#define XB_XSUB(j)  (1280 + 64 * (j))
#define XB_XGEN(j)  (2304 + 64 * (j))
#define XB_TOP      3328
#define XB_TOPGEN   3392
#define XCD_BAR_WORDS 3456
#define XB_SPIN_CAP (1u << 18)
DI unsigned xb_ld(unsigned* p)              { return __hip_atomic_load(p, __ATOMIC_RELAXED, __HIP_MEMORY_SCOPE_AGENT); }
DI unsigned xb_add(unsigned* p, unsigned v) { return __hip_atomic_fetch_add(p, v, __ATOMIC_RELAXED, __HIP_MEMORY_SCOPE_AGENT); }
DI unsigned xb_xcc_id() { return (unsigned)__builtin_amdgcn_s_getreg((3 << 11) | 20) & 0xFu; }
#define XB_SPIN(cond, bar) do { unsigned _sp = 0; while (cond) { __builtin_amdgcn_s_sleep(1); \
    if ((++_sp & 255u) == 0u) { if (xb_ld(&(bar)[XB_TMO])) break; if (_sp > XB_SPIN_CAP) { atomicAdd(&(bar)[XB_TMO], 1u); break; } } } } while (0)
DI void xcd_barrier_complete(unsigned* bar, unsigned x, unsigned& nloc, unsigned& nx) {
    const unsigned G = gridDim.x;
    unsigned sum, cnt, mine, sp = 0u;
    for (;;) {
        sum = 0u; cnt = 0u; mine = 0u;
#pragma unroll
        for (unsigned j = 0; j < 16; ++j) { const unsigned c = xb_ld(&bar[XB_XCNT(j)]); sum += c; cnt += (c > 0u) ? 1u : 0u; mine = (j == x) ? c : mine; }
        if (sum == G) break;
        __builtin_amdgcn_s_sleep(1);
        if ((++sp & 255u) == 0u) { if (xb_ld(&bar[XB_TMO])) break; if (sp > XB_SPIN_CAP) { atomicAdd(&bar[XB_TMO], 1u); break; } }
    }
    nloc = mine > 0u ? mine : 1u; nx = cnt > 0u ? cnt : 1u;
}
DI void grid_barrier(char* lds) {
    asm volatile("s_waitcnt vmcnt(0)" ::: "memory");
    __syncthreads();
    if (threadIdx.x == 0) {
        unsigned* bar = kparams()->bar; const unsigned x = xb_xcc_id();
        volatile LAS unsigned* st = (volatile LAS unsigned*)(lds + 131072 + 2048);
        __builtin_amdgcn_s_waitcnt(0);
        unsigned nloc = st[0], nx = st[1];
        if (nloc == 0u) { xcd_barrier_complete(bar, x, nloc, nx); st[0] = nloc; st[1] = nx; }
        const unsigned old = xb_add(&bar[XB_XSUB(x)], 1u);
        const unsigned gen = old / nloc;
        if (old + 1u == (gen + 1u) * nloc) {
            __builtin_amdgcn_fence(__ATOMIC_RELEASE, "agent");
            asm volatile("s_waitcnt vmcnt(0)" ::: "memory");
            const unsigned og = xb_add(&bar[XB_TOP], 1u);
            const unsigned tg = og / nx;
            if (og + 1u == (tg + 1u) * nx) xb_add(&bar[XB_TOPGEN], 1u);
            else XB_SPIN(xb_ld(&bar[XB_TOPGEN]) == tg, bar);
            __builtin_amdgcn_fence(__ATOMIC_ACQUIRE, "agent");
            xb_add(&bar[XB_XGEN(x)], 1u);
            asm volatile("s_waitcnt vmcnt(0)" ::: "memory");
        } else {
            XB_SPIN(xb_ld(&bar[XB_XGEN(x)]) == gen, bar);
            __builtin_amdgcn_fence(__ATOMIC_ACQUIRE, "agent");
            asm volatile("s_waitcnt vmcnt(0)" ::: "memory");
        }
    }
    __syncthreads();
}

__global__ void __launch_bounds__(NTHREADS) fwd_megakernel(Params Pval) {
    extern __shared__ __attribute__((aligned(16))) char lds[];
    cg::grid_group grid = cg::this_grid();
    const int lo = kparams()->phase_lo, hi = kparams()->phase_hi;
#define PH(n) if (lo <= (n) && (n) < hi)
#define SYNC(n) if (lo <= (n) && (n) + 1 < hi) grid_barrier(lds)
    if (hi > 1000) grid.sync();
    { volatile LAS unsigned* st = (volatile LAS unsigned*)(lds + 131072 + 2048);
      if (threadIdx.x == 0) { st[0] = 0u; st[1] = 0u; }
      __syncthreads();
      if (threadIdx.x == 0) (void)xb_add(&kparams()->bar[XB_XCNT(xb_xcc_id())], 1u); }
    PH(0) phase0(kparams(), lds);
#ifdef PROBE_P0
    __syncthreads(); phase0(kparams(), lds);
#endif
#ifdef PROBE_SYNC
    for (int i = 0; i < 24; ++i) grid_barrier(lds);
#endif
    SYNC(0);
    PH(1) phase_h(kparams());
#ifdef PROBE_ROWS
    phase_h(kparams());
#endif
    SYNC(1);
    for (int ph = 2; ph <= 12; ++ph) {
        if (ph == 4) { PH(4) attn_phase(kparams(), lds, 0);
#ifdef PROBE_ATTN2
            __syncthreads(); attn_phase(kparams(), lds, 1);
#endif
            SYNC(4); continue; }
        if (ph == 8) { PH(8) phase_mid(kparams());
#ifdef PROBE_ROWS
            phase_mid(kparams());
#endif
            SYNC(8); continue; }
        if (ph == 10) { PH(10) phase_conv(kparams());
#ifdef PROBE_CONV
            phase_conv(kparams());
#endif
            SYNC(10); continue; }
        if (ph == 12) { PH(12) phase_final(kparams()); continue; }
        if (lo <= ph && ph < hi) {
            const int npass = (ph == 3 || ph == 6) ? 2 : 1;
            for (int pass = 0; pass < npass; ++pass) {
                GemmDesc d; d.C = nullptr; d.ldc = 0; d.start = 0; KP P = kparams();
                switch (ph) {
                case 2: d.A = P->h; d.lda = DM; d.Bt = P->WinT; d.ldb = DM; d.K = DM; d.nM = 65; d.nN = 9; d.epi = E_INPROJ; break;
                case 3: if (pass == 0) { d.A = P->qlat; d.lda = 384; d.Bt = P->WuqT; d.ldb = 384; d.K = 384; d.nM = 65; d.nN = 3; d.epi = E_UQ; }
                        else { d.A = P->latent; d.lda = 256; d.Bt = P->WukvT; d.ldb = 256; d.K = 256; d.nM = 193; d.nN = 4; d.epi = E_UKV; d.start = 195; } break;
                case 5: d.A = P->h; d.lda = DM; d.Bt = P->WgT; d.ldb = DM; d.K = DM; d.nM = 64; d.nN = 8; d.epi = E_GATE; break;
                case 6: d.A = P->o + pass * 512; d.lda = DM; d.Bt = pass ? P->WpbT : P->WpaT; d.ldb = 512; d.K = 512; d.nM = 64; d.nN = 4; d.epi = pass ? E_PROJB : E_PROJA; break;
                case 7: d.A = P->merged; d.lda = DM; d.Bt = P->WoutT; d.ldb = DM; d.K = DM; d.nM = 64; d.nN = 4; d.epi = E_PLAIN; d.C = P->m2; d.ldc = DM; break;
                case 9: d.A = P->h2; d.lda = DM; d.Bt = P->WupT; d.ldb = DM; d.K = DM; d.nM = 65; d.nN = 22; d.epi = E_UP; break;
                default: d.A = P->g; d.lda = DFF; d.Bt = P->WdownT; d.ldb = DFF; d.K = DFF; d.nM = 64; d.nN = 4; d.epi = E_PLAIN; d.C = P->f; d.ldc = DM; break;
                }
                gemm_run(d, lds);
#ifdef PROBE_GEMM2
                if (ph == PROBE_GEMM2 && !(ph == 6 && pass == 0)) { __syncthreads(); if (ph == 6) { GemmDesc d0 = d; d0.A = P->o; d0.Bt = P->WpaT; d0.epi = E_PROJA; gemm_run(d0, lds); } gemm_run(d, lds); }
#endif
            }
        }
        if (lo <= ph && ph < hi) {
            KP P = kparams();
            if (ph == 5) gemm_small<1, 8>(P, P->h, DM, P->WgT, DM, 2048, P->gates, 2048, lds);
            else if (ph == 6) gemm_small<2, 4>(P, P->o, DM, P->WpaT, 512, 1024, P->merged, DM, lds);
            else if (ph == 7) gemm_small<0, 8>(P, P->merged, DM, P->WoutT, DM, 1024, P->m2, DM, lds);
            else if (ph == 11) gemm_small<0, 22>(P, P->g, DFF, P->WdownT, DFF, 1024, P->f, DM, lds);
#ifdef PROBE_SMALL
            if (ph == 5) gemm_small<1, 8>(P, P->h, DM, P->WgT, DM, 2048, P->gates, 2048, lds);
            else if (ph == 6) gemm_small<2, 4>(P, P->o, DM, P->WpaT, 512, 1024, P->merged, DM, lds);
            else if (ph == 7) gemm_small<0, 8>(P, P->merged, DM, P->WoutT, DM, 1024, P->m2, DM, lds);
            else if (ph == 11) gemm_small<0, 22>(P, P->g, DFF, P->WdownT, DFF, 1024, P->f, DM, lds);
#endif
        }
        SYNC(ph);
    }
}

static size_t bump(size_t& off, size_t bytes) { size_t r = off; off += (bytes + 255) & ~(size_t)255; return r; }

extern "C" void kernel_launch(void* const* d_in, const int* in_sizes, int n_in, void* d_out, int out_size, void* d_ws, size_t ws_size, hipStream_t stream) {
    Params P; memset(&P, 0, sizeof(P));
    const float* const* in = (const float* const*)d_in;
    P.x_p = in[0]; P.x_s = in[1]; P.c_ckv = in[2]; P.c_kr = in[3]; P.c_sbk = in[4]; P.c_sbv = in[5]; P.c_conv = in[6]; P.c_p = in[7]; P.c_s = in[8];
    P.w_ada = in[9]; P.b_ada = in[10]; P.g_pre_mix = in[11]; P.g_post_mix = in[12]; P.g_pre_ffn = in[13]; P.g_post_ffn = in[14];
    const float* w_in = in[15]; const float* g_q = in[16]; const float* w_uq = in[17]; P.g_kv = in[18]; const float* w_uk = in[19]; const float* w_uv = in[20];
    const float* w_pa = in[21]; const float* w_pb = in[22]; const float* w_out = in[23]; const float* w_up = in[24]; P.conv_w = in[25]; P.conv_b = in[26]; const float* w_down = in[27];
    P.out = (float*)d_out;
    char* ws = (char*)d_ws; size_t off = 0;
    P.WupT = (bf16_t*)(ws + bump(off, (size_t)DFF2 * DM * 2));
    P.WdownT = (bf16_t*)(ws + bump(off, (size_t)DM * DFF * 2));
    P.ropeT = (float*)(ws + bump(off, (size_t)TP * 32 * 4));
    P.ada = (float*)(ws + bump(off, 10 * 6144 * 4));
    P.ctr = (unsigned*)(ws + bump(off, 256));
    P.bar = (unsigned*)(ws + bump(off, XCD_BAR_WORDS * 4));
    const size_t R0 = off;
    P.WinT = (bf16_t*)(ws + bump(off, (size_t)2304 * DM * 2));
    P.WgT = (bf16_t*)(ws + bump(off, (size_t)2048 * DM * 2));
    P.WuqT = (bf16_t*)(ws + bump(off, (size_t)768 * 384 * 2));
    P.WukvT = (bf16_t*)(ws + bump(off, (size_t)1024 * 256 * 2));
    P.WpaT = (bf16_t*)(ws + bump(off, (size_t)1024 * 512 * 2));
    P.WpbT = (bf16_t*)(ws + bump(off, (size_t)1024 * 512 * 2));
    P.WoutT = (bf16_t*)(ws + bump(off, (size_t)1024 * 1024 * 2));
    const size_t o_kva = off;
    P.kva = (bf16_t*)(ws + bump(off, (size_t)KVROWS_PAD * 512 * 2));
    P.vaT_p = (bf16_t*)(ws + bump(off, (size_t)2 * 512 * TP * 2));
    P.vaT_s = (bf16_t*)(ws + bump(off, (size_t)8 * 512 * SKP * 2));
    const size_t o_kb = off;
    P.kb = (bf16_t*)(ws + bump(off, (size_t)KVROWS_PAD * 512 * 2));
    const size_t o_vbT = off;
    P.vbT_p = (bf16_t*)(ws + bump(off, (size_t)2 * 512 * TP * 2));
    P.vbT_s = (bf16_t*)(ws + bump(off, (size_t)8 * 512 * SKP * 2));
    const size_t o_kr = off;
    P.krope = (bf16_t*)(ws + bump(off, (size_t)KVROWS_PAD * 32 * 2));
    P.qb = (bf16_t*)(ws + bump(off, (size_t)MT * 512 * 2));
    P.q = (bf16_t*)(ws + bump(off, (size_t)MT * 768 * 2));
    P.latent = (bf16_t*)(ws + bump(off, (size_t)KVROWS_PAD * 256 * 2));
    size_t need = off;
    P.gates = (bf16_t*)(ws + o_kva);
    P.merged = (bf16_t*)(ws + o_kb);
    P.m2 = (bf16_t*)(ws + o_vbT);
    P.u = (bf16_t*)(ws + R0);
    const size_t o_g = R0 + (size_t)MT * DFF2 * 2;
    P.g = (bf16_t*)(ws + o_g);
    P.f = (bf16_t*)(ws + R0);
    size_t o_h2 = o_kr > o_g ? o_kr : o_g;
    P.h2 = (bf16_t*)(ws + o_h2);
    if (o_g + (size_t)MT * DFF * 2 > need) need = o_g + (size_t)MT * DFF * 2;
    if (o_h2 + (size_t)MT * DM * 2 > need) need = o_h2 + (size_t)MT * DM * 2;
    P.h = (bf16_t*)d_out;
    P.o = (bf16_t*)d_out + (size_t)MT * DM;
    P.qlat = P.o;
    if (need > ws_size) { fprintf(stderr, "workspace too small: need %zu have %zu\n", need, ws_size); return; }

    int nj = 0, tiles = 0;
    auto job = [&](const float* src, int lds, int coff, bf16_t* dst, int ldd, int Klen, int Nlen, const float* ks, int zero) {
        TJob& J = P.tj[nj++]; J.src = src; J.kscale = ks; J.dst = dst; J.lds = lds; J.coff = coff; J.ldd = ldd; J.Klen = Klen; J.Nlen = Nlen; J.zero = zero; J.tile0 = tiles; J.pad = 0;
        tiles += (Klen / 64) * ((Nlen + 255) / 256); };
    job(w_up, DFF2, 0, P.WupT, DM, DM, DFF2, nullptr, 0);
    job(w_down, DM, 0, P.WdownT, DFF, DFF, DM, nullptr, 0);
    job(w_in, 4256, 0, P.WinT, DM, DM, 384, nullptr, 0);
    job(w_in, 4256, 640, P.WinT + (size_t)384 * DM, DM, DM, 32, nullptr, 0);
    job(w_in, 4256, 0, P.WinT + (size_t)416 * DM, DM, DM, 96, nullptr, 1);
    job(w_in, 4256, 384, P.WinT + (size_t)512 * DM, DM, DM, 256, nullptr, 0);
    job(w_in, 4256, 672, P.WinT + (size_t)768 * DM, DM, DM, 1536, nullptr, 0);
    job(w_in, 4256, 2208, P.WgT, DM, DM, 2048, nullptr, 0);
    job(w_uq, 768, 0, P.WuqT, 384, 384, 768, g_q, 0);
    job(w_uk, 512, 0, P.WukvT, 256, 256, 512, nullptr, 0);
    job(w_uv, 512, 0, P.WukvT + (size_t)512 * 256, 256, 256, 512, nullptr, 0);
    job(w_pa, DM, 0, P.WpaT, 512, 512, DM, nullptr, 0);
    job(w_pb, DM, 0, P.WpbT, 512, 512, DM, nullptr, 0);
    job(w_out, DM, 0, P.WoutT, DM, DM, DM, nullptr, 0);
    P.ntj_tiles = tiles; P.pad0 = nj;
    P.phase_lo = 0; P.phase_hi = 13;

    static int grid_blocks = 0;
    if (!grid_blocks) {
        (void)hipFuncSetAttribute((const void*)fwd_megakernel, hipFuncAttributeMaxDynamicSharedMemorySize, LDS_BYTES);
        int dev = 0, cus = 0, per_cu = 0;
        (void)hipGetDevice(&dev);
        (void)hipDeviceGetAttribute(&cus, hipDeviceAttributeMultiprocessorCount, dev);
        (void)hipOccupancyMaxActiveBlocksPerMultiprocessor(&per_cu, fwd_megakernel, NTHREADS, LDS_BYTES);
        if (per_cu > 1) per_cu = 1;
        grid_blocks = cus * per_cu;
    }
    (void)hipMemsetAsync(P.ctr, 0, 256 + XCD_BAR_WORDS * 4, stream);
    void* args[] = {&P};
    hipError_t e = hipLaunchCooperativeKernel((const void*)fwd_megakernel, dim3(grid_blocks), dim3(NTHREADS), args, LDS_BYTES, stream);
    if (e != hipSuccess) fprintf(stderr, "cooperative launch failed: %s (grid %d)\n", hipGetErrorString(e), grid_blocks);
}
```

```cpp
#include <hip/hip_runtime.h>
#include <hip/hip_cooperative_groups.h>
#include <stdint.h>
#include <stdio.h>
#include <string.h>
namespace cg = cooperative_groups;

typedef unsigned short bf16_t;
typedef short bf16x8 __attribute__((ext_vector_type(8)));
typedef short s16x4 __attribute__((ext_vector_type(4)));
typedef float f32x2 __attribute__((ext_vector_type(2)));
typedef float f32x4 __attribute__((ext_vector_type(4)));
typedef float f32x16 __attribute__((ext_vector_type(16)));
typedef unsigned u32x2 __attribute__((ext_vector_type(2)));
typedef unsigned u32x4 __attribute__((ext_vector_type(4)));
typedef __bf16 bf2_t __attribute__((ext_vector_type(2)));
#define DI __device__ __forceinline__

constexpr int DM = 1024, TP = 8192, MP = 16384, MS = 256, MT = 16640, PAST = 4096, SKEYS = 4128, SKP = 4160;
constexpr int KVROWS = MP + 8 * SKEYS;
constexpr int KVROWS_PAD = KVROWS + 64;
constexpr int DFF = 2816, DFF2 = 5632;
constexpr float EPS = 1e-6f;
constexpr float LOG2E = 1.4426950408889634f, LN2 = 0.6931471805599453f;
constexpr int NTHREADS = 512;
constexpr int LDS_BYTES = 131072 + 8192;
constexpr long O_Y = 0, O_CKV_P = 17039360, O_KR_P = 21233664, O_SBK_P = 21757952, O_SBV_P = 30146560, O_CONV_P = 38535168,
               O_CKV_S = 38557696, O_KR_S = 38623232, O_SBK_S = 38631424, O_SBV_S = 38762496, O_CONV_S = 38893568;

struct TJob { const float* src; const float* kscale; bf16_t* dst; int lds, coff, ldd, Klen, Nlen, zero, tile0, pad; };
constexpr int NTJ = 22;

struct Params {
    const float *x_p, *x_s, *c_ckv, *c_kr, *c_sbk, *c_sbv, *c_conv, *c_p, *c_s;
    const float *w_ada, *b_ada, *g_pre_mix, *g_post_mix, *g_pre_ffn, *g_post_ffn, *g_kv, *conv_w, *conv_b;
    float* out;
    bf16_t *WupT, *WdownT, *WinT, *WgT, *WuqT, *WukvT, *WpaT, *WpbT, *WoutT;
    float* ropeT; float* ada; unsigned* ctr; unsigned* bar;
    bf16_t *h, *o, *qlat, *latent, *krope, *kb, *vbT_p, *vbT_s, *qb, *q, *kva, *vaT_p, *vaT_s, *gates, *merged, *m2, *h2, *u, *g, *f;
    TJob tj[NTJ]; int ntj_tiles; int phase_lo, phase_hi, pad0;
};

#define LAS __attribute__((address_space(3)))
typedef const Params __attribute__((address_space(4))) * KP;
DI KP kparams() { KP p = (KP)__builtin_amdgcn_kernarg_segment_ptr(); asm volatile("" : "+s"(p)); return p; }
DI int otid() { int t = threadIdx.x; asm volatile("" : "+v"(t)); return t; }
DI int obid() { int b = blockIdx.x; asm volatile("" : "+s"(b)); return b; }
DI int ogrid() { int g = gridDim.x; asm volatile("" : "+s"(g)); return g; }
DI unsigned pk2(float a, float b) { f32x2 f = {a, b}; bf2_t r = __builtin_convertvector(f, bf2_t); return __builtin_bit_cast(unsigned, r); }
DI float bf_lo(unsigned u) { return __uint_as_float(u << 16); }
DI float bf_hi(unsigned u) { return __uint_as_float(u & 0xffff0000u); }
DI int kvrow_of(int row) { if (row < MP) return row; const int r = row - MP; return MP + (r >> 5) * SKEYS + PAST + (r & 31); }
DI int pos_of(int row) { return row < MP ? (row & (TP - 1)) : PAST + ((row - MP) & 31); }
DI int ada_b(int row) { return row < MP ? (row >> 13) : 2 + ((row - MP) >> 5); }
DI float sigmoidf_(float x) { return 1.0f / (1.0f + __expf(-x)); }

constexpr int BM = 256, BK = 64, HALF = 128, HT = HALF * BK;
DI int lds_byte(int r, int c) { int st = (r >> 4) * 2 + (c >> 5), rr = r & 15, cc = c & 31, ob = rr * 64 + cc * 2; return st * 1024 + (ob ^ (((ob >> 9) & 1) << 5)); }
DI void stage_rc(int b, int& R, int& C) { int st = b / 1024, sb = b % 1024, swz = sb ^ (((sb >> 9) & 1) << 5); R = (st >> 1) * 16 + swz / 64; C = (st & 1) * 32 + (swz % 64) / 2; }

enum { E_INPROJ = 0, E_GATE, E_UQ, E_UKV, E_PROJA, E_PROJB, E_PLAIN, E_UP };
struct GemmDesc { const bf16_t* A; const bf16_t* Bt; bf16_t* C; int lda, ldb, ldc, K, nM, nN, epi, start; };

constexpr int HTB = HT * 2;
#define SA(b, h) (((b) * 2 + (h)) * HTB)
#define SB(b, h) ((4 + (b) * 2 + (h)) * HTB)
#define STAGE(bufoff, gbase, voff) do { _Pragma("unroll") for (int _i = 0; _i < 2; ++_i) \
    __builtin_amdgcn_global_load_lds((const unsigned*)((const char*)(gbase) + (voff)[_i]), (LAS unsigned*)(ldsl + (bufoff) + ldsw + _i * 8192), 16, 0, 0); } while (0)
#define LDA(dst, b, h) do { _Pragma("unroll") for (int m = 0; m < 4; ++m) _Pragma("unroll") for (int k = 0; k < 2; ++k) dst[m][k] = *(const LAS bf16x8*)(ldsl + SA(b, h) + aoff + m * 2048 + k * 1024); } while (0)
#define LDB(dst, b, h) do { _Pragma("unroll") for (int n = 0; n < 2; ++n) _Pragma("unroll") for (int k = 0; k < 2; ++k) dst[n][k] = *(const LAS bf16x8*)(ldsl + SB(b, h) + boff + n * 2048 + k * 1024); } while (0)
#define MMA(ai, bj, At, Bt_) do { __builtin_amdgcn_s_setprio(1); _Pragma("unroll") for (int m = 0; m < 4; ++m) _Pragma("unroll") for (int n = 0; n < 2; ++n) _Pragma("unroll") for (int k = 0; k < 2; ++k) \
      acc[ai][bj][m][n] = __builtin_amdgcn_mfma_f32_16x16x32_bf16(Bt_[n][k], At[m][k], acc[ai][bj][m][n], 0, 0, 0); \
    __builtin_amdgcn_s_setprio(0); } while (0)
#define WAIT_V(n) asm volatile("s_waitcnt vmcnt(" #n ")" ::: "memory")
#define WAIT_L(n) asm volatile("s_waitcnt lgkmcnt(" #n ")" ::: "memory")
#define BAR __builtin_amdgcn_s_barrier()
#define SCHED __builtin_amdgcn_sched_barrier(0)
#define ZERO_ACC do { _Pragma("unroll") for (int a_ = 0; a_ < 2; ++a_) _Pragma("unroll") for (int b_ = 0; b_ < 2; ++b_) _Pragma("unroll") for (int m_ = 0; m_ < 4; ++m_) _Pragma("unroll") for (int n_ = 0; n_ < 2; ++n_) \
    acc[a_][b_][m_][n_] = (f32x4){0.f, 0.f, 0.f, 0.f}; } while (0)

#define EPI_ROWS for (int ai = 0; ai < 2; ++ai) for (int m = 0; m < 4; ++m, ({ asm volatile("" ::: "memory"); }))
#define EPI_COLS for (int bj = 0; bj < 2; ++bj) for (int n = 0; n < 2; ++n)

DI float dpp_xor1(float x) { return __int_as_float(__builtin_amdgcn_mov_dpp(__float_as_int(x), 0xB1, 0xF, 0xF, true)); }
DI float dpp_xor2(float x) { return __int_as_float(__builtin_amdgcn_mov_dpp(__float_as_int(x), 0x4E, 0xF, 0xF, true)); }
DI f32x4 quad_transpose(f32x4 v, int i) {
    { const float a = (i & 1) ? v[0] : v[1], c = (i & 1) ? v[2] : v[3]; const float ra = dpp_xor1(a), rc = dpp_xor1(c);
      if (i & 1) { v[0] = ra; v[2] = rc; } else { v[1] = ra; v[3] = rc; } }
    { const float a = (i & 2) ? v[0] : v[2], c = (i & 2) ? v[1] : v[3]; const float ra = dpp_xor2(a), rc = dpp_xor2(c);
      if (i & 2) { v[0] = ra; v[1] = rc; } else { v[2] = ra; v[3] = rc; } }
    return v;
}
DI void store_bf4(bf16_t* p, f32x4 v) { u32x2 w; w.x = pk2(v[0], v[1]); w.y = pk2(v[2], v[3]); *(u32x2*)p = w; }

DI int unit_at(int k, int bid, int G, int nM, int nN, int start) {
    if (G != 256) { const int u = (bid + G - (start % G)) % G + k * G; return u < nM * nN ? u : -1; }
    const int x = bid & 7, l = ((bid >> 3) + start) & 31, cnt = nM >> 3, mainn = cnt * nN, j = l + 32 * k;
    if (j < mainn) { const int pn = j / cnt, rm = j - pn * cnt; return (x + 8 * rm) * nN + pn; }
    const int idx = x + 8 * (j - mainn);
    if (idx < (nM & 7) * nN) return (8 * cnt + idx / nN) * nN + idx % nN;
    return -1;
}

DI void gemm_run(const GemmDesc& d, char* lds) {
    LAS char* ldsl = (LAS char*)lds;
    float* xl = (float*)(lds + 131072);
    float* xp = (float*)(lds + 131072 + 4096);
    const int G = ogrid(), bid_ = obid(), first = unit_at(0, bid_, G, d.nM, d.nN, d.start);
    if (first < 0) return;
    int kun = 0;
    const int tid = otid(), wid = __builtin_amdgcn_readfirstlane(tid >> 6), wr = wid >> 2, wc = wid & 3;
    const unsigned lda2 = (unsigned)d.lda * 2u, ldb2 = (unsigned)d.ldb * 2u;
    unsigned voffA[2], voffB[2];
    { const int lane = tid & 63;
#pragma unroll
      for (int i = 0; i < 2; ++i) { int R, C; stage_rc(tid * 16 + i * 8192, R, C); voffA[i] = (unsigned)R * lda2 + (unsigned)C * 2u; voffB[i] = (unsigned)R * ldb2 + (unsigned)C * 2u; }
      (void)lane; }
    const size_t kstep = 128, hA = (size_t)HALF * lda2, hB = (size_t)HALF * ldb2;
    const unsigned ldsw = (unsigned)wid * 1024u;
    const int aoff = lds_byte(wr * 64 + (tid & 15), ((tid & 63) >> 4) * 8), boff = lds_byte(wc * 32 + (tid & 15), ((tid & 63) >> 4) * 8);
    const int nt = d.K / BK;
    int u = first;
    const char* cA = (const char*)d.A + (size_t)(u / d.nN) * 2 * hA; const char* cB = (const char*)d.Bt + (size_t)(u % d.nN) * 2 * hB;
    f32x4 acc[2][2][4][2];
    ZERO_ACC;
    bf16x8 At[4][2], B0[2][2], B1[2][2];
    STAGE(SB(0, 0), cB, voffB); STAGE(SB(0, 1), cB + hB, voffB); STAGE(SA(0, 0), cA, voffA); STAGE(SA(0, 1), cA + hA, voffA);
    if (wr == 1) BAR;
    WAIT_V(2); BAR;
    STAGE(SB(1, 0), cB + kstep, voffB); STAGE(SA(1, 0), cA + kstep, voffA); STAGE(SB(1, 1), cB + hB + kstep, voffB);
    WAIT_V(6); BAR;
    for (;;) {
        const int un = unit_at(kun + 1, bid_, G, d.nM, d.nN, d.start); const bool has_next = un >= 0;
        const char* nA = has_next ? (const char*)d.A + (size_t)(un / d.nN) * 2 * hA : cA; const char* nB = has_next ? (const char*)d.Bt + (size_t)(un % d.nN) * 2 * hB : cB;
        for (int t = 0; t < nt; t += 2) {
            const bool last = (t == nt - 2);
            const char* a1 = cA + (size_t)(t + 1) * kstep;
            const char* a2 = last ? nA : cA + (size_t)(t + 2) * kstep; const char* b2 = last ? nB : cB + (size_t)(t + 2) * kstep;
            const char* a3 = a2 + kstep; const char* b3 = b2 + kstep;
            LDB(B0, 0, 0); LDB(B1, 0, 1); SCHED; LDA(At, 0, 0); STAGE(SA(1, 1), a1 + hA, voffA);
            WAIT_V(8); WAIT_L(0); BAR; MMA(0, 0, At, B0); MMA(0, 1, At, B1); BAR; SCHED;
            LDA(At, 0, 1); STAGE(SB(0, 0), b2, voffB); STAGE(SB(0, 1), b2 + hB, voffB); STAGE(SA(0, 0), a2, voffA);
            WAIT_V(8); WAIT_L(0); BAR; MMA(1, 0, At, B0); MMA(1, 1, At, B1); BAR; SCHED;
            LDB(B0, 1, 0); LDB(B1, 1, 1); SCHED; LDA(At, 1, 0); STAGE(SA(0, 1), a2 + hA, voffA);
            WAIT_V(8); WAIT_L(0); BAR; MMA(0, 0, At, B0); MMA(0, 1, At, B1); BAR; SCHED;
            LDA(At, 1, 1); STAGE(SB(1, 0), b3, voffB); STAGE(SB(1, 1), b3 + hB, voffB); STAGE(SA(1, 0), a3, voffA);
            WAIT_V(8); WAIT_L(0); BAR; MMA(1, 0, At, B0); MMA(1, 1, At, B1); BAR; SCHED;
        }
        if (wr == 0) BAR;
        {
        const int pm = u / d.nN, pn = u % d.nN, brow = pm * BM, bcol = pn * BM;
        if (d.epi == E_UQ) {
            const int tq_ = otid(), r = tq_ >> 1, hf = tq_ & 1;
            const u32x4* src = (const u32x4*)(d.A + (long)(brow + r) * 384 + hf * 192);
            float sq = 0.f;
#pragma unroll 4
            for (int i = 0; i < 24; ++i) { u32x4 v = src[i];
                for (int e = 0; e < 4; ++e) { float a_ = bf_lo(v[e]), b_ = bf_hi(v[e]); sq += a_ * a_ + b_ * b_; } }
            sq += __shfl_xor(sq, 1);
            if (hf == 0) xl[r] = rsqrtf(sq * (1.0f / 384.0f) + EPS);
            WAIT_L(0); BAR; asm volatile("" ::: "memory");
        }
        int lane_e = threadIdx.x & 63; asm volatile("" : "+v"(lane_e));
        const int fr = lane_e & 15, fq = lane_e >> 4;
        KP P = kparams();
        const int rbase = brow + wr * 64 + fr, cbase = bcol + wc * 32 + fq * 4;
        switch (d.epi) {
        case E_INPROJ: {
            if (pn == 0) {
#pragma unroll
                EPI_ROWS { const int row = rbase + ai * 128 + m * 16;
#pragma unroll
                    EPI_COLS store_bf4(P->qlat + (long)row * 384 + (cbase + bj * 128 + n * 16), acc[ai][bj][m][n]); }
            } else if (pn == 1) {
#pragma unroll
                EPI_ROWS { const int row = rbase + ai * 128 + m * 16;
#pragma unroll
                    for (int n = 0; n < 2; ++n) store_bf4(P->qlat + (long)row * 384 + 256 + (wc * 32 + fq * 4 + n * 16), acc[ai][0][m][n]);
                    if (wc == 0) {
                        const int pos = pos_of(row);
                        const f32x4 cs0 = *(const f32x4*)(P->ropeT + (long)pos * 32 + fq * 8), cs1 = *(const f32x4*)(P->ropeT + (long)pos * 32 + fq * 8 + 4);
                        const f32x4 x1 = acc[ai][1][m][0], x2 = acc[ai][1][m][1];
                        f32x4 co = {cs0[0], cs0[2], cs1[0], cs1[2]}, si = {cs0[1], cs0[3], cs1[1], cs1[3]};
                        f32x4 o1 = x1 * co - x2 * si, o2 = x2 * co + x1 * si;
                        float* of = P->out + (row < MP ? O_KR_P + (long)row * 32 : O_KR_S + (long)(row - MP) * 32);
                        *(f32x4*)(of + fq * 4) = o1; *(f32x4*)(of + 16 + fq * 4) = o2;
                        bf16_t* ob = P->krope + (long)kvrow_of(row) * 32;
                        store_bf4(ob + fq * 4, o1); store_bf4(ob + 16 + fq * 4, o2);
                    } }
            } else if (pn == 2) {
                float ss[2][4];
#pragma unroll
                EPI_ROWS { float s = 0.f;
#pragma unroll
                    EPI_COLS { const f32x4 v = acc[ai][bj][m][n]; s += v[0] * v[0] + v[1] * v[1] + v[2] * v[2] + v[3] * v[3]; }
                    s += __shfl_xor(s, 16); s += __shfl_xor(s, 32); ss[ai][m] = s;
                    if (fq == 0) xp[(ai * 128 + wr * 64 + m * 16 + fr) * 4 + wc] = s; }
                WAIT_L(0); BAR; asm volatile("" ::: "memory");
#pragma unroll
                EPI_ROWS { const int rl = ai * 128 + wr * 64 + m * 16 + fr, row = brow + rl;
                    const f32x4 pp = *(const f32x4*)(xp + rl * 4);
                    const float rstd = rsqrtf((pp[0] + pp[1] + pp[2] + pp[3]) * (1.0f / 256.0f) + EPS);
                    float* of = P->out + (row < MP ? O_CKV_P + (long)row * 256 : O_CKV_S + (long)(row - MP) * 256);
                    bf16_t* ob = P->latent + (long)kvrow_of(row) * 256;
#pragma unroll
                    EPI_COLS { const int c = wc * 32 + fq * 4 + bj * 128 + n * 16;
                        const f32x4 gv = *(const f32x4*)(P->g_kv + c); const f32x4 o = acc[ai][bj][m][n] * rstd * gv;
                        *(f32x4*)(of + c) = o; store_bf4(ob + c, o); } }
            } else if (pn <= 4) {
#pragma unroll
                EPI_ROWS { const int row = rbase + ai * 128 + m * 16;
#pragma unroll
                    EPI_COLS store_bf4(P->qb + (long)row * 512 + (cbase - 768 + bj * 128 + n * 16), acc[ai][bj][m][n] * 0.125f); }
            } else if (pn <= 6) {
#pragma unroll
                EPI_ROWS { const int row = rbase + ai * 128 + m * 16;
                    float* of = P->out + (row < MP ? O_SBK_P + (long)row * 512 : O_SBK_S + (long)(row - MP) * 512);
                    bf16_t* ob = P->kb + (long)kvrow_of(row) * 512;
#pragma unroll
                    EPI_COLS { const int c = cbase - 1280 + bj * 128 + n * 16; *(f32x4*)(of + c) = acc[ai][bj][m][n]; store_bf4(ob + c, acc[ai][bj][m][n]); } }
            } else {
#pragma unroll
                EPI_ROWS { const int row = rbase + ai * 128 + m * 16;
                    float* of = P->out + (row < MP ? O_SBV_P + (long)row * 512 : O_SBV_S + (long)(row - MP) * 512);
                    const int qi = fr & 3, row4 = row - qi;
                    bf16_t* vt; int ldv;
                    if (row4 < MP) { vt = P->vbT_p + (long)(row4 >> 13) * 512 * TP + (row4 & (TP - 1)); ldv = TP; }
                    else { const int r = row4 - MP; vt = P->vbT_s + (long)(r >> 5) * 512 * SKP + PAST + (r & 31); ldv = SKP; }
#pragma unroll
                    EPI_COLS { const int c = cbase - 1792 + bj * 128 + n * 16; const f32x4 v = acc[ai][bj][m][n]; *(f32x4*)(of + c) = v;
                        store_bf4(vt + (long)(c + qi) * ldv, quad_transpose(v, qi)); } }
            }
        } break;
        case E_GATE: {
#pragma unroll
            EPI_ROWS { const int row = rbase + ai * 128 + m * 16;
#pragma unroll
                EPI_COLS { const f32x4 v = acc[ai][bj][m][n]; f32x4 s = {sigmoidf_(v[0]), sigmoidf_(v[1]), sigmoidf_(v[2]), sigmoidf_(v[3])};
                    store_bf4(P->gates + (long)row * 2048 + (cbase + bj * 128 + n * 16), s); } }
        } break;
        case E_UQ: {
            const float qs = 0.10206207261596577f * LOG2E;
#pragma unroll
            EPI_ROWS { const int rl = ai * 128 + wr * 64 + m * 16 + fr, row = brow + rl; const float rs = xl[rl] * qs;
#pragma unroll
                for (int bj = 0; bj < 2; ++bj) { const int grp = pn * 8 + bj * 4 + wc; bf16_t* dst = P->q + (long)row * 768 + grp * 32 + fq * 4;
                    f32x4 v0 = acc[ai][bj][m][0] * rs, v1 = acc[ai][bj][m][1] * rs;
                    if (grp % 3 == 2) {
                        const int pos = pos_of(row);
                        const f32x4 cs0 = *(const f32x4*)(P->ropeT + (long)pos * 32 + fq * 8), cs1 = *(const f32x4*)(P->ropeT + (long)pos * 32 + fq * 8 + 4);
                        f32x4 co = {cs0[0], cs0[2], cs1[0], cs1[2]}, si = {cs0[1], cs0[3], cs1[1], cs1[3]};
                        const f32x4 o1 = v0 * co - v1 * si, o2 = v1 * co + v0 * si; v0 = o1; v1 = o2;
                    }
                    store_bf4(dst, v0); store_bf4(dst + 16, v1); } }
        } break;
        case E_UKV: {
#pragma unroll
            EPI_ROWS { const int row = rbase + ai * 128 + m * 16;
                if (pn < 2) {
#pragma unroll
                    EPI_COLS store_bf4(P->kva + (long)row * 512 + (cbase + bj * 128 + n * 16), acc[ai][bj][m][n]);
                } else {
                    const int qi = fr & 3, row4 = row - qi;
                    bf16_t* vt; int ldv;
                    if (row4 < MP) { vt = P->vaT_p + (long)(row4 >> 13) * 512 * TP + (row4 & (TP - 1)); ldv = TP; }
                    else { const int r = row4 - MP, b = r / SKEYS; vt = P->vaT_s + (long)b * 512 * SKP + (r - b * SKEYS); ldv = SKP; }
#pragma unroll
                    EPI_COLS { const int c = cbase - 512 + bj * 128 + n * 16; const f32x4 vtr = quad_transpose(acc[ai][bj][m][n], qi);
                        if (row4 < KVROWS) store_bf4(vt + (long)(c + qi) * ldv, vtr); }
                } }
        } break;
        case E_PROJA: case E_PROJB: {
            const int goff = d.epi == E_PROJA ? 0 : 1024;
#pragma unroll
            EPI_ROWS { const int row = rbase + ai * 128 + m * 16;
#pragma unroll
                EPI_COLS { const int c = cbase + bj * 128 + n * 16; const u32x2 gw = *(const u32x2*)(P->gates + (long)row * 2048 + goff + c);
                    f32x4 gv = {bf_lo(gw.x), bf_hi(gw.x), bf_lo(gw.y), bf_hi(gw.y)}; f32x4 v = acc[ai][bj][m][n] * gv;
                    bf16_t* dst = P->merged + (long)row * 1024 + c;
                    if (d.epi == E_PROJB) { const u32x2 pw = *(const u32x2*)dst; f32x4 pv = {bf_lo(pw.x), bf_hi(pw.x), bf_lo(pw.y), bf_hi(pw.y)}; v += pv; }
                    store_bf4(dst, v); } }
        } break;
        case E_PLAIN: {
#pragma unroll
            EPI_ROWS { const int row = rbase + ai * 128 + m * 16;
#pragma unroll
                EPI_COLS store_bf4(d.C + (long)row * d.ldc + (cbase + bj * 128 + n * 16), acc[ai][bj][m][n]); }
        } break;
        case E_UP: {
#pragma unroll
            EPI_ROWS { const int row = rbase + ai * 128 + m * 16;
                float* cf = nullptr;
                if (row < MP) { const int t = row & (TP - 1); if (t >= TP - 2) cf = P->out + O_CONV_P + (long)((row >> 13) * 2 + (t - (TP - 2))) * DFF2; }
                else { const int r = row - MP, t = r & 31; if (t >= 30) cf = P->out + O_CONV_S + (long)((r >> 5) * 2 + (t - 30)) * DFF2; }
#pragma unroll
                EPI_COLS { const int c = cbase + bj * 128 + n * 16; store_bf4(P->u + (long)row * DFF2 + c, acc[ai][bj][m][n]);
                    if (cf) *(f32x4*)(cf + c) = acc[ai][bj][m][n]; } }
        } break;
        }
        }
        if (!has_next) break;
        ZERO_ACC;
        u = un; cA = nA; cB = nB; ++kun;
        if (wr == 1) BAR;
    }
    WAIT_V(0);
    BAR;
}

#define MFMA32(a, b, c) __builtin_amdgcn_mfma_f32_32x32x16_bf16((a), (b), (c), 0, 0, 0)
template <int KIND, int KSTEPS  >
DI void gemm_small(KP P, const bf16_t* A, int lda, const bf16_t* Bt, int ldb, int N, bf16_t* C, int ldc, char* lds) {
    const int tid = otid(), lane = tid & 63, w = tid >> 6, r = lane & 31, hh = lane >> 5, G = ogrid();
    const int ntask = 8 * (N >> 5);
    float* part = (float*)lds;
    for (int task = obid(); task < ntask; task += G) {
        const int cb = (task & 7) + 8 * (task >> 6), rb = (task >> 3) & 7, row0 = MP + rb * 32, col0 = cb * 32;
#pragma unroll
        for (int pass = 0; pass < (KIND == 2 ? 2 : 1); ++pass) {
            const bf16_t* ap = A + pass * 512 + (long)(row0 + r) * lda + w * (KSTEPS * 16) + 8 * hh;
            const bf16_t* bp = (pass ? P->WpbT : Bt) + (long)(col0 + r) * ldb + w * (KSTEPS * 16) + 8 * hh;
            f32x16 acc;
#pragma unroll
            for (int i = 0; i < 16; ++i) acc[i] = 0.f;
            constexpr int UN = KSTEPS > 11 ? 11 : KSTEPS;
#pragma unroll 1
            for (int s0 = 0; s0 < KSTEPS; s0 += UN) {
                bf16x8 af[UN], bf[UN];
#pragma unroll
                for (int s = 0; s < UN; ++s) { af[s] = *(const bf16x8*)(ap + (s0 + s) * 16); bf[s] = *(const bf16x8*)(bp + (s0 + s) * 16); }
#pragma unroll
                for (int s = 0; s < UN; ++s) acc = MFMA32(bf[s], af[s], acc);
            }
            float* pp = part + ((pass * 8 + w) * 32 + r) * 32 + 4 * hh;
#pragma unroll
            for (int g = 0; g < 4; ++g) *(f32x4*)(pp + 8 * g) = (f32x4){acc[4 * g], acc[4 * g + 1], acc[4 * g + 2], acc[4 * g + 3]};
        }
        __syncthreads();
        {
            const int e = tid * 2, rr = e >> 5, cc = e & 31;
            f32x2 s1 = {0.f, 0.f}, s2 = {0.f, 0.f};
#pragma unroll
            for (int ww = 0; ww < 8; ++ww) { s1 += *(const f32x2*)(part + (ww * 32 + rr) * 32 + cc); if (KIND == 2) s2 += *(const f32x2*)(part + ((8 + ww) * 32 + rr) * 32 + cc); }
            const long row = row0 + rr; const int col = col0 + cc;
            if (KIND == 1) { s1[0] = sigmoidf_(s1[0]); s1[1] = sigmoidf_(s1[1]); }
            if (KIND == 2) { const unsigned ga = *(const unsigned*)(P->gates + row * 2048 + col), gb = *(const unsigned*)(P->gates + row * 2048 + 1024 + col);
                s1[0] = s1[0] * bf_lo(ga) + s2[0] * bf_lo(gb); s1[1] = s1[1] * bf_hi(ga) + s2[1] * bf_hi(gb); }
            *(unsigned*)(C + row * ldc + col) = pk2(s1[0], s1[1]);
        }
        __syncthreads();
    }
}

DI int crow(int i, int h) { return (i & 3) + 8 * (i >> 2) + 4 * h; }

template <int MODE>
DI void attn_unit(KP P, char* lds, bool sample, int b, int h, int ublk) {
    constexpr int DQK = MODE == 0 ? 96 : 64, KS = DQK * 2 + 16, VS = 144, NS = DQK / 16;
    constexpr int KBYTES = 64 * KS, BUF = KBYTES + 64 * VS;
    const int tid = otid(), w = tid >> 6, lane = tid & 63, ql = lane & 31, hh = lane >> 5;
    const int kvrow0 = sample ? MP + b * SKEYS : b * TP;
    const int qrow0 = sample ? MP + b * 32 : b * TP + ublk * 256;
    const int ntiles = sample ? 65 : 4 * (ublk + 1);
    const int t0 = sample ? 0 : ublk * 256 + w * 32, tq = t0 + ql;
    int klim, wmax, wmin;
    if (MODE == 0) { if (sample) { klim = wmax = wmin = SKEYS; } else { klim = ((tq >> 6) + 1) << 6; wmax = (((t0 + 31) >> 6) + 1) << 6; wmin = ((t0 >> 6) + 1) << 6; } }
    else { if (sample) { klim = PAST + tq; wmax = PAST + 31; wmin = PAST; } else { klim = tq; wmax = t0 + 31; wmin = t0; } }
    const bool wactive = sample ? (w == 0) : true;
    const bf16_t* Kp; const bf16_t* Qp; const bf16_t* VT; int ldq; long ldv;
    if (MODE == 0) { Kp = P->kva + (long)kvrow0 * 512 + h * 64; Qp = P->q + (long)qrow0 * 768 + h * 96; ldq = 768;
        VT = sample ? P->vaT_s + (long)(b * 512 + h * 64) * SKP : P->vaT_p + (long)(b * 512 + h * 64) * TP; }
    else { Kp = P->kb + (long)kvrow0 * 512 + h * 64; Qp = P->qb + (long)qrow0 * 512 + h * 64; ldq = 512;
        VT = sample ? P->vbT_s + (long)(b * 512 + h * 64) * SKP : P->vbT_p + (long)(b * 512 + h * 64) * TP; }
    ldv = sample ? SKP : TP;
    const bf16_t* Kr = P->krope + (long)kvrow0 * 32;

    bf16x8 qf[NS];
    if (wactive) {
        const bf16_t* qp = Qp + (long)(w * 32 + ql) * ldq + 8 * hh;
#pragma unroll
        for (int s = 0; s < NS; ++s) qf[s] = *(const bf16x8*)(qp + 16 * s);
    } else {
#pragma unroll
        for (int s = 0; s < NS; ++s) qf[s] = (bf16x8){0, 0, 0, 0, 0, 0, 0, 0};
    }
    f32x16 O0, O1;
#pragma unroll
    for (int i = 0; i < 16; ++i) { O0[i] = 0.f; O1[i] = 0.f; }
    float mrun = -INFINITY, lrun = 0.f, carry = 0.f;
    bool wdone = !wactive;
    volatile int* flags = (volatile int*)(lds + 65536 + 64);

    u32x4 rk0, rk1, rv;
    const int krow_s = tid >> 3, kc_s = tid & 7, rrow_s = tid >> 2, rc_s = tid & 3;
    const bool f32path = (MODE == 1) && sample;
    const float* Kf = P->c_sbk + ((long)b * PAST * 512 + h * 64); const float* Vf = P->c_sbv + ((long)b * PAST * 512 + h * 64);
    auto load_tile = [&](int kt) {
        if (f32path && kt < 64) {
            const float* kp_ = Kf + (long)(kt * 64 + krow_s) * 512 + kc_s * 8; const float* vp_ = Vf + (long)(kt * 64 + krow_s) * 512 + kc_s * 8;
            const f32x4 a0 = *(const f32x4*)kp_, a1 = *(const f32x4*)(kp_ + 4), c0 = *(const f32x4*)vp_, c1 = *(const f32x4*)(vp_ + 4);
            rk0.x = pk2(a0[0], a0[1]); rk0.y = pk2(a0[2], a0[3]); rk0.z = pk2(a1[0], a1[1]); rk0.w = pk2(a1[2], a1[3]);
            rv.x = pk2(c0[0], c0[1]); rv.y = pk2(c0[2], c0[3]); rv.z = pk2(c1[0], c1[1]); rv.w = pk2(c1[2], c1[3]);
            return;
        }
        rk0 = *(const u32x4*)(Kp + (long)(kt * 64 + krow_s) * 512 + kc_s * 8);
        if (MODE == 0 && tid < 256) rk1 = *(const u32x4*)(Kr + (long)(kt * 64 + rrow_s) * 32 + rc_s * 8);
        rv = *(const u32x4*)(VT + (long)krow_s * ldv + kt * 64 + kc_s * 8);
    };
    auto store_tile = [&](int buf, int kt) {
        char* kb_ = lds + buf * BUF; char* vb_ = kb_ + KBYTES;
        *(u32x4*)(kb_ + krow_s * KS + kc_s * 16) = rk0;
        if (f32path && kt < 64) {
#pragma unroll
            for (int e = 0; e < 4; ++e) { *(bf16_t*)(vb_ + (kc_s * 8 + 2 * e) * VS + krow_s * 2) = (bf16_t)(rv[e] & 0xffff); *(bf16_t*)(vb_ + (kc_s * 8 + 2 * e + 1) * VS + krow_s * 2) = (bf16_t)(rv[e] >> 16); }
            return;
        }
        if (MODE == 0 && tid < 256) *(u32x4*)(kb_ + rrow_s * KS + 128 + rc_s * 16) = rk1;
        *(u32x4*)(vb_ + krow_s * VS + kc_s * 16) = rv;
    };
    load_tile(ntiles - 1); store_tile(0, ntiles - 1);
    __syncthreads();
    for (int it = 0; it < ntiles; ++it) {
        const int kt = ntiles - 1 - it, cur = it & 1;
        if (it + 1 < ntiles) load_tile(kt - 1);
        if (wactive && !wdone && kt * 64 < wmax) {
            const char* kb_ = lds + cur * BUF; const char* vb_ = kb_ + KBYTES;
            f32x16 S0, S1;
#pragma unroll
            for (int i = 0; i < 16; ++i) { S0[i] = 0.f; S1[i] = 0.f; }
#pragma unroll
            for (int s = 0; s < NS; ++s) {
                const bf16x8 k0 = *(const bf16x8*)(kb_ + ql * KS + (16 * s + 8 * hh) * 2);
                const bf16x8 k1 = *(const bf16x8*)(kb_ + (32 + ql) * KS + (16 * s + 8 * hh) * 2);
                S0 = MFMA32(k0, qf[s], S0); S1 = MFMA32(k1, qf[s], S1);
            }
            const bool need_mask = (kt * 64 + 64 > wmin);
            const int kbase = kt * 64 + 4 * hh;
            if (MODE == 0) {
                if (need_mask) {
#pragma unroll
                    for (int i = 0; i < 16; ++i) { const int key = kbase + (i & 3) + 8 * (i >> 2);
                        if (key >= klim) S0[i] = -INFINITY; if (key + 32 >= klim) S1[i] = -INFINITY; }
                }
                float mx = S0[0];
#pragma unroll
                for (int i = 1; i < 16; ++i) mx = fmaxf(mx, S0[i]);
#pragma unroll
                for (int i = 0; i < 16; ++i) mx = fmaxf(mx, S1[i]);
                mx = fmaxf(mx, __shfl_xor(mx, 32));
                const float mnew = fmaxf(mrun, mx);
                const float alpha = __builtin_amdgcn_exp2f(mrun - mnew);
                mrun = mnew;
                float ps = 0.f;
#pragma unroll
                for (int i = 0; i < 16; ++i) { S0[i] = __builtin_amdgcn_exp2f(S0[i] - mnew); S1[i] = __builtin_amdgcn_exp2f(S1[i] - mnew); ps += S0[i] + S1[i]; }
                lrun = lrun * alpha + ps;
#pragma unroll
                for (int i = 0; i < 16; ++i) { O0[i] *= alpha; O1[i] *= alpha; }
            } else {
                float gs[2][4], gp[2][4];
                f32x16 SP0, SP1;
#pragma unroll
                for (int i = 0; i < 16; ++i) { const int key = kbase + (i & 3) + 8 * (i >> 2);
                    { const float z = S0[i]; const float t = __builtin_amdgcn_exp2f(-fabsf(z) * LOG2E); float sp = fmaxf(z, 0.f) + LN2 * __builtin_amdgcn_logf(1.0f + t);
                      if (need_mask && key >= klim) sp = 0.f; SP0[i] = sp; }
                    { const float z = S1[i]; const float t = __builtin_amdgcn_exp2f(-fabsf(z) * LOG2E); float sp = fmaxf(z, 0.f) + LN2 * __builtin_amdgcn_logf(1.0f + t);
                      if (need_mask && key + 32 >= klim) sp = 0.f; SP1[i] = sp; } }
#pragma unroll
                for (int g = 0; g < 4; ++g) { gs[0][g] = (SP0[4 * g] + SP0[4 * g + 1]) + (SP0[4 * g + 2] + SP0[4 * g + 3]);
                    gs[1][g] = (SP1[4 * g] + SP1[4 * g + 1]) + (SP1[4 * g + 2] + SP1[4 * g + 3]); }
#pragma unroll
                for (int g = 0; g < 4; ++g) { gp[0][g] = __shfl_xor(gs[0][g], 32); gp[1][g] = __shfl_xor(gs[1][g], 32); }
                float running = carry;
#pragma unroll
                for (int blk = 1; blk >= 0; --blk)
#pragma unroll
                    for (int g = 3; g >= 0; --g) {
                        const float sum1 = hh ? gs[blk][g] : gp[blk][g], sum0 = hh ? gp[blk][g] : gs[blk][g];
                        const float mybase = hh ? running : running + sum1;
                        running += sum0 + sum1;
                        float later = mybase;
#pragma unroll
                        for (int j = 3; j >= 0; --j) { const int i = 4 * g + j; const int key = kbase + j + 8 * g + 32 * blk;
                            const float z = blk ? S1[i] : S0[i], sp = blk ? SP1[i] : SP0[i];
                            float a = __builtin_amdgcn_exp2f((z - sp - later) * LOG2E);
                            if (need_mask && key >= klim) a = 0.f;
                            later += sp;
                            if (blk) S1[i] = a; else S0[i] = a; }
                    }
                carry = running;
                wdone = __all((carry > 104.0f) || (klim <= 0));
            }
            bf16x8 pf[2][2];
#pragma unroll
            for (int s = 0; s < 2; ++s) {
                u32x4 a, c;
                a.x = pk2(S0[8 * s], S0[8 * s + 1]); a.y = pk2(S0[8 * s + 2], S0[8 * s + 3]); a.z = pk2(S0[8 * s + 4], S0[8 * s + 5]); a.w = pk2(S0[8 * s + 6], S0[8 * s + 7]);
                c.x = pk2(S1[8 * s], S1[8 * s + 1]); c.y = pk2(S1[8 * s + 2], S1[8 * s + 3]); c.z = pk2(S1[8 * s + 4], S1[8 * s + 5]); c.w = pk2(S1[8 * s + 6], S1[8 * s + 7]);
                pf[0][s] = __builtin_bit_cast(bf16x8, a); pf[1][s] = __builtin_bit_cast(bf16x8, c);
            }
#pragma unroll
            for (int blk = 0; blk < 2; ++blk)
#pragma unroll
                for (int s = 0; s < 2; ++s) {
                    const int koff = (32 * blk + 16 * s + 4 * hh) * 2;
                    const s16x4 lo0 = *(const s16x4*)(vb_ + ql * VS + koff), hi0 = *(const s16x4*)(vb_ + ql * VS + koff + 16);
                    const s16x4 lo1 = *(const s16x4*)(vb_ + (32 + ql) * VS + koff), hi1 = *(const s16x4*)(vb_ + (32 + ql) * VS + koff + 16);
                    const bf16x8 v0 = __builtin_shufflevector(lo0, hi0, 0, 1, 2, 3, 4, 5, 6, 7), v1 = __builtin_shufflevector(lo1, hi1, 0, 1, 2, 3, 4, 5, 6, 7);
                    O0 = MFMA32(v0, pf[blk][s], O0); O1 = MFMA32(v1, pf[blk][s], O1);
                }
        }
        if (it + 1 < ntiles) store_tile(cur ^ 1, kt - 1);
        if (MODE == 1 && lane == 0) flags[(it & 1) * 8 + w] = wdone ? 1 : 0;
        __syncthreads();
        if (MODE == 1) { int alld = 1;
#pragma unroll
            for (int ww = 0; ww < 8; ++ww) alld &= flags[(it & 1) * 8 + ww];
            if (alld) break; }
    }
    if (wactive) {
        float inv = 1.0f;
        if (MODE == 0) { const float lt = lrun + __shfl_xor(lrun, 32); inv = 1.0f / lt; }
        bf16_t* op = P->o + (long)(qrow0 + w * 32 + ql) * 1024 + (MODE == 0 ? 0 : 512) + h * 64 + 4 * hh;
#pragma unroll
        for (int g = 0; g < 4; ++g) {
            f32x4 a = {O0[4 * g] * inv, O0[4 * g + 1] * inv, O0[4 * g + 2] * inv, O0[4 * g + 3] * inv};
            f32x4 c = {O1[4 * g] * inv, O1[4 * g + 1] * inv, O1[4 * g + 2] * inv, O1[4 * g + 3] * inv};
            store_bf4(op + 8 * g, a); store_bf4(op + 32 + 8 * g, c);
        }
    }
}

DI void attn_phase(KP P, char* lds, int cidx) {
    unsigned* slot = (unsigned*)(lds + 65536);
    for (;;) {
        if (threadIdx.x == 0) *slot = atomicAdd(P->ctr + cidx, 1u);
        __syncthreads();
        const unsigned idx = *slot;
        __syncthreads();
        if (idx >= 1152u) break;
        bool sample; int mode, b, h, ublk = 0;
        if (idx < 128u) { sample = true; mode = idx >> 6; b = (idx >> 3) & 7; h = idx & 7; }
        else { const int j = idx - 128; sample = false; ublk = 31 - (j >> 5); const int r = j & 31; mode = r >> 4; b = (r >> 3) & 1; h = r & 7; }
        if (mode == 0) attn_unit<0>(P, lds, sample, b, h, ublk); else attn_unit<1>(P, lds, sample, b, h, ublk);
    }
}

DI void phase0(KP P, char* lds) {
    const int tid = otid(), G = ogrid(), bid = obid(), w = tid >> 6, lane = tid & 63;
    for (int item = bid; item < 96; item += G) {
        float* sc = (float*)lds; float* red = (float*)(lds + 40960);
        for (int i = tid; i < 10240; i += NTHREADS) { const int bb = i >> 10, k = i & 1023; const float cv = bb < 2 ? P->c_p[bb * 1024 + k] : P->c_s[(bb - 2) * 1024 + k]; sc[i] = cv / (1.0f + __expf(-cv)); }
        __syncthreads();
        const int col = item * 64 + lane;
        float a0 = 0, a1 = 0, a2 = 0, a3 = 0, a4 = 0, a5 = 0, a6 = 0, a7 = 0, a8 = 0, a9 = 0;
        for (int k0 = w * 128; k0 < w * 128 + 128; k0 += 16) {
            float wv[16];
#pragma unroll
            for (int j = 0; j < 16; ++j) wv[j] = P->w_ada[(long)(k0 + j) * 6144 + col];
#pragma unroll
            for (int j = 0; j < 16; ++j) { const int k = k0 + j;
                a0 += sc[k] * wv[j]; a1 += sc[1024 + k] * wv[j]; a2 += sc[2048 + k] * wv[j]; a3 += sc[3072 + k] * wv[j]; a4 += sc[4096 + k] * wv[j];
                a5 += sc[5120 + k] * wv[j]; a6 += sc[6144 + k] * wv[j]; a7 += sc[7168 + k] * wv[j]; a8 += sc[8192 + k] * wv[j]; a9 += sc[9216 + k] * wv[j]; }
        }
        float* rr = red + w * 640 + lane;
        rr[0] = a0; rr[64] = a1; rr[128] = a2; rr[192] = a3; rr[256] = a4; rr[320] = a5; rr[384] = a6; rr[448] = a7; rr[512] = a8; rr[576] = a9;
        __syncthreads();
        for (int i = tid; i < 640; i += NTHREADS) { float s = 0.f; for (int ww = 0; ww < 8; ++ww) s += red[ww * 640 + i];
            const int bb = i >> 6, l = i & 63; P->ada[bb * 6144 + item * 64 + l] = s + P->b_ada[item * 64 + l]; }
        __syncthreads();
    }
    {
        float* tile = (float*)lds;
        for (int it = (bid + 96) % G; it < P->ntj_tiles; it += G) {
            int j = 0;
#pragma unroll 1
            for (int q = 1; q < P->pad0; ++q) if (it >= P->tj[q].tile0) j = q;
            TJob J; J.src = P->tj[j].src; J.kscale = P->tj[j].kscale; J.dst = P->tj[j].dst; J.lds = P->tj[j].lds; J.coff = P->tj[j].coff; J.ldd = P->tj[j].ldd;
            J.Klen = P->tj[j].Klen; J.Nlen = P->tj[j].Nlen; J.zero = P->tj[j].zero; J.tile0 = P->tj[j].tile0;
            const int lt = it - J.tile0, nk = J.Klen >> 6, tk = lt % nk, tn = lt / nk, k0 = tk * 64, n0 = tn * 256;
            f32x4 lv[8];
#pragma unroll
            for (int r = 0; r < 8; ++r) { const int e = tid + r * NTHREADS, kk = e >> 6, n4 = (e & 63) * 4;
                lv[r] = (f32x4){0.f, 0.f, 0.f, 0.f};
                if (!J.zero && n0 + n4 < J.Nlen) lv[r] = *(const f32x4*)(J.src + (long)(k0 + kk) * J.lds + J.coff + n0 + n4); }
#pragma unroll
            for (int r = 0; r < 8; ++r) { const int e = tid + r * NTHREADS, kk = e >> 6, n4 = (e & 63) * 4;
                f32x4 v = lv[r]; if (J.kscale) v *= J.kscale[k0 + kk];
                float* tp = tile + kk * 257 + n4; tp[0] = v[0]; tp[1] = v[1]; tp[2] = v[2]; tp[3] = v[3]; }
            __syncthreads();
#pragma unroll
            for (int r = 0; r < 4; ++r) { const int e = tid + r * NTHREADS, nn = e >> 3, kc = (e & 7) * 8;
                if (n0 + nn < J.Nlen) { const float* tp = tile + kc * 257 + nn; u32x4 o;
                    o.x = pk2(tp[0], tp[257]); o.y = pk2(tp[2 * 257], tp[3 * 257]); o.z = pk2(tp[4 * 257], tp[5 * 257]); o.w = pk2(tp[6 * 257], tp[7 * 257]);
                    *(u32x4*)(J.dst + (long)(n0 + nn) * J.ldd + k0 + kc) = o; } }
            __syncthreads();
        }
    }
    const long gt = (long)bid * NTHREADS + tid, gn = (long)G * NTHREADS;
    for (long i0 = gt; i0 < 8L * PAST * 64; i0 += 4 * gn) { f32x4 v[4];
#pragma unroll
        for (int r = 0; r < 4; ++r) { const long i = i0 + r * gn; if (i < 8L * PAST * 64) v[r] = *(const f32x4*)(P->c_ckv + i * 4); }
#pragma unroll
        for (int r = 0; r < 4; ++r) { const long i = i0 + r * gn; if (i < 8L * PAST * 64) { const long row = i >> 6; const int c = (int)(i & 63) * 4; const int bb = (int)(row >> 12), sq = (int)(row & 4095);
            store_bf4(P->latent + (long)(MP + bb * SKEYS + sq) * 256 + c, v[r]); } } }
    for (long i0 = gt; i0 < 8L * PAST * 8; i0 += 4 * gn) { f32x4 v[4];
#pragma unroll
        for (int r = 0; r < 4; ++r) { const long i = i0 + r * gn; if (i < 8L * PAST * 8) v[r] = *(const f32x4*)(P->c_kr + i * 4); }
#pragma unroll
        for (int r = 0; r < 4; ++r) { const long i = i0 + r * gn; if (i < 8L * PAST * 8) { const long row = i >> 3; const int c = (int)(i & 7) * 4; const int bb = (int)(row >> 12), sq = (int)(row & 4095);
            store_bf4(P->krope + (long)(MP + bb * SKEYS + sq) * 32 + c, v[r]); } } }
    for (long i = gt; i < 8L * 512 * 8; i += gn) { const long r = i >> 3; const int c = (int)(i & 7) * 4; const u32x2 z = {0u, 0u};
        *(u32x2*)(P->vaT_s + r * SKP + SKEYS + c) = z; *(u32x2*)(P->vbT_s + r * SKP + SKEYS + c) = z; }
    for (long i = gt; i < (long)TP * 16; i += gn) { const int pos = (int)(i >> 4), fi = (int)(i & 15);
        const float inv = exp2f(-(float)fi * (13.287712379549449f / 16.0f));
        const float ang = (float)pos * inv;
        const double rev = (double)ang * 0.15915494309189535; const float fr_ = (float)(rev - floor(rev));
        P->ropeT[i * 2] = __builtin_amdgcn_cosf(fr_); P->ropeT[i * 2 + 1] = __builtin_amdgcn_sinf(fr_); }
}

DI void phase_h(KP P) {
    const int tid_ = otid(), lane = tid_ & 63, gw = obid() * 8 + (tid_ >> 6), nw = ogrid() * 8;
    for (int row = gw; row < MT; row += nw) {
        const float* xr = row < MP ? P->x_p + (long)row * DM : P->x_s + (long)(row - MP) * DM;
        const float* ad = P->ada + ada_b(row) * 6144;
        f32x4 v[4]; float s = 0.f;
#pragma unroll
        for (int i = 0; i < 4; ++i) { v[i] = *(const f32x4*)(xr + i * 256 + lane * 4); s += v[i][0] * v[i][0] + v[i][1] * v[i][1] + v[i][2] * v[i][2] + v[i][3] * v[i][3]; }
#pragma unroll
        for (int o = 1; o < 64; o <<= 1) s += __shfl_xor(s, o);
        const float rstd = rsqrtf(s * (1.0f / DM) + EPS);
#pragma unroll
        for (int i = 0; i < 4; ++i) { const int c = i * 256 + lane * 4;
            const f32x4 g = *(const f32x4*)(P->g_pre_mix + c), sh = *(const f32x4*)(ad + c), scl = *(const f32x4*)(ad + 1024 + c);
            store_bf4(P->h + (long)row * DM + c, v[i] * rstd * g * (1.0f + scl) + sh); }
    }
}

DI void phase_mid(KP P) {
    const int tid_ = otid(), lane = tid_ & 63, gw = obid() * 8 + (tid_ >> 6), nw = ogrid() * 8;
    for (int row = gw; row < MT; row += nw) {
        const float* xr = row < MP ? P->x_p + (long)row * DM : P->x_s + (long)(row - MP) * DM;
        const float* ad = P->ada + ada_b(row) * 6144;
        f32x4 mv[4]; float s = 0.f;
#pragma unroll
        for (int i = 0; i < 4; ++i) { const u32x2 wv = *(const u32x2*)(P->m2 + (long)row * DM + i * 256 + lane * 4);
            mv[i] = (f32x4){bf_lo(wv.x), bf_hi(wv.x), bf_lo(wv.y), bf_hi(wv.y)}; s += mv[i][0] * mv[i][0] + mv[i][1] * mv[i][1] + mv[i][2] * mv[i][2] + mv[i][3] * mv[i][3]; }
#pragma unroll
        for (int o = 1; o < 64; o <<= 1) s += __shfl_xor(s, o);
        const float rstd = rsqrtf(s * (1.0f / DM) + EPS);
        float s2 = 0.f;
#pragma unroll
        for (int i = 0; i < 4; ++i) { const int c = i * 256 + lane * 4;
            const f32x4 xv = *(const f32x4*)(xr + c), g = *(const f32x4*)(P->g_post_mix + c), gt = *(const f32x4*)(ad + 2048 + c);
            mv[i] = xv + gt * (mv[i] * rstd * g);
            *(f32x4*)(P->out + O_Y + (long)row * DM + c) = mv[i];
            s2 += mv[i][0] * mv[i][0] + mv[i][1] * mv[i][1] + mv[i][2] * mv[i][2] + mv[i][3] * mv[i][3]; }
#pragma unroll
        for (int o = 1; o < 64; o <<= 1) s2 += __shfl_xor(s2, o);
        const float rstd2 = rsqrtf(s2 * (1.0f / DM) + EPS);
#pragma unroll
        for (int i = 0; i < 4; ++i) { const int c = i * 256 + lane * 4;
            const f32x4 g = *(const f32x4*)(P->g_pre_ffn + c), sh = *(const f32x4*)(ad + 3072 + c), scl = *(const f32x4*)(ad + 4096 + c);
            store_bf4(P->h2 + (long)row * DM + c, mv[i] * rstd2 * g * (1.0f + scl) + sh); }
    }
}

DI void phase_final(KP P) {
    const int tid_ = otid(), lane = tid_ & 63, gw = obid() * 8 + (tid_ >> 6), nw = ogrid() * 8;
    for (int row = gw; row < MT; row += nw) {
        const float* ad = P->ada + ada_b(row) * 6144;
        f32x4 fv[4]; float s = 0.f;
#pragma unroll
        for (int i = 0; i < 4; ++i) { const u32x2 wv = *(const u32x2*)(P->f + (long)row * DM + i * 256 + lane * 4);
            fv[i] = (f32x4){bf_lo(wv.x), bf_hi(wv.x), bf_lo(wv.y), bf_hi(wv.y)}; s += fv[i][0] * fv[i][0] + fv[i][1] * fv[i][1] + fv[i][2] * fv[i][2] + fv[i][3] * fv[i][3]; }
#pragma unroll
        for (int o = 1; o < 64; o <<= 1) s += __shfl_xor(s, o);
        const float rstd = rsqrtf(s * (1.0f / DM) + EPS);
#pragma unroll
        for (int i = 0; i < 4; ++i) { const int c = i * 256 + lane * 4; float* yp = P->out + O_Y + (long)row * DM + c;
            const f32x4 xv = *(const f32x4*)yp, g = *(const f32x4*)(P->g_post_ffn + c), gt = *(const f32x4*)(ad + 5120 + c);
            *(f32x4*)yp = xv + gt * (fv[i] * rstd * g); }
    }
}

DI float gelu_tanh(float a) { const float t = 0.7978845608028654f * (a + 0.044715f * a * a * a); const float e = __expf(2.0f * t); return 0.5f * a * (2.0f - 2.0f / (1.0f + e)); }

DI void phase_conv(KP P) {
    const long gt = (long)obid() * NTHREADS + otid(), gn = (long)ogrid() * NTHREADS;
    for (long i = gt; i < (long)(MT / 8) * 352; i += gn) {
        const int rg = (int)(i / 352), c = (int)(i % 352) * 8, row0 = rg * 8;
        int t0, bs = -1; if (row0 < MP) t0 = row0 & (TP - 1); else { t0 = (row0 - MP) & 31; bs = (row0 - MP) >> 5; }
        u32x4 ua[10], ub[10];
#pragma unroll
        for (int r = 0; r < 10; ++r) { const int rr = (t0 == 0 && r < 2) ? row0 : row0 + r - 2;
            ua[r] = *(const u32x4*)(P->u + (long)rr * DFF2 + c); ub[r] = *(const u32x4*)(P->u + (long)rr * DFF2 + DFF + c); }
        float wa[3][8], wb[3][8], ba[8], bb[8];
#pragma unroll
        for (int tap = 0; tap < 3; ++tap) { const f32x4 x0 = *(const f32x4*)(P->conv_w + tap * DFF2 + c), x1 = *(const f32x4*)(P->conv_w + tap * DFF2 + c + 4);
            const f32x4 y0 = *(const f32x4*)(P->conv_w + tap * DFF2 + DFF + c), y1 = *(const f32x4*)(P->conv_w + tap * DFF2 + DFF + c + 4);
#pragma unroll
            for (int e = 0; e < 4; ++e) { wa[tap][e] = x0[e]; wa[tap][4 + e] = x1[e]; wb[tap][e] = y0[e]; wb[tap][4 + e] = y1[e]; } }
        { const f32x4 x0 = *(const f32x4*)(P->conv_b + c), x1 = *(const f32x4*)(P->conv_b + c + 4), y0 = *(const f32x4*)(P->conv_b + DFF + c), y1 = *(const f32x4*)(P->conv_b + DFF + c + 4);
#pragma unroll
          for (int e = 0; e < 4; ++e) { ba[e] = x0[e]; ba[4 + e] = x1[e]; bb[e] = y0[e]; bb[4 + e] = y1[e]; } }
        float ha[2][8], hb[2][8];
#pragma unroll
        for (int r = 0; r < 2; ++r)
#pragma unroll
            for (int e = 0; e < 4; ++e) { ha[r][2 * e] = bf_lo(ua[r][e]); ha[r][2 * e + 1] = bf_hi(ua[r][e]); hb[r][2 * e] = bf_lo(ub[r][e]); hb[r][2 * e + 1] = bf_hi(ub[r][e]); }
        if (t0 == 0) {
            if (bs >= 0) {
#pragma unroll
                for (int r = 0; r < 2; ++r) { const float* sp = P->c_conv + (long)(bs * 2 + r) * DFF2 + c;
#pragma unroll
                    for (int e = 0; e < 8; ++e) { ha[r][e] = sp[e]; hb[r][e] = sp[DFF + e]; } }
            } else {
#pragma unroll
                for (int r = 0; r < 2; ++r)
#pragma unroll
                    for (int e = 0; e < 8; ++e) { ha[r][e] = 0.f; hb[r][e] = 0.f; }
            }
        }
        float pa2[8], pa1[8], pb2[8], pb1[8];
#pragma unroll
        for (int e = 0; e < 8; ++e) { pa2[e] = ha[0][e]; pa1[e] = ha[1][e]; pb2[e] = hb[0][e]; pb1[e] = hb[1][e]; }
#pragma unroll
        for (int r = 0; r < 8; ++r) {
            float ca[8], cb[8];
#pragma unroll
            for (int e = 0; e < 4; ++e) { ca[2 * e] = bf_lo(ua[r + 2][e]); ca[2 * e + 1] = bf_hi(ua[r + 2][e]); cb[2 * e] = bf_lo(ub[r + 2][e]); cb[2 * e + 1] = bf_hi(ub[r + 2][e]); }
            u32x4 ov;
#pragma unroll
            for (int e = 0; e < 4; ++e) {
                const float ya0 = ba[2 * e] + wa[0][2 * e] * pa2[2 * e] + wa[1][2 * e] * pa1[2 * e] + wa[2][2 * e] * ca[2 * e];
                const float ya1 = ba[2 * e + 1] + wa[0][2 * e + 1] * pa2[2 * e + 1] + wa[1][2 * e + 1] * pa1[2 * e + 1] + wa[2][2 * e + 1] * ca[2 * e + 1];
                const float yb0 = bb[2 * e] + wb[0][2 * e] * pb2[2 * e] + wb[1][2 * e] * pb1[2 * e] + wb[2][2 * e] * cb[2 * e];
                const float yb1 = bb[2 * e + 1] + wb[0][2 * e + 1] * pb2[2 * e + 1] + wb[1][2 * e + 1] * pb1[2 * e + 1] + wb[2][2 * e + 1] * cb[2 * e + 1];
                ov[e] = pk2(gelu_tanh(ya0) * yb0, gelu_tanh(ya1) * yb1); }
            *(u32x4*)(P->g + (long)(row0 + r) * DFF + c) = ov;
#pragma unroll
            for (int e = 0; e < 8; ++e) { pa2[e] = pa1[e]; pa1[e] = ca[e]; pb2[e] = pb1[e]; pb1[e] = cb[e]; }
        }
    }
}

#define XB_TMO      128
#define XB_XCNT(j)  (256  + 64 * (j))
#define XB_XSUB(j)  (1280 + 64 * (j))
#define XB_XGEN(j)  (2304 + 64 * (j))
#define XB_TOP      3328
#define XB_TOPGEN   3392
#define XCD_BAR_WORDS 3456
#define XB_SPIN_CAP (1u << 18)
DI unsigned xb_ld(unsigned* p)              { return __hip_atomic_load(p, __ATOMIC_RELAXED, __HIP_MEMORY_SCOPE_AGENT); }
DI unsigned xb_add(unsigned* p, unsigned v) { return __hip_atomic_fetch_add(p, v, __ATOMIC_RELAXED, __HIP_MEMORY_SCOPE_AGENT); }
DI unsigned xb_xcc_id() { return (unsigned)__builtin_amdgcn_s_getreg((3 << 11) | 20) & 0xFu; }
#define XB_SPIN(cond, bar) do { unsigned _sp = 0; while (cond) { __builtin_amdgcn_s_sleep(1); \
    if ((++_sp & 255u) == 0u) { if (xb_ld(&(bar)[XB_TMO])) break; if (_sp > XB_SPIN_CAP) { atomicAdd(&(bar)[XB_TMO], 1u); break; } } } } while (0)
DI void xcd_barrier_complete(unsigned* bar, unsigned x, unsigned& nloc, unsigned& nx) {
    const unsigned G = gridDim.x;
    unsigned sum, cnt, mine, sp = 0u;
    for (;;) {
        sum = 0u; cnt = 0u; mine = 0u;
#pragma unroll
        for (unsigned j = 0; j < 16; ++j) { const unsigned c = xb_ld(&bar[XB_XCNT(j)]); sum += c; cnt += (c > 0u) ? 1u : 0u; mine = (j == x) ? c : mine; }
        if (sum == G) break;
        __builtin_amdgcn_s_sleep(1);
        if ((++sp & 255u) == 0u) { if (xb_ld(&bar[XB_TMO])) break; if (sp > XB_SPIN_CAP) { atomicAdd(&bar[XB_TMO], 1u); break; } }
    }
    nloc = mine > 0u ? mine : 1u; nx = cnt > 0u ? cnt : 1u;
}
DI void grid_barrier(char* lds) {
    asm volatile("s_waitcnt vmcnt(0)" ::: "memory");
    __syncthreads();
    if (threadIdx.x == 0) {
        unsigned* bar = kparams()->bar; const unsigned x = xb_xcc_id();
        volatile LAS unsigned* st = (volatile LAS unsigned*)(lds + 131072 + 2048);
        __builtin_amdgcn_s_waitcnt(0);
        unsigned nloc = st[0], nx = st[1];
        if (nloc == 0u) { xcd_barrier_complete(bar, x, nloc, nx); st[0] = nloc; st[1] = nx; }
        const unsigned old = xb_add(&bar[XB_XSUB(x)], 1u);
        const unsigned gen = old / nloc;
        if (old + 1u == (gen + 1u) * nloc) {
            __builtin_amdgcn_fence(__ATOMIC_RELEASE, "agent");
            asm volatile("s_waitcnt vmcnt(0)" ::: "memory");
            const unsigned og = xb_add(&bar[XB_TOP], 1u);
            const unsigned tg = og / nx;
            if (og + 1u == (tg + 1u) * nx) xb_add(&bar[XB_TOPGEN], 1u);
            else XB_SPIN(xb_ld(&bar[XB_TOPGEN]) == tg, bar);
            __builtin_amdgcn_fence(__ATOMIC_ACQUIRE, "agent");
            xb_add(&bar[XB_XGEN(x)], 1u);
            asm volatile("s_waitcnt vmcnt(0)" ::: "memory");
        } else {
            XB_SPIN(xb_ld(&bar[XB_XGEN(x)]) == gen, bar);
            __builtin_amdgcn_fence(__ATOMIC_ACQUIRE, "agent");
            asm volatile("s_waitcnt vmcnt(0)" ::: "memory");
        }
    }
    __syncthreads();
}

__global__ void __launch_bounds__(NTHREADS) fwd_megakernel(Params Pval) {
    extern __shared__ __attribute__((aligned(16))) char lds[];
    cg::grid_group grid = cg::this_grid();
    const int lo = kparams()->phase_lo, hi = kparams()->phase_hi;
#define PH(n) if (lo <= (n) && (n) < hi)
#define SYNC(n) if (lo <= (n) && (n) + 1 < hi) grid_barrier(lds)
    if (hi > 1000) grid.sync();
    { volatile LAS unsigned* st = (volatile LAS unsigned*)(lds + 131072 + 2048);
      if (threadIdx.x == 0) { st[0] = 0u; st[1] = 0u; }
      __syncthreads();
      if (threadIdx.x == 0) (void)xb_add(&kparams()->bar[XB_XCNT(xb_xcc_id())], 1u); }
    PH(0) phase0(kparams(), lds);
#ifdef PROBE_P0
    __syncthreads(); phase0(kparams(), lds);
#endif
#ifdef PROBE_SYNC
    for (int i = 0; i < 24; ++i) grid_barrier(lds);
#endif
    SYNC(0);
    PH(1) phase_h(kparams());
#ifdef PROBE_ROWS
    phase_h(kparams());
#endif
    SYNC(1);
    for (int ph = 2; ph <= 12; ++ph) {
        if (ph == 4) { PH(4) attn_phase(kparams(), lds, 0);
#ifdef PROBE_ATTN2
            __syncthreads(); attn_phase(kparams(), lds, 1);
#endif
            SYNC(4); continue; }
        if (ph == 8) { PH(8) phase_mid(kparams());
#ifdef PROBE_ROWS
            phase_mid(kparams());
#endif
            SYNC(8); continue; }
        if (ph == 10) { PH(10) phase_conv(kparams());
#ifdef PROBE_CONV
            phase_conv(kparams());
#endif
            SYNC(10); continue; }
        if (ph == 12) { PH(12) phase_final(kparams()); continue; }
        if (lo <= ph && ph < hi) {
            const int npass = (ph == 3 || ph == 6) ? 2 : 1;
            for (int pass = 0; pass < npass; ++pass) {
                GemmDesc d; d.C = nullptr; d.ldc = 0; d.start = 0; KP P = kparams();
                switch (ph) {
                case 2: d.A = P->h; d.lda = DM; d.Bt = P->WinT; d.ldb = DM; d.K = DM; d.nM = 65; d.nN = 9; d.epi = E_INPROJ; break;
                case 3: if (pass == 0) { d.A = P->qlat; d.lda = 384; d.Bt = P->WuqT; d.ldb = 384; d.K = 384; d.nM = 65; d.nN = 3; d.epi = E_UQ; }
                        else { d.A = P->latent; d.lda = 256; d.Bt = P->WukvT; d.ldb = 256; d.K = 256; d.nM = 193; d.nN = 4; d.epi = E_UKV; d.start = 195; } break;
                case 5: d.A = P->h; d.lda = DM; d.Bt = P->WgT; d.ldb = DM; d.K = DM; d.nM = 64; d.nN = 8; d.epi = E_GATE; break;
                case 6: d.A = P->o + pass * 512; d.lda = DM; d.Bt = pass ? P->WpbT : P->WpaT; d.ldb = 512; d.K = 512; d.nM = 64; d.nN = 4; d.epi = pass ? E_PROJB : E_PROJA; break;
                case 7: d.A = P->merged; d.lda = DM; d.Bt = P->WoutT; d.ldb = DM; d.K = DM; d.nM = 64; d.nN = 4; d.epi = E_PLAIN; d.C = P->m2; d.ldc = DM; break;
                case 9: d.A = P->h2; d.lda = DM; d.Bt = P->WupT; d.ldb = DM; d.K = DM; d.nM = 65; d.nN = 22; d.epi = E_UP; break;
                default: d.A = P->g; d.lda = DFF; d.Bt = P->WdownT; d.ldb = DFF; d.K = DFF; d.nM = 64; d.nN = 4; d.epi = E_PLAIN; d.C = P->f; d.ldc = DM; break;
                }
                gemm_run(d, lds);
#ifdef PROBE_GEMM2
                if (ph == PROBE_GEMM2 && !(ph == 6 && pass == 0)) { __syncthreads(); if (ph == 6) { GemmDesc d0 = d; d0.A = P->o; d0.Bt = P->WpaT; d0.epi = E_PROJA; gemm_run(d0, lds); } gemm_run(d, lds); }
#endif
            }
        }
        if (lo <= ph && ph < hi) {
            KP P = kparams();
            if (ph == 5) gemm_small<1, 8>(P, P->h, DM, P->WgT, DM, 2048, P->gates, 2048, lds);
            else if (ph == 6) gemm_small<2, 4>(P, P->o, DM, P->WpaT, 512, 1024, P->merged, DM, lds);
            else if (ph == 7) gemm_small<0, 8>(P, P->merged, DM, P->WoutT, DM, 1024, P->m2, DM, lds);
            else if (ph == 11) gemm_small<0, 22>(P, P->g, DFF, P->WdownT, DFF, 1024, P->f, DM, lds);
#ifdef PROBE_SMALL
            if (ph == 5) gemm_small<1, 8>(P, P->h, DM, P->WgT, DM, 2048, P->gates, 2048, lds);
            else if (ph == 6) gemm_small<2, 4>(P, P->o, DM, P->WpaT, 512, 1024, P->merged, DM, lds);
            else if (ph == 7) gemm_small<0, 8>(P, P->merged, DM, P->WoutT, DM, 1024, P->m2, DM, lds);
            else if (ph == 11) gemm_small<0, 22>(P, P->g, DFF, P->WdownT, DFF, 1024, P->f, DM, lds);
#endif
        }
        SYNC(ph);
    }
}

static size_t bump(size_t& off, size_t bytes) { size_t r = off; off += (bytes + 255) & ~(size_t)255; return r; }

extern "C" void kernel_launch(void* const* d_in, const int* in_sizes, int n_in, void* d_out, int out_size, void* d_ws, size_t ws_size, hipStream_t stream) {
    Params P; memset(&P, 0, sizeof(P));
    const float* const* in = (const float* const*)d_in;
    P.x_p = in[0]; P.x_s = in[1]; P.c_ckv = in[2]; P.c_kr = in[3]; P.c_sbk = in[4]; P.c_sbv = in[5]; P.c_conv = in[6]; P.c_p = in[7]; P.c_s = in[8];
    P.w_ada = in[9]; P.b_ada = in[10]; P.g_pre_mix = in[11]; P.g_post_mix = in[12]; P.g_pre_ffn = in[13]; P.g_post_ffn = in[14];
    const float* w_in = in[15]; const float* g_q = in[16]; const float* w_uq = in[17]; P.g_kv = in[18]; const float* w_uk = in[19]; const float* w_uv = in[20];
    const float* w_pa = in[21]; const float* w_pb = in[22]; const float* w_out = in[23]; const float* w_up = in[24]; P.conv_w = in[25]; P.conv_b = in[26]; const float* w_down = in[27];
    P.out = (float*)d_out;
    char* ws = (char*)d_ws; size_t off = 0;
    P.WupT = (bf16_t*)(ws + bump(off, (size_t)DFF2 * DM * 2));
    P.WdownT = (bf16_t*)(ws + bump(off, (size_t)DM * DFF * 2));
    P.ropeT = (float*)(ws + bump(off, (size_t)TP * 32 * 4));
    P.ada = (float*)(ws + bump(off, 10 * 6144 * 4));
    P.ctr = (unsigned*)(ws + bump(off, 256));
    P.bar = (unsigned*)(ws + bump(off, XCD_BAR_WORDS * 4));
    const size_t R0 = off;
    P.WinT = (bf16_t*)(ws + bump(off, (size_t)2304 * DM * 2));
    P.WgT = (bf16_t*)(ws + bump(off, (size_t)2048 * DM * 2));
    P.WuqT = (bf16_t*)(ws + bump(off, (size_t)768 * 384 * 2));
    P.WukvT = (bf16_t*)(ws + bump(off, (size_t)1024 * 256 * 2));
    P.WpaT = (bf16_t*)(ws + bump(off, (size_t)1024 * 512 * 2));
    P.WpbT = (bf16_t*)(ws + bump(off, (size_t)1024 * 512 * 2));
    P.WoutT = (bf16_t*)(ws + bump(off, (size_t)1024 * 1024 * 2));
    const size_t o_kva = off;
    P.kva = (bf16_t*)(ws + bump(off, (size_t)KVROWS_PAD * 512 * 2));
    P.vaT_p = (bf16_t*)(ws + bump(off, (size_t)2 * 512 * TP * 2));
    P.vaT_s = (bf16_t*)(ws + bump(off, (size_t)8 * 512 * SKP * 2));
    const size_t o_kb = off;
    P.kb = (bf16_t*)(ws + bump(off, (size_t)KVROWS_PAD * 512 * 2));
    const size_t o_vbT = off;
    P.vbT_p = (bf16_t*)(ws + bump(off, (size_t)2 * 512 * TP * 2));
    P.vbT_s = (bf16_t*)(ws + bump(off, (size_t)8 * 512 * SKP * 2));
    const size_t o_kr = off;
    P.krope = (bf16_t*)(ws + bump(off, (size_t)KVROWS_PAD * 32 * 2));
    P.qb = (bf16_t*)(ws + bump(off, (size_t)MT * 512 * 2));
    P.q = (bf16_t*)(ws + bump(off, (size_t)MT * 768 * 2));
    P.latent = (bf16_t*)(ws + bump(off, (size_t)KVROWS_PAD * 256 * 2));
    size_t need = off;
    P.gates = (bf16_t*)(ws + o_kva);
    P.merged = (bf16_t*)(ws + o_kb);
    P.m2 = (bf16_t*)(ws + o_vbT);
    P.u = (bf16_t*)(ws + R0);
    const size_t o_g = R0 + (size_t)MT * DFF2 * 2;
    P.g = (bf16_t*)(ws + o_g);
    P.f = (bf16_t*)(ws + R0);
    size_t o_h2 = o_kr > o_g ? o_kr : o_g;
    P.h2 = (bf16_t*)(ws + o_h2);
    if (o_g + (size_t)MT * DFF * 2 > need) need = o_g + (size_t)MT * DFF * 2;
    if (o_h2 + (size_t)MT * DM * 2 > need) need = o_h2 + (size_t)MT * DM * 2;
    P.h = (bf16_t*)d_out;
    P.o = (bf16_t*)d_out + (size_t)MT * DM;
    P.qlat = P.o;
    if (need > ws_size) { fprintf(stderr, "workspace too small: need %zu have %zu\n", need, ws_size); return; }

    int nj = 0, tiles = 0;
    auto job = [&](const float* src, int lds, int coff, bf16_t* dst, int ldd, int Klen, int Nlen, const float* ks, int zero) {
        TJob& J = P.tj[nj++]; J.src = src; J.kscale = ks; J.dst = dst; J.lds = lds; J.coff = coff; J.ldd = ldd; J.Klen = Klen; J.Nlen = Nlen; J.zero = zero; J.tile0 = tiles; J.pad = 0;
        tiles += (Klen / 64) * ((Nlen + 255) / 256); };
    job(w_up, DFF2, 0, P.WupT, DM, DM, DFF2, nullptr, 0);
    job(w_down, DM, 0, P.WdownT, DFF, DFF, DM, nullptr, 0);
    job(w_in, 4256, 0, P.WinT, DM, DM, 384, nullptr, 0);
    job(w_in, 4256, 640, P.WinT + (size_t)384 * DM, DM, DM, 32, nullptr, 0);
    job(w_in, 4256, 0, P.WinT + (size_t)416 * DM, DM, DM, 96, nullptr, 1);
    job(w_in, 4256, 384, P.WinT + (size_t)512 * DM, DM, DM, 256, nullptr, 0);
    job(w_in, 4256, 672, P.WinT + (size_t)768 * DM, DM, DM, 1536, nullptr, 0);
    job(w_in, 4256, 2208, P.WgT, DM, DM, 2048, nullptr, 0);
    job(w_uq, 768, 0, P.WuqT, 384, 384, 768, g_q, 0);
    job(w_uk, 512, 0, P.WukvT, 256, 256, 512, nullptr, 0);
    job(w_uv, 512, 0, P.WukvT + (size_t)512 * 256, 256, 256, 512, nullptr, 0);
    job(w_pa, DM, 0, P.WpaT, 512, 512, DM, nullptr, 0);
    job(w_pb, DM, 0, P.WpbT, 512, 512, DM, nullptr, 0);
    job(w_out, DM, 0, P.WoutT, DM, DM, DM, nullptr, 0);
    P.ntj_tiles = tiles; P.pad0 = nj;
    P.phase_lo = 0; P.phase_hi = 13;

    static int grid_blocks = 0;
    if (!grid_blocks) {
        (void)hipFuncSetAttribute((const void*)fwd_megakernel, hipFuncAttributeMaxDynamicSharedMemorySize, LDS_BYTES);
        int dev = 0, cus = 0, per_cu = 0;
        (void)hipGetDevice(&dev);
        (void)hipDeviceGetAttribute(&cus, hipDeviceAttributeMultiprocessorCount, dev);
        (void)hipOccupancyMaxActiveBlocksPerMultiprocessor(&per_cu, fwd_megakernel, NTHREADS, LDS_BYTES);
        if (per_cu > 1) per_cu = 1;
        grid_blocks = cus * per_cu;
    }
    (void)hipMemsetAsync(P.ctr, 0, 256 + XCD_BAR_WORDS * 4, stream);
    void* args[] = {&P};
    hipError_t e = hipLaunchCooperativeKernel((const void*)fwd_megakernel, dim3(grid_blocks), dim3(NTHREADS), args, LDS_BYTES, stream);
    if (e != hipSuccess) fprintf(stderr, "cooperative launch failed: %s (grid %d)\n", hipGetErrorString(e), grid_blocks);
}
```

```cpp
#include <hip/hip_runtime.h>
#include <hip/hip_cooperative_groups.h>
#include <stdint.h>
#include <stdio.h>
#include <string.h>
namespace cg = cooperative_groups;

typedef unsigned short bf16_t;
typedef short bf16x8 __attribute__((ext_vector_type(8)));
typedef short s16x4 __attribute__((ext_vector_type(4)));
typedef float f32x2 __attribute__((ext_vector_type(2)));
typedef float f32x4 __attribute__((ext_vector_type(4)));
typedef float f32x16 __attribute__((ext_vector_type(16)));
typedef unsigned u32x2 __attribute__((ext_vector_type(2)));
typedef unsigned u32x4 __attribute__((ext_vector_type(4)));
typedef __bf16 bf2_t __attribute__((ext_vector_type(2)));
#define DI __device__ __forceinline__

constexpr int DM = 1024, TP = 8192, MP = 16384, MS = 256, MT = 16640, PAST = 4096, SKEYS = 4128, SKP = 4160;
constexpr int KVROWS = MP + 8 * SKEYS;
constexpr int KVROWS_PAD = KVROWS + 64;
constexpr int DFF = 2816, DFF2 = 5632;
constexpr float EPS = 1e-6f;
constexpr float LOG2E = 1.4426950408889634f, LN2 = 0.6931471805599453f;
constexpr int NTHREADS = 512;
constexpr int LDS_BYTES = 131072 + 8192;
constexpr long O_Y = 0, O_CKV_P = 17039360, O_KR_P = 21233664, O_SBK_P = 21757952, O_SBV_P = 30146560, O_CONV_P = 38535168,
               O_CKV_S = 38557696, O_KR_S = 38623232, O_SBK_S = 38631424, O_SBV_S = 38762496, O_CONV_S = 38893568;

struct TJob { const float* src; const float* kscale; bf16_t* dst; int lds, coff, ldd, Klen, Nlen, zero, tile0, pad; };
constexpr int NTJ = 22;

struct Params {
    const float *x_p, *x_s, *c_ckv, *c_kr, *c_sbk, *c_sbv, *c_conv, *c_p, *c_s;
    const float *w_ada, *b_ada, *g_pre_mix, *g_post_mix, *g_pre_ffn, *g_post_ffn, *g_kv, *conv_w, *conv_b;
    float* out;
    bf16_t *WupT, *WdownT, *WinT, *WgT, *WuqT, *WukvT, *WpaT, *WpbT, *WoutT;
    float* ropeT; float* ada; unsigned* ctr; unsigned* bar;
    bf16_t *h, *o, *qlat, *latent, *krope, *kb, *vbT_p, *vbT_s, *qb, *q, *kva, *vaT_p, *vaT_s, *gates, *merged, *m2, *h2, *u, *g, *f, *ub;
    TJob tj[NTJ]; int ntj_tiles; int phase_lo, phase_hi, pad0;
};

#define LAS __attribute__((address_space(3)))
typedef const Params __attribute__((address_space(4))) * KP;
DI KP kparams() { KP p = (KP)__builtin_amdgcn_kernarg_segment_ptr(); asm volatile("" : "+s"(p)); return p; }
DI int otid() { int t = threadIdx.x; asm volatile("" : "+v"(t)); return t; }
DI int obid() { int b = blockIdx.x; asm volatile("" : "+s"(b)); return b; }
DI int ogrid() { int g = gridDim.x; asm volatile("" : "+s"(g)); return g; }
DI unsigned pk2(float a, float b) { f32x2 f = {a, b}; bf2_t r = __builtin_convertvector(f, bf2_t); return __builtin_bit_cast(unsigned, r); }
DI float bf_lo(unsigned u) { return __uint_as_float(u << 16); }
DI float bf_hi(unsigned u) { return __uint_as_float(u & 0xffff0000u); }
DI int kvrow_of(int row) { if (row < MP) return row; const int r = row - MP; return MP + (r >> 5) * SKEYS + PAST + (r & 31); }
DI int pos_of(int row) { return row < MP ? (row & (TP - 1)) : PAST + ((row - MP) & 31); }
DI int ada_b(int row) { return row < MP ? (row >> 13) : 2 + ((row - MP) >> 5); }
DI float sigmoidf_(float x) { return __builtin_amdgcn_rcpf(1.0f + __builtin_amdgcn_exp2f(-1.4426950408889634f * x)); }

constexpr int BM = 256, BK = 64, HALF = 128, HT = HALF * BK;
DI int lds_byte(int r, int c) { int st = (r >> 4) * 2 + (c >> 5), rr = r & 15, cc = c & 31, ob = rr * 64 + cc * 2; return st * 1024 + (ob ^ (((ob >> 9) & 1) << 5)); }
DI void stage_rc(int b, int& R, int& C) { int st = b / 1024, sb = b % 1024, swz = sb ^ (((sb >> 9) & 1) << 5); R = (st >> 1) * 16 + swz / 64; C = (st & 1) * 32 + (swz % 64) / 2; }

enum { E_INPROJ = 0, E_GATE, E_UQ, E_UKV, E_PROJA, E_PROJB, E_PLAIN, E_UP };
struct GemmDesc { const bf16_t* A; const bf16_t* Bt; bf16_t* C; int lda, ldb, ldc, K, nM, nN, epi, start; };

constexpr int HTB = HT * 2;
#define SA(b, h) (((b) * 2 + (h)) * HTB)
#define SB(b, h) ((4 + (b) * 2 + (h)) * HTB)
#define STAGE(bufoff, gbase, voff) do { _Pragma("unroll") for (int _i = 0; _i < 2; ++_i) \
    __builtin_amdgcn_global_load_lds((const unsigned*)((const char*)(gbase) + (voff)[_i]), (LAS unsigned*)(ldsl + (bufoff) + ldsw + _i * 8192), 16, 0, 0); } while (0)
#define LDA(dst, b, h) do { _Pragma("unroll") for (int m = 0; m < 4; ++m) _Pragma("unroll") for (int k = 0; k < 2; ++k) dst[m][k] = *(const LAS bf16x8*)(ldsl + SA(b, h) + aoff + m * 2048 + k * 1024); } while (0)
#define LDB(dst, b, h) do { _Pragma("unroll") for (int n = 0; n < 2; ++n) _Pragma("unroll") for (int k = 0; k < 2; ++k) dst[n][k] = *(const LAS bf16x8*)(ldsl + SB(b, h) + boff + n * 2048 + k * 1024); } while (0)
#define MMA(ai, bj, At, Bt_) do { __builtin_amdgcn_s_setprio(1); _Pragma("unroll") for (int m = 0; m < 4; ++m) _Pragma("unroll") for (int n = 0; n < 2; ++n) _Pragma("unroll") for (int k = 0; k < 2; ++k) \
      acc[ai][bj][m][n] = __builtin_amdgcn_mfma_f32_16x16x32_bf16(Bt_[n][k], At[m][k], acc[ai][bj][m][n], 0, 0, 0); \
    __builtin_amdgcn_s_setprio(0); } while (0)
#define WAIT_V(n) asm volatile("s_waitcnt vmcnt(" #n ")" ::: "memory")
#define WAIT_L(n) asm volatile("s_waitcnt lgkmcnt(" #n ")" ::: "memory")
#define BAR __builtin_amdgcn_s_barrier()
#define SCHED __builtin_amdgcn_sched_barrier(0)
#define ZERO_ACC do { _Pragma("unroll") for (int a_ = 0; a_ < 2; ++a_) _Pragma("unroll") for (int b_ = 0; b_ < 2; ++b_) _Pragma("unroll") for (int m_ = 0; m_ < 4; ++m_) _Pragma("unroll") for (int n_ = 0; n_ < 2; ++n_) \
    acc[a_][b_][m_][n_] = (f32x4){0.f, 0.f, 0.f, 0.f}; } while (0)

#define EPI_ROWS for (int ai = 0; ai < 2; ++ai) for (int m = 0; m < 4; ++m, ({ asm volatile("" ::: "memory"); }))
#define EPI_COLS for (int bj = 0; bj < 2; ++bj) for (int n = 0; n < 2; ++n)

DI float dpp_xor1(float x) { return __int_as_float(__builtin_amdgcn_mov_dpp(__float_as_int(x), 0xB1, 0xF, 0xF, true)); }
DI float dpp_xor2(float x) { return __int_as_float(__builtin_amdgcn_mov_dpp(__float_as_int(x), 0x4E, 0xF, 0xF, true)); }
DI float gelu_tanh(float a) { const float a2 = a * a; const float q = a * __builtin_fmaf(0.10294324f, a2, 2.3022082f);
    const float e = __builtin_amdgcn_exp2f(q); const float r = __builtin_amdgcn_rcpf(1.0f + e); return __builtin_fmaf(-a, r, a); }
DI float dpp_ror1(float x) { return __int_as_float(__builtin_amdgcn_mov_dpp(__float_as_int(x), 0x121, 0xF, 0xF, true)); }
DI float dpp_ror2(float x) { return __int_as_float(__builtin_amdgcn_mov_dpp(__float_as_int(x), 0x122, 0xF, 0xF, true)); }
DI f32x4 ror1_4(f32x4 v) { return (f32x4){dpp_ror1(v[0]), dpp_ror1(v[1]), dpp_ror1(v[2]), dpp_ror1(v[3])}; }
DI f32x4 ror2_4(f32x4 v) { return (f32x4){dpp_ror2(v[0]), dpp_ror2(v[1]), dpp_ror2(v[2]), dpp_ror2(v[3])}; }
DI f32x4 quad_transpose(f32x4 v, int i) {
    { const float a = (i & 1) ? v[0] : v[1], c = (i & 1) ? v[2] : v[3]; const float ra = dpp_xor1(a), rc = dpp_xor1(c);
      if (i & 1) { v[0] = ra; v[2] = rc; } else { v[1] = ra; v[3] = rc; } }
    { const float a = (i & 2) ? v[0] : v[2], c = (i & 2) ? v[1] : v[3]; const float ra = dpp_xor2(a), rc = dpp_xor2(c);
      if (i & 2) { v[0] = ra; v[1] = rc; } else { v[2] = ra; v[3] = rc; } }
    return v;
}
DI void store_bf4(bf16_t* p, f32x4 v) { u32x2 w; w.x = pk2(v[0], v[1]); w.y = pk2(v[2], v[3]); *(u32x2*)p = w; }

DI int unit_at(int k, int bid, int G, int nM, int nN, int start) {
    if (G != 256) { const int u = (bid + G - (start % G)) % G + k * G; return u < nM * nN ? u : -1; }
    const int x = bid & 7, l = ((bid >> 3) + start) & 31, cnt = nM >> 3, mainn = cnt * nN, j = l + 32 * k;
    if (j < mainn) { const int pn = j / cnt, rm = j - pn * cnt; return (x + 8 * rm) * nN + pn; }
    const int idx = x + 8 * (j - mainn);
    if (idx < (nM & 7) * nN) return (8 * cnt + idx / nN) * nN + idx % nN;
    return -1;
}

DI void gemm_run(const GemmDesc& d, char* lds) {
    LAS char* ldsl = (LAS char*)lds;
    float* xl = (float*)(lds + 131072);
    float* xp = (float*)(lds + 131072 + 4096);
    const int G = ogrid(), bid_ = obid(), first = unit_at(0, bid_, G, d.nM, d.nN, d.start);
    if (first < 0) return;
    int kun = 0;
    const int tid = otid(), wid = __builtin_amdgcn_readfirstlane(tid >> 6), wr = wid >> 2, wc = wid & 3;
    const unsigned lda2 = (unsigned)d.lda * 2u, ldb2 = (unsigned)d.ldb * 2u;
    unsigned voffA[2], voffB[2];
    { const int lane = tid & 63;
#pragma unroll
      for (int i = 0; i < 2; ++i) { int R, C; stage_rc(tid * 16 + i * 8192, R, C); voffA[i] = (unsigned)R * lda2 + (unsigned)C * 2u; voffB[i] = (unsigned)R * ldb2 + (unsigned)C * 2u; }
      (void)lane; }
    const size_t kstep = 128, hA = (size_t)HALF * lda2, hB = (size_t)HALF * ldb2;
    const unsigned ldsw = (unsigned)wid * 1024u;
    const int aoff = lds_byte(wr * 64 + (tid & 15), ((tid & 63) >> 4) * 8), boff = lds_byte(wc * 32 + (tid & 15), ((tid & 63) >> 4) * 8);
    const int nt = d.K / BK;
    int u = first;
    const char* cA = (const char*)d.A + (size_t)(u / d.nN) * 2 * hA; const char* cB = (const char*)d.Bt + (size_t)(u % d.nN) * 2 * hB;
    f32x4 acc[2][2][4][2];
    ZERO_ACC;
    bf16x8 At[4][2], B0[2][2], B1[2][2];
    STAGE(SB(0, 0), cB, voffB); STAGE(SB(0, 1), cB + hB, voffB); STAGE(SA(0, 0), cA, voffA); STAGE(SA(0, 1), cA + hA, voffA);
    if (wr == 1) BAR;
    WAIT_V(2); BAR;
    STAGE(SB(1, 0), cB + kstep, voffB); STAGE(SA(1, 0), cA + kstep, voffA); STAGE(SB(1, 1), cB + hB + kstep, voffB);
    WAIT_V(6); BAR;
    for (;;) {
        const int un = unit_at(kun + 1, bid_, G, d.nM, d.nN, d.start); const bool has_next = un >= 0;
        const char* nA = has_next ? (const char*)d.A + (size_t)(un / d.nN) * 2 * hA : cA; const char* nB = has_next ? (const char*)d.Bt + (size_t)(un % d.nN) * 2 * hB : cB;
        for (int t = 0; t < nt; t += 2) {
            const bool last = (t == nt - 2);
            const char* a1 = cA + (size_t)(t + 1) * kstep;
            const char* a2 = last ? nA : cA + (size_t)(t + 2) * kstep; const char* b2 = last ? nB : cB + (size_t)(t + 2) * kstep;
            const char* a3 = a2 + kstep; const char* b3 = b2 + kstep;
            LDB(B0, 0, 0); LDB(B1, 0, 1); SCHED; LDA(At, 0, 0); STAGE(SA(1, 1), a1 + hA, voffA);
            WAIT_V(8); WAIT_L(0); BAR; MMA(0, 0, At, B0); MMA(0, 1, At, B1); BAR; SCHED;
            LDA(At, 0, 1); STAGE(SB(0, 0), b2, voffB); STAGE(SB(0, 1), b2 + hB, voffB); STAGE(SA(0, 0), a2, voffA);
            WAIT_V(8); WAIT_L(0); BAR; MMA(1, 0, At, B0); MMA(1, 1, At, B1); BAR; SCHED;
            LDB(B0, 1, 0); LDB(B1, 1, 1); SCHED; LDA(At, 1, 0); STAGE(SA(0, 1), a2 + hA, voffA);
            WAIT_V(8); WAIT_L(0); BAR; MMA(0, 0, At, B0); MMA(0, 1, At, B1); BAR; SCHED;
            LDA(At, 1, 1); STAGE(SB(1, 0), b3, voffB); STAGE(SB(1, 1), b3 + hB, voffB); STAGE(SA(1, 0), a3, voffA);
            WAIT_V(8); WAIT_L(0); BAR; MMA(1, 0, At, B0); MMA(1, 1, At, B1); BAR; SCHED;
        }
        if (wr == 0) BAR;
        {
        const int pm = u / d.nN, pn = u % d.nN, brow = pm * BM, bcol = pn * BM;
        if (d.epi == E_UQ) {
            const int tq_ = otid(), r = tq_ >> 1, hf = tq_ & 1;
            const u32x4* src = (const u32x4*)(d.A + (long)(brow + r) * 384 + hf * 192);
            float sq = 0.f;
#pragma unroll 4
            for (int i = 0; i < 24; ++i) { u32x4 v = src[i];
                for (int e = 0; e < 4; ++e) { float a_ = bf_lo(v[e]), b_ = bf_hi(v[e]); sq += a_ * a_ + b_ * b_; } }
            sq += __shfl_xor(sq, 1);
            if (hf == 0) xl[r] = rsqrtf(sq * (1.0f / 384.0f) + EPS);
            WAIT_L(0); BAR; asm volatile("" ::: "memory");
        }
        int lane_e = threadIdx.x & 63; asm volatile("" : "+v"(lane_e));
        const int fr = lane_e & 15, fq = lane_e >> 4;
        KP P = kparams();
        const int rbase = brow + wr * 64 + fr, cbase = bcol + wc * 32 + fq * 4;
        switch (d.epi) {
        case E_INPROJ: {
            if (pn == 0) {
#pragma unroll
                EPI_ROWS { const int row = rbase + ai * 128 + m * 16;
#pragma unroll
                    EPI_COLS store_bf4(P->qlat + (long)row * 384 + (cbase + bj * 128 + n * 16), acc[ai][bj][m][n]); }
            } else if (pn == 1) {
#pragma unroll
                EPI_ROWS { const int row = rbase + ai * 128 + m * 16;
#pragma unroll
                    for (int n = 0; n < 2; ++n) store_bf4(P->qlat + (long)row * 384 + 256 + (wc * 32 + fq * 4 + n * 16), acc[ai][0][m][n]);
                    if (wc == 0) {
                        const int pos = pos_of(row);
                        const f32x4 cs0 = *(const f32x4*)(P->ropeT + (long)pos * 32 + fq * 8), cs1 = *(const f32x4*)(P->ropeT + (long)pos * 32 + fq * 8 + 4);
                        const f32x4 x1 = acc[ai][1][m][0], x2 = acc[ai][1][m][1];
                        f32x4 co = {cs0[0], cs0[2], cs1[0], cs1[2]}, si = {cs0[1], cs0[3], cs1[1], cs1[3]};
                        f32x4 o1 = x1 * co - x2 * si, o2 = x2 * co + x1 * si;
                        float* of = P->out + (row < MP ? O_KR_P + (long)row * 32 : O_KR_S + (long)(row - MP) * 32);
                        *(f32x4*)(of + fq * 4) = o1; *(f32x4*)(of + 16 + fq * 4) = o2;
                        bf16_t* ob = P->krope + (long)kvrow_of(row) * 32;
                        store_bf4(ob + fq * 4, o1); store_bf4(ob + 16 + fq * 4, o2);
                    } }
            } else if (pn == 2) {
                float ss[2][4];
#pragma unroll
                EPI_ROWS { float s = 0.f;
#pragma unroll
                    EPI_COLS { const f32x4 v = acc[ai][bj][m][n]; s += v[0] * v[0] + v[1] * v[1] + v[2] * v[2] + v[3] * v[3]; }
                    s += __shfl_xor(s, 16); s += __shfl_xor(s, 32); ss[ai][m] = s;
                    if (fq == 0) xp[(ai * 128 + wr * 64 + m * 16 + fr) * 4 + wc] = s; }
                WAIT_L(0); BAR; asm volatile("" ::: "memory");
#pragma unroll
                EPI_ROWS { const int rl = ai * 128 + wr * 64 + m * 16 + fr, row = brow + rl;
                    const f32x4 pp = *(const f32x4*)(xp + rl * 4);
                    const float rstd = rsqrtf((pp[0] + pp[1] + pp[2] + pp[3]) * (1.0f / 256.0f) + EPS);
                    float* of = P->out + (row < MP ? O_CKV_P + (long)row * 256 : O_CKV_S + (long)(row - MP) * 256);
                    bf16_t* ob = P->latent + (long)kvrow_of(row) * 256;
#pragma unroll
                    EPI_COLS { const int c = wc * 32 + fq * 4 + bj * 128 + n * 16;
                        const f32x4 gv = *(const f32x4*)(P->g_kv + c); const f32x4 o = acc[ai][bj][m][n] * rstd * gv;
                        *(f32x4*)(of + c) = o; store_bf4(ob + c, o); } }
            } else if (pn <= 4) {
#pragma unroll
                EPI_ROWS { const int row = rbase + ai * 128 + m * 16;
#pragma unroll
                    EPI_COLS store_bf4(P->qb + (long)row * 512 + (cbase - 768 + bj * 128 + n * 16), acc[ai][bj][m][n] * 0.125f); }
            } else if (pn <= 6) {
#pragma unroll
                EPI_ROWS { const int row = rbase + ai * 128 + m * 16;
                    float* of = P->out + (row < MP ? O_SBK_P + (long)row * 512 : O_SBK_S + (long)(row - MP) * 512);
                    bf16_t* ob = P->kb + (long)kvrow_of(row) * 512;
#pragma unroll
                    EPI_COLS { const int c = cbase - 1280 + bj * 128 + n * 16; *(f32x4*)(of + c) = acc[ai][bj][m][n]; store_bf4(ob + c, acc[ai][bj][m][n]); } }
            } else {
#pragma unroll
                EPI_ROWS { const int row = rbase + ai * 128 + m * 16;
                    float* of = P->out + (row < MP ? O_SBV_P + (long)row * 512 : O_SBV_S + (long)(row - MP) * 512);
                    const int qi = fr & 3, row4 = row - qi;
                    bf16_t* vt; int ldv;
                    if (row4 < MP) { vt = P->vbT_p + (long)(row4 >> 13) * 512 * TP + (row4 & (TP - 1)); ldv = TP; }
                    else { const int r = row4 - MP; vt = P->vbT_s + (long)(r >> 5) * 512 * SKP + PAST + (r & 31); ldv = SKP; }
#pragma unroll
                    EPI_COLS { const int c = cbase - 1792 + bj * 128 + n * 16; const f32x4 v = acc[ai][bj][m][n]; *(f32x4*)(of + c) = v;
                        store_bf4(vt + (long)(c + qi) * ldv, quad_transpose(v, qi)); } }
            }
        } break;
        case E_GATE: {
#pragma unroll
            EPI_ROWS { const int row = rbase + ai * 128 + m * 16;
#pragma unroll
                EPI_COLS { const f32x4 v = acc[ai][bj][m][n]; f32x4 s = {sigmoidf_(v[0]), sigmoidf_(v[1]), sigmoidf_(v[2]), sigmoidf_(v[3])};
                    store_bf4(P->gates + (long)row * 2048 + (cbase + bj * 128 + n * 16), s); } }
        } break;
        case E_UQ: {
            const float qs = 0.10206207261596577f * LOG2E;
#pragma unroll
            EPI_ROWS { const int rl = ai * 128 + wr * 64 + m * 16 + fr, row = brow + rl; const float rs = xl[rl] * qs;
#pragma unroll
                for (int bj = 0; bj < 2; ++bj) { const int grp = pn * 8 + bj * 4 + wc; bf16_t* dst = P->q + (long)row * 768 + grp * 32 + fq * 4;
                    f32x4 v0 = acc[ai][bj][m][0] * rs, v1 = acc[ai][bj][m][1] * rs;
                    if (grp % 3 == 2) {
                        const int pos = pos_of(row);
                        const f32x4 cs0 = *(const f32x4*)(P->ropeT + (long)pos * 32 + fq * 8), cs1 = *(const f32x4*)(P->ropeT + (long)pos * 32 + fq * 8 + 4);
                        f32x4 co = {cs0[0], cs0[2], cs1[0], cs1[2]}, si = {cs0[1], cs0[3], cs1[1], cs1[3]};
                        const f32x4 o1 = v0 * co - v1 * si, o2 = v1 * co + v0 * si; v0 = o1; v1 = o2;
                    }
                    store_bf4(dst, v0); store_bf4(dst + 16, v1); } }
        } break;
        case E_UKV: {
#pragma unroll
            EPI_ROWS { const int row = rbase + ai * 128 + m * 16;
                if (pn < 2) {
#pragma unroll
                    EPI_COLS store_bf4(P->kva + (long)row * 512 + (cbase + bj * 128 + n * 16), acc[ai][bj][m][n]);
                } else {
                    const int qi = fr & 3, row4 = row - qi;
                    bf16_t* vt; int ldv;
                    if (row4 < MP) { vt = P->vaT_p + (long)(row4 >> 13) * 512 * TP + (row4 & (TP - 1)); ldv = TP; }
                    else { const int r = row4 - MP, b = r / SKEYS; vt = P->vaT_s + (long)b * 512 * SKP + (r - b * SKEYS); ldv = SKP; }
#pragma unroll
                    EPI_COLS { const int c = cbase - 512 + bj * 128 + n * 16; const f32x4 vtr = quad_transpose(acc[ai][bj][m][n], qi);
                        if (row4 < KVROWS) store_bf4(vt + (long)(c + qi) * ldv, vtr); }
                } }
        } break;
        case E_PROJA: case E_PROJB: {
            const int goff = d.epi == E_PROJA ? 0 : 1024;
#pragma unroll
            EPI_ROWS { const int row = rbase + ai * 128 + m * 16;
#pragma unroll
                EPI_COLS { const int c = cbase + bj * 128 + n * 16; const u32x2 gw = *(const u32x2*)(P->gates + (long)row * 2048 + goff + c);
                    f32x4 gv = {bf_lo(gw.x), bf_hi(gw.x), bf_lo(gw.y), bf_hi(gw.y)}; f32x4 v = acc[ai][bj][m][n] * gv;
                    bf16_t* dst = P->merged + (long)row * 1024 + c;
                    if (d.epi == E_PROJB) { const u32x2 pw = *(const u32x2*)dst; f32x4 pv = {bf_lo(pw.x), bf_hi(pw.x), bf_lo(pw.y), bf_hi(pw.y)}; v += pv; }
                    store_bf4(dst, v); } }
        } break;
        case E_PLAIN: {
#pragma unroll
            EPI_ROWS { const int row = rbase + ai * 128 + m * 16;
#pragma unroll
                EPI_COLS store_bf4(d.C + (long)row * d.ldc + (cbase + bj * 128 + n * 16), acc[ai][bj][m][n]); }
        } break;
        case E_UP: {
            const int jc0 = pn * 128 + wc * 32 + fq * 4;
            if (pm != 64) {
                const int tq_ = otid(), arr = tq_ >> 6, c2 = (tq_ & 63) * 2, hfb = arr >> 2, kk = arr & 3;
                const float* src = (kk < 3 ? P->conv_w + kk * DFF2 : P->conv_b) + hfb * DFF + pn * 128 + c2;
                *(f32x2*)(xp + arr * 128 + c2) = *(const f32x2*)src;
                WAIT_L(0); BAR; asm volatile("" ::: "memory");
            }
            if (pm == 64) {
#pragma unroll
                EPI_ROWS { const int row = rbase + ai * 128 + m * 16, r = row - MP, t = r & 31;
                    float* cf = t >= 30 ? P->out + O_CONV_S + (long)((r >> 5) * 2 + (t - 30)) * DFF2 : nullptr;
#pragma unroll
                    EPI_COLS { const int c = (bj ? DFF : 0) + jc0 + n * 16; store_bf4(P->u + (long)r * DFF2 + c, acc[ai][bj][m][n]); if (cf) *(f32x4*)(cf + c) = acc[ai][bj][m][n]; } }
            } else {
#pragma unroll
                for (int ai = 0; ai < 2; ++ai)
#pragma unroll
                    for (int n = 0; n < 2; ++n) {
                        const int ca = jc0 + n * 16;
                        f32x4 pa1 = {0.f, 0.f, 0.f, 0.f}, pa2 = pa1, pb1 = pa1, pb2 = pa1;
#pragma unroll
                        for (int m = 0; m < 4; ++m) {
                            const int row = rbase + ai * 128 + m * 16;
                            const f32x4 va = acc[ai][0][m][n], vb = acc[ai][1][m][n];
                            const f32x4 ra1 = ror1_4(va), ra2 = ror2_4(va), rb1 = ror1_4(vb), rb2 = ror2_4(vb);
                            const f32x4 p1a = fr >= 1 ? ra1 : pa1, p2a = fr >= 2 ? ra2 : pa2, p1b = fr >= 1 ? rb1 : pb1, p2b = fr >= 2 ? rb2 : pb2;
                            const float* wl = xp + (ca - pn * 128);
                            f32x4 ya = *(const f32x4*)(wl + 3 * 128) + *(const f32x4*)(wl) * p2a; ya += *(const f32x4*)(wl + 128) * p1a; ya += *(const f32x4*)(wl + 2 * 128) * va;
                            f32x4 yb = *(const f32x4*)(wl + 7 * 128) + *(const f32x4*)(wl + 4 * 128) * p2b; yb += *(const f32x4*)(wl + 5 * 128) * p1b; yb += *(const f32x4*)(wl + 6 * 128) * vb;
                            const f32x4 g4 = {gelu_tanh(ya[0]) * yb[0], gelu_tanh(ya[1]) * yb[1], gelu_tanh(ya[2]) * yb[2], gelu_tanh(ya[3]) * yb[3]};
                            if (!(m == 0 && fr < 2)) store_bf4(P->g + (long)row * DFF + ca, g4);
                            const int blk = row >> 6;
                            if (m == 0 && fr < 2) { bf16_t* up = P->ub + (long)(blk * 4 + 2 + fr) * DFF2 + ca; store_bf4(up, va); store_bf4(up + DFF, vb); }
                            if (m == 3 && fr >= 14) { bf16_t* up = P->ub + (long)(blk * 4 + (fr - 14)) * DFF2 + ca; store_bf4(up, va); store_bf4(up + DFF, vb);
                                const int t = row & (TP - 1);
                                if (t >= TP - 2) { float* cf = P->out + O_CONV_P + (long)((row >> 13) * 2 + (t - (TP - 2))) * DFF2 + ca; *(f32x4*)cf = va; *(f32x4*)(cf + DFF) = vb; } }
                            pa1 = ra1; pa2 = ra2; pb1 = rb1; pb2 = rb2;
                            asm volatile("" ::: "memory");
                        }
                    }
            }
        } break;
        }
        }
        if (!has_next) break;
        ZERO_ACC;
        u = un; cA = nA; cB = nB; ++kun;
        if (wr == 1) BAR;
    }
    WAIT_V(0);
    BAR;
}

#define MFMA32(a, b, c) __builtin_amdgcn_mfma_f32_32x32x16_bf16((a), (b), (c), 0, 0, 0)
template <int KIND, int KSTEPS  >
DI void gemm_small(KP P, const bf16_t* A, int lda, const bf16_t* Bt, int ldb, int N, bf16_t* C, int ldc, char* lds) {
    const int tid = otid(), lane = tid & 63, w = tid >> 6, r = lane & 31, hh = lane >> 5, G = ogrid();
    const int ntask = 8 * (N >> 5);
    float* part = (float*)lds;
    for (int task = obid(); task < ntask; task += G) {
        const int cb = (task & 7) + 8 * (task >> 6), rb = (task >> 3) & 7, row0 = MP + rb * 32, col0 = cb * 32;
#pragma unroll
        for (int pass = 0; pass < (KIND == 2 ? 2 : 1); ++pass) {
            const bf16_t* ap = A + pass * 512 + (long)(row0 + r) * lda + w * (KSTEPS * 16) + 8 * hh;
            const bf16_t* bp = (pass ? P->WpbT : Bt) + (long)(col0 + r) * ldb + w * (KSTEPS * 16) + 8 * hh;
            f32x16 acc;
#pragma unroll
            for (int i = 0; i < 16; ++i) acc[i] = 0.f;
            constexpr int UN = KSTEPS > 11 ? 11 : KSTEPS;
#pragma unroll 1
            for (int s0 = 0; s0 < KSTEPS; s0 += UN) {
                bf16x8 af[UN], bf[UN];
#pragma unroll
                for (int s = 0; s < UN; ++s) { af[s] = *(const bf16x8*)(ap + (s0 + s) * 16); bf[s] = *(const bf16x8*)(bp + (s0 + s) * 16); }
#pragma unroll
                for (int s = 0; s < UN; ++s) acc = MFMA32(bf[s], af[s], acc);
            }
            float* pp = part + ((pass * 8 + w) * 32 + r) * 32 + 4 * hh;
#pragma unroll
            for (int g = 0; g < 4; ++g) *(f32x4*)(pp + 8 * g) = (f32x4){acc[4 * g], acc[4 * g + 1], acc[4 * g + 2], acc[4 * g + 3]};
        }
        __syncthreads();
        {
            const int e = tid * 2, rr = e >> 5, cc = e & 31;
            f32x2 s1 = {0.f, 0.f}, s2 = {0.f, 0.f};
#pragma unroll
            for (int ww = 0; ww < 8; ++ww) { s1 += *(const f32x2*)(part + (ww * 32 + rr) * 32 + cc); if (KIND == 2) s2 += *(const f32x2*)(part + ((8 + ww) * 32 + rr) * 32 + cc); }
            const long row = row0 + rr; const int col = col0 + cc;
            if (KIND == 1) { s1[0] = sigmoidf_(s1[0]); s1[1] = sigmoidf_(s1[1]); }
            if (KIND == 2) { const unsigned ga = *(const unsigned*)(P->gates + row * 2048 + col), gb = *(const unsigned*)(P->gates + row * 2048 + 1024 + col);
                s1[0] = s1[0] * bf_lo(ga) + s2[0] * bf_lo(gb); s1[1] = s1[1] * bf_hi(ga) + s2[1] * bf_hi(gb); }
            *(unsigned*)(C + row * ldc + col) = pk2(s1[0], s1[1]);
        }
        __syncthreads();
    }
}

DI int crow(int i, int h) { return (i & 3) + 8 * (i >> 2) + 4 * h; }

template <int MODE>
DI void attn_unit(KP P, char* lds, bool sample, int b, int h, int ublk) {
    constexpr int DQK = MODE == 0 ? 96 : 64, KS = DQK * 2 + 16, VS = 144, NS = DQK / 16;
    constexpr int KBYTES = 64 * KS, BUF = KBYTES + 64 * VS;
    const int tid = otid(), w = tid >> 6, lane = tid & 63, ql = lane & 31, hh = lane >> 5;
    const int kvrow0 = sample ? MP + b * SKEYS : b * TP;
    const int qrow0 = sample ? MP + b * 32 : b * TP + ublk * 256;
    const int ntiles = sample ? 65 : 4 * (ublk + 1);
    const int t0 = sample ? 0 : ublk * 256 + w * 32, tq = t0 + ql;
    int klim, wmax, wmin;
    if (MODE == 0) { if (sample) { klim = wmax = wmin = SKEYS; } else { klim = ((tq >> 6) + 1) << 6; wmax = (((t0 + 31) >> 6) + 1) << 6; wmin = ((t0 >> 6) + 1) << 6; } }
    else { if (sample) { klim = PAST + tq; wmax = PAST + 31; wmin = PAST; } else { klim = tq; wmax = t0 + 31; wmin = t0; } }
    const bool wactive = sample ? (w == 0) : true;
    const bf16_t* Kp; const bf16_t* Qp; const bf16_t* VT; int ldq; long ldv;
    if (MODE == 0) { Kp = P->kva + (long)kvrow0 * 512 + h * 64; Qp = P->q + (long)qrow0 * 768 + h * 96; ldq = 768;
        VT = sample ? P->vaT_s + (long)(b * 512 + h * 64) * SKP : P->vaT_p + (long)(b * 512 + h * 64) * TP; }
    else { Kp = P->kb + (long)kvrow0 * 512 + h * 64; Qp = P->qb + (long)qrow0 * 512 + h * 64; ldq = 512;
        VT = sample ? P->vbT_s + (long)(b * 512 + h * 64) * SKP : P->vbT_p + (long)(b * 512 + h * 64) * TP; }
    ldv = sample ? SKP : TP;
    const bf16_t* Kr = P->krope + (long)kvrow0 * 32;

    bf16x8 qf[NS];
    if (wactive) {
        const bf16_t* qp = Qp + (long)(w * 32 + ql) * ldq + 8 * hh;
#pragma unroll
        for (int s = 0; s < NS; ++s) qf[s] = *(const bf16x8*)(qp + 16 * s);
    } else {
#pragma unroll
        for (int s = 0; s < NS; ++s) qf[s] = (bf16x8){0, 0, 0, 0, 0, 0, 0, 0};
    }
    f32x16 O0, O1;
#pragma unroll
    for (int i = 0; i < 16; ++i) { O0[i] = 0.f; O1[i] = 0.f; }
    float mrun = -INFINITY, lrun = 0.f, carry = 0.f;
    bool wdone = !wactive;
    volatile int* flags = (volatile int*)(lds + 65536 + 64);

    u32x4 rk0, rk1, rv;
    const int krow_s = tid >> 3, kc_s = tid & 7, rrow_s = tid >> 2, rc_s = tid & 3;
    const bool f32path = (MODE == 1) && sample;
    const float* Kf = P->c_sbk + ((long)b * PAST * 512 + h * 64); const float* Vf = P->c_sbv + ((long)b * PAST * 512 + h * 64);
    auto load_tile = [&](int kt) {
        if (f32path && kt < 64) {
            const float* kp_ = Kf + (long)(kt * 64 + krow_s) * 512 + kc_s * 8; const float* vp_ = Vf + (long)(kt * 64 + krow_s) * 512 + kc_s * 8;
            const f32x4 a0 = *(const f32x4*)kp_, a1 = *(const f32x4*)(kp_ + 4), c0 = *(const f32x4*)vp_, c1 = *(const f32x4*)(vp_ + 4);
            rk0.x = pk2(a0[0], a0[1]); rk0.y = pk2(a0[2], a0[3]); rk0.z = pk2(a1[0], a1[1]); rk0.w = pk2(a1[2], a1[3]);
            rv.x = pk2(c0[0], c0[1]); rv.y = pk2(c0[2], c0[3]); rv.z = pk2(c1[0], c1[1]); rv.w = pk2(c1[2], c1[3]);
            return;
        }
        rk0 = *(const u32x4*)(Kp + (long)(kt * 64 + krow_s) * 512 + kc_s * 8);
        if (MODE == 0 && tid < 256) rk1 = *(const u32x4*)(Kr + (long)(kt * 64 + rrow_s) * 32 + rc_s * 8);
        rv = *(const u32x4*)(VT + (long)krow_s * ldv + kt * 64 + kc_s * 8);
    };
    auto store_tile = [&](int buf, int kt) {
        char* kb_ = lds + buf * BUF; char* vb_ = kb_ + KBYTES;
        *(u32x4*)(kb_ + krow_s * KS + kc_s * 16) = rk0;
        if (f32path && kt < 64) {
#pragma unroll
            for (int e = 0; e < 4; ++e) { *(bf16_t*)(vb_ + (kc_s * 8 + 2 * e) * VS + krow_s * 2) = (bf16_t)(rv[e] & 0xffff); *(bf16_t*)(vb_ + (kc_s * 8 + 2 * e + 1) * VS + krow_s * 2) = (bf16_t)(rv[e] >> 16); }
            return;
        }
        if (MODE == 0 && tid < 256) *(u32x4*)(kb_ + rrow_s * KS + 128 + rc_s * 16) = rk1;
        *(u32x4*)(vb_ + krow_s * VS + kc_s * 16) = rv;
    };
    load_tile(ntiles - 1); store_tile(0, ntiles - 1);
    __syncthreads();
    for (int it = 0; it < ntiles; ++it) {
        const int kt = ntiles - 1 - it, cur = it & 1;
        if (it + 1 < ntiles) load_tile(kt - 1);
        if (wactive && !wdone && kt * 64 < wmax) {
            const char* kb_ = lds + cur * BUF; const char* vb_ = kb_ + KBYTES;
            f32x16 S0, S1;
#pragma unroll
            for (int i = 0; i < 16; ++i) { S0[i] = 0.f; S1[i] = 0.f; }
#pragma unroll
            for (int s = 0; s < NS; ++s) {
                const bf16x8 k0 = *(const bf16x8*)(kb_ + ql * KS + (16 * s + 8 * hh) * 2);
                const bf16x8 k1 = *(const bf16x8*)(kb_ + (32 + ql) * KS + (16 * s + 8 * hh) * 2);
                S0 = MFMA32(k0, qf[s], S0); S1 = MFMA32(k1, qf[s], S1);
            }
            const bool need_mask = (kt * 64 + 64 > wmin);
            const int kbase = kt * 64 + 4 * hh;
            if (MODE == 0) {
                if (need_mask) {
#pragma unroll
                    for (int i = 0; i < 16; ++i) { const int key = kbase + (i & 3) + 8 * (i >> 2);
                        if (key >= klim) S0[i] = -INFINITY; if (key + 32 >= klim) S1[i] = -INFINITY; }
                }
                float mx = S0[0];
#pragma unroll
                for (int i = 1; i < 16; ++i) mx = fmaxf(mx, S0[i]);
#pragma unroll
                for (int i = 0; i < 16; ++i) mx = fmaxf(mx, S1[i]);
                mx = fmaxf(mx, __shfl_xor(mx, 32));
                const float mnew = fmaxf(mrun, mx);
                const float alpha = __builtin_amdgcn_exp2f(mrun - mnew);
                mrun = mnew;
                float ps = 0.f;
#pragma unroll
                for (int i = 0; i < 16; ++i) { S0[i] = __builtin_amdgcn_exp2f(S0[i] - mnew); S1[i] = __builtin_amdgcn_exp2f(S1[i] - mnew); ps += S0[i] + S1[i]; }
                lrun = lrun * alpha + ps;
#pragma unroll
                for (int i = 0; i < 16; ++i) { O0[i] *= alpha; O1[i] *= alpha; }
            } else {
                float gs[2][4], gp[2][4];
                f32x16 SP0, SP1;
#pragma unroll
                for (int i = 0; i < 16; ++i) { const int key = kbase + (i & 3) + 8 * (i >> 2);
                    { const float z = S0[i]; const float t = __builtin_amdgcn_exp2f(-fabsf(z) * LOG2E); float sp = fmaxf(z, 0.f) + LN2 * __builtin_amdgcn_logf(1.0f + t);
                      if (need_mask && key >= klim) sp = 0.f; SP0[i] = sp; }
                    { const float z = S1[i]; const float t = __builtin_amdgcn_exp2f(-fabsf(z) * LOG2E); float sp = fmaxf(z, 0.f) + LN2 * __builtin_amdgcn_logf(1.0f + t);
                      if (need_mask && key + 32 >= klim) sp = 0.f; SP1[i] = sp; } }
#pragma unroll
                for (int g = 0; g < 4; ++g) { gs[0][g] = (SP0[4 * g] + SP0[4 * g + 1]) + (SP0[4 * g + 2] + SP0[4 * g + 3]);
                    gs[1][g] = (SP1[4 * g] + SP1[4 * g + 1]) + (SP1[4 * g + 2] + SP1[4 * g + 3]); }
#pragma unroll
                for (int g = 0; g < 4; ++g) { gp[0][g] = __shfl_xor(gs[0][g], 32); gp[1][g] = __shfl_xor(gs[1][g], 32); }
                float running = carry;
#pragma unroll
                for (int blk = 1; blk >= 0; --blk)
#pragma unroll
                    for (int g = 3; g >= 0; --g) {
                        const float sum1 = hh ? gs[blk][g] : gp[blk][g], sum0 = hh ? gp[blk][g] : gs[blk][g];
                        const float mybase = hh ? running : running + sum1;
                        running += sum0 + sum1;
                        float later = mybase;
#pragma unroll
                        for (int j = 3; j >= 0; --j) { const int i = 4 * g + j; const int key = kbase + j + 8 * g + 32 * blk;
                            const float z = blk ? S1[i] : S0[i], sp = blk ? SP1[i] : SP0[i];
                            float a = __builtin_amdgcn_exp2f((z - sp - later) * LOG2E);
                            if (need_mask && key >= klim) a = 0.f;
                            later += sp;
                            if (blk) S1[i] = a; else S0[i] = a; }
                    }
                carry = running;
                wdone = __all((carry > 104.0f) || (klim <= 0));
            }
            bf16x8 pf[2][2];
#pragma unroll
            for (int s = 0; s < 2; ++s) {
                u32x4 a, c;
                a.x = pk2(S0[8 * s], S0[8 * s + 1]); a.y = pk2(S0[8 * s + 2], S0[8 * s + 3]); a.z = pk2(S0[8 * s + 4], S0[8 * s + 5]); a.w = pk2(S0[8 * s + 6], S0[8 * s + 7]);
                c.x = pk2(S1[8 * s], S1[8 * s + 1]); c.y = pk2(S1[8 * s + 2], S1[8 * s + 3]); c.z = pk2(S1[8 * s + 4], S1[8 * s + 5]); c.w = pk2(S1[8 * s + 6], S1[8 * s + 7]);
                pf[0][s] = __builtin_bit_cast(bf16x8, a); pf[1][s] = __builtin_bit_cast(bf16x8, c);
            }
#pragma unroll
            for (int blk = 0; blk < 2; ++blk)
#pragma unroll
                for (int s = 0; s < 2; ++s) {
                    const int koff = (32 * blk + 16 * s + 4 * hh) * 2;
                    const s16x4 lo0 = *(const s16x4*)(vb_ + ql * VS + koff), hi0 = *(const s16x4*)(vb_ + ql * VS + koff + 16);
                    const s16x4 lo1 = *(const s16x4*)(vb_ + (32 + ql) * VS + koff), hi1 = *(const s16x4*)(vb_ + (32 + ql) * VS + koff + 16);
                    const bf16x8 v0 = __builtin_shufflevector(lo0, hi0, 0, 1, 2, 3, 4, 5, 6, 7), v1 = __builtin_shufflevector(lo1, hi1, 0, 1, 2, 3, 4, 5, 6, 7);
                    O0 = MFMA32(v0, pf[blk][s], O0); O1 = MFMA32(v1, pf[blk][s], O1);
                }
        }
        if (it + 1 < ntiles) store_tile(cur ^ 1, kt - 1);
        if (MODE == 1 && lane == 0) flags[(it & 1) * 8 + w] = wdone ? 1 : 0;
        __syncthreads();
        if (MODE == 1) { int alld = 1;
#pragma unroll
            for (int ww = 0; ww < 8; ++ww) alld &= flags[(it & 1) * 8 + ww];
            if (alld) break; }
    }
    if (wactive) {
        float inv = 1.0f;
        if (MODE == 0) { const float lt = lrun + __shfl_xor(lrun, 32); inv = 1.0f / lt; }
        bf16_t* op = P->o + (long)(qrow0 + w * 32 + ql) * 1024 + (MODE == 0 ? 0 : 512) + h * 64 + 4 * hh;
#pragma unroll
        for (int g = 0; g < 4; ++g) {
            f32x4 a = {O0[4 * g] * inv, O0[4 * g + 1] * inv, O0[4 * g + 2] * inv, O0[4 * g + 3] * inv};
            f32x4 c = {O1[4 * g] * inv, O1[4 * g + 1] * inv, O1[4 * g + 2] * inv, O1[4 * g + 3] * inv};
            store_bf4(op + 8 * g, a); store_bf4(op + 32 + 8 * g, c);
        }
    }
}

DI void attn_phase(KP P, char* lds, int cidx) {
    unsigned* slot = (unsigned*)(lds + 65536);
    for (;;) {
        if (threadIdx.x == 0) *slot = atomicAdd(P->ctr + cidx, 1u);
        __syncthreads();
        const unsigned idx = *slot;
        __syncthreads();
        if (idx >= 1152u) break;
        bool sample; int mode, b, h, ublk = 0;
        if (idx < 128u) { sample = true; mode = idx >> 6; b = (idx >> 3) & 7; h = idx & 7; }
        else { const int j = idx - 128; sample = false; ublk = 31 - (j >> 5); const int r = j & 31; mode = r >> 4; b = (r >> 3) & 1; h = r & 7; }
        if (mode == 0) attn_unit<0>(P, lds, sample, b, h, ublk); else attn_unit<1>(P, lds, sample, b, h, ublk);
    }
}

DI void phase0(KP P, char* lds) {
    const int tid = otid(), G = ogrid(), bid = obid(), w = tid >> 6, lane = tid & 63;
    for (int item = bid; item < 96; item += G) {
        float* sc = (float*)lds; float* red = (float*)(lds + 40960);
        for (int i = tid; i < 10240; i += NTHREADS) { const int bb = i >> 10, k = i & 1023; const float cv = bb < 2 ? P->c_p[bb * 1024 + k] : P->c_s[(bb - 2) * 1024 + k]; sc[i] = cv / (1.0f + __expf(-cv)); }
        __syncthreads();
        const int col = item * 64 + lane;
        float a0 = 0, a1 = 0, a2 = 0, a3 = 0, a4 = 0, a5 = 0, a6 = 0, a7 = 0, a8 = 0, a9 = 0;
        for (int k0 = w * 128; k0 < w * 128 + 128; k0 += 16) {
            float wv[16];
#pragma unroll
            for (int j = 0; j < 16; ++j) wv[j] = P->w_ada[(long)(k0 + j) * 6144 + col];
#pragma unroll
            for (int j = 0; j < 16; ++j) { const int k = k0 + j;
                a0 += sc[k] * wv[j]; a1 += sc[1024 + k] * wv[j]; a2 += sc[2048 + k] * wv[j]; a3 += sc[3072 + k] * wv[j]; a4 += sc[4096 + k] * wv[j];
                a5 += sc[5120 + k] * wv[j]; a6 += sc[6144 + k] * wv[j]; a7 += sc[7168 + k] * wv[j]; a8 += sc[8192 + k] * wv[j]; a9 += sc[9216 + k] * wv[j]; }
        }
        float* rr = red + w * 640 + lane;
        rr[0] = a0; rr[64] = a1; rr[128] = a2; rr[192] = a3; rr[256] = a4; rr[320] = a5; rr[384] = a6; rr[448] = a7; rr[512] = a8; rr[576] = a9;
        __syncthreads();
        for (int i = tid; i < 640; i += NTHREADS) { float s = 0.f; for (int ww = 0; ww < 8; ++ww) s += red[ww * 640 + i];
            const int bb = i >> 6, l = i & 63; P->ada[bb * 6144 + item * 64 + l] = s + P->b_ada[item * 64 + l]; }
        __syncthreads();
    }
    {
        float* tile = (float*)lds;
        for (int it = (bid + 96) % G; it < P->ntj_tiles; it += G) {
            int j = 0;
#pragma unroll 1
            for (int q = 1; q < P->pad0; ++q) if (it >= P->tj[q].tile0) j = q;
            TJob J; J.src = P->tj[j].src; J.kscale = P->tj[j].kscale; J.dst = P->tj[j].dst; J.lds = P->tj[j].lds; J.coff = P->tj[j].coff; J.ldd = P->tj[j].ldd;
            J.Klen = P->tj[j].Klen; J.Nlen = P->tj[j].Nlen; J.zero = P->tj[j].zero; J.tile0 = P->tj[j].tile0;
            const int lt = it - J.tile0, nk = J.Klen >> 6, tk = lt % nk, tn = lt / nk, k0 = tk * 64, n0 = tn * 256;
            f32x4 lv[8];
#pragma unroll
            for (int r = 0; r < 8; ++r) { const int e = tid + r * NTHREADS, kk = e >> 6, n4 = (e & 63) * 4;
                lv[r] = (f32x4){0.f, 0.f, 0.f, 0.f};
                if (J.zero == 2) { const int nn_ = n0 + n4, sc_ = (nn_ >> 8) * 128 + (nn_ & 127) + ((nn_ >> 7) & 1) * DFF;
                    lv[r] = *(const f32x4*)(J.src + (long)(k0 + kk) * J.lds + sc_); }
                else if (!J.zero && n0 + n4 < J.Nlen) lv[r] = *(const f32x4*)(J.src + (long)(k0 + kk) * J.lds + J.coff + n0 + n4); }
#pragma unroll
            for (int r = 0; r < 8; ++r) { const int e = tid + r * NTHREADS, kk = e >> 6, n4 = (e & 63) * 4;
                f32x4 v = lv[r]; if (J.kscale) v *= J.kscale[k0 + kk];
                float* tp = tile + kk * 257 + n4; tp[0] = v[0]; tp[1] = v[1]; tp[2] = v[2]; tp[3] = v[3]; }
            __syncthreads();
#pragma unroll
            for (int r = 0; r < 4; ++r) { const int e = tid + r * NTHREADS, nn = e >> 3, kc = (e & 7) * 8;
                if (n0 + nn < J.Nlen) { const float* tp = tile + kc * 257 + nn; u32x4 o;
                    o.x = pk2(tp[0], tp[257]); o.y = pk2(tp[2 * 257], tp[3 * 257]); o.z = pk2(tp[4 * 257], tp[5 * 257]); o.w = pk2(tp[6 * 257], tp[7 * 257]);
                    *(u32x4*)(J.dst + (long)(n0 + nn) * J.ldd + k0 + kc) = o; } }
            __syncthreads();
        }
    }
    const long gt = (long)bid * NTHREADS + tid, gn = (long)G * NTHREADS;
    for (long i0 = gt; i0 < 8L * PAST * 64; i0 += 4 * gn) { f32x4 v[4];
#pragma unroll
        for (int r = 0; r < 4; ++r) { const long i = i0 + r * gn; if (i < 8L * PAST * 64) v[r] = *(const f32x4*)(P->c_ckv + i * 4); }
#pragma unroll
        for (int r = 0; r < 4; ++r) { const long i = i0 + r * gn; if (i < 8L * PAST * 64) { const long row = i >> 6; const int c = (int)(i & 63) * 4; const int bb = (int)(row >> 12), sq = (int)(row & 4095);
            store_bf4(P->latent + (long)(MP + bb * SKEYS + sq) * 256 + c, v[r]); } } }
    for (long i0 = gt; i0 < 8L * PAST * 8; i0 += 4 * gn) { f32x4 v[4];
#pragma unroll
        for (int r = 0; r < 4; ++r) { const long i = i0 + r * gn; if (i < 8L * PAST * 8) v[r] = *(const f32x4*)(P->c_kr + i * 4); }
#pragma unroll
        for (int r = 0; r < 4; ++r) { const long i = i0 + r * gn; if (i < 8L * PAST * 8) { const long row = i >> 3; const int c = (int)(i & 7) * 4; const int bb = (int)(row >> 12), sq = (int)(row & 4095);
            store_bf4(P->krope + (long)(MP + bb * SKEYS + sq) * 32 + c, v[r]); } } }
    for (long i = gt; i < 8L * 512 * 8; i += gn) { const long r = i >> 3; const int c = (int)(i & 7) * 4; const u32x2 z = {0u, 0u};
        *(u32x2*)(P->vaT_s + r * SKP + SKEYS + c) = z; *(u32x2*)(P->vbT_s + r * SKP + SKEYS + c) = z; }
    for (long i = gt; i < (long)TP * 16; i += gn) { const int pos = (int)(i >> 4), fi = (int)(i & 15);
        const float inv = exp2f(-(float)fi * (13.287712379549449f / 16.0f));
        const float ang = (float)pos * inv;
        const double rev = (double)ang * 0.15915494309189535; const float fr_ = (float)(rev - floor(rev));
        P->ropeT[i * 2] = __builtin_amdgcn_cosf(fr_); P->ropeT[i * 2 + 1] = __builtin_amdgcn_sinf(fr_); }
}

DI void phase_h(KP P) {
    const int tid_ = otid(), lane = tid_ & 63, gw = obid() * 8 + (tid_ >> 6), nw = ogrid() * 8;
    for (int row = gw; row < MT; row += nw) {
        const float* xr = row < MP ? P->x_p + (long)row * DM : P->x_s + (long)(row - MP) * DM;
        const float* ad = P->ada + ada_b(row) * 6144;
        f32x4 v[4]; float s = 0.f;
#pragma unroll
        for (int i = 0; i < 4; ++i) { v[i] = *(const f32x4*)(xr + i * 256 + lane * 4); s += v[i][0] * v[i][0] + v[i][1] * v[i][1] + v[i][2] * v[i][2] + v[i][3] * v[i][3]; }
#pragma unroll
        for (int o = 1; o < 64; o <<= 1) s += __shfl_xor(s, o);
        const float rstd = rsqrtf(s * (1.0f / DM) + EPS);
#pragma unroll
        for (int i = 0; i < 4; ++i) { const int c = i * 256 + lane * 4;
            const f32x4 g = *(const f32x4*)(P->g_pre_mix + c), sh = *(const f32x4*)(ad + c), scl = *(const f32x4*)(ad + 1024 + c);
            store_bf4(P->h + (long)row * DM + c, v[i] * rstd * g * (1.0f + scl) + sh); }
    }
}

DI void phase_mid(KP P) {
    const int tid_ = otid(), lane = tid_ & 63, gw = obid() * 8 + (tid_ >> 6), nw = ogrid() * 8;
    for (int row = gw; row < MT; row += nw) {
        const float* xr = row < MP ? P->x_p + (long)row * DM : P->x_s + (long)(row - MP) * DM;
        const float* ad = P->ada + ada_b(row) * 6144;
        f32x4 mv[4]; float s = 0.f;
#pragma unroll
        for (int i = 0; i < 4; ++i) { const u32x2 wv = *(const u32x2*)(P->m2 + (long)row * DM + i * 256 + lane * 4);
            mv[i] = (f32x4){bf_lo(wv.x), bf_hi(wv.x), bf_lo(wv.y), bf_hi(wv.y)}; s += mv[i][0] * mv[i][0] + mv[i][1] * mv[i][1] + mv[i][2] * mv[i][2] + mv[i][3] * mv[i][3]; }
#pragma unroll
        for (int o = 1; o < 64; o <<= 1) s += __shfl_xor(s, o);
        const float rstd = rsqrtf(s * (1.0f / DM) + EPS);
        float s2 = 0.f;
#pragma unroll
        for (int i = 0; i < 4; ++i) { const int c = i * 256 + lane * 4;
            const f32x4 xv = *(const f32x4*)(xr + c), g = *(const f32x4*)(P->g_post_mix + c), gt = *(const f32x4*)(ad + 2048 + c);
            mv[i] = xv + gt * (mv[i] * rstd * g);
            *(f32x4*)(P->out + O_Y + (long)row * DM + c) = mv[i];
            s2 += mv[i][0] * mv[i][0] + mv[i][1] * mv[i][1] + mv[i][2] * mv[i][2] + mv[i][3] * mv[i][3]; }
#pragma unroll
        for (int o = 1; o < 64; o <<= 1) s2 += __shfl_xor(s2, o);
        const float rstd2 = rsqrtf(s2 * (1.0f / DM) + EPS);
#pragma unroll
        for (int i = 0; i < 4; ++i) { const int c = i * 256 + lane * 4;
            const f32x4 g = *(const f32x4*)(P->g_pre_ffn + c), sh = *(const f32x4*)(ad + 3072 + c), scl = *(const f32x4*)(ad + 4096 + c);
            store_bf4(P->h2 + (long)row * DM + c, mv[i] * rstd2 * g * (1.0f + scl) + sh); }
    }
}

DI void phase_final(KP P) {
    const int tid_ = otid(), lane = tid_ & 63, gw = obid() * 8 + (tid_ >> 6), nw = ogrid() * 8;
    for (int row = gw; row < MT; row += nw) {
        const float* ad = P->ada + ada_b(row) * 6144;
        f32x4 fv[4]; float s = 0.f;
#pragma unroll
        for (int i = 0; i < 4; ++i) { const u32x2 wv = *(const u32x2*)(P->f + (long)row * DM + i * 256 + lane * 4);
            fv[i] = (f32x4){bf_lo(wv.x), bf_hi(wv.x), bf_lo(wv.y), bf_hi(wv.y)}; s += fv[i][0] * fv[i][0] + fv[i][1] * fv[i][1] + fv[i][2] * fv[i][2] + fv[i][3] * fv[i][3]; }
#pragma unroll
        for (int o = 1; o < 64; o <<= 1) s += __shfl_xor(s, o);
        const float rstd = rsqrtf(s * (1.0f / DM) + EPS);
#pragma unroll
        for (int i = 0; i < 4; ++i) { const int c = i * 256 + lane * 4; float* yp = P->out + O_Y + (long)row * DM + c;
            const f32x4 xv = *(const f32x4*)yp, g = *(const f32x4*)(P->g_post_ffn + c), gt = *(const f32x4*)(ad + 5120 + c);
            *(f32x4*)yp = xv + gt * (fv[i] * rstd * g); }
    }
}


DI void load8(const bf16_t* p, float (&o)[8]) { const u32x4 w = *(const u32x4*)p;
#pragma unroll
    for (int e = 0; e < 4; ++e) { o[2 * e] = bf_lo(w[e]); o[2 * e + 1] = bf_hi(w[e]); } }
DI void phase_convfix(KP P) {
    const long gt = (long)obid() * NTHREADS + otid(), gn = (long)ogrid() * NTHREADS;
    for (long i = gt; i < 768L * 352; i += gn) {
        const int ri = (int)(i / 352), c = (int)(i % 352) * 8;
        float u0[2][8], u1[2][8], u2[2][8];
        long grow;
        if (ri < 512) {
            const int B = ri >> 1, rsel = ri & 1; const bool first = ((B * 64) & (TP - 1)) == 0; grow = (long)B * 64 + rsel;
            const bf16_t* cur = P->ub + (long)(B * 4) * DFF2 + c; const bf16_t* prv = P->ub + (long)((B > 0 ? B - 1 : 0) * 4) * DFF2 + c;
#pragma unroll
            for (int hf = 0; hf < 2; ++hf) {
                load8(cur + (long)(2 + rsel) * DFF2 + hf * DFF, u2[hf]);
                if (rsel == 0) { if (first) { for (int e = 0; e < 8; ++e) { u1[hf][e] = 0.f; u0[hf][e] = 0.f; } } else { load8(prv + (long)1 * DFF2 + hf * DFF, u1[hf]); load8(prv + hf * DFF, u0[hf]); } }
                else { load8(cur + (long)2 * DFF2 + hf * DFF, u1[hf]); if (first) { for (int e = 0; e < 8; ++e) u0[hf][e] = 0.f; } else load8(prv + (long)1 * DFF2 + hf * DFF, u0[hf]); }
            }
        } else {
            const int r = ri - 512, t = r & 31, bs = r >> 5; grow = (long)MP + r;
            const float* st = P->c_conv + (long)bs * 2 * DFF2 + c;
#pragma unroll
            for (int hf = 0; hf < 2; ++hf) {
                load8(P->u + (long)r * DFF2 + hf * DFF + c, u2[hf]);
                if (t >= 1) load8(P->u + (long)(r - 1) * DFF2 + hf * DFF + c, u1[hf]); else { for (int e = 0; e < 8; ++e) u1[hf][e] = st[DFF2 + hf * DFF + e]; }
                if (t >= 2) load8(P->u + (long)(r - 2) * DFF2 + hf * DFF + c, u0[hf]); else { for (int e = 0; e < 8; ++e) u0[hf][e] = st[(long)t * DFF2 + hf * DFF + e]; }
            }
        }
        float y[2][8];
#pragma unroll
        for (int hf = 0; hf < 2; ++hf)
#pragma unroll
            for (int e = 0; e < 8; ++e) { const int cc = hf * DFF + c + e;
                y[hf][e] = P->conv_b[cc] + P->conv_w[cc] * u0[hf][e] + P->conv_w[DFF2 + cc] * u1[hf][e] + P->conv_w[2 * DFF2 + cc] * u2[hf][e]; }
        u32x4 ov;
#pragma unroll
        for (int e = 0; e < 4; ++e) ov[e] = pk2(gelu_tanh(y[0][2 * e]) * y[1][2 * e], gelu_tanh(y[0][2 * e + 1]) * y[1][2 * e + 1]);
        *(u32x4*)(P->g + grow * DFF + c) = ov;
    }
}

#define XB_TMO      128
#define XB_XCNT(j)  (256  + 64 * (j))
#define XB_XSUB(j)  (1280 + 64 * (j))
#define XB_XGEN(j)  (2304 + 64 * (j))
#define XB_TOP      3328
#define XB_TOPGEN   3392
#define XCD_BAR_WORDS 3456
#define XB_SPIN_CAP (1u << 18)
DI unsigned xb_ld(unsigned* p)              { return __hip_atomic_load(p, __ATOMIC_RELAXED, __HIP_MEMORY_SCOPE_AGENT); }
DI unsigned xb_add(unsigned* p, unsigned v) { return __hip_atomic_fetch_add(p, v, __ATOMIC_RELAXED, __HIP_MEMORY_SCOPE_AGENT); }
DI unsigned xb_xcc_id() { return (unsigned)__builtin_amdgcn_s_getreg((3 << 11) | 20) & 0xFu; }
#define XB_SPIN(cond, bar) do { unsigned _sp = 0; while (cond) { __builtin_amdgcn_s_sleep(1); \
    if ((++_sp & 255u) == 0u) { if (xb_ld(&(bar)[XB_TMO])) break; if (_sp > XB_SPIN_CAP) { atomicAdd(&(bar)[XB_TMO], 1u); break; } } } } while (0)
DI void xcd_barrier_complete(unsigned* bar, unsigned x, unsigned& nloc, unsigned& nx) {
    const unsigned G = gridDim.x;
    unsigned sum, cnt, mine, sp = 0u;
    for (;;) {
        sum = 0u; cnt = 0u; mine = 0u;
#pragma unroll
        for (unsigned j = 0; j < 16; ++j) { const unsigned c = xb_ld(&bar[XB_XCNT(j)]); sum += c; cnt += (c > 0u) ? 1u : 0u; mine = (j == x) ? c : mine; }
        if (sum == G) break;
        __builtin_amdgcn_s_sleep(1);
        if ((++sp & 255u) == 0u) { if (xb_ld(&bar[XB_TMO])) break; if (sp > XB_SPIN_CAP) { atomicAdd(&bar[XB_TMO], 1u); break; } }
    }
    nloc = mine > 0u ? mine : 1u; nx = cnt > 0u ? cnt : 1u;
}
DI void grid_barrier(char* lds) {
    asm volatile("s_waitcnt vmcnt(0)" ::: "memory");
    __syncthreads();
    if (threadIdx.x == 0) {
        unsigned* bar = kparams()->bar; const unsigned x = xb_xcc_id();
        volatile LAS unsigned* st = (volatile LAS unsigned*)(lds + 131072 + 2048);
        __builtin_amdgcn_s_waitcnt(0);
        unsigned nloc = st[0], nx = st[1];
        if (nloc == 0u) { xcd_barrier_complete(bar, x, nloc, nx); st[0] = nloc; st[1] = nx; }
        const unsigned old = xb_add(&bar[XB_XSUB(x)], 1u);
        const unsigned gen = old / nloc;
        if (old + 1u == (gen + 1u) * nloc) {
            __builtin_amdgcn_fence(__ATOMIC_RELEASE, "agent");
            asm volatile("s_waitcnt vmcnt(0)" ::: "memory");
            const unsigned og = xb_add(&bar[XB_TOP], 1u);
            const unsigned tg = og / nx;
            if (og + 1u == (tg + 1u) * nx) xb_add(&bar[XB_TOPGEN], 1u);
            else XB_SPIN(xb_ld(&bar[XB_TOPGEN]) == tg, bar);
            __builtin_amdgcn_fence(__ATOMIC_ACQUIRE, "agent");
            xb_add(&bar[XB_XGEN(x)], 1u);
            asm volatile("s_waitcnt vmcnt(0)" ::: "memory");
        } else {
            XB_SPIN(xb_ld(&bar[XB_XGEN(x)]) == gen, bar);
            __builtin_amdgcn_fence(__ATOMIC_ACQUIRE, "agent");
            asm volatile("s_waitcnt vmcnt(0)" ::: "memory");
        }
    }
    __syncthreads();
}

__global__ void __launch_bounds__(NTHREADS) fwd_megakernel(Params Pval) {
    extern __shared__ __attribute__((aligned(16))) char lds[];
    cg::grid_group grid = cg::this_grid();
    const int lo = kparams()->phase_lo, hi = kparams()->phase_hi;
#define PH(n) if (lo <= (n) && (n) < hi)
#define SYNC(n) if (lo <= (n) && (n) + 1 < hi) grid_barrier(lds)
    if (hi > 1000) grid.sync();
    { volatile LAS unsigned* st = (volatile LAS unsigned*)(lds + 131072 + 2048);
      if (threadIdx.x == 0) { st[0] = 0u; st[1] = 0u; }
      __syncthreads();
      if (threadIdx.x == 0) (void)xb_add(&kparams()->bar[XB_XCNT(xb_xcc_id())], 1u); }
    PH(0) phase0(kparams(), lds);
#ifdef PROBE_P0
    __syncthreads(); phase0(kparams(), lds);
#endif
#ifdef PROBE_SYNC
    for (int i = 0; i < 24; ++i) grid_barrier(lds);
#endif
    SYNC(0);
    PH(1) phase_h(kparams());
#ifdef PROBE_ROWS
    phase_h(kparams());
#endif
    SYNC(1);
    for (int ph = 2; ph <= 12; ++ph) {
        if (ph == 4) { PH(4) attn_phase(kparams(), lds, 0);
#ifdef PROBE_ATTN2
            __syncthreads(); attn_phase(kparams(), lds, 1);
#endif
            SYNC(4); continue; }
        if (ph == 8) { PH(8) phase_mid(kparams());
#ifdef PROBE_ROWS
            phase_mid(kparams());
#endif
            SYNC(8); continue; }
        if (ph == 10) { PH(10) phase_convfix(kparams());

            SYNC(10); continue; }
        if (ph == 12) { PH(12) phase_final(kparams()); continue; }
        if (lo <= ph && ph < hi) {
            const int npass = (ph == 3 || ph == 6) ? 2 : 1;
            for (int pass = 0; pass < npass; ++pass) {
                GemmDesc d; d.C = nullptr; d.ldc = 0; d.start = 0; KP P = kparams();
                switch (ph) {
                case 2: d.A = P->h; d.lda = DM; d.Bt = P->WinT; d.ldb = DM; d.K = DM; d.nM = 65; d.nN = 9; d.epi = E_INPROJ; break;
                case 3: if (pass == 0) { d.A = P->qlat; d.lda = 384; d.Bt = P->WuqT; d.ldb = 384; d.K = 384; d.nM = 65; d.nN = 3; d.epi = E_UQ; }
                        else { d.A = P->latent; d.lda = 256; d.Bt = P->WukvT; d.ldb = 256; d.K = 256; d.nM = 193; d.nN = 4; d.epi = E_UKV; d.start = 195; } break;
                case 5: d.A = P->h; d.lda = DM; d.Bt = P->WgT; d.ldb = DM; d.K = DM; d.nM = 64; d.nN = 8; d.epi = E_GATE; break;
                case 6: d.A = P->o + pass * 512; d.lda = DM; d.Bt = pass ? P->WpbT : P->WpaT; d.ldb = 512; d.K = 512; d.nM = 64; d.nN = 4; d.epi = pass ? E_PROJB : E_PROJA; break;
                case 7: d.A = P->merged; d.lda = DM; d.Bt = P->WoutT; d.ldb = DM; d.K = DM; d.nM = 64; d.nN = 4; d.epi = E_PLAIN; d.C = P->m2; d.ldc = DM; break;
                case 9: d.A = P->h2; d.lda = DM; d.Bt = P->WupT; d.ldb = DM; d.K = DM; d.nM = 65; d.nN = 22; d.epi = E_UP; break;
                default: d.A = P->g; d.lda = DFF; d.Bt = P->WdownT; d.ldb = DFF; d.K = DFF; d.nM = 64; d.nN = 4; d.epi = E_PLAIN; d.C = P->f; d.ldc = DM; break;
                }
                gemm_run(d, lds);
#ifdef PROBE_GEMM2
                if (ph == PROBE_GEMM2 && !(ph == 6 && pass == 0)) { __syncthreads(); if (ph == 6) { GemmDesc d0 = d; d0.A = P->o; d0.Bt = P->WpaT; d0.epi = E_PROJA; gemm_run(d0, lds); } gemm_run(d, lds); }
#endif
            }
        }
        if (lo <= ph && ph < hi) {
            KP P = kparams();
            if (ph == 5) gemm_small<1, 8>(P, P->h, DM, P->WgT, DM, 2048, P->gates, 2048, lds);
            else if (ph == 6) gemm_small<2, 4>(P, P->o, DM, P->WpaT, 512, 1024, P->merged, DM, lds);
            else if (ph == 7) gemm_small<0, 8>(P, P->merged, DM, P->WoutT, DM, 1024, P->m2, DM, lds);
            else if (ph == 11) gemm_small<0, 22>(P, P->g, DFF, P->WdownT, DFF, 1024, P->f, DM, lds);
#ifdef PROBE_SMALL
            if (ph == 5) gemm_small<1, 8>(P, P->h, DM, P->WgT, DM, 2048, P->gates, 2048, lds);
            else if (ph == 6) gemm_small<2, 4>(P, P->o, DM, P->WpaT, 512, 1024, P->merged, DM, lds);
            else if (ph == 7) gemm_small<0, 8>(P, P->merged, DM, P->WoutT, DM, 1024, P->m2, DM, lds);
            else if (ph == 11) gemm_small<0, 22>(P, P->g, DFF, P->WdownT, DFF, 1024, P->f, DM, lds);
#endif
        }
        SYNC(ph);
    }
}

static size_t bump(size_t& off, size_t bytes) { size_t r = off; off += (bytes + 255) & ~(size_t)255; return r; }

extern "C" void kernel_launch(void* const* d_in, const int* in_sizes, int n_in, void* d_out, int out_size, void* d_ws, size_t ws_size, hipStream_t stream) {
    Params P; memset(&P, 0, sizeof(P));
    const float* const* in = (const float* const*)d_in;
    P.x_p = in[0]; P.x_s = in[1]; P.c_ckv = in[2]; P.c_kr = in[3]; P.c_sbk = in[4]; P.c_sbv = in[5]; P.c_conv = in[6]; P.c_p = in[7]; P.c_s = in[8];
    P.w_ada = in[9]; P.b_ada = in[10]; P.g_pre_mix = in[11]; P.g_post_mix = in[12]; P.g_pre_ffn = in[13]; P.g_post_ffn = in[14];
    const float* w_in = in[15]; const float* g_q = in[16]; const float* w_uq = in[17]; P.g_kv = in[18]; const float* w_uk = in[19]; const float* w_uv = in[20];
    const float* w_pa = in[21]; const float* w_pb = in[22]; const float* w_out = in[23]; const float* w_up = in[24]; P.conv_w = in[25]; P.conv_b = in[26]; const float* w_down = in[27];
    P.out = (float*)d_out;
    char* ws = (char*)d_ws; size_t off = 0;
    P.WupT = (bf16_t*)(ws + bump(off, (size_t)DFF2 * DM * 2));
    P.WdownT = (bf16_t*)(ws + bump(off, (size_t)DM * DFF * 2));
    P.ropeT = (float*)(ws + bump(off, (size_t)TP * 32 * 4));
    P.ada = (float*)(ws + bump(off, 10 * 6144 * 4));
    P.ctr = (unsigned*)(ws + bump(off, 256));
    P.bar = (unsigned*)(ws + bump(off, XCD_BAR_WORDS * 4));
    const size_t R0 = off;
    P.WinT = (bf16_t*)(ws + bump(off, (size_t)2304 * DM * 2));
    P.WgT = (bf16_t*)(ws + bump(off, (size_t)2048 * DM * 2));
    P.WuqT = (bf16_t*)(ws + bump(off, (size_t)768 * 384 * 2));
    P.WukvT = (bf16_t*)(ws + bump(off, (size_t)1024 * 256 * 2));
    P.WpaT = (bf16_t*)(ws + bump(off, (size_t)1024 * 512 * 2));
    P.WpbT = (bf16_t*)(ws + bump(off, (size_t)1024 * 512 * 2));
    P.WoutT = (bf16_t*)(ws + bump(off, (size_t)1024 * 1024 * 2));
    const size_t o_kva = off;
    P.kva = (bf16_t*)(ws + bump(off, (size_t)KVROWS_PAD * 512 * 2));
    P.vaT_p = (bf16_t*)(ws + bump(off, (size_t)2 * 512 * TP * 2));
    P.vaT_s = (bf16_t*)(ws + bump(off, (size_t)8 * 512 * SKP * 2));
    const size_t o_kb = off;
    P.kb = (bf16_t*)(ws + bump(off, (size_t)KVROWS_PAD * 512 * 2));
    const size_t o_vbT = off;
    P.vbT_p = (bf16_t*)(ws + bump(off, (size_t)2 * 512 * TP * 2));
    P.vbT_s = (bf16_t*)(ws + bump(off, (size_t)8 * 512 * SKP * 2));
    const size_t o_kr = off;
    P.krope = (bf16_t*)(ws + bump(off, (size_t)KVROWS_PAD * 32 * 2));
    P.qb = (bf16_t*)(ws + bump(off, (size_t)MT * 512 * 2));
    P.q = (bf16_t*)(ws + bump(off, (size_t)MT * 768 * 2));
    P.latent = (bf16_t*)(ws + bump(off, (size_t)KVROWS_PAD * 256 * 2));
    size_t need = off;
    P.gates = (bf16_t*)(ws + o_kva);
    P.merged = (bf16_t*)(ws + o_kb);
    P.m2 = (bf16_t*)(ws + o_vbT);
    const size_t o_g = R0 + (size_t)MT * DFF2 * 2;
    P.g = (bf16_t*)(ws + R0);
    P.f = (bf16_t*)(ws + R0 + (size_t)100 * 1024 * 1024);
    P.ub = (bf16_t*)(ws + R0 + (size_t)140 * 1024 * 1024);
    P.u = (bf16_t*)(ws + R0 + (size_t)155 * 1024 * 1024);
    size_t o_h2 = o_kr > o_g ? o_kr : o_g;
    P.h2 = (bf16_t*)(ws + o_h2);
    if (o_h2 + (size_t)MT * DM * 2 > need) need = o_h2 + (size_t)MT * DM * 2;
    P.h = (bf16_t*)d_out;
    P.o = (bf16_t*)d_out + (size_t)MT * DM;
    P.qlat = P.o;
    if (need > ws_size) { fprintf(stderr, "workspace too small: need %zu have %zu\n", need, ws_size); return; }

    int nj = 0, tiles = 0;
    auto job = [&](const float* src, int lds, int coff, bf16_t* dst, int ldd, int Klen, int Nlen, const float* ks, int zero) {
        TJob& J = P.tj[nj++]; J.src = src; J.kscale = ks; J.dst = dst; J.lds = lds; J.coff = coff; J.ldd = ldd; J.Klen = Klen; J.Nlen = Nlen; J.zero = zero; J.tile0 = tiles; J.pad = 0;
        tiles += (Klen / 64) * ((Nlen + 255) / 256); };
    job(w_up, DFF2, 0, P.WupT, DM, DM, DFF2, nullptr, 2);
    job(w_down, DM, 0, P.WdownT, DFF, DFF, DM, nullptr, 0);
    job(w_in, 4256, 0, P.WinT, DM, DM, 384, nullptr, 0);
    job(w_in, 4256, 640, P.WinT + (size_t)384 * DM, DM, DM, 32, nullptr, 0);
    job(w_in, 4256, 0, P.WinT + (size_t)416 * DM, DM, DM, 96, nullptr, 1);
    job(w_in, 4256, 384, P.WinT + (size_t)512 * DM, DM, DM, 256, nullptr, 0);
    job(w_in, 4256, 672, P.WinT + (size_t)768 * DM, DM, DM, 1536, nullptr, 0);
    job(w_in, 4256, 2208, P.WgT, DM, DM, 2048, nullptr, 0);
    job(w_uq, 768, 0, P.WuqT, 384, 384, 768, g_q, 0);
    job(w_uk, 512, 0, P.WukvT, 256, 256, 512, nullptr, 0);
    job(w_uv, 512, 0, P.WukvT + (size_t)512 * 256, 256, 256, 512, nullptr, 0);
    job(w_pa, DM, 0, P.WpaT, 512, 512, DM, nullptr, 0);
    job(w_pb, DM, 0, P.WpbT, 512, 512, DM, nullptr, 0);
    job(w_out, DM, 0, P.WoutT, DM, DM, DM, nullptr, 0);
    P.ntj_tiles = tiles; P.pad0 = nj;
    P.phase_lo = 0; P.phase_hi = 13;

    static int grid_blocks = 0;
    if (!grid_blocks) {
        (void)hipFuncSetAttribute((const void*)fwd_megakernel, hipFuncAttributeMaxDynamicSharedMemorySize, LDS_BYTES);
        int dev = 0, cus = 0, per_cu = 0;
        (void)hipGetDevice(&dev);
        (void)hipDeviceGetAttribute(&cus, hipDeviceAttributeMultiprocessorCount, dev);
        (void)hipOccupancyMaxActiveBlocksPerMultiprocessor(&per_cu, fwd_megakernel, NTHREADS, LDS_BYTES);
        if (per_cu > 1) per_cu = 1;
        grid_blocks = cus * per_cu;
    }
    (void)hipMemsetAsync(P.ctr, 0, 256 + XCD_BAR_WORDS * 4, stream);
    void* args[] = {&P};
    hipError_t e = hipLaunchCooperativeKernel((const void*)fwd_megakernel, dim3(grid_blocks), dim3(NTHREADS), args, LDS_BYTES, stream);
    if (e != hipSuccess) fprintf(stderr, "cooperative launch failed: %s (grid %d)\n", hipGetErrorString(e), grid_blocks);
}
```

```cpp
#include <hip/hip_runtime.h>
#include <hip/hip_cooperative_groups.h>
#include <stdint.h>
#include <stdio.h>
#include <string.h>
namespace cg = cooperative_groups;

typedef unsigned short bf16_t;
typedef short bf16x8 __attribute__((ext_vector_type(8)));
typedef short s16x4 __attribute__((ext_vector_type(4)));
typedef float f32x2 __attribute__((ext_vector_type(2)));
typedef float f32x4 __attribute__((ext_vector_type(4)));
typedef float f32x16 __attribute__((ext_vector_type(16)));
typedef unsigned u32x2 __attribute__((ext_vector_type(2)));
typedef unsigned u32x4 __attribute__((ext_vector_type(4)));
typedef __bf16 bf2_t __attribute__((ext_vector_type(2)));
#define DI __device__ __forceinline__

constexpr int DM = 1024, TP = 8192, MP = 16384, MS = 256, MT = 16640, PAST = 4096, SKEYS = 4128, SKP = 4160;
constexpr int KVROWS = MP + 8 * SKEYS;
constexpr int KVROWS_PAD = KVROWS + 64;
constexpr int DFF = 2816, DFF2 = 5632;
constexpr float EPS = 1e-6f;
constexpr float LOG2E = 1.4426950408889634f, LN2 = 0.6931471805599453f;
constexpr int NTHREADS = 512;
constexpr int LDS_BYTES = 131072 + 8192;
constexpr long O_Y = 0, O_CKV_P = 17039360, O_KR_P = 21233664, O_SBK_P = 21757952, O_SBV_P = 30146560, O_CONV_P = 38535168,
               O_CKV_S = 38557696, O_KR_S = 38623232, O_SBK_S = 38631424, O_SBV_S = 38762496, O_CONV_S = 38893568;

struct TJob { const float* src; const float* kscale; bf16_t* dst; int lds, coff, ldd, Klen, Nlen, zero, tile0, pad; };
constexpr int NTJ = 22;

struct Params {
    const float *x_p, *x_s, *c_ckv, *c_kr, *c_sbk, *c_sbv, *c_conv, *c_p, *c_s;
    const float *w_ada, *b_ada, *g_pre_mix, *g_post_mix, *g_pre_ffn, *g_post_ffn, *g_kv, *conv_w, *conv_b;
    float* out;
    bf16_t *WupT, *WdownT, *WinT, *WgT, *WuqT, *WukvT, *WpaT, *WpbT, *WoutT;
    float* ropeT; float* ada; unsigned* ctr; unsigned* bar;
    bf16_t *h, *o, *qlat, *latent, *krope, *kb, *vbT_p, *vbT_s, *qb, *q, *kva, *vaT_p, *vaT_s, *gates, *merged, *m2, *h2, *u, *g, *f, *ub;
    TJob tj[NTJ]; int ntj_tiles; int phase_lo, phase_hi, pad0;
};

#define LAS __attribute__((address_space(3)))
typedef const Params __attribute__((address_space(4))) * KP;
DI KP kparams() { KP p = (KP)__builtin_amdgcn_kernarg_segment_ptr(); asm volatile("" : "+s"(p)); return p; }
DI int otid() { int t = threadIdx.x; asm volatile("" : "+v"(t)); return t; }
DI int obid() { int b = blockIdx.x; asm volatile("" : "+s"(b)); return b; }
DI int ogrid() { int g = gridDim.x; asm volatile("" : "+s"(g)); return g; }
DI unsigned pk2(float a, float b) { f32x2 f = {a, b}; bf2_t r = __builtin_convertvector(f, bf2_t); return __builtin_bit_cast(unsigned, r); }
DI float bf_lo(unsigned u) { return __uint_as_float(u << 16); }
DI float bf_hi(unsigned u) { return __uint_as_float(u & 0xffff0000u); }
DI int kvrow_of(int row) { if (row < MP) return row; const int r = row - MP; return MP + (r >> 5) * SKEYS + PAST + (r & 31); }
DI int pos_of(int row) { return row < MP ? (row & (TP - 1)) : PAST + ((row - MP) & 31); }
DI int ada_b(int row) { return row < MP ? (row >> 13) : 2 + ((row - MP) >> 5); }
DI float sigmoidf_(float x) { return __builtin_amdgcn_rcpf(1.0f + __builtin_amdgcn_exp2f(-1.4426950408889634f * x)); }

constexpr int BM = 256, BK = 64, HALF = 128, HT = HALF * BK;
DI int lds_byte(int r, int c) { int st = (r >> 4) * 2 + (c >> 5), rr = r & 15, cc = c & 31, ob = rr * 64 + cc * 2; return st * 1024 + (ob ^ (((ob >> 9) & 1) << 5)); }
DI void stage_rc(int b, int& R, int& C) { int st = b / 1024, sb = b % 1024, swz = sb ^ (((sb >> 9) & 1) << 5); R = (st >> 1) * 16 + swz / 64; C = (st & 1) * 32 + (swz % 64) / 2; }

enum { E_INPROJ = 0, E_GATE, E_UQ, E_UKV, E_PROJA, E_PROJB, E_PLAIN, E_UP };
struct GemmDesc { const bf16_t* A; const bf16_t* Bt; bf16_t* C; int lda, ldb, ldc, K, nM, nN, epi, start; };

constexpr int HTB = HT * 2;
#define SA(b, h) (((b) * 2 + (h)) * HTB)
#define SB(b, h) ((4 + (b) * 2 + (h)) * HTB)
#define STAGE(bufoff, gbase, voff) do { _Pragma("unroll") for (int _i = 0; _i < 2; ++_i) \
    __builtin_amdgcn_global_load_lds((const unsigned*)((const char*)(gbase) + (voff)[_i]), (LAS unsigned*)(ldsl + (bufoff) + ldsw + _i * 8192), 16, 0, 0); } while (0)
#define LDA(dst, b, h) do { _Pragma("unroll") for (int m = 0; m < 4; ++m) _Pragma("unroll") for (int k = 0; k < 2; ++k) dst[m][k] = *(const LAS bf16x8*)(ldsl + SA(b, h) + aoff + m * 2048 + k * 1024); } while (0)
#define LDB(dst, b, h) do { _Pragma("unroll") for (int n = 0; n < 2; ++n) _Pragma("unroll") for (int k = 0; k < 2; ++k) dst[n][k] = *(const LAS bf16x8*)(ldsl + SB(b, h) + boff + n * 2048 + k * 1024); } while (0)
#define MMA(ai, bj, At, Bt_) do { __builtin_amdgcn_s_setprio(1); _Pragma("unroll") for (int m = 0; m < 4; ++m) _Pragma("unroll") for (int n = 0; n < 2; ++n) _Pragma("unroll") for (int k = 0; k < 2; ++k) \
      acc[ai][bj][m][n] = __builtin_amdgcn_mfma_f32_16x16x32_bf16(Bt_[n][k], At[m][k], acc[ai][bj][m][n], 0, 0, 0); \
    __builtin_amdgcn_s_setprio(0); } while (0)
#define WAIT_V(n) asm volatile("s_waitcnt vmcnt(" #n ")" ::: "memory")
#define WAIT_L(n) asm volatile("s_waitcnt lgkmcnt(" #n ")" ::: "memory")
#define BAR __builtin_amdgcn_s_barrier()
#define SCHED __builtin_amdgcn_sched_barrier(0)
#define ZERO_ACC do { _Pragma("unroll") for (int a_ = 0; a_ < 2; ++a_) _Pragma("unroll") for (int b_ = 0; b_ < 2; ++b_) _Pragma("unroll") for (int m_ = 0; m_ < 4; ++m_) _Pragma("unroll") for (int n_ = 0; n_ < 2; ++n_) \
    acc[a_][b_][m_][n_] = (f32x4){0.f, 0.f, 0.f, 0.f}; } while (0)

#define EPI_ROWS for (int ai = 0; ai < 2; ++ai) for (int m = 0; m < 4; ++m, ({ asm volatile("" ::: "memory"); }))
#define EPI_COLS for (int bj = 0; bj < 2; ++bj) for (int n = 0; n < 2; ++n)

DI float dpp_xor1(float x) { return __int_as_float(__builtin_amdgcn_mov_dpp(__float_as_int(x), 0xB1, 0xF, 0xF, true)); }
DI float dpp_xor2(float x) { return __int_as_float(__builtin_amdgcn_mov_dpp(__float_as_int(x), 0x4E, 0xF, 0xF, true)); }
DI float gelu_tanh(float a) { const float a2 = a * a; const float q = a * __builtin_fmaf(0.10294324f, a2, 2.3022082f);
    const float e = __builtin_amdgcn_exp2f(q); const float r = __builtin_amdgcn_rcpf(1.0f + e); return __builtin_fmaf(-a, r, a); }
DI float dpp_ror1(float x) { return __int_as_float(__builtin_amdgcn_mov_dpp(__float_as_int(x), 0x121, 0xF, 0xF, true)); }
DI float dpp_ror2(float x) { return __int_as_float(__builtin_amdgcn_mov_dpp(__float_as_int(x), 0x122, 0xF, 0xF, true)); }
DI f32x4 ror1_4(f32x4 v) { return (f32x4){dpp_ror1(v[0]), dpp_ror1(v[1]), dpp_ror1(v[2]), dpp_ror1(v[3])}; }
DI f32x4 ror2_4(f32x4 v) { return (f32x4){dpp_ror2(v[0]), dpp_ror2(v[1]), dpp_ror2(v[2]), dpp_ror2(v[3])}; }
DI f32x4 quad_transpose(f32x4 v, int i) {
    { const float a = (i & 1) ? v[0] : v[1], c = (i & 1) ? v[2] : v[3]; const float ra = dpp_xor1(a), rc = dpp_xor1(c);
      if (i & 1) { v[0] = ra; v[2] = rc; } else { v[1] = ra; v[3] = rc; } }
    { const float a = (i & 2) ? v[0] : v[2], c = (i & 2) ? v[1] : v[3]; const float ra = dpp_xor2(a), rc = dpp_xor2(c);
      if (i & 2) { v[0] = ra; v[1] = rc; } else { v[2] = ra; v[3] = rc; } }
    return v;
}
DI void store_bf4(bf16_t* p, f32x4 v) { u32x2 w; w.x = pk2(v[0], v[1]); w.y = pk2(v[2], v[3]); *(u32x2*)p = w; }

DI int unit_at(int k, int bid, int G, int nM, int nN, int start) {
    if (G != 256) { const int u = (bid + G - (start % G)) % G + k * G; return u < nM * nN ? u : -1; }
    const int x = bid & 7, l = ((bid >> 3) + start) & 31, cnt = nM >> 3, mainn = cnt * nN, j = l + 32 * k;
    if (j < mainn) { const int pn = j / cnt, rm = j - pn * cnt; return (x + 8 * rm) * nN + pn; }
    const int idx = x + 8 * (j - mainn);
    if (idx < (nM & 7) * nN) return (8 * cnt + idx / nN) * nN + idx % nN;
    return -1;
}

DI void gemm_run(const GemmDesc& d, char* lds) {
    LAS char* ldsl = (LAS char*)lds;
    float* xl = (float*)(lds + 131072);
    float* xp = (float*)(lds + 131072 + 4096);
    const int G = ogrid(), bid_ = obid(), first = unit_at(0, bid_, G, d.nM, d.nN, d.start);
    if (first < 0) return;
    int kun = 0;
    const int tid = otid(), wid = __builtin_amdgcn_readfirstlane(tid >> 6), wr = wid >> 2, wc = wid & 3;
    const unsigned lda2 = (unsigned)d.lda * 2u, ldb2 = (unsigned)d.ldb * 2u;
    unsigned voffA[2], voffB[2];
    { const int lane = tid & 63;
#pragma unroll
      for (int i = 0; i < 2; ++i) { int R, C; stage_rc(tid * 16 + i * 8192, R, C); voffA[i] = (unsigned)R * lda2 + (unsigned)C * 2u; voffB[i] = (unsigned)R * ldb2 + (unsigned)C * 2u; }
      (void)lane; }
    const size_t kstep = 128, hA = (size_t)HALF * lda2, hB = (size_t)HALF * ldb2;
    const unsigned ldsw = (unsigned)wid * 1024u;
    const int aoff = lds_byte(wr * 64 + (tid & 15), ((tid & 63) >> 4) * 8), boff = lds_byte(wc * 32 + (tid & 15), ((tid & 63) >> 4) * 8);
    const int nt = d.K / BK;
    int u = first;
    const char* cA = (const char*)d.A + (size_t)(u / d.nN) * 2 * hA; const char* cB = (const char*)d.Bt + (size_t)(u % d.nN) * 2 * hB;
    f32x4 acc[2][2][4][2];
    ZERO_ACC;
    bf16x8 At[4][2], B0[2][2], B1[2][2];
    STAGE(SB(0, 0), cB, voffB); STAGE(SB(0, 1), cB + hB, voffB); STAGE(SA(0, 0), cA, voffA); STAGE(SA(0, 1), cA + hA, voffA);
    if (wr == 1) BAR;
    WAIT_V(2); BAR;
    STAGE(SB(1, 0), cB + kstep, voffB); STAGE(SA(1, 0), cA + kstep, voffA); STAGE(SB(1, 1), cB + hB + kstep, voffB);
    WAIT_V(6); BAR;
    for (;;) {
        const int un = unit_at(kun + 1, bid_, G, d.nM, d.nN, d.start); const bool has_next = un >= 0;
        const char* nA = has_next ? (const char*)d.A + (size_t)(un / d.nN) * 2 * hA : cA; const char* nB = has_next ? (const char*)d.Bt + (size_t)(un % d.nN) * 2 * hB : cB;
        for (int t = 0; t < nt; t += 2) {
            const bool last = (t == nt - 2);
            const char* a1 = cA + (size_t)(t + 1) * kstep;
            const char* a2 = last ? nA : cA + (size_t)(t + 2) * kstep; const char* b2 = last ? nB : cB + (size_t)(t + 2) * kstep;
            const char* a3 = a2 + kstep; const char* b3 = b2 + kstep;
            LDB(B0, 0, 0); LDB(B1, 0, 1); SCHED; LDA(At, 0, 0); STAGE(SA(1, 1), a1 + hA, voffA);
            WAIT_V(8); WAIT_L(0); BAR; MMA(0, 0, At, B0); MMA(0, 1, At, B1); BAR; SCHED;
            LDA(At, 0, 1); STAGE(SB(0, 0), b2, voffB); STAGE(SB(0, 1), b2 + hB, voffB); STAGE(SA(0, 0), a2, voffA);
            WAIT_V(8); WAIT_L(0); BAR; MMA(1, 0, At, B0); MMA(1, 1, At, B1); BAR; SCHED;
            LDB(B0, 1, 0); LDB(B1, 1, 1); SCHED; LDA(At, 1, 0); STAGE(SA(0, 1), a2 + hA, voffA);
            WAIT_V(8); WAIT_L(0); BAR; MMA(0, 0, At, B0); MMA(0, 1, At, B1); BAR; SCHED;
            LDA(At, 1, 1); STAGE(SB(1, 0), b3, voffB); STAGE(SB(1, 1), b3 + hB, voffB); STAGE(SA(1, 0), a3, voffA);
            WAIT_V(8); WAIT_L(0); BAR; MMA(1, 0, At, B0); MMA(1, 1, At, B1); BAR; SCHED;
        }
        if (wr == 0) BAR;
        {
        const int pm = u / d.nN, pn = u % d.nN, brow = pm * BM, bcol = pn * BM;
        if (d.epi == E_UQ) {
            const int tq_ = otid(), r = tq_ >> 1, hf = tq_ & 1;
            const u32x4* src = (const u32x4*)(d.A + (long)(brow + r) * 384 + hf * 192);
            float sq = 0.f;
#pragma unroll 4
            for (int i = 0; i < 24; ++i) { u32x4 v = src[i];
                for (int e = 0; e < 4; ++e) { float a_ = bf_lo(v[e]), b_ = bf_hi(v[e]); sq += a_ * a_ + b_ * b_; } }
            sq += __shfl_xor(sq, 1);
            if (hf == 0) xl[r] = rsqrtf(sq * (1.0f / 384.0f) + EPS);
            WAIT_L(0); BAR; asm volatile("" ::: "memory");
        }
        int lane_e = threadIdx.x & 63; asm volatile("" : "+v"(lane_e));
        const int fr = lane_e & 15, fq = lane_e >> 4;
        KP P = kparams();
        const int rbase = brow + wr * 64 + fr, cbase = bcol + wc * 32 + fq * 4;
        switch (d.epi) {
        case E_INPROJ: {
            if (pn == 0) {
#pragma unroll
                EPI_ROWS { const int row = rbase + ai * 128 + m * 16;
#pragma unroll
                    EPI_COLS store_bf4(P->qlat + (long)row * 384 + (cbase + bj * 128 + n * 16), acc[ai][bj][m][n]); }
            } else if (pn == 1) {
#pragma unroll
                EPI_ROWS { const int row = rbase + ai * 128 + m * 16;
#pragma unroll
                    for (int n = 0; n < 2; ++n) store_bf4(P->qlat + (long)row * 384 + 256 + (wc * 32 + fq * 4 + n * 16), acc[ai][0][m][n]);
                    if (wc == 0) {
                        const int pos = pos_of(row);
                        const f32x4 cs0 = *(const f32x4*)(P->ropeT + (long)pos * 32 + fq * 8), cs1 = *(const f32x4*)(P->ropeT + (long)pos * 32 + fq * 8 + 4);
                        const f32x4 x1 = acc[ai][1][m][0], x2 = acc[ai][1][m][1];
                        f32x4 co = {cs0[0], cs0[2], cs1[0], cs1[2]}, si = {cs0[1], cs0[3], cs1[1], cs1[3]};
                        f32x4 o1 = x1 * co - x2 * si, o2 = x2 * co + x1 * si;
                        float* of = P->out + (row < MP ? O_KR_P + (long)row * 32 : O_KR_S + (long)(row - MP) * 32);
                        *(f32x4*)(of + fq * 4) = o1; *(f32x4*)(of + 16 + fq * 4) = o2;
                        bf16_t* ob = P->krope + (long)kvrow_of(row) * 32;
                        store_bf4(ob + fq * 4, o1); store_bf4(ob + 16 + fq * 4, o2);
                    } }
            } else if (pn == 2) {
                float ss[2][4];
#pragma unroll
                EPI_ROWS { float s = 0.f;
#pragma unroll
                    EPI_COLS { const f32x4 v = acc[ai][bj][m][n]; s += v[0] * v[0] + v[1] * v[1] + v[2] * v[2] + v[3] * v[3]; }
                    s += __shfl_xor(s, 16); s += __shfl_xor(s, 32); ss[ai][m] = s;
                    if (fq == 0) xp[(ai * 128 + wr * 64 + m * 16 + fr) * 4 + wc] = s; }
                WAIT_L(0); BAR; asm volatile("" ::: "memory");
#pragma unroll
                EPI_ROWS { const int rl = ai * 128 + wr * 64 + m * 16 + fr, row = brow + rl;
                    const f32x4 pp = *(const f32x4*)(xp + rl * 4);
                    const float rstd = rsqrtf((pp[0] + pp[1] + pp[2] + pp[3]) * (1.0f / 256.0f) + EPS);
                    float* of = P->out + (row < MP ? O_CKV_P + (long)row * 256 : O_CKV_S + (long)(row - MP) * 256);
                    bf16_t* ob = P->latent + (long)kvrow_of(row) * 256;
#pragma unroll
                    EPI_COLS { const int c = wc * 32 + fq * 4 + bj * 128 + n * 16;
                        const f32x4 gv = *(const f32x4*)(P->g_kv + c); const f32x4 o = acc[ai][bj][m][n] * rstd * gv;
                        *(f32x4*)(of + c) = o; store_bf4(ob + c, o); } }
            } else if (pn <= 4) {
#pragma unroll
                EPI_ROWS { const int row = rbase + ai * 128 + m * 16;
#pragma unroll
                    EPI_COLS store_bf4(P->qb + (long)row * 512 + (cbase - 768 + bj * 128 + n * 16), acc[ai][bj][m][n] * 0.125f); }
            } else if (pn <= 6) {
#pragma unroll
                EPI_ROWS { const int row = rbase + ai * 128 + m * 16;
                    float* of = P->out + (row < MP ? O_SBK_P + (long)row * 512 : O_SBK_S + (long)(row - MP) * 512);
                    bf16_t* ob = P->kb + (long)kvrow_of(row) * 512;
#pragma unroll
                    EPI_COLS { const int c = cbase - 1280 + bj * 128 + n * 16; *(f32x4*)(of + c) = acc[ai][bj][m][n]; store_bf4(ob + c, acc[ai][bj][m][n]); } }
            } else {
#pragma unroll
                EPI_ROWS { const int row = rbase + ai * 128 + m * 16;
                    float* of = P->out + (row < MP ? O_SBV_P + (long)row * 512 : O_SBV_S + (long)(row - MP) * 512);
                    const int qi = fr & 3, row4 = row - qi;
                    bf16_t* vt; int ldv;
                    if (row4 < MP) { vt = P->vbT_p + (long)(row4 >> 13) * 512 * TP + (row4 & (TP - 1)); ldv = TP; }
                    else { const int r = row4 - MP; vt = P->vbT_s + (long)(r >> 5) * 512 * SKP + PAST + (r & 31); ldv = SKP; }
#pragma unroll
                    EPI_COLS { const int c = cbase - 1792 + bj * 128 + n * 16; const f32x4 v = acc[ai][bj][m][n]; *(f32x4*)(of + c) = v;
                        store_bf4(vt + (long)(c + qi) * ldv, quad_transpose(v, qi)); } }
            }
        } break;
        case E_GATE: {
#pragma unroll
            EPI_ROWS { const int row = rbase + ai * 128 + m * 16;
#pragma unroll
                EPI_COLS { const f32x4 v = acc[ai][bj][m][n]; f32x4 s = {sigmoidf_(v[0]), sigmoidf_(v[1]), sigmoidf_(v[2]), sigmoidf_(v[3])};
                    store_bf4(P->gates + (long)row * 2048 + (cbase + bj * 128 + n * 16), s); } }
        } break;
        case E_UQ: {
            const float qs = 0.10206207261596577f * LOG2E;
#pragma unroll
            EPI_ROWS { const int rl = ai * 128 + wr * 64 + m * 16 + fr, row = brow + rl; const float rs = xl[rl] * qs;
#pragma unroll
                for (int bj = 0; bj < 2; ++bj) { const int grp = pn * 8 + bj * 4 + wc; bf16_t* dst = P->q + (long)row * 768 + grp * 32 + fq * 4;
                    f32x4 v0 = acc[ai][bj][m][0] * rs, v1 = acc[ai][bj][m][1] * rs;
                    if (grp % 3 == 2) {
                        const int pos = pos_of(row);
                        const f32x4 cs0 = *(const f32x4*)(P->ropeT + (long)pos * 32 + fq * 8), cs1 = *(const f32x4*)(P->ropeT + (long)pos * 32 + fq * 8 + 4);
                        f32x4 co = {cs0[0], cs0[2], cs1[0], cs1[2]}, si = {cs0[1], cs0[3], cs1[1], cs1[3]};
                        const f32x4 o1 = v0 * co - v1 * si, o2 = v1 * co + v0 * si; v0 = o1; v1 = o2;
                    }
                    store_bf4(dst, v0); store_bf4(dst + 16, v1); } }
        } break;
        case E_UKV: {
#pragma unroll
            EPI_ROWS { const int row = rbase + ai * 128 + m * 16;
                if (pn < 2) {
#pragma unroll
                    EPI_COLS store_bf4(P->kva + (long)row * 512 + (cbase + bj * 128 + n * 16), acc[ai][bj][m][n]);
                } else {
                    const int qi = fr & 3, row4 = row - qi;
                    bf16_t* vt; int ldv;
                    if (row4 < MP) { vt = P->vaT_p + (long)(row4 >> 13) * 512 * TP + (row4 & (TP - 1)); ldv = TP; }
                    else { const int r = row4 - MP, b = r / SKEYS; vt = P->vaT_s + (long)b * 512 * SKP + (r - b * SKEYS); ldv = SKP; }
#pragma unroll
                    EPI_COLS { const int c = cbase - 512 + bj * 128 + n * 16; const f32x4 vtr = quad_transpose(acc[ai][bj][m][n], qi);
                        if (row4 < KVROWS) store_bf4(vt + (long)(c + qi) * ldv, vtr); }
                } }
        } break;
        case E_PROJA: case E_PROJB: {
            const int goff = d.epi == E_PROJA ? 0 : 1024;
#pragma unroll
            EPI_ROWS { const int row = rbase + ai * 128 + m * 16;
#pragma unroll
                EPI_COLS { const int c = cbase + bj * 128 + n * 16; const u32x2 gw = *(const u32x2*)(P->gates + (long)row * 2048 + goff + c);
                    f32x4 gv = {bf_lo(gw.x), bf_hi(gw.x), bf_lo(gw.y), bf_hi(gw.y)}; f32x4 v = acc[ai][bj][m][n] * gv;
                    bf16_t* dst = P->merged + (long)row * 1024 + c;
                    if (d.epi == E_PROJB) { const u32x2 pw = *(const u32x2*)dst; f32x4 pv = {bf_lo(pw.x), bf_hi(pw.x), bf_lo(pw.y), bf_hi(pw.y)}; v += pv; }
                    store_bf4(dst, v); } }
        } break;
        case E_PLAIN: {
#pragma unroll
            EPI_ROWS { const int row = rbase + ai * 128 + m * 16;
#pragma unroll
                EPI_COLS store_bf4(d.C + (long)row * d.ldc + (cbase + bj * 128 + n * 16), acc[ai][bj][m][n]); }
        } break;
        case E_UP: {
            const int jc0 = pn * 128 + wc * 32 + fq * 4;
            if (pm != 64) {
                const int tq_ = otid(), arr = tq_ >> 6, c2 = (tq_ & 63) * 2, hfb = arr >> 2, kk = arr & 3;
                const float* src = (kk < 3 ? P->conv_w + kk * DFF2 : P->conv_b) + hfb * DFF + pn * 128 + c2;
                *(f32x2*)(xp + arr * 128 + c2) = *(const f32x2*)src;
                WAIT_L(0); BAR; asm volatile("" ::: "memory");
            }
            if (pm == 64) {
#pragma unroll
                EPI_ROWS { const int row = rbase + ai * 128 + m * 16, r = row - MP, t = r & 31;
                    float* cf = t >= 30 ? P->out + O_CONV_S + (long)((r >> 5) * 2 + (t - 30)) * DFF2 : nullptr;
#pragma unroll
                    EPI_COLS { const int c = (bj ? DFF : 0) + jc0 + n * 16; store_bf4(P->u + (long)r * DFF2 + c, acc[ai][bj][m][n]); if (cf) *(f32x4*)(cf + c) = acc[ai][bj][m][n]; } }
            } else {
#pragma unroll
                for (int ai = 0; ai < 2; ++ai)
#pragma unroll
                    for (int n = 0; n < 2; ++n) {
                        const int ca = jc0 + n * 16;
                        f32x4 pa1 = {0.f, 0.f, 0.f, 0.f}, pa2 = pa1, pb1 = pa1, pb2 = pa1;
#pragma unroll
                        for (int m = 0; m < 4; ++m) {
                            const int row = rbase + ai * 128 + m * 16;
                            const f32x4 va = acc[ai][0][m][n], vb = acc[ai][1][m][n];
                            const f32x4 ra1 = ror1_4(va), ra2 = ror2_4(va), rb1 = ror1_4(vb), rb2 = ror2_4(vb);
                            const f32x4 p1a = fr >= 1 ? ra1 : pa1, p2a = fr >= 2 ? ra2 : pa2, p1b = fr >= 1 ? rb1 : pb1, p2b = fr >= 2 ? rb2 : pb2;
                            const float* wl = xp + (ca - pn * 128);
                            f32x4 ya = *(const f32x4*)(wl + 3 * 128) + *(const f32x4*)(wl) * p2a; ya += *(const f32x4*)(wl + 128) * p1a; ya += *(const f32x4*)(wl + 2 * 128) * va;
                            f32x4 yb = *(const f32x4*)(wl + 7 * 128) + *(const f32x4*)(wl + 4 * 128) * p2b; yb += *(const f32x4*)(wl + 5 * 128) * p1b; yb += *(const f32x4*)(wl + 6 * 128) * vb;
                            const f32x4 g4 = {gelu_tanh(ya[0]) * yb[0], gelu_tanh(ya[1]) * yb[1], gelu_tanh(ya[2]) * yb[2], gelu_tanh(ya[3]) * yb[3]};
                            if (!(m == 0 && fr < 2)) store_bf4(P->g + (long)row * DFF + ca, g4);
                            const int blk = row >> 6;
                            if (m == 0 && fr < 2) { bf16_t* up = P->ub + (long)(blk * 4 + 2 + fr) * DFF2 + ca; store_bf4(up, va); store_bf4(up + DFF, vb); }
                            if (m == 3 && fr >= 14) { bf16_t* up = P->ub + (long)(blk * 4 + (fr - 14)) * DFF2 + ca; store_bf4(up, va); store_bf4(up + DFF, vb);
                                const int t = row & (TP - 1);
                                if (t >= TP - 2) { float* cf = P->out + O_CONV_P + (long)((row >> 13) * 2 + (t - (TP - 2))) * DFF2 + ca; *(f32x4*)cf = va; *(f32x4*)(cf + DFF) = vb; } }
                            pa1 = ra1; pa2 = ra2; pb1 = rb1; pb2 = rb2;
                            asm volatile("" ::: "memory");
                        }
                    }
            }
        } break;
        }
        }
        if (!has_next) break;
        ZERO_ACC;
        u = un; cA = nA; cB = nB; ++kun;
        if (wr == 1) BAR;
    }
    WAIT_V(0);
    BAR;
}

#define MFMA32(a, b, c) __builtin_amdgcn_mfma_f32_32x32x16_bf16((a), (b), (c), 0, 0, 0)
template <int KIND, int KSTEPS  >
DI void gemm_small(KP P, const bf16_t* A, int lda, const bf16_t* Bt, int ldb, int N, bf16_t* C, int ldc, char* lds) {
    const int tid = otid(), lane = tid & 63, w = tid >> 6, r = lane & 31, hh = lane >> 5, G = ogrid();
    const int ntask = 8 * (N >> 5);
    float* part = (float*)lds;
    for (int task = obid(); task < ntask; task += G) {
        const int cb = (task & 7) + 8 * (task >> 6), rb = (task >> 3) & 7, row0 = MP + rb * 32, col0 = cb * 32;
#pragma unroll
        for (int pass = 0; pass < (KIND == 2 ? 2 : 1); ++pass) {
            const bf16_t* ap = A + pass * 512 + (long)(row0 + r) * lda + w * (KSTEPS * 16) + 8 * hh;
            const bf16_t* bp = (pass ? P->WpbT : Bt) + (long)(col0 + r) * ldb + w * (KSTEPS * 16) + 8 * hh;
            f32x16 acc;
#pragma unroll
            for (int i = 0; i < 16; ++i) acc[i] = 0.f;
            constexpr int UN = KSTEPS > 11 ? 11 : KSTEPS;
#pragma unroll 1
            for (int s0 = 0; s0 < KSTEPS; s0 += UN) {
                bf16x8 af[UN], bf[UN];
#pragma unroll
                for (int s = 0; s < UN; ++s) { af[s] = *(const bf16x8*)(ap + (s0 + s) * 16); bf[s] = *(const bf16x8*)(bp + (s0 + s) * 16); }
#pragma unroll
                for (int s = 0; s < UN; ++s) acc = MFMA32(bf[s], af[s], acc);
            }
            float* pp = part + ((pass * 8 + w) * 32 + r) * 32 + 4 * hh;
#pragma unroll
            for (int g = 0; g < 4; ++g) *(f32x4*)(pp + 8 * g) = (f32x4){acc[4 * g], acc[4 * g + 1], acc[4 * g + 2], acc[4 * g + 3]};
        }
        __syncthreads();
        {
            const int e = tid * 2, rr = e >> 5, cc = e & 31;
            f32x2 s1 = {0.f, 0.f}, s2 = {0.f, 0.f};
#pragma unroll
            for (int ww = 0; ww < 8; ++ww) { s1 += *(const f32x2*)(part + (ww * 32 + rr) * 32 + cc); if (KIND == 2) s2 += *(const f32x2*)(part + ((8 + ww) * 32 + rr) * 32 + cc); }
            const long row = row0 + rr; const int col = col0 + cc;
            if (KIND == 1) { s1[0] = sigmoidf_(s1[0]); s1[1] = sigmoidf_(s1[1]); }
            if (KIND == 2) { const unsigned ga = *(const unsigned*)(P->gates + row * 2048 + col), gb = *(const unsigned*)(P->gates + row * 2048 + 1024 + col);
                s1[0] = s1[0] * bf_lo(ga) + s2[0] * bf_lo(gb); s1[1] = s1[1] * bf_hi(ga) + s2[1] * bf_hi(gb); }
            *(unsigned*)(C + row * ldc + col) = pk2(s1[0], s1[1]);
        }
        __syncthreads();
    }
}

DI int crow(int i, int h) { return (i & 3) + 8 * (i >> 2) + 4 * h; }

template <int MODE>
DI void attn_unit(KP P, char* lds, bool sample, int b, int h, int ublk) {
    constexpr int DQK = MODE == 0 ? 96 : 64, KS = DQK * 2 + 16, VS = 144, NS = DQK / 16;
    constexpr int KBYTES = 64 * KS, BUF = KBYTES + 64 * VS;
    const int tid = otid(), w = tid >> 6, lane = tid & 63, ql = lane & 31, hh = lane >> 5;
    const int kvrow0 = sample ? MP + b * SKEYS : b * TP;
    const int qrow0 = sample ? MP + b * 32 : b * TP + ublk * 256;
    const int ntiles = sample ? 65 : 4 * (ublk + 1);
    const int t0 = sample ? 0 : ublk * 256 + w * 32, tq = t0 + ql;
    int klim, wmax, wmin;
    if (MODE == 0) { if (sample) { klim = wmax = wmin = SKEYS; } else { klim = ((tq >> 6) + 1) << 6; wmax = (((t0 + 31) >> 6) + 1) << 6; wmin = ((t0 >> 6) + 1) << 6; } }
    else { if (sample) { klim = PAST + tq; wmax = PAST + 31; wmin = PAST; } else { klim = tq; wmax = t0 + 31; wmin = t0; } }
    const bool wactive = sample ? (w == 0) : true;
    const bf16_t* Kp; const bf16_t* Qp; const bf16_t* VT; int ldq; long ldv;
    if (MODE == 0) { Kp = P->kva + (long)kvrow0 * 512 + h * 64; Qp = P->q + (long)qrow0 * 768 + h * 96; ldq = 768;
        VT = sample ? P->vaT_s + (long)(b * 512 + h * 64) * SKP : P->vaT_p + (long)(b * 512 + h * 64) * TP; }
    else { Kp = P->kb + (long)kvrow0 * 512 + h * 64; Qp = P->qb + (long)qrow0 * 512 + h * 64; ldq = 512;
        VT = sample ? P->vbT_s + (long)(b * 512 + h * 64) * SKP : P->vbT_p + (long)(b * 512 + h * 64) * TP; }
    ldv = sample ? SKP : TP;
    const bf16_t* Kr = P->krope + (long)kvrow0 * 32;

    bf16x8 qf[NS];
    if (wactive) {
        const bf16_t* qp = Qp + (long)(w * 32 + ql) * ldq + 8 * hh;
#pragma unroll
        for (int s = 0; s < NS; ++s) qf[s] = *(const bf16x8*)(qp + 16 * s);
    } else {
#pragma unroll
        for (int s = 0; s < NS; ++s) qf[s] = (bf16x8){0, 0, 0, 0, 0, 0, 0, 0};
    }
    f32x16 O0, O1;
#pragma unroll
    for (int i = 0; i < 16; ++i) { O0[i] = 0.f; O1[i] = 0.f; }
    float mrun = -INFINITY, lrun = 0.f, carry = 0.f;
    bool wdone = !wactive;
    volatile int* flags = (volatile int*)(lds + 65536 + 64);

    u32x4 rk0, rk1, rv;
    const int krow_s = tid >> 3, kc_s = tid & 7, rrow_s = tid >> 2, rc_s = tid & 3;
    const bool f32path = (MODE == 1) && sample;
    const float* Kf = P->c_sbk + ((long)b * PAST * 512 + h * 64); const float* Vf = P->c_sbv + ((long)b * PAST * 512 + h * 64);
    auto load_tile = [&](int kt) {
        if (f32path && kt < 64) {
            const float* kp_ = Kf + (long)(kt * 64 + krow_s) * 512 + kc_s * 8; const float* vp_ = Vf + (long)(kt * 64 + krow_s) * 512 + kc_s * 8;
            const f32x4 a0 = *(const f32x4*)kp_, a1 = *(const f32x4*)(kp_ + 4), c0 = *(const f32x4*)vp_, c1 = *(const f32x4*)(vp_ + 4);
            rk0.x = pk2(a0[0], a0[1]); rk0.y = pk2(a0[2], a0[3]); rk0.z = pk2(a1[0], a1[1]); rk0.w = pk2(a1[2], a1[3]);
            rv.x = pk2(c0[0], c0[1]); rv.y = pk2(c0[2], c0[3]); rv.z = pk2(c1[0], c1[1]); rv.w = pk2(c1[2], c1[3]);
            return;
        }
        rk0 = *(const u32x4*)(Kp + (long)(kt * 64 + krow_s) * 512 + kc_s * 8);
        if (MODE == 0 && tid < 256) rk1 = *(const u32x4*)(Kr + (long)(kt * 64 + rrow_s) * 32 + rc_s * 8);
        rv = *(const u32x4*)(VT + (long)krow_s * ldv + kt * 64 + kc_s * 8);
    };
    auto store_tile = [&](int buf, int kt) {
        char* kb_ = lds + buf * BUF; char* vb_ = kb_ + KBYTES;
        *(u32x4*)(kb_ + krow_s * KS + kc_s * 16) = rk0;
        if (f32path && kt < 64) {
#pragma unroll
            for (int e = 0; e < 4; ++e) { *(bf16_t*)(vb_ + (kc_s * 8 + 2 * e) * VS + krow_s * 2) = (bf16_t)(rv[e] & 0xffff); *(bf16_t*)(vb_ + (kc_s * 8 + 2 * e + 1) * VS + krow_s * 2) = (bf16_t)(rv[e] >> 16); }
            return;
        }
        if (MODE == 0 && tid < 256) *(u32x4*)(kb_ + rrow_s * KS + 128 + rc_s * 16) = rk1;
        *(u32x4*)(vb_ + krow_s * VS + kc_s * 16) = rv;
    };
    load_tile(ntiles - 1); store_tile(0, ntiles - 1);
    __syncthreads();
    for (int it = 0; it < ntiles; ++it) {
        const int kt = ntiles - 1 - it, cur = it & 1;
        if (it + 1 < ntiles) load_tile(kt - 1);
        if (wactive && !wdone && kt * 64 < wmax) {
            const char* kb_ = lds + cur * BUF; const char* vb_ = kb_ + KBYTES;
            f32x16 S0, S1;
#pragma unroll
            for (int i = 0; i < 16; ++i) { S0[i] = 0.f; S1[i] = 0.f; }
#pragma unroll
            for (int s = 0; s < NS; ++s) {
                const bf16x8 k0 = *(const bf16x8*)(kb_ + ql * KS + (16 * s + 8 * hh) * 2);
                const bf16x8 k1 = *(const bf16x8*)(kb_ + (32 + ql) * KS + (16 * s + 8 * hh) * 2);
                S0 = MFMA32(k0, qf[s], S0); S1 = MFMA32(k1, qf[s], S1);
            }
            const bool need_mask = (kt * 64 + 64 > wmin);
            const int kbase = kt * 64 + 4 * hh;
            if (MODE == 0) {
                if (need_mask) {
#pragma unroll
                    for (int i = 0; i < 16; ++i) { const int key = kbase + (i & 3) + 8 * (i >> 2);
                        if (key >= klim) S0[i] = -INFINITY; if (key + 32 >= klim) S1[i] = -INFINITY; }
                }
                float mx = S0[0];
#pragma unroll
                for (int i = 1; i < 16; ++i) mx = fmaxf(mx, S0[i]);
#pragma unroll
                for (int i = 0; i < 16; ++i) mx = fmaxf(mx, S1[i]);
                mx = fmaxf(mx, __shfl_xor(mx, 32));
                const float mnew = fmaxf(mrun, mx);
                const float alpha = __builtin_amdgcn_exp2f(mrun - mnew);
                mrun = mnew;
                float ps = 0.f;
#pragma unroll
                for (int i = 0; i < 16; ++i) { S0[i] = __builtin_amdgcn_exp2f(S0[i] - mnew); S1[i] = __builtin_amdgcn_exp2f(S1[i] - mnew); ps += S0[i] + S1[i]; }
                lrun = lrun * alpha + ps;
#pragma unroll
                for (int i = 0; i < 16; ++i) { O0[i] *= alpha; O1[i] *= alpha; }
            } else {
                float gs[2][4], gp[2][4];
                f32x16 SP0, SP1;
#pragma unroll
                for (int i = 0; i < 16; ++i) { const int key = kbase + (i & 3) + 8 * (i >> 2);
                    { const float z = S0[i]; const float t = __builtin_amdgcn_exp2f(-fabsf(z) * LOG2E); float sp = fmaxf(z, 0.f) + LN2 * __builtin_amdgcn_logf(1.0f + t);
                      if (need_mask && key >= klim) sp = 0.f; SP0[i] = sp; }
                    { const float z = S1[i]; const float t = __builtin_amdgcn_exp2f(-fabsf(z) * LOG2E); float sp = fmaxf(z, 0.f) + LN2 * __builtin_amdgcn_logf(1.0f + t);
                      if (need_mask && key + 32 >= klim) sp = 0.f; SP1[i] = sp; } }
#pragma unroll
                for (int g = 0; g < 4; ++g) { gs[0][g] = (SP0[4 * g] + SP0[4 * g + 1]) + (SP0[4 * g + 2] + SP0[4 * g + 3]);
                    gs[1][g] = (SP1[4 * g] + SP1[4 * g + 1]) + (SP1[4 * g + 2] + SP1[4 * g + 3]); }
#pragma unroll
                for (int g = 0; g < 4; ++g) { gp[0][g] = __shfl_xor(gs[0][g], 32); gp[1][g] = __shfl_xor(gs[1][g], 32); }
                float running = carry;
#pragma unroll
                for (int blk = 1; blk >= 0; --blk)
#pragma unroll
                    for (int g = 3; g >= 0; --g) {
                        const float sum1 = hh ? gs[blk][g] : gp[blk][g], sum0 = hh ? gp[blk][g] : gs[blk][g];
                        const float mybase = hh ? running : running + sum1;
                        running += sum0 + sum1;
                        float later = mybase;
#pragma unroll
                        for (int j = 3; j >= 0; --j) { const int i = 4 * g + j; const int key = kbase + j + 8 * g + 32 * blk;
                            const float z = blk ? S1[i] : S0[i], sp = blk ? SP1[i] : SP0[i];
                            float a = __builtin_amdgcn_exp2f((z - sp - later) * LOG2E);
                            if (need_mask && key >= klim) a = 0.f;
                            later += sp;
                            if (blk) S1[i] = a; else S0[i] = a; }
                    }
                carry = running;
                wdone = __all((carry > 104.0f) || (klim <= 0));
            }
            bf16x8 pf[2][2];
#pragma unroll
            for (int s = 0; s < 2; ++s) {
                u32x4 a, c;
                a.x = pk2(S0[8 * s], S0[8 * s + 1]); a.y = pk2(S0[8 * s + 2], S0[8 * s + 3]); a.z = pk2(S0[8 * s + 4], S0[8 * s + 5]); a.w = pk2(S0[8 * s + 6], S0[8 * s + 7]);
                c.x = pk2(S1[8 * s], S1[8 * s + 1]); c.y = pk2(S1[8 * s + 2], S1[8 * s + 3]); c.z = pk2(S1[8 * s + 4], S1[8 * s + 5]); c.w = pk2(S1[8 * s + 6], S1[8 * s + 7]);
                pf[0][s] = __builtin_bit_cast(bf16x8, a); pf[1][s] = __builtin_bit_cast(bf16x8, c);
            }
#pragma unroll
            for (int blk = 0; blk < 2; ++blk)
#pragma unroll
                for (int s = 0; s < 2; ++s) {
                    const int koff = (32 * blk + 16 * s + 4 * hh) * 2;
                    const s16x4 lo0 = *(const s16x4*)(vb_ + ql * VS + koff), hi0 = *(const s16x4*)(vb_ + ql * VS + koff + 16);
                    const s16x4 lo1 = *(const s16x4*)(vb_ + (32 + ql) * VS + koff), hi1 = *(const s16x4*)(vb_ + (32 + ql) * VS + koff + 16);
                    const bf16x8 v0 = __builtin_shufflevector(lo0, hi0, 0, 1, 2, 3, 4, 5, 6, 7), v1 = __builtin_shufflevector(lo1, hi1, 0, 1, 2, 3, 4, 5, 6, 7);
                    O0 = MFMA32(v0, pf[blk][s], O0); O1 = MFMA32(v1, pf[blk][s], O1);
                }
        }
        if (it + 1 < ntiles) store_tile(cur ^ 1, kt - 1);
        if (MODE == 1 && lane == 0) flags[(it & 1) * 8 + w] = wdone ? 1 : 0;
        __syncthreads();
        if (MODE == 1) { int alld = 1;
#pragma unroll
            for (int ww = 0; ww < 8; ++ww) alld &= flags[(it & 1) * 8 + ww];
            if (alld) break; }
    }
    if (wactive) {
        float inv = 1.0f;
        if (MODE == 0) { const float lt = lrun + __shfl_xor(lrun, 32); inv = 1.0f / lt; }
        bf16_t* op = P->o + (long)(qrow0 + w * 32 + ql) * 1024 + (MODE == 0 ? 0 : 512) + h * 64 + 4 * hh;
#pragma unroll
        for (int g = 0; g < 4; ++g) {
            f32x4 a = {O0[4 * g] * inv, O0[4 * g + 1] * inv, O0[4 * g + 2] * inv, O0[4 * g + 3] * inv};
            f32x4 c = {O1[4 * g] * inv, O1[4 * g + 1] * inv, O1[4 * g + 2] * inv, O1[4 * g + 3] * inv};
            store_bf4(op + 8 * g, a); store_bf4(op + 32 + 8 * g, c);
        }
    }
}

DI void attn_phase(KP P, char* lds, int cidx) {
    unsigned* slot = (unsigned*)(lds + 65536);
    for (;;) {
        if (threadIdx.x == 0) *slot = atomicAdd(P->ctr + cidx, 1u);
        __syncthreads();
        const unsigned idx = *slot;
        __syncthreads();
        if (idx >= 1152u) break;
        bool sample; int mode, b, h, ublk = 0;
        if (idx < 128u) { sample = true; mode = idx >> 6; b = (idx >> 3) & 7; h = idx & 7; }
        else { const int j = idx - 128; sample = false; ublk = 31 - (j >> 5); const int r = j & 31; mode = r >> 4; b = (r >> 3) & 1; h = r & 7; }
        if (mode == 0) attn_unit<0>(P, lds, sample, b, h, ublk); else attn_unit<1>(P, lds, sample, b, h, ublk);
    }
}

DI void phase0(KP P, char* lds) {
    const int tid = otid(), G = ogrid(), bid = obid(), w = tid >> 6, lane = tid & 63;
    for (int item = bid; item < 96; item += G) {
        float* sc = (float*)lds; float* red = (float*)(lds + 40960);
        for (int i = tid; i < 10240; i += NTHREADS) { const int bb = i >> 10, k = i & 1023; const float cv = bb < 2 ? P->c_p[bb * 1024 + k] : P->c_s[(bb - 2) * 1024 + k]; sc[i] = cv / (1.0f + __expf(-cv)); }
        __syncthreads();
        const int col = item * 64 + lane;
        float a0 = 0, a1 = 0, a2 = 0, a3 = 0, a4 = 0, a5 = 0, a6 = 0, a7 = 0, a8 = 0, a9 = 0;
        for (int k0 = w * 128; k0 < w * 128 + 128; k0 += 16) {
            float wv[16];
#pragma unroll
            for (int j = 0; j < 16; ++j) wv[j] = P->w_ada[(long)(k0 + j) * 6144 + col];
#pragma unroll
            for (int j = 0; j < 16; ++j) { const int k = k0 + j;
                a0 += sc[k] * wv[j]; a1 += sc[1024 + k] * wv[j]; a2 += sc[2048 + k] * wv[j]; a3 += sc[3072 + k] * wv[j]; a4 += sc[4096 + k] * wv[j];
                a5 += sc[5120 + k] * wv[j]; a6 += sc[6144 + k] * wv[j]; a7 += sc[7168 + k] * wv[j]; a8 += sc[8192 + k] * wv[j]; a9 += sc[9216 + k] * wv[j]; }
        }
        float* rr = red + w * 640 + lane;
        rr[0] = a0; rr[64] = a1; rr[128] = a2; rr[192] = a3; rr[256] = a4; rr[320] = a5; rr[384] = a6; rr[448] = a7; rr[512] = a8; rr[576] = a9;
        __syncthreads();
        for (int i = tid; i < 640; i += NTHREADS) { float s = 0.f; for (int ww = 0; ww < 8; ++ww) s += red[ww * 640 + i];
            const int bb = i >> 6, l = i & 63; P->ada[bb * 6144 + item * 64 + l] = s + P->b_ada[item * 64 + l]; }
        __syncthreads();
    }
    {
        float* tile = (float*)lds;
        for (int it = (bid + 96) % G; it < P->ntj_tiles; it += G) {
            int j = 0;
#pragma unroll
            for (int q = 1; q < 16; ++q) if (it >= P->tj[q].tile0) j = q;
            TJob J; J.src = P->tj[j].src; J.kscale = P->tj[j].kscale; J.dst = P->tj[j].dst; J.lds = P->tj[j].lds; J.coff = P->tj[j].coff; J.ldd = P->tj[j].ldd;
            J.Klen = P->tj[j].Klen; J.Nlen = P->tj[j].Nlen; J.zero = P->tj[j].zero; J.tile0 = P->tj[j].tile0;
            const int lt = it - J.tile0, nk = J.Klen >> 6, tk = lt % nk, tn = lt / nk, k0 = tk * 64, n0 = tn * 256;
            f32x4 lv[8];
#pragma unroll
            for (int r = 0; r < 8; ++r) { const int e = tid + r * NTHREADS, kk = e >> 6, n4 = (e & 63) * 4;
                lv[r] = (f32x4){0.f, 0.f, 0.f, 0.f};
                if (J.zero == 2) { const int nn_ = n0 + n4, sc_ = (nn_ >> 8) * 128 + (nn_ & 127) + ((nn_ >> 7) & 1) * DFF;
                    lv[r] = *(const f32x4*)(J.src + (long)(k0 + kk) * J.lds + sc_); }
                else if (!J.zero && n0 + n4 < J.Nlen) lv[r] = *(const f32x4*)(J.src + (long)(k0 + kk) * J.lds + J.coff + n0 + n4); }
#pragma unroll
            for (int r = 0; r < 8; ++r) { const int e = tid + r * NTHREADS, kk = e >> 6, n4 = (e & 63) * 4;
                f32x4 v = lv[r]; if (J.kscale) v *= J.kscale[k0 + kk];
                float* tp = tile + kk * 257 + n4; tp[0] = v[0]; tp[1] = v[1]; tp[2] = v[2]; tp[3] = v[3]; }
            __syncthreads();
#pragma unroll
            for (int r = 0; r < 4; ++r) { const int e = tid + r * NTHREADS, nn = e >> 3, kc = (e & 7) * 8;
                if (n0 + nn < J.Nlen) { const float* tp = tile + kc * 257 + nn; u32x4 o;
                    o.x = pk2(tp[0], tp[257]); o.y = pk2(tp[2 * 257], tp[3 * 257]); o.z = pk2(tp[4 * 257], tp[5 * 257]); o.w = pk2(tp[6 * 257], tp[7 * 257]);
                    *(u32x4*)(J.dst + (long)(n0 + nn) * J.ldd + k0 + kc) = o; } }
            __syncthreads();
        }
    }
    const long gt = (long)bid * NTHREADS + tid, gn = (long)G * NTHREADS;
    for (long i0 = gt; i0 < 8L * PAST * 64; i0 += 4 * gn) { f32x4 v[4];
#pragma unroll
        for (int r = 0; r < 4; ++r) { const long i = i0 + r * gn; if (i < 8L * PAST * 64) v[r] = *(const f32x4*)(P->c_ckv + i * 4); }
#pragma unroll
        for (int r = 0; r < 4; ++r) { const long i = i0 + r * gn; if (i < 8L * PAST * 64) { const long row = i >> 6; const int c = (int)(i & 63) * 4; const int bb = (int)(row >> 12), sq = (int)(row & 4095);
            store_bf4(P->latent + (long)(MP + bb * SKEYS + sq) * 256 + c, v[r]); } } }
    for (long i0 = gt; i0 < 8L * PAST * 8; i0 += 4 * gn) { f32x4 v[4];
#pragma unroll
        for (int r = 0; r < 4; ++r) { const long i = i0 + r * gn; if (i < 8L * PAST * 8) v[r] = *(const f32x4*)(P->c_kr + i * 4); }
#pragma unroll
        for (int r = 0; r < 4; ++r) { const long i = i0 + r * gn; if (i < 8L * PAST * 8) { const long row = i >> 3; const int c = (int)(i & 7) * 4; const int bb = (int)(row >> 12), sq = (int)(row & 4095);
            store_bf4(P->krope + (long)(MP + bb * SKEYS + sq) * 32 + c, v[r]); } } }
    for (long i = gt; i < 8L * 512 * 8; i += gn) { const long r = i >> 3; const int c = (int)(i & 7) * 4; const u32x2 z = {0u, 0u};
        *(u32x2*)(P->vaT_s + r * SKP + SKEYS + c) = z; *(u32x2*)(P->vbT_s + r * SKP + SKEYS + c) = z; }
    for (long i = gt; i < (long)TP * 16; i += gn) { const int pos = (int)(i >> 4), fi = (int)(i & 15);
        const float inv = exp2f(-(float)fi * (13.287712379549449f / 16.0f));
        const float ang = (float)pos * inv;
        const double rev = (double)ang * 0.15915494309189535; const float fr_ = (float)(rev - floor(rev));
        P->ropeT[i * 2] = __builtin_amdgcn_cosf(fr_); P->ropeT[i * 2 + 1] = __builtin_amdgcn_sinf(fr_); }
}

DI void phase_h(KP P) {
    const int tid_ = otid(), lane = tid_ & 63, gw = obid() * 8 + (tid_ >> 6), nw = ogrid() * 8;
    for (int row = gw; row < MT; row += nw) {
        const float* xr = row < MP ? P->x_p + (long)row * DM : P->x_s + (long)(row - MP) * DM;
        const float* ad = P->ada + ada_b(row) * 6144;
        f32x4 v[4]; float s = 0.f;
#pragma unroll
        for (int i = 0; i < 4; ++i) { v[i] = *(const f32x4*)(xr + i * 256 + lane * 4); s += v[i][0] * v[i][0] + v[i][1] * v[i][1] + v[i][2] * v[i][2] + v[i][3] * v[i][3]; }
#pragma unroll
        for (int o = 1; o < 64; o <<= 1) s += __shfl_xor(s, o);
        const float rstd = rsqrtf(s * (1.0f / DM) + EPS);
#pragma unroll
        for (int i = 0; i < 4; ++i) { const int c = i * 256 + lane * 4;
            const f32x4 g = *(const f32x4*)(P->g_pre_mix + c), sh = *(const f32x4*)(ad + c), scl = *(const f32x4*)(ad + 1024 + c);
            store_bf4(P->h + (long)row * DM + c, v[i] * rstd * g * (1.0f + scl) + sh); }
    }
}

DI void phase_mid(KP P) {
    const int tid_ = otid(), lane = tid_ & 63, gw = obid() * 8 + (tid_ >> 6), nw = ogrid() * 8;
    for (int row = gw; row < MT; row += nw) {
        const float* xr = row < MP ? P->x_p + (long)row * DM : P->x_s + (long)(row - MP) * DM;
        const float* ad = P->ada + ada_b(row) * 6144;
        f32x4 mv[4]; float s = 0.f;
#pragma unroll
        for (int i = 0; i < 4; ++i) { const u32x2 wv = *(const u32x2*)(P->m2 + (long)row * DM + i * 256 + lane * 4);
            mv[i] = (f32x4){bf_lo(wv.x), bf_hi(wv.x), bf_lo(wv.y), bf_hi(wv.y)}; s += mv[i][0] * mv[i][0] + mv[i][1] * mv[i][1] + mv[i][2] * mv[i][2] + mv[i][3] * mv[i][3]; }
#pragma unroll
        for (int o = 1; o < 64; o <<= 1) s += __shfl_xor(s, o);
        const float rstd = rsqrtf(s * (1.0f / DM) + EPS);
        float s2 = 0.f;
#pragma unroll
        for (int i = 0; i < 4; ++i) { const int c = i * 256 + lane * 4;
            const f32x4 xv = *(const f32x4*)(xr + c), g = *(const f32x4*)(P->g_post_mix + c), gt = *(const f32x4*)(ad + 2048 + c);
            mv[i] = xv + gt * (mv[i] * rstd * g);
            *(f32x4*)(P->out + O_Y + (long)row * DM + c) = mv[i];
            s2 += mv[i][0] * mv[i][0] + mv[i][1] * mv[i][1] + mv[i][2] * mv[i][2] + mv[i][3] * mv[i][3]; }
#pragma unroll
        for (int o = 1; o < 64; o <<= 1) s2 += __shfl_xor(s2, o);
        const float rstd2 = rsqrtf(s2 * (1.0f / DM) + EPS);
#pragma unroll
        for (int i = 0; i < 4; ++i) { const int c = i * 256 + lane * 4;
            const f32x4 g = *(const f32x4*)(P->g_pre_ffn + c), sh = *(const f32x4*)(ad + 3072 + c), scl = *(const f32x4*)(ad + 4096 + c);
            store_bf4(P->h2 + (long)row * DM + c, mv[i] * rstd2 * g * (1.0f + scl) + sh); }
    }
}

DI void phase_final(KP P) {
    const int tid_ = otid(), lane = tid_ & 63, gw = obid() * 8 + (tid_ >> 6), nw = ogrid() * 8;
    for (int row = gw; row < MT; row += nw) {
        const float* ad = P->ada + ada_b(row) * 6144;
        f32x4 fv[4]; float s = 0.f;
#pragma unroll
        for (int i = 0; i < 4; ++i) { const u32x2 wv = *(const u32x2*)(P->f + (long)row * DM + i * 256 + lane * 4);
            fv[i] = (f32x4){bf_lo(wv.x), bf_hi(wv.x), bf_lo(wv.y), bf_hi(wv.y)}; s += fv[i][0] * fv[i][0] + fv[i][1] * fv[i][1] + fv[i][2] * fv[i][2] + fv[i][3] * fv[i][3]; }
#pragma unroll
        for (int o = 1; o < 64; o <<= 1) s += __shfl_xor(s, o);
        const float rstd = rsqrtf(s * (1.0f / DM) + EPS);
#pragma unroll
        for (int i = 0; i < 4; ++i) { const int c = i * 256 + lane * 4; float* yp = P->out + O_Y + (long)row * DM + c;
            const f32x4 xv = *(const f32x4*)yp, g = *(const f32x4*)(P->g_post_ffn + c), gt = *(const f32x4*)(ad + 5120 + c);
            *(f32x4*)yp = xv + gt * (fv[i] * rstd * g); }
    }
}


DI void load8(const bf16_t* p, float (&o)[8]) { const u32x4 w = *(const u32x4*)p;
#pragma unroll
    for (int e = 0; e < 4; ++e) { o[2 * e] = bf_lo(w[e]); o[2 * e + 1] = bf_hi(w[e]); } }
DI void phase_convfix(KP P) {
    const long gt = (long)obid() * NTHREADS + otid(), gn = (long)ogrid() * NTHREADS;
    for (long i = gt; i < 768L * 352; i += gn) {
        const int ri = (int)(i / 352), c = (int)(i % 352) * 8;
        float u0[2][8], u1[2][8], u2[2][8];
        long grow;
        if (ri < 512) {
            const int B = ri >> 1, rsel = ri & 1; const bool first = ((B * 64) & (TP - 1)) == 0; grow = (long)B * 64 + rsel;
            const bf16_t* cur = P->ub + (long)(B * 4) * DFF2 + c; const bf16_t* prv = P->ub + (long)((B > 0 ? B - 1 : 0) * 4) * DFF2 + c;
#pragma unroll
            for (int hf = 0; hf < 2; ++hf) {
                load8(cur + (long)(2 + rsel) * DFF2 + hf * DFF, u2[hf]);
                if (rsel == 0) { if (first) { for (int e = 0; e < 8; ++e) { u1[hf][e] = 0.f; u0[hf][e] = 0.f; } } else { load8(prv + (long)1 * DFF2 + hf * DFF, u1[hf]); load8(prv + hf * DFF, u0[hf]); } }
                else { load8(cur + (long)2 * DFF2 + hf * DFF, u1[hf]); if (first) { for (int e = 0; e < 8; ++e) u0[hf][e] = 0.f; } else load8(prv + (long)1 * DFF2 + hf * DFF, u0[hf]); }
            }
        } else {
            const int r = ri - 512, t = r & 31, bs = r >> 5; grow = (long)MP + r;
            const float* st = P->c_conv + (long)bs * 2 * DFF2 + c;
#pragma unroll
            for (int hf = 0; hf < 2; ++hf) {
                load8(P->u + (long)r * DFF2 + hf * DFF + c, u2[hf]);
                if (t >= 1) load8(P->u + (long)(r - 1) * DFF2 + hf * DFF + c, u1[hf]); else { for (int e = 0; e < 8; ++e) u1[hf][e] = st[DFF2 + hf * DFF + e]; }
                if (t >= 2) load8(P->u + (long)(r - 2) * DFF2 + hf * DFF + c, u0[hf]); else { for (int e = 0; e < 8; ++e) u0[hf][e] = st[(long)t * DFF2 + hf * DFF + e]; }
            }
        }
        float y[2][8];
#pragma unroll
        for (int hf = 0; hf < 2; ++hf)
#pragma unroll
            for (int e = 0; e < 8; ++e) { const int cc = hf * DFF + c + e;
                y[hf][e] = P->conv_b[cc] + P->conv_w[cc] * u0[hf][e] + P->conv_w[DFF2 + cc] * u1[hf][e] + P->conv_w[2 * DFF2 + cc] * u2[hf][e]; }
        u32x4 ov;
#pragma unroll
        for (int e = 0; e < 4; ++e) ov[e] = pk2(gelu_tanh(y[0][2 * e]) * y[1][2 * e], gelu_tanh(y[0][2 * e + 1]) * y[1][2 * e + 1]);
        *(u32x4*)(P->g + grow * DFF + c) = ov;
    }
}

#define XB_TMO      128
#define XB_XCNT(j)  (256  + 64 * (j))
#define XB_XSUB(j)  (1280 + 64 * (j))
#define XB_XGEN(j)  (2304 + 64 * (j))
#define XB_TOP      3328
#define XB_TOPGEN   3392
#define XCD_BAR_WORDS 3456
#define XB_SPIN_CAP (1u << 18)
DI unsigned xb_ld(unsigned* p)              { return __hip_atomic_load(p, __ATOMIC_RELAXED, __HIP_MEMORY_SCOPE_AGENT); }
DI unsigned xb_add(unsigned* p, unsigned v) { return __hip_atomic_fetch_add(p, v, __ATOMIC_RELAXED, __HIP_MEMORY_SCOPE_AGENT); }
DI unsigned xb_xcc_id() { return (unsigned)__builtin_amdgcn_s_getreg((3 << 11) | 20) & 0xFu; }
#define XB_SPIN(cond, bar) do { unsigned _sp = 0; while (cond) { __builtin_amdgcn_s_sleep(1); \
    if ((++_sp & 255u) == 0u) { if (xb_ld(&(bar)[XB_TMO])) break; if (_sp > XB_SPIN_CAP) { atomicAdd(&(bar)[XB_TMO], 1u); break; } } } } while (0)
DI void xcd_barrier_complete(unsigned* bar, unsigned x, unsigned& nloc, unsigned& nx) {
    const unsigned G = gridDim.x;
    unsigned sum, cnt, mine, sp = 0u;
    for (;;) {
        sum = 0u; cnt = 0u; mine = 0u;
#pragma unroll
        for (unsigned j = 0; j < 16; ++j) { const unsigned c = xb_ld(&bar[XB_XCNT(j)]); sum += c; cnt += (c > 0u) ? 1u : 0u; mine = (j == x) ? c : mine; }
        if (sum == G) break;
        __builtin_amdgcn_s_sleep(1);
        if ((++sp & 255u) == 0u) { if (xb_ld(&bar[XB_TMO])) break; if (sp > XB_SPIN_CAP) { atomicAdd(&bar[XB_TMO], 1u); break; } }
    }
    nloc = mine > 0u ? mine : 1u; nx = cnt > 0u ? cnt : 1u;
}
DI void grid_barrier(char* lds) {
    asm volatile("s_waitcnt vmcnt(0)" ::: "memory");
    __syncthreads();
    if (threadIdx.x == 0) {
        unsigned* bar = kparams()->bar; const unsigned x = xb_xcc_id();
        volatile LAS unsigned* st = (volatile LAS unsigned*)(lds + 131072 + 2048);
        __builtin_amdgcn_s_waitcnt(0);
        unsigned nloc = st[0], nx = st[1];
        if (nloc == 0u) { xcd_barrier_complete(bar, x, nloc, nx); st[0] = nloc; st[1] = nx; }
        const unsigned old = xb_add(&bar[XB_XSUB(x)], 1u);
        const unsigned gen = old / nloc;
        if (old + 1u == (gen + 1u) * nloc) {
            __builtin_amdgcn_fence(__ATOMIC_RELEASE, "agent");
            asm volatile("s_waitcnt vmcnt(0)" ::: "memory");
            const unsigned og = xb_add(&bar[XB_TOP], 1u);
            const unsigned tg = og / nx;
            if (og + 1u == (tg + 1u) * nx) xb_add(&bar[XB_TOPGEN], 1u);
            else XB_SPIN(xb_ld(&bar[XB_TOPGEN]) == tg, bar);
            __builtin_amdgcn_fence(__ATOMIC_ACQUIRE, "agent");
            xb_add(&bar[XB_XGEN(x)], 1u);
            asm volatile("s_waitcnt vmcnt(0)" ::: "memory");
        } else {
            XB_SPIN(xb_ld(&bar[XB_XGEN(x)]) == gen, bar);
            __builtin_amdgcn_fence(__ATOMIC_ACQUIRE, "agent");
            asm volatile("s_waitcnt vmcnt(0)" ::: "memory");
        }
    }
    __syncthreads();
}

__global__ void __launch_bounds__(NTHREADS) fwd_megakernel(Params Pval) {
    extern __shared__ __attribute__((aligned(16))) char lds[];
    cg::grid_group grid = cg::this_grid();
    const int lo = kparams()->phase_lo, hi = kparams()->phase_hi;
#define PH(n) if (lo <= (n) && (n) < hi)
#define SYNC(n) if (lo <= (n) && (n) + 1 < hi) grid_barrier(lds)
    if (hi > 1000) grid.sync();
    { volatile LAS unsigned* st = (volatile LAS unsigned*)(lds + 131072 + 2048);
      if (threadIdx.x == 0) { st[0] = 0u; st[1] = 0u; }
      __syncthreads();
      if (threadIdx.x == 0) (void)xb_add(&kparams()->bar[XB_XCNT(xb_xcc_id())], 1u); }
    PH(0) phase0(kparams(), lds);
#ifdef PROBE_P0
    __syncthreads(); phase0(kparams(), lds);
#endif
#ifdef PROBE_SYNC
    for (int i = 0; i < 24; ++i) grid_barrier(lds);
#endif
    SYNC(0);
    PH(1) phase_h(kparams());
#ifdef PROBE_ROWS
    phase_h(kparams());
#endif
    SYNC(1);
    for (int ph = 2; ph <= 12; ++ph) {
        if (ph == 4) { PH(4) attn_phase(kparams(), lds, 0);
#ifdef PROBE_ATTN2
            __syncthreads(); attn_phase(kparams(), lds, 1);
#endif
            SYNC(4); continue; }
        if (ph == 8) { PH(8) phase_mid(kparams());
#ifdef PROBE_ROWS
            phase_mid(kparams());
#endif
            SYNC(8); continue; }
        if (ph == 10) { PH(10) phase_convfix(kparams());

            SYNC(10); continue; }
        if (ph == 12) { PH(12) phase_final(kparams()); continue; }
        if (lo <= ph && ph < hi) {
            const int npass = (ph == 3 || ph == 6) ? 2 : 1;
            for (int pass = 0; pass < npass; ++pass) {
                GemmDesc d; d.C = nullptr; d.ldc = 0; d.start = 0; KP P = kparams();
                switch (ph) {
                case 2: d.A = P->h; d.lda = DM; d.Bt = P->WinT; d.ldb = DM; d.K = DM; d.nM = 65; d.nN = 9; d.epi = E_INPROJ; break;
                case 3: if (pass == 0) { d.A = P->qlat; d.lda = 384; d.Bt = P->WuqT; d.ldb = 384; d.K = 384; d.nM = 65; d.nN = 3; d.epi = E_UQ; }
                        else { d.A = P->latent; d.lda = 256; d.Bt = P->WukvT; d.ldb = 256; d.K = 256; d.nM = 193; d.nN = 4; d.epi = E_UKV; d.start = 195; } break;
                case 5: d.A = P->h; d.lda = DM; d.Bt = P->WgT; d.ldb = DM; d.K = DM; d.nM = 64; d.nN = 8; d.epi = E_GATE; break;
                case 6: d.A = P->o + pass * 512; d.lda = DM; d.Bt = pass ? P->WpbT : P->WpaT; d.ldb = 512; d.K = 512; d.nM = 64; d.nN = 4; d.epi = pass ? E_PROJB : E_PROJA; break;
                case 7: d.A = P->merged; d.lda = DM; d.Bt = P->WoutT; d.ldb = DM; d.K = DM; d.nM = 64; d.nN = 4; d.epi = E_PLAIN; d.C = P->m2; d.ldc = DM; break;
                case 9: d.A = P->h2; d.lda = DM; d.Bt = P->WupT; d.ldb = DM; d.K = DM; d.nM = 65; d.nN = 22; d.epi = E_UP; break;
                default: d.A = P->g; d.lda = DFF; d.Bt = P->WdownT; d.ldb = DFF; d.K = DFF; d.nM = 64; d.nN = 4; d.epi = E_PLAIN; d.C = P->f; d.ldc = DM; break;
                }
                gemm_run(d, lds);
#ifdef PROBE_GEMM2
                if (ph == PROBE_GEMM2 && !(ph == 6 && pass == 0)) { __syncthreads(); if (ph == 6) { GemmDesc d0 = d; d0.A = P->o; d0.Bt = P->WpaT; d0.epi = E_PROJA; gemm_run(d0, lds); } gemm_run(d, lds); }
#endif
            }
        }
        if (lo <= ph && ph < hi) {
            KP P = kparams();
            if (ph == 5) gemm_small<1, 8>(P, P->h, DM, P->WgT, DM, 2048, P->gates, 2048, lds);
            else if (ph == 6) gemm_small<2, 4>(P, P->o, DM, P->WpaT, 512, 1024, P->merged, DM, lds);
            else if (ph == 7) gemm_small<0, 8>(P, P->merged, DM, P->WoutT, DM, 1024, P->m2, DM, lds);
            else if (ph == 11) gemm_small<0, 22>(P, P->g, DFF, P->WdownT, DFF, 1024, P->f, DM, lds);
#ifdef PROBE_SMALL
            if (ph == 5) gemm_small<1, 8>(P, P->h, DM, P->WgT, DM, 2048, P->gates, 2048, lds);
            else if (ph == 6) gemm_small<2, 4>(P, P->o, DM, P->WpaT, 512, 1024, P->merged, DM, lds);
            else if (ph == 7) gemm_small<0, 8>(P, P->merged, DM, P->WoutT, DM, 1024, P->m2, DM, lds);
            else if (ph == 11) gemm_small<0, 22>(P, P->g, DFF, P->WdownT, DFF, 1024, P->f, DM, lds);
#endif
        }
        SYNC(ph);
    }
}

static size_t bump(size_t& off, size_t bytes) { size_t r = off; off += (bytes + 255) & ~(size_t)255; return r; }

extern "C" void kernel_launch(void* const* d_in, const int* in_sizes, int n_in, void* d_out, int out_size, void* d_ws, size_t ws_size, hipStream_t stream) {
    Params P; memset(&P, 0, sizeof(P));
    const float* const* in = (const float* const*)d_in;
    P.x_p = in[0]; P.x_s = in[1]; P.c_ckv = in[2]; P.c_kr = in[3]; P.c_sbk = in[4]; P.c_sbv = in[5]; P.c_conv = in[6]; P.c_p = in[7]; P.c_s = in[8];
    P.w_ada = in[9]; P.b_ada = in[10]; P.g_pre_mix = in[11]; P.g_post_mix = in[12]; P.g_pre_ffn = in[13]; P.g_post_ffn = in[14];
    const float* w_in = in[15]; const float* g_q = in[16]; const float* w_uq = in[17]; P.g_kv = in[18]; const float* w_uk = in[19]; const float* w_uv = in[20];
    const float* w_pa = in[21]; const float* w_pb = in[22]; const float* w_out = in[23]; const float* w_up = in[24]; P.conv_w = in[25]; P.conv_b = in[26]; const float* w_down = in[27];
    P.out = (float*)d_out;
    char* ws = (char*)d_ws; size_t off = 0;
    P.WupT = (bf16_t*)(ws + bump(off, (size_t)DFF2 * DM * 2));
    P.WdownT = (bf16_t*)(ws + bump(off, (size_t)DM * DFF * 2));
    P.ropeT = (float*)(ws + bump(off, (size_t)TP * 32 * 4));
    P.ada = (float*)(ws + bump(off, 10 * 6144 * 4));
    P.ctr = (unsigned*)(ws + bump(off, 256));
    P.bar = (unsigned*)(ws + bump(off, XCD_BAR_WORDS * 4));
    const size_t R0 = off;
    P.WinT = (bf16_t*)(ws + bump(off, (size_t)2304 * DM * 2));
    P.WgT = (bf16_t*)(ws + bump(off, (size_t)2048 * DM * 2));
    P.WuqT = (bf16_t*)(ws + bump(off, (size_t)768 * 384 * 2));
    P.WukvT = (bf16_t*)(ws + bump(off, (size_t)1024 * 256 * 2));
    P.WpaT = (bf16_t*)(ws + bump(off, (size_t)1024 * 512 * 2));
    P.WpbT = (bf16_t*)(ws + bump(off, (size_t)1024 * 512 * 2));
    P.WoutT = (bf16_t*)(ws + bump(off, (size_t)1024 * 1024 * 2));
    const size_t o_kva = off;
    P.kva = (bf16_t*)(ws + bump(off, (size_t)KVROWS_PAD * 512 * 2));
    P.vaT_p = (bf16_t*)(ws + bump(off, (size_t)2 * 512 * TP * 2));
    P.vaT_s = (bf16_t*)(ws + bump(off, (size_t)8 * 512 * SKP * 2));
    const size_t o_kb = off;
    P.kb = (bf16_t*)(ws + bump(off, (size_t)KVROWS_PAD * 512 * 2));
    const size_t o_vbT = off;
    P.vbT_p = (bf16_t*)(ws + bump(off, (size_t)2 * 512 * TP * 2));
    P.vbT_s = (bf16_t*)(ws + bump(off, (size_t)8 * 512 * SKP * 2));
    const size_t o_kr = off;
    P.krope = (bf16_t*)(ws + bump(off, (size_t)KVROWS_PAD * 32 * 2));
    P.qb = (bf16_t*)(ws + bump(off, (size_t)MT * 512 * 2));
    P.q = (bf16_t*)(ws + bump(off, (size_t)MT * 768 * 2));
    P.latent = (bf16_t*)(ws + bump(off, (size_t)KVROWS_PAD * 256 * 2));
    size_t need = off;
    P.gates = (bf16_t*)(ws + o_kva);
    P.merged = (bf16_t*)(ws + o_kb);
    P.m2 = (bf16_t*)(ws + o_vbT);
    const size_t o_g = R0 + (size_t)MT * DFF2 * 2;
    P.g = (bf16_t*)(ws + R0);
    P.f = (bf16_t*)(ws + R0 + (size_t)100 * 1024 * 1024);
    P.ub = (bf16_t*)(ws + R0 + (size_t)140 * 1024 * 1024);
    P.u = (bf16_t*)(ws + R0 + (size_t)155 * 1024 * 1024);
    size_t o_h2 = o_kr > o_g ? o_kr : o_g;
    P.h2 = (bf16_t*)(ws + o_h2);
    if (o_h2 + (size_t)MT * DM * 2 > need) need = o_h2 + (size_t)MT * DM * 2;
    P.h = (bf16_t*)d_out;
    P.o = (bf16_t*)d_out + (size_t)MT * DM;
    P.qlat = P.o;
    if (need > ws_size) { fprintf(stderr, "workspace too small: need %zu have %zu\n", need, ws_size); return; }

    int nj = 0, tiles = 0;
    auto job = [&](const float* src, int lds, int coff, bf16_t* dst, int ldd, int Klen, int Nlen, const float* ks, int zero) {
        TJob& J = P.tj[nj++]; J.src = src; J.kscale = ks; J.dst = dst; J.lds = lds; J.coff = coff; J.ldd = ldd; J.Klen = Klen; J.Nlen = Nlen; J.zero = zero; J.tile0 = tiles; J.pad = 0;
        tiles += (Klen / 64) * ((Nlen + 255) / 256); };
    job(w_up, DFF2, 0, P.WupT, DM, DM, DFF2, nullptr, 2);
    job(w_down, DM, 0, P.WdownT, DFF, DFF, DM, nullptr, 0);
    job(w_in, 4256, 0, P.WinT, DM, DM, 384, nullptr, 0);
    job(w_in, 4256, 640, P.WinT + (size_t)384 * DM, DM, DM, 32, nullptr, 0);
    job(w_in, 4256, 0, P.WinT + (size_t)416 * DM, DM, DM, 96, nullptr, 1);
    job(w_in, 4256, 384, P.WinT + (size_t)512 * DM, DM, DM, 256, nullptr, 0);
    job(w_in, 4256, 672, P.WinT + (size_t)768 * DM, DM, DM, 1536, nullptr, 0);
    job(w_in, 4256, 2208, P.WgT, DM, DM, 2048, nullptr, 0);
    job(w_uq, 768, 0, P.WuqT, 384, 384, 768, g_q, 0);
    job(w_uk, 512, 0, P.WukvT, 256, 256, 512, nullptr, 0);
    job(w_uv, 512, 0, P.WukvT + (size_t)512 * 256, 256, 256, 512, nullptr, 0);
    job(w_pa, DM, 0, P.WpaT, 512, 512, DM, nullptr, 0);
    job(w_pb, DM, 0, P.WpbT, 512, 512, DM, nullptr, 0);
    job(w_out, DM, 0, P.WoutT, DM, DM, DM, nullptr, 0);
    P.ntj_tiles = tiles; P.pad0 = nj;
    for (int q = nj; q < NTJ; ++q) P.tj[q].tile0 = 0x7fffffff;
    P.phase_lo = 0; P.phase_hi = 13;

    static int grid_blocks = 0;
    if (!grid_blocks) {
        (void)hipFuncSetAttribute((const void*)fwd_megakernel, hipFuncAttributeMaxDynamicSharedMemorySize, LDS_BYTES);
        int dev = 0, cus = 0, per_cu = 0;
        (void)hipGetDevice(&dev);
        (void)hipDeviceGetAttribute(&cus, hipDeviceAttributeMultiprocessorCount, dev);
        (void)hipOccupancyMaxActiveBlocksPerMultiprocessor(&per_cu, fwd_megakernel, NTHREADS, LDS_BYTES);
        if (per_cu > 1) per_cu = 1;
        grid_blocks = cus * per_cu;
    }
    (void)hipMemsetAsync(P.ctr, 0, 256 + XCD_BAR_WORDS * 4, stream);
    void* args[] = {&P};
    hipError_t e = hipLaunchCooperativeKernel((const void*)fwd_megakernel, dim3(grid_blocks), dim3(NTHREADS), args, LDS_BYTES, stream);
    if (e != hipSuccess) fprintf(stderr, "cooperative launch failed: %s (grid %d)\n", hipGetErrorString(e), grid_blocks);
}
```

```cpp
#include <hip/hip_runtime.h>
#include <hip/hip_cooperative_groups.h>
#include <stdint.h>
#include <stdio.h>
#include <string.h>
namespace cg = cooperative_groups;

typedef unsigned short bf16_t;
typedef short bf16x8 __attribute__((ext_vector_type(8)));
typedef short s16x4 __attribute__((ext_vector_type(4)));
typedef float f32x2 __attribute__((ext_vector_type(2)));
typedef float f32x4 __attribute__((ext_vector_type(4)));
typedef float f32x16 __attribute__((ext_vector_type(16)));
typedef unsigned u32x2 __attribute__((ext_vector_type(2)));
typedef unsigned u32x4 __attribute__((ext_vector_type(4)));
typedef __bf16 bf2_t __attribute__((ext_vector_type(2)));
#define DI __device__ __forceinline__

constexpr int DM = 1024, TP = 8192, MP = 16384, MS = 256, MT = 16640, PAST = 4096, SKEYS = 4128, SKP = 4160;
constexpr int KVROWS = MP + 8 * SKEYS;
constexpr int KVROWS_PAD = KVROWS + 64;
constexpr int DFF = 2816, DFF2 = 5632;
constexpr float EPS = 1e-6f;
constexpr float LOG2E = 1.4426950408889634f, LN2 = 0.6931471805599453f;
constexpr int NTHREADS = 512;
constexpr int LDS_BYTES = 131072 + 8192;
constexpr long O_Y = 0, O_CKV_P = 17039360, O_KR_P = 21233664, O_SBK_P = 21757952, O_SBV_P = 30146560, O_CONV_P = 38535168,
               O_CKV_S = 38557696, O_KR_S = 38623232, O_SBK_S = 38631424, O_SBV_S = 38762496, O_CONV_S = 38893568;

struct TJob { const float* src; const float* kscale; bf16_t* dst; int lds, coff, ldd, Klen, Nlen, zero, tile0, pad; };
constexpr int NTJ = 22;

struct Params {
    const float *x_p, *x_s, *c_ckv, *c_kr, *c_sbk, *c_sbv, *c_conv, *c_p, *c_s;
    const float *w_ada, *b_ada, *g_pre_mix, *g_post_mix, *g_pre_ffn, *g_post_ffn, *g_kv, *conv_w, *conv_b;
    float* out;
    bf16_t *WupT, *WdownT, *WinT, *WgT, *WuqT, *WukvT, *WpaT, *WpbT, *WoutT;
    float* ropeT; float* ada; unsigned* ctr; unsigned* bar;
    bf16_t *h, *o, *qlat, *latent, *krope, *kb, *vbT_p, *vbT_s, *qb, *q, *kva, *vaT_p, *vaT_s, *gates, *merged, *m2, *h2, *u, *g, *f, *ub;
    TJob tj[NTJ]; int ntj_tiles; int phase_lo, phase_hi, pad0;
};

#define LAS __attribute__((address_space(3)))
typedef const Params __attribute__((address_space(4))) * KP;
DI KP kparams() { KP p = (KP)__builtin_amdgcn_kernarg_segment_ptr(); asm volatile("" : "+s"(p)); return p; }
DI int otid() { int t = threadIdx.x; asm volatile("" : "+v"(t)); return t; }
DI int obid() { int b = blockIdx.x; asm volatile("" : "+s"(b)); return b; }
DI int ogrid() { int g = gridDim.x; asm volatile("" : "+s"(g)); return g; }
DI unsigned pk2(float a, float b) { f32x2 f = {a, b}; bf2_t r = __builtin_convertvector(f, bf2_t); return __builtin_bit_cast(unsigned, r); }
DI float bf_lo(unsigned u) { return __uint_as_float(u << 16); }
DI float bf_hi(unsigned u) { return __uint_as_float(u & 0xffff0000u); }
DI int kvrow_of(int row) { if (row < MP) return row; const int r = row - MP; return MP + (r >> 5) * SKEYS + PAST + (r & 31); }
DI int pos_of(int row) { return row < MP ? (row & (TP - 1)) : PAST + ((row - MP) & 31); }
DI int ada_b(int row) { return row < MP ? (row >> 13) : 2 + ((row - MP) >> 5); }
DI float sigmoidf_(float x) { return __builtin_amdgcn_rcpf(1.0f + __builtin_amdgcn_exp2f(-1.4426950408889634f * x)); }

constexpr int BM = 256, BK = 64, HALF = 128, HT = HALF * BK;
DI int lds_byte(int r, int c) { int st = (r >> 4) * 2 + (c >> 5), rr = r & 15, cc = c & 31, ob = rr * 64 + cc * 2; return st * 1024 + (ob ^ (((ob >> 9) & 1) << 5)); }
DI void stage_rc(int b, int& R, int& C) { int st = b / 1024, sb = b % 1024, swz = sb ^ (((sb >> 9) & 1) << 5); R = (st >> 1) * 16 + swz / 64; C = (st & 1) * 32 + (swz % 64) / 2; }

enum { E_INPROJ = 0, E_GATE, E_UQ, E_UKV, E_PROJA, E_PROJB, E_PLAIN, E_UP };
struct GemmDesc { const bf16_t* A; const bf16_t* Bt; bf16_t* C; int lda, ldb, ldc, K, nM, nN, epi, start; };

constexpr int HTB = HT * 2;
#define SA(b, h) (((b) * 2 + (h)) * HTB)
#define SB(b, h) ((4 + (b) * 2 + (h)) * HTB)
#define STAGE(bufoff, gbase, voff) do { _Pragma("unroll") for (int _i = 0; _i < 2; ++_i) \
    __builtin_amdgcn_global_load_lds((const unsigned*)((const char*)(gbase) + (voff)[_i]), (LAS unsigned*)(ldsl + (bufoff) + ldsw + _i * 8192), 16, 0, 0); } while (0)
#define LDA(dst, b, h) do { _Pragma("unroll") for (int m = 0; m < 4; ++m) _Pragma("unroll") for (int k = 0; k < 2; ++k) dst[m][k] = *(const LAS bf16x8*)(ldsl + SA(b, h) + aoff + m * 2048 + k * 1024); } while (0)
#define LDB(dst, b, h) do { _Pragma("unroll") for (int n = 0; n < 2; ++n) _Pragma("unroll") for (int k = 0; k < 2; ++k) dst[n][k] = *(const LAS bf16x8*)(ldsl + SB(b, h) + boff + n * 2048 + k * 1024); } while (0)
#define MMA(ai, bj, At, Bt_) do { __builtin_amdgcn_s_setprio(1); _Pragma("unroll") for (int m = 0; m < 4; ++m) _Pragma("unroll") for (int n = 0; n < 2; ++n) _Pragma("unroll") for (int k = 0; k < 2; ++k) \
      acc[ai][bj][m][n] = __builtin_amdgcn_mfma_f32_16x16x32_bf16(Bt_[n][k], At[m][k], acc[ai][bj][m][n], 0, 0, 0); \
    __builtin_amdgcn_s_setprio(0); } while (0)
#define WAIT_V(n) asm volatile("s_waitcnt vmcnt(" #n ")" ::: "memory")
#define WAIT_L(n) asm volatile("s_waitcnt lgkmcnt(" #n ")" ::: "memory")
#define BAR __builtin_amdgcn_s_barrier()
#define SCHED __builtin_amdgcn_sched_barrier(0)
#define ZERO_ACC do { _Pragma("unroll") for (int a_ = 0; a_ < 2; ++a_) _Pragma("unroll") for (int b_ = 0; b_ < 2; ++b_) _Pragma("unroll") for (int m_ = 0; m_ < 4; ++m_) _Pragma("unroll") for (int n_ = 0; n_ < 2; ++n_) \
    acc[a_][b_][m_][n_] = (f32x4){0.f, 0.f, 0.f, 0.f}; } while (0)

#define EPI_ROWS for (int ai = 0; ai < 2; ++ai) for (int m = 0; m < 4; ++m, ({ asm volatile("" ::: "memory"); }))
#define EPI_COLS for (int bj = 0; bj < 2; ++bj) for (int n = 0; n < 2; ++n)

DI float dpp_xor1(float x) { return __int_as_float(__builtin_amdgcn_mov_dpp(__float_as_int(x), 0xB1, 0xF, 0xF, true)); }
DI float dpp_xor2(float x) { return __int_as_float(__builtin_amdgcn_mov_dpp(__float_as_int(x), 0x4E, 0xF, 0xF, true)); }
DI float gelu_tanh(float a) { const float a2 = a * a; const float q = a * __builtin_fmaf(0.10294324f, a2, 2.3022082f);
    const float e = __builtin_amdgcn_exp2f(q); const float r = __builtin_amdgcn_rcpf(1.0f + e); return __builtin_fmaf(-a, r, a); }
DI float dpp_ror1(float x) { return __int_as_float(__builtin_amdgcn_mov_dpp(__float_as_int(x), 0x121, 0xF, 0xF, true)); }
DI float dpp_ror2(float x) { return __int_as_float(__builtin_amdgcn_mov_dpp(__float_as_int(x), 0x122, 0xF, 0xF, true)); }
DI f32x4 ror1_4(f32x4 v) { return (f32x4){dpp_ror1(v[0]), dpp_ror1(v[1]), dpp_ror1(v[2]), dpp_ror1(v[3])}; }
DI f32x4 ror2_4(f32x4 v) { return (f32x4){dpp_ror2(v[0]), dpp_ror2(v[1]), dpp_ror2(v[2]), dpp_ror2(v[3])}; }
DI f32x4 quad_transpose(f32x4 v, int i) {
    { const float a = (i & 1) ? v[0] : v[1], c = (i & 1) ? v[2] : v[3]; const float ra = dpp_xor1(a), rc = dpp_xor1(c);
      if (i & 1) { v[0] = ra; v[2] = rc; } else { v[1] = ra; v[3] = rc; } }
    { const float a = (i & 2) ? v[0] : v[2], c = (i & 2) ? v[1] : v[3]; const float ra = dpp_xor2(a), rc = dpp_xor2(c);
      if (i & 2) { v[0] = ra; v[1] = rc; } else { v[2] = ra; v[3] = rc; } }
    return v;
}
DI void store_bf4(bf16_t* p, f32x4 v) { u32x2 w; w.x = pk2(v[0], v[1]); w.y = pk2(v[2], v[3]); *(u32x2*)p = w; }

DI int unit_at(int k, int bid, int G, int nM, int nN, int start) {
    if (G != 256) { const int u = (bid + G - (start % G)) % G + k * G; return u < nM * nN ? u : -1; }
    const int x = bid & 7, l = ((bid >> 3) + start) & 31, cnt = nM >> 3, mainn = cnt * nN, j = l + 32 * k;
    if (j < mainn) { const int pn = j / cnt, rm = j - pn * cnt; return (x + 8 * rm) * nN + pn; }
    const int idx = x + 8 * (j - mainn);
    if (idx < (nM & 7) * nN) return (8 * cnt + idx / nN) * nN + idx % nN;
    return -1;
}

DI void gemm_run(const GemmDesc& d, char* lds) {
    LAS char* ldsl = (LAS char*)lds;
    float* xl = (float*)(lds + 131072);
    float* xp = (float*)(lds + 131072 + 4096);
    const int G = ogrid(), bid_ = obid(), first = unit_at(0, bid_, G, d.nM, d.nN, d.start);
    if (first < 0) return;
    int kun = 0;
    const int tid = otid(), wid = __builtin_amdgcn_readfirstlane(tid >> 6), wr = wid >> 2, wc = wid & 3;
    const unsigned lda2 = (unsigned)d.lda * 2u, ldb2 = (unsigned)d.ldb * 2u;
    unsigned voffA[2], voffB[2];
    { const int lane = tid & 63;
#pragma unroll
      for (int i = 0; i < 2; ++i) { int R, C; stage_rc(tid * 16 + i * 8192, R, C); voffA[i] = (unsigned)R * lda2 + (unsigned)C * 2u; voffB[i] = (unsigned)R * ldb2 + (unsigned)C * 2u; }
      (void)lane; }
    const size_t kstep = 128, hA = (size_t)HALF * lda2, hB = (size_t)HALF * ldb2;
    const unsigned ldsw = (unsigned)wid * 1024u;
    const int aoff = lds_byte(wr * 64 + (tid & 15), ((tid & 63) >> 4) * 8), boff = lds_byte(wc * 32 + (tid & 15), ((tid & 63) >> 4) * 8);
    const int nt = d.K / BK;
    int u = first;
    const char* cA = (const char*)d.A + (size_t)(u / d.nN) * 2 * hA; const char* cB = (const char*)d.Bt + (size_t)(u % d.nN) * 2 * hB;
    f32x4 acc[2][2][4][2];
    ZERO_ACC;
    bf16x8 At[4][2], B0[2][2], B1[2][2];
    STAGE(SB(0, 0), cB, voffB); STAGE(SB(0, 1), cB + hB, voffB); STAGE(SA(0, 0), cA, voffA); STAGE(SA(0, 1), cA + hA, voffA);
    if (wr == 1) BAR;
    WAIT_V(2); BAR;
    STAGE(SB(1, 0), cB + kstep, voffB); STAGE(SA(1, 0), cA + kstep, voffA); STAGE(SB(1, 1), cB + hB + kstep, voffB);
    WAIT_V(6); BAR;
    for (;;) {
        const int un = unit_at(kun + 1, bid_, G, d.nM, d.nN, d.start); const bool has_next = un >= 0;
        const char* nA = has_next ? (const char*)d.A + (size_t)(un / d.nN) * 2 * hA : cA; const char* nB = has_next ? (const char*)d.Bt + (size_t)(un % d.nN) * 2 * hB : cB;
        for (int t = 0; t < nt; t += 2) {
            const bool last = (t == nt - 2);
            const char* a1 = cA + (size_t)(t + 1) * kstep;
            const char* a2 = last ? nA : cA + (size_t)(t + 2) * kstep; const char* b2 = last ? nB : cB + (size_t)(t + 2) * kstep;
            const char* a3 = a2 + kstep; const char* b3 = b2 + kstep;
            LDB(B0, 0, 0); LDB(B1, 0, 1); SCHED; LDA(At, 0, 0); STAGE(SA(1, 1), a1 + hA, voffA);
            WAIT_V(8); WAIT_L(0); BAR; MMA(0, 0, At, B0); MMA(0, 1, At, B1); BAR; SCHED;
            LDA(At, 0, 1); STAGE(SB(0, 0), b2, voffB); STAGE(SB(0, 1), b2 + hB, voffB); STAGE(SA(0, 0), a2, voffA);
            WAIT_V(8); WAIT_L(0); BAR; MMA(1, 0, At, B0); MMA(1, 1, At, B1); BAR; SCHED;
            LDB(B0, 1, 0); LDB(B1, 1, 1); SCHED; LDA(At, 1, 0); STAGE(SA(0, 1), a2 + hA, voffA);
            WAIT_V(8); WAIT_L(0); BAR; MMA(0, 0, At, B0); MMA(0, 1, At, B1); BAR; SCHED;
            LDA(At, 1, 1); STAGE(SB(1, 0), b3, voffB); STAGE(SB(1, 1), b3 + hB, voffB); STAGE(SA(1, 0), a3, voffA);
            WAIT_V(8); WAIT_L(0); BAR; MMA(1, 0, At, B0); MMA(1, 1, At, B1); BAR; SCHED;
        }
        if (wr == 0) BAR;
        {
        const int pm = u / d.nN, pn = u % d.nN, brow = pm * BM, bcol = pn * BM;
        if (d.epi == E_UQ) {
            const int tq_ = otid(), r = tq_ >> 1, hf = tq_ & 1;
            const u32x4* src = (const u32x4*)(d.A + (long)(brow + r) * 384 + hf * 192);
            float sq = 0.f;
#pragma unroll 4
            for (int i = 0; i < 24; ++i) { u32x4 v = src[i];
                for (int e = 0; e < 4; ++e) { float a_ = bf_lo(v[e]), b_ = bf_hi(v[e]); sq += a_ * a_ + b_ * b_; } }
            sq += __shfl_xor(sq, 1);
            if (hf == 0) xl[r] = rsqrtf(sq * (1.0f / 384.0f) + EPS);
            WAIT_L(0); BAR; asm volatile("" ::: "memory");
        }
        int lane_e = threadIdx.x & 63; asm volatile("" : "+v"(lane_e));
        const int fr = lane_e & 15, fq = lane_e >> 4;
        KP P = kparams();
        const int rbase = brow + wr * 64 + fr, cbase = bcol + wc * 32 + fq * 4;
        switch (d.epi) {
        case E_INPROJ: {
            if (pn == 0) {
#pragma unroll
                EPI_ROWS { const int row = rbase + ai * 128 + m * 16;
#pragma unroll
                    EPI_COLS store_bf4(P->qlat + (long)row * 384 + (cbase + bj * 128 + n * 16), acc[ai][bj][m][n]); }
            } else if (pn == 1) {
#pragma unroll
                EPI_ROWS { const int row = rbase + ai * 128 + m * 16;
#pragma unroll
                    for (int n = 0; n < 2; ++n) store_bf4(P->qlat + (long)row * 384 + 256 + (wc * 32 + fq * 4 + n * 16), acc[ai][0][m][n]);
                    if (wc == 0) {
                        const int pos = pos_of(row);
                        const f32x4 cs0 = *(const f32x4*)(P->ropeT + (long)pos * 32 + fq * 8), cs1 = *(const f32x4*)(P->ropeT + (long)pos * 32 + fq * 8 + 4);
                        const f32x4 x1 = acc[ai][1][m][0], x2 = acc[ai][1][m][1];
                        f32x4 co = {cs0[0], cs0[2], cs1[0], cs1[2]}, si = {cs0[1], cs0[3], cs1[1], cs1[3]};
                        f32x4 o1 = x1 * co - x2 * si, o2 = x2 * co + x1 * si;
                        float* of = P->out + (row < MP ? O_KR_P + (long)row * 32 : O_KR_S + (long)(row - MP) * 32);
                        *(f32x4*)(of + fq * 4) = o1; *(f32x4*)(of + 16 + fq * 4) = o2;
                        bf16_t* ob = P->krope + (long)kvrow_of(row) * 32;
                        store_bf4(ob + fq * 4, o1); store_bf4(ob + 16 + fq * 4, o2);
                    } }
            } else if (pn == 2) {
                float ss[2][4];
#pragma unroll
                EPI_ROWS { float s = 0.f;
#pragma unroll
                    EPI_COLS { const f32x4 v = acc[ai][bj][m][n]; s += v[0] * v[0] + v[1] * v[1] + v[2] * v[2] + v[3] * v[3]; }
                    s += __shfl_xor(s, 16); s += __shfl_xor(s, 32); ss[ai][m] = s;
                    if (fq == 0) xp[(ai * 128 + wr * 64 + m * 16 + fr) * 4 + wc] = s; }
                WAIT_L(0); BAR; asm volatile("" ::: "memory");
#pragma unroll
                EPI_ROWS { const int rl = ai * 128 + wr * 64 + m * 16 + fr, row = brow + rl;
                    const f32x4 pp = *(const f32x4*)(xp + rl * 4);
                    const float rstd = rsqrtf((pp[0] + pp[1] + pp[2] + pp[3]) * (1.0f / 256.0f) + EPS);
                    float* of = P->out + (row < MP ? O_CKV_P + (long)row * 256 : O_CKV_S + (long)(row - MP) * 256);
                    bf16_t* ob = P->latent + (long)kvrow_of(row) * 256;
#pragma unroll
                    EPI_COLS { const int c = wc * 32 + fq * 4 + bj * 128 + n * 16;
                        const f32x4 gv = *(const f32x4*)(P->g_kv + c); const f32x4 o = acc[ai][bj][m][n] * rstd * gv;
                        *(f32x4*)(of + c) = o; store_bf4(ob + c, o); } }
            } else if (pn <= 4) {
#pragma unroll
                EPI_ROWS { const int row = rbase + ai * 128 + m * 16;
#pragma unroll
                    EPI_COLS store_bf4(P->qb + (long)row * 512 + (cbase - 768 + bj * 128 + n * 16), acc[ai][bj][m][n] * 0.125f); }
            } else if (pn <= 6) {
#pragma unroll
                EPI_ROWS { const int row = rbase + ai * 128 + m * 16;
                    float* of = P->out + (row < MP ? O_SBK_P + (long)row * 512 : O_SBK_S + (long)(row - MP) * 512);
                    bf16_t* ob = P->kb + (long)kvrow_of(row) * 512;
#pragma unroll
                    EPI_COLS { const int c = cbase - 1280 + bj * 128 + n * 16; *(f32x4*)(of + c) = acc[ai][bj][m][n]; store_bf4(ob + c, acc[ai][bj][m][n]); } }
            } else {
#pragma unroll
                EPI_ROWS { const int row = rbase + ai * 128 + m * 16;
                    float* of = P->out + (row < MP ? O_SBV_P + (long)row * 512 : O_SBV_S + (long)(row - MP) * 512);
                    const int qi = fr & 3, row4 = row - qi;
                    bf16_t* vt; int ldv;
                    if (row4 < MP) { vt = P->vbT_p + (long)(row4 >> 13) * 512 * TP + (row4 & (TP - 1)); ldv = TP; }
                    else { const int r = row4 - MP; vt = P->vbT_s + (long)(r >> 5) * 512 * SKP + PAST + (r & 31); ldv = SKP; }
#pragma unroll
                    EPI_COLS { const int c = cbase - 1792 + bj * 128 + n * 16; const f32x4 v = acc[ai][bj][m][n]; *(f32x4*)(of + c) = v;
                        store_bf4(vt + (long)(c + qi) * ldv, quad_transpose(v, qi)); } }
            }
        } break;
        case E_GATE: {
#pragma unroll
            EPI_ROWS { const int row = rbase + ai * 128 + m * 16;
#pragma unroll
                EPI_COLS { const f32x4 v = acc[ai][bj][m][n]; f32x4 s = {sigmoidf_(v[0]), sigmoidf_(v[1]), sigmoidf_(v[2]), sigmoidf_(v[3])};
                    store_bf4(P->gates + (long)row * 2048 + (cbase + bj * 128 + n * 16), s); } }
        } break;
        case E_UQ: {
            const float qs = 0.10206207261596577f * LOG2E;
#pragma unroll
            EPI_ROWS { const int rl = ai * 128 + wr * 64 + m * 16 + fr, row = brow + rl; const float rs = xl[rl] * qs;
#pragma unroll
                for (int bj = 0; bj < 2; ++bj) { const int grp = pn * 8 + bj * 4 + wc; bf16_t* dst = P->q + (long)row * 768 + grp * 32 + fq * 4;
                    f32x4 v0 = acc[ai][bj][m][0] * rs, v1 = acc[ai][bj][m][1] * rs;
                    if (grp % 3 == 2) {
                        const int pos = pos_of(row);
                        const f32x4 cs0 = *(const f32x4*)(P->ropeT + (long)pos * 32 + fq * 8), cs1 = *(const f32x4*)(P->ropeT + (long)pos * 32 + fq * 8 + 4);
                        f32x4 co = {cs0[0], cs0[2], cs1[0], cs1[2]}, si = {cs0[1], cs0[3], cs1[1], cs1[3]};
                        const f32x4 o1 = v0 * co - v1 * si, o2 = v1 * co + v0 * si; v0 = o1; v1 = o2;
                    }
                    store_bf4(dst, v0); store_bf4(dst + 16, v1); } }
        } break;
        case E_UKV: {
#pragma unroll
            EPI_ROWS { const int row = rbase + ai * 128 + m * 16;
                if (pn < 2) {
#pragma unroll
                    EPI_COLS store_bf4(P->kva + (long)row * 512 + (cbase + bj * 128 + n * 16), acc[ai][bj][m][n]);
                } else {
                    const int qi = fr & 3, row4 = row - qi;
                    bf16_t* vt; int ldv;
                    if (row4 < MP) { vt = P->vaT_p + (long)(row4 >> 13) * 512 * TP + (row4 & (TP - 1)); ldv = TP; }
                    else { const int r = row4 - MP, b = r / SKEYS; vt = P->vaT_s + (long)b * 512 * SKP + (r - b * SKEYS); ldv = SKP; }
#pragma unroll
                    EPI_COLS { const int c = cbase - 512 + bj * 128 + n * 16; const f32x4 vtr = quad_transpose(acc[ai][bj][m][n], qi);
                        if (row4 < KVROWS) store_bf4(vt + (long)(c + qi) * ldv, vtr); }
                } }
        } break;
        case E_PROJA: case E_PROJB: {
            const int goff = d.epi == E_PROJA ? 0 : 1024;
#pragma unroll
            EPI_ROWS { const int row = rbase + ai * 128 + m * 16;
#pragma unroll
                EPI_COLS { const int c = cbase + bj * 128 + n * 16; const u32x2 gw = *(const u32x2*)(P->gates + (long)row * 2048 + goff + c);
                    f32x4 gv = {bf_lo(gw.x), bf_hi(gw.x), bf_lo(gw.y), bf_hi(gw.y)}; f32x4 v = acc[ai][bj][m][n] * gv;
                    bf16_t* dst = P->merged + (long)row * 1024 + c;
                    if (d.epi == E_PROJB) { const u32x2 pw = *(const u32x2*)dst; f32x4 pv = {bf_lo(pw.x), bf_hi(pw.x), bf_lo(pw.y), bf_hi(pw.y)}; v += pv; }
                    store_bf4(dst, v); } }
        } break;
        case E_PLAIN: {
#pragma unroll
            EPI_ROWS { const int row = rbase + ai * 128 + m * 16;
#pragma unroll
                EPI_COLS store_bf4(d.C + (long)row * d.ldc + (cbase + bj * 128 + n * 16), acc[ai][bj][m][n]); }
        } break;
        case E_UP: {
            const int jc0 = pn * 128 + wc * 32 + fq * 4;
            if (pm != 64) {
                const int tq_ = otid(), arr = tq_ >> 6, c2 = (tq_ & 63) * 2, hfb = arr >> 2, kk = arr & 3;
                const float* src = (kk < 3 ? P->conv_w + kk * DFF2 : P->conv_b) + hfb * DFF + pn * 128 + c2;
                *(f32x2*)(xp + arr * 128 + c2) = *(const f32x2*)src;
                WAIT_L(0); BAR; asm volatile("" ::: "memory");
            }
            if (pm == 64) {
#pragma unroll
                EPI_ROWS { const int row = rbase + ai * 128 + m * 16, r = row - MP, t = r & 31;
                    float* cf = t >= 30 ? P->out + O_CONV_S + (long)((r >> 5) * 2 + (t - 30)) * DFF2 : nullptr;
#pragma unroll
                    EPI_COLS { const int c = (bj ? DFF : 0) + jc0 + n * 16; store_bf4(P->u + (long)r * DFF2 + c, acc[ai][bj][m][n]); if (cf) *(f32x4*)(cf + c) = acc[ai][bj][m][n]; } }
            } else {
#pragma unroll
                for (int ai = 0; ai < 2; ++ai)
#pragma unroll
                    for (int n = 0; n < 2; ++n) {
                        const int ca = jc0 + n * 16;
                        f32x4 pa1 = {0.f, 0.f, 0.f, 0.f}, pa2 = pa1, pb1 = pa1, pb2 = pa1;
#pragma unroll
                        for (int m = 0; m < 4; ++m) {
                            const int row = rbase + ai * 128 + m * 16;
                            const f32x4 va = acc[ai][0][m][n], vb = acc[ai][1][m][n];
                            const f32x4 ra1 = ror1_4(va), ra2 = ror2_4(va), rb1 = ror1_4(vb), rb2 = ror2_4(vb);
                            const f32x4 p1a = fr >= 1 ? ra1 : pa1, p2a = fr >= 2 ? ra2 : pa2, p1b = fr >= 1 ? rb1 : pb1, p2b = fr >= 2 ? rb2 : pb2;
                            const float* wl = xp + (ca - pn * 128);
                            f32x4 ya = *(const f32x4*)(wl + 3 * 128) + *(const f32x4*)(wl) * p2a; ya += *(const f32x4*)(wl + 128) * p1a; ya += *(const f32x4*)(wl + 2 * 128) * va;
                            f32x4 yb = *(const f32x4*)(wl + 7 * 128) + *(const f32x4*)(wl + 4 * 128) * p2b; yb += *(const f32x4*)(wl + 5 * 128) * p1b; yb += *(const f32x4*)(wl + 6 * 128) * vb;
                            const f32x4 g4 = {gelu_tanh(ya[0]) * yb[0], gelu_tanh(ya[1]) * yb[1], gelu_tanh(ya[2]) * yb[2], gelu_tanh(ya[3]) * yb[3]};
                            if (!(m == 0 && fr < 2)) store_bf4(P->g + (long)row * DFF + ca, g4);
                            const int blk = row >> 6;
                            if (m == 0 && fr < 2) { bf16_t* up = P->ub + (long)(blk * 4 + 2 + fr) * DFF2 + ca; store_bf4(up, va); store_bf4(up + DFF, vb); }
                            if (m == 3 && fr >= 14) { bf16_t* up = P->ub + (long)(blk * 4 + (fr - 14)) * DFF2 + ca; store_bf4(up, va); store_bf4(up + DFF, vb);
                                const int t = row & (TP - 1);
                                if (t >= TP - 2) { float* cf = P->out + O_CONV_P + (long)((row >> 13) * 2 + (t - (TP - 2))) * DFF2 + ca; *(f32x4*)cf = va; *(f32x4*)(cf + DFF) = vb; } }
                            pa1 = ra1; pa2 = ra2; pb1 = rb1; pb2 = rb2;
                            asm volatile("" ::: "memory");
                        }
                    }
            }
        } break;
        }
        }
        if (!has_next) break;
        ZERO_ACC;
        u = un; cA = nA; cB = nB; ++kun;
        if (wr == 1) BAR;
    }
    WAIT_V(0);
    BAR;
}

#define MFMA32(a, b, c) __builtin_amdgcn_mfma_f32_32x32x16_bf16((a), (b), (c), 0, 0, 0)
template <int KIND, int KSTEPS  >
DI void gemm_small(KP P, const bf16_t* A, int lda, const bf16_t* Bt, int ldb, int N, bf16_t* C, int ldc, char* lds) {
    const int tid = otid(), lane = tid & 63, w = tid >> 6, r = lane & 31, hh = lane >> 5, G = ogrid();
    const int ntask = 8 * (N >> 5);
    float* part = (float*)lds;
    for (int task = obid(); task < ntask; task += G) {
        const int cb = (task & 7) + 8 * (task >> 6), rb = (task >> 3) & 7, row0 = MP + rb * 32, col0 = cb * 32;
#pragma unroll
        for (int pass = 0; pass < (KIND == 2 ? 2 : 1); ++pass) {
            const bf16_t* ap = A + pass * 512 + (long)(row0 + r) * lda + w * (KSTEPS * 16) + 8 * hh;
            const bf16_t* bp = (pass ? P->WpbT : Bt) + (long)(col0 + r) * ldb + w * (KSTEPS * 16) + 8 * hh;
            f32x16 acc;
#pragma unroll
            for (int i = 0; i < 16; ++i) acc[i] = 0.f;
            constexpr int UN = KSTEPS > 11 ? 11 : KSTEPS;
#pragma unroll 1
            for (int s0 = 0; s0 < KSTEPS; s0 += UN) {
                bf16x8 af[UN], bf[UN];
#pragma unroll
                for (int s = 0; s < UN; ++s) { af[s] = *(const bf16x8*)(ap + (s0 + s) * 16); bf[s] = *(const bf16x8*)(bp + (s0 + s) * 16); }
#pragma unroll
                for (int s = 0; s < UN; ++s) acc = MFMA32(bf[s], af[s], acc);
            }
            float* pp = part + ((pass * 8 + w) * 32 + r) * 32 + 4 * hh;
#pragma unroll
            for (int g = 0; g < 4; ++g) *(f32x4*)(pp + 8 * g) = (f32x4){acc[4 * g], acc[4 * g + 1], acc[4 * g + 2], acc[4 * g + 3]};
        }
        __syncthreads();
        {
            const int e = tid * 2, rr = e >> 5, cc = e & 31;
            f32x2 s1 = {0.f, 0.f}, s2 = {0.f, 0.f};
#pragma unroll
            for (int ww = 0; ww < 8; ++ww) { s1 += *(const f32x2*)(part + (ww * 32 + rr) * 32 + cc); if (KIND == 2) s2 += *(const f32x2*)(part + ((8 + ww) * 32 + rr) * 32 + cc); }
            const long row = row0 + rr; const int col = col0 + cc;
            if (KIND == 1) { s1[0] = sigmoidf_(s1[0]); s1[1] = sigmoidf_(s1[1]); }
            if (KIND == 2) { const unsigned ga = *(const unsigned*)(P->gates + row * 2048 + col), gb = *(const unsigned*)(P->gates + row * 2048 + 1024 + col);
                s1[0] = s1[0] * bf_lo(ga) + s2[0] * bf_lo(gb); s1[1] = s1[1] * bf_hi(ga) + s2[1] * bf_hi(gb); }
            *(unsigned*)(C + row * ldc + col) = pk2(s1[0], s1[1]);
        }
        __syncthreads();
    }
}

DI int crow(int i, int h) { return (i & 3) + 8 * (i >> 2) + 4 * h; }

template <int MODE>
DI void attn_unit(KP P, char* lds, bool sample, int b, int h, int ublk) {
    constexpr int DQK = MODE == 0 ? 96 : 64, KS = DQK * 2 + 16, VS = 144, NS = DQK / 16;
    constexpr int KBYTES = 64 * KS, BUF = KBYTES + 64 * VS;
    const int tid = otid(), w = tid >> 6, lane = tid & 63, ql = lane & 31, hh = lane >> 5;
    const int kvrow0 = sample ? MP + b * SKEYS : b * TP;
    const int qrow0 = sample ? MP + b * 32 : b * TP + ublk * 256;
    const int ntiles = sample ? 65 : 4 * (ublk + 1);
    const int t0 = sample ? 0 : ublk * 256 + w * 32, tq = t0 + ql;
    int klim, wmax, wmin;
    if (MODE == 0) { if (sample) { klim = wmax = wmin = SKEYS; } else { klim = ((tq >> 6) + 1) << 6; wmax = (((t0 + 31) >> 6) + 1) << 6; wmin = ((t0 >> 6) + 1) << 6; } }
    else { if (sample) { klim = PAST + tq; wmax = PAST + 31; wmin = PAST; } else { klim = tq; wmax = t0 + 31; wmin = t0; } }
    const bool wactive = sample ? (w == 0) : true;
    const bf16_t* Kp; const bf16_t* Qp; const bf16_t* VT; int ldq; long ldv;
    if (MODE == 0) { Kp = P->kva + (long)kvrow0 * 512 + h * 64; Qp = P->q + (long)qrow0 * 768 + h * 96; ldq = 768;
        VT = sample ? P->vaT_s + (long)(b * 512 + h * 64) * SKP : P->vaT_p + (long)(b * 512 + h * 64) * TP; }
    else { Kp = P->kb + (long)kvrow0 * 512 + h * 64; Qp = P->qb + (long)qrow0 * 512 + h * 64; ldq = 512;
        VT = sample ? P->vbT_s + (long)(b * 512 + h * 64) * SKP : P->vbT_p + (long)(b * 512 + h * 64) * TP; }
    ldv = sample ? SKP : TP;
    const bf16_t* Kr = P->krope + (long)kvrow0 * 32;

    bf16x8 qf[NS];
    if (wactive) {
        const bf16_t* qp = Qp + (long)(w * 32 + ql) * ldq + 8 * hh;
#pragma unroll
        for (int s = 0; s < NS; ++s) qf[s] = *(const bf16x8*)(qp + 16 * s);
    } else {
#pragma unroll
        for (int s = 0; s < NS; ++s) qf[s] = (bf16x8){0, 0, 0, 0, 0, 0, 0, 0};
    }
    f32x16 O0, O1;
#pragma unroll
    for (int i = 0; i < 16; ++i) { O0[i] = 0.f; O1[i] = 0.f; }
    float mrun = -INFINITY, lrun = 0.f, carry = 0.f;
    bool wdone = !wactive;
    volatile int* flags = (volatile int*)(lds + 65536 + 64);

    u32x4 rk0, rk1, rv;
    const int krow_s = tid >> 3, kc_s = tid & 7, rrow_s = tid >> 2, rc_s = tid & 3;
    const bool f32path = (MODE == 1) && sample;
    const float* Kf = P->c_sbk + ((long)b * PAST * 512 + h * 64); const float* Vf = P->c_sbv + ((long)b * PAST * 512 + h * 64);
    auto load_tile = [&](int kt) {
        if (f32path && kt < 64) {
            const float* kp_ = Kf + (long)(kt * 64 + krow_s) * 512 + kc_s * 8; const float* vp_ = Vf + (long)(kt * 64 + krow_s) * 512 + kc_s * 8;
            const f32x4 a0 = *(const f32x4*)kp_, a1 = *(const f32x4*)(kp_ + 4), c0 = *(const f32x4*)vp_, c1 = *(const f32x4*)(vp_ + 4);
            rk0.x = pk2(a0[0], a0[1]); rk0.y = pk2(a0[2], a0[3]); rk0.z = pk2(a1[0], a1[1]); rk0.w = pk2(a1[2], a1[3]);
            rv.x = pk2(c0[0], c0[1]); rv.y = pk2(c0[2], c0[3]); rv.z = pk2(c1[0], c1[1]); rv.w = pk2(c1[2], c1[3]);
            return;
        }
        rk0 = *(const u32x4*)(Kp + (long)(kt * 64 + krow_s) * 512 + kc_s * 8);
        if (MODE == 0 && tid < 256) rk1 = *(const u32x4*)(Kr + (long)(kt * 64 + rrow_s) * 32 + rc_s * 8);
        rv = *(const u32x4*)(VT + (long)krow_s * ldv + kt * 64 + kc_s * 8);
    };
    auto store_tile = [&](int buf, int kt) {
        char* kb_ = lds + buf * BUF; char* vb_ = kb_ + KBYTES;
        *(u32x4*)(kb_ + krow_s * KS + kc_s * 16) = rk0;
        if (f32path && kt < 64) {
#pragma unroll
            for (int e = 0; e < 4; ++e) { *(bf16_t*)(vb_ + (kc_s * 8 + 2 * e) * VS + krow_s * 2) = (bf16_t)(rv[e] & 0xffff); *(bf16_t*)(vb_ + (kc_s * 8 + 2 * e + 1) * VS + krow_s * 2) = (bf16_t)(rv[e] >> 16); }
            return;
        }
        if (MODE == 0 && tid < 256) *(u32x4*)(kb_ + rrow_s * KS + 128 + rc_s * 16) = rk1;
        *(u32x4*)(vb_ + krow_s * VS + kc_s * 16) = rv;
    };
    load_tile(ntiles - 1); store_tile(0, ntiles - 1);
    __syncthreads();
    for (int it = 0; it < ntiles; ++it) {
        const int kt = ntiles - 1 - it, cur = it & 1;
        if (it + 1 < ntiles) load_tile(kt - 1);
        if (wactive && !wdone && kt * 64 < wmax) {
            const char* kb_ = lds + cur * BUF; const char* vb_ = kb_ + KBYTES;
            f32x16 S0, S1;
#pragma unroll
            for (int i = 0; i < 16; ++i) { S0[i] = 0.f; S1[i] = 0.f; }
#pragma unroll
            for (int s = 0; s < NS; ++s) {
                const bf16x8 k0 = *(const bf16x8*)(kb_ + ql * KS + (16 * s + 8 * hh) * 2);
                const bf16x8 k1 = *(const bf16x8*)(kb_ + (32 + ql) * KS + (16 * s + 8 * hh) * 2);
                S0 = MFMA32(k0, qf[s], S0); S1 = MFMA32(k1, qf[s], S1);
            }
            const bool need_mask = (kt * 64 + 64 > wmin);
            const int kbase = kt * 64 + 4 * hh;
            if (MODE == 0) {
                if (need_mask) {
#pragma unroll
                    for (int i = 0; i < 16; ++i) { const int key = kbase + (i & 3) + 8 * (i >> 2);
                        if (key >= klim) S0[i] = -INFINITY; if (key + 32 >= klim) S1[i] = -INFINITY; }
                }
                float mx = S0[0];
#pragma unroll
                for (int i = 1; i < 16; ++i) mx = fmaxf(mx, S0[i]);
#pragma unroll
                for (int i = 0; i < 16; ++i) mx = fmaxf(mx, S1[i]);
                mx = fmaxf(mx, __shfl_xor(mx, 32));
                const float mnew = fmaxf(mrun, mx);
                const float alpha = __builtin_amdgcn_exp2f(mrun - mnew);
                mrun = mnew;
                float ps = 0.f;
#pragma unroll
                for (int i = 0; i < 16; ++i) { S0[i] = __builtin_amdgcn_exp2f(S0[i] - mnew); S1[i] = __builtin_amdgcn_exp2f(S1[i] - mnew); ps += S0[i] + S1[i]; }
                lrun = lrun * alpha + ps;
#pragma unroll
                for (int i = 0; i < 16; ++i) { O0[i] *= alpha; O1[i] *= alpha; }
            } else {
                float gs[2][4], gp[2][4];
                f32x16 SP0, SP1;
#pragma unroll
                for (int i = 0; i < 16; ++i) { const int key = kbase + (i & 3) + 8 * (i >> 2);
                    { const float z = S0[i]; const float t = __builtin_amdgcn_exp2f(-fabsf(z) * LOG2E); float sp = fmaxf(z, 0.f) + LN2 * __builtin_amdgcn_logf(1.0f + t);
                      if (need_mask && key >= klim) sp = 0.f; SP0[i] = sp; }
                    { const float z = S1[i]; const float t = __builtin_amdgcn_exp2f(-fabsf(z) * LOG2E); float sp = fmaxf(z, 0.f) + LN2 * __builtin_amdgcn_logf(1.0f + t);
                      if (need_mask && key + 32 >= klim) sp = 0.f; SP1[i] = sp; } }
#pragma unroll
                for (int g = 0; g < 4; ++g) { gs[0][g] = (SP0[4 * g] + SP0[4 * g + 1]) + (SP0[4 * g + 2] + SP0[4 * g + 3]);
                    gs[1][g] = (SP1[4 * g] + SP1[4 * g + 1]) + (SP1[4 * g + 2] + SP1[4 * g + 3]); }
#pragma unroll
                for (int g = 0; g < 4; ++g) { gp[0][g] = __shfl_xor(gs[0][g], 32); gp[1][g] = __shfl_xor(gs[1][g], 32); }
                float running = carry;
#pragma unroll
                for (int blk = 1; blk >= 0; --blk)
#pragma unroll
                    for (int g = 3; g >= 0; --g) {
                        const float sum1 = hh ? gs[blk][g] : gp[blk][g], sum0 = hh ? gp[blk][g] : gs[blk][g];
                        const float mybase = hh ? running : running + sum1;
                        running += sum0 + sum1;
                        float later = mybase;
#pragma unroll
                        for (int j = 3; j >= 0; --j) { const int i = 4 * g + j; const int key = kbase + j + 8 * g + 32 * blk;
                            const float z = blk ? S1[i] : S0[i], sp = blk ? SP1[i] : SP0[i];
                            float a = __builtin_amdgcn_exp2f((z - sp - later) * LOG2E);
                            if (need_mask && key >= klim) a = 0.f;
                            later += sp;
                            if (blk) S1[i] = a; else S0[i] = a; }
                    }
                carry = running;
                wdone = __all((carry > 104.0f) || (klim <= 0));
            }
            bf16x8 pf[2][2];
#pragma unroll
            for (int s = 0; s < 2; ++s) {
                u32x4 a, c;
                a.x = pk2(S0[8 * s], S0[8 * s + 1]); a.y = pk2(S0[8 * s + 2], S0[8 * s + 3]); a.z = pk2(S0[8 * s + 4], S0[8 * s + 5]); a.w = pk2(S0[8 * s + 6], S0[8 * s + 7]);
                c.x = pk2(S1[8 * s], S1[8 * s + 1]); c.y = pk2(S1[8 * s + 2], S1[8 * s + 3]); c.z = pk2(S1[8 * s + 4], S1[8 * s + 5]); c.w = pk2(S1[8 * s + 6], S1[8 * s + 7]);
                pf[0][s] = __builtin_bit_cast(bf16x8, a); pf[1][s] = __builtin_bit_cast(bf16x8, c);
            }
#pragma unroll
            for (int blk = 0; blk < 2; ++blk)
#pragma unroll
                for (int s = 0; s < 2; ++s) {
                    const int koff = (32 * blk + 16 * s + 4 * hh) * 2;
                    const s16x4 lo0 = *(const s16x4*)(vb_ + ql * VS + koff), hi0 = *(const s16x4*)(vb_ + ql * VS + koff + 16);
                    const s16x4 lo1 = *(const s16x4*)(vb_ + (32 + ql) * VS + koff), hi1 = *(const s16x4*)(vb_ + (32 + ql) * VS + koff + 16);
                    const bf16x8 v0 = __builtin_shufflevector(lo0, hi0, 0, 1, 2, 3, 4, 5, 6, 7), v1 = __builtin_shufflevector(lo1, hi1, 0, 1, 2, 3, 4, 5, 6, 7);
                    O0 = MFMA32(v0, pf[blk][s], O0); O1 = MFMA32(v1, pf[blk][s], O1);
                }
        }
        if (it + 1 < ntiles) store_tile(cur ^ 1, kt - 1);
        if (MODE == 1 && lane == 0) flags[(it & 1) * 8 + w] = wdone ? 1 : 0;
        __syncthreads();
        if (MODE == 1) { int alld = 1;
#pragma unroll
            for (int ww = 0; ww < 8; ++ww) alld &= flags[(it & 1) * 8 + ww];
            if (alld) break; }
    }
    if (wactive) {
        float inv = 1.0f;
        if (MODE == 0) { const float lt = lrun + __shfl_xor(lrun, 32); inv = 1.0f / lt; }
        bf16_t* op = P->o + (long)(qrow0 + w * 32 + ql) * 1024 + (MODE == 0 ? 0 : 512) + h * 64 + 4 * hh;
#pragma unroll
        for (int g = 0; g < 4; ++g) {
            f32x4 a = {O0[4 * g] * inv, O0[4 * g + 1] * inv, O0[4 * g + 2] * inv, O0[4 * g + 3] * inv};
            f32x4 c = {O1[4 * g] * inv, O1[4 * g + 1] * inv, O1[4 * g + 2] * inv, O1[4 * g + 3] * inv};
            store_bf4(op + 8 * g, a); store_bf4(op + 32 + 8 * g, c);
        }
    }
}

DI void attn_mla128(KP P, char* lds, bool sample, int b, int h, int ublk) {
    constexpr int KS = 208, VS = 272, KBYTES = 128 * KS, BUF = KBYTES + 64 * VS;
    const int tid = otid(), w = tid >> 6, lane = tid & 63, ql = lane & 31, hh = lane >> 5;
    const int kvrow0 = sample ? MP + b * SKEYS : b * TP;
    const int qrow0 = sample ? MP + b * 32 : b * TP + ublk * 256;
    const int ntiles = sample ? 33 : 2 * (ublk + 1);
    const int t0 = sample ? 0 : ublk * 256 + w * 32;
    const int wmax = sample ? SKEYS : ((((t0 + 31) >> 6) + 1) << 6);
    const bool wactive = sample ? (w == 0) : true;
    const bf16_t* Kp = P->kva + (long)kvrow0 * 512 + h * 64; const bf16_t* Qp = P->q + (long)qrow0 * 768 + h * 96;
    const bf16_t* VT = sample ? P->vaT_s + (long)(b * 512 + h * 64) * SKP : P->vaT_p + (long)(b * 512 + h * 64) * TP;
    const long ldv = sample ? SKP : TP;
    const bf16_t* Kr = P->krope + (long)kvrow0 * 32;
    bf16x8 qf[6];
    if (wactive) { const bf16_t* qp = Qp + (long)(w * 32 + ql) * 768 + 8 * hh;
#pragma unroll
        for (int s = 0; s < 6; ++s) qf[s] = *(const bf16x8*)(qp + 16 * s); }
    else {
#pragma unroll
        for (int s = 0; s < 6; ++s) qf[s] = (bf16x8){0, 0, 0, 0, 0, 0, 0, 0}; }
    f32x16 O0, O1;
#pragma unroll
    for (int i = 0; i < 16; ++i) { O0[i] = 0.f; O1[i] = 0.f; }
    float mrun = -INFINITY, lrun = 0.f;
    u32x4 rk[2], rr, rv[2];
    auto load_tile = [&](int kt) {
#pragma unroll
        for (int i = 0; i < 2; ++i) { const int c = tid + i * 512;
            rk[i] = *(const u32x4*)(Kp + (long)(kt * 128 + (c >> 3)) * 512 + (c & 7) * 8);
            rv[i] = *(const u32x4*)(VT + (long)(c >> 4) * ldv + kt * 128 + (c & 15) * 8); }
        rr = *(const u32x4*)(Kr + (long)(kt * 128 + (tid >> 2)) * 32 + (tid & 3) * 8);
    };
    auto store_tile = [&](int buf) {
        char* kb_ = lds + buf * BUF; char* vb_ = kb_ + KBYTES;
#pragma unroll
        for (int i = 0; i < 2; ++i) { const int c = tid + i * 512;
            *(u32x4*)(kb_ + (c >> 3) * KS + (c & 7) * 16) = rk[i];
            *(u32x4*)(vb_ + (c >> 4) * VS + (c & 15) * 16) = rv[i]; }
        *(u32x4*)(kb_ + (tid >> 2) * KS + 128 + (tid & 3) * 16) = rr;
    };
    load_tile(ntiles - 1); store_tile(0);
    __syncthreads();
    for (int it = 0; it < ntiles; ++it) {
        const int kt = ntiles - 1 - it, cur = it & 1;
        if (it + 1 < ntiles) load_tile(kt - 1);
        if (wactive && kt * 128 < wmax) {
            const char* kb_ = lds + cur * BUF; const char* vb_ = kb_ + KBYTES;
            const int nblk = (wmax - kt * 128) >> 5;
            f32x16 S[4];
#pragma unroll
            for (int blk = 0; blk < 4; ++blk) {
#pragma unroll
                for (int i = 0; i < 16; ++i) S[blk][i] = 0.f;
#pragma unroll
                for (int s = 0; s < 6; ++s) { const bf16x8 kf = *(const bf16x8*)(kb_ + (32 * blk + ql) * KS + (16 * s + 8 * hh) * 2); S[blk] = MFMA32(kf, qf[s], S[blk]); }
            }
            if (nblk < 4) {
#pragma unroll
                for (int blk = 1; blk < 4; ++blk) if (blk >= nblk) {
#pragma unroll
                    for (int i = 0; i < 16; ++i) S[blk][i] = -INFINITY; }
            }
            float mx = S[0][0];
#pragma unroll
            for (int blk = 0; blk < 4; ++blk)
#pragma unroll
                for (int i = 0; i < 16; ++i) mx = fmaxf(mx, S[blk][i]);
            mx = fmaxf(mx, __shfl_xor(mx, 32));
            const float mnew = fmaxf(mrun, mx);
            const float alpha = __builtin_amdgcn_exp2f(mrun - mnew);
            mrun = mnew;
            float ps = 0.f;
#pragma unroll
            for (int blk = 0; blk < 4; ++blk)
#pragma unroll
                for (int i = 0; i < 16; ++i) { S[blk][i] = __builtin_amdgcn_exp2f(S[blk][i] - mnew); ps += S[blk][i]; }
            lrun = lrun * alpha + ps;
#pragma unroll
            for (int i = 0; i < 16; ++i) { O0[i] *= alpha; O1[i] *= alpha; }
#pragma unroll
            for (int blk = 0; blk < 4; ++blk)
#pragma unroll
                for (int s = 0; s < 2; ++s) {
                    u32x4 a;
                    a.x = pk2(S[blk][8 * s], S[blk][8 * s + 1]); a.y = pk2(S[blk][8 * s + 2], S[blk][8 * s + 3]); a.z = pk2(S[blk][8 * s + 4], S[blk][8 * s + 5]); a.w = pk2(S[blk][8 * s + 6], S[blk][8 * s + 7]);
                    const bf16x8 pf = __builtin_bit_cast(bf16x8, a);
                    const int koff = (32 * blk + 16 * s + 4 * hh) * 2;
                    const s16x4 lo0 = *(const s16x4*)(vb_ + ql * VS + koff), hi0 = *(const s16x4*)(vb_ + ql * VS + koff + 16);
                    const s16x4 lo1 = *(const s16x4*)(vb_ + (32 + ql) * VS + koff), hi1 = *(const s16x4*)(vb_ + (32 + ql) * VS + koff + 16);
                    const bf16x8 v0 = __builtin_shufflevector(lo0, hi0, 0, 1, 2, 3, 4, 5, 6, 7), v1 = __builtin_shufflevector(lo1, hi1, 0, 1, 2, 3, 4, 5, 6, 7);
                    O0 = MFMA32(v0, pf, O0); O1 = MFMA32(v1, pf, O1);
                }
        }
        if (it + 1 < ntiles) store_tile(cur ^ 1);
        __syncthreads();
    }
    if (wactive) {
        const float lt = lrun + __shfl_xor(lrun, 32); const float inv = 1.0f / lt;
        bf16_t* op = P->o + (long)(qrow0 + w * 32 + ql) * 1024 + h * 64 + 4 * hh;
#pragma unroll
        for (int g = 0; g < 4; ++g) {
            f32x4 a = {O0[4 * g] * inv, O0[4 * g + 1] * inv, O0[4 * g + 2] * inv, O0[4 * g + 3] * inv};
            f32x4 c = {O1[4 * g] * inv, O1[4 * g + 1] * inv, O1[4 * g + 2] * inv, O1[4 * g + 3] * inv};
            store_bf4(op + 8 * g, a); store_bf4(op + 32 + 8 * g, c);
        }
    }
}

DI void attn_phase(KP P, char* lds, int cidx) {
    unsigned* slot = (unsigned*)(lds + 131072 + 3072);
    for (;;) {
        if (threadIdx.x == 0) *slot = atomicAdd(P->ctr + cidx, 1u);
        __syncthreads();
        const unsigned idx = *slot;
        __syncthreads();
        if (idx >= 1152u) break;
        bool sample; int mode, b, h, ublk = 0;
        if (idx < 128u) { sample = true; mode = idx >> 6; b = (idx >> 3) & 7; h = idx & 7; }
        else { const int j = idx - 128; sample = false; ublk = 31 - (j >> 5); const int r = j & 31; mode = r >> 4; b = (r >> 3) & 1; h = r & 7; }
        if (mode == 0) attn_mla128(P, lds, sample, b, h, ublk); else attn_unit<1>(P, lds, sample, b, h, ublk);
    }
}

DI void phase0(KP P, char* lds) {
    const int tid = otid(), G = ogrid(), bid = obid(), w = tid >> 6, lane = tid & 63;
    for (int item = bid; item < 96; item += G) {
        float* sc = (float*)lds; float* red = (float*)(lds + 40960);
        for (int i = tid; i < 10240; i += NTHREADS) { const int bb = i >> 10, k = i & 1023; const float cv = bb < 2 ? P->c_p[bb * 1024 + k] : P->c_s[(bb - 2) * 1024 + k]; sc[i] = cv / (1.0f + __expf(-cv)); }
        __syncthreads();
        const int col = item * 64 + lane;
        float a0 = 0, a1 = 0, a2 = 0, a3 = 0, a4 = 0, a5 = 0, a6 = 0, a7 = 0, a8 = 0, a9 = 0;
        for (int k0 = w * 128; k0 < w * 128 + 128; k0 += 16) {
            float wv[16];
#pragma unroll
            for (int j = 0; j < 16; ++j) wv[j] = P->w_ada[(long)(k0 + j) * 6144 + col];
#pragma unroll
            for (int j = 0; j < 16; ++j) { const int k = k0 + j;
                a0 += sc[k] * wv[j]; a1 += sc[1024 + k] * wv[j]; a2 += sc[2048 + k] * wv[j]; a3 += sc[3072 + k] * wv[j]; a4 += sc[4096 + k] * wv[j];
                a5 += sc[5120 + k] * wv[j]; a6 += sc[6144 + k] * wv[j]; a7 += sc[7168 + k] * wv[j]; a8 += sc[8192 + k] * wv[j]; a9 += sc[9216 + k] * wv[j]; }
        }
        float* rr = red + w * 640 + lane;
        rr[0] = a0; rr[64] = a1; rr[128] = a2; rr[192] = a3; rr[256] = a4; rr[320] = a5; rr[384] = a6; rr[448] = a7; rr[512] = a8; rr[576] = a9;
        __syncthreads();
        for (int i = tid; i < 640; i += NTHREADS) { float s = 0.f; for (int ww = 0; ww < 8; ++ww) s += red[ww * 640 + i];
            const int bb = i >> 6, l = i & 63; P->ada[bb * 6144 + item * 64 + l] = s + P->b_ada[item * 64 + l]; }
        __syncthreads();
    }
    {
        float* tile = (float*)lds;
        for (int it = (bid + 96) % G; it < P->ntj_tiles; it += G) {
            int j = 0;
#pragma unroll
            for (int q = 1; q < 16; ++q) if (it >= P->tj[q].tile0) j = q;
            TJob J; J.src = P->tj[j].src; J.kscale = P->tj[j].kscale; J.dst = P->tj[j].dst; J.lds = P->tj[j].lds; J.coff = P->tj[j].coff; J.ldd = P->tj[j].ldd;
            J.Klen = P->tj[j].Klen; J.Nlen = P->tj[j].Nlen; J.zero = P->tj[j].zero; J.tile0 = P->tj[j].tile0;
            const int lt = it - J.tile0, nk = J.Klen >> 6, tk = lt % nk, tn = lt / nk, k0 = tk * 64, n0 = tn * 256;
            f32x4 lv[8];
#pragma unroll
            for (int r = 0; r < 8; ++r) { const int e = tid + r * NTHREADS, kk = e >> 6, n4 = (e & 63) * 4;
                lv[r] = (f32x4){0.f, 0.f, 0.f, 0.f};
                if (J.zero == 2) { const int nn_ = n0 + n4, sc_ = (nn_ >> 8) * 128 + (nn_ & 127) + ((nn_ >> 7) & 1) * DFF;
                    lv[r] = *(const f32x4*)(J.src + (long)(k0 + kk) * J.lds + sc_); }
                else if (!J.zero && n0 + n4 < J.Nlen) lv[r] = *(const f32x4*)(J.src + (long)(k0 + kk) * J.lds + J.coff + n0 + n4); }
#pragma unroll
            for (int r = 0; r < 8; ++r) { const int e = tid + r * NTHREADS, kk = e >> 6, n4 = (e & 63) * 4;
                f32x4 v = lv[r]; if (J.kscale) v *= J.kscale[k0 + kk];
                float* tp = tile + kk * 257 + n4; tp[0] = v[0]; tp[1] = v[1]; tp[2] = v[2]; tp[3] = v[3]; }
            __syncthreads();
#pragma unroll
            for (int r = 0; r < 4; ++r) { const int e = tid + r * NTHREADS, nn = e >> 3, kc = (e & 7) * 8;
                if (n0 + nn < J.Nlen) { const float* tp = tile + kc * 257 + nn; u32x4 o;
                    o.x = pk2(tp[0], tp[257]); o.y = pk2(tp[2 * 257], tp[3 * 257]); o.z = pk2(tp[4 * 257], tp[5 * 257]); o.w = pk2(tp[6 * 257], tp[7 * 257]);
                    *(u32x4*)(J.dst + (long)(n0 + nn) * J.ldd + k0 + kc) = o; } }
            __syncthreads();
        }
    }
    const long gt = (long)bid * NTHREADS + tid, gn = (long)G * NTHREADS;
    for (long i0 = gt; i0 < 8L * PAST * 64; i0 += 4 * gn) { f32x4 v[4];
#pragma unroll
        for (int r = 0; r < 4; ++r) { const long i = i0 + r * gn; if (i < 8L * PAST * 64) v[r] = *(const f32x4*)(P->c_ckv + i * 4); }
#pragma unroll
        for (int r = 0; r < 4; ++r) { const long i = i0 + r * gn; if (i < 8L * PAST * 64) { const long row = i >> 6; const int c = (int)(i & 63) * 4; const int bb = (int)(row >> 12), sq = (int)(row & 4095);
            store_bf4(P->latent + (long)(MP + bb * SKEYS + sq) * 256 + c, v[r]); } } }
    for (long i0 = gt; i0 < 8L * PAST * 8; i0 += 4 * gn) { f32x4 v[4];
#pragma unroll
        for (int r = 0; r < 4; ++r) { const long i = i0 + r * gn; if (i < 8L * PAST * 8) v[r] = *(const f32x4*)(P->c_kr + i * 4); }
#pragma unroll
        for (int r = 0; r < 4; ++r) { const long i = i0 + r * gn; if (i < 8L * PAST * 8) { const long row = i >> 3; const int c = (int)(i & 7) * 4; const int bb = (int)(row >> 12), sq = (int)(row & 4095);
            store_bf4(P->krope + (long)(MP + bb * SKEYS + sq) * 32 + c, v[r]); } } }
    for (long i = gt; i < 8L * 512 * 8; i += gn) { const long r = i >> 3; const int c = (int)(i & 7) * 4; const u32x2 z = {0u, 0u};
        *(u32x2*)(P->vaT_s + r * SKP + SKEYS + c) = z; *(u32x2*)(P->vbT_s + r * SKP + SKEYS + c) = z; }
    for (long i = gt; i < (long)TP * 16; i += gn) { const int pos = (int)(i >> 4), fi = (int)(i & 15);
        const float inv = exp2f(-(float)fi * (13.287712379549449f / 16.0f));
        const float ang = (float)pos * inv;
        const double rev = (double)ang * 0.15915494309189535; const float fr_ = (float)(rev - floor(rev));
        P->ropeT[i * 2] = __builtin_amdgcn_cosf(fr_); P->ropeT[i * 2 + 1] = __builtin_amdgcn_sinf(fr_); }
}

DI void phase_h(KP P) {
    const int tid_ = otid(), lane = tid_ & 63, gw = obid() * 8 + (tid_ >> 6), nw = ogrid() * 8;
    for (int row = gw; row < MT; row += nw) {
        const float* xr = row < MP ? P->x_p + (long)row * DM : P->x_s + (long)(row - MP) * DM;
        const float* ad = P->ada + ada_b(row) * 6144;
        f32x4 v[4]; float s = 0.f;
#pragma unroll
        for (int i = 0; i < 4; ++i) { v[i] = *(const f32x4*)(xr + i * 256 + lane * 4); s += v[i][0] * v[i][0] + v[i][1] * v[i][1] + v[i][2] * v[i][2] + v[i][3] * v[i][3]; }
#pragma unroll
        for (int o = 1; o < 64; o <<= 1) s += __shfl_xor(s, o);
        const float rstd = rsqrtf(s * (1.0f / DM) + EPS);
#pragma unroll
        for (int i = 0; i < 4; ++i) { const int c = i * 256 + lane * 4;
            const f32x4 g = *(const f32x4*)(P->g_pre_mix + c), sh = *(const f32x4*)(ad + c), scl = *(const f32x4*)(ad + 1024 + c);
            store_bf4(P->h + (long)row * DM + c, v[i] * rstd * g * (1.0f + scl) + sh); }
    }
}

DI void phase_mid(KP P) {
    const int tid_ = otid(), lane = tid_ & 63, gw = obid() * 8 + (tid_ >> 6), nw = ogrid() * 8;
    for (int row = gw; row < MT; row += nw) {
        const float* xr = row < MP ? P->x_p + (long)row * DM : P->x_s + (long)(row - MP) * DM;
        const float* ad = P->ada + ada_b(row) * 6144;
        f32x4 mv[4]; float s = 0.f;
#pragma unroll
        for (int i = 0; i < 4; ++i) { const u32x2 wv = *(const u32x2*)(P->m2 + (long)row * DM + i * 256 + lane * 4);
            mv[i] = (f32x4){bf_lo(wv.x), bf_hi(wv.x), bf_lo(wv.y), bf_hi(wv.y)}; s += mv[i][0] * mv[i][0] + mv[i][1] * mv[i][1] + mv[i][2] * mv[i][2] + mv[i][3] * mv[i][3]; }
#pragma unroll
        for (int o = 1; o < 64; o <<= 1) s += __shfl_xor(s, o);
        const float rstd = rsqrtf(s * (1.0f / DM) + EPS);
        float s2 = 0.f;
#pragma unroll
        for (int i = 0; i < 4; ++i) { const int c = i * 256 + lane * 4;
            const f32x4 xv = *(const f32x4*)(xr + c), g = *(const f32x4*)(P->g_post_mix + c), gt = *(const f32x4*)(ad + 2048 + c);
            mv[i] = xv + gt * (mv[i] * rstd * g);
            *(f32x4*)(P->out + O_Y + (long)row * DM + c) = mv[i];
            s2 += mv[i][0] * mv[i][0] + mv[i][1] * mv[i][1] + mv[i][2] * mv[i][2] + mv[i][3] * mv[i][3]; }
#pragma unroll
        for (int o = 1; o < 64; o <<= 1) s2 += __shfl_xor(s2, o);
        const float rstd2 = rsqrtf(s2 * (1.0f / DM) + EPS);
#pragma unroll
        for (int i = 0; i < 4; ++i) { const int c = i * 256 + lane * 4;
            const f32x4 g = *(const f32x4*)(P->g_pre_ffn + c), sh = *(const f32x4*)(ad + 3072 + c), scl = *(const f32x4*)(ad + 4096 + c);
            store_bf4(P->h2 + (long)row * DM + c, mv[i] * rstd2 * g * (1.0f + scl) + sh); }
    }
}

DI void phase_final(KP P) {
    const int tid_ = otid(), lane = tid_ & 63, gw = obid() * 8 + (tid_ >> 6), nw = ogrid() * 8;
    for (int row = gw; row < MT; row += nw) {
        const float* ad = P->ada + ada_b(row) * 6144;
        f32x4 fv[4]; float s = 0.f;
#pragma unroll
        for (int i = 0; i < 4; ++i) { const u32x2 wv = *(const u32x2*)(P->f + (long)row * DM + i * 256 + lane * 4);
            fv[i] = (f32x4){bf_lo(wv.x), bf_hi(wv.x), bf_lo(wv.y), bf_hi(wv.y)}; s += fv[i][0] * fv[i][0] + fv[i][1] * fv[i][1] + fv[i][2] * fv[i][2] + fv[i][3] * fv[i][3]; }
#pragma unroll
        for (int o = 1; o < 64; o <<= 1) s += __shfl_xor(s, o);
        const float rstd = rsqrtf(s * (1.0f / DM) + EPS);
#pragma unroll
        for (int i = 0; i < 4; ++i) { const int c = i * 256 + lane * 4; float* yp = P->out + O_Y + (long)row * DM + c;
            const f32x4 xv = *(const f32x4*)yp, g = *(const f32x4*)(P->g_post_ffn + c), gt = *(const f32x4*)(ad + 5120 + c);
            *(f32x4*)yp = xv + gt * (fv[i] * rstd * g); }
    }
}


DI void load8(const bf16_t* p, float (&o)[8]) { const u32x4 w = *(const u32x4*)p;
#pragma unroll
    for (int e = 0; e < 4; ++e) { o[2 * e] = bf_lo(w[e]); o[2 * e + 1] = bf_hi(w[e]); } }
DI void phase_convfix(KP P) {
    const long gt = (long)obid() * NTHREADS + otid(), gn = (long)ogrid() * NTHREADS;
    for (long i = gt; i < 768L * 352; i += gn) {
        const int ri = (int)(i / 352), c = (int)(i % 352) * 8;
        float u0[2][8], u1[2][8], u2[2][8];
        long grow;
        if (ri < 512) {
            const int B = ri >> 1, rsel = ri & 1; const bool first = ((B * 64) & (TP - 1)) == 0; grow = (long)B * 64 + rsel;
            const bf16_t* cur = P->ub + (long)(B * 4) * DFF2 + c; const bf16_t* prv = P->ub + (long)((B > 0 ? B - 1 : 0) * 4) * DFF2 + c;
#pragma unroll
            for (int hf = 0; hf < 2; ++hf) {
                load8(cur + (long)(2 + rsel) * DFF2 + hf * DFF, u2[hf]);
                if (rsel == 0) { if (first) { for (int e = 0; e < 8; ++e) { u1[hf][e] = 0.f; u0[hf][e] = 0.f; } } else { load8(prv + (long)1 * DFF2 + hf * DFF, u1[hf]); load8(prv + hf * DFF, u0[hf]); } }
                else { load8(cur + (long)2 * DFF2 + hf * DFF, u1[hf]); if (first) { for (int e = 0; e < 8; ++e) u0[hf][e] = 0.f; } else load8(prv + (long)1 * DFF2 + hf * DFF, u0[hf]); }
            }
        } else {
            const int r = ri - 512, t = r & 31, bs = r >> 5; grow = (long)MP + r;
            const float* st = P->c_conv + (long)bs * 2 * DFF2 + c;
#pragma unroll
            for (int hf = 0; hf < 2; ++hf) {
                load8(P->u + (long)r * DFF2 + hf * DFF + c, u2[hf]);
                if (t >= 1) load8(P->u + (long)(r - 1) * DFF2 + hf * DFF + c, u1[hf]); else { for (int e = 0; e < 8; ++e) u1[hf][e] = st[DFF2 + hf * DFF + e]; }
                if (t >= 2) load8(P->u + (long)(r - 2) * DFF2 + hf * DFF + c, u0[hf]); else { for (int e = 0; e < 8; ++e) u0[hf][e] = st[(long)t * DFF2 + hf * DFF + e]; }
            }
        }
        float y[2][8];
#pragma unroll
        for (int hf = 0; hf < 2; ++hf)
#pragma unroll
            for (int e = 0; e < 8; ++e) { const int cc = hf * DFF + c + e;
                y[hf][e] = P->conv_b[cc] + P->conv_w[cc] * u0[hf][e] + P->conv_w[DFF2 + cc] * u1[hf][e] + P->conv_w[2 * DFF2 + cc] * u2[hf][e]; }
        u32x4 ov;
#pragma unroll
        for (int e = 0; e < 4; ++e) ov[e] = pk2(gelu_tanh(y[0][2 * e]) * y[1][2 * e], gelu_tanh(y[0][2 * e + 1]) * y[1][2 * e + 1]);
        *(u32x4*)(P->g + grow * DFF + c) = ov;
    }
}

#define XB_TMO      128
#define XB_XCNT(j)  (256  + 64 * (j))
#define XB_XSUB(j)  (1280 + 64 * (j))
#define XB_XGEN(j)  (2304 + 64 * (j))
#define XB_TOP      3328
#define XB_TOPGEN   3392
#define XCD_BAR_WORDS 3456
#define XB_SPIN_CAP (1u << 18)
DI unsigned xb_ld(unsigned* p)              { return __hip_atomic_load(p, __ATOMIC_RELAXED, __HIP_MEMORY_SCOPE_AGENT); }
DI unsigned xb_add(unsigned* p, unsigned v) { return __hip_atomic_fetch_add(p, v, __ATOMIC_RELAXED, __HIP_MEMORY_SCOPE_AGENT); }
DI unsigned xb_xcc_id() { return (unsigned)__builtin_amdgcn_s_getreg((3 << 11) | 20) & 0xFu; }
#define XB_SPIN(cond, bar) do { unsigned _sp = 0; while (cond) { __builtin_amdgcn_s_sleep(1); \
    if ((++_sp & 255u) == 0u) { if (xb_ld(&(bar)[XB_TMO])) break; if (_sp > XB_SPIN_CAP) { atomicAdd(&(bar)[XB_TMO], 1u); break; } } } } while (0)
DI void xcd_barrier_complete(unsigned* bar, unsigned x, unsigned& nloc, unsigned& nx) {
    const unsigned G = gridDim.x;
    unsigned sum, cnt, mine, sp = 0u;
    for (;;) {
        sum = 0u; cnt = 0u; mine = 0u;
#pragma unroll
        for (unsigned j = 0; j < 16; ++j) { const unsigned c = xb_ld(&bar[XB_XCNT(j)]); sum += c; cnt += (c > 0u) ? 1u : 0u; mine = (j == x) ? c : mine; }
        if (sum == G) break;
        __builtin_amdgcn_s_sleep(1);
        if ((++sp & 255u) == 0u) { if (xb_ld(&bar[XB_TMO])) break; if (sp > XB_SPIN_CAP) { atomicAdd(&bar[XB_TMO], 1u); break; } }
    }
    nloc = mine > 0u ? mine : 1u; nx = cnt > 0u ? cnt : 1u;
}
DI void grid_barrier(char* lds) {
    asm volatile("s_waitcnt vmcnt(0)" ::: "memory");
    __syncthreads();
    if (threadIdx.x == 0) {
        unsigned* bar = kparams()->bar; const unsigned x = xb_xcc_id();
        volatile LAS unsigned* st = (volatile LAS unsigned*)(lds + 131072 + 2048);
        __builtin_amdgcn_s_waitcnt(0);
        unsigned nloc = st[0], nx = st[1];
        if (nloc == 0u) { xcd_barrier_complete(bar, x, nloc, nx); st[0] = nloc; st[1] = nx; }
        const unsigned old = xb_add(&bar[XB_XSUB(x)], 1u);
        const unsigned gen = old / nloc;
        if (old + 1u == (gen + 1u) * nloc) {
            __builtin_amdgcn_fence(__ATOMIC_RELEASE, "agent");
            asm volatile("s_waitcnt vmcnt(0)" ::: "memory");
            const unsigned og = xb_add(&bar[XB_TOP], 1u);
            const unsigned tg = og / nx;
            if (og + 1u == (tg + 1u) * nx) xb_add(&bar[XB_TOPGEN], 1u);
            else XB_SPIN(xb_ld(&bar[XB_TOPGEN]) == tg, bar);
            __builtin_amdgcn_fence(__ATOMIC_ACQUIRE, "agent");
            xb_add(&bar[XB_XGEN(x)], 1u);
            asm volatile("s_waitcnt vmcnt(0)" ::: "memory");
        } else {
            XB_SPIN(xb_ld(&bar[XB_XGEN(x)]) == gen, bar);
            __builtin_amdgcn_fence(__ATOMIC_ACQUIRE, "agent");
            asm volatile("s_waitcnt vmcnt(0)" ::: "memory");
        }
    }
    __syncthreads();
}

__global__ void __launch_bounds__(NTHREADS) fwd_megakernel(Params Pval) {
    extern __shared__ __attribute__((aligned(16))) char lds[];
    cg::grid_group grid = cg::this_grid();
    const int lo = kparams()->phase_lo, hi = kparams()->phase_hi;
#define PH(n) if (lo <= (n) && (n) < hi)
#define SYNC(n) if (lo <= (n) && (n) + 1 < hi) grid_barrier(lds)
    if (hi > 1000) grid.sync();
    { volatile LAS unsigned* st = (volatile LAS unsigned*)(lds + 131072 + 2048);
      if (threadIdx.x == 0) { st[0] = 0u; st[1] = 0u; }
      __syncthreads();
      if (threadIdx.x == 0) (void)xb_add(&kparams()->bar[XB_XCNT(xb_xcc_id())], 1u); }
    PH(0) phase0(kparams(), lds);
#ifdef PROBE_P0
    __syncthreads(); phase0(kparams(), lds);
#endif
#ifdef PROBE_SYNC
    for (int i = 0; i < 24; ++i) grid_barrier(lds);
#endif
    SYNC(0);
    PH(1) phase_h(kparams());
#ifdef PROBE_ROWS
    phase_h(kparams());
#endif
    SYNC(1);
    for (int ph = 2; ph <= 12; ++ph) {
        if (ph == 4) { PH(4) attn_phase(kparams(), lds, 0);
#ifdef PROBE_ATTN2
            __syncthreads(); attn_phase(kparams(), lds, 1);
#endif
            SYNC(4); continue; }
        if (ph == 8) { PH(8) phase_mid(kparams());
#ifdef PROBE_ROWS
            phase_mid(kparams());
#endif
            SYNC(8); continue; }
        if (ph == 10) { PH(10) phase_convfix(kparams());

            SYNC(10); continue; }
        if (ph == 12) { PH(12) phase_final(kparams()); continue; }
        if (lo <= ph && ph < hi) {
            const int npass = (ph == 3 || ph == 6) ? 2 : 1;
            for (int pass = 0; pass < npass; ++pass) {
                GemmDesc d; d.C = nullptr; d.ldc = 0; d.start = 0; KP P = kparams();
                switch (ph) {
                case 2: d.A = P->h; d.lda = DM; d.Bt = P->WinT; d.ldb = DM; d.K = DM; d.nM = 65; d.nN = 9; d.epi = E_INPROJ; break;
                case 3: if (pass == 0) { d.A = P->qlat; d.lda = 384; d.Bt = P->WuqT; d.ldb = 384; d.K = 384; d.nM = 65; d.nN = 3; d.epi = E_UQ; }
                        else { d.A = P->latent; d.lda = 256; d.Bt = P->WukvT; d.ldb = 256; d.K = 256; d.nM = 193; d.nN = 4; d.epi = E_UKV; d.start = 195; } break;
                case 5: d.A = P->h; d.lda = DM; d.Bt = P->WgT; d.ldb = DM; d.K = DM; d.nM = 64; d.nN = 8; d.epi = E_GATE; break;
                case 6: d.A = P->o + pass * 512; d.lda = DM; d.Bt = pass ? P->WpbT : P->WpaT; d.ldb = 512; d.K = 512; d.nM = 64; d.nN = 4; d.epi = pass ? E_PROJB : E_PROJA; break;
                case 7: d.A = P->merged; d.lda = DM; d.Bt = P->WoutT; d.ldb = DM; d.K = DM; d.nM = 64; d.nN = 4; d.epi = E_PLAIN; d.C = P->m2; d.ldc = DM; break;
                case 9: d.A = P->h2; d.lda = DM; d.Bt = P->WupT; d.ldb = DM; d.K = DM; d.nM = 65; d.nN = 22; d.epi = E_UP; break;
                default: d.A = P->g; d.lda = DFF; d.Bt = P->WdownT; d.ldb = DFF; d.K = DFF; d.nM = 64; d.nN = 4; d.epi = E_PLAIN; d.C = P->f; d.ldc = DM; break;
                }
                gemm_run(d, lds);
#ifdef PROBE_GEMM2
                if (ph == PROBE_GEMM2 && !(ph == 6 && pass == 0)) { __syncthreads(); if (ph == 6) { GemmDesc d0 = d; d0.A = P->o; d0.Bt = P->WpaT; d0.epi = E_PROJA; gemm_run(d0, lds); } gemm_run(d, lds); }
#endif
            }
        }
        if (lo <= ph && ph < hi) {
            KP P = kparams();
            if (ph == 5) gemm_small<1, 8>(P, P->h, DM, P->WgT, DM, 2048, P->gates, 2048, lds);
            else if (ph == 6) gemm_small<2, 4>(P, P->o, DM, P->WpaT, 512, 1024, P->merged, DM, lds);
            else if (ph == 7) gemm_small<0, 8>(P, P->merged, DM, P->WoutT, DM, 1024, P->m2, DM, lds);
            else if (ph == 11) gemm_small<0, 22>(P, P->g, DFF, P->WdownT, DFF, 1024, P->f, DM, lds);
#ifdef PROBE_SMALL
            if (ph == 5) gemm_small<1, 8>(P, P->h, DM, P->WgT, DM, 2048, P->gates, 2048, lds);
            else if (ph == 6) gemm_small<2, 4>(P, P->o, DM, P->WpaT, 512, 1024, P->merged, DM, lds);
            else if (ph == 7) gemm_small<0, 8>(P, P->merged, DM, P->WoutT, DM, 1024, P->m2, DM, lds);
            else if (ph == 11) gemm_small<0, 22>(P, P->g, DFF, P->WdownT, DFF, 1024, P->f, DM, lds);
#endif
        }
        SYNC(ph);
    }
}

static size_t bump(size_t& off, size_t bytes) { size_t r = off; off += (bytes + 255) & ~(size_t)255; return r; }

extern "C" void kernel_launch(void* const* d_in, const int* in_sizes, int n_in, void* d_out, int out_size, void* d_ws, size_t ws_size, hipStream_t stream) {
    Params P; memset(&P, 0, sizeof(P));
    const float* const* in = (const float* const*)d_in;
    P.x_p = in[0]; P.x_s = in[1]; P.c_ckv = in[2]; P.c_kr = in[3]; P.c_sbk = in[4]; P.c_sbv = in[5]; P.c_conv = in[6]; P.c_p = in[7]; P.c_s = in[8];
    P.w_ada = in[9]; P.b_ada = in[10]; P.g_pre_mix = in[11]; P.g_post_mix = in[12]; P.g_pre_ffn = in[13]; P.g_post_ffn = in[14];
    const float* w_in = in[15]; const float* g_q = in[16]; const float* w_uq = in[17]; P.g_kv = in[18]; const float* w_uk = in[19]; const float* w_uv = in[20];
    const float* w_pa = in[21]; const float* w_pb = in[22]; const float* w_out = in[23]; const float* w_up = in[24]; P.conv_w = in[25]; P.conv_b = in[26]; const float* w_down = in[27];
    P.out = (float*)d_out;
    char* ws = (char*)d_ws; size_t off = 0;
    P.WupT = (bf16_t*)(ws + bump(off, (size_t)DFF2 * DM * 2));
    P.WdownT = (bf16_t*)(ws + bump(off, (size_t)DM * DFF * 2));
    P.ropeT = (float*)(ws + bump(off, (size_t)TP * 32 * 4));
    P.ada = (float*)(ws + bump(off, 10 * 6144 * 4));
    P.ctr = (unsigned*)(ws + bump(off, 256));
    P.bar = (unsigned*)(ws + bump(off, XCD_BAR_WORDS * 4));
    const size_t R0 = off;
    P.WinT = (bf16_t*)(ws + bump(off, (size_t)2304 * DM * 2));
    P.WgT = (bf16_t*)(ws + bump(off, (size_t)2048 * DM * 2));
    P.WuqT = (bf16_t*)(ws + bump(off, (size_t)768 * 384 * 2));
    P.WukvT = (bf16_t*)(ws + bump(off, (size_t)1024 * 256 * 2));
    P.WpaT = (bf16_t*)(ws + bump(off, (size_t)1024 * 512 * 2));
    P.WpbT = (bf16_t*)(ws + bump(off, (size_t)1024 * 512 * 2));
    P.WoutT = (bf16_t*)(ws + bump(off, (size_t)1024 * 1024 * 2));
    const size_t o_kva = off;
    P.kva = (bf16_t*)(ws + bump(off, (size_t)KVROWS_PAD * 512 * 2));
    P.vaT_p = (bf16_t*)(ws + bump(off, (size_t)2 * 512 * TP * 2));
    P.vaT_s = (bf16_t*)(ws + bump(off, (size_t)8 * 512 * SKP * 2));
    const size_t o_kb = off;
    P.kb = (bf16_t*)(ws + bump(off, (size_t)KVROWS_PAD * 512 * 2));
    const size_t o_vbT = off;
    P.vbT_p = (bf16_t*)(ws + bump(off, (size_t)2 * 512 * TP * 2));
    P.vbT_s = (bf16_t*)(ws + bump(off, (size_t)8 * 512 * SKP * 2));
    const size_t o_kr = off;
    P.krope = (bf16_t*)(ws + bump(off, (size_t)KVROWS_PAD * 32 * 2));
    P.qb = (bf16_t*)(ws + bump(off, (size_t)MT * 512 * 2));
    P.q = (bf16_t*)(ws + bump(off, (size_t)MT * 768 * 2));
    P.latent = (bf16_t*)(ws + bump(off, (size_t)KVROWS_PAD * 256 * 2));
    size_t need = off;
    P.gates = (bf16_t*)(ws + o_kva);
    P.merged = (bf16_t*)(ws + o_kb);
    P.m2 = (bf16_t*)(ws + o_vbT);
    const size_t o_g = R0 + (size_t)MT * DFF2 * 2;
    P.g = (bf16_t*)(ws + R0);
    P.f = (bf16_t*)(ws + R0 + (size_t)100 * 1024 * 1024);
    P.ub = (bf16_t*)(ws + R0 + (size_t)140 * 1024 * 1024);
    P.u = (bf16_t*)(ws + R0 + (size_t)155 * 1024 * 1024);
    size_t o_h2 = o_kr > o_g ? o_kr : o_g;
    P.h2 = (bf16_t*)(ws + o_h2);
    if (o_h2 + (size_t)MT * DM * 2 > need) need = o_h2 + (size_t)MT * DM * 2;
    P.h = (bf16_t*)d_out;
    P.o = (bf16_t*)d_out + (size_t)MT * DM;
    P.qlat = P.o;
    if (need > ws_size) { fprintf(stderr, "workspace too small: need %zu have %zu\n", need, ws_size); return; }

    int nj = 0, tiles = 0;
    auto job = [&](const float* src, int lds, int coff, bf16_t* dst, int ldd, int Klen, int Nlen, const float* ks, int zero) {
        TJob& J = P.tj[nj++]; J.src = src; J.kscale = ks; J.dst = dst; J.lds = lds; J.coff = coff; J.ldd = ldd; J.Klen = Klen; J.Nlen = Nlen; J.zero = zero; J.tile0 = tiles; J.pad = 0;
        tiles += (Klen / 64) * ((Nlen + 255) / 256); };
    job(w_up, DFF2, 0, P.WupT, DM, DM, DFF2, nullptr, 2);
    job(w_down, DM, 0, P.WdownT, DFF, DFF, DM, nullptr, 0);
    job(w_in, 4256, 0, P.WinT, DM, DM, 384, nullptr, 0);
    job(w_in, 4256, 640, P.WinT + (size_t)384 * DM, DM, DM, 32, nullptr, 0);
    job(w_in, 4256, 0, P.WinT + (size_t)416 * DM, DM, DM, 96, nullptr, 1);
    job(w_in, 4256, 384, P.WinT + (size_t)512 * DM, DM, DM, 256, nullptr, 0);
    job(w_in, 4256, 672, P.WinT + (size_t)768 * DM, DM, DM, 1536, nullptr, 0);
    job(w_in, 4256, 2208, P.WgT, DM, DM, 2048, nullptr, 0);
    job(w_uq, 768, 0, P.WuqT, 384, 384, 768, g_q, 0);
    job(w_uk, 512, 0, P.WukvT, 256, 256, 512, nullptr, 0);
    job(w_uv, 512, 0, P.WukvT + (size_t)512 * 256, 256, 256, 512, nullptr, 0);
    job(w_pa, DM, 0, P.WpaT, 512, 512, DM, nullptr, 0);
    job(w_pb, DM, 0, P.WpbT, 512, 512, DM, nullptr, 0);
    job(w_out, DM, 0, P.WoutT, DM, DM, DM, nullptr, 0);
    P.ntj_tiles = tiles; P.pad0 = nj;
    for (int q = nj; q < NTJ; ++q) P.tj[q].tile0 = 0x7fffffff;
    P.phase_lo = 0; P.phase_hi = 13;

    static int grid_blocks = 0;
    if (!grid_blocks) {
        (void)hipFuncSetAttribute((const void*)fwd_megakernel, hipFuncAttributeMaxDynamicSharedMemorySize, LDS_BYTES);
        int dev = 0, cus = 0, per_cu = 0;
        (void)hipGetDevice(&dev);
        (void)hipDeviceGetAttribute(&cus, hipDeviceAttributeMultiprocessorCount, dev);
        (void)hipOccupancyMaxActiveBlocksPerMultiprocessor(&per_cu, fwd_megakernel, NTHREADS, LDS_BYTES);
        if (per_cu > 1) per_cu = 1;
        grid_blocks = cus * per_cu;
    }
    (void)hipMemsetAsync(P.ctr, 0, 256 + XCD_BAR_WORDS * 4, stream);
    void* args[] = {&P};
    hipError_t e = hipLaunchCooperativeKernel((const void*)fwd_megakernel, dim3(grid_blocks), dim3(NTHREADS), args, LDS_BYTES, stream);
    if (e != hipSuccess) fprintf(stderr, "cooperative launch failed: %s (grid %d)\n", hipGetErrorString(e), grid_blocks);
}
```

```cpp
#include <hip/hip_runtime.h>
#include <hip/hip_cooperative_groups.h>
#include <stdint.h>
#include <stdio.h>
#include <string.h>
namespace cg = cooperative_groups;

typedef unsigned short bf16_t;
typedef short bf16x8 __attribute__((ext_vector_type(8)));
typedef short s16x4 __attribute__((ext_vector_type(4)));
typedef float f32x2 __attribute__((ext_vector_type(2)));
typedef float f32x4 __attribute__((ext_vector_type(4)));
typedef float f32x16 __attribute__((ext_vector_type(16)));
typedef unsigned u32x2 __attribute__((ext_vector_type(2)));
typedef unsigned u32x4 __attribute__((ext_vector_type(4)));
typedef __bf16 bf2_t __attribute__((ext_vector_type(2)));
#define DI __device__ __forceinline__

constexpr int DM = 1024, TP = 8192, MP = 16384, MS = 256, MT = 16640, PAST = 4096, SKEYS = 4128, SKP = 4160;
constexpr int KVROWS = MP + 8 * SKEYS;
constexpr int KVROWS_PAD = KVROWS + 64;
constexpr int DFF = 2816, DFF2 = 5632;
constexpr float EPS = 1e-6f;
constexpr float LOG2E = 1.4426950408889634f, LN2 = 0.6931471805599453f;
constexpr int NTHREADS = 512;
constexpr int LDS_BYTES = 131072 + 8192;
constexpr long O_Y = 0, O_CKV_P = 17039360, O_KR_P = 21233664, O_SBK_P = 21757952, O_SBV_P = 30146560, O_CONV_P = 38535168,
               O_CKV_S = 38557696, O_KR_S = 38623232, O_SBK_S = 38631424, O_SBV_S = 38762496, O_CONV_S = 38893568;

struct TJob { const float* src; const float* kscale; bf16_t* dst; int lds, coff, ldd, Klen, Nlen, zero, tile0, pad; };
constexpr int NTJ = 22;

struct Params {
    const float *x_p, *x_s, *c_ckv, *c_kr, *c_sbk, *c_sbv, *c_conv, *c_p, *c_s;
    const float *w_ada, *b_ada, *g_pre_mix, *g_post_mix, *g_pre_ffn, *g_post_ffn, *g_kv, *conv_w, *conv_b;
    float* out;
    bf16_t *WupT, *WdownT, *WinT, *WgT, *WuqT, *WukvT, *WpaT, *WpbT, *WoutT;
    float* ropeT; float* ada; unsigned* ctr; unsigned* bar;
    bf16_t *h, *o, *qlat, *latent, *krope, *kb, *vbT_p, *vbT_s, *qb, *q, *kva, *vaT_p, *vaT_s, *gates, *merged, *m2, *h2, *u, *g, *f, *ub;
    TJob tj[NTJ]; int ntj_tiles; int phase_lo, phase_hi, pad0;
};

#define LAS __attribute__((address_space(3)))
typedef const Params __attribute__((address_space(4))) * KP;
DI KP kparams() { KP p = (KP)__builtin_amdgcn_kernarg_segment_ptr(); asm volatile("" : "+s"(p)); return p; }
DI int otid() { int t = threadIdx.x; asm volatile("" : "+v"(t)); return t; }
DI int obid() { int b = blockIdx.x; asm volatile("" : "+s"(b)); return b; }
DI int ogrid() { int g = gridDim.x; asm volatile("" : "+s"(g)); return g; }
DI unsigned pk2(float a, float b) { f32x2 f = {a, b}; bf2_t r = __builtin_convertvector(f, bf2_t); return __builtin_bit_cast(unsigned, r); }
DI float bf_lo(unsigned u) { return __uint_as_float(u << 16); }
DI float bf_hi(unsigned u) { return __uint_as_float(u & 0xffff0000u); }
DI int kvrow_of(int row) { if (row < MP) return row; const int r = row - MP; return MP + (r >> 5) * SKEYS + PAST + (r & 31); }
DI int pos_of(int row) { return row < MP ? (row & (TP - 1)) : PAST + ((row - MP) & 31); }
DI int ada_b(int row) { return row < MP ? (row >> 13) : 2 + ((row - MP) >> 5); }
DI float sigmoidf_(float x) { return __builtin_amdgcn_rcpf(1.0f + __builtin_amdgcn_exp2f(-1.4426950408889634f * x)); }

constexpr int BM = 256, BK = 64, HALF = 128, HT = HALF * BK;
DI int lds_byte(int r, int c) { int st = (r >> 4) * 2 + (c >> 5), rr = r & 15, cc = c & 31, ob = rr * 64 + cc * 2; return st * 1024 + (ob ^ (((ob >> 9) & 1) << 5)); }
DI void stage_rc(int b, int& R, int& C) { int st = b / 1024, sb = b % 1024, swz = sb ^ (((sb >> 9) & 1) << 5); R = (st >> 1) * 16 + swz / 64; C = (st & 1) * 32 + (swz % 64) / 2; }

enum { E_INPROJ = 0, E_GATE, E_UQ, E_UKV, E_PROJA, E_PROJB, E_PLAIN, E_UP };
struct GemmDesc { const bf16_t* A; const bf16_t* Bt; bf16_t* C; int lda, ldb, ldc, K, nM, nN, epi, start; };

constexpr int HTB = HT * 2;
#define SA(b, h) (((b) * 2 + (h)) * HTB)
#define SB(b, h) ((4 + (b) * 2 + (h)) * HTB)
#define STAGE(bufoff, gbase, voff) do { _Pragma("unroll") for (int _i = 0; _i < 2; ++_i) \
    __builtin_amdgcn_global_load_lds((const unsigned*)((const char*)(gbase) + (voff)[_i]), (LAS unsigned*)(ldsl + (bufoff) + ldsw + _i * 8192), 16, 0, 0); } while (0)
#define LDA(dst, b, h) do { _Pragma("unroll") for (int m = 0; m < 4; ++m) _Pragma("unroll") for (int k = 0; k < 2; ++k) dst[m][k] = *(const LAS bf16x8*)(ldsl + SA(b, h) + aoff + m * 2048 + k * 1024); } while (0)
#define LDB(dst, b, h) do { _Pragma("unroll") for (int n = 0; n < 2; ++n) _Pragma("unroll") for (int k = 0; k < 2; ++k) dst[n][k] = *(const LAS bf16x8*)(ldsl + SB(b, h) + boff + n * 2048 + k * 1024); } while (0)
#define MMA(ai, bj, At, Bt_) do { __builtin_amdgcn_s_setprio(1); _Pragma("unroll") for (int m = 0; m < 4; ++m) _Pragma("unroll") for (int n = 0; n < 2; ++n) _Pragma("unroll") for (int k = 0; k < 2; ++k) \
      acc[ai][bj][m][n] = __builtin_amdgcn_mfma_f32_16x16x32_bf16(Bt_[n][k], At[m][k], acc[ai][bj][m][n], 0, 0, 0); \
    __builtin_amdgcn_s_setprio(0); } while (0)
#define WAIT_V(n) asm volatile("s_waitcnt vmcnt(" #n ")" ::: "memory")
#define WAIT_L(n) asm volatile("s_waitcnt lgkmcnt(" #n ")" ::: "memory")
#define BAR __builtin_amdgcn_s_barrier()
#define SCHED __builtin_amdgcn_sched_barrier(0)
#define ZERO_ACC do { _Pragma("unroll") for (int a_ = 0; a_ < 2; ++a_) _Pragma("unroll") for (int b_ = 0; b_ < 2; ++b_) _Pragma("unroll") for (int m_ = 0; m_ < 4; ++m_) _Pragma("unroll") for (int n_ = 0; n_ < 2; ++n_) \
    acc[a_][b_][m_][n_] = (f32x4){0.f, 0.f, 0.f, 0.f}; } while (0)

#define EPI_ROWS for (int ai = 0; ai < 2; ++ai) for (int m = 0; m < 4; ++m, ({ asm volatile("" ::: "memory"); }))
#define EPI_COLS for (int bj = 0; bj < 2; ++bj) for (int n = 0; n < 2; ++n)

DI float dpp_xor1(float x) { return __int_as_float(__builtin_amdgcn_mov_dpp(__float_as_int(x), 0xB1, 0xF, 0xF, true)); }
DI float dpp_xor2(float x) { return __int_as_float(__builtin_amdgcn_mov_dpp(__float_as_int(x), 0x4E, 0xF, 0xF, true)); }
DI float gelu_tanh(float a) { const float a2 = a * a; const float q = a * __builtin_fmaf(0.10294324f, a2, 2.3022082f);
    const float e = __builtin_amdgcn_exp2f(q); const float r = __builtin_amdgcn_rcpf(1.0f + e); return __builtin_fmaf(-a, r, a); }
DI float dpp_ror1(float x) { return __int_as_float(__builtin_amdgcn_mov_dpp(__float_as_int(x), 0x121, 0xF, 0xF, true)); }
DI float dpp_ror2(float x) { return __int_as_float(__builtin_amdgcn_mov_dpp(__float_as_int(x), 0x122, 0xF, 0xF, true)); }
DI f32x4 ror1_4(f32x4 v) { return (f32x4){dpp_ror1(v[0]), dpp_ror1(v[1]), dpp_ror1(v[2]), dpp_ror1(v[3])}; }
DI f32x4 ror2_4(f32x4 v) { return (f32x4){dpp_ror2(v[0]), dpp_ror2(v[1]), dpp_ror2(v[2]), dpp_ror2(v[3])}; }
DI f32x4 quad_transpose(f32x4 v, int i) {
    { const float a = (i & 1) ? v[0] : v[1], c = (i & 1) ? v[2] : v[3]; const float ra = dpp_xor1(a), rc = dpp_xor1(c);
      if (i & 1) { v[0] = ra; v[2] = rc; } else { v[1] = ra; v[3] = rc; } }
    { const float a = (i & 2) ? v[0] : v[2], c = (i & 2) ? v[1] : v[3]; const float ra = dpp_xor2(a), rc = dpp_xor2(c);
      if (i & 2) { v[0] = ra; v[1] = rc; } else { v[2] = ra; v[3] = rc; } }
    return v;
}
DI void store_bf4(bf16_t* p, f32x4 v) { u32x2 w; w.x = pk2(v[0], v[1]); w.y = pk2(v[2], v[3]); *(u32x2*)p = w; }

DI int unit_at(int k, int bid, int G, int nM, int nN, int start) {
    if (G != 256) { const int u = (bid + G - (start % G)) % G + k * G; return u < nM * nN ? u : -1; }
    const int x = bid & 7, l = ((bid >> 3) + start) & 31, cnt = nM >> 3, mainn = cnt * nN, j = l + 32 * k;
    if (j < mainn) { const int pn = j / cnt, rm = j - pn * cnt; return (x + 8 * rm) * nN + pn; }
    const int idx = x + 8 * (j - mainn);
    if (idx < (nM & 7) * nN) return (8 * cnt + idx / nN) * nN + idx % nN;
    return -1;
}

DI void gemm_run(const GemmDesc& d, char* lds) {
    LAS char* ldsl = (LAS char*)lds;
    float* xl = (float*)(lds + 131072);
    float* xp = (float*)(lds + 131072 + 4096);
    const int G = ogrid(), bid_ = obid(), first = unit_at(0, bid_, G, d.nM, d.nN, d.start);
    if (first < 0) return;
    int kun = 0;
    const int tid = otid(), wid = __builtin_amdgcn_readfirstlane(tid >> 6), wr = wid >> 2, wc = wid & 3;
    const unsigned lda2 = (unsigned)d.lda * 2u, ldb2 = (unsigned)d.ldb * 2u;
    unsigned voffA[2], voffB[2];
    { const int lane = tid & 63;
#pragma unroll
      for (int i = 0; i < 2; ++i) { int R, C; stage_rc(tid * 16 + i * 8192, R, C); voffA[i] = (unsigned)R * lda2 + (unsigned)C * 2u; voffB[i] = (unsigned)R * ldb2 + (unsigned)C * 2u; }
      (void)lane; }
    const size_t kstep = 128, hA = (size_t)HALF * lda2, hB = (size_t)HALF * ldb2;
    const unsigned ldsw = (unsigned)wid * 1024u;
    const int aoff = lds_byte(wr * 64 + (tid & 15), ((tid & 63) >> 4) * 8), boff = lds_byte(wc * 32 + (tid & 15), ((tid & 63) >> 4) * 8);
    const int nt = d.K / BK;
    int u = first;
    const char* cA = (const char*)d.A + (size_t)(u / d.nN) * 2 * hA; const char* cB = (const char*)d.Bt + (size_t)(u % d.nN) * 2 * hB;
    f32x4 acc[2][2][4][2];
    ZERO_ACC;
    bf16x8 At[4][2], B0[2][2], B1[2][2];
    STAGE(SB(0, 0), cB, voffB); STAGE(SB(0, 1), cB + hB, voffB); STAGE(SA(0, 0), cA, voffA); STAGE(SA(0, 1), cA + hA, voffA);
    if (wr == 1) BAR;
    WAIT_V(2); BAR;
    STAGE(SB(1, 0), cB + kstep, voffB); STAGE(SA(1, 0), cA + kstep, voffA); STAGE(SB(1, 1), cB + hB + kstep, voffB);
    WAIT_V(6); BAR;
    for (;;) {
        const int un = unit_at(kun + 1, bid_, G, d.nM, d.nN, d.start); const bool has_next = un >= 0;
        const char* nA = has_next ? (const char*)d.A + (size_t)(un / d.nN) * 2 * hA : cA; const char* nB = has_next ? (const char*)d.Bt + (size_t)(un % d.nN) * 2 * hB : cB;
        for (int t = 0; t < nt; t += 2) {
            const bool last = (t == nt - 2);
            const char* a1 = cA + (size_t)(t + 1) * kstep;
            const char* a2 = last ? nA : cA + (size_t)(t + 2) * kstep; const char* b2 = last ? nB : cB + (size_t)(t + 2) * kstep;
            const char* a3 = a2 + kstep; const char* b3 = b2 + kstep;
            LDB(B0, 0, 0); LDB(B1, 0, 1); SCHED; LDA(At, 0, 0); STAGE(SA(1, 1), a1 + hA, voffA);
            WAIT_V(8); WAIT_L(0); BAR; MMA(0, 0, At, B0); MMA(0, 1, At, B1); BAR; SCHED;
            LDA(At, 0, 1); STAGE(SB(0, 0), b2, voffB); STAGE(SB(0, 1), b2 + hB, voffB); STAGE(SA(0, 0), a2, voffA);
            WAIT_V(8); WAIT_L(0); BAR; MMA(1, 0, At, B0); MMA(1, 1, At, B1); BAR; SCHED;
            LDB(B0, 1, 0); LDB(B1, 1, 1); SCHED; LDA(At, 1, 0); STAGE(SA(0, 1), a2 + hA, voffA);
            WAIT_V(8); WAIT_L(0); BAR; MMA(0, 0, At, B0); MMA(0, 1, At, B1); BAR; SCHED;
            LDA(At, 1, 1); STAGE(SB(1, 0), b3, voffB); STAGE(SB(1, 1), b3 + hB, voffB); STAGE(SA(1, 0), a3, voffA);
            WAIT_V(8); WAIT_L(0); BAR; MMA(1, 0, At, B0); MMA(1, 1, At, B1); BAR; SCHED;
        }
        if (wr == 0) BAR;
        {
        const int pm = u / d.nN, pn = u % d.nN, brow = pm * BM, bcol = pn * BM;
        if (d.epi == E_UQ) {
            const int tq_ = otid(), r = tq_ >> 1, hf = tq_ & 1;
            const u32x4* src = (const u32x4*)(d.A + (long)(brow + r) * 384 + hf * 192);
            float sq = 0.f;
#pragma unroll 4
            for (int i = 0; i < 24; ++i) { u32x4 v = src[i];
                for (int e = 0; e < 4; ++e) { float a_ = bf_lo(v[e]), b_ = bf_hi(v[e]); sq += a_ * a_ + b_ * b_; } }
            sq += __shfl_xor(sq, 1);
            if (hf == 0) xl[r] = rsqrtf(sq * (1.0f / 384.0f) + EPS);
            WAIT_L(0); BAR; asm volatile("" ::: "memory");
        }
        int lane_e = threadIdx.x & 63; asm volatile("" : "+v"(lane_e));
        const int fr = lane_e & 15, fq = lane_e >> 4;
        KP P = kparams();
        const int rbase = brow + wr * 64 + fr, cbase = bcol + wc * 32 + fq * 4;
        switch (d.epi) {
        case E_INPROJ: {
            if (pn == 0) {
#pragma unroll
                EPI_ROWS { const int row = rbase + ai * 128 + m * 16;
#pragma unroll
                    EPI_COLS store_bf4(P->qlat + (long)row * 384 + (cbase + bj * 128 + n * 16), acc[ai][bj][m][n]); }
            } else if (pn == 1) {
#pragma unroll
                EPI_ROWS { const int row = rbase + ai * 128 + m * 16;
#pragma unroll
                    for (int n = 0; n < 2; ++n) store_bf4(P->qlat + (long)row * 384 + 256 + (wc * 32 + fq * 4 + n * 16), acc[ai][0][m][n]);
                    if (wc == 0) {
                        const int pos = pos_of(row);
                        const f32x4 cs0 = *(const f32x4*)(P->ropeT + (long)pos * 32 + fq * 8), cs1 = *(const f32x4*)(P->ropeT + (long)pos * 32 + fq * 8 + 4);
                        const f32x4 x1 = acc[ai][1][m][0], x2 = acc[ai][1][m][1];
                        f32x4 co = {cs0[0], cs0[2], cs1[0], cs1[2]}, si = {cs0[1], cs0[3], cs1[1], cs1[3]};
                        f32x4 o1 = x1 * co - x2 * si, o2 = x2 * co + x1 * si;
                        float* of = P->out + (row < MP ? O_KR_P + (long)row * 32 : O_KR_S + (long)(row - MP) * 32);
                        *(f32x4*)(of + fq * 4) = o1; *(f32x4*)(of + 16 + fq * 4) = o2;
                        bf16_t* ob = P->krope + (long)kvrow_of(row) * 32;
                        store_bf4(ob + fq * 4, o1); store_bf4(ob + 16 + fq * 4, o2);
                    } }
            } else if (pn == 2) {
                float ss[2][4];
#pragma unroll
                EPI_ROWS { float s = 0.f;
#pragma unroll
                    EPI_COLS { const f32x4 v = acc[ai][bj][m][n]; s += v[0] * v[0] + v[1] * v[1] + v[2] * v[2] + v[3] * v[3]; }
                    s += __shfl_xor(s, 16); s += __shfl_xor(s, 32); ss[ai][m] = s;
                    if (fq == 0) xp[(ai * 128 + wr * 64 + m * 16 + fr) * 4 + wc] = s; }
                WAIT_L(0); BAR; asm volatile("" ::: "memory");
#pragma unroll
                EPI_ROWS { const int rl = ai * 128 + wr * 64 + m * 16 + fr, row = brow + rl;
                    const f32x4 pp = *(const f32x4*)(xp + rl * 4);
                    const float rstd = rsqrtf((pp[0] + pp[1] + pp[2] + pp[3]) * (1.0f / 256.0f) + EPS);
                    float* of = P->out + (row < MP ? O_CKV_P + (long)row * 256 : O_CKV_S + (long)(row - MP) * 256);
                    bf16_t* ob = P->latent + (long)kvrow_of(row) * 256;
#pragma unroll
                    EPI_COLS { const int c = wc * 32 + fq * 4 + bj * 128 + n * 16;
                        const f32x4 gv = *(const f32x4*)(P->g_kv + c); const f32x4 o = acc[ai][bj][m][n] * rstd * gv;
                        *(f32x4*)(of + c) = o; store_bf4(ob + c, o); } }
            } else if (pn <= 4) {
#pragma unroll
                EPI_ROWS { const int row = rbase + ai * 128 + m * 16;
#pragma unroll
                    EPI_COLS store_bf4(P->qb + (long)row * 512 + (cbase - 768 + bj * 128 + n * 16), acc[ai][bj][m][n] * 0.125f); }
            } else if (pn <= 6) {
#pragma unroll
                EPI_ROWS { const int row = rbase + ai * 128 + m * 16;
                    float* of = P->out + (row < MP ? O_SBK_P + (long)row * 512 : O_SBK_S + (long)(row - MP) * 512);
                    bf16_t* ob = P->kb + (long)kvrow_of(row) * 512;
#pragma unroll
                    EPI_COLS { const int c = cbase - 1280 + bj * 128 + n * 16; *(f32x4*)(of + c) = acc[ai][bj][m][n]; store_bf4(ob + c, acc[ai][bj][m][n]); } }
            } else {
#pragma unroll
                EPI_ROWS { const int row = rbase + ai * 128 + m * 16;
                    float* of = P->out + (row < MP ? O_SBV_P + (long)row * 512 : O_SBV_S + (long)(row - MP) * 512);
                    const int qi = fr & 3, row4 = row - qi;
                    bf16_t* vt; int ldv;
                    if (row4 < MP) { vt = P->vbT_p + (long)(row4 >> 13) * 512 * TP + (row4 & (TP - 1)); ldv = TP; }
                    else { const int r = row4 - MP; vt = P->vbT_s + (long)(r >> 5) * 512 * SKP + PAST + (r & 31); ldv = SKP; }
#pragma unroll
                    EPI_COLS { const int c = cbase - 1792 + bj * 128 + n * 16; const f32x4 v = acc[ai][bj][m][n]; *(f32x4*)(of + c) = v;
                        store_bf4(vt + (long)(c + qi) * ldv, quad_transpose(v, qi)); } }
            }
        } break;
        case E_GATE: {
#pragma unroll
            EPI_ROWS { const int row = rbase + ai * 128 + m * 16;
#pragma unroll
                EPI_COLS { const f32x4 v = acc[ai][bj][m][n]; f32x4 s = {sigmoidf_(v[0]), sigmoidf_(v[1]), sigmoidf_(v[2]), sigmoidf_(v[3])};
                    store_bf4(P->gates + (long)row * 2048 + (cbase + bj * 128 + n * 16), s); } }
        } break;
        case E_UQ: {
            const float qs = 0.10206207261596577f * LOG2E;
#pragma unroll
            EPI_ROWS { const int rl = ai * 128 + wr * 64 + m * 16 + fr, row = brow + rl; const float rs = xl[rl] * qs;
#pragma unroll
                for (int bj = 0; bj < 2; ++bj) { const int grp = pn * 8 + bj * 4 + wc; bf16_t* dst = P->q + (long)row * 768 + grp * 32 + fq * 4;
                    f32x4 v0 = acc[ai][bj][m][0] * rs, v1 = acc[ai][bj][m][1] * rs;
                    if (grp % 3 == 2) {
                        const int pos = pos_of(row);
                        const f32x4 cs0 = *(const f32x4*)(P->ropeT + (long)pos * 32 + fq * 8), cs1 = *(const f32x4*)(P->ropeT + (long)pos * 32 + fq * 8 + 4);
                        f32x4 co = {cs0[0], cs0[2], cs1[0], cs1[2]}, si = {cs0[1], cs0[3], cs1[1], cs1[3]};
                        const f32x4 o1 = v0 * co - v1 * si, o2 = v1 * co + v0 * si; v0 = o1; v1 = o2;
                    }
                    store_bf4(dst, v0); store_bf4(dst + 16, v1); } }
        } break;
        case E_UKV: {
#pragma unroll
            EPI_ROWS { const int row = rbase + ai * 128 + m * 16;
                if (pn < 2) {
#pragma unroll
                    EPI_COLS store_bf4(P->kva + (long)row * 512 + (cbase + bj * 128 + n * 16), acc[ai][bj][m][n]);
                } else {
                    const int qi = fr & 3, row4 = row - qi;
                    bf16_t* vt; int ldv;
                    if (row4 < MP) { vt = P->vaT_p + (long)(row4 >> 13) * 512 * TP + (row4 & (TP - 1)); ldv = TP; }
                    else { const int r = row4 - MP, b = r / SKEYS; vt = P->vaT_s + (long)b * 512 * SKP + (r - b * SKEYS); ldv = SKP; }
#pragma unroll
                    EPI_COLS { const int c = cbase - 512 + bj * 128 + n * 16; const f32x4 vtr = quad_transpose(acc[ai][bj][m][n], qi);
                        if (row4 < KVROWS) store_bf4(vt + (long)(c + qi) * ldv, vtr); }
                } }
        } break;
        case E_PROJA: case E_PROJB: {
            const int goff = d.epi == E_PROJA ? 0 : 1024;
#pragma unroll
            EPI_ROWS { const int row = rbase + ai * 128 + m * 16;
#pragma unroll
                EPI_COLS { const int c = cbase + bj * 128 + n * 16; const u32x2 gw = *(const u32x2*)(P->gates + (long)row * 2048 + goff + c);
                    f32x4 gv = {bf_lo(gw.x), bf_hi(gw.x), bf_lo(gw.y), bf_hi(gw.y)}; f32x4 v = acc[ai][bj][m][n] * gv;
                    bf16_t* dst = P->merged + (long)row * 1024 + c;
                    if (d.epi == E_PROJB) { const u32x2 pw = *(const u32x2*)dst; f32x4 pv = {bf_lo(pw.x), bf_hi(pw.x), bf_lo(pw.y), bf_hi(pw.y)}; v += pv; }
                    store_bf4(dst, v); } }
        } break;
        case E_PLAIN: {
#pragma unroll
            EPI_ROWS { const int row = rbase + ai * 128 + m * 16;
#pragma unroll
                EPI_COLS store_bf4(d.C + (long)row * d.ldc + (cbase + bj * 128 + n * 16), acc[ai][bj][m][n]); }
        } break;
        case E_UP: {
            const int jc0 = pn * 128 + wc * 32 + fq * 4;
            if (pm != 64) {
                const int tq_ = otid(), arr = tq_ >> 6, c2 = (tq_ & 63) * 2, hfb = arr >> 2, kk = arr & 3;
                const float* src = (kk < 3 ? P->conv_w + kk * DFF2 : P->conv_b) + hfb * DFF + pn * 128 + c2;
                *(f32x2*)(xp + arr * 128 + c2) = *(const f32x2*)src;
                WAIT_L(0); BAR; asm volatile("" ::: "memory");
            }
            if (pm == 64) {
#pragma unroll
                EPI_ROWS { const int row = rbase + ai * 128 + m * 16, r = row - MP, t = r & 31;
                    float* cf = t >= 30 ? P->out + O_CONV_S + (long)((r >> 5) * 2 + (t - 30)) * DFF2 : nullptr;
#pragma unroll
                    EPI_COLS { const int c = (bj ? DFF : 0) + jc0 + n * 16; store_bf4(P->u + (long)r * DFF2 + c, acc[ai][bj][m][n]); if (cf) *(f32x4*)(cf + c) = acc[ai][bj][m][n]; } }
            } else {
#pragma unroll
                for (int ai = 0; ai < 2; ++ai)
#pragma unroll
                    for (int n = 0; n < 2; ++n) {
                        const int ca = jc0 + n * 16;
                        f32x4 pa1 = {0.f, 0.f, 0.f, 0.f}, pa2 = pa1, pb1 = pa1, pb2 = pa1;
#pragma unroll
                        for (int m = 0; m < 4; ++m) {
                            const int row = rbase + ai * 128 + m * 16;
                            const f32x4 va = acc[ai][0][m][n], vb = acc[ai][1][m][n];
                            const f32x4 ra1 = ror1_4(va), ra2 = ror2_4(va), rb1 = ror1_4(vb), rb2 = ror2_4(vb);
                            const f32x4 p1a = fr >= 1 ? ra1 : pa1, p2a = fr >= 2 ? ra2 : pa2, p1b = fr >= 1 ? rb1 : pb1, p2b = fr >= 2 ? rb2 : pb2;
                            const float* wl = xp + (ca - pn * 128);
                            f32x4 ya = *(const f32x4*)(wl + 3 * 128) + *(const f32x4*)(wl) * p2a; ya += *(const f32x4*)(wl + 128) * p1a; ya += *(const f32x4*)(wl + 2 * 128) * va;
                            f32x4 yb = *(const f32x4*)(wl + 7 * 128) + *(const f32x4*)(wl + 4 * 128) * p2b; yb += *(const f32x4*)(wl + 5 * 128) * p1b; yb += *(const f32x4*)(wl + 6 * 128) * vb;
                            const f32x4 g4 = {gelu_tanh(ya[0]) * yb[0], gelu_tanh(ya[1]) * yb[1], gelu_tanh(ya[2]) * yb[2], gelu_tanh(ya[3]) * yb[3]};
                            if (!(m == 0 && fr < 2)) store_bf4(P->g + (long)row * DFF + ca, g4);
                            const int blk = row >> 6;
                            if (m == 0 && fr < 2) { bf16_t* up = P->ub + (long)(blk * 4 + 2 + fr) * DFF2 + ca; store_bf4(up, va); store_bf4(up + DFF, vb); }
                            if (m == 3 && fr >= 14) { bf16_t* up = P->ub + (long)(blk * 4 + (fr - 14)) * DFF2 + ca; store_bf4(up, va); store_bf4(up + DFF, vb);
                                const int t = row & (TP - 1);
                                if (t >= TP - 2) { float* cf = P->out + O_CONV_P + (long)((row >> 13) * 2 + (t - (TP - 2))) * DFF2 + ca; *(f32x4*)cf = va; *(f32x4*)(cf + DFF) = vb; } }
                            pa1 = ra1; pa2 = ra2; pb1 = rb1; pb2 = rb2;
                            asm volatile("" ::: "memory");
                        }
                    }
            }
        } break;
        }
        }
        if (!has_next) break;
        ZERO_ACC;
        u = un; cA = nA; cB = nB; ++kun;
        if (wr == 1) BAR;
    }
    WAIT_V(0);
    BAR;
}

#define MFMA32(a, b, c) __builtin_amdgcn_mfma_f32_32x32x16_bf16((a), (b), (c), 0, 0, 0)
template <int KIND, int KSTEPS  >
DI void gemm_small(KP P, const bf16_t* A, int lda, const bf16_t* Bt, int ldb, int N, bf16_t* C, int ldc, char* lds) {
    const int tid = otid(), lane = tid & 63, w = tid >> 6, r = lane & 31, hh = lane >> 5, G = ogrid();
    const int ntask = 8 * (N >> 5);
    float* part = (float*)lds;
    for (int task = obid(); task < ntask; task += G) {
        const int cb = (task & 7) + 8 * (task >> 6), rb = (task >> 3) & 7, row0 = MP + rb * 32, col0 = cb * 32;
#pragma unroll
        for (int pass = 0; pass < (KIND == 2 ? 2 : 1); ++pass) {
            const bf16_t* ap = A + pass * 512 + (long)(row0 + r) * lda + w * (KSTEPS * 16) + 8 * hh;
            const bf16_t* bp = (pass ? P->WpbT : Bt) + (long)(col0 + r) * ldb + w * (KSTEPS * 16) + 8 * hh;
            f32x16 acc;
#pragma unroll
            for (int i = 0; i < 16; ++i) acc[i] = 0.f;
            constexpr int UN = KSTEPS > 11 ? 11 : KSTEPS;
#pragma unroll 1
            for (int s0 = 0; s0 < KSTEPS; s0 += UN) {
                bf16x8 af[UN], bf[UN];
#pragma unroll
                for (int s = 0; s < UN; ++s) { af[s] = *(const bf16x8*)(ap + (s0 + s) * 16); bf[s] = *(const bf16x8*)(bp + (s0 + s) * 16); }
#pragma unroll
                for (int s = 0; s < UN; ++s) acc = MFMA32(bf[s], af[s], acc);
            }
            float* pp = part + ((pass * 8 + w) * 32 + r) * 32 + 4 * hh;
#pragma unroll
            for (int g = 0; g < 4; ++g) *(f32x4*)(pp + 8 * g) = (f32x4){acc[4 * g], acc[4 * g + 1], acc[4 * g + 2], acc[4 * g + 3]};
        }
        __syncthreads();
        {
            const int e = tid * 2, rr = e >> 5, cc = e & 31;
            f32x2 s1 = {0.f, 0.f}, s2 = {0.f, 0.f};
#pragma unroll
            for (int ww = 0; ww < 8; ++ww) { s1 += *(const f32x2*)(part + (ww * 32 + rr) * 32 + cc); if (KIND == 2) s2 += *(const f32x2*)(part + ((8 + ww) * 32 + rr) * 32 + cc); }
            const long row = row0 + rr; const int col = col0 + cc;
            if (KIND == 1) { s1[0] = sigmoidf_(s1[0]); s1[1] = sigmoidf_(s1[1]); }
            if (KIND == 2) { const unsigned ga = *(const unsigned*)(P->gates + row * 2048 + col), gb = *(const unsigned*)(P->gates + row * 2048 + 1024 + col);
                s1[0] = s1[0] * bf_lo(ga) + s2[0] * bf_lo(gb); s1[1] = s1[1] * bf_hi(ga) + s2[1] * bf_hi(gb); }
            *(unsigned*)(C + row * ldc + col) = pk2(s1[0], s1[1]);
        }
        __syncthreads();
    }
}

DI int crow(int i, int h) { return (i & 3) + 8 * (i >> 2) + 4 * h; }

template <int MODE, bool F32P>
DI void attn_unit(KP P, char* lds, bool sample, int b, int h, int ublk) {
    constexpr int DQK = MODE == 0 ? 96 : 64, KS = DQK * 2 + 16, VS = 144, NS = DQK / 16;
    constexpr int KBYTES = 64 * KS, BUF = KBYTES + 64 * VS;
    const int tid = otid(), w = tid >> 6, lane = tid & 63, ql = lane & 31, hh = lane >> 5;
    const int kvrow0 = sample ? MP + b * SKEYS : b * TP;
    const int qrow0 = sample ? MP + b * 32 : b * TP + ublk * 256;
    const int ntiles = sample ? 65 : 4 * (ublk + 1);
    const int t0 = sample ? 0 : ublk * 256 + w * 32, tq = t0 + ql;
    int klim, wmax, wmin;
    if (MODE == 0) { if (sample) { klim = wmax = wmin = SKEYS; } else { klim = ((tq >> 6) + 1) << 6; wmax = (((t0 + 31) >> 6) + 1) << 6; wmin = ((t0 >> 6) + 1) << 6; } }
    else { if (sample) { klim = PAST + tq; wmax = PAST + 31; wmin = PAST; } else { klim = tq; wmax = t0 + 31; wmin = t0; } }
    const bool wactive = sample ? (w == 0) : true;
    const bf16_t* Kp; const bf16_t* Qp; const bf16_t* VT; int ldq; long ldv;
    if (MODE == 0) { Kp = P->kva + (long)kvrow0 * 512 + h * 64; Qp = P->q + (long)qrow0 * 768 + h * 96; ldq = 768;
        VT = sample ? P->vaT_s + (long)(b * 512 + h * 64) * SKP : P->vaT_p + (long)(b * 512 + h * 64) * TP; }
    else { Kp = P->kb + (long)kvrow0 * 512 + h * 64; Qp = P->qb + (long)qrow0 * 512 + h * 64; ldq = 512;
        VT = sample ? P->vbT_s + (long)(b * 512 + h * 64) * SKP : P->vbT_p + (long)(b * 512 + h * 64) * TP; }
    ldv = sample ? SKP : TP;
    const bf16_t* Kr = P->krope + (long)kvrow0 * 32;

    bf16x8 qf[NS];
    if (wactive) {
        const bf16_t* qp = Qp + (long)(w * 32 + ql) * ldq + 8 * hh;
#pragma unroll
        for (int s = 0; s < NS; ++s) qf[s] = *(const bf16x8*)(qp + 16 * s);
    } else {
#pragma unroll
        for (int s = 0; s < NS; ++s) qf[s] = (bf16x8){0, 0, 0, 0, 0, 0, 0, 0};
    }
    f32x16 O0, O1;
#pragma unroll
    for (int i = 0; i < 16; ++i) { O0[i] = 0.f; O1[i] = 0.f; }
    float mrun = -INFINITY, lrun = 0.f, carry = 0.f;
    bool wdone = !wactive;
    volatile int* flags = (volatile int*)(lds + 65536 + 64);

    u32x4 rk0, rk1, rv; f32x4 fa0, fa1, fc0, fc1;
    const int krow_s = tid >> 3, kc_s = tid & 7, rrow_s = tid >> 2, rc_s = tid & 3;
    const float* Kf = P->c_sbk + ((long)b * PAST * 512 + h * 64); const float* Vf = P->c_sbv + ((long)b * PAST * 512 + h * 64);
    auto load_bf = [&](int kt) {
        rk0 = *(const u32x4*)(Kp + (long)(kt * 64 + krow_s) * 512 + kc_s * 8);
        if (MODE == 0 && tid < 256) rk1 = *(const u32x4*)(Kr + (long)(kt * 64 + rrow_s) * 32 + rc_s * 8);
        rv = *(const u32x4*)(VT + (long)krow_s * ldv + kt * 64 + kc_s * 8);
    };
    auto store_bf = [&](int buf) {
        char* kb_ = lds + buf * BUF; char* vb_ = kb_ + KBYTES;
        *(u32x4*)(kb_ + krow_s * KS + kc_s * 16) = rk0;
        if (MODE == 0 && tid < 256) *(u32x4*)(kb_ + rrow_s * KS + 128 + rc_s * 16) = rk1;
        *(u32x4*)(vb_ + krow_s * VS + kc_s * 16) = rv;
    };
    auto load_f32 = [&](int kt) {
        const float* kp_ = Kf + (long)(kt * 64 + krow_s) * 512 + kc_s * 8; const float* vp_ = Vf + (long)(kt * 64 + krow_s) * 512 + kc_s * 8;
        fa0 = *(const f32x4*)kp_; fa1 = *(const f32x4*)(kp_ + 4); fc0 = *(const f32x4*)vp_; fc1 = *(const f32x4*)(vp_ + 4);
    };
    auto store_f32 = [&](int buf) {
        char* kb_ = lds + buf * BUF; char* vb_ = kb_ + KBYTES;
        u32x4 kk, vv;
        kk.x = pk2(fa0[0], fa0[1]); kk.y = pk2(fa0[2], fa0[3]); kk.z = pk2(fa1[0], fa1[1]); kk.w = pk2(fa1[2], fa1[3]);
        vv.x = pk2(fc0[0], fc0[1]); vv.y = pk2(fc0[2], fc0[3]); vv.z = pk2(fc1[0], fc1[1]); vv.w = pk2(fc1[2], fc1[3]);
        *(u32x4*)(kb_ + krow_s * KS + kc_s * 16) = kk;
#pragma unroll
        for (int e = 0; e < 4; ++e) { *(bf16_t*)(vb_ + (kc_s * 8 + 2 * e) * VS + krow_s * 2) = (bf16_t)(vv[e] & 0xffff); *(bf16_t*)(vb_ + (kc_s * 8 + 2 * e + 1) * VS + krow_s * 2) = (bf16_t)(vv[e] >> 16); }
    };
    load_bf(ntiles - 1); store_bf(0);
    __syncthreads();
    for (int it = 0; it < ntiles; ++it) {
        const int kt = ntiles - 1 - it, cur = it & 1;
        if (it + 1 < ntiles) { if (F32P) load_f32(kt - 1); else load_bf(kt - 1); }
        if (wactive && !wdone && kt * 64 < wmax) {
            const char* kb_ = lds + cur * BUF; const char* vb_ = kb_ + KBYTES;
            f32x16 S0, S1;
#pragma unroll
            for (int i = 0; i < 16; ++i) { S0[i] = 0.f; S1[i] = 0.f; }
#pragma unroll
            for (int s = 0; s < NS; ++s) {
                const bf16x8 k0 = *(const bf16x8*)(kb_ + ql * KS + (16 * s + 8 * hh) * 2);
                const bf16x8 k1 = *(const bf16x8*)(kb_ + (32 + ql) * KS + (16 * s + 8 * hh) * 2);
                S0 = MFMA32(k0, qf[s], S0); S1 = MFMA32(k1, qf[s], S1);
            }
            const bool need_mask = (kt * 64 + 64 > wmin);
            const int kbase = kt * 64 + 4 * hh;
            if (MODE == 0) {
                if (need_mask) {
#pragma unroll
                    for (int i = 0; i < 16; ++i) { const int key = kbase + (i & 3) + 8 * (i >> 2);
                        if (key >= klim) S0[i] = -INFINITY; if (key + 32 >= klim) S1[i] = -INFINITY; }
                }
                float mx = S0[0];
#pragma unroll
                for (int i = 1; i < 16; ++i) mx = fmaxf(mx, S0[i]);
#pragma unroll
                for (int i = 0; i < 16; ++i) mx = fmaxf(mx, S1[i]);
                mx = fmaxf(mx, __shfl_xor(mx, 32));
                const float mnew = fmaxf(mrun, mx);
                const float alpha = __builtin_amdgcn_exp2f(mrun - mnew);
                mrun = mnew;
                float ps = 0.f;
#pragma unroll
                for (int i = 0; i < 16; ++i) { S0[i] = __builtin_amdgcn_exp2f(S0[i] - mnew); S1[i] = __builtin_amdgcn_exp2f(S1[i] - mnew); ps += S0[i] + S1[i]; }
                lrun = lrun * alpha + ps;
#pragma unroll
                for (int i = 0; i < 16; ++i) { O0[i] *= alpha; O1[i] *= alpha; }
            } else {
                float gs[2][4], gp[2][4];
                f32x16 SP0, SP1;
#pragma unroll
                for (int i = 0; i < 16; ++i) { const int key = kbase + (i & 3) + 8 * (i >> 2);
                    { const float z = S0[i]; const float t = __builtin_amdgcn_exp2f(-fabsf(z) * LOG2E); float sp = fmaxf(z, 0.f) + LN2 * __builtin_amdgcn_logf(1.0f + t);
                      if (need_mask && key >= klim) sp = 0.f; SP0[i] = sp; }
                    { const float z = S1[i]; const float t = __builtin_amdgcn_exp2f(-fabsf(z) * LOG2E); float sp = fmaxf(z, 0.f) + LN2 * __builtin_amdgcn_logf(1.0f + t);
                      if (need_mask && key + 32 >= klim) sp = 0.f; SP1[i] = sp; } }
#pragma unroll
                for (int g = 0; g < 4; ++g) { gs[0][g] = (SP0[4 * g] + SP0[4 * g + 1]) + (SP0[4 * g + 2] + SP0[4 * g + 3]);
                    gs[1][g] = (SP1[4 * g] + SP1[4 * g + 1]) + (SP1[4 * g + 2] + SP1[4 * g + 3]); }
#pragma unroll
                for (int g = 0; g < 4; ++g) { gp[0][g] = __shfl_xor(gs[0][g], 32); gp[1][g] = __shfl_xor(gs[1][g], 32); }
                float running = carry;
#pragma unroll
                for (int blk = 1; blk >= 0; --blk)
#pragma unroll
                    for (int g = 3; g >= 0; --g) {
                        const float sum1 = hh ? gs[blk][g] : gp[blk][g], sum0 = hh ? gp[blk][g] : gs[blk][g];
                        const float mybase = hh ? running : running + sum1;
                        running += sum0 + sum1;
                        float later = mybase;
#pragma unroll
                        for (int j = 3; j >= 0; --j) { const int i = 4 * g + j; const int key = kbase + j + 8 * g + 32 * blk;
                            const float z = blk ? S1[i] : S0[i], sp = blk ? SP1[i] : SP0[i];
                            float a = __builtin_amdgcn_exp2f((z - sp - later) * LOG2E);
                            if (need_mask && key >= klim) a = 0.f;
                            later += sp;
                            if (blk) S1[i] = a; else S0[i] = a; }
                    }
                carry = running;
                wdone = __all((carry > 104.0f) || (klim <= 0));
            }
            bf16x8 pf[2][2];
#pragma unroll
            for (int s = 0; s < 2; ++s) {
                u32x4 a, c;
                a.x = pk2(S0[8 * s], S0[8 * s + 1]); a.y = pk2(S0[8 * s + 2], S0[8 * s + 3]); a.z = pk2(S0[8 * s + 4], S0[8 * s + 5]); a.w = pk2(S0[8 * s + 6], S0[8 * s + 7]);
                c.x = pk2(S1[8 * s], S1[8 * s + 1]); c.y = pk2(S1[8 * s + 2], S1[8 * s + 3]); c.z = pk2(S1[8 * s + 4], S1[8 * s + 5]); c.w = pk2(S1[8 * s + 6], S1[8 * s + 7]);
                pf[0][s] = __builtin_bit_cast(bf16x8, a); pf[1][s] = __builtin_bit_cast(bf16x8, c);
            }
#pragma unroll
            for (int blk = 0; blk < 2; ++blk)
#pragma unroll
                for (int s = 0; s < 2; ++s) {
                    const int koff = (32 * blk + 16 * s + 4 * hh) * 2;
                    const s16x4 lo0 = *(const s16x4*)(vb_ + ql * VS + koff), hi0 = *(const s16x4*)(vb_ + ql * VS + koff + 16);
                    const s16x4 lo1 = *(const s16x4*)(vb_ + (32 + ql) * VS + koff), hi1 = *(const s16x4*)(vb_ + (32 + ql) * VS + koff + 16);
                    const bf16x8 v0 = __builtin_shufflevector(lo0, hi0, 0, 1, 2, 3, 4, 5, 6, 7), v1 = __builtin_shufflevector(lo1, hi1, 0, 1, 2, 3, 4, 5, 6, 7);
                    O0 = MFMA32(v0, pf[blk][s], O0); O1 = MFMA32(v1, pf[blk][s], O1);
                }
        }
        if (it + 1 < ntiles) { if (F32P) store_f32(cur ^ 1); else store_bf(cur ^ 1); }
        if (MODE == 1 && lane == 0) flags[(it & 1) * 8 + w] = wdone ? 1 : 0;
        __syncthreads();
        if (MODE == 1) { int alld = 1;
#pragma unroll
            for (int ww = 0; ww < 8; ++ww) alld &= flags[(it & 1) * 8 + ww];
            if (alld) break; }
    }
    if (wactive) {
        float inv = 1.0f;
        if (MODE == 0) { const float lt = lrun + __shfl_xor(lrun, 32); inv = 1.0f / lt; }
        bf16_t* op = P->o + (long)(qrow0 + w * 32 + ql) * 1024 + (MODE == 0 ? 0 : 512) + h * 64 + 4 * hh;
#pragma unroll
        for (int g = 0; g < 4; ++g) {
            f32x4 a = {O0[4 * g] * inv, O0[4 * g + 1] * inv, O0[4 * g + 2] * inv, O0[4 * g + 3] * inv};
            f32x4 c = {O1[4 * g] * inv, O1[4 * g + 1] * inv, O1[4 * g + 2] * inv, O1[4 * g + 3] * inv};
            store_bf4(op + 8 * g, a); store_bf4(op + 32 + 8 * g, c);
        }
    }
}

DI void attn_mla128(KP P, char* lds, bool sample, int b, int h, int ublk) {
    constexpr int KS = 208, VS = 272, KBYTES = 128 * KS, BUF = KBYTES + 64 * VS;
    const int tid = otid(), w = tid >> 6, lane = tid & 63, ql = lane & 31, hh = lane >> 5;
    const int kvrow0 = sample ? MP + b * SKEYS : b * TP;
    const int qrow0 = sample ? MP + b * 32 : b * TP + ublk * 256;
    const int ntiles = sample ? 33 : 2 * (ublk + 1);
    const int t0 = sample ? 0 : ublk * 256 + w * 32;
    const int wmax = sample ? SKEYS : ((((t0 + 31) >> 6) + 1) << 6);
    const bool wactive = sample ? (w == 0) : true;
    const bf16_t* Kp = P->kva + (long)kvrow0 * 512 + h * 64; const bf16_t* Qp = P->q + (long)qrow0 * 768 + h * 96;
    const bf16_t* VT = sample ? P->vaT_s + (long)(b * 512 + h * 64) * SKP : P->vaT_p + (long)(b * 512 + h * 64) * TP;
    const long ldv = sample ? SKP : TP;
    const bf16_t* Kr = P->krope + (long)kvrow0 * 32;
    bf16x8 qf[6];
    if (wactive) { const bf16_t* qp = Qp + (long)(w * 32 + ql) * 768 + 8 * hh;
#pragma unroll
        for (int s = 0; s < 6; ++s) qf[s] = *(const bf16x8*)(qp + 16 * s); }
    else {
#pragma unroll
        for (int s = 0; s < 6; ++s) qf[s] = (bf16x8){0, 0, 0, 0, 0, 0, 0, 0}; }
    f32x16 O0, O1;
#pragma unroll
    for (int i = 0; i < 16; ++i) { O0[i] = 0.f; O1[i] = 0.f; }
    float mrun = -INFINITY, lrun = 0.f;
    u32x4 rk[2], rr, rv[2];
    auto load_tile = [&](int kt) {
#pragma unroll
        for (int i = 0; i < 2; ++i) { const int c = tid + i * 512;
            rk[i] = *(const u32x4*)(Kp + (long)(kt * 128 + (c >> 3)) * 512 + (c & 7) * 8);
            rv[i] = *(const u32x4*)(VT + (long)(c >> 4) * ldv + kt * 128 + (c & 15) * 8); }
        rr = *(const u32x4*)(Kr + (long)(kt * 128 + (tid >> 2)) * 32 + (tid & 3) * 8);
    };
    auto store_tile = [&](int buf) {
        char* kb_ = lds + buf * BUF; char* vb_ = kb_ + KBYTES;
#pragma unroll
        for (int i = 0; i < 2; ++i) { const int c = tid + i * 512;
            *(u32x4*)(kb_ + (c >> 3) * KS + (c & 7) * 16) = rk[i];
            *(u32x4*)(vb_ + (c >> 4) * VS + (c & 15) * 16) = rv[i]; }
        *(u32x4*)(kb_ + (tid >> 2) * KS + 128 + (tid & 3) * 16) = rr;
    };
    load_tile(ntiles - 1); store_tile(0);
    __syncthreads();
    for (int it = 0; it < ntiles; ++it) {
        const int kt = ntiles - 1 - it, cur = it & 1;
        if (it + 1 < ntiles) load_tile(kt - 1);
        if (wactive && kt * 128 < wmax) {
            const char* kb_ = lds + cur * BUF; const char* vb_ = kb_ + KBYTES;
            const int nblk = (wmax - kt * 128) >> 5;
            f32x16 S[4];
#pragma unroll
            for (int blk = 0; blk < 4; ++blk) {
#pragma unroll
                for (int i = 0; i < 16; ++i) S[blk][i] = 0.f;
#pragma unroll
                for (int s = 0; s < 6; ++s) { const bf16x8 kf = *(const bf16x8*)(kb_ + (32 * blk + ql) * KS + (16 * s + 8 * hh) * 2); S[blk] = MFMA32(kf, qf[s], S[blk]); }
            }
            if (nblk < 4) {
#pragma unroll
                for (int blk = 1; blk < 4; ++blk) if (blk >= nblk) {
#pragma unroll
                    for (int i = 0; i < 16; ++i) S[blk][i] = -INFINITY; }
            }
            float mx = S[0][0];
#pragma unroll
            for (int blk = 0; blk < 4; ++blk)
#pragma unroll
                for (int i = 0; i < 16; ++i) mx = fmaxf(mx, S[blk][i]);
            mx = fmaxf(mx, __shfl_xor(mx, 32));
            const float mnew = fmaxf(mrun, mx);
            const float alpha = __builtin_amdgcn_exp2f(mrun - mnew);
            mrun = mnew;
            float ps = 0.f;
#pragma unroll
            for (int blk = 0; blk < 4; ++blk)
#pragma unroll
                for (int i = 0; i < 16; ++i) { S[blk][i] = __builtin_amdgcn_exp2f(S[blk][i] - mnew); ps += S[blk][i]; }
            lrun = lrun * alpha + ps;
#pragma unroll
            for (int i = 0; i < 16; ++i) { O0[i] *= alpha; O1[i] *= alpha; }
#pragma unroll
            for (int blk = 0; blk < 4; ++blk)
#pragma unroll
                for (int s = 0; s < 2; ++s) {
                    u32x4 a;
                    a.x = pk2(S[blk][8 * s], S[blk][8 * s + 1]); a.y = pk2(S[blk][8 * s + 2], S[blk][8 * s + 3]); a.z = pk2(S[blk][8 * s + 4], S[blk][8 * s + 5]); a.w = pk2(S[blk][8 * s + 6], S[blk][8 * s + 7]);
                    const bf16x8 pf = __builtin_bit_cast(bf16x8, a);
                    const int koff = (32 * blk + 16 * s + 4 * hh) * 2;
                    const s16x4 lo0 = *(const s16x4*)(vb_ + ql * VS + koff), hi0 = *(const s16x4*)(vb_ + ql * VS + koff + 16);
                    const s16x4 lo1 = *(const s16x4*)(vb_ + (32 + ql) * VS + koff), hi1 = *(const s16x4*)(vb_ + (32 + ql) * VS + koff + 16);
                    const bf16x8 v0 = __builtin_shufflevector(lo0, hi0, 0, 1, 2, 3, 4, 5, 6, 7), v1 = __builtin_shufflevector(lo1, hi1, 0, 1, 2, 3, 4, 5, 6, 7);
                    O0 = MFMA32(v0, pf, O0); O1 = MFMA32(v1, pf, O1);
                }
        }
        if (it + 1 < ntiles) store_tile(cur ^ 1);
        __syncthreads();
    }
    if (wactive) {
        const float lt = lrun + __shfl_xor(lrun, 32); const float inv = 1.0f / lt;
        bf16_t* op = P->o + (long)(qrow0 + w * 32 + ql) * 1024 + h * 64 + 4 * hh;
#pragma unroll
        for (int g = 0; g < 4; ++g) {
            f32x4 a = {O0[4 * g] * inv, O0[4 * g + 1] * inv, O0[4 * g + 2] * inv, O0[4 * g + 3] * inv};
            f32x4 c = {O1[4 * g] * inv, O1[4 * g + 1] * inv, O1[4 * g + 2] * inv, O1[4 * g + 3] * inv};
            store_bf4(op + 8 * g, a); store_bf4(op + 32 + 8 * g, c);
        }
    }
}

DI void attn_phase(KP P, char* lds, int cidx) {
    unsigned* slot = (unsigned*)(lds + 131072 + 3072);
    for (;;) {
        if (threadIdx.x == 0) *slot = atomicAdd(P->ctr + cidx, 1u);
        __syncthreads();
        const unsigned idx = *slot;
        __syncthreads();
        if (idx >= 1152u) break;
        bool sample; int mode, b, h, ublk = 0;
        if (idx < 128u) { sample = true; mode = idx >> 6; b = (idx >> 3) & 7; h = idx & 7; }
        else { const int j = idx - 128; sample = false; ublk = 31 - (j >> 5); const int r = j & 31; mode = r >> 4; b = (r >> 3) & 1; h = r & 7; }
        if (mode == 0) attn_mla128(P, lds, sample, b, h, ublk); else if (sample) attn_unit<1, true>(P, lds, true, b, h, ublk); else attn_unit<1, false>(P, lds, false, b, h, ublk);
    }
}

DI void phase0(KP P, char* lds) {
    const int tid = otid(), G = ogrid(), bid = obid(), w = tid >> 6, lane = tid & 63;
    for (int item = bid; item < 96; item += G) {
        float* sc = (float*)lds; float* red = (float*)(lds + 40960);
        for (int i = tid; i < 10240; i += NTHREADS) { const int bb = i >> 10, k = i & 1023; const float cv = bb < 2 ? P->c_p[bb * 1024 + k] : P->c_s[(bb - 2) * 1024 + k]; sc[i] = cv / (1.0f + __expf(-cv)); }
        __syncthreads();
        const int col = item * 64 + lane;
        float a0 = 0, a1 = 0, a2 = 0, a3 = 0, a4 = 0, a5 = 0, a6 = 0, a7 = 0, a8 = 0, a9 = 0;
        for (int k0 = w * 128; k0 < w * 128 + 128; k0 += 16) {
            float wv[16];
#pragma unroll
            for (int j = 0; j < 16; ++j) wv[j] = P->w_ada[(long)(k0 + j) * 6144 + col];
#pragma unroll
            for (int j = 0; j < 16; ++j) { const int k = k0 + j;
                a0 += sc[k] * wv[j]; a1 += sc[1024 + k] * wv[j]; a2 += sc[2048 + k] * wv[j]; a3 += sc[3072 + k] * wv[j]; a4 += sc[4096 + k] * wv[j];
                a5 += sc[5120 + k] * wv[j]; a6 += sc[6144 + k] * wv[j]; a7 += sc[7168 + k] * wv[j]; a8 += sc[8192 + k] * wv[j]; a9 += sc[9216 + k] * wv[j]; }
        }
        float* rr = red + w * 640 + lane;
        rr[0] = a0; rr[64] = a1; rr[128] = a2; rr[192] = a3; rr[256] = a4; rr[320] = a5; rr[384] = a6; rr[448] = a7; rr[512] = a8; rr[576] = a9;
        __syncthreads();
        for (int i = tid; i < 640; i += NTHREADS) { float s = 0.f; for (int ww = 0; ww < 8; ++ww) s += red[ww * 640 + i];
            const int bb = i >> 6, l = i & 63; P->ada[bb * 6144 + item * 64 + l] = s + P->b_ada[item * 64 + l]; }
        __syncthreads();
    }
    {
        float* tile = (float*)lds;
        for (int it = (bid + 96) % G; it < P->ntj_tiles; it += G) {
            int j = 0;
#pragma unroll
            for (int q = 1; q < 16; ++q) if (it >= P->tj[q].tile0) j = q;
            TJob J; J.src = P->tj[j].src; J.kscale = P->tj[j].kscale; J.dst = P->tj[j].dst; J.lds = P->tj[j].lds; J.coff = P->tj[j].coff; J.ldd = P->tj[j].ldd;
            J.Klen = P->tj[j].Klen; J.Nlen = P->tj[j].Nlen; J.zero = P->tj[j].zero; J.tile0 = P->tj[j].tile0;
            const int lt = it - J.tile0, nk = J.Klen >> 6, tk = lt % nk, tn = lt / nk, k0 = tk * 64, n0 = tn * 256;
            f32x4 lv[8];
#pragma unroll
            for (int r = 0; r < 8; ++r) { const int e = tid + r * NTHREADS, kk = e >> 6, n4 = (e & 63) * 4;
                lv[r] = (f32x4){0.f, 0.f, 0.f, 0.f};
                if (J.zero == 2) { const int nn_ = n0 + n4, sc_ = (nn_ >> 8) * 128 + (nn_ & 127) + ((nn_ >> 7) & 1) * DFF;
                    lv[r] = *(const f32x4*)(J.src + (long)(k0 + kk) * J.lds + sc_); }
                else if (!J.zero && n0 + n4 < J.Nlen) lv[r] = *(const f32x4*)(J.src + (long)(k0 + kk) * J.lds + J.coff + n0 + n4); }
#pragma unroll
            for (int r = 0; r < 8; ++r) { const int e = tid + r * NTHREADS, kk = e >> 6, n4 = (e & 63) * 4;
                f32x4 v = lv[r]; if (J.kscale) v *= J.kscale[k0 + kk];
                float* tp = tile + kk * 257 + n4; tp[0] = v[0]; tp[1] = v[1]; tp[2] = v[2]; tp[3] = v[3]; }
            __syncthreads();
#pragma unroll
            for (int r = 0; r < 4; ++r) { const int e = tid + r * NTHREADS, nn = e >> 3, kc = (e & 7) * 8;
                if (n0 + nn < J.Nlen) { const float* tp = tile + kc * 257 + nn; u32x4 o;
                    o.x = pk2(tp[0], tp[257]); o.y = pk2(tp[2 * 257], tp[3 * 257]); o.z = pk2(tp[4 * 257], tp[5 * 257]); o.w = pk2(tp[6 * 257], tp[7 * 257]);
                    *(u32x4*)(J.dst + (long)(n0 + nn) * J.ldd + k0 + kc) = o; } }
            __syncthreads();
        }
    }
    const long gt = (long)bid * NTHREADS + tid, gn = (long)G * NTHREADS;
    for (long i0 = gt; i0 < 8L * PAST * 64; i0 += 4 * gn) { f32x4 v[4];
#pragma unroll
        for (int r = 0; r < 4; ++r) { const long i = i0 + r * gn; if (i < 8L * PAST * 64) v[r] = *(const f32x4*)(P->c_ckv + i * 4); }
#pragma unroll
        for (int r = 0; r < 4; ++r) { const long i = i0 + r * gn; if (i < 8L * PAST * 64) { const long row = i >> 6; const int c = (int)(i & 63) * 4; const int bb = (int)(row >> 12), sq = (int)(row & 4095);
            store_bf4(P->latent + (long)(MP + bb * SKEYS + sq) * 256 + c, v[r]); } } }
    for (long i0 = gt; i0 < 8L * PAST * 8; i0 += 4 * gn) { f32x4 v[4];
#pragma unroll
        for (int r = 0; r < 4; ++r) { const long i = i0 + r * gn; if (i < 8L * PAST * 8) v[r] = *(const f32x4*)(P->c_kr + i * 4); }
#pragma unroll
        for (int r = 0; r < 4; ++r) { const long i = i0 + r * gn; if (i < 8L * PAST * 8) { const long row = i >> 3; const int c = (int)(i & 7) * 4; const int bb = (int)(row >> 12), sq = (int)(row & 4095);
            store_bf4(P->krope + (long)(MP + bb * SKEYS + sq) * 32 + c, v[r]); } } }
    for (long i = gt; i < 8L * 512 * 8; i += gn) { const long r = i >> 3; const int c = (int)(i & 7) * 4; const u32x2 z = {0u, 0u};
        *(u32x2*)(P->vaT_s + r * SKP + SKEYS + c) = z; *(u32x2*)(P->vbT_s + r * SKP + SKEYS + c) = z; }
    for (long i = gt; i < (long)TP * 16; i += gn) { const int pos = (int)(i >> 4), fi = (int)(i & 15);
        const float inv = exp2f(-(float)fi * (13.287712379549449f / 16.0f));
        const float ang = (float)pos * inv;
        const double rev = (double)ang * 0.15915494309189535; const float fr_ = (float)(rev - floor(rev));
        P->ropeT[i * 2] = __builtin_amdgcn_cosf(fr_); P->ropeT[i * 2 + 1] = __builtin_amdgcn_sinf(fr_); }
}

DI void phase_h(KP P) {
    const int tid_ = otid(), lane = tid_ & 63, gw = obid() * 8 + (tid_ >> 6), nw = ogrid() * 8;
    for (int row = gw; row < MT; row += nw) {
        const float* xr = row < MP ? P->x_p + (long)row * DM : P->x_s + (long)(row - MP) * DM;
        const float* ad = P->ada + ada_b(row) * 6144;
        f32x4 v[4]; float s = 0.f;
#pragma unroll
        for (int i = 0; i < 4; ++i) { v[i] = *(const f32x4*)(xr + i * 256 + lane * 4); s += v[i][0] * v[i][0] + v[i][1] * v[i][1] + v[i][2] * v[i][2] + v[i][3] * v[i][3]; }
#pragma unroll
        for (int o = 1; o < 64; o <<= 1) s += __shfl_xor(s, o);
        const float rstd = rsqrtf(s * (1.0f / DM) + EPS);
#pragma unroll
        for (int i = 0; i < 4; ++i) { const int c = i * 256 + lane * 4;
            const f32x4 g = *(const f32x4*)(P->g_pre_mix + c), sh = *(const f32x4*)(ad + c), scl = *(const f32x4*)(ad + 1024 + c);
            store_bf4(P->h + (long)row * DM + c, v[i] * rstd * g * (1.0f + scl) + sh); }
    }
}

DI void phase_mid(KP P) {
    const int tid_ = otid(), lane = tid_ & 63, gw = obid() * 8 + (tid_ >> 6), nw = ogrid() * 8;
    for (int row = gw; row < MT; row += nw) {
        const float* xr = row < MP ? P->x_p + (long)row * DM : P->x_s + (long)(row - MP) * DM;
        const float* ad = P->ada + ada_b(row) * 6144;
        f32x4 mv[4]; float s = 0.f;
#pragma unroll
        for (int i = 0; i < 4; ++i) { const u32x2 wv = *(const u32x2*)(P->m2 + (long)row * DM + i * 256 + lane * 4);
            mv[i] = (f32x4){bf_lo(wv.x), bf_hi(wv.x), bf_lo(wv.y), bf_hi(wv.y)}; s += mv[i][0] * mv[i][0] + mv[i][1] * mv[i][1] + mv[i][2] * mv[i][2] + mv[i][3] * mv[i][3]; }
#pragma unroll
        for (int o = 1; o < 64; o <<= 1) s += __shfl_xor(s, o);
        const float rstd = rsqrtf(s * (1.0f / DM) + EPS);
        float s2 = 0.f;
#pragma unroll
        for (int i = 0; i < 4; ++i) { const int c = i * 256 + lane * 4;
            const f32x4 xv = *(const f32x4*)(xr + c), g = *(const f32x4*)(P->g_post_mix + c), gt = *(const f32x4*)(ad + 2048 + c);
            mv[i] = xv + gt * (mv[i] * rstd * g);
            *(f32x4*)(P->out + O_Y + (long)row * DM + c) = mv[i];
            s2 += mv[i][0] * mv[i][0] + mv[i][1] * mv[i][1] + mv[i][2] * mv[i][2] + mv[i][3] * mv[i][3]; }
#pragma unroll
        for (int o = 1; o < 64; o <<= 1) s2 += __shfl_xor(s2, o);
        const float rstd2 = rsqrtf(s2 * (1.0f / DM) + EPS);
#pragma unroll
        for (int i = 0; i < 4; ++i) { const int c = i * 256 + lane * 4;
            const f32x4 g = *(const f32x4*)(P->g_pre_ffn + c), sh = *(const f32x4*)(ad + 3072 + c), scl = *(const f32x4*)(ad + 4096 + c);
            store_bf4(P->h2 + (long)row * DM + c, mv[i] * rstd2 * g * (1.0f + scl) + sh); }
    }
}

DI void phase_final(KP P) {
    const int tid_ = otid(), lane = tid_ & 63, gw = obid() * 8 + (tid_ >> 6), nw = ogrid() * 8;
    for (int row = gw; row < MT; row += nw) {
        const float* ad = P->ada + ada_b(row) * 6144;
        f32x4 fv[4]; float s = 0.f;
#pragma unroll
        for (int i = 0; i < 4; ++i) { const u32x2 wv = *(const u32x2*)(P->f + (long)row * DM + i * 256 + lane * 4);
            fv[i] = (f32x4){bf_lo(wv.x), bf_hi(wv.x), bf_lo(wv.y), bf_hi(wv.y)}; s += fv[i][0] * fv[i][0] + fv[i][1] * fv[i][1] + fv[i][2] * fv[i][2] + fv[i][3] * fv[i][3]; }
#pragma unroll
        for (int o = 1; o < 64; o <<= 1) s += __shfl_xor(s, o);
        const float rstd = rsqrtf(s * (1.0f / DM) + EPS);
#pragma unroll
        for (int i = 0; i < 4; ++i) { const int c = i * 256 + lane * 4; float* yp = P->out + O_Y + (long)row * DM + c;
            const f32x4 xv = *(const f32x4*)yp, g = *(const f32x4*)(P->g_post_ffn + c), gt = *(const f32x4*)(ad + 5120 + c);
            *(f32x4*)yp = xv + gt * (fv[i] * rstd * g); }
    }
}


DI void load8(const bf16_t* p, float (&o)[8]) { const u32x4 w = *(const u32x4*)p;
#pragma unroll
    for (int e = 0; e < 4; ++e) { o[2 * e] = bf_lo(w[e]); o[2 * e + 1] = bf_hi(w[e]); } }
DI void phase_convfix(KP P) {
    const long gt = (long)obid() * NTHREADS + otid(), gn = (long)ogrid() * NTHREADS;
    for (long i = gt; i < 768L * 352; i += gn) {
        const int ri = (int)(i / 352), c = (int)(i % 352) * 8;
        float u0[2][8], u1[2][8], u2[2][8];
        long grow;
        if (ri < 512) {
            const int B = ri >> 1, rsel = ri & 1; const bool first = ((B * 64) & (TP - 1)) == 0; grow = (long)B * 64 + rsel;
            const bf16_t* cur = P->ub + (long)(B * 4) * DFF2 + c; const bf16_t* prv = P->ub + (long)((B > 0 ? B - 1 : 0) * 4) * DFF2 + c;
#pragma unroll
            for (int hf = 0; hf < 2; ++hf) {
                load8(cur + (long)(2 + rsel) * DFF2 + hf * DFF, u2[hf]);
                if (rsel == 0) { if (first) { for (int e = 0; e < 8; ++e) { u1[hf][e] = 0.f; u0[hf][e] = 0.f; } } else { load8(prv + (long)1 * DFF2 + hf * DFF, u1[hf]); load8(prv + hf * DFF, u0[hf]); } }
                else { load8(cur + (long)2 * DFF2 + hf * DFF, u1[hf]); if (first) { for (int e = 0; e < 8; ++e) u0[hf][e] = 0.f; } else load8(prv + (long)1 * DFF2 + hf * DFF, u0[hf]); }
            }
        } else {
            const int r = ri - 512, t = r & 31, bs = r >> 5; grow = (long)MP + r;
            const float* st = P->c_conv + (long)bs * 2 * DFF2 + c;
#pragma unroll
            for (int hf = 0; hf < 2; ++hf) {
                load8(P->u + (long)r * DFF2 + hf * DFF + c, u2[hf]);
                if (t >= 1) load8(P->u + (long)(r - 1) * DFF2 + hf * DFF + c, u1[hf]); else { for (int e = 0; e < 8; ++e) u1[hf][e] = st[DFF2 + hf * DFF + e]; }
                if (t >= 2) load8(P->u + (long)(r - 2) * DFF2 + hf * DFF + c, u0[hf]); else { for (int e = 0; e < 8; ++e) u0[hf][e] = st[(long)t * DFF2 + hf * DFF + e]; }
            }
        }
        float y[2][8];
#pragma unroll
        for (int hf = 0; hf < 2; ++hf)
#pragma unroll
            for (int e = 0; e < 8; ++e) { const int cc = hf * DFF + c + e;
                y[hf][e] = P->conv_b[cc] + P->conv_w[cc] * u0[hf][e] + P->conv_w[DFF2 + cc] * u1[hf][e] + P->conv_w[2 * DFF2 + cc] * u2[hf][e]; }
        u32x4 ov;
#pragma unroll
        for (int e = 0; e < 4; ++e) ov[e] = pk2(gelu_tanh(y[0][2 * e]) * y[1][2 * e], gelu_tanh(y[0][2 * e + 1]) * y[1][2 * e + 1]);
        *(u32x4*)(P->g + grow * DFF + c) = ov;
    }
}

#define XB_TMO      128
#define XB_XCNT(j)  (256  + 64 * (j))
#define XB_XSUB(j)  (1280 + 64 * (j))
#define XB_XGEN(j)  (2304 + 64 * (j))
#define XB_TOP      3328
#define XB_TOPGEN   3392
#define XCD_BAR_WORDS 3456
#define XB_SPIN_CAP (1u << 18)
DI unsigned xb_ld(unsigned* p)              { return __hip_atomic_load(p, __ATOMIC_RELAXED, __HIP_MEMORY_SCOPE_AGENT); }
DI unsigned xb_add(unsigned* p, unsigned v) { return __hip_atomic_fetch_add(p, v, __ATOMIC_RELAXED, __HIP_MEMORY_SCOPE_AGENT); }
DI unsigned xb_xcc_id() { return (unsigned)__builtin_amdgcn_s_getreg((3 << 11) | 20) & 0xFu; }
#define XB_SPIN(cond, bar) do { unsigned _sp = 0; while (cond) { __builtin_amdgcn_s_sleep(1); \
    if ((++_sp & 255u) == 0u) { if (xb_ld(&(bar)[XB_TMO])) break; if (_sp > XB_SPIN_CAP) { atomicAdd(&(bar)[XB_TMO], 1u); break; } } } } while (0)
DI void xcd_barrier_complete(unsigned* bar, unsigned x, unsigned& nloc, unsigned& nx) {
    const unsigned G = gridDim.x;
    unsigned sum, cnt, mine, sp = 0u;
    for (;;) {
        sum = 0u; cnt = 0u; mine = 0u;
#pragma unroll
        for (unsigned j = 0; j < 16; ++j) { const unsigned c = xb_ld(&bar[XB_XCNT(j)]); sum += c; cnt += (c > 0u) ? 1u : 0u; mine = (j == x) ? c : mine; }
        if (sum == G) break;
        __builtin_amdgcn_s_sleep(1);
        if ((++sp & 255u) == 0u) { if (xb_ld(&bar[XB_TMO])) break; if (sp > XB_SPIN_CAP) { atomicAdd(&bar[XB_TMO], 1u); break; } }
    }
    nloc = mine > 0u ? mine : 1u; nx = cnt > 0u ? cnt : 1u;
}
DI void grid_barrier(char* lds) {
    asm volatile("s_waitcnt vmcnt(0)" ::: "memory");
    __syncthreads();
    if (threadIdx.x == 0) {
        unsigned* bar = kparams()->bar; const unsigned x = xb_xcc_id();
        volatile LAS unsigned* st = (volatile LAS unsigned*)(lds + 131072 + 2048);
        __builtin_amdgcn_s_waitcnt(0);
        unsigned nloc = st[0], nx = st[1];
        if (nloc == 0u) { xcd_barrier_complete(bar, x, nloc, nx); st[0] = nloc; st[1] = nx; }
        const unsigned old = xb_add(&bar[XB_XSUB(x)], 1u);
        const unsigned gen = old / nloc;
        if (old + 1u == (gen + 1u) * nloc) {
            __builtin_amdgcn_fence(__ATOMIC_RELEASE, "agent");
            asm volatile("s_waitcnt vmcnt(0)" ::: "memory");
            const unsigned og = xb_add(&bar[XB_TOP], 1u);
            const unsigned tg = og / nx;
            if (og + 1u == (tg + 1u) * nx) xb_add(&bar[XB_TOPGEN], 1u);
            else XB_SPIN(xb_ld(&bar[XB_TOPGEN]) == tg, bar);
            __builtin_amdgcn_fence(__ATOMIC_ACQUIRE, "agent");
            xb_add(&bar[XB_XGEN(x)], 1u);
            asm volatile("s_waitcnt vmcnt(0)" ::: "memory");
        } else {
            XB_SPIN(xb_ld(&bar[XB_XGEN(x)]) == gen, bar);
            __builtin_amdgcn_fence(__ATOMIC_ACQUIRE, "agent");
            asm volatile("s_waitcnt vmcnt(0)" ::: "memory");
        }
    }
    __syncthreads();
}

__global__ void __launch_bounds__(NTHREADS) fwd_megakernel(Params Pval) {
    extern __shared__ __attribute__((aligned(16))) char lds[];
    cg::grid_group grid = cg::this_grid();
    const int lo = kparams()->phase_lo, hi = kparams()->phase_hi;
#define PH(n) if (lo <= (n) && (n) < hi)
#define SYNC(n) if (lo <= (n) && (n) + 1 < hi) grid_barrier(lds)
    if (hi > 1000) grid.sync();
    { volatile LAS unsigned* st = (volatile LAS unsigned*)(lds + 131072 + 2048);
      if (threadIdx.x == 0) { st[0] = 0u; st[1] = 0u; }
      __syncthreads();
      if (threadIdx.x == 0) (void)xb_add(&kparams()->bar[XB_XCNT(xb_xcc_id())], 1u); }
    PH(0) phase0(kparams(), lds);
#ifdef PROBE_P0
    __syncthreads(); phase0(kparams(), lds);
#endif
#ifdef PROBE_SYNC
    for (int i = 0; i < 24; ++i) grid_barrier(lds);
#endif
    SYNC(0);
    PH(1) phase_h(kparams());
#ifdef PROBE_ROWS
    phase_h(kparams());
#endif
    SYNC(1);
    for (int ph = 2; ph <= 12; ++ph) {
        if (ph == 4) { PH(4) attn_phase(kparams(), lds, 0);
#ifdef PROBE_ATTN2
            __syncthreads(); attn_phase(kparams(), lds, 1);
#endif
            SYNC(4); continue; }
        if (ph == 8) { PH(8) phase_mid(kparams());
#ifdef PROBE_ROWS
            phase_mid(kparams());
#endif
            SYNC(8); continue; }
        if (ph == 10) { PH(10) phase_convfix(kparams());

            SYNC(10); continue; }
        if (ph == 12) { PH(12) phase_final(kparams()); continue; }
        if (lo <= ph && ph < hi) {
            const int npass = (ph == 3 || ph == 6) ? 2 : 1;
            for (int pass = 0; pass < npass; ++pass) {
                GemmDesc d; d.C = nullptr; d.ldc = 0; d.start = 0; KP P = kparams();
                switch (ph) {
                case 2: d.A = P->h; d.lda = DM; d.Bt = P->WinT; d.ldb = DM; d.K = DM; d.nM = 65; d.nN = 9; d.epi = E_INPROJ; break;
                case 3: if (pass == 0) { d.A = P->qlat; d.lda = 384; d.Bt = P->WuqT; d.ldb = 384; d.K = 384; d.nM = 65; d.nN = 3; d.epi = E_UQ; }
                        else { d.A = P->latent; d.lda = 256; d.Bt = P->WukvT; d.ldb = 256; d.K = 256; d.nM = 193; d.nN = 4; d.epi = E_UKV; d.start = 195; } break;
                case 5: d.A = P->h; d.lda = DM; d.Bt = P->WgT; d.ldb = DM; d.K = DM; d.nM = 64; d.nN = 8; d.epi = E_GATE; break;
                case 6: d.A = P->o + pass * 512; d.lda = DM; d.Bt = pass ? P->WpbT : P->WpaT; d.ldb = 512; d.K = 512; d.nM = 64; d.nN = 4; d.epi = pass ? E_PROJB : E_PROJA; break;
                case 7: d.A = P->merged; d.lda = DM; d.Bt = P->WoutT; d.ldb = DM; d.K = DM; d.nM = 64; d.nN = 4; d.epi = E_PLAIN; d.C = P->m2; d.ldc = DM; break;
                case 9: d.A = P->h2; d.lda = DM; d.Bt = P->WupT; d.ldb = DM; d.K = DM; d.nM = 65; d.nN = 22; d.epi = E_UP; break;
                default: d.A = P->g; d.lda = DFF; d.Bt = P->WdownT; d.ldb = DFF; d.K = DFF; d.nM = 64; d.nN = 4; d.epi = E_PLAIN; d.C = P->f; d.ldc = DM; break;
                }
                gemm_run(d, lds);
#ifdef PROBE_GEMM2
                if (ph == PROBE_GEMM2 && !(ph == 6 && pass == 0)) { __syncthreads(); if (ph == 6) { GemmDesc d0 = d; d0.A = P->o; d0.Bt = P->WpaT; d0.epi = E_PROJA; gemm_run(d0, lds); } gemm_run(d, lds); }
#endif
            }
        }
        if (lo <= ph && ph < hi) {
            KP P = kparams();
            if (ph == 5) gemm_small<1, 8>(P, P->h, DM, P->WgT, DM, 2048, P->gates, 2048, lds);
            else if (ph == 6) gemm_small<2, 4>(P, P->o, DM, P->WpaT, 512, 1024, P->merged, DM, lds);
            else if (ph == 7) gemm_small<0, 8>(P, P->merged, DM, P->WoutT, DM, 1024, P->m2, DM, lds);
            else if (ph == 11) gemm_small<0, 22>(P, P->g, DFF, P->WdownT, DFF, 1024, P->f, DM, lds);
#ifdef PROBE_SMALL
            if (ph == 5) gemm_small<1, 8>(P, P->h, DM, P->WgT, DM, 2048, P->gates, 2048, lds);
            else if (ph == 6) gemm_small<2, 4>(P, P->o, DM, P->WpaT, 512, 1024, P->merged, DM, lds);
            else if (ph == 7) gemm_small<0, 8>(P, P->merged, DM, P->WoutT, DM, 1024, P->m2, DM, lds);
            else if (ph == 11) gemm_small<0, 22>(P, P->g, DFF, P->WdownT, DFF, 1024, P->f, DM, lds);
#endif
        }
        SYNC(ph);
    }
}

static size_t bump(size_t& off, size_t bytes) { size_t r = off; off += (bytes + 255) & ~(size_t)255; return r; }

extern "C" void kernel_launch(void* const* d_in, const int* in_sizes, int n_in, void* d_out, int out_size, void* d_ws, size_t ws_size, hipStream_t stream) {
    Params P; memset(&P, 0, sizeof(P));
    const float* const* in = (const float* const*)d_in;
    P.x_p = in[0]; P.x_s = in[1]; P.c_ckv = in[2]; P.c_kr = in[3]; P.c_sbk = in[4]; P.c_sbv = in[5]; P.c_conv = in[6]; P.c_p = in[7]; P.c_s = in[8];
    P.w_ada = in[9]; P.b_ada = in[10]; P.g_pre_mix = in[11]; P.g_post_mix = in[12]; P.g_pre_ffn = in[13]; P.g_post_ffn = in[14];
    const float* w_in = in[15]; const float* g_q = in[16]; const float* w_uq = in[17]; P.g_kv = in[18]; const float* w_uk = in[19]; const float* w_uv = in[20];
    const float* w_pa = in[21]; const float* w_pb = in[22]; const float* w_out = in[23]; const float* w_up = in[24]; P.conv_w = in[25]; P.conv_b = in[26]; const float* w_down = in[27];
    P.out = (float*)d_out;
    char* ws = (char*)d_ws; size_t off = 0;
    P.WupT = (bf16_t*)(ws + bump(off, (size_t)DFF2 * DM * 2));
    P.WdownT = (bf16_t*)(ws + bump(off, (size_t)DM * DFF * 2));
    P.ropeT = (float*)(ws + bump(off, (size_t)TP * 32 * 4));
    P.ada = (float*)(ws + bump(off, 10 * 6144 * 4));
    P.ctr = (unsigned*)(ws + bump(off, 256));
    P.bar = (unsigned*)(ws + bump(off, XCD_BAR_WORDS * 4));
    const size_t R0 = off;
    P.WinT = (bf16_t*)(ws + bump(off, (size_t)2304 * DM * 2));
    P.WgT = (bf16_t*)(ws + bump(off, (size_t)2048 * DM * 2));
    P.WuqT = (bf16_t*)(ws + bump(off, (size_t)768 * 384 * 2));
    P.WukvT = (bf16_t*)(ws + bump(off, (size_t)1024 * 256 * 2));
    P.WpaT = (bf16_t*)(ws + bump(off, (size_t)1024 * 512 * 2));
    P.WpbT = (bf16_t*)(ws + bump(off, (size_t)1024 * 512 * 2));
    P.WoutT = (bf16_t*)(ws + bump(off, (size_t)1024 * 1024 * 2));
    const size_t o_kva = off;
    P.kva = (bf16_t*)(ws + bump(off, (size_t)KVROWS_PAD * 512 * 2));
    P.vaT_p = (bf16_t*)(ws + bump(off, (size_t)2 * 512 * TP * 2));
    P.vaT_s = (bf16_t*)(ws + bump(off, (size_t)8 * 512 * SKP * 2));
    const size_t o_kb = off;
    P.kb = (bf16_t*)(ws + bump(off, (size_t)KVROWS_PAD * 512 * 2));
    const size_t o_vbT = off;
    P.vbT_p = (bf16_t*)(ws + bump(off, (size_t)2 * 512 * TP * 2));
    P.vbT_s = (bf16_t*)(ws + bump(off, (size_t)8 * 512 * SKP * 2));
    const size_t o_kr = off;
    P.krope = (bf16_t*)(ws + bump(off, (size_t)KVROWS_PAD * 32 * 2));
    P.qb = (bf16_t*)(ws + bump(off, (size_t)MT * 512 * 2));
    P.q = (bf16_t*)(ws + bump(off, (size_t)MT * 768 * 2));
    P.latent = (bf16_t*)(ws + bump(off, (size_t)KVROWS_PAD * 256 * 2));
    size_t need = off;
    P.gates = (bf16_t*)(ws + o_kva);
    P.merged = (bf16_t*)(ws + o_kb);
    P.m2 = (bf16_t*)(ws + o_vbT);
    const size_t o_g = R0 + (size_t)MT * DFF2 * 2;
    P.g = (bf16_t*)(ws + R0);
    P.f = (bf16_t*)(ws + R0 + (size_t)100 * 1024 * 1024);
    P.ub = (bf16_t*)(ws + R0 + (size_t)140 * 1024 * 1024);
    P.u = (bf16_t*)(ws + R0 + (size_t)155 * 1024 * 1024);
    size_t o_h2 = o_kr > o_g ? o_kr : o_g;
    P.h2 = (bf16_t*)(ws + o_h2);
    if (o_h2 + (size_t)MT * DM * 2 > need) need = o_h2 + (size_t)MT * DM * 2;
    P.h = (bf16_t*)d_out;
    P.o = (bf16_t*)d_out + (size_t)MT * DM;
    P.qlat = P.o;
    if (need > ws_size) { fprintf(stderr, "workspace too small: need %zu have %zu\n", need, ws_size); return; }

    int nj = 0, tiles = 0;
    auto job = [&](const float* src, int lds, int coff, bf16_t* dst, int ldd, int Klen, int Nlen, const float* ks, int zero) {
        TJob& J = P.tj[nj++]; J.src = src; J.kscale = ks; J.dst = dst; J.lds = lds; J.coff = coff; J.ldd = ldd; J.Klen = Klen; J.Nlen = Nlen; J.zero = zero; J.tile0 = tiles; J.pad = 0;
        tiles += (Klen / 64) * ((Nlen + 255) / 256); };
    job(w_up, DFF2, 0, P.WupT, DM, DM, DFF2, nullptr, 2);
    job(w_down, DM, 0, P.WdownT, DFF, DFF, DM, nullptr, 0);
    job(w_in, 4256, 0, P.WinT, DM, DM, 384, nullptr, 0);
    job(w_in, 4256, 640, P.WinT + (size_t)384 * DM, DM, DM, 32, nullptr, 0);
    job(w_in, 4256, 0, P.WinT + (size_t)416 * DM, DM, DM, 96, nullptr, 1);
    job(w_in, 4256, 384, P.WinT + (size_t)512 * DM, DM, DM, 256, nullptr, 0);
    job(w_in, 4256, 672, P.WinT + (size_t)768 * DM, DM, DM, 1536, nullptr, 0);
    job(w_in, 4256, 2208, P.WgT, DM, DM, 2048, nullptr, 0);
    job(w_uq, 768, 0, P.WuqT, 384, 384, 768, g_q, 0);
    job(w_uk, 512, 0, P.WukvT, 256, 256, 512, nullptr, 0);
    job(w_uv, 512, 0, P.WukvT + (size_t)512 * 256, 256, 256, 512, nullptr, 0);
    job(w_pa, DM, 0, P.WpaT, 512, 512, DM, nullptr, 0);
    job(w_pb, DM, 0, P.WpbT, 512, 512, DM, nullptr, 0);
    job(w_out, DM, 0, P.WoutT, DM, DM, DM, nullptr, 0);
    P.ntj_tiles = tiles; P.pad0 = nj;
    for (int q = nj; q < NTJ; ++q) P.tj[q].tile0 = 0x7fffffff;
    P.phase_lo = 0; P.phase_hi = 13;

    static int grid_blocks = 0;
    if (!grid_blocks) {
        (void)hipFuncSetAttribute((const void*)fwd_megakernel, hipFuncAttributeMaxDynamicSharedMemorySize, LDS_BYTES);
        int dev = 0, cus = 0, per_cu = 0;
        (void)hipGetDevice(&dev);
        (void)hipDeviceGetAttribute(&cus, hipDeviceAttributeMultiprocessorCount, dev);
        (void)hipOccupancyMaxActiveBlocksPerMultiprocessor(&per_cu, fwd_megakernel, NTHREADS, LDS_BYTES);
        if (per_cu > 1) per_cu = 1;
        grid_blocks = cus * per_cu;
    }
    (void)hipMemsetAsync(P.ctr, 0, 256 + XCD_BAR_WORDS * 4, stream);
    void* args[] = {&P};
    hipError_t e = hipLaunchCooperativeKernel((const void*)fwd_megakernel, dim3(grid_blocks), dim3(NTHREADS), args, LDS_BYTES, stream);
    if (e != hipSuccess) fprintf(stderr, "cooperative launch failed: %s (grid %d)\n", hipGetErrorString(e), grid_blocks);
}
```

```cpp
#include <hip/hip_runtime.h>
#include <hip/hip_cooperative_groups.h>
#include <stdint.h>
#include <stdio.h>
#include <string.h>
namespace cg = cooperative_groups;

typedef unsigned short bf16_t;
typedef short bf16x8 __attribute__((ext_vector_type(8)));
typedef short s16x4 __attribute__((ext_vector_type(4)));
typedef float f32x2 __attribute__((ext_vector_type(2)));
typedef float f32x4 __attribute__((ext_vector_type(4)));
typedef float f32x16 __attribute__((ext_vector_type(16)));
typedef unsigned u32x2 __attribute__((ext_vector_type(2)));
typedef unsigned u32x4 __attribute__((ext_vector_type(4)));
typedef __bf16 bf2_t __attribute__((ext_vector_type(2)));
#define DI __device__ __forceinline__

constexpr int DM = 1024, TP = 8192, MP = 16384, MS = 256, MT = 16640, PAST = 4096, SKEYS = 4128, SKP = 4160;
constexpr int KVROWS = MP + 8 * SKEYS;
constexpr int KVROWS_PAD = KVROWS + 64;
constexpr int DFF = 2816, DFF2 = 5632;
constexpr float EPS = 1e-6f;
constexpr float LOG2E = 1.4426950408889634f, LN2 = 0.6931471805599453f;
constexpr int NTHREADS = 512;
constexpr int LDS_BYTES = 131072 + 8192;
constexpr long O_Y = 0, O_CKV_P = 17039360, O_KR_P = 21233664, O_SBK_P = 21757952, O_SBV_P = 30146560, O_CONV_P = 38535168,
               O_CKV_S = 38557696, O_KR_S = 38623232, O_SBK_S = 38631424, O_SBV_S = 38762496, O_CONV_S = 38893568;

struct TJob { const float* src; const float* kscale; bf16_t* dst; int lds, coff, ldd, Klen, Nlen, zero, tile0, pad; };
constexpr int NTJ = 22;

struct Params {
    const float *x_p, *x_s, *c_ckv, *c_kr, *c_sbk, *c_sbv, *c_conv, *c_p, *c_s;
    const float *w_ada, *b_ada, *g_pre_mix, *g_post_mix, *g_pre_ffn, *g_post_ffn, *g_kv, *conv_w, *conv_b;
    float* out;
    bf16_t *WupT, *WdownT, *WinT, *WgT, *WuqT, *WukvT, *WpaT, *WpbT, *WoutT;
    float* ropeT; float* ada; unsigned* ctr; unsigned* bar;
    bf16_t *h, *o, *qlat, *latent, *krope, *kb, *vbT_p, *vbT_s, *qb, *q, *kva, *vaT_p, *vaT_s, *gates, *merged, *m2, *h2, *u, *g, *f, *ub;
    TJob tj[NTJ]; int ntj_tiles; int phase_lo, phase_hi, pad0; int ntj_early, pad1;
};

#define LAS __attribute__((address_space(3)))
typedef const Params __attribute__((address_space(4))) * KP;
DI KP kparams() { KP p = (KP)__builtin_amdgcn_kernarg_segment_ptr(); asm volatile("" : "+s"(p)); return p; }
DI int otid() { int t = threadIdx.x; asm volatile("" : "+v"(t)); return t; }
DI int obid() { int b = blockIdx.x; asm volatile("" : "+s"(b)); return b; }
DI int ogrid() { int g = gridDim.x; asm volatile("" : "+s"(g)); return g; }
DI unsigned pk2(float a, float b) { f32x2 f = {a, b}; bf2_t r = __builtin_convertvector(f, bf2_t); return __builtin_bit_cast(unsigned, r); }
DI float bf_lo(unsigned u) { return __uint_as_float(u << 16); }
DI float bf_hi(unsigned u) { return __uint_as_float(u & 0xffff0000u); }
DI int kvrow_of(int row) { if (row < MP) return row; const int r = row - MP; return MP + (r >> 5) * SKEYS + PAST + (r & 31); }
DI int pos_of(int row) { return row < MP ? (row & (TP - 1)) : PAST + ((row - MP) & 31); }
DI int ada_b(int row) { return row < MP ? (row >> 13) : 2 + ((row - MP) >> 5); }
DI float sigmoidf_(float x) { return __builtin_amdgcn_rcpf(1.0f + __builtin_amdgcn_exp2f(-1.4426950408889634f * x)); }

constexpr int BM = 256, BK = 64, HALF = 128, HT = HALF * BK;
DI int lds_byte(int r, int c) { int st = (r >> 4) * 2 + (c >> 5), rr = r & 15, cc = c & 31, ob = rr * 64 + cc * 2; return st * 1024 + (ob ^ (((ob >> 9) & 1) << 5)); }
DI void stage_rc(int b, int& R, int& C) { int st = b / 1024, sb = b % 1024, swz = sb ^ (((sb >> 9) & 1) << 5); R = (st >> 1) * 16 + swz / 64; C = (st & 1) * 32 + (swz % 64) / 2; }

enum { E_INPROJ = 0, E_GATE, E_UQ, E_UKV, E_PROJA, E_PROJB, E_PLAIN, E_UP };
struct GemmDesc { const bf16_t* A; const bf16_t* Bt; bf16_t* C; int lda, ldb, ldc, K, nM, nN, epi, start; };

constexpr int HTB = HT * 2;
#define SA(b, h) (((b) * 2 + (h)) * HTB)
#define SB(b, h) ((4 + (b) * 2 + (h)) * HTB)
#define STAGE(bufoff, gbase, voff) do { _Pragma("unroll") for (int _i = 0; _i < 2; ++_i) \
    __builtin_amdgcn_global_load_lds((const unsigned*)((const char*)(gbase) + (voff)[_i]), (LAS unsigned*)(ldsl + (bufoff) + ldsw + _i * 8192), 16, 0, 0); } while (0)
#define LDA(dst, b, h) do { _Pragma("unroll") for (int m = 0; m < 4; ++m) _Pragma("unroll") for (int k = 0; k < 2; ++k) dst[m][k] = *(const LAS bf16x8*)(ldsl + SA(b, h) + aoff + m * 2048 + k * 1024); } while (0)
#define LDB(dst, b, h) do { _Pragma("unroll") for (int n = 0; n < 2; ++n) _Pragma("unroll") for (int k = 0; k < 2; ++k) dst[n][k] = *(const LAS bf16x8*)(ldsl + SB(b, h) + boff + n * 2048 + k * 1024); } while (0)
#define MMA(ai, bj, At, Bt_) do { __builtin_amdgcn_s_setprio(1); _Pragma("unroll") for (int m = 0; m < 4; ++m) _Pragma("unroll") for (int n = 0; n < 2; ++n) _Pragma("unroll") for (int k = 0; k < 2; ++k) \
      acc[ai][bj][m][n] = __builtin_amdgcn_mfma_f32_16x16x32_bf16(Bt_[n][k], At[m][k], acc[ai][bj][m][n], 0, 0, 0); \
    __builtin_amdgcn_s_setprio(0); } while (0)
#define WAIT_V(n) asm volatile("s_waitcnt vmcnt(" #n ")" ::: "memory")
#define WAIT_L(n) asm volatile("s_waitcnt lgkmcnt(" #n ")" ::: "memory")
#define BAR __builtin_amdgcn_s_barrier()
#define SCHED __builtin_amdgcn_sched_barrier(0)
#define ZERO_ACC do { _Pragma("unroll") for (int a_ = 0; a_ < 2; ++a_) _Pragma("unroll") for (int b_ = 0; b_ < 2; ++b_) _Pragma("unroll") for (int m_ = 0; m_ < 4; ++m_) _Pragma("unroll") for (int n_ = 0; n_ < 2; ++n_) \
    acc[a_][b_][m_][n_] = (f32x4){0.f, 0.f, 0.f, 0.f}; } while (0)

#define EPI_ROWS for (int ai = 0; ai < 2; ++ai) for (int m = 0; m < 4; ++m, ({ asm volatile("" ::: "memory"); }))
#define EPI_COLS for (int bj = 0; bj < 2; ++bj) for (int n = 0; n < 2; ++n)

DI float dpp_xor1(float x) { return __int_as_float(__builtin_amdgcn_mov_dpp(__float_as_int(x), 0xB1, 0xF, 0xF, true)); }
DI float dpp_xor2(float x) { return __int_as_float(__builtin_amdgcn_mov_dpp(__float_as_int(x), 0x4E, 0xF, 0xF, true)); }
DI float gelu_tanh(float a) { const float a2 = a * a; const float q = a * __builtin_fmaf(0.10294324f, a2, 2.3022082f);
    const float e = __builtin_amdgcn_exp2f(q); const float r = __builtin_amdgcn_rcpf(1.0f + e); return __builtin_fmaf(-a, r, a); }
DI float dpp_ror1(float x) { return __int_as_float(__builtin_amdgcn_mov_dpp(__float_as_int(x), 0x121, 0xF, 0xF, true)); }
DI float dpp_ror2(float x) { return __int_as_float(__builtin_amdgcn_mov_dpp(__float_as_int(x), 0x122, 0xF, 0xF, true)); }
DI f32x4 ror1_4(f32x4 v) { return (f32x4){dpp_ror1(v[0]), dpp_ror1(v[1]), dpp_ror1(v[2]), dpp_ror1(v[3])}; }
DI f32x4 ror2_4(f32x4 v) { return (f32x4){dpp_ror2(v[0]), dpp_ror2(v[1]), dpp_ror2(v[2]), dpp_ror2(v[3])}; }
DI f32x4 quad_transpose(f32x4 v, int i) {
    { const float a = (i & 1) ? v[0] : v[1], c = (i & 1) ? v[2] : v[3]; const float ra = dpp_xor1(a), rc = dpp_xor1(c);
      if (i & 1) { v[0] = ra; v[2] = rc; } else { v[1] = ra; v[3] = rc; } }
    { const float a = (i & 2) ? v[0] : v[2], c = (i & 2) ? v[1] : v[3]; const float ra = dpp_xor2(a), rc = dpp_xor2(c);
      if (i & 2) { v[0] = ra; v[1] = rc; } else { v[2] = ra; v[3] = rc; } }
    return v;
}
DI void store_bf4(bf16_t* p, f32x4 v) { u32x2 w; w.x = pk2(v[0], v[1]); w.y = pk2(v[2], v[3]); *(u32x2*)p = w; }

DI int unit_at(int k, int bid, int G, int nM, int nN, int start) {
    if (G != 256) { const int u = (bid + G - (start % G)) % G + k * G; return u < nM * nN ? u : -1; }
    const int x = bid & 7, l = ((bid >> 3) + start) & 31, cnt = nM >> 3, mainn = cnt * nN, j = l + 32 * k;
    if (j < mainn) { const int pn = j / cnt, rm = j - pn * cnt; return (x + 8 * rm) * nN + pn; }
    const int idx = x + 8 * (j - mainn);
    if (idx < (nM & 7) * nN) return (8 * cnt + idx / nN) * nN + idx % nN;
    return -1;
}

DI void gemm_run(const GemmDesc& d, char* lds) {
    LAS char* ldsl = (LAS char*)lds;
    float* xl = (float*)(lds + 131072);
    float* xp = (float*)(lds + 131072 + 4096);
    const int G = ogrid(), bid_ = obid(), first = unit_at(0, bid_, G, d.nM, d.nN, d.start);
    if (first < 0) return;
    int kun = 0;
    const int tid = otid(), wid = __builtin_amdgcn_readfirstlane(tid >> 6), wr = wid >> 2, wc = wid & 3;
    const unsigned lda2 = (unsigned)d.lda * 2u, ldb2 = (unsigned)d.ldb * 2u;
    unsigned voffA[2], voffB[2];
    { const int lane = tid & 63;
#pragma unroll
      for (int i = 0; i < 2; ++i) { int R, C; stage_rc(tid * 16 + i * 8192, R, C); voffA[i] = (unsigned)R * lda2 + (unsigned)C * 2u; voffB[i] = (unsigned)R * ldb2 + (unsigned)C * 2u; }
      (void)lane; }
    const size_t kstep = 128, hA = (size_t)HALF * lda2, hB = (size_t)HALF * ldb2;
    const unsigned ldsw = (unsigned)wid * 1024u;
    const int aoff = lds_byte(wr * 64 + (tid & 15), ((tid & 63) >> 4) * 8), boff = lds_byte(wc * 32 + (tid & 15), ((tid & 63) >> 4) * 8);
    const int nt = d.K / BK;
    int u = first;
    const char* cA = (const char*)d.A + (size_t)(u / d.nN) * 2 * hA; const char* cB = (const char*)d.Bt + (size_t)(u % d.nN) * 2 * hB;
    f32x4 acc[2][2][4][2];
    ZERO_ACC;
    bf16x8 At[4][2], B0[2][2], B1[2][2];
    STAGE(SB(0, 0), cB, voffB); STAGE(SB(0, 1), cB + hB, voffB); STAGE(SA(0, 0), cA, voffA); STAGE(SA(0, 1), cA + hA, voffA);
    if (wr == 1) BAR;
    WAIT_V(2); BAR;
    STAGE(SB(1, 0), cB + kstep, voffB); STAGE(SA(1, 0), cA + kstep, voffA); STAGE(SB(1, 1), cB + hB + kstep, voffB);
    WAIT_V(6); BAR;
    for (;;) {
        const int un = unit_at(kun + 1, bid_, G, d.nM, d.nN, d.start); const bool has_next = un >= 0;
        const char* nA = has_next ? (const char*)d.A + (size_t)(un / d.nN) * 2 * hA : cA; const char* nB = has_next ? (const char*)d.Bt + (size_t)(un % d.nN) * 2 * hB : cB;
        for (int t = 0; t < nt; t += 2) {
            const bool last = (t == nt - 2);
            const char* a1 = cA + (size_t)(t + 1) * kstep;
            const char* a2 = last ? nA : cA + (size_t)(t + 2) * kstep; const char* b2 = last ? nB : cB + (size_t)(t + 2) * kstep;
            const char* a3 = a2 + kstep; const char* b3 = b2 + kstep;
            LDB(B0, 0, 0); LDB(B1, 0, 1); SCHED; LDA(At, 0, 0); STAGE(SA(1, 1), a1 + hA, voffA);
            WAIT_V(8); WAIT_L(0); BAR; MMA(0, 0, At, B0); MMA(0, 1, At, B1); BAR; SCHED;
            LDA(At, 0, 1); STAGE(SB(0, 0), b2, voffB); STAGE(SB(0, 1), b2 + hB, voffB); STAGE(SA(0, 0), a2, voffA);
            WAIT_V(8); WAIT_L(0); BAR; MMA(1, 0, At, B0); MMA(1, 1, At, B1); BAR; SCHED;
            LDB(B0, 1, 0); LDB(B1, 1, 1); SCHED; LDA(At, 1, 0); STAGE(SA(0, 1), a2 + hA, voffA);
            WAIT_V(8); WAIT_L(0); BAR; MMA(0, 0, At, B0); MMA(0, 1, At, B1); BAR; SCHED;
            LDA(At, 1, 1); STAGE(SB(1, 0), b3, voffB); STAGE(SB(1, 1), b3 + hB, voffB); STAGE(SA(1, 0), a3, voffA);
            WAIT_V(8); WAIT_L(0); BAR; MMA(1, 0, At, B0); MMA(1, 1, At, B1); BAR; SCHED;
        }
        if (wr == 0) BAR;
        {
        const int pm = u / d.nN, pn = u % d.nN, brow = pm * BM, bcol = pn * BM;
        if (d.epi == E_UQ) {
            const int tq_ = otid(), r = tq_ >> 1, hf = tq_ & 1;
            const u32x4* src = (const u32x4*)(d.A + (long)(brow + r) * 384 + hf * 192);
            float sq = 0.f;
#pragma unroll 4
            for (int i = 0; i < 24; ++i) { u32x4 v = src[i];
                for (int e = 0; e < 4; ++e) { float a_ = bf_lo(v[e]), b_ = bf_hi(v[e]); sq += a_ * a_ + b_ * b_; } }
            sq += __shfl_xor(sq, 1);
            if (hf == 0) xl[r] = rsqrtf(sq * (1.0f / 384.0f) + EPS);
            WAIT_L(0); BAR; asm volatile("" ::: "memory");
        }
        int lane_e = threadIdx.x & 63; asm volatile("" : "+v"(lane_e));
        const int fr = lane_e & 15, fq = lane_e >> 4;
        KP P = kparams();
        const int rbase = brow + wr * 64 + fr, cbase = bcol + wc * 32 + fq * 4;
        switch (d.epi) {
        case E_INPROJ: {
            if (pn == 0) {
#pragma unroll
                EPI_ROWS { const int row = rbase + ai * 128 + m * 16;
#pragma unroll
                    EPI_COLS store_bf4(P->qlat + (long)row * 384 + (cbase + bj * 128 + n * 16), acc[ai][bj][m][n]); }
            } else if (pn == 1) {
#pragma unroll
                EPI_ROWS { const int row = rbase + ai * 128 + m * 16;
#pragma unroll
                    for (int n = 0; n < 2; ++n) store_bf4(P->qlat + (long)row * 384 + 256 + (wc * 32 + fq * 4 + n * 16), acc[ai][0][m][n]);
                    if (wc == 0) {
                        const int pos = pos_of(row);
                        const f32x4 cs0 = *(const f32x4*)(P->ropeT + (long)pos * 32 + fq * 8), cs1 = *(const f32x4*)(P->ropeT + (long)pos * 32 + fq * 8 + 4);
                        const f32x4 x1 = acc[ai][1][m][0], x2 = acc[ai][1][m][1];
                        f32x4 co = {cs0[0], cs0[2], cs1[0], cs1[2]}, si = {cs0[1], cs0[3], cs1[1], cs1[3]};
                        f32x4 o1 = x1 * co - x2 * si, o2 = x2 * co + x1 * si;
                        float* of = P->out + (row < MP ? O_KR_P + (long)row * 32 : O_KR_S + (long)(row - MP) * 32);
                        *(f32x4*)(of + fq * 4) = o1; *(f32x4*)(of + 16 + fq * 4) = o2;
                        bf16_t* ob = P->krope + (long)kvrow_of(row) * 32;
                        store_bf4(ob + fq * 4, o1); store_bf4(ob + 16 + fq * 4, o2);
                    } }
            } else if (pn == 2) {
                float ss[2][4];
#pragma unroll
                EPI_ROWS { float s = 0.f;
#pragma unroll
                    EPI_COLS { const f32x4 v = acc[ai][bj][m][n]; s += v[0] * v[0] + v[1] * v[1] + v[2] * v[2] + v[3] * v[3]; }
                    s += __shfl_xor(s, 16); s += __shfl_xor(s, 32); ss[ai][m] = s;
                    if (fq == 0) xp[(ai * 128 + wr * 64 + m * 16 + fr) * 4 + wc] = s; }
                WAIT_L(0); BAR; asm volatile("" ::: "memory");
#pragma unroll
                EPI_ROWS { const int rl = ai * 128 + wr * 64 + m * 16 + fr, row = brow + rl;
                    const f32x4 pp = *(const f32x4*)(xp + rl * 4);
                    const float rstd = rsqrtf((pp[0] + pp[1] + pp[2] + pp[3]) * (1.0f / 256.0f) + EPS);
                    float* of = P->out + (row < MP ? O_CKV_P + (long)row * 256 : O_CKV_S + (long)(row - MP) * 256);
                    bf16_t* ob = P->latent + (long)kvrow_of(row) * 256;
#pragma unroll
                    EPI_COLS { const int c = wc * 32 + fq * 4 + bj * 128 + n * 16;
                        const f32x4 gv = *(const f32x4*)(P->g_kv + c); const f32x4 o = acc[ai][bj][m][n] * rstd * gv;
                        *(f32x4*)(of + c) = o; store_bf4(ob + c, o); } }
            } else if (pn <= 4) {
#pragma unroll
                EPI_ROWS { const int row = rbase + ai * 128 + m * 16;
#pragma unroll
                    EPI_COLS store_bf4(P->qb + (long)row * 512 + (cbase - 768 + bj * 128 + n * 16), acc[ai][bj][m][n] * 0.125f); }
            } else if (pn <= 6) {
#pragma unroll
                EPI_ROWS { const int row = rbase + ai * 128 + m * 16;
                    float* of = P->out + (row < MP ? O_SBK_P + (long)row * 512 : O_SBK_S + (long)(row - MP) * 512);
                    bf16_t* ob = P->kb + (long)kvrow_of(row) * 512;
#pragma unroll
                    EPI_COLS { const int c = cbase - 1280 + bj * 128 + n * 16; *(f32x4*)(of + c) = acc[ai][bj][m][n]; store_bf4(ob + c, acc[ai][bj][m][n]); } }
            } else {
#pragma unroll
                EPI_ROWS { const int row = rbase + ai * 128 + m * 16;
                    float* of = P->out + (row < MP ? O_SBV_P + (long)row * 512 : O_SBV_S + (long)(row - MP) * 512);
                    const int qi = fr & 3, row4 = row - qi;
                    bf16_t* vt; int ldv;
                    if (row4 < MP) { vt = P->vbT_p + (long)(row4 >> 13) * 512 * TP + (row4 & (TP - 1)); ldv = TP; }
                    else { const int r = row4 - MP; vt = P->vbT_s + (long)(r >> 5) * 512 * SKP + PAST + (r & 31); ldv = SKP; }
#pragma unroll
                    EPI_COLS { const int c = cbase - 1792 + bj * 128 + n * 16; const f32x4 v = acc[ai][bj][m][n]; *(f32x4*)(of + c) = v;
                        store_bf4(vt + (long)(c + qi) * ldv, quad_transpose(v, qi)); } }
            }
        } break;
        case E_GATE: {
#pragma unroll
            EPI_ROWS { const int row = rbase + ai * 128 + m * 16;
#pragma unroll
                EPI_COLS { const f32x4 v = acc[ai][bj][m][n]; f32x4 s = {sigmoidf_(v[0]), sigmoidf_(v[1]), sigmoidf_(v[2]), sigmoidf_(v[3])};
                    store_bf4(P->gates + (long)row * 2048 + (cbase + bj * 128 + n * 16), s); } }
        } break;
        case E_UQ: {
            const float qs = 0.10206207261596577f * LOG2E;
#pragma unroll
            EPI_ROWS { const int rl = ai * 128 + wr * 64 + m * 16 + fr, row = brow + rl; const float rs = xl[rl] * qs;
#pragma unroll
                for (int bj = 0; bj < 2; ++bj) { const int grp = pn * 8 + bj * 4 + wc; bf16_t* dst = P->q + (long)row * 768 + grp * 32 + fq * 4;
                    f32x4 v0 = acc[ai][bj][m][0] * rs, v1 = acc[ai][bj][m][1] * rs;
                    if (grp % 3 == 2) {
                        const int pos = pos_of(row);
                        const f32x4 cs0 = *(const f32x4*)(P->ropeT + (long)pos * 32 + fq * 8), cs1 = *(const f32x4*)(P->ropeT + (long)pos * 32 + fq * 8 + 4);
                        f32x4 co = {cs0[0], cs0[2], cs1[0], cs1[2]}, si = {cs0[1], cs0[3], cs1[1], cs1[3]};
                        const f32x4 o1 = v0 * co - v1 * si, o2 = v1 * co + v0 * si; v0 = o1; v1 = o2;
                    }
                    store_bf4(dst, v0); store_bf4(dst + 16, v1); } }
        } break;
        case E_UKV: {
#pragma unroll
            EPI_ROWS { const int row = rbase + ai * 128 + m * 16;
                if (pn < 2) {
#pragma unroll
                    EPI_COLS store_bf4(P->kva + (long)row * 512 + (cbase + bj * 128 + n * 16), acc[ai][bj][m][n]);
                } else {
                    const int qi = fr & 3, row4 = row - qi;
                    bf16_t* vt; int ldv;
                    if (row4 < MP) { vt = P->vaT_p + (long)(row4 >> 13) * 512 * TP + (row4 & (TP - 1)); ldv = TP; }
                    else { const int r = row4 - MP, b = r / SKEYS; vt = P->vaT_s + (long)b * 512 * SKP + (r - b * SKEYS); ldv = SKP; }
#pragma unroll
                    EPI_COLS { const int c = cbase - 512 + bj * 128 + n * 16; const f32x4 vtr = quad_transpose(acc[ai][bj][m][n], qi);
                        if (row4 < KVROWS) store_bf4(vt + (long)(c + qi) * ldv, vtr); }
                } }
        } break;
        case E_PROJA: case E_PROJB: {
            const int goff = d.epi == E_PROJA ? 0 : 1024;
#pragma unroll
            EPI_ROWS { const int row = rbase + ai * 128 + m * 16;
#pragma unroll
                EPI_COLS { const int c = cbase + bj * 128 + n * 16; const u32x2 gw = *(const u32x2*)(P->gates + (long)row * 2048 + goff + c);
                    f32x4 gv = {bf_lo(gw.x), bf_hi(gw.x), bf_lo(gw.y), bf_hi(gw.y)}; f32x4 v = acc[ai][bj][m][n] * gv;
                    bf16_t* dst = P->merged + (long)row * 1024 + c;
                    if (d.epi == E_PROJB) { const u32x2 pw = *(const u32x2*)dst; f32x4 pv = {bf_lo(pw.x), bf_hi(pw.x), bf_lo(pw.y), bf_hi(pw.y)}; v += pv; }
                    store_bf4(dst, v); } }
        } break;
        case E_PLAIN: {
#pragma unroll
            EPI_ROWS { const int row = rbase + ai * 128 + m * 16;
#pragma unroll
                EPI_COLS store_bf4(d.C + (long)row * d.ldc + (cbase + bj * 128 + n * 16), acc[ai][bj][m][n]); }
        } break;
        case E_UP: {
            const int jc0 = pn * 128 + wc * 32 + fq * 4;
            if (pm != 64) {
                const int tq_ = otid(), arr = tq_ >> 6, c2 = (tq_ & 63) * 2, hfb = arr >> 2, kk = arr & 3;
                const float* src = (kk < 3 ? P->conv_w + kk * DFF2 : P->conv_b) + hfb * DFF + pn * 128 + c2;
                *(f32x2*)(xp + arr * 128 + c2) = *(const f32x2*)src;
                WAIT_L(0); BAR; asm volatile("" ::: "memory");
            }
            if (pm == 64) {
#pragma unroll
                EPI_ROWS { const int row = rbase + ai * 128 + m * 16, r = row - MP, t = r & 31;
                    float* cf = t >= 30 ? P->out + O_CONV_S + (long)((r >> 5) * 2 + (t - 30)) * DFF2 : nullptr;
#pragma unroll
                    EPI_COLS { const int c = (bj ? DFF : 0) + jc0 + n * 16; store_bf4(P->u + (long)r * DFF2 + c, acc[ai][bj][m][n]); if (cf) *(f32x4*)(cf + c) = acc[ai][bj][m][n]; } }
            } else {
#pragma unroll
                for (int ai = 0; ai < 2; ++ai)
#pragma unroll
                    for (int n = 0; n < 2; ++n) {
                        const int ca = jc0 + n * 16;
                        f32x4 pa1 = {0.f, 0.f, 0.f, 0.f}, pa2 = pa1, pb1 = pa1, pb2 = pa1;
#pragma unroll
                        for (int m = 0; m < 4; ++m) {
                            const int row = rbase + ai * 128 + m * 16;
                            const f32x4 va = acc[ai][0][m][n], vb = acc[ai][1][m][n];
                            const f32x4 ra1 = ror1_4(va), ra2 = ror2_4(va), rb1 = ror1_4(vb), rb2 = ror2_4(vb);
                            const f32x4 p1a = fr >= 1 ? ra1 : pa1, p2a = fr >= 2 ? ra2 : pa2, p1b = fr >= 1 ? rb1 : pb1, p2b = fr >= 2 ? rb2 : pb2;
                            const float* wl = xp + (ca - pn * 128);
                            f32x4 ya = *(const f32x4*)(wl + 3 * 128) + *(const f32x4*)(wl) * p2a; ya += *(const f32x4*)(wl + 128) * p1a; ya += *(const f32x4*)(wl + 2 * 128) * va;
                            f32x4 yb = *(const f32x4*)(wl + 7 * 128) + *(const f32x4*)(wl + 4 * 128) * p2b; yb += *(const f32x4*)(wl + 5 * 128) * p1b; yb += *(const f32x4*)(wl + 6 * 128) * vb;
                            const f32x4 g4 = {gelu_tanh(ya[0]) * yb[0], gelu_tanh(ya[1]) * yb[1], gelu_tanh(ya[2]) * yb[2], gelu_tanh(ya[3]) * yb[3]};
                            if (!(m == 0 && fr < 2)) store_bf4(P->g + (long)row * DFF + ca, g4);
                            const int blk = row >> 6;
                            if (m == 0 && fr < 2) { bf16_t* up = P->ub + (long)(blk * 4 + 2 + fr) * DFF2 + ca; store_bf4(up, va); store_bf4(up + DFF, vb); }
                            if (m == 3 && fr >= 14) { bf16_t* up = P->ub + (long)(blk * 4 + (fr - 14)) * DFF2 + ca; store_bf4(up, va); store_bf4(up + DFF, vb);
                                const int t = row & (TP - 1);
                                if (t >= TP - 2) { float* cf = P->out + O_CONV_P + (long)((row >> 13) * 2 + (t - (TP - 2))) * DFF2 + ca; *(f32x4*)cf = va; *(f32x4*)(cf + DFF) = vb; } }
                            pa1 = ra1; pa2 = ra2; pb1 = rb1; pb2 = rb2;
                            asm volatile("" ::: "memory");
                        }
                    }
            }
        } break;
        }
        }
        if (!has_next) break;
        ZERO_ACC;
        u = un; cA = nA; cB = nB; ++kun;
        if (wr == 1) BAR;
    }
    WAIT_V(0);
    BAR;
}

#define MFMA32(a, b, c) __builtin_amdgcn_mfma_f32_32x32x16_bf16((a), (b), (c), 0, 0, 0)
template <int KIND, int KSTEPS  >
DI void gemm_small(KP P, const bf16_t* A, int lda, const bf16_t* Bt, int ldb, int N, bf16_t* C, int ldc, char* lds) {
    const int tid = otid(), lane = tid & 63, w = tid >> 6, r = lane & 31, hh = lane >> 5, G = ogrid();
    const int ntask = 8 * (N >> 5);
    float* part = (float*)lds;
    for (int task = obid(); task < ntask; task += G) {
        const int cb = (task & 7) + 8 * (task >> 6), rb = (task >> 3) & 7, row0 = MP + rb * 32, col0 = cb * 32;
#pragma unroll
        for (int pass = 0; pass < (KIND == 2 ? 2 : 1); ++pass) {
            const bf16_t* ap = A + pass * 512 + (long)(row0 + r) * lda + w * (KSTEPS * 16) + 8 * hh;
            const bf16_t* bp = (pass ? P->WpbT : Bt) + (long)(col0 + r) * ldb + w * (KSTEPS * 16) + 8 * hh;
            f32x16 acc;
#pragma unroll
            for (int i = 0; i < 16; ++i) acc[i] = 0.f;
            constexpr int UN = KSTEPS > 11 ? 11 : KSTEPS;
#pragma unroll 1
            for (int s0 = 0; s0 < KSTEPS; s0 += UN) {
                bf16x8 af[UN], bf[UN];
#pragma unroll
                for (int s = 0; s < UN; ++s) { af[s] = *(const bf16x8*)(ap + (s0 + s) * 16); bf[s] = *(const bf16x8*)(bp + (s0 + s) * 16); }
#pragma unroll
                for (int s = 0; s < UN; ++s) acc = MFMA32(bf[s], af[s], acc);
            }
            float* pp = part + ((pass * 8 + w) * 32 + r) * 32 + 4 * hh;
#pragma unroll
            for (int g = 0; g < 4; ++g) *(f32x4*)(pp + 8 * g) = (f32x4){acc[4 * g], acc[4 * g + 1], acc[4 * g + 2], acc[4 * g + 3]};
        }
        __syncthreads();
        {
            const int e = tid * 2, rr = e >> 5, cc = e & 31;
            f32x2 s1 = {0.f, 0.f}, s2 = {0.f, 0.f};
#pragma unroll
            for (int ww = 0; ww < 8; ++ww) { s1 += *(const f32x2*)(part + (ww * 32 + rr) * 32 + cc); if (KIND == 2) s2 += *(const f32x2*)(part + ((8 + ww) * 32 + rr) * 32 + cc); }
            const long row = row0 + rr; const int col = col0 + cc;
            if (KIND == 1) { s1[0] = sigmoidf_(s1[0]); s1[1] = sigmoidf_(s1[1]); }
            if (KIND == 2) { const unsigned ga = *(const unsigned*)(P->gates + row * 2048 + col), gb = *(const unsigned*)(P->gates + row * 2048 + 1024 + col);
                s1[0] = s1[0] * bf_lo(ga) + s2[0] * bf_lo(gb); s1[1] = s1[1] * bf_hi(ga) + s2[1] * bf_hi(gb); }
            *(unsigned*)(C + row * ldc + col) = pk2(s1[0], s1[1]);
        }
        __syncthreads();
    }
}

DI int crow(int i, int h) { return (i & 3) + 8 * (i >> 2) + 4 * h; }

template <int MODE, bool F32P>
DI void attn_unit(KP P, char* lds, bool sample, int b, int h, int ublk) {
    constexpr int DQK = MODE == 0 ? 96 : 64, KS = DQK * 2 + 16, VS = 144, NS = DQK / 16;
    constexpr int KBYTES = 64 * KS, BUF = KBYTES + 64 * VS;
    const int tid = otid(), w = tid >> 6, lane = tid & 63, ql = lane & 31, hh = lane >> 5;
    const int kvrow0 = sample ? MP + b * SKEYS : b * TP;
    const int qrow0 = sample ? MP + b * 32 : b * TP + ublk * 256;
    const int ntiles = sample ? 65 : 4 * (ublk + 1);
    const int t0 = sample ? 0 : ublk * 256 + w * 32, tq = t0 + ql;
    int klim, wmax, wmin;
    if (MODE == 0) { if (sample) { klim = wmax = wmin = SKEYS; } else { klim = ((tq >> 6) + 1) << 6; wmax = (((t0 + 31) >> 6) + 1) << 6; wmin = ((t0 >> 6) + 1) << 6; } }
    else { if (sample) { klim = PAST + tq; wmax = PAST + 31; wmin = PAST; } else { klim = tq; wmax = t0 + 31; wmin = t0; } }
    const bool wactive = sample ? (w == 0) : true;
    const bf16_t* Kp; const bf16_t* Qp; const bf16_t* VT; int ldq; long ldv;
    if (MODE == 0) { Kp = P->kva + (long)kvrow0 * 512 + h * 64; Qp = P->q + (long)qrow0 * 768 + h * 96; ldq = 768;
        VT = sample ? P->vaT_s + (long)(b * 512 + h * 64) * SKP : P->vaT_p + (long)(b * 512 + h * 64) * TP; }
    else { Kp = P->kb + (long)kvrow0 * 512 + h * 64; Qp = P->qb + (long)qrow0 * 512 + h * 64; ldq = 512;
        VT = sample ? P->vbT_s + (long)(b * 512 + h * 64) * SKP : P->vbT_p + (long)(b * 512 + h * 64) * TP; }
    ldv = sample ? SKP : TP;
    const bf16_t* Kr = P->krope + (long)kvrow0 * 32;

    bf16x8 qf[NS];
    if (wactive) {
        const bf16_t* qp = Qp + (long)(w * 32 + ql) * ldq + 8 * hh;
#pragma unroll
        for (int s = 0; s < NS; ++s) qf[s] = *(const bf16x8*)(qp + 16 * s);
    } else {
#pragma unroll
        for (int s = 0; s < NS; ++s) qf[s] = (bf16x8){0, 0, 0, 0, 0, 0, 0, 0};
    }
    f32x16 O0, O1;
#pragma unroll
    for (int i = 0; i < 16; ++i) { O0[i] = 0.f; O1[i] = 0.f; }
    float mrun = -INFINITY, lrun = 0.f, carry = 0.f;
    bool wdone = !wactive;
    volatile int* flags = (volatile int*)(lds + 65536 + 64);

    u32x4 rk0, rk1, rv; f32x4 fa0, fa1, fc0, fc1;
    const int krow_s = tid >> 3, kc_s = tid & 7, rrow_s = tid >> 2, rc_s = tid & 3;
    const float* Kf = P->c_sbk + ((long)b * PAST * 512 + h * 64); const float* Vf = P->c_sbv + ((long)b * PAST * 512 + h * 64);
    auto load_bf = [&](int kt) {
        rk0 = *(const u32x4*)(Kp + (long)(kt * 64 + krow_s) * 512 + kc_s * 8);
        if (MODE == 0 && tid < 256) rk1 = *(const u32x4*)(Kr + (long)(kt * 64 + rrow_s) * 32 + rc_s * 8);
        rv = *(const u32x4*)(VT + (long)krow_s * ldv + kt * 64 + kc_s * 8);
    };
    auto store_bf = [&](int buf) {
        char* kb_ = lds + buf * BUF; char* vb_ = kb_ + KBYTES;
        *(u32x4*)(kb_ + krow_s * KS + kc_s * 16) = rk0;
        if (MODE == 0 && tid < 256) *(u32x4*)(kb_ + rrow_s * KS + 128 + rc_s * 16) = rk1;
        *(u32x4*)(vb_ + krow_s * VS + kc_s * 16) = rv;
    };
    auto load_f32 = [&](int kt) {
        const float* kp_ = Kf + (long)(kt * 64 + krow_s) * 512 + kc_s * 8; const float* vp_ = Vf + (long)(kt * 64 + krow_s) * 512 + kc_s * 8;
        fa0 = *(const f32x4*)kp_; fa1 = *(const f32x4*)(kp_ + 4); fc0 = *(const f32x4*)vp_; fc1 = *(const f32x4*)(vp_ + 4);
    };
    auto store_f32 = [&](int buf) {
        char* kb_ = lds + buf * BUF; char* vb_ = kb_ + KBYTES;
        u32x4 kk, vv;
        kk.x = pk2(fa0[0], fa0[1]); kk.y = pk2(fa0[2], fa0[3]); kk.z = pk2(fa1[0], fa1[1]); kk.w = pk2(fa1[2], fa1[3]);
        vv.x = pk2(fc0[0], fc0[1]); vv.y = pk2(fc0[2], fc0[3]); vv.z = pk2(fc1[0], fc1[1]); vv.w = pk2(fc1[2], fc1[3]);
        *(u32x4*)(kb_ + krow_s * KS + kc_s * 16) = kk;
#pragma unroll
        for (int e = 0; e < 4; ++e) { *(bf16_t*)(vb_ + (kc_s * 8 + 2 * e) * VS + krow_s * 2) = (bf16_t)(vv[e] & 0xffff); *(bf16_t*)(vb_ + (kc_s * 8 + 2 * e + 1) * VS + krow_s * 2) = (bf16_t)(vv[e] >> 16); }
    };
    load_bf(ntiles - 1); store_bf(0);
    __syncthreads();
    for (int it = 0; it < ntiles; ++it) {
        const int kt = ntiles - 1 - it, cur = it & 1;
        if (it + 1 < ntiles) { if (F32P) load_f32(kt - 1); else load_bf(kt - 1); }
        if (wactive && !wdone && kt * 64 < wmax) {
            const char* kb_ = lds + cur * BUF; const char* vb_ = kb_ + KBYTES;
            f32x16 S0, S1;
#pragma unroll
            for (int i = 0; i < 16; ++i) { S0[i] = 0.f; S1[i] = 0.f; }
#pragma unroll
            for (int s = 0; s < NS; ++s) {
                const bf16x8 k0 = *(const bf16x8*)(kb_ + ql * KS + (16 * s + 8 * hh) * 2);
                const bf16x8 k1 = *(const bf16x8*)(kb_ + (32 + ql) * KS + (16 * s + 8 * hh) * 2);
                S0 = MFMA32(k0, qf[s], S0); S1 = MFMA32(k1, qf[s], S1);
            }
            const bool need_mask = (kt * 64 + 64 > wmin);
            const int kbase = kt * 64 + 4 * hh;
            if (MODE == 0) {
                if (need_mask) {
#pragma unroll
                    for (int i = 0; i < 16; ++i) { const int key = kbase + (i & 3) + 8 * (i >> 2);
                        if (key >= klim) S0[i] = -INFINITY; if (key + 32 >= klim) S1[i] = -INFINITY; }
                }
                float mx = S0[0];
#pragma unroll
                for (int i = 1; i < 16; ++i) mx = fmaxf(mx, S0[i]);
#pragma unroll
                for (int i = 0; i < 16; ++i) mx = fmaxf(mx, S1[i]);
                mx = fmaxf(mx, __shfl_xor(mx, 32));
                const float mnew = fmaxf(mrun, mx);
                const float alpha = __builtin_amdgcn_exp2f(mrun - mnew);
                mrun = mnew;
                float ps = 0.f;
#pragma unroll
                for (int i = 0; i < 16; ++i) { S0[i] = __builtin_amdgcn_exp2f(S0[i] - mnew); S1[i] = __builtin_amdgcn_exp2f(S1[i] - mnew); ps += S0[i] + S1[i]; }
                lrun = lrun * alpha + ps;
#pragma unroll
                for (int i = 0; i < 16; ++i) { O0[i] *= alpha; O1[i] *= alpha; }
            } else {
                float gs[2][4], gp[2][4];
                f32x16 SP0, SP1;
#pragma unroll
                for (int i = 0; i < 16; ++i) { const int key = kbase + (i & 3) + 8 * (i >> 2);
                    { const float z = S0[i]; const float t = __builtin_amdgcn_exp2f(-fabsf(z) * LOG2E); float sp = fmaxf(z, 0.f) + LN2 * __builtin_amdgcn_logf(1.0f + t);
                      if (need_mask && key >= klim) sp = 0.f; SP0[i] = sp; }
                    { const float z = S1[i]; const float t = __builtin_amdgcn_exp2f(-fabsf(z) * LOG2E); float sp = fmaxf(z, 0.f) + LN2 * __builtin_amdgcn_logf(1.0f + t);
                      if (need_mask && key + 32 >= klim) sp = 0.f; SP1[i] = sp; } }
#pragma unroll
                for (int g = 0; g < 4; ++g) { gs[0][g] = (SP0[4 * g] + SP0[4 * g + 1]) + (SP0[4 * g + 2] + SP0[4 * g + 3]);
                    gs[1][g] = (SP1[4 * g] + SP1[4 * g + 1]) + (SP1[4 * g + 2] + SP1[4 * g + 3]); }
#pragma unroll
                for (int g = 0; g < 4; ++g) { gp[0][g] = __shfl_xor(gs[0][g], 32); gp[1][g] = __shfl_xor(gs[1][g], 32); }
                float running = carry;
#pragma unroll
                for (int blk = 1; blk >= 0; --blk)
#pragma unroll
                    for (int g = 3; g >= 0; --g) {
                        const float sum1 = hh ? gs[blk][g] : gp[blk][g], sum0 = hh ? gp[blk][g] : gs[blk][g];
                        const float mybase = hh ? running : running + sum1;
                        running += sum0 + sum1;
                        float later = mybase;
#pragma unroll
                        for (int j = 3; j >= 0; --j) { const int i = 4 * g + j; const int key = kbase + j + 8 * g + 32 * blk;
                            const float z = blk ? S1[i] : S0[i], sp = blk ? SP1[i] : SP0[i];
                            float a = __builtin_amdgcn_exp2f((z - sp - later) * LOG2E);
                            if (need_mask && key >= klim) a = 0.f;
                            later += sp;
                            if (blk) S1[i] = a; else S0[i] = a; }
                    }
                carry = running;
                wdone = __all((carry > 104.0f) || (klim <= 0));
            }
            bf16x8 pf[2][2];
#pragma unroll
            for (int s = 0; s < 2; ++s) {
                u32x4 a, c;
                a.x = pk2(S0[8 * s], S0[8 * s + 1]); a.y = pk2(S0[8 * s + 2], S0[8 * s + 3]); a.z = pk2(S0[8 * s + 4], S0[8 * s + 5]); a.w = pk2(S0[8 * s + 6], S0[8 * s + 7]);
                c.x = pk2(S1[8 * s], S1[8 * s + 1]); c.y = pk2(S1[8 * s + 2], S1[8 * s + 3]); c.z = pk2(S1[8 * s + 4], S1[8 * s + 5]); c.w = pk2(S1[8 * s + 6], S1[8 * s + 7]);
                pf[0][s] = __builtin_bit_cast(bf16x8, a); pf[1][s] = __builtin_bit_cast(bf16x8, c);
            }
#pragma unroll
            for (int blk = 0; blk < 2; ++blk)
#pragma unroll
                for (int s = 0; s < 2; ++s) {
                    const int koff = (32 * blk + 16 * s + 4 * hh) * 2;
                    const s16x4 lo0 = *(const s16x4*)(vb_ + ql * VS + koff), hi0 = *(const s16x4*)(vb_ + ql * VS + koff + 16);
                    const s16x4 lo1 = *(const s16x4*)(vb_ + (32 + ql) * VS + koff), hi1 = *(const s16x4*)(vb_ + (32 + ql) * VS + koff + 16);
                    const bf16x8 v0 = __builtin_shufflevector(lo0, hi0, 0, 1, 2, 3, 4, 5, 6, 7), v1 = __builtin_shufflevector(lo1, hi1, 0, 1, 2, 3, 4, 5, 6, 7);
                    O0 = MFMA32(v0, pf[blk][s], O0); O1 = MFMA32(v1, pf[blk][s], O1);
                }
        }
        if (it + 1 < ntiles) { if (F32P) store_f32(cur ^ 1); else store_bf(cur ^ 1); }
        if (MODE == 1 && lane == 0) flags[(it & 1) * 8 + w] = wdone ? 1 : 0;
        __syncthreads();
        if (MODE == 1) { int alld = 1;
#pragma unroll
            for (int ww = 0; ww < 8; ++ww) alld &= flags[(it & 1) * 8 + ww];
            if (alld) break; }
    }
    if (wactive) {
        float inv = 1.0f;
        if (MODE == 0) { const float lt = lrun + __shfl_xor(lrun, 32); inv = 1.0f / lt; }
        bf16_t* op = P->o + (long)(qrow0 + w * 32 + ql) * 1024 + (MODE == 0 ? 0 : 512) + h * 64 + 4 * hh;
#pragma unroll
        for (int g = 0; g < 4; ++g) {
            f32x4 a = {O0[4 * g] * inv, O0[4 * g + 1] * inv, O0[4 * g + 2] * inv, O0[4 * g + 3] * inv};
            f32x4 c = {O1[4 * g] * inv, O1[4 * g + 1] * inv, O1[4 * g + 2] * inv, O1[4 * g + 3] * inv};
            store_bf4(op + 8 * g, a); store_bf4(op + 32 + 8 * g, c);
        }
    }
}

DI void attn_mla128(KP P, char* lds, bool sample, int b, int h, int ublk) {
    constexpr int KS = 208, VS = 272, KBYTES = 128 * KS, BUF = KBYTES + 64 * VS;
    const int tid = otid(), w = tid >> 6, lane = tid & 63, ql = lane & 31, hh = lane >> 5;
    const int kvrow0 = sample ? MP + b * SKEYS : b * TP;
    const int qrow0 = sample ? MP + b * 32 : b * TP + ublk * 256;
    const int ntiles = sample ? 33 : 2 * (ublk + 1);
    const int t0 = sample ? 0 : ublk * 256 + w * 32;
    const int wmax = sample ? SKEYS : ((((t0 + 31) >> 6) + 1) << 6);
    const bool wactive = sample ? (w == 0) : true;
    const bf16_t* Kp = P->kva + (long)kvrow0 * 512 + h * 64; const bf16_t* Qp = P->q + (long)qrow0 * 768 + h * 96;
    const bf16_t* VT = sample ? P->vaT_s + (long)(b * 512 + h * 64) * SKP : P->vaT_p + (long)(b * 512 + h * 64) * TP;
    const long ldv = sample ? SKP : TP;
    const bf16_t* Kr = P->krope + (long)kvrow0 * 32;
    bf16x8 qf[6];
    if (wactive) { const bf16_t* qp = Qp + (long)(w * 32 + ql) * 768 + 8 * hh;
#pragma unroll
        for (int s = 0; s < 6; ++s) qf[s] = *(const bf16x8*)(qp + 16 * s); }
    else {
#pragma unroll
        for (int s = 0; s < 6; ++s) qf[s] = (bf16x8){0, 0, 0, 0, 0, 0, 0, 0}; }
    f32x16 O0, O1;
#pragma unroll
    for (int i = 0; i < 16; ++i) { O0[i] = 0.f; O1[i] = 0.f; }
    float mrun = -INFINITY, lrun = 0.f;
    u32x4 rk[2], rr, rv[2];
    auto load_tile = [&](int kt) {
#pragma unroll
        for (int i = 0; i < 2; ++i) { const int c = tid + i * 512;
            rk[i] = *(const u32x4*)(Kp + (long)(kt * 128 + (c >> 3)) * 512 + (c & 7) * 8);
            rv[i] = *(const u32x4*)(VT + (long)(c >> 4) * ldv + kt * 128 + (c & 15) * 8); }
        rr = *(const u32x4*)(Kr + (long)(kt * 128 + (tid >> 2)) * 32 + (tid & 3) * 8);
    };
    auto store_tile = [&](int buf) {
        char* kb_ = lds + buf * BUF; char* vb_ = kb_ + KBYTES;
#pragma unroll
        for (int i = 0; i < 2; ++i) { const int c = tid + i * 512;
            *(u32x4*)(kb_ + (c >> 3) * KS + (c & 7) * 16) = rk[i];
            *(u32x4*)(vb_ + (c >> 4) * VS + (c & 15) * 16) = rv[i]; }
        *(u32x4*)(kb_ + (tid >> 2) * KS + 128 + (tid & 3) * 16) = rr;
    };
    load_tile(ntiles - 1); store_tile(0);
    __syncthreads();
    for (int it = 0; it < ntiles; ++it) {
        const int kt = ntiles - 1 - it, cur = it & 1;
        if (it + 1 < ntiles) load_tile(kt - 1);
        if (wactive && kt * 128 < wmax) {
            const char* kb_ = lds + cur * BUF; const char* vb_ = kb_ + KBYTES;
            const int nblk = (wmax - kt * 128) >> 5;
            f32x16 S[4];
#pragma unroll
            for (int blk = 0; blk < 4; ++blk) {
#pragma unroll
                for (int i = 0; i < 16; ++i) S[blk][i] = 0.f;
#pragma unroll
                for (int s = 0; s < 6; ++s) { const bf16x8 kf = *(const bf16x8*)(kb_ + (32 * blk + ql) * KS + (16 * s + 8 * hh) * 2); S[blk] = MFMA32(kf, qf[s], S[blk]); }
            }
            if (nblk < 4) {
#pragma unroll
                for (int blk = 1; blk < 4; ++blk) if (blk >= nblk) {
#pragma unroll
                    for (int i = 0; i < 16; ++i) S[blk][i] = -INFINITY; }
            }
            float mx = S[0][0];
#pragma unroll
            for (int blk = 0; blk < 4; ++blk)
#pragma unroll
                for (int i = 0; i < 16; ++i) mx = fmaxf(mx, S[blk][i]);
            mx = fmaxf(mx, __shfl_xor(mx, 32));
            const float mnew = fmaxf(mrun, mx);
            const float alpha = __builtin_amdgcn_exp2f(mrun - mnew);
            mrun = mnew;
            float ps = 0.f;
#pragma unroll
            for (int blk = 0; blk < 4; ++blk)
#pragma unroll
                for (int i = 0; i < 16; ++i) { S[blk][i] = __builtin_amdgcn_exp2f(S[blk][i] - mnew); ps += S[blk][i]; }
            lrun = lrun * alpha + ps;
#pragma unroll
            for (int i = 0; i < 16; ++i) { O0[i] *= alpha; O1[i] *= alpha; }
#pragma unroll
            for (int blk = 0; blk < 4; ++blk)
#pragma unroll
                for (int s = 0; s < 2; ++s) {
                    u32x4 a;
                    a.x = pk2(S[blk][8 * s], S[blk][8 * s + 1]); a.y = pk2(S[blk][8 * s + 2], S[blk][8 * s + 3]); a.z = pk2(S[blk][8 * s + 4], S[blk][8 * s + 5]); a.w = pk2(S[blk][8 * s + 6], S[blk][8 * s + 7]);
                    const bf16x8 pf = __builtin_bit_cast(bf16x8, a);
                    const int koff = (32 * blk + 16 * s + 4 * hh) * 2;
                    const s16x4 lo0 = *(const s16x4*)(vb_ + ql * VS + koff), hi0 = *(const s16x4*)(vb_ + ql * VS + koff + 16);
                    const s16x4 lo1 = *(const s16x4*)(vb_ + (32 + ql) * VS + koff), hi1 = *(const s16x4*)(vb_ + (32 + ql) * VS + koff + 16);
                    const bf16x8 v0 = __builtin_shufflevector(lo0, hi0, 0, 1, 2, 3, 4, 5, 6, 7), v1 = __builtin_shufflevector(lo1, hi1, 0, 1, 2, 3, 4, 5, 6, 7);
                    O0 = MFMA32(v0, pf, O0); O1 = MFMA32(v1, pf, O1);
                }
        }
        if (it + 1 < ntiles) store_tile(cur ^ 1);
        __syncthreads();
    }
    if (wactive) {
        const float lt = lrun + __shfl_xor(lrun, 32); const float inv = 1.0f / lt;
        bf16_t* op = P->o + (long)(qrow0 + w * 32 + ql) * 1024 + h * 64 + 4 * hh;
#pragma unroll
        for (int g = 0; g < 4; ++g) {
            f32x4 a = {O0[4 * g] * inv, O0[4 * g + 1] * inv, O0[4 * g + 2] * inv, O0[4 * g + 3] * inv};
            f32x4 c = {O1[4 * g] * inv, O1[4 * g + 1] * inv, O1[4 * g + 2] * inv, O1[4 * g + 3] * inv};
            store_bf4(op + 8 * g, a); store_bf4(op + 32 + 8 * g, c);
        }
    }
}

DI void attn_phase(KP P, char* lds, int cidx) {
    unsigned* slot = (unsigned*)(lds + 131072 + 3072);
    for (;;) {
        if (threadIdx.x == 0) *slot = atomicAdd(P->ctr + cidx, 1u);
        __syncthreads();
        const unsigned idx = *slot;
        __syncthreads();
        if (idx >= 1152u) break;
        bool sample; int mode, b, h, ublk = 0;
        if (idx < 128u) { sample = true; mode = idx >> 6; b = (idx >> 3) & 7; h = idx & 7; }
        else { const int j = idx - 128; sample = false; ublk = 31 - (j >> 5); const int r = j & 31; mode = r >> 4; b = (r >> 3) & 1; h = r & 7; }
        if (mode == 0) attn_mla128(P, lds, sample, b, h, ublk); else if (sample) attn_unit<1, true>(P, lds, true, b, h, ublk); else attn_unit<1, false>(P, lds, false, b, h, ublk);
    }
}

DI void tconv_tiles(KP P, char* lds, int it0, int itstep, int it_end) {
    const int tid = otid();
    float* tile = (float*)lds;
        for (int it = it0; it < it_end; it += itstep) {
            int j = 0;
#pragma unroll
            for (int q = 1; q < 16; ++q) if (it >= P->tj[q].tile0) j = q;
            TJob J; J.src = P->tj[j].src; J.kscale = P->tj[j].kscale; J.dst = P->tj[j].dst; J.lds = P->tj[j].lds; J.coff = P->tj[j].coff; J.ldd = P->tj[j].ldd;
            J.Klen = P->tj[j].Klen; J.Nlen = P->tj[j].Nlen; J.zero = P->tj[j].zero; J.tile0 = P->tj[j].tile0;
            const int lt = it - J.tile0, nk = J.Klen >> 6, tk = lt % nk, tn = lt / nk, k0 = tk * 64, n0 = tn * 256;
            f32x4 lv[8];
#pragma unroll
            for (int r = 0; r < 8; ++r) { const int e = tid + r * NTHREADS, kk = e >> 6, n4 = (e & 63) * 4;
                lv[r] = (f32x4){0.f, 0.f, 0.f, 0.f};
                if (J.zero == 2) { const int nn_ = n0 + n4, sc_ = (nn_ >> 8) * 128 + (nn_ & 127) + ((nn_ >> 7) & 1) * DFF;
                    lv[r] = *(const f32x4*)(J.src + (long)(k0 + kk) * J.lds + sc_); }
                else if (!J.zero && n0 + n4 < J.Nlen) lv[r] = *(const f32x4*)(J.src + (long)(k0 + kk) * J.lds + J.coff + n0 + n4); }
#pragma unroll
            for (int r = 0; r < 8; ++r) { const int e = tid + r * NTHREADS, kk = e >> 6, n4 = (e & 63) * 4;
                f32x4 v = lv[r]; if (J.kscale) v *= J.kscale[k0 + kk];
                float* tp = tile + kk * 257 + n4; tp[0] = v[0]; tp[1] = v[1]; tp[2] = v[2]; tp[3] = v[3]; }
            __syncthreads();
#pragma unroll
            for (int r = 0; r < 4; ++r) { const int e = tid + r * NTHREADS, nn = e >> 3, kc = (e & 7) * 8;
                if (n0 + nn < J.Nlen) { const float* tp = tile + kc * 257 + nn; u32x4 o;
                    o.x = pk2(tp[0], tp[257]); o.y = pk2(tp[2 * 257], tp[3 * 257]); o.z = pk2(tp[4 * 257], tp[5 * 257]); o.w = pk2(tp[6 * 257], tp[7 * 257]);
                    *(u32x4*)(J.dst + (long)(n0 + nn) * J.ldd + k0 + kc) = o; } }
            __syncthreads();
        }
}

DI void phase0(KP P, char* lds) {
    const int tid = otid(), G = ogrid(), bid = obid(), w = tid >> 6, lane = tid & 63;
    for (int item = bid; item < 96; item += G) {
        float* sc = (float*)lds; float* red = (float*)(lds + 40960);
        for (int i = tid; i < 10240; i += NTHREADS) { const int bb = i >> 10, k = i & 1023; const float cv = bb < 2 ? P->c_p[bb * 1024 + k] : P->c_s[(bb - 2) * 1024 + k]; sc[i] = cv / (1.0f + __expf(-cv)); }
        __syncthreads();
        const int col = item * 64 + lane;
        float a0 = 0, a1 = 0, a2 = 0, a3 = 0, a4 = 0, a5 = 0, a6 = 0, a7 = 0, a8 = 0, a9 = 0;
        for (int k0 = w * 128; k0 < w * 128 + 128; k0 += 16) {
            float wv[16];
#pragma unroll
            for (int j = 0; j < 16; ++j) wv[j] = P->w_ada[(long)(k0 + j) * 6144 + col];
#pragma unroll
            for (int j = 0; j < 16; ++j) { const int k = k0 + j;
                a0 += sc[k] * wv[j]; a1 += sc[1024 + k] * wv[j]; a2 += sc[2048 + k] * wv[j]; a3 += sc[3072 + k] * wv[j]; a4 += sc[4096 + k] * wv[j];
                a5 += sc[5120 + k] * wv[j]; a6 += sc[6144 + k] * wv[j]; a7 += sc[7168 + k] * wv[j]; a8 += sc[8192 + k] * wv[j]; a9 += sc[9216 + k] * wv[j]; }
        }
        float* rr = red + w * 640 + lane;
        rr[0] = a0; rr[64] = a1; rr[128] = a2; rr[192] = a3; rr[256] = a4; rr[320] = a5; rr[384] = a6; rr[448] = a7; rr[512] = a8; rr[576] = a9;
        __syncthreads();
        for (int i = tid; i < 640; i += NTHREADS) { float s = 0.f; for (int ww = 0; ww < 8; ++ww) s += red[ww * 640 + i];
            const int bb = i >> 6, l = i & 63; P->ada[bb * 6144 + item * 64 + l] = s + P->b_ada[item * 64 + l]; }
        __syncthreads();
    }
    tconv_tiles(P, lds, (bid + 96) % G, G, P->ntj_early);
    const long gt = (long)bid * NTHREADS + tid, gn = (long)G * NTHREADS;
    for (long i0 = gt; i0 < 8L * PAST * 64; i0 += 4 * gn) { f32x4 v[4];
#pragma unroll
        for (int r = 0; r < 4; ++r) { const long i = i0 + r * gn; if (i < 8L * PAST * 64) v[r] = *(const f32x4*)(P->c_ckv + i * 4); }
#pragma unroll
        for (int r = 0; r < 4; ++r) { const long i = i0 + r * gn; if (i < 8L * PAST * 64) { const long row = i >> 6; const int c = (int)(i & 63) * 4; const int bb = (int)(row >> 12), sq = (int)(row & 4095);
            store_bf4(P->latent + (long)(MP + bb * SKEYS + sq) * 256 + c, v[r]); } } }
    for (long i0 = gt; i0 < 8L * PAST * 8; i0 += 4 * gn) { f32x4 v[4];
#pragma unroll
        for (int r = 0; r < 4; ++r) { const long i = i0 + r * gn; if (i < 8L * PAST * 8) v[r] = *(const f32x4*)(P->c_kr + i * 4); }
#pragma unroll
        for (int r = 0; r < 4; ++r) { const long i = i0 + r * gn; if (i < 8L * PAST * 8) { const long row = i >> 3; const int c = (int)(i & 7) * 4; const int bb = (int)(row >> 12), sq = (int)(row & 4095);
            store_bf4(P->krope + (long)(MP + bb * SKEYS + sq) * 32 + c, v[r]); } } }
    for (long i = gt; i < 8L * 512 * 8; i += gn) { const long r = i >> 3; const int c = (int)(i & 7) * 4; const u32x2 z = {0u, 0u};
        *(u32x2*)(P->vaT_s + r * SKP + SKEYS + c) = z; *(u32x2*)(P->vbT_s + r * SKP + SKEYS + c) = z; }
    for (long i = gt; i < (long)TP * 16; i += gn) { const int pos = (int)(i >> 4), fi = (int)(i & 15);
        const float inv = exp2f(-(float)fi * (13.287712379549449f / 16.0f));
        const float ang = (float)pos * inv;
        const double rev = (double)ang * 0.15915494309189535; const float fr_ = (float)(rev - floor(rev));
        P->ropeT[i * 2] = __builtin_amdgcn_cosf(fr_); P->ropeT[i * 2 + 1] = __builtin_amdgcn_sinf(fr_); }
}

DI void phase_h(KP P) {
    const int tid_ = otid(), lane = tid_ & 63, gw = obid() * 8 + (tid_ >> 6), nw = ogrid() * 8;
    for (int row = gw; row < MT; row += nw) {
        const float* xr = row < MP ? P->x_p + (long)row * DM : P->x_s + (long)(row - MP) * DM;
        const float* ad = P->ada + ada_b(row) * 6144;
        f32x4 v[4]; float s = 0.f;
#pragma unroll
        for (int i = 0; i < 4; ++i) { v[i] = *(const f32x4*)(xr + i * 256 + lane * 4); s += v[i][0] * v[i][0] + v[i][1] * v[i][1] + v[i][2] * v[i][2] + v[i][3] * v[i][3]; }
#pragma unroll
        for (int o = 1; o < 64; o <<= 1) s += __shfl_xor(s, o);
        const float rstd = rsqrtf(s * (1.0f / DM) + EPS);
#pragma unroll
        for (int i = 0; i < 4; ++i) { const int c = i * 256 + lane * 4;
            const f32x4 g = *(const f32x4*)(P->g_pre_mix + c), sh = *(const f32x4*)(ad + c), scl = *(const f32x4*)(ad + 1024 + c);
            store_bf4(P->h + (long)row * DM + c, v[i] * rstd * g * (1.0f + scl) + sh); }
    }
}

DI void phase_mid(KP P) {
    const int tid_ = otid(), lane = tid_ & 63, gw = obid() * 8 + (tid_ >> 6), nw = ogrid() * 8;
    for (int row = gw; row < MT; row += nw) {
        const float* xr = row < MP ? P->x_p + (long)row * DM : P->x_s + (long)(row - MP) * DM;
        const float* ad = P->ada + ada_b(row) * 6144;
        f32x4 mv[4]; float s = 0.f;
#pragma unroll
        for (int i = 0; i < 4; ++i) { const u32x2 wv = *(const u32x2*)(P->m2 + (long)row * DM + i * 256 + lane * 4);
            mv[i] = (f32x4){bf_lo(wv.x), bf_hi(wv.x), bf_lo(wv.y), bf_hi(wv.y)}; s += mv[i][0] * mv[i][0] + mv[i][1] * mv[i][1] + mv[i][2] * mv[i][2] + mv[i][3] * mv[i][3]; }
#pragma unroll
        for (int o = 1; o < 64; o <<= 1) s += __shfl_xor(s, o);
        const float rstd = rsqrtf(s * (1.0f / DM) + EPS);
        float s2 = 0.f;
#pragma unroll
        for (int i = 0; i < 4; ++i) { const int c = i * 256 + lane * 4;
            const f32x4 xv = *(const f32x4*)(xr + c), g = *(const f32x4*)(P->g_post_mix + c), gt = *(const f32x4*)(ad + 2048 + c);
            mv[i] = xv + gt * (mv[i] * rstd * g);
            *(f32x4*)(P->out + O_Y + (long)row * DM + c) = mv[i];
            s2 += mv[i][0] * mv[i][0] + mv[i][1] * mv[i][1] + mv[i][2] * mv[i][2] + mv[i][3] * mv[i][3]; }
#pragma unroll
        for (int o = 1; o < 64; o <<= 1) s2 += __shfl_xor(s2, o);
        const float rstd2 = rsqrtf(s2 * (1.0f / DM) + EPS);
#pragma unroll
        for (int i = 0; i < 4; ++i) { const int c = i * 256 + lane * 4;
            const f32x4 g = *(const f32x4*)(P->g_pre_ffn + c), sh = *(const f32x4*)(ad + 3072 + c), scl = *(const f32x4*)(ad + 4096 + c);
            store_bf4(P->h2 + (long)row * DM + c, mv[i] * rstd2 * g * (1.0f + scl) + sh); }
    }
}

DI void phase_final(KP P) {
    const int tid_ = otid(), lane = tid_ & 63, gw = obid() * 8 + (tid_ >> 6), nw = ogrid() * 8;
    for (int row = gw; row < MT; row += nw) {
        const float* ad = P->ada + ada_b(row) * 6144;
        f32x4 fv[4]; float s = 0.f;
#pragma unroll
        for (int i = 0; i < 4; ++i) { const u32x2 wv = *(const u32x2*)(P->f + (long)row * DM + i * 256 + lane * 4);
            fv[i] = (f32x4){bf_lo(wv.x), bf_hi(wv.x), bf_lo(wv.y), bf_hi(wv.y)}; s += fv[i][0] * fv[i][0] + fv[i][1] * fv[i][1] + fv[i][2] * fv[i][2] + fv[i][3] * fv[i][3]; }
#pragma unroll
        for (int o = 1; o < 64; o <<= 1) s += __shfl_xor(s, o);
        const float rstd = rsqrtf(s * (1.0f / DM) + EPS);
#pragma unroll
        for (int i = 0; i < 4; ++i) { const int c = i * 256 + lane * 4; float* yp = P->out + O_Y + (long)row * DM + c;
            const f32x4 xv = *(const f32x4*)yp, g = *(const f32x4*)(P->g_post_ffn + c), gt = *(const f32x4*)(ad + 5120 + c);
            *(f32x4*)yp = xv + gt * (fv[i] * rstd * g); }
    }
}


DI void load8(const bf16_t* p, float (&o)[8]) { const u32x4 w = *(const u32x4*)p;
#pragma unroll
    for (int e = 0; e < 4; ++e) { o[2 * e] = bf_lo(w[e]); o[2 * e + 1] = bf_hi(w[e]); } }
DI void phase_convfix(KP P) {
    const long gt = (long)obid() * NTHREADS + otid(), gn = (long)ogrid() * NTHREADS;
    for (long i = gt; i < 768L * 352; i += gn) {
        const int ri = (int)(i / 352), c = (int)(i % 352) * 8;
        float u0[2][8], u1[2][8], u2[2][8];
        long grow;
        if (ri < 512) {
            const int B = ri >> 1, rsel = ri & 1; const bool first = ((B * 64) & (TP - 1)) == 0; grow = (long)B * 64 + rsel;
            const bf16_t* cur = P->ub + (long)(B * 4) * DFF2 + c; const bf16_t* prv = P->ub + (long)((B > 0 ? B - 1 : 0) * 4) * DFF2 + c;
#pragma unroll
            for (int hf = 0; hf < 2; ++hf) {
                load8(cur + (long)(2 + rsel) * DFF2 + hf * DFF, u2[hf]);
                if (rsel == 0) { if (first) { for (int e = 0; e < 8; ++e) { u1[hf][e] = 0.f; u0[hf][e] = 0.f; } } else { load8(prv + (long)1 * DFF2 + hf * DFF, u1[hf]); load8(prv + hf * DFF, u0[hf]); } }
                else { load8(cur + (long)2 * DFF2 + hf * DFF, u1[hf]); if (first) { for (int e = 0; e < 8; ++e) u0[hf][e] = 0.f; } else load8(prv + (long)1 * DFF2 + hf * DFF, u0[hf]); }
            }
        } else {
            const int r = ri - 512, t = r & 31, bs = r >> 5; grow = (long)MP + r;
            const float* st = P->c_conv + (long)bs * 2 * DFF2 + c;
#pragma unroll
            for (int hf = 0; hf < 2; ++hf) {
                load8(P->u + (long)r * DFF2 + hf * DFF + c, u2[hf]);
                if (t >= 1) load8(P->u + (long)(r - 1) * DFF2 + hf * DFF + c, u1[hf]); else { for (int e = 0; e < 8; ++e) u1[hf][e] = st[DFF2 + hf * DFF + e]; }
                if (t >= 2) load8(P->u + (long)(r - 2) * DFF2 + hf * DFF + c, u0[hf]); else { for (int e = 0; e < 8; ++e) u0[hf][e] = st[(long)t * DFF2 + hf * DFF + e]; }
            }
        }
        float y[2][8];
#pragma unroll
        for (int hf = 0; hf < 2; ++hf)
#pragma unroll
            for (int e = 0; e < 8; ++e) { const int cc = hf * DFF + c + e;
                y[hf][e] = P->conv_b[cc] + P->conv_w[cc] * u0[hf][e] + P->conv_w[DFF2 + cc] * u1[hf][e] + P->conv_w[2 * DFF2 + cc] * u2[hf][e]; }
        u32x4 ov;
#pragma unroll
        for (int e = 0; e < 4; ++e) ov[e] = pk2(gelu_tanh(y[0][2 * e]) * y[1][2 * e], gelu_tanh(y[0][2 * e + 1]) * y[1][2 * e + 1]);
        *(u32x4*)(P->g + grow * DFF + c) = ov;
    }
}

#define XB_TMO      128
#define XB_XCNT(j)  (256  + 64 * (j))
#define XB_XSUB(j)  (1280 + 64 * (j))
#define XB_XGEN(j)  (2304 + 64 * (j))
#define XB_TOP      3328
#define XB_TOPGEN   3392
#define XCD_BAR_WORDS 3456
#define XB_SPIN_CAP (1u << 18)
DI unsigned xb_ld(unsigned* p)              { return __hip_atomic_load(p, __ATOMIC_RELAXED, __HIP_MEMORY_SCOPE_AGENT); }
DI unsigned xb_add(unsigned* p, unsigned v) { return __hip_atomic_fetch_add(p, v, __ATOMIC_RELAXED, __HIP_MEMORY_SCOPE_AGENT); }
DI unsigned xb_xcc_id() { return (unsigned)__builtin_amdgcn_s_getreg((3 << 11) | 20) & 0xFu; }
#define XB_SPIN(cond, bar) do { unsigned _sp = 0; while (cond) { __builtin_amdgcn_s_sleep(1); \
    if ((++_sp & 255u) == 0u) { if (xb_ld(&(bar)[XB_TMO])) break; if (_sp > XB_SPIN_CAP) { atomicAdd(&(bar)[XB_TMO], 1u); break; } } } } while (0)
DI void xcd_barrier_complete(unsigned* bar, unsigned x, unsigned& nloc, unsigned& nx) {
    const unsigned G = gridDim.x;
    unsigned sum, cnt, mine, sp = 0u;
    for (;;) {
        sum = 0u; cnt = 0u; mine = 0u;
#pragma unroll
        for (unsigned j = 0; j < 16; ++j) { const unsigned c = xb_ld(&bar[XB_XCNT(j)]); sum += c; cnt += (c > 0u) ? 1u : 0u; mine = (j == x) ? c : mine; }
        if (sum == G) break;
        __builtin_amdgcn_s_sleep(1);
        if ((++sp & 255u) == 0u) { if (xb_ld(&bar[XB_TMO])) break; if (sp > XB_SPIN_CAP) { atomicAdd(&bar[XB_TMO], 1u); break; } }
    }
    nloc = mine > 0u ? mine : 1u; nx = cnt > 0u ? cnt : 1u;
}
DI void grid_barrier(char* lds) {
    asm volatile("s_waitcnt vmcnt(0)" ::: "memory");
    __syncthreads();
    if (threadIdx.x == 0) {
        unsigned* bar = kparams()->bar; const unsigned x = xb_xcc_id();
        volatile LAS unsigned* st = (volatile LAS unsigned*)(lds + 131072 + 2048);
        __builtin_amdgcn_s_waitcnt(0);
        unsigned nloc = st[0], nx = st[1];
        if (nloc == 0u) { xcd_barrier_complete(bar, x, nloc, nx); st[0] = nloc; st[1] = nx; }
        const unsigned old = xb_add(&bar[XB_XSUB(x)], 1u);
        const unsigned gen = old / nloc;
        if (old + 1u == (gen + 1u) * nloc) {
            __builtin_amdgcn_fence(__ATOMIC_RELEASE, "agent");
            asm volatile("s_waitcnt vmcnt(0)" ::: "memory");
            const unsigned og = xb_add(&bar[XB_TOP], 1u);
            const unsigned tg = og / nx;
            if (og + 1u == (tg + 1u) * nx) xb_add(&bar[XB_TOPGEN], 1u);
            else XB_SPIN(xb_ld(&bar[XB_TOPGEN]) == tg, bar);
            __builtin_amdgcn_fence(__ATOMIC_ACQUIRE, "agent");
            xb_add(&bar[XB_XGEN(x)], 1u);
            asm volatile("s_waitcnt vmcnt(0)" ::: "memory");
        } else {
            XB_SPIN(xb_ld(&bar[XB_XGEN(x)]) == gen, bar);
            __builtin_amdgcn_fence(__ATOMIC_ACQUIRE, "agent");
            asm volatile("s_waitcnt vmcnt(0)" ::: "memory");
        }
    }
    __syncthreads();
}

__global__ void __launch_bounds__(NTHREADS) fwd_megakernel(Params Pval) {
    extern __shared__ __attribute__((aligned(16))) char lds[];
    cg::grid_group grid = cg::this_grid();
    const int lo = kparams()->phase_lo, hi = kparams()->phase_hi;
#define PH(n) if (lo <= (n) && (n) < hi)
#define SYNC(n) if (lo <= (n) && (n) + 1 < hi) grid_barrier(lds)
    if (hi > 1000) grid.sync();
    { volatile LAS unsigned* st = (volatile LAS unsigned*)(lds + 131072 + 2048);
      if (threadIdx.x == 0) { st[0] = 0u; st[1] = 0u; }
      __syncthreads();
      if (threadIdx.x == 0) (void)xb_add(&kparams()->bar[XB_XCNT(xb_xcc_id())], 1u); }
    PH(0) phase0(kparams(), lds);
#ifdef PROBE_P0
    __syncthreads(); phase0(kparams(), lds);
#endif
#ifdef PROBE_SYNC
    for (int i = 0; i < 24; ++i) grid_barrier(lds);
#endif
    SYNC(0);
    PH(1) phase_h(kparams());
#ifdef PROBE_ROWS
    phase_h(kparams());
#endif
    SYNC(1);
    for (int ph = 2; ph <= 12; ++ph) {
        if (ph == 4) { PH(4) attn_phase(kparams(), lds, 0);
#ifdef PROBE_ATTN2
            __syncthreads(); attn_phase(kparams(), lds, 1);
#endif
            SYNC(4); continue; }
        if (ph == 8) { PH(8) phase_mid(kparams());
#ifdef PROBE_ROWS
            phase_mid(kparams());
#endif
            SYNC(8); continue; }
        if (ph == 10) { PH(10) phase_convfix(kparams());

            SYNC(10); continue; }
        if (ph == 12) { PH(12) phase_final(kparams()); continue; }
        if (lo <= ph && ph < hi) {
            const int npass = (ph == 3 || ph == 6) ? 2 : 1;
            for (int pass = 0; pass < npass; ++pass) {
                GemmDesc d; d.C = nullptr; d.ldc = 0; d.start = 0; KP P = kparams();
                switch (ph) {
                case 2: d.A = P->h; d.lda = DM; d.Bt = P->WinT; d.ldb = DM; d.K = DM; d.nM = 65; d.nN = 9; d.epi = E_INPROJ; break;
                case 3: if (pass == 0) { d.A = P->qlat; d.lda = 384; d.Bt = P->WuqT; d.ldb = 384; d.K = 384; d.nM = 65; d.nN = 3; d.epi = E_UQ; }
                        else { d.A = P->latent; d.lda = 256; d.Bt = P->WukvT; d.ldb = 256; d.K = 256; d.nM = 193; d.nN = 4; d.epi = E_UKV; d.start = 195; } break;
                case 5: d.A = P->h; d.lda = DM; d.Bt = P->WgT; d.ldb = DM; d.K = DM; d.nM = 64; d.nN = 8; d.epi = E_GATE; break;
                case 6: d.A = P->o + pass * 512; d.lda = DM; d.Bt = pass ? P->WpbT : P->WpaT; d.ldb = 512; d.K = 512; d.nM = 64; d.nN = 4; d.epi = pass ? E_PROJB : E_PROJA; break;
                case 7: d.A = P->merged; d.lda = DM; d.Bt = P->WoutT; d.ldb = DM; d.K = DM; d.nM = 64; d.nN = 4; d.epi = E_PLAIN; d.C = P->m2; d.ldc = DM; break;
                case 9: d.A = P->h2; d.lda = DM; d.Bt = P->WupT; d.ldb = DM; d.K = DM; d.nM = 65; d.nN = 22; d.epi = E_UP; break;
                default: d.A = P->g; d.lda = DFF; d.Bt = P->WdownT; d.ldb = DFF; d.K = DFF; d.nM = 64; d.nN = 4; d.epi = E_PLAIN; d.C = P->f; d.ldc = DM; break;
                }
                gemm_run(d, lds);
                if (ph == 2) {
                    const int G_ = ogrid(), b_ = obid(); int wi = b_, nW = G_;
                    if (G_ == 256) { const int l_ = b_ >> 3; wi = l_ >= 10 ? (l_ - 10) * 8 + (b_ & 7) : -1; nW = 176; }
                    if (wi >= 0) tconv_tiles(P, lds, P->ntj_early + wi, nW, P->ntj_tiles);
                }
#ifdef PROBE_GEMM2
                if (ph == PROBE_GEMM2 && !(ph == 6 && pass == 0)) { __syncthreads(); if (ph == 6) { GemmDesc d0 = d; d0.A = P->o; d0.Bt = P->WpaT; d0.epi = E_PROJA; gemm_run(d0, lds); } gemm_run(d, lds); }
#endif
            }
        }
        if (lo <= ph && ph < hi) {
            KP P = kparams();
            if (ph == 5) gemm_small<1, 8>(P, P->h, DM, P->WgT, DM, 2048, P->gates, 2048, lds);
            else if (ph == 6) gemm_small<2, 4>(P, P->o, DM, P->WpaT, 512, 1024, P->merged, DM, lds);
            else if (ph == 7) gemm_small<0, 8>(P, P->merged, DM, P->WoutT, DM, 1024, P->m2, DM, lds);
            else if (ph == 11) gemm_small<0, 22>(P, P->g, DFF, P->WdownT, DFF, 1024, P->f, DM, lds);
#ifdef PROBE_SMALL
            if (ph == 5) gemm_small<1, 8>(P, P->h, DM, P->WgT, DM, 2048, P->gates, 2048, lds);
            else if (ph == 6) gemm_small<2, 4>(P, P->o, DM, P->WpaT, 512, 1024, P->merged, DM, lds);
            else if (ph == 7) gemm_small<0, 8>(P, P->merged, DM, P->WoutT, DM, 1024, P->m2, DM, lds);
            else if (ph == 11) gemm_small<0, 22>(P, P->g, DFF, P->WdownT, DFF, 1024, P->f, DM, lds);
#endif
        }
        SYNC(ph);
    }
}

static size_t bump(size_t& off, size_t bytes) { size_t r = off; off += (bytes + 255) & ~(size_t)255; return r; }

extern "C" void kernel_launch(void* const* d_in, const int* in_sizes, int n_in, void* d_out, int out_size, void* d_ws, size_t ws_size, hipStream_t stream) {
    Params P; memset(&P, 0, sizeof(P));
    const float* const* in = (const float* const*)d_in;
    P.x_p = in[0]; P.x_s = in[1]; P.c_ckv = in[2]; P.c_kr = in[3]; P.c_sbk = in[4]; P.c_sbv = in[5]; P.c_conv = in[6]; P.c_p = in[7]; P.c_s = in[8];
    P.w_ada = in[9]; P.b_ada = in[10]; P.g_pre_mix = in[11]; P.g_post_mix = in[12]; P.g_pre_ffn = in[13]; P.g_post_ffn = in[14];
    const float* w_in = in[15]; const float* g_q = in[16]; const float* w_uq = in[17]; P.g_kv = in[18]; const float* w_uk = in[19]; const float* w_uv = in[20];
    const float* w_pa = in[21]; const float* w_pb = in[22]; const float* w_out = in[23]; const float* w_up = in[24]; P.conv_w = in[25]; P.conv_b = in[26]; const float* w_down = in[27];
    P.out = (float*)d_out;
    char* ws = (char*)d_ws; size_t off = 0;
    P.WupT = (bf16_t*)(ws + bump(off, (size_t)DFF2 * DM * 2));
    P.WdownT = (bf16_t*)(ws + bump(off, (size_t)DM * DFF * 2));
    P.ropeT = (float*)(ws + bump(off, (size_t)TP * 32 * 4));
    P.ada = (float*)(ws + bump(off, 10 * 6144 * 4));
    P.ctr = (unsigned*)(ws + bump(off, 256));
    P.bar = (unsigned*)(ws + bump(off, XCD_BAR_WORDS * 4));
    const size_t R0 = off;
    P.WinT = (bf16_t*)(ws + bump(off, (size_t)2304 * DM * 2));
    P.WgT = (bf16_t*)(ws + bump(off, (size_t)2048 * DM * 2));
    P.WuqT = (bf16_t*)(ws + bump(off, (size_t)768 * 384 * 2));
    P.WukvT = (bf16_t*)(ws + bump(off, (size_t)1024 * 256 * 2));
    P.WpaT = (bf16_t*)(ws + bump(off, (size_t)1024 * 512 * 2));
    P.WpbT = (bf16_t*)(ws + bump(off, (size_t)1024 * 512 * 2));
    P.WoutT = (bf16_t*)(ws + bump(off, (size_t)1024 * 1024 * 2));
    const size_t o_kva = off;
    P.kva = (bf16_t*)(ws + bump(off, (size_t)KVROWS_PAD * 512 * 2));
    P.vaT_p = (bf16_t*)(ws + bump(off, (size_t)2 * 512 * TP * 2));
    P.vaT_s = (bf16_t*)(ws + bump(off, (size_t)8 * 512 * SKP * 2));
    const size_t o_kb = off;
    P.kb = (bf16_t*)(ws + bump(off, (size_t)KVROWS_PAD * 512 * 2));
    const size_t o_vbT = off;
    P.vbT_p = (bf16_t*)(ws + bump(off, (size_t)2 * 512 * TP * 2));
    P.vbT_s = (bf16_t*)(ws + bump(off, (size_t)8 * 512 * SKP * 2));
    const size_t o_kr = off;
    P.krope = (bf16_t*)(ws + bump(off, (size_t)KVROWS_PAD * 32 * 2));
    P.qb = (bf16_t*)(ws + bump(off, (size_t)MT * 512 * 2));
    P.q = (bf16_t*)(ws + bump(off, (size_t)MT * 768 * 2));
    P.latent = (bf16_t*)(ws + bump(off, (size_t)KVROWS_PAD * 256 * 2));
    size_t need = off;
    P.gates = (bf16_t*)(ws + o_kva);
    P.merged = (bf16_t*)(ws + o_kb);
    P.m2 = (bf16_t*)(ws + o_vbT);
    const size_t o_g = R0 + (size_t)MT * DFF2 * 2;
    P.g = (bf16_t*)(ws + R0);
    P.f = (bf16_t*)(ws + R0 + (size_t)100 * 1024 * 1024);
    P.ub = (bf16_t*)(ws + R0 + (size_t)140 * 1024 * 1024);
    P.u = (bf16_t*)(ws + R0 + (size_t)155 * 1024 * 1024);
    size_t o_h2 = o_kr > o_g ? o_kr : o_g;
    P.h2 = (bf16_t*)(ws + o_h2);
    if (o_h2 + (size_t)MT * DM * 2 > need) need = o_h2 + (size_t)MT * DM * 2;
    P.h = (bf16_t*)d_out;
    P.o = (bf16_t*)d_out + (size_t)MT * DM;
    P.qlat = P.o;
    if (need > ws_size) { fprintf(stderr, "workspace too small: need %zu have %zu\n", need, ws_size); return; }

    int nj = 0, tiles = 0;
    auto job = [&](const float* src, int lds, int coff, bf16_t* dst, int ldd, int Klen, int Nlen, const float* ks, int zero) {
        TJob& J = P.tj[nj++]; J.src = src; J.kscale = ks; J.dst = dst; J.lds = lds; J.coff = coff; J.ldd = ldd; J.Klen = Klen; J.Nlen = Nlen; J.zero = zero; J.tile0 = tiles; J.pad = 0;
        tiles += (Klen / 64) * ((Nlen + 255) / 256); };
    job(w_in, 4256, 0, P.WinT, DM, DM, 384, nullptr, 0);
    job(w_in, 4256, 640, P.WinT + (size_t)384 * DM, DM, DM, 32, nullptr, 0);
    job(w_in, 4256, 0, P.WinT + (size_t)416 * DM, DM, DM, 96, nullptr, 1);
    job(w_in, 4256, 384, P.WinT + (size_t)512 * DM, DM, DM, 256, nullptr, 0);
    job(w_in, 4256, 672, P.WinT + (size_t)768 * DM, DM, DM, 1536, nullptr, 0);
    job(w_uq, 768, 0, P.WuqT, 384, 384, 768, g_q, 0);
    job(w_uk, 512, 0, P.WukvT, 256, 256, 512, nullptr, 0);
    job(w_uv, 512, 0, P.WukvT + (size_t)512 * 256, 256, 256, 512, nullptr, 0);
    P.ntj_early = tiles;
    job(w_in, 4256, 2208, P.WgT, DM, DM, 2048, nullptr, 0);
    job(w_pa, DM, 0, P.WpaT, 512, 512, DM, nullptr, 0);
    job(w_pb, DM, 0, P.WpbT, 512, 512, DM, nullptr, 0);
    job(w_out, DM, 0, P.WoutT, DM, DM, DM, nullptr, 0);
    job(w_up, DFF2, 0, P.WupT, DM, DM, DFF2, nullptr, 2);
    job(w_down, DM, 0, P.WdownT, DFF, DFF, DM, nullptr, 0);
    P.ntj_tiles = tiles; P.pad0 = nj;
    for (int q = nj; q < NTJ; ++q) P.tj[q].tile0 = 0x7fffffff;
    P.phase_lo = 0; P.phase_hi = 13;

    static int grid_blocks = 0;
    if (!grid_blocks) {
        (void)hipFuncSetAttribute((const void*)fwd_megakernel, hipFuncAttributeMaxDynamicSharedMemorySize, LDS_BYTES);
        int dev = 0, cus = 0, per_cu = 0;
        (void)hipGetDevice(&dev);
        (void)hipDeviceGetAttribute(&cus, hipDeviceAttributeMultiprocessorCount, dev);
        (void)hipOccupancyMaxActiveBlocksPerMultiprocessor(&per_cu, fwd_megakernel, NTHREADS, LDS_BYTES);
        if (per_cu > 1) per_cu = 1;
        grid_blocks = cus * per_cu;
    }
    (void)hipMemsetAsync(P.ctr, 0, 256 + XCD_BAR_WORDS * 4, stream);
    void* args[] = {&P};
    hipError_t e = hipLaunchCooperativeKernel((const void*)fwd_megakernel, dim3(grid_blocks), dim3(NTHREADS), args, LDS_BYTES, stream);
    if (e != hipSuccess) fprintf(stderr, "cooperative launch failed: %s (grid %d)\n", hipGetErrorString(e), grid_blocks);
}
```

```cpp
#include <hip/hip_runtime.h>
#include <hip/hip_cooperative_groups.h>
#include <stdint.h>
#include <stdio.h>
#include <string.h>
namespace cg = cooperative_groups;

typedef unsigned short bf16_t;
typedef short bf16x8 __attribute__((ext_vector_type(8)));
typedef short s16x4 __attribute__((ext_vector_type(4)));
typedef float f32x2 __attribute__((ext_vector_type(2)));
typedef float f32x4 __attribute__((ext_vector_type(4)));
typedef float f32x16 __attribute__((ext_vector_type(16)));
typedef unsigned u32x2 __attribute__((ext_vector_type(2)));
typedef unsigned u32x4 __attribute__((ext_vector_type(4)));
typedef __bf16 bf2_t __attribute__((ext_vector_type(2)));
#define DI __device__ __forceinline__

constexpr int DM = 1024, TP = 8192, MP = 16384, MS = 256, MT = 16640, PAST = 4096, SKEYS = 4128, SKP = 4160;
constexpr int KVROWS = MP + 8 * SKEYS;
constexpr int KVROWS_PAD = KVROWS + 64;
constexpr int DFF = 2816, DFF2 = 5632;
constexpr float EPS = 1e-6f;
constexpr float LOG2E = 1.4426950408889634f, LN2 = 0.6931471805599453f;
constexpr int NTHREADS = 512;
constexpr int LDS_BYTES = 131072 + 8192;
constexpr long O_Y = 0, O_CKV_P = 17039360, O_KR_P = 21233664, O_SBK_P = 21757952, O_SBV_P = 30146560, O_CONV_P = 38535168,
               O_CKV_S = 38557696, O_KR_S = 38623232, O_SBK_S = 38631424, O_SBV_S = 38762496, O_CONV_S = 38893568;

struct TJob { const float* src; const float* kscale; bf16_t* dst; int lds, coff, ldd, Klen, Nlen, zero, tile0, pad; };
constexpr int NTJ = 22;

struct Params {
    const float *x_p, *x_s, *c_ckv, *c_kr, *c_sbk, *c_sbv, *c_conv, *c_p, *c_s;
    const float *w_ada, *b_ada, *g_pre_mix, *g_post_mix, *g_pre_ffn, *g_post_ffn, *g_kv, *conv_w, *conv_b;
    float* out;
    bf16_t *WupT, *WdownT, *WinT, *WgT, *WuqT, *WukvT, *WpaT, *WpbT, *WoutT;
    float* ropeT; float* ada; unsigned* ctr; unsigned* bar;
    bf16_t *h, *o, *qlat, *latent, *krope, *kb, *vbT_p, *vbT_s, *qb, *q, *kva, *vaT_p, *vaT_s, *gates, *merged, *m2, *h2, *u, *g, *f, *ub;
    TJob tj[NTJ]; int ntj_tiles; int phase_lo, phase_hi, pad0; int ntj_early, pad1;
};

#define LAS __attribute__((address_space(3)))
typedef const Params __attribute__((address_space(4))) * KP;
DI KP kparams() { KP p = (KP)__builtin_amdgcn_kernarg_segment_ptr(); asm volatile("" : "+s"(p)); return p; }
DI int otid() { int t = threadIdx.x; asm volatile("" : "+v"(t)); return t; }
DI int obid() { int b = blockIdx.x; asm volatile("" : "+s"(b)); return b; }
DI int ogrid() { int g = gridDim.x; asm volatile("" : "+s"(g)); return g; }
DI unsigned pk2(float a, float b) { f32x2 f = {a, b}; bf2_t r = __builtin_convertvector(f, bf2_t); return __builtin_bit_cast(unsigned, r); }
DI float bf_lo(unsigned u) { return __uint_as_float(u << 16); }
DI float bf_hi(unsigned u) { return __uint_as_float(u & 0xffff0000u); }
DI int kvrow_of(int row) { if (row < MP) return row; const int r = row - MP; return MP + (r >> 5) * SKEYS + PAST + (r & 31); }
DI int pos_of(int row) { return row < MP ? (row & (TP - 1)) : PAST + ((row - MP) & 31); }
DI int ada_b(int row) { return row < MP ? (row >> 13) : 2 + ((row - MP) >> 5); }
DI float sigmoidf_(float x) { return __builtin_amdgcn_rcpf(1.0f + __builtin_amdgcn_exp2f(-1.4426950408889634f * x)); }

constexpr int BM = 256, BK = 64, HALF = 128, HT = HALF * BK;
DI int lds_byte(int r, int c) { int st = (r >> 4) * 2 + (c >> 5), rr = r & 15, cc = c & 31, ob = rr * 64 + cc * 2; return st * 1024 + (ob ^ (((ob >> 9) & 1) << 5)); }
DI void stage_rc(int b, int& R, int& C) { int st = b / 1024, sb = b % 1024, swz = sb ^ (((sb >> 9) & 1) << 5); R = (st >> 1) * 16 + swz / 64; C = (st & 1) * 32 + (swz % 64) / 2; }

enum { E_INPROJ = 0, E_GATE, E_UQ, E_UKV, E_PROJA, E_PROJB, E_PLAIN, E_UP };
struct GemmDesc { const bf16_t* A; const bf16_t* Bt; bf16_t* C; int lda, ldb, ldc, K, nM, nN, epi, start; };

constexpr int HTB = HT * 2;
#define SA(b, h) (((b) * 2 + (h)) * HTB)
#define SB(b, h) ((4 + (b) * 2 + (h)) * HTB)
#define STAGE(bufoff, gbase, voff) do { _Pragma("unroll") for (int _i = 0; _i < 2; ++_i) \
    __builtin_amdgcn_global_load_lds((const unsigned*)((const char*)(gbase) + (voff)[_i]), (LAS unsigned*)(ldsl + (bufoff) + ldsw + _i * 8192), 16, 0, 0); } while (0)
#define LDA(dst, b, h) do { _Pragma("unroll") for (int m = 0; m < 4; ++m) _Pragma("unroll") for (int k = 0; k < 2; ++k) dst[m][k] = *(const LAS bf16x8*)(ldsl + SA(b, h) + aoff + m * 2048 + k * 1024); } while (0)
#define LDB(dst, b, h) do { _Pragma("unroll") for (int n = 0; n < 2; ++n) _Pragma("unroll") for (int k = 0; k < 2; ++k) dst[n][k] = *(const LAS bf16x8*)(ldsl + SB(b, h) + boff + n * 2048 + k * 1024); } while (0)
#define MMA(ai, bj, At, Bt_) do { __builtin_amdgcn_s_setprio(1); _Pragma("unroll") for (int m = 0; m < 4; ++m) _Pragma("unroll") for (int n = 0; n < 2; ++n) _Pragma("unroll") for (int k = 0; k < 2; ++k) \
      acc[ai][bj][m][n] = __builtin_amdgcn_mfma_f32_16x16x32_bf16(Bt_[n][k], At[m][k], acc[ai][bj][m][n], 0, 0, 0); \
    __builtin_amdgcn_s_setprio(0); } while (0)
#define WAIT_V(n) asm volatile("s_waitcnt vmcnt(" #n ")" ::: "memory")
#define WAIT_L(n) asm volatile("s_waitcnt lgkmcnt(" #n ")" ::: "memory")
#define BAR __builtin_amdgcn_s_barrier()
#define SCHED __builtin_amdgcn_sched_barrier(0)
#define ZERO_ACC do { _Pragma("unroll") for (int a_ = 0; a_ < 2; ++a_) _Pragma("unroll") for (int b_ = 0; b_ < 2; ++b_) _Pragma("unroll") for (int m_ = 0; m_ < 4; ++m_) _Pragma("unroll") for (int n_ = 0; n_ < 2; ++n_) \
    acc[a_][b_][m_][n_] = (f32x4){0.f, 0.f, 0.f, 0.f}; } while (0)

#define EPI_ROWS for (int ai = 0; ai < 2; ++ai) for (int m = 0; m < 4; ++m, ({ asm volatile("" ::: "memory"); }))
#define EPI_COLS for (int bj = 0; bj < 2; ++bj) for (int n = 0; n < 2; ++n)

DI float dpp_xor1(float x) { return __int_as_float(__builtin_amdgcn_mov_dpp(__float_as_int(x), 0xB1, 0xF, 0xF, true)); }
DI float dpp_xor2(float x) { return __int_as_float(__builtin_amdgcn_mov_dpp(__float_as_int(x), 0x4E, 0xF, 0xF, true)); }
DI float gelu_tanh(float a) { const float a2 = a * a; const float q = a * __builtin_fmaf(0.10294324f, a2, 2.3022082f);
    const float e = __builtin_amdgcn_exp2f(q); const float r = __builtin_amdgcn_rcpf(1.0f + e); return __builtin_fmaf(-a, r, a); }
DI float dpp_ror1(float x) { return __int_as_float(__builtin_amdgcn_mov_dpp(__float_as_int(x), 0x121, 0xF, 0xF, true)); }
DI float dpp_ror2(float x) { return __int_as_float(__builtin_amdgcn_mov_dpp(__float_as_int(x), 0x122, 0xF, 0xF, true)); }
DI f32x4 ror1_4(f32x4 v) { return (f32x4){dpp_ror1(v[0]), dpp_ror1(v[1]), dpp_ror1(v[2]), dpp_ror1(v[3])}; }
DI f32x4 ror2_4(f32x4 v) { return (f32x4){dpp_ror2(v[0]), dpp_ror2(v[1]), dpp_ror2(v[2]), dpp_ror2(v[3])}; }
DI f32x4 quad_transpose(f32x4 v, int i) {
    { const float a = (i & 1) ? v[0] : v[1], c = (i & 1) ? v[2] : v[3]; const float ra = dpp_xor1(a), rc = dpp_xor1(c);
      if (i & 1) { v[0] = ra; v[2] = rc; } else { v[1] = ra; v[3] = rc; } }
    { const float a = (i & 2) ? v[0] : v[2], c = (i & 2) ? v[1] : v[3]; const float ra = dpp_xor2(a), rc = dpp_xor2(c);
      if (i & 2) { v[0] = ra; v[1] = rc; } else { v[2] = ra; v[3] = rc; } }
    return v;
}
DI void store_bf8(bf16_t* p, f32x4 a, f32x4 b) { u32x4 w; w.x = pk2(a[0], a[1]); w.y = pk2(a[2], a[3]); w.z = pk2(b[0], b[1]); w.w = pk2(b[2], b[3]); *(u32x4*)p = w; }
DI int perm32(int rho) { const int n = rho >> 4, i = rho & 15; return 8 * (i >> 2) + 4 * n + (i & 3); }
DI void store_bf4(bf16_t* p, f32x4 v) { u32x2 w; w.x = pk2(v[0], v[1]); w.y = pk2(v[2], v[3]); *(u32x2*)p = w; }

DI int unit_at(int k, int bid, int G, int nM, int nN, int start) {
    if (G != 256) { const int u = (bid + G - (start % G)) % G + k * G; return u < nM * nN ? u : -1; }
    const int x = bid & 7, l = ((bid >> 3) + start) & 31, cnt = nM >> 3, mainn = cnt * nN, j = l + 32 * k;
    if (j < mainn) { const int pn = j / cnt, rm = j - pn * cnt; return (x + 8 * rm) * nN + pn; }
    const int idx = x + 8 * (j - mainn);
    if (idx < (nM & 7) * nN) return (8 * cnt + idx / nN) * nN + idx % nN;
    return -1;
}

DI void gemm_run(const GemmDesc& d, char* lds) {
    LAS char* ldsl = (LAS char*)lds;
    float* xl = (float*)(lds + 131072);
    float* xp = (float*)(lds + 131072 + 4096);
    const int G = ogrid(), bid_ = obid(), first = unit_at(0, bid_, G, d.nM, d.nN, d.start);
    if (first < 0) return;
    int kun = 0;
    const int tid = otid(), wid = __builtin_amdgcn_readfirstlane(tid >> 6), wr = wid >> 2, wc = wid & 3;
    const unsigned lda2 = (unsigned)d.lda * 2u, ldb2 = (unsigned)d.ldb * 2u;
    unsigned voffA[2], voffB[2];
    { const int lane = tid & 63;
      const bool perm = d.epi == E_PLAIN || d.epi == E_GATE || d.epi == E_PROJA || d.epi == E_PROJB;
#pragma unroll
      for (int i = 0; i < 2; ++i) { int R, C; stage_rc(tid * 16 + i * 8192, R, C); const int Rb = perm ? ((R & ~31) + perm32(R & 31)) : R;
          voffA[i] = (unsigned)R * lda2 + (unsigned)C * 2u; voffB[i] = (unsigned)Rb * ldb2 + (unsigned)C * 2u; }
      (void)lane; }
    const size_t kstep = 128, hA = (size_t)HALF * lda2, hB = (size_t)HALF * ldb2;
    const unsigned ldsw = (unsigned)wid * 1024u;
    const int aoff = lds_byte(wr * 64 + (tid & 15), ((tid & 63) >> 4) * 8), boff = lds_byte(wc * 32 + (tid & 15), ((tid & 63) >> 4) * 8);
    const int nt = d.K / BK;
    int u = first;
    const char* cA = (const char*)d.A + (size_t)(u / d.nN) * 2 * hA; const char* cB = (const char*)d.Bt + (size_t)(u % d.nN) * 2 * hB;
    f32x4 acc[2][2][4][2];
    ZERO_ACC;
    bf16x8 At[4][2], B0[2][2], B1[2][2];
    STAGE(SB(0, 0), cB, voffB); STAGE(SB(0, 1), cB + hB, voffB); STAGE(SA(0, 0), cA, voffA); STAGE(SA(0, 1), cA + hA, voffA);
    if (wr == 1) BAR;
    WAIT_V(2); BAR;
    STAGE(SB(1, 0), cB + kstep, voffB); STAGE(SA(1, 0), cA + kstep, voffA); STAGE(SB(1, 1), cB + hB + kstep, voffB);
    WAIT_V(6); BAR;
    for (;;) {
        const int un = unit_at(kun + 1, bid_, G, d.nM, d.nN, d.start); const bool has_next = un >= 0;
        const char* nA = has_next ? (const char*)d.A + (size_t)(un / d.nN) * 2 * hA : cA; const char* nB = has_next ? (const char*)d.Bt + (size_t)(un % d.nN) * 2 * hB : cB;
        for (int t = 0; t < nt; t += 2) {
            const bool last = (t == nt - 2);
            const char* a1 = cA + (size_t)(t + 1) * kstep;
            const char* a2 = last ? nA : cA + (size_t)(t + 2) * kstep; const char* b2 = last ? nB : cB + (size_t)(t + 2) * kstep;
            const char* a3 = a2 + kstep; const char* b3 = b2 + kstep;
            LDB(B0, 0, 0); LDB(B1, 0, 1); SCHED; LDA(At, 0, 0); STAGE(SA(1, 1), a1 + hA, voffA);
            WAIT_V(8); WAIT_L(0); BAR; MMA(0, 0, At, B0); MMA(0, 1, At, B1); BAR; SCHED;
            LDA(At, 0, 1); STAGE(SB(0, 0), b2, voffB); STAGE(SB(0, 1), b2 + hB, voffB); STAGE(SA(0, 0), a2, voffA);
            WAIT_V(8); WAIT_L(0); BAR; MMA(1, 0, At, B0); MMA(1, 1, At, B1); BAR; SCHED;
            LDB(B0, 1, 0); LDB(B1, 1, 1); SCHED; LDA(At, 1, 0); STAGE(SA(0, 1), a2 + hA, voffA);
            WAIT_V(8); WAIT_L(0); BAR; MMA(0, 0, At, B0); MMA(0, 1, At, B1); BAR; SCHED;
            LDA(At, 1, 1); STAGE(SB(1, 0), b3, voffB); STAGE(SB(1, 1), b3 + hB, voffB); STAGE(SA(1, 0), a3, voffA);
            WAIT_V(8); WAIT_L(0); BAR; MMA(1, 0, At, B0); MMA(1, 1, At, B1); BAR; SCHED;
        }
        if (wr == 0) BAR;
        {
        const int pm = u / d.nN, pn = u % d.nN, brow = pm * BM, bcol = pn * BM;
        if (d.epi == E_UQ) {
            const int tq_ = otid(), r = tq_ >> 1, hf = tq_ & 1;
            const u32x4* src = (const u32x4*)(d.A + (long)(brow + r) * 384 + hf * 192);
            float sq = 0.f;
#pragma unroll 4
            for (int i = 0; i < 24; ++i) { u32x4 v = src[i];
                for (int e = 0; e < 4; ++e) { float a_ = bf_lo(v[e]), b_ = bf_hi(v[e]); sq += a_ * a_ + b_ * b_; } }
            sq += __shfl_xor(sq, 1);
            if (hf == 0) xl[r] = rsqrtf(sq * (1.0f / 384.0f) + EPS);
            WAIT_L(0); BAR; asm volatile("" ::: "memory");
        }
        int lane_e = threadIdx.x & 63; asm volatile("" : "+v"(lane_e));
        const int fr = lane_e & 15, fq = lane_e >> 4;
        KP P = kparams();
        const int rbase = brow + wr * 64 + fr, cbase = bcol + wc * 32 + fq * 4;
        switch (d.epi) {
        case E_INPROJ: {
            if (pn == 0) {
#pragma unroll
                EPI_ROWS { const int row = rbase + ai * 128 + m * 16;
#pragma unroll
                    EPI_COLS store_bf4(P->qlat + (long)row * 384 + (cbase + bj * 128 + n * 16), acc[ai][bj][m][n]); }
            } else if (pn == 1) {
#pragma unroll
                EPI_ROWS { const int row = rbase + ai * 128 + m * 16;
#pragma unroll
                    for (int n = 0; n < 2; ++n) store_bf4(P->qlat + (long)row * 384 + 256 + (wc * 32 + fq * 4 + n * 16), acc[ai][0][m][n]);
                    if (wc == 0) {
                        const int pos = pos_of(row);
                        const f32x4 cs0 = *(const f32x4*)(P->ropeT + (long)pos * 32 + fq * 8), cs1 = *(const f32x4*)(P->ropeT + (long)pos * 32 + fq * 8 + 4);
                        const f32x4 x1 = acc[ai][1][m][0], x2 = acc[ai][1][m][1];
                        f32x4 co = {cs0[0], cs0[2], cs1[0], cs1[2]}, si = {cs0[1], cs0[3], cs1[1], cs1[3]};
                        f32x4 o1 = x1 * co - x2 * si, o2 = x2 * co + x1 * si;
                        float* of = P->out + (row < MP ? O_KR_P + (long)row * 32 : O_KR_S + (long)(row - MP) * 32);
                        *(f32x4*)(of + fq * 4) = o1; *(f32x4*)(of + 16 + fq * 4) = o2;
                        bf16_t* ob = P->krope + (long)kvrow_of(row) * 32;
                        store_bf4(ob + fq * 4, o1); store_bf4(ob + 16 + fq * 4, o2);
                    } }
            } else if (pn == 2) {
                float ss[2][4];
#pragma unroll
                EPI_ROWS { float s = 0.f;
#pragma unroll
                    EPI_COLS { const f32x4 v = acc[ai][bj][m][n]; s += v[0] * v[0] + v[1] * v[1] + v[2] * v[2] + v[3] * v[3]; }
                    s += __shfl_xor(s, 16); s += __shfl_xor(s, 32); ss[ai][m] = s;
                    if (fq == 0) xp[(ai * 128 + wr * 64 + m * 16 + fr) * 4 + wc] = s; }
                WAIT_L(0); BAR; asm volatile("" ::: "memory");
#pragma unroll
                EPI_ROWS { const int rl = ai * 128 + wr * 64 + m * 16 + fr, row = brow + rl;
                    const f32x4 pp = *(const f32x4*)(xp + rl * 4);
                    const float rstd = rsqrtf((pp[0] + pp[1] + pp[2] + pp[3]) * (1.0f / 256.0f) + EPS);
                    float* of = P->out + (row < MP ? O_CKV_P + (long)row * 256 : O_CKV_S + (long)(row - MP) * 256);
                    bf16_t* ob = P->latent + (long)kvrow_of(row) * 256;
#pragma unroll
                    EPI_COLS { const int c = wc * 32 + fq * 4 + bj * 128 + n * 16;
                        const f32x4 gv = *(const f32x4*)(P->g_kv + c); const f32x4 o = acc[ai][bj][m][n] * rstd * gv;
                        *(f32x4*)(of + c) = o; store_bf4(ob + c, o); } }
            } else if (pn <= 4) {
#pragma unroll
                EPI_ROWS { const int row = rbase + ai * 128 + m * 16;
#pragma unroll
                    EPI_COLS store_bf4(P->qb + (long)row * 512 + (cbase - 768 + bj * 128 + n * 16), acc[ai][bj][m][n] * 0.125f); }
            } else if (pn <= 6) {
#pragma unroll
                EPI_ROWS { const int row = rbase + ai * 128 + m * 16;
                    float* of = P->out + (row < MP ? O_SBK_P + (long)row * 512 : O_SBK_S + (long)(row - MP) * 512);
                    bf16_t* ob = P->kb + (long)kvrow_of(row) * 512;
#pragma unroll
                    EPI_COLS { const int c = cbase - 1280 + bj * 128 + n * 16; *(f32x4*)(of + c) = acc[ai][bj][m][n]; store_bf4(ob + c, acc[ai][bj][m][n]); } }
            } else {
#pragma unroll
                EPI_ROWS { const int row = rbase + ai * 128 + m * 16;
                    float* of = P->out + (row < MP ? O_SBV_P + (long)row * 512 : O_SBV_S + (long)(row - MP) * 512);
                    const int qi = fr & 3, row4 = row - qi;
                    bf16_t* vt; int ldv;
                    if (row4 < MP) { vt = P->vbT_p + (long)(row4 >> 13) * 512 * TP + (row4 & (TP - 1)); ldv = TP; }
                    else { const int r = row4 - MP; vt = P->vbT_s + (long)(r >> 5) * 512 * SKP + PAST + (r & 31); ldv = SKP; }
#pragma unroll
                    EPI_COLS { const int c = cbase - 1792 + bj * 128 + n * 16; const f32x4 v = acc[ai][bj][m][n]; *(f32x4*)(of + c) = v;
                        store_bf4(vt + (long)(c + qi) * ldv, quad_transpose(v, qi)); } }
            }
        } break;
        case E_GATE: {
            const int c8 = bcol + wc * 32 + fq * 8;
#pragma unroll
            EPI_ROWS { const int row = rbase + ai * 128 + m * 16;
#pragma unroll
                for (int bj = 0; bj < 2; ++bj) { const f32x4 v0 = acc[ai][bj][m][0], v1 = acc[ai][bj][m][1];
                    const f32x4 s0 = {sigmoidf_(v0[0]), sigmoidf_(v0[1]), sigmoidf_(v0[2]), sigmoidf_(v0[3])}, s1 = {sigmoidf_(v1[0]), sigmoidf_(v1[1]), sigmoidf_(v1[2]), sigmoidf_(v1[3])};
                    store_bf8(P->gates + (long)row * 2048 + c8 + bj * 128, s0, s1); } }
        } break;
        case E_UQ: {
            const float qs = 0.10206207261596577f * LOG2E;
#pragma unroll
            EPI_ROWS { const int rl = ai * 128 + wr * 64 + m * 16 + fr, row = brow + rl; const float rs = xl[rl] * qs;
#pragma unroll
                for (int bj = 0; bj < 2; ++bj) { const int grp = pn * 8 + bj * 4 + wc; bf16_t* dst = P->q + (long)row * 768 + grp * 32 + fq * 4;
                    f32x4 v0 = acc[ai][bj][m][0] * rs, v1 = acc[ai][bj][m][1] * rs;
                    if (grp % 3 == 2) {
                        const int pos = pos_of(row);
                        const f32x4 cs0 = *(const f32x4*)(P->ropeT + (long)pos * 32 + fq * 8), cs1 = *(const f32x4*)(P->ropeT + (long)pos * 32 + fq * 8 + 4);
                        f32x4 co = {cs0[0], cs0[2], cs1[0], cs1[2]}, si = {cs0[1], cs0[3], cs1[1], cs1[3]};
                        const f32x4 o1 = v0 * co - v1 * si, o2 = v1 * co + v0 * si; v0 = o1; v1 = o2;
                    }
                    store_bf4(dst, v0); store_bf4(dst + 16, v1); } }
        } break;
        case E_UKV: {
#pragma unroll
            EPI_ROWS { const int row = rbase + ai * 128 + m * 16;
                if (pn < 2) {
#pragma unroll
                    EPI_COLS store_bf4(P->kva + (long)row * 512 + (cbase + bj * 128 + n * 16), acc[ai][bj][m][n]);
                } else {
                    const int qi = fr & 3, row4 = row - qi;
                    bf16_t* vt; int ldv;
                    if (row4 < MP) { vt = P->vaT_p + (long)(row4 >> 13) * 512 * TP + (row4 & (TP - 1)); ldv = TP; }
                    else { const int r = row4 - MP, b = r / SKEYS; vt = P->vaT_s + (long)b * 512 * SKP + (r - b * SKEYS); ldv = SKP; }
#pragma unroll
                    EPI_COLS { const int c = cbase - 512 + bj * 128 + n * 16; const f32x4 vtr = quad_transpose(acc[ai][bj][m][n], qi);
                        if (row4 < KVROWS) store_bf4(vt + (long)(c + qi) * ldv, vtr); }
                } }
        } break;
        case E_PROJA: case E_PROJB: {
            const int goff = d.epi == E_PROJA ? 0 : 1024, c8 = bcol + wc * 32 + fq * 8;
#pragma unroll
            EPI_ROWS { const int row = rbase + ai * 128 + m * 16;
#pragma unroll
                for (int bj = 0; bj < 2; ++bj) { const int c = c8 + bj * 128; const u32x4 gw = *(const u32x4*)(P->gates + (long)row * 2048 + goff + c);
                    f32x4 g0 = {bf_lo(gw.x), bf_hi(gw.x), bf_lo(gw.y), bf_hi(gw.y)}, g1 = {bf_lo(gw.z), bf_hi(gw.z), bf_lo(gw.w), bf_hi(gw.w)};
                    f32x4 v0 = acc[ai][bj][m][0] * g0, v1 = acc[ai][bj][m][1] * g1;
                    bf16_t* dst = P->merged + (long)row * 1024 + c;
                    if (d.epi == E_PROJB) { const u32x4 pw = *(const u32x4*)dst;
                        v0 += (f32x4){bf_lo(pw.x), bf_hi(pw.x), bf_lo(pw.y), bf_hi(pw.y)}; v1 += (f32x4){bf_lo(pw.z), bf_hi(pw.z), bf_lo(pw.w), bf_hi(pw.w)}; }
                    store_bf8(dst, v0, v1); } }
        } break;
        case E_PLAIN: {
            const int c8 = bcol + wc * 32 + fq * 8;
#pragma unroll
            EPI_ROWS { const int row = rbase + ai * 128 + m * 16;
#pragma unroll
                for (int bj = 0; bj < 2; ++bj) store_bf8(d.C + (long)row * d.ldc + c8 + bj * 128, acc[ai][bj][m][0], acc[ai][bj][m][1]); }
        } break;
        case E_UP: {
            const int jc0 = pn * 128 + wc * 32 + fq * 4;
            if (pm != 64) {
                const int tq_ = otid(), arr = tq_ >> 6, c2 = (tq_ & 63) * 2, hfb = arr >> 2, kk = arr & 3;
                const float* src = (kk < 3 ? P->conv_w + kk * DFF2 : P->conv_b) + hfb * DFF + pn * 128 + c2;
                *(f32x2*)(xp + arr * 128 + c2) = *(const f32x2*)src;
                WAIT_L(0); BAR; asm volatile("" ::: "memory");
            }
            if (pm == 64) {
#pragma unroll
                EPI_ROWS { const int row = rbase + ai * 128 + m * 16, r = row - MP, t = r & 31;
                    float* cf = t >= 30 ? P->out + O_CONV_S + (long)((r >> 5) * 2 + (t - 30)) * DFF2 : nullptr;
#pragma unroll
                    EPI_COLS { const int c = (bj ? DFF : 0) + jc0 + n * 16; store_bf4(P->u + (long)r * DFF2 + c, acc[ai][bj][m][n]); if (cf) *(f32x4*)(cf + c) = acc[ai][bj][m][n]; } }
            } else {
#pragma unroll
                for (int ai = 0; ai < 2; ++ai)
#pragma unroll
                    for (int n = 0; n < 2; ++n) {
                        const int ca = jc0 + n * 16;
                        f32x4 pa1 = {0.f, 0.f, 0.f, 0.f}, pa2 = pa1, pb1 = pa1, pb2 = pa1;
#pragma unroll
                        for (int m = 0; m < 4; ++m) {
                            const int row = rbase + ai * 128 + m * 16;
                            const f32x4 va = acc[ai][0][m][n], vb = acc[ai][1][m][n];
                            const f32x4 ra1 = ror1_4(va), ra2 = ror2_4(va), rb1 = ror1_4(vb), rb2 = ror2_4(vb);
                            const f32x4 p1a = fr >= 1 ? ra1 : pa1, p2a = fr >= 2 ? ra2 : pa2, p1b = fr >= 1 ? rb1 : pb1, p2b = fr >= 2 ? rb2 : pb2;
                            const float* wl = xp + (ca - pn * 128);
                            f32x4 ya = *(const f32x4*)(wl + 3 * 128) + *(const f32x4*)(wl) * p2a; ya += *(const f32x4*)(wl + 128) * p1a; ya += *(const f32x4*)(wl + 2 * 128) * va;
                            f32x4 yb = *(const f32x4*)(wl + 7 * 128) + *(const f32x4*)(wl + 4 * 128) * p2b; yb += *(const f32x4*)(wl + 5 * 128) * p1b; yb += *(const f32x4*)(wl + 6 * 128) * vb;
                            const f32x4 g4 = {gelu_tanh(ya[0]) * yb[0], gelu_tanh(ya[1]) * yb[1], gelu_tanh(ya[2]) * yb[2], gelu_tanh(ya[3]) * yb[3]};
                            if (!(m == 0 && fr < 2)) store_bf4(P->g + (long)row * DFF + ca, g4);
                            const int blk = row >> 6;
                            if (m == 0 && fr < 2) { bf16_t* up = P->ub + (long)(blk * 4 + 2 + fr) * DFF2 + ca; store_bf4(up, va); store_bf4(up + DFF, vb); }
                            if (m == 3 && fr >= 14) { bf16_t* up = P->ub + (long)(blk * 4 + (fr - 14)) * DFF2 + ca; store_bf4(up, va); store_bf4(up + DFF, vb);
                                const int t = row & (TP - 1);
                                if (t >= TP - 2) { float* cf = P->out + O_CONV_P + (long)((row >> 13) * 2 + (t - (TP - 2))) * DFF2 + ca; *(f32x4*)cf = va; *(f32x4*)(cf + DFF) = vb; } }
                            pa1 = ra1; pa2 = ra2; pb1 = rb1; pb2 = rb2;
                            asm volatile("" ::: "memory");
                        }
                    }
            }
        } break;
        }
        }
        if (!has_next) break;
        ZERO_ACC;
        u = un; cA = nA; cB = nB; ++kun;
        if (wr == 1) BAR;
    }
    WAIT_V(0);
    BAR;
}

#define MFMA32(a, b, c) __builtin_amdgcn_mfma_f32_32x32x16_bf16((a), (b), (c), 0, 0, 0)
template <int KIND, int KSTEPS  >
DI void gemm_small(KP P, const bf16_t* A, int lda, const bf16_t* Bt, int ldb, int N, bf16_t* C, int ldc, char* lds) {
    const int tid = otid(), lane = tid & 63, w = tid >> 6, r = lane & 31, hh = lane >> 5, G = ogrid();
    const int ntask = 8 * (N >> 5);
    float* part = (float*)lds;
    for (int task = obid(); task < ntask; task += G) {
        const int cb = (task & 7) + 8 * (task >> 6), rb = (task >> 3) & 7, row0 = MP + rb * 32, col0 = cb * 32;
#pragma unroll
        for (int pass = 0; pass < (KIND == 2 ? 2 : 1); ++pass) {
            const bf16_t* ap = A + pass * 512 + (long)(row0 + r) * lda + w * (KSTEPS * 16) + 8 * hh;
            const bf16_t* bp = (pass ? P->WpbT : Bt) + (long)(col0 + r) * ldb + w * (KSTEPS * 16) + 8 * hh;
            f32x16 acc;
#pragma unroll
            for (int i = 0; i < 16; ++i) acc[i] = 0.f;
            constexpr int UN = KSTEPS > 11 ? 11 : KSTEPS;
#pragma unroll 1
            for (int s0 = 0; s0 < KSTEPS; s0 += UN) {
                bf16x8 af[UN], bf[UN];
#pragma unroll
                for (int s = 0; s < UN; ++s) { af[s] = *(const bf16x8*)(ap + (s0 + s) * 16); bf[s] = *(const bf16x8*)(bp + (s0 + s) * 16); }
#pragma unroll
                for (int s = 0; s < UN; ++s) acc = MFMA32(bf[s], af[s], acc);
            }
            float* pp = part + ((pass * 8 + w) * 32 + r) * 32 + 4 * hh;
#pragma unroll
            for (int g = 0; g < 4; ++g) *(f32x4*)(pp + 8 * g) = (f32x4){acc[4 * g], acc[4 * g + 1], acc[4 * g + 2], acc[4 * g + 3]};
        }
        __syncthreads();
        {
            const int e = tid * 2, rr = e >> 5, cc = e & 31;
            f32x2 s1 = {0.f, 0.f}, s2 = {0.f, 0.f};
#pragma unroll
            for (int ww = 0; ww < 8; ++ww) { s1 += *(const f32x2*)(part + (ww * 32 + rr) * 32 + cc); if (KIND == 2) s2 += *(const f32x2*)(part + ((8 + ww) * 32 + rr) * 32 + cc); }
            const long row = row0 + rr; const int col = col0 + cc;
            if (KIND == 1) { s1[0] = sigmoidf_(s1[0]); s1[1] = sigmoidf_(s1[1]); }
            if (KIND == 2) { const unsigned ga = *(const unsigned*)(P->gates + row * 2048 + col), gb = *(const unsigned*)(P->gates + row * 2048 + 1024 + col);
                s1[0] = s1[0] * bf_lo(ga) + s2[0] * bf_lo(gb); s1[1] = s1[1] * bf_hi(ga) + s2[1] * bf_hi(gb); }
            *(unsigned*)(C + row * ldc + col) = pk2(s1[0], s1[1]);
        }
        __syncthreads();
    }
}

DI int crow(int i, int h) { return (i & 3) + 8 * (i >> 2) + 4 * h; }

template <int MODE, bool F32P>
DI void attn_unit(KP P, char* lds, bool sample, int b, int h, int ublk) {
    constexpr int DQK = MODE == 0 ? 96 : 64, KS = DQK * 2 + 16, VS = 144, NS = DQK / 16;
    constexpr int KBYTES = 64 * KS, BUF = KBYTES + 64 * VS;
    const int tid = otid(), w = tid >> 6, lane = tid & 63, ql = lane & 31, hh = lane >> 5;
    const int kvrow0 = sample ? MP + b * SKEYS : b * TP;
    const int qrow0 = sample ? MP + b * 32 : b * TP + ublk * 256;
    const int ntiles = sample ? 65 : 4 * (ublk + 1);
    const int t0 = sample ? 0 : ublk * 256 + w * 32, tq = t0 + ql;
    int klim, wmax, wmin;
    if (MODE == 0) { if (sample) { klim = wmax = wmin = SKEYS; } else { klim = ((tq >> 6) + 1) << 6; wmax = (((t0 + 31) >> 6) + 1) << 6; wmin = ((t0 >> 6) + 1) << 6; } }
    else { if (sample) { klim = PAST + tq; wmax = PAST + 31; wmin = PAST; } else { klim = tq; wmax = t0 + 31; wmin = t0; } }
    const bool wactive = sample ? (w == 0) : true;
    const bf16_t* Kp; const bf16_t* Qp; const bf16_t* VT; int ldq; long ldv;
    if (MODE == 0) { Kp = P->kva + (long)kvrow0 * 512 + h * 64; Qp = P->q + (long)qrow0 * 768 + h * 96; ldq = 768;
        VT = sample ? P->vaT_s + (long)(b * 512 + h * 64) * SKP : P->vaT_p + (long)(b * 512 + h * 64) * TP; }
    else { Kp = P->kb + (long)kvrow0 * 512 + h * 64; Qp = P->qb + (long)qrow0 * 512 + h * 64; ldq = 512;
        VT = sample ? P->vbT_s + (long)(b * 512 + h * 64) * SKP : P->vbT_p + (long)(b * 512 + h * 64) * TP; }
    ldv = sample ? SKP : TP;
    const bf16_t* Kr = P->krope + (long)kvrow0 * 32;

    bf16x8 qf[NS];
    if (wactive) {
        const bf16_t* qp = Qp + (long)(w * 32 + ql) * ldq + 8 * hh;
#pragma unroll
        for (int s = 0; s < NS; ++s) qf[s] = *(const bf16x8*)(qp + 16 * s);
    } else {
#pragma unroll
        for (int s = 0; s < NS; ++s) qf[s] = (bf16x8){0, 0, 0, 0, 0, 0, 0, 0};
    }
    f32x16 O0, O1;
#pragma unroll
    for (int i = 0; i < 16; ++i) { O0[i] = 0.f; O1[i] = 0.f; }
    float mrun = -INFINITY, lrun = 0.f, carry = 0.f;
    bool wdone = !wactive;
    volatile int* flags = (volatile int*)(lds + 65536 + 64);

    u32x4 rk0, rk1, rv; f32x4 fa0, fa1, fc0, fc1;
    const int krow_s = tid >> 3, kc_s = tid & 7, rrow_s = tid >> 2, rc_s = tid & 3;
    const float* Kf = P->c_sbk + ((long)b * PAST * 512 + h * 64); const float* Vf = P->c_sbv + ((long)b * PAST * 512 + h * 64);
    auto load_bf = [&](int kt) {
        rk0 = *(const u32x4*)(Kp + (long)(kt * 64 + krow_s) * 512 + kc_s * 8);
        if (MODE == 0 && tid < 256) rk1 = *(const u32x4*)(Kr + (long)(kt * 64 + rrow_s) * 32 + rc_s * 8);
        rv = *(const u32x4*)(VT + (long)krow_s * ldv + kt * 64 + kc_s * 8);
    };
    auto store_bf = [&](int buf) {
        char* kb_ = lds + buf * BUF; char* vb_ = kb_ + KBYTES;
        *(u32x4*)(kb_ + krow_s * KS + kc_s * 16) = rk0;
        if (MODE == 0 && tid < 256) *(u32x4*)(kb_ + rrow_s * KS + 128 + rc_s * 16) = rk1;
        *(u32x4*)(vb_ + krow_s * VS + kc_s * 16) = rv;
    };
    auto load_f32 = [&](int kt) {
        const float* kp_ = Kf + (long)(kt * 64 + krow_s) * 512 + kc_s * 8; const float* vp_ = Vf + (long)(kt * 64 + krow_s) * 512 + kc_s * 8;
        fa0 = *(const f32x4*)kp_; fa1 = *(const f32x4*)(kp_ + 4); fc0 = *(const f32x4*)vp_; fc1 = *(const f32x4*)(vp_ + 4);
    };
    auto store_f32 = [&](int buf) {
        char* kb_ = lds + buf * BUF; char* vb_ = kb_ + KBYTES;
        u32x4 kk, vv;
        kk.x = pk2(fa0[0], fa0[1]); kk.y = pk2(fa0[2], fa0[3]); kk.z = pk2(fa1[0], fa1[1]); kk.w = pk2(fa1[2], fa1[3]);
        vv.x = pk2(fc0[0], fc0[1]); vv.y = pk2(fc0[2], fc0[3]); vv.z = pk2(fc1[0], fc1[1]); vv.w = pk2(fc1[2], fc1[3]);
        *(u32x4*)(kb_ + krow_s * KS + kc_s * 16) = kk;
#pragma unroll
        for (int e = 0; e < 4; ++e) { *(bf16_t*)(vb_ + (kc_s * 8 + 2 * e) * VS + krow_s * 2) = (bf16_t)(vv[e] & 0xffff); *(bf16_t*)(vb_ + (kc_s * 8 + 2 * e + 1) * VS + krow_s * 2) = (bf16_t)(vv[e] >> 16); }
    };
    load_bf(ntiles - 1); store_bf(0);
    __syncthreads();
    for (int it = 0; it < ntiles; ++it) {
        const int kt = ntiles - 1 - it, cur = it & 1;
        if (it + 1 < ntiles) { if (F32P) load_f32(kt - 1); else load_bf(kt - 1); }
        if (wactive && !wdone && kt * 64 < wmax) {
            const char* kb_ = lds + cur * BUF; const char* vb_ = kb_ + KBYTES;
            f32x16 S0, S1;
#pragma unroll
            for (int i = 0; i < 16; ++i) { S0[i] = 0.f; S1[i] = 0.f; }
#pragma unroll
            for (int s = 0; s < NS; ++s) {
                const bf16x8 k0 = *(const bf16x8*)(kb_ + ql * KS + (16 * s + 8 * hh) * 2);
                const bf16x8 k1 = *(const bf16x8*)(kb_ + (32 + ql) * KS + (16 * s + 8 * hh) * 2);
                S0 = MFMA32(k0, qf[s], S0); S1 = MFMA32(k1, qf[s], S1);
            }
            const bool need_mask = (kt * 64 + 64 > wmin);
            const int kbase = kt * 64 + 4 * hh;
            if (MODE == 0) {
                if (need_mask) {
#pragma unroll
                    for (int i = 0; i < 16; ++i) { const int key = kbase + (i & 3) + 8 * (i >> 2);
                        if (key >= klim) S0[i] = -INFINITY; if (key + 32 >= klim) S1[i] = -INFINITY; }
                }
                float mx = S0[0];
#pragma unroll
                for (int i = 1; i < 16; ++i) mx = fmaxf(mx, S0[i]);
#pragma unroll
                for (int i = 0; i < 16; ++i) mx = fmaxf(mx, S1[i]);
                mx = fmaxf(mx, __shfl_xor(mx, 32));
                const float mnew = fmaxf(mrun, mx);
                const float alpha = __builtin_amdgcn_exp2f(mrun - mnew);
                mrun = mnew;
                float ps = 0.f;
#pragma unroll
                for (int i = 0; i < 16; ++i) { S0[i] = __builtin_amdgcn_exp2f(S0[i] - mnew); S1[i] = __builtin_amdgcn_exp2f(S1[i] - mnew); ps += S0[i] + S1[i]; }
                lrun = lrun * alpha + ps;
#pragma unroll
                for (int i = 0; i < 16; ++i) { O0[i] *= alpha; O1[i] *= alpha; }
            } else {
                float gs[2][4], gp[2][4];
                f32x16 SP0, SP1;
#pragma unroll
                for (int i = 0; i < 16; ++i) { const int key = kbase + (i & 3) + 8 * (i >> 2);
                    { const float z = S0[i]; const float t = __builtin_amdgcn_exp2f(-fabsf(z) * LOG2E); float sp = fmaxf(z, 0.f) + LN2 * __builtin_amdgcn_logf(1.0f + t);
                      if (need_mask && key >= klim) sp = 0.f; SP0[i] = sp; }
                    { const float z = S1[i]; const float t = __builtin_amdgcn_exp2f(-fabsf(z) * LOG2E); float sp = fmaxf(z, 0.f) + LN2 * __builtin_amdgcn_logf(1.0f + t);
                      if (need_mask && key + 32 >= klim) sp = 0.f; SP1[i] = sp; } }
#pragma unroll
                for (int g = 0; g < 4; ++g) { gs[0][g] = (SP0[4 * g] + SP0[4 * g + 1]) + (SP0[4 * g + 2] + SP0[4 * g + 3]);
                    gs[1][g] = (SP1[4 * g] + SP1[4 * g + 1]) + (SP1[4 * g + 2] + SP1[4 * g + 3]); }
#pragma unroll
                for (int g = 0; g < 4; ++g) { gp[0][g] = __shfl_xor(gs[0][g], 32); gp[1][g] = __shfl_xor(gs[1][g], 32); }
                float running = carry;
#pragma unroll
                for (int blk = 1; blk >= 0; --blk)
#pragma unroll
                    for (int g = 3; g >= 0; --g) {
                        const float sum1 = hh ? gs[blk][g] : gp[blk][g], sum0 = hh ? gp[blk][g] : gs[blk][g];
                        const float mybase = hh ? running : running + sum1;
                        running += sum0 + sum1;
                        float later = mybase;
#pragma unroll
                        for (int j = 3; j >= 0; --j) { const int i = 4 * g + j; const int key = kbase + j + 8 * g + 32 * blk;
                            const float z = blk ? S1[i] : S0[i], sp = blk ? SP1[i] : SP0[i];
                            float a = __builtin_amdgcn_exp2f((z - sp - later) * LOG2E);
                            if (need_mask && key >= klim) a = 0.f;
                            later += sp;
                            if (blk) S1[i] = a; else S0[i] = a; }
                    }
                carry = running;
                wdone = __all((carry > 104.0f) || (klim <= 0));
            }
            bf16x8 pf[2][2];
#pragma unroll
            for (int s = 0; s < 2; ++s) {
                u32x4 a, c;
                a.x = pk2(S0[8 * s], S0[8 * s + 1]); a.y = pk2(S0[8 * s + 2], S0[8 * s + 3]); a.z = pk2(S0[8 * s + 4], S0[8 * s + 5]); a.w = pk2(S0[8 * s + 6], S0[8 * s + 7]);
                c.x = pk2(S1[8 * s], S1[8 * s + 1]); c.y = pk2(S1[8 * s + 2], S1[8 * s + 3]); c.z = pk2(S1[8 * s + 4], S1[8 * s + 5]); c.w = pk2(S1[8 * s + 6], S1[8 * s + 7]);
                pf[0][s] = __builtin_bit_cast(bf16x8, a); pf[1][s] = __builtin_bit_cast(bf16x8, c);
            }
#pragma unroll
            for (int blk = 0; blk < 2; ++blk)
#pragma unroll
                for (int s = 0; s < 2; ++s) {
                    const int koff = (32 * blk + 16 * s + 4 * hh) * 2;
                    const s16x4 lo0 = *(const s16x4*)(vb_ + ql * VS + koff), hi0 = *(const s16x4*)(vb_ + ql * VS + koff + 16);
                    const s16x4 lo1 = *(const s16x4*)(vb_ + (32 + ql) * VS + koff), hi1 = *(const s16x4*)(vb_ + (32 + ql) * VS + koff + 16);
                    const bf16x8 v0 = __builtin_shufflevector(lo0, hi0, 0, 1, 2, 3, 4, 5, 6, 7), v1 = __builtin_shufflevector(lo1, hi1, 0, 1, 2, 3, 4, 5, 6, 7);
                    O0 = MFMA32(v0, pf[blk][s], O0); O1 = MFMA32(v1, pf[blk][s], O1);
                }
        }
        if (it + 1 < ntiles) { if (F32P) store_f32(cur ^ 1); else store_bf(cur ^ 1); }
        if (MODE == 1 && lane == 0) flags[(it & 1) * 8 + w] = wdone ? 1 : 0;
        __syncthreads();
        if (MODE == 1) { int alld = 1;
#pragma unroll
            for (int ww = 0; ww < 8; ++ww) alld &= flags[(it & 1) * 8 + ww];
            if (alld) break; }
    }
    if (wactive) {
        float inv = 1.0f;
        if (MODE == 0) { const float lt = lrun + __shfl_xor(lrun, 32); inv = 1.0f / lt; }
        bf16_t* op = P->o + (long)(qrow0 + w * 32 + ql) * 1024 + (MODE == 0 ? 0 : 512) + h * 64 + 4 * hh;
#pragma unroll
        for (int g = 0; g < 4; ++g) {
            f32x4 a = {O0[4 * g] * inv, O0[4 * g + 1] * inv, O0[4 * g + 2] * inv, O0[4 * g + 3] * inv};
            f32x4 c = {O1[4 * g] * inv, O1[4 * g + 1] * inv, O1[4 * g + 2] * inv, O1[4 * g + 3] * inv};
            store_bf4(op + 8 * g, a); store_bf4(op + 32 + 8 * g, c);
        }
    }
}

DI void attn_mla128(KP P, char* lds, bool sample, int b, int h, int ublk) {
    constexpr int KS = 208, VS = 272, KBYTES = 128 * KS, BUF = KBYTES + 64 * VS;
    const int tid = otid(), w = tid >> 6, lane = tid & 63, ql = lane & 31, hh = lane >> 5;
    const int kvrow0 = sample ? MP + b * SKEYS : b * TP;
    const int qrow0 = sample ? MP + b * 32 : b * TP + ublk * 256;
    const int ntiles = sample ? 33 : 2 * (ublk + 1);
    const int t0 = sample ? 0 : ublk * 256 + w * 32;
    const int wmax = sample ? SKEYS : ((((t0 + 31) >> 6) + 1) << 6);
    const bool wactive = sample ? (w == 0) : true;
    const bf16_t* Kp = P->kva + (long)kvrow0 * 512 + h * 64; const bf16_t* Qp = P->q + (long)qrow0 * 768 + h * 96;
    const bf16_t* VT = sample ? P->vaT_s + (long)(b * 512 + h * 64) * SKP : P->vaT_p + (long)(b * 512 + h * 64) * TP;
    const long ldv = sample ? SKP : TP;
    const bf16_t* Kr = P->krope + (long)kvrow0 * 32;
    bf16x8 qf[6];
    if (wactive) { const bf16_t* qp = Qp + (long)(w * 32 + ql) * 768 + 8 * hh;
#pragma unroll
        for (int s = 0; s < 6; ++s) qf[s] = *(const bf16x8*)(qp + 16 * s); }
    else {
#pragma unroll
        for (int s = 0; s < 6; ++s) qf[s] = (bf16x8){0, 0, 0, 0, 0, 0, 0, 0}; }
    f32x16 O0, O1;
#pragma unroll
    for (int i = 0; i < 16; ++i) { O0[i] = 0.f; O1[i] = 0.f; }
    float mrun = -INFINITY, lrun = 0.f;
    u32x4 rk[2], rr, rv[2];
    auto load_tile = [&](int kt) {
#pragma unroll
        for (int i = 0; i < 2; ++i) { const int c = tid + i * 512;
            rk[i] = *(const u32x4*)(Kp + (long)(kt * 128 + (c >> 3)) * 512 + (c & 7) * 8);
            rv[i] = *(const u32x4*)(VT + (long)(c >> 4) * ldv + kt * 128 + (c & 15) * 8); }
        rr = *(const u32x4*)(Kr + (long)(kt * 128 + (tid >> 2)) * 32 + (tid & 3) * 8);
    };
    auto store_tile = [&](int buf) {
        char* kb_ = lds + buf * BUF; char* vb_ = kb_ + KBYTES;
#pragma unroll
        for (int i = 0; i < 2; ++i) { const int c = tid + i * 512;
            *(u32x4*)(kb_ + (c >> 3) * KS + (c & 7) * 16) = rk[i];
            *(u32x4*)(vb_ + (c >> 4) * VS + (c & 15) * 16) = rv[i]; }
        *(u32x4*)(kb_ + (tid >> 2) * KS + 128 + (tid & 3) * 16) = rr;
    };
    load_tile(ntiles - 1); store_tile(0);
    __syncthreads();
    for (int it = 0; it < ntiles; ++it) {
        const int kt = ntiles - 1 - it, cur = it & 1;
        if (it + 1 < ntiles) load_tile(kt - 1);
        if (wactive && kt * 128 < wmax) {
            const char* kb_ = lds + cur * BUF; const char* vb_ = kb_ + KBYTES;
            const int nblk = (wmax - kt * 128) >> 5;
            f32x16 S[4];
#pragma unroll
            for (int blk = 0; blk < 4; ++blk) {
#pragma unroll
                for (int i = 0; i < 16; ++i) S[blk][i] = 0.f;
#pragma unroll
                for (int s = 0; s < 6; ++s) { const bf16x8 kf = *(const bf16x8*)(kb_ + (32 * blk + ql) * KS + (16 * s + 8 * hh) * 2); S[blk] = MFMA32(kf, qf[s], S[blk]); }
            }
            if (nblk < 4) {
#pragma unroll
                for (int blk = 1; blk < 4; ++blk) if (blk >= nblk) {
#pragma unroll
                    for (int i = 0; i < 16; ++i) S[blk][i] = -INFINITY; }
            }
            float mx = S[0][0];
#pragma unroll
            for (int blk = 0; blk < 4; ++blk)
#pragma unroll
                for (int i = 0; i < 16; ++i) mx = fmaxf(mx, S[blk][i]);
            mx = fmaxf(mx, __shfl_xor(mx, 32));
            const float mnew = fmaxf(mrun, mx);
            const float alpha = __builtin_amdgcn_exp2f(mrun - mnew);
            mrun = mnew;
            float ps = 0.f;
#pragma unroll
            for (int blk = 0; blk < 4; ++blk)
#pragma unroll
                for (int i = 0; i < 16; ++i) { S[blk][i] = __builtin_amdgcn_exp2f(S[blk][i] - mnew); ps += S[blk][i]; }
            lrun = lrun * alpha + ps;
#pragma unroll
            for (int i = 0; i < 16; ++i) { O0[i] *= alpha; O1[i] *= alpha; }
#pragma unroll
            for (int blk = 0; blk < 4; ++blk)
#pragma unroll
                for (int s = 0; s < 2; ++s) {
                    u32x4 a;
                    a.x = pk2(S[blk][8 * s], S[blk][8 * s + 1]); a.y = pk2(S[blk][8 * s + 2], S[blk][8 * s + 3]); a.z = pk2(S[blk][8 * s + 4], S[blk][8 * s + 5]); a.w = pk2(S[blk][8 * s + 6], S[blk][8 * s + 7]);
                    const bf16x8 pf = __builtin_bit_cast(bf16x8, a);
                    const int koff = (32 * blk + 16 * s + 4 * hh) * 2;
                    const s16x4 lo0 = *(const s16x4*)(vb_ + ql * VS + koff), hi0 = *(const s16x4*)(vb_ + ql * VS + koff + 16);
                    const s16x4 lo1 = *(const s16x4*)(vb_ + (32 + ql) * VS + koff), hi1 = *(const s16x4*)(vb_ + (32 + ql) * VS + koff + 16);
                    const bf16x8 v0 = __builtin_shufflevector(lo0, hi0, 0, 1, 2, 3, 4, 5, 6, 7), v1 = __builtin_shufflevector(lo1, hi1, 0, 1, 2, 3, 4, 5, 6, 7);
                    O0 = MFMA32(v0, pf, O0); O1 = MFMA32(v1, pf, O1);
                }
        }
        if (it + 1 < ntiles) store_tile(cur ^ 1);
        __syncthreads();
    }
    if (wactive) {
        const float lt = lrun + __shfl_xor(lrun, 32); const float inv = 1.0f / lt;
        bf16_t* op = P->o + (long)(qrow0 + w * 32 + ql) * 1024 + h * 64 + 4 * hh;
#pragma unroll
        for (int g = 0; g < 4; ++g) {
            f32x4 a = {O0[4 * g] * inv, O0[4 * g + 1] * inv, O0[4 * g + 2] * inv, O0[4 * g + 3] * inv};
            f32x4 c = {O1[4 * g] * inv, O1[4 * g + 1] * inv, O1[4 * g + 2] * inv, O1[4 * g + 3] * inv};
            store_bf4(op + 8 * g, a); store_bf4(op + 32 + 8 * g, c);
        }
    }
}

DI void attn_phase(KP P, char* lds, int cidx) {
    unsigned* slot = (unsigned*)(lds + 131072 + 3072);
    for (;;) {
        if (threadIdx.x == 0) *slot = atomicAdd(P->ctr + cidx, 1u);
        __syncthreads();
        const unsigned idx = *slot;
        __syncthreads();
        if (idx >= 1152u) break;
        bool sample; int mode, b, h, ublk = 0;
        if (idx < 128u) { sample = true; mode = idx >> 6; b = (idx >> 3) & 7; h = idx & 7; }
        else { const int j = idx - 128; sample = false; ublk = 31 - (j >> 5); const int r = j & 31; mode = r >> 4; b = (r >> 3) & 1; h = r & 7; }
        if (mode == 0) attn_mla128(P, lds, sample, b, h, ublk); else if (sample) attn_unit<1, true>(P, lds, true, b, h, ublk); else attn_unit<1, false>(P, lds, false, b, h, ublk);
    }
}

DI void tconv_tiles(KP P, char* lds, int it0, int itstep, int it_end) {
    const int tid = otid();
    float* tile = (float*)lds;
        for (int it = it0; it < it_end; it += itstep) {
            int j = 0;
#pragma unroll
            for (int q = 1; q < 16; ++q) if (it >= P->tj[q].tile0) j = q;
            TJob J; J.src = P->tj[j].src; J.kscale = P->tj[j].kscale; J.dst = P->tj[j].dst; J.lds = P->tj[j].lds; J.coff = P->tj[j].coff; J.ldd = P->tj[j].ldd;
            J.Klen = P->tj[j].Klen; J.Nlen = P->tj[j].Nlen; J.zero = P->tj[j].zero; J.tile0 = P->tj[j].tile0;
            const int lt = it - J.tile0, nk = J.Klen >> 6, tk = lt % nk, tn = lt / nk, k0 = tk * 64, n0 = tn * 256;
            f32x4 lv[8];
#pragma unroll
            for (int r = 0; r < 8; ++r) { const int e = tid + r * NTHREADS, kk = e >> 6, n4 = (e & 63) * 4;
                lv[r] = (f32x4){0.f, 0.f, 0.f, 0.f};
                if (J.zero == 2) { const int nn_ = n0 + n4, sc_ = (nn_ >> 8) * 128 + (nn_ & 127) + ((nn_ >> 7) & 1) * DFF;
                    lv[r] = *(const f32x4*)(J.src + (long)(k0 + kk) * J.lds + sc_); }
                else if (!J.zero && n0 + n4 < J.Nlen) lv[r] = *(const f32x4*)(J.src + (long)(k0 + kk) * J.lds + J.coff + n0 + n4); }
#pragma unroll
            for (int r = 0; r < 8; ++r) { const int e = tid + r * NTHREADS, kk = e >> 6, n4 = (e & 63) * 4;
                f32x4 v = lv[r]; if (J.kscale) v *= J.kscale[k0 + kk];
                float* tp = tile + kk * 257 + n4; tp[0] = v[0]; tp[1] = v[1]; tp[2] = v[2]; tp[3] = v[3]; }
            __syncthreads();
#pragma unroll
            for (int r = 0; r < 4; ++r) { const int e = tid + r * NTHREADS, nn = e >> 3, kc = (e & 7) * 8;
                if (n0 + nn < J.Nlen) { const float* tp = tile + kc * 257 + nn; u32x4 o;
                    o.x = pk2(tp[0], tp[257]); o.y = pk2(tp[2 * 257], tp[3 * 257]); o.z = pk2(tp[4 * 257], tp[5 * 257]); o.w = pk2(tp[6 * 257], tp[7 * 257]);
                    *(u32x4*)(J.dst + (long)(n0 + nn) * J.ldd + k0 + kc) = o; } }
            __syncthreads();
        }
}

DI void phase0(KP P, char* lds) {
    const int tid = otid(), G = ogrid(), bid = obid(), w = tid >> 6, lane = tid & 63;
    for (int item = bid; item < 96; item += G) {
        float* sc = (float*)lds; float* red = (float*)(lds + 40960);
        for (int i = tid; i < 10240; i += NTHREADS) { const int bb = i >> 10, k = i & 1023; const float cv = bb < 2 ? P->c_p[bb * 1024 + k] : P->c_s[(bb - 2) * 1024 + k]; sc[i] = cv / (1.0f + __expf(-cv)); }
        __syncthreads();
        const int col = item * 64 + lane;
        float a0 = 0, a1 = 0, a2 = 0, a3 = 0, a4 = 0, a5 = 0, a6 = 0, a7 = 0, a8 = 0, a9 = 0;
        for (int k0 = w * 128; k0 < w * 128 + 128; k0 += 16) {
            float wv[16];
#pragma unroll
            for (int j = 0; j < 16; ++j) wv[j] = P->w_ada[(long)(k0 + j) * 6144 + col];
#pragma unroll
            for (int j = 0; j < 16; ++j) { const int k = k0 + j;
                a0 += sc[k] * wv[j]; a1 += sc[1024 + k] * wv[j]; a2 += sc[2048 + k] * wv[j]; a3 += sc[3072 + k] * wv[j]; a4 += sc[4096 + k] * wv[j];
                a5 += sc[5120 + k] * wv[j]; a6 += sc[6144 + k] * wv[j]; a7 += sc[7168 + k] * wv[j]; a8 += sc[8192 + k] * wv[j]; a9 += sc[9216 + k] * wv[j]; }
        }
        float* rr = red + w * 640 + lane;
        rr[0] = a0; rr[64] = a1; rr[128] = a2; rr[192] = a3; rr[256] = a4; rr[320] = a5; rr[384] = a6; rr[448] = a7; rr[512] = a8; rr[576] = a9;
        __syncthreads();
        for (int i = tid; i < 640; i += NTHREADS) { float s = 0.f; for (int ww = 0; ww < 8; ++ww) s += red[ww * 640 + i];
            const int bb = i >> 6, l = i & 63; P->ada[bb * 6144 + item * 64 + l] = s + P->b_ada[item * 64 + l]; }
        __syncthreads();
    }
    tconv_tiles(P, lds, (bid + 96) % G, G, P->ntj_early);
    const long gt = (long)bid * NTHREADS + tid, gn = (long)G * NTHREADS;
    for (long i0 = gt; i0 < 8L * PAST * 64; i0 += 4 * gn) { f32x4 v[4];
#pragma unroll
        for (int r = 0; r < 4; ++r) { const long i = i0 + r * gn; if (i < 8L * PAST * 64) v[r] = *(const f32x4*)(P->c_ckv + i * 4); }
#pragma unroll
        for (int r = 0; r < 4; ++r) { const long i = i0 + r * gn; if (i < 8L * PAST * 64) { const long row = i >> 6; const int c = (int)(i & 63) * 4; const int bb = (int)(row >> 12), sq = (int)(row & 4095);
            store_bf4(P->latent + (long)(MP + bb * SKEYS + sq) * 256 + c, v[r]); } } }
    for (long i0 = gt; i0 < 8L * PAST * 8; i0 += 4 * gn) { f32x4 v[4];
#pragma unroll
        for (int r = 0; r < 4; ++r) { const long i = i0 + r * gn; if (i < 8L * PAST * 8) v[r] = *(const f32x4*)(P->c_kr + i * 4); }
#pragma unroll
        for (int r = 0; r < 4; ++r) { const long i = i0 + r * gn; if (i < 8L * PAST * 8) { const long row = i >> 3; const int c = (int)(i & 7) * 4; const int bb = (int)(row >> 12), sq = (int)(row & 4095);
            store_bf4(P->krope + (long)(MP + bb * SKEYS + sq) * 32 + c, v[r]); } } }
    for (long i = gt; i < 8L * 512 * 8; i += gn) { const long r = i >> 3; const int c = (int)(i & 7) * 4; const u32x2 z = {0u, 0u};
        *(u32x2*)(P->vaT_s + r * SKP + SKEYS + c) = z; *(u32x2*)(P->vbT_s + r * SKP + SKEYS + c) = z; }
    for (long i = gt; i < (long)TP * 16; i += gn) { const int pos = (int)(i >> 4), fi = (int)(i & 15);
        const float inv = exp2f(-(float)fi * (13.287712379549449f / 16.0f));
        const float ang = (float)pos * inv;
        const double rev = (double)ang * 0.15915494309189535; const float fr_ = (float)(rev - floor(rev));
        P->ropeT[i * 2] = __builtin_amdgcn_cosf(fr_); P->ropeT[i * 2 + 1] = __builtin_amdgcn_sinf(fr_); }
}

DI void phase_h(KP P) {
    const int tid_ = otid(), lane = tid_ & 63, gw = obid() * 8 + (tid_ >> 6), nw = ogrid() * 8;
    for (int row = gw; row < MT; row += nw) {
        const float* xr = row < MP ? P->x_p + (long)row * DM : P->x_s + (long)(row - MP) * DM;
        const float* ad = P->ada + ada_b(row) * 6144;
        f32x4 v[4]; float s = 0.f;
#pragma unroll
        for (int i = 0; i < 4; ++i) { v[i] = *(const f32x4*)(xr + i * 256 + lane * 4); s += v[i][0] * v[i][0] + v[i][1] * v[i][1] + v[i][2] * v[i][2] + v[i][3] * v[i][3]; }
#pragma unroll
        for (int o = 1; o < 64; o <<= 1) s += __shfl_xor(s, o);
        const float rstd = rsqrtf(s * (1.0f / DM) + EPS);
#pragma unroll
        for (int i = 0; i < 4; ++i) { const int c = i * 256 + lane * 4;
            const f32x4 g = *(const f32x4*)(P->g_pre_mix + c), sh = *(const f32x4*)(ad + c), scl = *(const f32x4*)(ad + 1024 + c);
            store_bf4(P->h + (long)row * DM + c, v[i] * rstd * g * (1.0f + scl) + sh); }
    }
}

DI void phase_mid(KP P) {
    const int tid_ = otid(), lane = tid_ & 63, gw = obid() * 8 + (tid_ >> 6), nw = ogrid() * 8;
    for (int row = gw; row < MT; row += nw) {
        const float* xr = row < MP ? P->x_p + (long)row * DM : P->x_s + (long)(row - MP) * DM;
        const float* ad = P->ada + ada_b(row) * 6144;
        f32x4 mv[4]; float s = 0.f;
#pragma unroll
        for (int i = 0; i < 4; ++i) { const u32x2 wv = *(const u32x2*)(P->m2 + (long)row * DM + i * 256 + lane * 4);
            mv[i] = (f32x4){bf_lo(wv.x), bf_hi(wv.x), bf_lo(wv.y), bf_hi(wv.y)}; s += mv[i][0] * mv[i][0] + mv[i][1] * mv[i][1] + mv[i][2] * mv[i][2] + mv[i][3] * mv[i][3]; }
#pragma unroll
        for (int o = 1; o < 64; o <<= 1) s += __shfl_xor(s, o);
        const float rstd = rsqrtf(s * (1.0f / DM) + EPS);
        float s2 = 0.f;
#pragma unroll
        for (int i = 0; i < 4; ++i) { const int c = i * 256 + lane * 4;
            const f32x4 xv = *(const f32x4*)(xr + c), g = *(const f32x4*)(P->g_post_mix + c), gt = *(const f32x4*)(ad + 2048 + c);
            mv[i] = xv + gt * (mv[i] * rstd * g);
            *(f32x4*)(P->out + O_Y + (long)row * DM + c) = mv[i];
            s2 += mv[i][0] * mv[i][0] + mv[i][1] * mv[i][1] + mv[i][2] * mv[i][2] + mv[i][3] * mv[i][3]; }
#pragma unroll
        for (int o = 1; o < 64; o <<= 1) s2 += __shfl_xor(s2, o);
        const float rstd2 = rsqrtf(s2 * (1.0f / DM) + EPS);
#pragma unroll
        for (int i = 0; i < 4; ++i) { const int c = i * 256 + lane * 4;
            const f32x4 g = *(const f32x4*)(P->g_pre_ffn + c), sh = *(const f32x4*)(ad + 3072 + c), scl = *(const f32x4*)(ad + 4096 + c);
            store_bf4(P->h2 + (long)row * DM + c, mv[i] * rstd2 * g * (1.0f + scl) + sh); }
    }
}

DI void phase_final(KP P) {
    const int tid_ = otid(), lane = tid_ & 63, gw = obid() * 8 + (tid_ >> 6), nw = ogrid() * 8;
    for (int row = gw; row < MT; row += nw) {
        const float* ad = P->ada + ada_b(row) * 6144;
        f32x4 fv[4]; float s = 0.f;
#pragma unroll
        for (int i = 0; i < 4; ++i) { const u32x2 wv = *(const u32x2*)(P->f + (long)row * DM + i * 256 + lane * 4);
            fv[i] = (f32x4){bf_lo(wv.x), bf_hi(wv.x), bf_lo(wv.y), bf_hi(wv.y)}; s += fv[i][0] * fv[i][0] + fv[i][1] * fv[i][1] + fv[i][2] * fv[i][2] + fv[i][3] * fv[i][3]; }
#pragma unroll
        for (int o = 1; o < 64; o <<= 1) s += __shfl_xor(s, o);
        const float rstd = rsqrtf(s * (1.0f / DM) + EPS);
#pragma unroll
        for (int i = 0; i < 4; ++i) { const int c = i * 256 + lane * 4; float* yp = P->out + O_Y + (long)row * DM + c;
            const f32x4 xv = *(const f32x4*)yp, g = *(const f32x4*)(P->g_post_ffn + c), gt = *(const f32x4*)(ad + 5120 + c);
            *(f32x4*)yp = xv + gt * (fv[i] * rstd * g); }
    }
}


DI void load8(const bf16_t* p, float (&o)[8]) { const u32x4 w = *(const u32x4*)p;
#pragma unroll
    for (int e = 0; e < 4; ++e) { o[2 * e] = bf_lo(w[e]); o[2 * e + 1] = bf_hi(w[e]); } }
DI void phase_convfix(KP P) {
    const long gt = (long)obid() * NTHREADS + otid(), gn = (long)ogrid() * NTHREADS;
    for (long i = gt; i < 768L * 352; i += gn) {
        const int ri = (int)(i / 352), c = (int)(i % 352) * 8;
        float u0[2][8], u1[2][8], u2[2][8];
        long grow;
        if (ri < 512) {
            const int B = ri >> 1, rsel = ri & 1; const bool first = ((B * 64) & (TP - 1)) == 0; grow = (long)B * 64 + rsel;
            const bf16_t* cur = P->ub + (long)(B * 4) * DFF2 + c; const bf16_t* prv = P->ub + (long)((B > 0 ? B - 1 : 0) * 4) * DFF2 + c;
#pragma unroll
            for (int hf = 0; hf < 2; ++hf) {
                load8(cur + (long)(2 + rsel) * DFF2 + hf * DFF, u2[hf]);
                if (rsel == 0) { if (first) { for (int e = 0; e < 8; ++e) { u1[hf][e] = 0.f; u0[hf][e] = 0.f; } } else { load8(prv + (long)1 * DFF2 + hf * DFF, u1[hf]); load8(prv + hf * DFF, u0[hf]); } }
                else { load8(cur + (long)2 * DFF2 + hf * DFF, u1[hf]); if (first) { for (int e = 0; e < 8; ++e) u0[hf][e] = 0.f; } else load8(prv + (long)1 * DFF2 + hf * DFF, u0[hf]); }
            }
        } else {
            const int r = ri - 512, t = r & 31, bs = r >> 5; grow = (long)MP + r;
            const float* st = P->c_conv + (long)bs * 2 * DFF2 + c;
#pragma unroll
            for (int hf = 0; hf < 2; ++hf) {
                load8(P->u + (long)r * DFF2 + hf * DFF + c, u2[hf]);
                if (t >= 1) load8(P->u + (long)(r - 1) * DFF2 + hf * DFF + c, u1[hf]); else { for (int e = 0; e < 8; ++e) u1[hf][e] = st[DFF2 + hf * DFF + e]; }
                if (t >= 2) load8(P->u + (long)(r - 2) * DFF2 + hf * DFF + c, u0[hf]); else { for (int e = 0; e < 8; ++e) u0[hf][e] = st[(long)t * DFF2 + hf * DFF + e]; }
            }
        }
        float y[2][8];
#pragma unroll
        for (int hf = 0; hf < 2; ++hf)
#pragma unroll
            for (int e = 0; e < 8; ++e) { const int cc = hf * DFF + c + e;
                y[hf][e] = P->conv_b[cc] + P->conv_w[cc] * u0[hf][e] + P->conv_w[DFF2 + cc] * u1[hf][e] + P->conv_w[2 * DFF2 + cc] * u2[hf][e]; }
        u32x4 ov;
#pragma unroll
        for (int e = 0; e < 4; ++e) ov[e] = pk2(gelu_tanh(y[0][2 * e]) * y[1][2 * e], gelu_tanh(y[0][2 * e + 1]) * y[1][2 * e + 1]);
        *(u32x4*)(P->g + grow * DFF + c) = ov;
    }
}

#define XB_TMO      128
#define XB_XCNT(j)  (256  + 64 * (j))
#define XB_XSUB(j)  (1280 + 64 * (j))
#define XB_XGEN(j)  (2304 + 64 * (j))
#define XB_TOP      3328
#define XB_TOPGEN   3392
#define XCD_BAR_WORDS 3456
#define XB_SPIN_CAP (1u << 18)
DI unsigned xb_ld(unsigned* p)              { return __hip_atomic_load(p, __ATOMIC_RELAXED, __HIP_MEMORY_SCOPE_AGENT); }
DI unsigned xb_add(unsigned* p, unsigned v) { return __hip_atomic_fetch_add(p, v, __ATOMIC_RELAXED, __HIP_MEMORY_SCOPE_AGENT); }
DI unsigned xb_xcc_id() { return (unsigned)__builtin_amdgcn_s_getreg((3 << 11) | 20) & 0xFu; }
#define XB_SPIN(cond, bar) do { unsigned _sp = 0; while (cond) { __builtin_amdgcn_s_sleep(1); \
    if ((++_sp & 255u) == 0u) { if (xb_ld(&(bar)[XB_TMO])) break; if (_sp > XB_SPIN_CAP) { atomicAdd(&(bar)[XB_TMO], 1u); break; } } } } while (0)
DI void xcd_barrier_complete(unsigned* bar, unsigned x, unsigned& nloc, unsigned& nx) {
    const unsigned G = gridDim.x;
    unsigned sum, cnt, mine, sp = 0u;
    for (;;) {
        sum = 0u; cnt = 0u; mine = 0u;
#pragma unroll
        for (unsigned j = 0; j < 16; ++j) { const unsigned c = xb_ld(&bar[XB_XCNT(j)]); sum += c; cnt += (c > 0u) ? 1u : 0u; mine = (j == x) ? c : mine; }
        if (sum == G) break;
        __builtin_amdgcn_s_sleep(1);
        if ((++sp & 255u) == 0u) { if (xb_ld(&bar[XB_TMO])) break; if (sp > XB_SPIN_CAP) { atomicAdd(&bar[XB_TMO], 1u); break; } }
    }
    nloc = mine > 0u ? mine : 1u; nx = cnt > 0u ? cnt : 1u;
}
DI void grid_barrier(char* lds) {
    asm volatile("s_waitcnt vmcnt(0)" ::: "memory");
    __syncthreads();
    if (threadIdx.x == 0) {
        unsigned* bar = kparams()->bar; const unsigned x = xb_xcc_id();
        volatile LAS unsigned* st = (volatile LAS unsigned*)(lds + 131072 + 2048);
        __builtin_amdgcn_s_waitcnt(0);
        unsigned nloc = st[0], nx = st[1];
        if (nloc == 0u) { xcd_barrier_complete(bar, x, nloc, nx); st[0] = nloc; st[1] = nx; }
        const unsigned old = xb_add(&bar[XB_XSUB(x)], 1u);
        const unsigned gen = old / nloc;
        if (old + 1u == (gen + 1u) * nloc) {
            __builtin_amdgcn_fence(__ATOMIC_RELEASE, "agent");
            asm volatile("s_waitcnt vmcnt(0)" ::: "memory");
            const unsigned og = xb_add(&bar[XB_TOP], 1u);
            const unsigned tg = og / nx;
            if (og + 1u == (tg + 1u) * nx) xb_add(&bar[XB_TOPGEN], 1u);
            else XB_SPIN(xb_ld(&bar[XB_TOPGEN]) == tg, bar);
            __builtin_amdgcn_fence(__ATOMIC_ACQUIRE, "agent");
            xb_add(&bar[XB_XGEN(x)], 1u);
            asm volatile("s_waitcnt vmcnt(0)" ::: "memory");
        } else {
            XB_SPIN(xb_ld(&bar[XB_XGEN(x)]) == gen, bar);
            __builtin_amdgcn_fence(__ATOMIC_ACQUIRE, "agent");
            asm volatile("s_waitcnt vmcnt(0)" ::: "memory");
        }
    }
    __syncthreads();
}

__global__ void __launch_bounds__(NTHREADS) fwd_megakernel(Params Pval) {
    extern __shared__ __attribute__((aligned(16))) char lds[];
    cg::grid_group grid = cg::this_grid();
    const int lo = kparams()->phase_lo, hi = kparams()->phase_hi;
#define PH(n) if (lo <= (n) && (n) < hi)
#define SYNC(n) if (lo <= (n) && (n) + 1 < hi) grid_barrier(lds)
    if (hi > 1000) grid.sync();
    { volatile LAS unsigned* st = (volatile LAS unsigned*)(lds + 131072 + 2048);
      if (threadIdx.x == 0) { st[0] = 0u; st[1] = 0u; }
      __syncthreads();
      if (threadIdx.x == 0) (void)xb_add(&kparams()->bar[XB_XCNT(xb_xcc_id())], 1u); }
    PH(0) phase0(kparams(), lds);
#ifdef PROBE_P0
    __syncthreads(); phase0(kparams(), lds);
#endif
#ifdef PROBE_SYNC
    for (int i = 0; i < 24; ++i) grid_barrier(lds);
#endif
    SYNC(0);
    PH(1) phase_h(kparams());
#ifdef PROBE_ROWS
    phase_h(kparams());
#endif
    SYNC(1);
    for (int ph = 2; ph <= 12; ++ph) {
        if (ph == 4) { PH(4) attn_phase(kparams(), lds, 0);
#ifdef PROBE_ATTN2
            __syncthreads(); attn_phase(kparams(), lds, 1);
#endif
            SYNC(4); continue; }
        if (ph == 8) { PH(8) phase_mid(kparams());
#ifdef PROBE_ROWS
            phase_mid(kparams());
#endif
            SYNC(8); continue; }
        if (ph == 10) { PH(10) phase_convfix(kparams());

            SYNC(10); continue; }
        if (ph == 12) { PH(12) phase_final(kparams()); continue; }
        if (lo <= ph && ph < hi) {
            const int npass = (ph == 3 || ph == 6) ? 2 : 1;
            for (int pass = 0; pass < npass; ++pass) {
                GemmDesc d; d.C = nullptr; d.ldc = 0; d.start = 0; KP P = kparams();
                switch (ph) {
                case 2: d.A = P->h; d.lda = DM; d.Bt = P->WinT; d.ldb = DM; d.K = DM; d.nM = 65; d.nN = 9; d.epi = E_INPROJ; break;
                case 3: if (pass == 0) { d.A = P->qlat; d.lda = 384; d.Bt = P->WuqT; d.ldb = 384; d.K = 384; d.nM = 65; d.nN = 3; d.epi = E_UQ; }
                        else { d.A = P->latent; d.lda = 256; d.Bt = P->WukvT; d.ldb = 256; d.K = 256; d.nM = 193; d.nN = 4; d.epi = E_UKV; d.start = 195; } break;
                case 5: d.A = P->h; d.lda = DM; d.Bt = P->WgT; d.ldb = DM; d.K = DM; d.nM = 64; d.nN = 8; d.epi = E_GATE; break;
                case 6: d.A = P->o + pass * 512; d.lda = DM; d.Bt = pass ? P->WpbT : P->WpaT; d.ldb = 512; d.K = 512; d.nM = 64; d.nN = 4; d.epi = pass ? E_PROJB : E_PROJA; break;
                case 7: d.A = P->merged; d.lda = DM; d.Bt = P->WoutT; d.ldb = DM; d.K = DM; d.nM = 64; d.nN = 4; d.epi = E_PLAIN; d.C = P->m2; d.ldc = DM; break;
                case 9: d.A = P->h2; d.lda = DM; d.Bt = P->WupT; d.ldb = DM; d.K = DM; d.nM = 65; d.nN = 22; d.epi = E_UP; break;
                default: d.A = P->g; d.lda = DFF; d.Bt = P->WdownT; d.ldb = DFF; d.K = DFF; d.nM = 64; d.nN = 4; d.epi = E_PLAIN; d.C = P->f; d.ldc = DM; break;
                }
                gemm_run(d, lds);
                if (ph == 2) {
                    const int G_ = ogrid(), b_ = obid(); int wi = b_, nW = G_;
                    if (G_ == 256) { const int l_ = b_ >> 3; wi = l_ >= 10 ? (l_ - 10) * 8 + (b_ & 7) : -1; nW = 176; }
                    if (wi >= 0) tconv_tiles(P, lds, P->ntj_early + wi, nW, P->ntj_tiles);
                }
#ifdef PROBE_GEMM2
                if (ph == PROBE_GEMM2 && !(ph == 6 && pass == 0)) { __syncthreads(); if (ph == 6) { GemmDesc d0 = d; d0.A = P->o; d0.Bt = P->WpaT; d0.epi = E_PROJA; gemm_run(d0, lds); } gemm_run(d, lds); }
#endif
            }
        }
        if (lo <= ph && ph < hi) {
            KP P = kparams();
            if (ph == 5) gemm_small<1, 8>(P, P->h, DM, P->WgT, DM, 2048, P->gates, 2048, lds);
            else if (ph == 6) gemm_small<2, 4>(P, P->o, DM, P->WpaT, 512, 1024, P->merged, DM, lds);
            else if (ph == 7) gemm_small<0, 8>(P, P->merged, DM, P->WoutT, DM, 1024, P->m2, DM, lds);
            else if (ph == 11) gemm_small<0, 22>(P, P->g, DFF, P->WdownT, DFF, 1024, P->f, DM, lds);
#ifdef PROBE_SMALL
            if (ph == 5) gemm_small<1, 8>(P, P->h, DM, P->WgT, DM, 2048, P->gates, 2048, lds);
            else if (ph == 6) gemm_small<2, 4>(P, P->o, DM, P->WpaT, 512, 1024, P->merged, DM, lds);
            else if (ph == 7) gemm_small<0, 8>(P, P->merged, DM, P->WoutT, DM, 1024, P->m2, DM, lds);
            else if (ph == 11) gemm_small<0, 22>(P, P->g, DFF, P->WdownT, DFF, 1024, P->f, DM, lds);
#endif
        }
        SYNC(ph);
    }
}

static size_t bump(size_t& off, size_t bytes) { size_t r = off; off += (bytes + 255) & ~(size_t)255; return r; }

extern "C" void kernel_launch(void* const* d_in, const int* in_sizes, int n_in, void* d_out, int out_size, void* d_ws, size_t ws_size, hipStream_t stream) {
    Params P; memset(&P, 0, sizeof(P));
    const float* const* in = (const float* const*)d_in;
    P.x_p = in[0]; P.x_s = in[1]; P.c_ckv = in[2]; P.c_kr = in[3]; P.c_sbk = in[4]; P.c_sbv = in[5]; P.c_conv = in[6]; P.c_p = in[7]; P.c_s = in[8];
    P.w_ada = in[9]; P.b_ada = in[10]; P.g_pre_mix = in[11]; P.g_post_mix = in[12]; P.g_pre_ffn = in[13]; P.g_post_ffn = in[14];
    const float* w_in = in[15]; const float* g_q = in[16]; const float* w_uq = in[17]; P.g_kv = in[18]; const float* w_uk = in[19]; const float* w_uv = in[20];
    const float* w_pa = in[21]; const float* w_pb = in[22]; const float* w_out = in[23]; const float* w_up = in[24]; P.conv_w = in[25]; P.conv_b = in[26]; const float* w_down = in[27];
    P.out = (float*)d_out;
    char* ws = (char*)d_ws; size_t off = 0;
    P.WupT = (bf16_t*)(ws + bump(off, (size_t)DFF2 * DM * 2));
    P.WdownT = (bf16_t*)(ws + bump(off, (size_t)DM * DFF * 2));
    P.ropeT = (float*)(ws + bump(off, (size_t)TP * 32 * 4));
    P.ada = (float*)(ws + bump(off, 10 * 6144 * 4));
    P.ctr = (unsigned*)(ws + bump(off, 256));
    P.bar = (unsigned*)(ws + bump(off, XCD_BAR_WORDS * 4));
    const size_t R0 = off;
    P.WinT = (bf16_t*)(ws + bump(off, (size_t)2304 * DM * 2));
    P.WgT = (bf16_t*)(ws + bump(off, (size_t)2048 * DM * 2));
    P.WuqT = (bf16_t*)(ws + bump(off, (size_t)768 * 384 * 2));
    P.WukvT = (bf16_t*)(ws + bump(off, (size_t)1024 * 256 * 2));
    P.WpaT = (bf16_t*)(ws + bump(off, (size_t)1024 * 512 * 2));
    P.WpbT = (bf16_t*)(ws + bump(off, (size_t)1024 * 512 * 2));
    P.WoutT = (bf16_t*)(ws + bump(off, (size_t)1024 * 1024 * 2));
    const size_t o_kva = off;
    P.kva = (bf16_t*)(ws + bump(off, (size_t)KVROWS_PAD * 512 * 2));
    P.vaT_p = (bf16_t*)(ws + bump(off, (size_t)2 * 512 * TP * 2));
    P.vaT_s = (bf16_t*)(ws + bump(off, (size_t)8 * 512 * SKP * 2));
    const size_t o_kb = off;
    P.kb = (bf16_t*)(ws + bump(off, (size_t)KVROWS_PAD * 512 * 2));
    const size_t o_vbT = off;
    P.vbT_p = (bf16_t*)(ws + bump(off, (size_t)2 * 512 * TP * 2));
    P.vbT_s = (bf16_t*)(ws + bump(off, (size_t)8 * 512 * SKP * 2));
    const size_t o_kr = off;
    P.krope = (bf16_t*)(ws + bump(off, (size_t)KVROWS_PAD * 32 * 2));
    P.qb = (bf16_t*)(ws + bump(off, (size_t)MT * 512 * 2));
    P.q = (bf16_t*)(ws + bump(off, (size_t)MT * 768 * 2));
    P.latent = (bf16_t*)(ws + bump(off, (size_t)KVROWS_PAD * 256 * 2));
    size_t need = off;
    P.gates = (bf16_t*)(ws + o_kva);
    P.merged = (bf16_t*)(ws + o_kb);
    P.m2 = (bf16_t*)(ws + o_vbT);
    const size_t o_g = R0 + (size_t)MT * DFF2 * 2;
    P.g = (bf16_t*)(ws + R0);
    P.f = (bf16_t*)(ws + R0 + (size_t)100 * 1024 * 1024);
    P.ub = (bf16_t*)(ws + R0 + (size_t)140 * 1024 * 1024);
    P.u = (bf16_t*)(ws + R0 + (size_t)155 * 1024 * 1024);
    size_t o_h2 = o_kr > o_g ? o_kr : o_g;
    P.h2 = (bf16_t*)(ws + o_h2);
    if (o_h2 + (size_t)MT * DM * 2 > need) need = o_h2 + (size_t)MT * DM * 2;
    P.h = (bf16_t*)d_out;
    P.o = (bf16_t*)d_out + (size_t)MT * DM;
    P.qlat = P.o;
    if (need > ws_size) { fprintf(stderr, "workspace too small: need %zu have %zu\n", need, ws_size); return; }

    int nj = 0, tiles = 0;
    auto job = [&](const float* src, int lds, int coff, bf16_t* dst, int ldd, int Klen, int Nlen, const float* ks, int zero) {
        TJob& J = P.tj[nj++]; J.src = src; J.kscale = ks; J.dst = dst; J.lds = lds; J.coff = coff; J.ldd = ldd; J.Klen = Klen; J.Nlen = Nlen; J.zero = zero; J.tile0 = tiles; J.pad = 0;
        tiles += (Klen / 64) * ((Nlen + 255) / 256); };
    job(w_in, 4256, 0, P.WinT, DM, DM, 384, nullptr, 0);
    job(w_in, 4256, 640, P.WinT + (size_t)384 * DM, DM, DM, 32, nullptr, 0);
    job(w_in, 4256, 0, P.WinT + (size_t)416 * DM, DM, DM, 96, nullptr, 1);
    job(w_in, 4256, 384, P.WinT + (size_t)512 * DM, DM, DM, 256, nullptr, 0);
    job(w_in, 4256, 672, P.WinT + (size_t)768 * DM, DM, DM, 1536, nullptr, 0);
    job(w_uq, 768, 0, P.WuqT, 384, 384, 768, g_q, 0);
    job(w_uk, 512, 0, P.WukvT, 256, 256, 512, nullptr, 0);
    job(w_uv, 512, 0, P.WukvT + (size_t)512 * 256, 256, 256, 512, nullptr, 0);
    P.ntj_early = tiles;
    job(w_in, 4256, 2208, P.WgT, DM, DM, 2048, nullptr, 0);
    job(w_pa, DM, 0, P.WpaT, 512, 512, DM, nullptr, 0);
    job(w_pb, DM, 0, P.WpbT, 512, 512, DM, nullptr, 0);
    job(w_out, DM, 0, P.WoutT, DM, DM, DM, nullptr, 0);
    job(w_up, DFF2, 0, P.WupT, DM, DM, DFF2, nullptr, 2);
    job(w_down, DM, 0, P.WdownT, DFF, DFF, DM, nullptr, 0);
    P.ntj_tiles = tiles; P.pad0 = nj;
    for (int q = nj; q < NTJ; ++q) P.tj[q].tile0 = 0x7fffffff;
    P.phase_lo = 0; P.phase_hi = 13;

    static int grid_blocks = 0;
    if (!grid_blocks) {
        (void)hipFuncSetAttribute((const void*)fwd_megakernel, hipFuncAttributeMaxDynamicSharedMemorySize, LDS_BYTES);
        int dev = 0, cus = 0, per_cu = 0;
        (void)hipGetDevice(&dev);
        (void)hipDeviceGetAttribute(&cus, hipDeviceAttributeMultiprocessorCount, dev);
        (void)hipOccupancyMaxActiveBlocksPerMultiprocessor(&per_cu, fwd_megakernel, NTHREADS, LDS_BYTES);
        if (per_cu > 1) per_cu = 1;
        grid_blocks = cus * per_cu;
    }
    (void)hipMemsetAsync(P.ctr, 0, 256 + XCD_BAR_WORDS * 4, stream);
    void* args[] = {&P};
    hipError_t e = hipLaunchCooperativeKernel((const void*)fwd_megakernel, dim3(grid_blocks), dim3(NTHREADS), args, LDS_BYTES, stream);
    if (e != hipSuccess) fprintf(stderr, "cooperative launch failed: %s (grid %d)\n", hipGetErrorString(e), grid_blocks);
}
```

```cpp
#include <hip/hip_runtime.h>
#include <hip/hip_cooperative_groups.h>
#include <stdint.h>
#include <stdio.h>
#include <string.h>
namespace cg = cooperative_groups;

typedef unsigned short bf16_t;
typedef short bf16x8 __attribute__((ext_vector_type(8)));
typedef short s16x4 __attribute__((ext_vector_type(4)));
typedef float f32x2 __attribute__((ext_vector_type(2)));
typedef float f32x4 __attribute__((ext_vector_type(4)));
typedef float f32x16 __attribute__((ext_vector_type(16)));
typedef unsigned u32x2 __attribute__((ext_vector_type(2)));
typedef unsigned u32x4 __attribute__((ext_vector_type(4)));
typedef __bf16 bf2_t __attribute__((ext_vector_type(2)));
#define DI __device__ __forceinline__

constexpr int DM = 1024, TP = 8192, MP = 16384, MS = 256, MT = 16640, PAST = 4096, SKEYS = 4128, SKP = 4160;
constexpr int KVROWS = MP + 8 * SKEYS;
constexpr int KVROWS_PAD = KVROWS + 64;
constexpr int DFF = 2816, DFF2 = 5632;
constexpr float EPS = 1e-6f;
constexpr float LOG2E = 1.4426950408889634f, LN2 = 0.6931471805599453f;
constexpr int NTHREADS = 512;
constexpr int LDS_BYTES = 131072 + 8192;
constexpr long O_Y = 0, O_CKV_P = 17039360, O_KR_P = 21233664, O_SBK_P = 21757952, O_SBV_P = 30146560, O_CONV_P = 38535168,
               O_CKV_S = 38557696, O_KR_S = 38623232, O_SBK_S = 38631424, O_SBV_S = 38762496, O_CONV_S = 38893568;

struct TJob { const float* src; const float* kscale; bf16_t* dst; int lds, coff, ldd, Klen, Nlen, zero, tile0, pad; };
constexpr int NTJ = 22;

struct Params {
    const float *x_p, *x_s, *c_ckv, *c_kr, *c_sbk, *c_sbv, *c_conv, *c_p, *c_s;
    const float *w_ada, *b_ada, *g_pre_mix, *g_post_mix, *g_pre_ffn, *g_post_ffn, *g_kv, *conv_w, *conv_b;
    float* out;
    bf16_t *WupT, *WdownT, *WinT, *WgT, *WuqT, *WukvT, *WpaT, *WpbT, *WoutT;
    float* ropeT; float* ada; unsigned* ctr; unsigned* bar;
    bf16_t *h, *o, *qlat, *latent, *krope, *kb, *vbT_p, *vbT_s, *qb, *q, *kva, *vaT_p, *vaT_s, *gates, *merged, *m2, *h2, *u, *g, *f, *ub;
    TJob tj[NTJ]; int ntj_tiles; int phase_lo, phase_hi, pad0; int ntj_early, pad1;
};

#define LAS __attribute__((address_space(3)))
typedef const Params __attribute__((address_space(4))) * KP;
DI KP kparams() { KP p = (KP)__builtin_amdgcn_kernarg_segment_ptr(); asm volatile("" : "+s"(p)); return p; }
DI int otid() { int t = threadIdx.x; asm volatile("" : "+v"(t)); return t; }
DI int obid() { int b = blockIdx.x; asm volatile("" : "+s"(b)); return b; }
DI int ogrid() { int g = gridDim.x; asm volatile("" : "+s"(g)); return g; }
DI unsigned pk2(float a, float b) { f32x2 f = {a, b}; bf2_t r = __builtin_convertvector(f, bf2_t); return __builtin_bit_cast(unsigned, r); }
DI float bf_lo(unsigned u) { return __uint_as_float(u << 16); }
DI float bf_hi(unsigned u) { return __uint_as_float(u & 0xffff0000u); }
DI int kvrow_of(int row) { if (row < MP) return row; const int r = row - MP; return MP + (r >> 5) * SKEYS + PAST + (r & 31); }
DI int pos_of(int row) { return row < MP ? (row & (TP - 1)) : PAST + ((row - MP) & 31); }
DI int ada_b(int row) { return row < MP ? (row >> 13) : 2 + ((row - MP) >> 5); }
DI float sigmoidf_(float x) { return __builtin_amdgcn_rcpf(1.0f + __builtin_amdgcn_exp2f(-1.4426950408889634f * x)); }

constexpr int BM = 256, BK = 64, HALF = 128, HT = HALF * BK;
DI int lds_byte(int r, int c) { int st = (r >> 4) * 2 + (c >> 5), rr = r & 15, cc = c & 31, ob = rr * 64 + cc * 2; return st * 1024 + (ob ^ (((ob >> 9) & 1) << 5)); }
DI void stage_rc(int b, int& R, int& C) { int st = b / 1024, sb = b % 1024, swz = sb ^ (((sb >> 9) & 1) << 5); R = (st >> 1) * 16 + swz / 64; C = (st & 1) * 32 + (swz % 64) / 2; }

enum { E_INPROJ = 0, E_GATE, E_UQ, E_UKV, E_PROJA, E_PROJB, E_PLAIN, E_UP };
struct GemmDesc { const bf16_t* A; const bf16_t* Bt; bf16_t* C; int lda, ldb, ldc, K, nM, nN, epi, start; };

constexpr int HTB = HT * 2;
#define SA(b, h) (((b) * 2 + (h)) * HTB)
#define SB(b, h) ((4 + (b) * 2 + (h)) * HTB)
#define STAGE(bufoff, gbase, voff) do { _Pragma("unroll") for (int _i = 0; _i < 2; ++_i) \
    __builtin_amdgcn_global_load_lds((const unsigned*)((const char*)(gbase) + (voff)[_i]), (LAS unsigned*)(ldsl + (bufoff) + ldsw + _i * 8192), 16, 0, 0); } while (0)
#define LDA(dst, b, h) do { _Pragma("unroll") for (int m = 0; m < 4; ++m) _Pragma("unroll") for (int k = 0; k < 2; ++k) dst[m][k] = *(const LAS bf16x8*)(ldsl + SA(b, h) + aoff + m * 2048 + k * 1024); } while (0)
#define LDB(dst, b, h) do { _Pragma("unroll") for (int n = 0; n < 2; ++n) _Pragma("unroll") for (int k = 0; k < 2; ++k) dst[n][k] = *(const LAS bf16x8*)(ldsl + SB(b, h) + boff + n * 2048 + k * 1024); } while (0)
#define MMA(ai, bj, At, Bt_) do { __builtin_amdgcn_s_setprio(1); _Pragma("unroll") for (int m = 0; m < 4; ++m) _Pragma("unroll") for (int n = 0; n < 2; ++n) _Pragma("unroll") for (int k = 0; k < 2; ++k) \
      acc[ai][bj][m][n] = __builtin_amdgcn_mfma_f32_16x16x32_bf16(Bt_[n][k], At[m][k], acc[ai][bj][m][n], 0, 0, 0); \
    __builtin_amdgcn_s_setprio(0); } while (0)
#define WAIT_V(n) asm volatile("s_waitcnt vmcnt(" #n ")" ::: "memory")
#define WAIT_L(n) asm volatile("s_waitcnt lgkmcnt(" #n ")" ::: "memory")
#define BAR __builtin_amdgcn_s_barrier()
#define SCHED __builtin_amdgcn_sched_barrier(0)
#define ZERO_ACC do { _Pragma("unroll") for (int a_ = 0; a_ < 2; ++a_) _Pragma("unroll") for (int b_ = 0; b_ < 2; ++b_) _Pragma("unroll") for (int m_ = 0; m_ < 4; ++m_) _Pragma("unroll") for (int n_ = 0; n_ < 2; ++n_) \
    acc[a_][b_][m_][n_] = (f32x4){0.f, 0.f, 0.f, 0.f}; } while (0)

#define EPI_ROWS for (int ai = 0; ai < 2; ++ai) for (int m = 0; m < 4; ++m, ({ asm volatile("" ::: "memory"); }))
#define EPI_COLS for (int bj = 0; bj < 2; ++bj) for (int n = 0; n < 2; ++n)

DI float dpp_xor1(float x) { return __int_as_float(__builtin_amdgcn_mov_dpp(__float_as_int(x), 0xB1, 0xF, 0xF, true)); }
DI float dpp_xor2(float x) { return __int_as_float(__builtin_amdgcn_mov_dpp(__float_as_int(x), 0x4E, 0xF, 0xF, true)); }
DI float gelu_tanh(float a) { const float a2 = a * a; const float q = a * __builtin_fmaf(0.10294324f, a2, 2.3022082f);
    const float e = __builtin_amdgcn_exp2f(q); const float r = __builtin_amdgcn_rcpf(1.0f + e); return __builtin_fmaf(-a, r, a); }
DI float dpp_ror1(float x) { return __int_as_float(__builtin_amdgcn_mov_dpp(__float_as_int(x), 0x121, 0xF, 0xF, true)); }
DI float dpp_ror2(float x) { return __int_as_float(__builtin_amdgcn_mov_dpp(__float_as_int(x), 0x122, 0xF, 0xF, true)); }
DI f32x4 ror1_4(f32x4 v) { return (f32x4){dpp_ror1(v[0]), dpp_ror1(v[1]), dpp_ror1(v[2]), dpp_ror1(v[3])}; }
DI f32x4 ror2_4(f32x4 v) { return (f32x4){dpp_ror2(v[0]), dpp_ror2(v[1]), dpp_ror2(v[2]), dpp_ror2(v[3])}; }
DI f32x4 quad_transpose(f32x4 v, int i) {
    { const float a = (i & 1) ? v[0] : v[1], c = (i & 1) ? v[2] : v[3]; const float ra = dpp_xor1(a), rc = dpp_xor1(c);
      if (i & 1) { v[0] = ra; v[2] = rc; } else { v[1] = ra; v[3] = rc; } }
    { const float a = (i & 2) ? v[0] : v[2], c = (i & 2) ? v[1] : v[3]; const float ra = dpp_xor2(a), rc = dpp_xor2(c);
      if (i & 2) { v[0] = ra; v[1] = rc; } else { v[2] = ra; v[3] = rc; } }
    return v;
}
DI void store_bf8(bf16_t* p, f32x4 a, f32x4 b) { u32x4 w; w.x = pk2(a[0], a[1]); w.y = pk2(a[2], a[3]); w.z = pk2(b[0], b[1]); w.w = pk2(b[2], b[3]); *(u32x4*)p = w; }
DI int perm32(int rho) { const int n = rho >> 4, i = rho & 15; return 8 * (i >> 2) + 4 * n + (i & 3); }
DI void store_bf4(bf16_t* p, f32x4 v) { u32x2 w; w.x = pk2(v[0], v[1]); w.y = pk2(v[2], v[3]); *(u32x2*)p = w; }

DI int unit_at(int k, int bid, int G, int nM, int nN, int start) {
    if (G != 256) { const int u = (bid + G - (start % G)) % G + k * G; return u < nM * nN ? u : -1; }
    const int x = bid & 7, l = ((bid >> 3) + start) & 31, cnt = nM >> 3, mainn = cnt * nN, j = l + 32 * k;
    if (j < mainn) { const int pn = j / cnt, rm = j - pn * cnt; return (x + 8 * rm) * nN + pn; }
    const int idx = x + 8 * (j - mainn);
    if (idx < (nM & 7) * nN) return (8 * cnt + idx / nN) * nN + idx % nN;
    return -1;
}

DI void gemm_run(const GemmDesc& d, char* lds) {
    LAS char* ldsl = (LAS char*)lds;
    float* xl = (float*)(lds + 131072);
    float* xp = (float*)(lds + 131072 + 4096);
    const int G = ogrid(), bid_ = obid(), first = unit_at(0, bid_, G, d.nM, d.nN, d.start);
    if (first < 0) return;
    int kun = 0;
    const int tid = otid(), wid = __builtin_amdgcn_readfirstlane(tid >> 6), wr = wid >> 2, wc = wid & 3;
    const unsigned lda2 = (unsigned)d.lda * 2u, ldb2 = (unsigned)d.ldb * 2u;
    unsigned voffA[2], voffB[2];
    { const int lane = tid & 63;
      const bool perm = d.epi == E_PLAIN || d.epi == E_GATE || d.epi == E_PROJA || d.epi == E_PROJB || d.epi == E_UKV;
#pragma unroll
      for (int i = 0; i < 2; ++i) { int R, C; stage_rc(tid * 16 + i * 8192, R, C); const int Rb = perm ? ((R & ~31) + perm32(R & 31)) : R;
          voffA[i] = (unsigned)R * lda2 + (unsigned)C * 2u; voffB[i] = (unsigned)Rb * ldb2 + (unsigned)C * 2u; }
      (void)lane; }
    const size_t kstep = 128, hA = (size_t)HALF * lda2, hB = (size_t)HALF * ldb2;
    const unsigned ldsw = (unsigned)wid * 1024u;
    const int aoff = lds_byte(wr * 64 + (tid & 15), ((tid & 63) >> 4) * 8), boff = lds_byte(wc * 32 + (tid & 15), ((tid & 63) >> 4) * 8);
    const int nt = d.K / BK;
    int u = first;
    const char* cA = (const char*)d.A + (size_t)(u / d.nN) * 2 * hA; const char* cB = (const char*)d.Bt + (size_t)(u % d.nN) * 2 * hB;
    f32x4 acc[2][2][4][2];
    ZERO_ACC;
    bf16x8 At[4][2], B0[2][2], B1[2][2];
    STAGE(SB(0, 0), cB, voffB); STAGE(SB(0, 1), cB + hB, voffB); STAGE(SA(0, 0), cA, voffA); STAGE(SA(0, 1), cA + hA, voffA);
    if (wr == 1) BAR;
    WAIT_V(2); BAR;
    STAGE(SB(1, 0), cB + kstep, voffB); STAGE(SA(1, 0), cA + kstep, voffA); STAGE(SB(1, 1), cB + hB + kstep, voffB);
    WAIT_V(6); BAR;
    for (;;) {
        const int un = unit_at(kun + 1, bid_, G, d.nM, d.nN, d.start); const bool has_next = un >= 0;
        const char* nA = has_next ? (const char*)d.A + (size_t)(un / d.nN) * 2 * hA : cA; const char* nB = has_next ? (const char*)d.Bt + (size_t)(un % d.nN) * 2 * hB : cB;
        for (int t = 0; t < nt; t += 2) {
            const bool last = (t == nt - 2);
            const char* a1 = cA + (size_t)(t + 1) * kstep;
            const char* a2 = last ? nA : cA + (size_t)(t + 2) * kstep; const char* b2 = last ? nB : cB + (size_t)(t + 2) * kstep;
            const char* a3 = a2 + kstep; const char* b3 = b2 + kstep;
            LDB(B0, 0, 0); LDB(B1, 0, 1); SCHED; LDA(At, 0, 0); STAGE(SA(1, 1), a1 + hA, voffA);
            WAIT_V(8); WAIT_L(0); BAR; MMA(0, 0, At, B0); MMA(0, 1, At, B1); BAR; SCHED;
            LDA(At, 0, 1); STAGE(SB(0, 0), b2, voffB); STAGE(SB(0, 1), b2 + hB, voffB); STAGE(SA(0, 0), a2, voffA);
            WAIT_V(8); WAIT_L(0); BAR; MMA(1, 0, At, B0); MMA(1, 1, At, B1); BAR; SCHED;
            LDB(B0, 1, 0); LDB(B1, 1, 1); SCHED; LDA(At, 1, 0); STAGE(SA(0, 1), a2 + hA, voffA);
            WAIT_V(8); WAIT_L(0); BAR; MMA(0, 0, At, B0); MMA(0, 1, At, B1); BAR; SCHED;
            LDA(At, 1, 1); STAGE(SB(1, 0), b3, voffB); STAGE(SB(1, 1), b3 + hB, voffB); STAGE(SA(1, 0), a3, voffA);
            WAIT_V(8); WAIT_L(0); BAR; MMA(1, 0, At, B0); MMA(1, 1, At, B1); BAR; SCHED;
        }
        if (wr == 0) BAR;
        {
        const int pm = u / d.nN, pn = u % d.nN, brow = pm * BM, bcol = pn * BM;
        if (d.epi == E_UQ) {
            const int tq_ = otid(), r = tq_ >> 1, hf = tq_ & 1;
            const u32x4* src = (const u32x4*)(d.A + (long)(brow + r) * 384 + hf * 192);
            float sq = 0.f;
#pragma unroll 4
            for (int i = 0; i < 24; ++i) { u32x4 v = src[i];
                for (int e = 0; e < 4; ++e) { float a_ = bf_lo(v[e]), b_ = bf_hi(v[e]); sq += a_ * a_ + b_ * b_; } }
            sq += __shfl_xor(sq, 1);
            if (hf == 0) xl[r] = rsqrtf(sq * (1.0f / 384.0f) + EPS);
            WAIT_L(0); BAR; asm volatile("" ::: "memory");
        }
        int lane_e = threadIdx.x & 63; asm volatile("" : "+v"(lane_e));
        const int fr = lane_e & 15, fq = lane_e >> 4;
        KP P = kparams();
        const int rbase = brow + wr * 64 + fr, cbase = bcol + wc * 32 + fq * 4;
        switch (d.epi) {
        case E_INPROJ: {
            if (pn == 0) {
#pragma unroll
                EPI_ROWS { const int row = rbase + ai * 128 + m * 16;
#pragma unroll
                    EPI_COLS store_bf4(P->qlat + (long)row * 384 + (cbase + bj * 128 + n * 16), acc[ai][bj][m][n]); }
            } else if (pn == 1) {
#pragma unroll
                EPI_ROWS { const int row = rbase + ai * 128 + m * 16;
#pragma unroll
                    for (int n = 0; n < 2; ++n) store_bf4(P->qlat + (long)row * 384 + 256 + (wc * 32 + fq * 4 + n * 16), acc[ai][0][m][n]);
                    if (wc == 0) {
                        const int pos = pos_of(row);
                        const f32x4 cs0 = *(const f32x4*)(P->ropeT + (long)pos * 32 + fq * 8), cs1 = *(const f32x4*)(P->ropeT + (long)pos * 32 + fq * 8 + 4);
                        const f32x4 x1 = acc[ai][1][m][0], x2 = acc[ai][1][m][1];
                        f32x4 co = {cs0[0], cs0[2], cs1[0], cs1[2]}, si = {cs0[1], cs0[3], cs1[1], cs1[3]};
                        f32x4 o1 = x1 * co - x2 * si, o2 = x2 * co + x1 * si;
                        float* of = P->out + (row < MP ? O_KR_P + (long)row * 32 : O_KR_S + (long)(row - MP) * 32);
                        *(f32x4*)(of + fq * 4) = o1; *(f32x4*)(of + 16 + fq * 4) = o2;
                        bf16_t* ob = P->krope + (long)kvrow_of(row) * 32;
                        store_bf4(ob + fq * 4, o1); store_bf4(ob + 16 + fq * 4, o2);
                    } }
            } else if (pn == 2) {
                float ss[2][4];
#pragma unroll
                EPI_ROWS { float s = 0.f;
#pragma unroll
                    EPI_COLS { const f32x4 v = acc[ai][bj][m][n]; s += v[0] * v[0] + v[1] * v[1] + v[2] * v[2] + v[3] * v[3]; }
                    s += __shfl_xor(s, 16); s += __shfl_xor(s, 32); ss[ai][m] = s;
                    if (fq == 0) xp[(ai * 128 + wr * 64 + m * 16 + fr) * 4 + wc] = s; }
                WAIT_L(0); BAR; asm volatile("" ::: "memory");
#pragma unroll
                EPI_ROWS { const int rl = ai * 128 + wr * 64 + m * 16 + fr, row = brow + rl;
                    const f32x4 pp = *(const f32x4*)(xp + rl * 4);
                    const float rstd = rsqrtf((pp[0] + pp[1] + pp[2] + pp[3]) * (1.0f / 256.0f) + EPS);
                    float* of = P->out + (row < MP ? O_CKV_P + (long)row * 256 : O_CKV_S + (long)(row - MP) * 256);
                    bf16_t* ob = P->latent + (long)kvrow_of(row) * 256;
#pragma unroll
                    EPI_COLS { const int c = wc * 32 + fq * 4 + bj * 128 + n * 16;
                        const f32x4 gv = *(const f32x4*)(P->g_kv + c); const f32x4 o = acc[ai][bj][m][n] * rstd * gv;
                        *(f32x4*)(of + c) = o; store_bf4(ob + c, o); } }
            } else if (pn <= 4) {
#pragma unroll
                EPI_ROWS { const int row = rbase + ai * 128 + m * 16;
#pragma unroll
                    EPI_COLS store_bf4(P->qb + (long)row * 512 + (cbase - 768 + bj * 128 + n * 16), acc[ai][bj][m][n] * 0.125f); }
            } else if (pn <= 6) {
#pragma unroll
                EPI_ROWS { const int row = rbase + ai * 128 + m * 16;
                    float* of = P->out + (row < MP ? O_SBK_P + (long)row * 512 : O_SBK_S + (long)(row - MP) * 512);
                    bf16_t* ob = P->kb + (long)kvrow_of(row) * 512;
#pragma unroll
                    EPI_COLS { const int c = cbase - 1280 + bj * 128 + n * 16; *(f32x4*)(of + c) = acc[ai][bj][m][n]; store_bf4(ob + c, acc[ai][bj][m][n]); } }
            } else {
#pragma unroll
                EPI_ROWS { const int row = rbase + ai * 128 + m * 16;
                    float* of = P->out + (row < MP ? O_SBV_P + (long)row * 512 : O_SBV_S + (long)(row - MP) * 512);
                    const int qi = fr & 3, row4 = row - qi;
                    bf16_t* vt; int ldv;
                    if (row4 < MP) { vt = P->vbT_p + (long)(row4 >> 13) * 512 * TP + (row4 & (TP - 1)); ldv = TP; }
                    else { const int r = row4 - MP; vt = P->vbT_s + (long)(r >> 5) * 512 * SKP + PAST + (r & 31); ldv = SKP; }
#pragma unroll
                    EPI_COLS { const int c = cbase - 1792 + bj * 128 + n * 16; const f32x4 v = acc[ai][bj][m][n]; *(f32x4*)(of + c) = v;
                        store_bf4(vt + (long)(c + qi) * ldv, quad_transpose(v, qi)); } }
            }
        } break;
        case E_GATE: {
            const int c8 = bcol + wc * 32 + fq * 8;
#pragma unroll
            EPI_ROWS { const int row = rbase + ai * 128 + m * 16;
#pragma unroll
                for (int bj = 0; bj < 2; ++bj) { const f32x4 v0 = acc[ai][bj][m][0], v1 = acc[ai][bj][m][1];
                    const f32x4 s0 = {sigmoidf_(v0[0]), sigmoidf_(v0[1]), sigmoidf_(v0[2]), sigmoidf_(v0[3])}, s1 = {sigmoidf_(v1[0]), sigmoidf_(v1[1]), sigmoidf_(v1[2]), sigmoidf_(v1[3])};
                    store_bf8(P->gates + (long)row * 2048 + c8 + bj * 128, s0, s1); } }
        } break;
        case E_UQ: {
            const float qs = 0.10206207261596577f * LOG2E;
#pragma unroll
            EPI_ROWS { const int rl = ai * 128 + wr * 64 + m * 16 + fr, row = brow + rl; const float rs = xl[rl] * qs;
#pragma unroll
                for (int bj = 0; bj < 2; ++bj) { const int grp = pn * 8 + bj * 4 + wc; bf16_t* dst = P->q + (long)row * 768 + grp * 32 + fq * 4;
                    f32x4 v0 = acc[ai][bj][m][0] * rs, v1 = acc[ai][bj][m][1] * rs;
                    if (grp % 3 == 2) {
                        const int pos = pos_of(row);
                        const f32x4 cs0 = *(const f32x4*)(P->ropeT + (long)pos * 32 + fq * 8), cs1 = *(const f32x4*)(P->ropeT + (long)pos * 32 + fq * 8 + 4);
                        f32x4 co = {cs0[0], cs0[2], cs1[0], cs1[2]}, si = {cs0[1], cs0[3], cs1[1], cs1[3]};
                        const f32x4 o1 = v0 * co - v1 * si, o2 = v1 * co + v0 * si; v0 = o1; v1 = o2;
                    }
                    store_bf4(dst, v0); store_bf4(dst + 16, v1); } }
        } break;
        case E_UKV: {
            const int c8 = bcol + wc * 32 + fq * 8;
#pragma unroll
            EPI_ROWS { const int row = rbase + ai * 128 + m * 16;
                if (pn < 2) {
#pragma unroll
                    for (int bj = 0; bj < 2; ++bj) store_bf8(P->kva + (long)row * 512 + c8 + bj * 128, acc[ai][bj][m][0], acc[ai][bj][m][1]);
                } else {
                    const int qi = fr & 3, row4 = row - qi;
                    bf16_t* vt; int ldv;
                    if (row4 < MP) { vt = P->vaT_p + (long)(row4 >> 13) * 512 * TP + (row4 & (TP - 1)); ldv = TP; }
                    else { const int r = row4 - MP, b = r / SKEYS; vt = P->vaT_s + (long)b * 512 * SKP + (r - b * SKEYS); ldv = SKP; }
#pragma unroll
                    EPI_COLS { const int c = c8 - 512 + bj * 128 + n * 4; const f32x4 vtr = quad_transpose(acc[ai][bj][m][n], qi);
                        if (row4 < KVROWS) store_bf4(vt + (long)(c + qi) * ldv, vtr); }
                } }
        } break;
        case E_PROJA: case E_PROJB: {
            const int goff = d.epi == E_PROJA ? 0 : 1024, c8 = bcol + wc * 32 + fq * 8;
#pragma unroll
            EPI_ROWS { const int row = rbase + ai * 128 + m * 16;
#pragma unroll
                for (int bj = 0; bj < 2; ++bj) { const int c = c8 + bj * 128; const u32x4 gw = *(const u32x4*)(P->gates + (long)row * 2048 + goff + c);
                    f32x4 g0 = {bf_lo(gw.x), bf_hi(gw.x), bf_lo(gw.y), bf_hi(gw.y)}, g1 = {bf_lo(gw.z), bf_hi(gw.z), bf_lo(gw.w), bf_hi(gw.w)};
                    f32x4 v0 = acc[ai][bj][m][0] * g0, v1 = acc[ai][bj][m][1] * g1;
                    bf16_t* dst = P->merged + (long)row * 1024 + c;
                    if (d.epi == E_PROJB) { const u32x4 pw = *(const u32x4*)dst;
                        v0 += (f32x4){bf_lo(pw.x), bf_hi(pw.x), bf_lo(pw.y), bf_hi(pw.y)}; v1 += (f32x4){bf_lo(pw.z), bf_hi(pw.z), bf_lo(pw.w), bf_hi(pw.w)}; }
                    store_bf8(dst, v0, v1); } }
        } break;
        case E_PLAIN: {
            const int c8 = bcol + wc * 32 + fq * 8;
#pragma unroll
            EPI_ROWS { const int row = rbase + ai * 128 + m * 16;
#pragma unroll
                for (int bj = 0; bj < 2; ++bj) store_bf8(d.C + (long)row * d.ldc + c8 + bj * 128, acc[ai][bj][m][0], acc[ai][bj][m][1]); }
        } break;
        case E_UP: {
            const int jc0 = pn * 128 + wc * 32 + fq * 4;
            if (pm != 64) {
                const int tq_ = otid(), arr = tq_ >> 6, c2 = (tq_ & 63) * 2, hfb = arr >> 2, kk = arr & 3;
                const float* src = (kk < 3 ? P->conv_w + kk * DFF2 : P->conv_b) + hfb * DFF + pn * 128 + c2;
                *(f32x2*)(xp + arr * 128 + c2) = *(const f32x2*)src;
                WAIT_L(0); BAR; asm volatile("" ::: "memory");
            }
            if (pm == 64) {
#pragma unroll
                EPI_ROWS { const int row = rbase + ai * 128 + m * 16, r = row - MP, t = r & 31;
                    float* cf = t >= 30 ? P->out + O_CONV_S + (long)((r >> 5) * 2 + (t - 30)) * DFF2 : nullptr;
#pragma unroll
                    EPI_COLS { const int c = (bj ? DFF : 0) + jc0 + n * 16; store_bf4(P->u + (long)r * DFF2 + c, acc[ai][bj][m][n]); if (cf) *(f32x4*)(cf + c) = acc[ai][bj][m][n]; } }
            } else {
#pragma unroll
                for (int ai = 0; ai < 2; ++ai)
#pragma unroll
                    for (int n = 0; n < 2; ++n) {
                        const int ca = jc0 + n * 16;
                        f32x4 pa1 = {0.f, 0.f, 0.f, 0.f}, pa2 = pa1, pb1 = pa1, pb2 = pa1;
#pragma unroll
                        for (int m = 0; m < 4; ++m) {
                            const int row = rbase + ai * 128 + m * 16;
                            const f32x4 va = acc[ai][0][m][n], vb = acc[ai][1][m][n];
                            const f32x4 ra1 = ror1_4(va), ra2 = ror2_4(va), rb1 = ror1_4(vb), rb2 = ror2_4(vb);
                            const f32x4 p1a = fr >= 1 ? ra1 : pa1, p2a = fr >= 2 ? ra2 : pa2, p1b = fr >= 1 ? rb1 : pb1, p2b = fr >= 2 ? rb2 : pb2;
                            const float* wl = xp + (ca - pn * 128);
                            f32x4 ya = *(const f32x4*)(wl + 3 * 128) + *(const f32x4*)(wl) * p2a; ya += *(const f32x4*)(wl + 128) * p1a; ya += *(const f32x4*)(wl + 2 * 128) * va;
                            f32x4 yb = *(const f32x4*)(wl + 7 * 128) + *(const f32x4*)(wl + 4 * 128) * p2b; yb += *(const f32x4*)(wl + 5 * 128) * p1b; yb += *(const f32x4*)(wl + 6 * 128) * vb;
                            const f32x4 g4 = {gelu_tanh(ya[0]) * yb[0], gelu_tanh(ya[1]) * yb[1], gelu_tanh(ya[2]) * yb[2], gelu_tanh(ya[3]) * yb[3]};
                            if (!(m == 0 && fr < 2)) store_bf4(P->g + (long)row * DFF + ca, g4);
                            const int blk = row >> 6;
                            if (m == 0 && fr < 2) { bf16_t* up = P->ub + (long)(blk * 4 + 2 + fr) * DFF2 + ca; store_bf4(up, va); store_bf4(up + DFF, vb); }
                            if (m == 3 && fr >= 14) { bf16_t* up = P->ub + (long)(blk * 4 + (fr - 14)) * DFF2 + ca; store_bf4(up, va); store_bf4(up + DFF, vb);
                                const int t = row & (TP - 1);
                                if (t >= TP - 2) { float* cf = P->out + O_CONV_P + (long)((row >> 13) * 2 + (t - (TP - 2))) * DFF2 + ca; *(f32x4*)cf = va; *(f32x4*)(cf + DFF) = vb; } }
                            pa1 = ra1; pa2 = ra2; pb1 = rb1; pb2 = rb2;
                            asm volatile("" ::: "memory");
                        }
                    }
            }
        } break;
        }
        }
        if (!has_next) break;
        ZERO_ACC;
        u = un; cA = nA; cB = nB; ++kun;
        if (wr == 1) BAR;
    }
    WAIT_V(0);
    BAR;
}

#define MFMA32(a, b, c) __builtin_amdgcn_mfma_f32_32x32x16_bf16((a), (b), (c), 0, 0, 0)
template <int KIND, int KSTEPS  >
DI void gemm_small(KP P, const bf16_t* A, int lda, const bf16_t* Bt, int ldb, int N, bf16_t* C, int ldc, char* lds) {
    const int tid = otid(), lane = tid & 63, w = tid >> 6, r = lane & 31, hh = lane >> 5, G = ogrid();
    const int ntask = 8 * (N >> 5);
    float* part = (float*)lds;
    for (int task = obid(); task < ntask; task += G) {
        const int cb = (task & 7) + 8 * (task >> 6), rb = (task >> 3) & 7, row0 = MP + rb * 32, col0 = cb * 32;
#pragma unroll
        for (int pass = 0; pass < (KIND == 2 ? 2 : 1); ++pass) {
            const bf16_t* ap = A + pass * 512 + (long)(row0 + r) * lda + w * (KSTEPS * 16) + 8 * hh;
            const bf16_t* bp = (pass ? P->WpbT : Bt) + (long)(col0 + r) * ldb + w * (KSTEPS * 16) + 8 * hh;
            f32x16 acc;
#pragma unroll
            for (int i = 0; i < 16; ++i) acc[i] = 0.f;
            constexpr int UN = KSTEPS > 11 ? 11 : KSTEPS;
#pragma unroll 1
            for (int s0 = 0; s0 < KSTEPS; s0 += UN) {
                bf16x8 af[UN], bf[UN];
#pragma unroll
                for (int s = 0; s < UN; ++s) { af[s] = *(const bf16x8*)(ap + (s0 + s) * 16); bf[s] = *(const bf16x8*)(bp + (s0 + s) * 16); }
#pragma unroll
                for (int s = 0; s < UN; ++s) acc = MFMA32(bf[s], af[s], acc);
            }
            float* pp = part + ((pass * 8 + w) * 32 + r) * 32 + 4 * hh;
#pragma unroll
            for (int g = 0; g < 4; ++g) *(f32x4*)(pp + 8 * g) = (f32x4){acc[4 * g], acc[4 * g + 1], acc[4 * g + 2], acc[4 * g + 3]};
        }
        __syncthreads();
        {
            const int e = tid * 2, rr = e >> 5, cc = e & 31;
            f32x2 s1 = {0.f, 0.f}, s2 = {0.f, 0.f};
#pragma unroll
            for (int ww = 0; ww < 8; ++ww) { s1 += *(const f32x2*)(part + (ww * 32 + rr) * 32 + cc); if (KIND == 2) s2 += *(const f32x2*)(part + ((8 + ww) * 32 + rr) * 32 + cc); }
            const long row = row0 + rr; const int col = col0 + cc;
            if (KIND == 1) { s1[0] = sigmoidf_(s1[0]); s1[1] = sigmoidf_(s1[1]); }
            if (KIND == 2) { const unsigned ga = *(const unsigned*)(P->gates + row * 2048 + col), gb = *(const unsigned*)(P->gates + row * 2048 + 1024 + col);
                s1[0] = s1[0] * bf_lo(ga) + s2[0] * bf_lo(gb); s1[1] = s1[1] * bf_hi(ga) + s2[1] * bf_hi(gb); }
            *(unsigned*)(C + row * ldc + col) = pk2(s1[0], s1[1]);
        }
        __syncthreads();
    }
}

DI int crow(int i, int h) { return (i & 3) + 8 * (i >> 2) + 4 * h; }

template <int MODE, bool F32P>
DI void attn_unit(KP P, char* lds, bool sample, int b, int h, int ublk) {
    constexpr int DQK = MODE == 0 ? 96 : 64, KS = DQK * 2 + 16, VS = 144, NS = DQK / 16;
    constexpr int KBYTES = 64 * KS, BUF = KBYTES + 64 * VS;
    const int tid = otid(), w = tid >> 6, lane = tid & 63, ql = lane & 31, hh = lane >> 5;
    const int kvrow0 = sample ? MP + b * SKEYS : b * TP;
    const int qrow0 = sample ? MP + b * 32 : b * TP + ublk * 256;
    const int ntiles = sample ? 65 : 4 * (ublk + 1);
    const int t0 = sample ? 0 : ublk * 256 + w * 32, tq = t0 + ql;
    int klim, wmax, wmin;
    if (MODE == 0) { if (sample) { klim = wmax = wmin = SKEYS; } else { klim = ((tq >> 6) + 1) << 6; wmax = (((t0 + 31) >> 6) + 1) << 6; wmin = ((t0 >> 6) + 1) << 6; } }
    else { if (sample) { klim = PAST + tq; wmax = PAST + 31; wmin = PAST; } else { klim = tq; wmax = t0 + 31; wmin = t0; } }
    const bool wactive = sample ? (w == 0) : true;
    const bf16_t* Kp; const bf16_t* Qp; const bf16_t* VT; int ldq; long ldv;
    if (MODE == 0) { Kp = P->kva + (long)kvrow0 * 512 + h * 64; Qp = P->q + (long)qrow0 * 768 + h * 96; ldq = 768;
        VT = sample ? P->vaT_s + (long)(b * 512 + h * 64) * SKP : P->vaT_p + (long)(b * 512 + h * 64) * TP; }
    else { Kp = P->kb + (long)kvrow0 * 512 + h * 64; Qp = P->qb + (long)qrow0 * 512 + h * 64; ldq = 512;
        VT = sample ? P->vbT_s + (long)(b * 512 + h * 64) * SKP : P->vbT_p + (long)(b * 512 + h * 64) * TP; }
    ldv = sample ? SKP : TP;
    const bf16_t* Kr = P->krope + (long)kvrow0 * 32;

    bf16x8 qf[NS];
    if (wactive) {
        const bf16_t* qp = Qp + (long)(w * 32 + ql) * ldq + 8 * hh;
#pragma unroll
        for (int s = 0; s < NS; ++s) qf[s] = *(const bf16x8*)(qp + 16 * s);
    } else {
#pragma unroll
        for (int s = 0; s < NS; ++s) qf[s] = (bf16x8){0, 0, 0, 0, 0, 0, 0, 0};
    }
    f32x16 O0, O1;
#pragma unroll
    for (int i = 0; i < 16; ++i) { O0[i] = 0.f; O1[i] = 0.f; }
    float mrun = -INFINITY, lrun = 0.f, carry = 0.f;
    bool wdone = !wactive;
    volatile int* flags = (volatile int*)(lds + 65536 + 64);

    u32x4 rk0, rk1, rv; f32x4 fa0, fa1, fc0, fc1;
    const int krow_s = tid >> 3, kc_s = tid & 7, rrow_s = tid >> 2, rc_s = tid & 3;
    const float* Kf = P->c_sbk + ((long)b * PAST * 512 + h * 64); const float* Vf = P->c_sbv + ((long)b * PAST * 512 + h * 64);
    auto load_bf = [&](int kt) {
        rk0 = *(const u32x4*)(Kp + (long)(kt * 64 + krow_s) * 512 + kc_s * 8);
        if (MODE == 0 && tid < 256) rk1 = *(const u32x4*)(Kr + (long)(kt * 64 + rrow_s) * 32 + rc_s * 8);
        rv = *(const u32x4*)(VT + (long)krow_s * ldv + kt * 64 + kc_s * 8);
    };
    auto store_bf = [&](int buf) {
        char* kb_ = lds + buf * BUF; char* vb_ = kb_ + KBYTES;
        *(u32x4*)(kb_ + krow_s * KS + kc_s * 16) = rk0;
        if (MODE == 0 && tid < 256) *(u32x4*)(kb_ + rrow_s * KS + 128 + rc_s * 16) = rk1;
        *(u32x4*)(vb_ + krow_s * VS + kc_s * 16) = rv;
    };
    auto load_f32 = [&](int kt) {
        const float* kp_ = Kf + (long)(kt * 64 + krow_s) * 512 + kc_s * 8; const float* vp_ = Vf + (long)(kt * 64 + krow_s) * 512 + kc_s * 8;
        fa0 = *(const f32x4*)kp_; fa1 = *(const f32x4*)(kp_ + 4); fc0 = *(const f32x4*)vp_; fc1 = *(const f32x4*)(vp_ + 4);
    };
    auto store_f32 = [&](int buf) {
        char* kb_ = lds + buf * BUF; char* vb_ = kb_ + KBYTES;
        u32x4 kk, vv;
        kk.x = pk2(fa0[0], fa0[1]); kk.y = pk2(fa0[2], fa0[3]); kk.z = pk2(fa1[0], fa1[1]); kk.w = pk2(fa1[2], fa1[3]);
        vv.x = pk2(fc0[0], fc0[1]); vv.y = pk2(fc0[2], fc0[3]); vv.z = pk2(fc1[0], fc1[1]); vv.w = pk2(fc1[2], fc1[3]);
        *(u32x4*)(kb_ + krow_s * KS + kc_s * 16) = kk;
#pragma unroll
        for (int e = 0; e < 4; ++e) { *(bf16_t*)(vb_ + (kc_s * 8 + 2 * e) * VS + krow_s * 2) = (bf16_t)(vv[e] & 0xffff); *(bf16_t*)(vb_ + (kc_s * 8 + 2 * e + 1) * VS + krow_s * 2) = (bf16_t)(vv[e] >> 16); }
    };
    load_bf(ntiles - 1); store_bf(0);
    __syncthreads();
    for (int it = 0; it < ntiles; ++it) {
        const int kt = ntiles - 1 - it, cur = it & 1;
        if (it + 1 < ntiles) { if (F32P) load_f32(kt - 1); else load_bf(kt - 1); }
        if (wactive && !wdone && kt * 64 < wmax) {
            const char* kb_ = lds + cur * BUF; const char* vb_ = kb_ + KBYTES;
            f32x16 S0, S1;
#pragma unroll
            for (int i = 0; i < 16; ++i) { S0[i] = 0.f; S1[i] = 0.f; }
#pragma unroll
            for (int s = 0; s < NS; ++s) {
                const bf16x8 k0 = *(const bf16x8*)(kb_ + ql * KS + (16 * s + 8 * hh) * 2);
                const bf16x8 k1 = *(const bf16x8*)(kb_ + (32 + ql) * KS + (16 * s + 8 * hh) * 2);
                S0 = MFMA32(k0, qf[s], S0); S1 = MFMA32(k1, qf[s], S1);
            }
            const bool need_mask = (kt * 64 + 64 > wmin);
            const int kbase = kt * 64 + 4 * hh;
            if (MODE == 0) {
                if (need_mask) {
#pragma unroll
                    for (int i = 0; i < 16; ++i) { const int key = kbase + (i & 3) + 8 * (i >> 2);
                        if (key >= klim) S0[i] = -INFINITY; if (key + 32 >= klim) S1[i] = -INFINITY; }
                }
                float mx = S0[0];
#pragma unroll
                for (int i = 1; i < 16; ++i) mx = fmaxf(mx, S0[i]);
#pragma unroll
                for (int i = 0; i < 16; ++i) mx = fmaxf(mx, S1[i]);
                mx = fmaxf(mx, __shfl_xor(mx, 32));
                const float mnew = fmaxf(mrun, mx);
                const float alpha = __builtin_amdgcn_exp2f(mrun - mnew);
                mrun = mnew;
                float ps = 0.f;
#pragma unroll
                for (int i = 0; i < 16; ++i) { S0[i] = __builtin_amdgcn_exp2f(S0[i] - mnew); S1[i] = __builtin_amdgcn_exp2f(S1[i] - mnew); ps += S0[i] + S1[i]; }
                lrun = lrun * alpha + ps;
#pragma unroll
                for (int i = 0; i < 16; ++i) { O0[i] *= alpha; O1[i] *= alpha; }
            } else {
                float gs[2][4], gp[2][4];
                f32x16 SP0, SP1;
#pragma unroll
                for (int i = 0; i < 16; ++i) { const int key = kbase + (i & 3) + 8 * (i >> 2);
                    { const float z = S0[i]; const float t = __builtin_amdgcn_exp2f(-fabsf(z) * LOG2E); float sp = fmaxf(z, 0.f) + LN2 * __builtin_amdgcn_logf(1.0f + t);
                      if (need_mask && key >= klim) sp = 0.f; SP0[i] = sp; }
                    { const float z = S1[i]; const float t = __builtin_amdgcn_exp2f(-fabsf(z) * LOG2E); float sp = fmaxf(z, 0.f) + LN2 * __builtin_amdgcn_logf(1.0f + t);
                      if (need_mask && key + 32 >= klim) sp = 0.f; SP1[i] = sp; } }
#pragma unroll
                for (int g = 0; g < 4; ++g) { gs[0][g] = (SP0[4 * g] + SP0[4 * g + 1]) + (SP0[4 * g + 2] + SP0[4 * g + 3]);
                    gs[1][g] = (SP1[4 * g] + SP1[4 * g + 1]) + (SP1[4 * g + 2] + SP1[4 * g + 3]); }
#pragma unroll
                for (int g = 0; g < 4; ++g) { gp[0][g] = __shfl_xor(gs[0][g], 32); gp[1][g] = __shfl_xor(gs[1][g], 32); }
                float running = carry;
#pragma unroll
                for (int blk = 1; blk >= 0; --blk)
#pragma unroll
                    for (int g = 3; g >= 0; --g) {
                        const float sum1 = hh ? gs[blk][g] : gp[blk][g], sum0 = hh ? gp[blk][g] : gs[blk][g];
                        const float mybase = hh ? running : running + sum1;
                        running += sum0 + sum1;
                        float later = mybase;
#pragma unroll
                        for (int j = 3; j >= 0; --j) { const int i = 4 * g + j; const int key = kbase + j + 8 * g + 32 * blk;
                            const float z = blk ? S1[i] : S0[i], sp = blk ? SP1[i] : SP0[i];
                            float a = __builtin_amdgcn_exp2f((z - sp - later) * LOG2E);
                            if (need_mask && key >= klim) a = 0.f;
                            later += sp;
                            if (blk) S1[i] = a; else S0[i] = a; }
                    }
                carry = running;
                wdone = __all((carry > 104.0f) || (klim <= 0));
            }
            bf16x8 pf[2][2];
#pragma unroll
            for (int s = 0; s < 2; ++s) {
                u32x4 a, c;
                a.x = pk2(S0[8 * s], S0[8 * s + 1]); a.y = pk2(S0[8 * s + 2], S0[8 * s + 3]); a.z = pk2(S0[8 * s + 4], S0[8 * s + 5]); a.w = pk2(S0[8 * s + 6], S0[8 * s + 7]);
                c.x = pk2(S1[8 * s], S1[8 * s + 1]); c.y = pk2(S1[8 * s + 2], S1[8 * s + 3]); c.z = pk2(S1[8 * s + 4], S1[8 * s + 5]); c.w = pk2(S1[8 * s + 6], S1[8 * s + 7]);
                pf[0][s] = __builtin_bit_cast(bf16x8, a); pf[1][s] = __builtin_bit_cast(bf16x8, c);
            }
#pragma unroll
            for (int blk = 0; blk < 2; ++blk)
#pragma unroll
                for (int s = 0; s < 2; ++s) {
                    const int koff = (32 * blk + 16 * s + 4 * hh) * 2;
                    const s16x4 lo0 = *(const s16x4*)(vb_ + ql * VS + koff), hi0 = *(const s16x4*)(vb_ + ql * VS + koff + 16);
                    const s16x4 lo1 = *(const s16x4*)(vb_ + (32 + ql) * VS + koff), hi1 = *(const s16x4*)(vb_ + (32 + ql) * VS + koff + 16);
                    const bf16x8 v0 = __builtin_shufflevector(lo0, hi0, 0, 1, 2, 3, 4, 5, 6, 7), v1 = __builtin_shufflevector(lo1, hi1, 0, 1, 2, 3, 4, 5, 6, 7);
                    O0 = MFMA32(v0, pf[blk][s], O0); O1 = MFMA32(v1, pf[blk][s], O1);
                }
        }
        if (it + 1 < ntiles) { if (F32P) store_f32(cur ^ 1); else store_bf(cur ^ 1); }
        if (MODE == 1 && lane == 0) flags[(it & 1) * 8 + w] = wdone ? 1 : 0;
        __syncthreads();
        if (MODE == 1) { int alld = 1;
#pragma unroll
            for (int ww = 0; ww < 8; ++ww) alld &= flags[(it & 1) * 8 + ww];
            if (alld) break; }
    }
    if (wactive) {
        float inv = 1.0f;
        if (MODE == 0) { const float lt = lrun + __shfl_xor(lrun, 32); inv = 1.0f / lt; }
        bf16_t* op = P->o + (long)(qrow0 + w * 32 + ql) * 1024 + (MODE == 0 ? 0 : 512) + h * 64 + 4 * hh;
#pragma unroll
        for (int g = 0; g < 4; ++g) {
            f32x4 a = {O0[4 * g] * inv, O0[4 * g + 1] * inv, O0[4 * g + 2] * inv, O0[4 * g + 3] * inv};
            f32x4 c = {O1[4 * g] * inv, O1[4 * g + 1] * inv, O1[4 * g + 2] * inv, O1[4 * g + 3] * inv};
            store_bf4(op + 8 * g, a); store_bf4(op + 32 + 8 * g, c);
        }
    }
}

DI void attn_mla128(KP P, char* lds, bool sample, int b, int h, int ublk) {
    constexpr int KS = 208, VS = 272, KBYTES = 128 * KS, BUF = KBYTES + 64 * VS;
    const int tid = otid(), w = tid >> 6, lane = tid & 63, ql = lane & 31, hh = lane >> 5;
    const int kvrow0 = sample ? MP + b * SKEYS : b * TP;
    const int qrow0 = sample ? MP + b * 32 : b * TP + ublk * 256;
    const int ntiles = sample ? 33 : 2 * (ublk + 1);
    const int t0 = sample ? 0 : ublk * 256 + w * 32;
    const int wmax = sample ? SKEYS : ((((t0 + 31) >> 6) + 1) << 6);
    const bool wactive = sample ? (w == 0) : true;
    const bf16_t* Kp = P->kva + (long)kvrow0 * 512 + h * 64; const bf16_t* Qp = P->q + (long)qrow0 * 768 + h * 96;
    const bf16_t* VT = sample ? P->vaT_s + (long)(b * 512 + h * 64) * SKP : P->vaT_p + (long)(b * 512 + h * 64) * TP;
    const long ldv = sample ? SKP : TP;
    const bf16_t* Kr = P->krope + (long)kvrow0 * 32;
    bf16x8 qf[6];
    if (wactive) { const bf16_t* qp = Qp + (long)(w * 32 + ql) * 768 + 8 * hh;
#pragma unroll
        for (int s = 0; s < 6; ++s) qf[s] = *(const bf16x8*)(qp + 16 * s); }
    else {
#pragma unroll
        for (int s = 0; s < 6; ++s) qf[s] = (bf16x8){0, 0, 0, 0, 0, 0, 0, 0}; }
    f32x16 O0, O1;
#pragma unroll
    for (int i = 0; i < 16; ++i) { O0[i] = 0.f; O1[i] = 0.f; }
    float mrun = -INFINITY, lrun = 0.f;
    u32x4 rk[2], rr, rv[2];
    auto load_tile = [&](int kt) {
#pragma unroll
        for (int i = 0; i < 2; ++i) { const int c = tid + i * 512;
            rk[i] = *(const u32x4*)(Kp + (long)(kt * 128 + (c >> 3)) * 512 + (c & 7) * 8);
            rv[i] = *(const u32x4*)(VT + (long)(c >> 4) * ldv + kt * 128 + (c & 15) * 8); }
        rr = *(const u32x4*)(Kr + (long)(kt * 128 + (tid >> 2)) * 32 + (tid & 3) * 8);
    };
    auto store_tile = [&](int buf) {
        char* kb_ = lds + buf * BUF; char* vb_ = kb_ + KBYTES;
#pragma unroll
        for (int i = 0; i < 2; ++i) { const int c = tid + i * 512;
            *(u32x4*)(kb_ + (c >> 3) * KS + (c & 7) * 16) = rk[i];
            *(u32x4*)(vb_ + (c >> 4) * VS + (c & 15) * 16) = rv[i]; }
        *(u32x4*)(kb_ + (tid >> 2) * KS + 128 + (tid & 3) * 16) = rr;
    };
    load_tile(ntiles - 1); store_tile(0);
    __syncthreads();
    for (int it = 0; it < ntiles; ++it) {
        const int kt = ntiles - 1 - it, cur = it & 1;
        if (it + 1 < ntiles) load_tile(kt - 1);
        if (wactive && kt * 128 < wmax) {
            const char* kb_ = lds + cur * BUF; const char* vb_ = kb_ + KBYTES;
            const int nblk = (wmax - kt * 128) >> 5;
            f32x16 S[4];
#pragma unroll
            for (int blk = 0; blk < 4; ++blk) {
#pragma unroll
                for (int i = 0; i < 16; ++i) S[blk][i] = 0.f;
#pragma unroll
                for (int s = 0; s < 6; ++s) { const bf16x8 kf = *(const bf16x8*)(kb_ + (32 * blk + ql) * KS + (16 * s + 8 * hh) * 2); S[blk] = MFMA32(kf, qf[s], S[blk]); }
            }
            if (nblk < 4) {
#pragma unroll
                for (int blk = 1; blk < 4; ++blk) if (blk >= nblk) {
#pragma unroll
                    for (int i = 0; i < 16; ++i) S[blk][i] = -INFINITY; }
            }
            float mx = S[0][0];
#pragma unroll
            for (int blk = 0; blk < 4; ++blk)
#pragma unroll
                for (int i = 0; i < 16; ++i) mx = fmaxf(mx, S[blk][i]);
            mx = fmaxf(mx, __shfl_xor(mx, 32));
            const float mnew = fmaxf(mrun, mx);
            const float alpha = __builtin_amdgcn_exp2f(mrun - mnew);
            mrun = mnew;
            float ps = 0.f;
#pragma unroll
            for (int blk = 0; blk < 4; ++blk)
#pragma unroll
                for (int i = 0; i < 16; ++i) { S[blk][i] = __builtin_amdgcn_exp2f(S[blk][i] - mnew); ps += S[blk][i]; }
            lrun = lrun * alpha + ps;
#pragma unroll
            for (int i = 0; i < 16; ++i) { O0[i] *= alpha; O1[i] *= alpha; }
#pragma unroll
            for (int blk = 0; blk < 4; ++blk)
#pragma unroll
                for (int s = 0; s < 2; ++s) {
                    u32x4 a;
                    a.x = pk2(S[blk][8 * s], S[blk][8 * s + 1]); a.y = pk2(S[blk][8 * s + 2], S[blk][8 * s + 3]); a.z = pk2(S[blk][8 * s + 4], S[blk][8 * s + 5]); a.w = pk2(S[blk][8 * s + 6], S[blk][8 * s + 7]);
                    const bf16x8 pf = __builtin_bit_cast(bf16x8, a);
                    const int koff = (32 * blk + 16 * s + 4 * hh) * 2;
                    const s16x4 lo0 = *(const s16x4*)(vb_ + ql * VS + koff), hi0 = *(const s16x4*)(vb_ + ql * VS + koff + 16);
                    const s16x4 lo1 = *(const s16x4*)(vb_ + (32 + ql) * VS + koff), hi1 = *(const s16x4*)(vb_ + (32 + ql) * VS + koff + 16);
                    const bf16x8 v0 = __builtin_shufflevector(lo0, hi0, 0, 1, 2, 3, 4, 5, 6, 7), v1 = __builtin_shufflevector(lo1, hi1, 0, 1, 2, 3, 4, 5, 6, 7);
                    O0 = MFMA32(v0, pf, O0); O1 = MFMA32(v1, pf, O1);
                }
        }
        if (it + 1 < ntiles) store_tile(cur ^ 1);
        __syncthreads();
    }
    if (wactive) {
        const float lt = lrun + __shfl_xor(lrun, 32); const float inv = 1.0f / lt;
        bf16_t* op = P->o + (long)(qrow0 + w * 32 + ql) * 1024 + h * 64 + 4 * hh;
#pragma unroll
        for (int g = 0; g < 4; ++g) {
            f32x4 a = {O0[4 * g] * inv, O0[4 * g + 1] * inv, O0[4 * g + 2] * inv, O0[4 * g + 3] * inv};
            f32x4 c = {O1[4 * g] * inv, O1[4 * g + 1] * inv, O1[4 * g + 2] * inv, O1[4 * g + 3] * inv};
            store_bf4(op + 8 * g, a); store_bf4(op + 32 + 8 * g, c);
        }
    }
}

DI void attn_phase(KP P, char* lds, int cidx) {
    unsigned* slot = (unsigned*)(lds + 131072 + 3072);
    for (;;) {
        if (threadIdx.x == 0) *slot = atomicAdd(P->ctr + cidx, 1u);
        __syncthreads();
        const unsigned idx = *slot;
        __syncthreads();
        if (idx >= 1152u) break;
        bool sample; int mode, b, h, ublk = 0;
        if (idx < 128u) { sample = true; mode = idx >> 6; b = (idx >> 3) & 7; h = idx & 7; }
        else { const int j = idx - 128; sample = false; ublk = 31 - (j >> 5); const int r = j & 31; mode = r >> 4; b = (r >> 3) & 1; h = r & 7; }
        if (mode == 0) attn_mla128(P, lds, sample, b, h, ublk); else if (sample) attn_unit<1, true>(P, lds, true, b, h, ublk); else attn_unit<1, false>(P, lds, false, b, h, ublk);
    }
}

DI void tconv_tiles(KP P, char* lds, int it0, int itstep, int it_end) {
    const int tid = otid();
    float* tile = (float*)lds;
        for (int it = it0; it < it_end; it += itstep) {
            int j = 0;
#pragma unroll
            for (int q = 1; q < 16; ++q) if (it >= P->tj[q].tile0) j = q;
            TJob J; J.src = P->tj[j].src; J.kscale = P->tj[j].kscale; J.dst = P->tj[j].dst; J.lds = P->tj[j].lds; J.coff = P->tj[j].coff; J.ldd = P->tj[j].ldd;
            J.Klen = P->tj[j].Klen; J.Nlen = P->tj[j].Nlen; J.zero = P->tj[j].zero; J.tile0 = P->tj[j].tile0;
            const int lt = it - J.tile0, nk = J.Klen >> 6, tk = lt % nk, tn = lt / nk, k0 = tk * 64, n0 = tn * 256;
            f32x4 lv[8];
#pragma unroll
            for (int r = 0; r < 8; ++r) { const int e = tid + r * NTHREADS, kk = e >> 6, n4 = (e & 63) * 4;
                lv[r] = (f32x4){0.f, 0.f, 0.f, 0.f};
                if (J.zero == 2) { const int nn_ = n0 + n4, sc_ = (nn_ >> 8) * 128 + (nn_ & 127) + ((nn_ >> 7) & 1) * DFF;
                    lv[r] = *(const f32x4*)(J.src + (long)(k0 + kk) * J.lds + sc_); }
                else if (!J.zero && n0 + n4 < J.Nlen) lv[r] = *(const f32x4*)(J.src + (long)(k0 + kk) * J.lds + J.coff + n0 + n4); }
#pragma unroll
            for (int r = 0; r < 8; ++r) { const int e = tid + r * NTHREADS, kk = e >> 6, n4 = (e & 63) * 4;
                f32x4 v = lv[r]; if (J.kscale) v *= J.kscale[k0 + kk];
                float* tp = tile + kk * 257 + n4; tp[0] = v[0]; tp[1] = v[1]; tp[2] = v[2]; tp[3] = v[3]; }
            __syncthreads();
#pragma unroll
            for (int r = 0; r < 4; ++r) { const int e = tid + r * NTHREADS, nn = e >> 3, kc = (e & 7) * 8;
                if (n0 + nn < J.Nlen) { const float* tp = tile + kc * 257 + nn; u32x4 o;
                    o.x = pk2(tp[0], tp[257]); o.y = pk2(tp[2 * 257], tp[3 * 257]); o.z = pk2(tp[4 * 257], tp[5 * 257]); o.w = pk2(tp[6 * 257], tp[7 * 257]);
                    *(u32x4*)(J.dst + (long)(n0 + nn) * J.ldd + k0 + kc) = o; } }
            __syncthreads();
        }
}

DI void phase0(KP P, char* lds) {
    const int tid = otid(), G = ogrid(), bid = obid(), w = tid >> 6, lane = tid & 63;
    for (int item = bid; item < 96; item += G) {
        float* sc = (float*)lds; float* red = (float*)(lds + 40960);
        for (int i = tid; i < 10240; i += NTHREADS) { const int bb = i >> 10, k = i & 1023; const float cv = bb < 2 ? P->c_p[bb * 1024 + k] : P->c_s[(bb - 2) * 1024 + k]; sc[i] = cv / (1.0f + __expf(-cv)); }
        __syncthreads();
        const int col = item * 64 + lane;
        float a0 = 0, a1 = 0, a2 = 0, a3 = 0, a4 = 0, a5 = 0, a6 = 0, a7 = 0, a8 = 0, a9 = 0;
        for (int k0 = w * 128; k0 < w * 128 + 128; k0 += 16) {
            float wv[16];
#pragma unroll
            for (int j = 0; j < 16; ++j) wv[j] = P->w_ada[(long)(k0 + j) * 6144 + col];
#pragma unroll
            for (int j = 0; j < 16; ++j) { const int k = k0 + j;
                a0 += sc[k] * wv[j]; a1 += sc[1024 + k] * wv[j]; a2 += sc[2048 + k] * wv[j]; a3 += sc[3072 + k] * wv[j]; a4 += sc[4096 + k] * wv[j];
                a5 += sc[5120 + k] * wv[j]; a6 += sc[6144 + k] * wv[j]; a7 += sc[7168 + k] * wv[j]; a8 += sc[8192 + k] * wv[j]; a9 += sc[9216 + k] * wv[j]; }
        }
        float* rr = red + w * 640 + lane;
        rr[0] = a0; rr[64] = a1; rr[128] = a2; rr[192] = a3; rr[256] = a4; rr[320] = a5; rr[384] = a6; rr[448] = a7; rr[512] = a8; rr[576] = a9;
        __syncthreads();
        for (int i = tid; i < 640; i += NTHREADS) { float s = 0.f; for (int ww = 0; ww < 8; ++ww) s += red[ww * 640 + i];
            const int bb = i >> 6, l = i & 63; P->ada[bb * 6144 + item * 64 + l] = s + P->b_ada[item * 64 + l]; }
        __syncthreads();
    }
    tconv_tiles(P, lds, (bid + 96) % G, G, P->ntj_early);
    const long gt = (long)bid * NTHREADS + tid, gn = (long)G * NTHREADS;
    for (long i0 = gt; i0 < 8L * PAST * 64; i0 += 4 * gn) { f32x4 v[4];
#pragma unroll
        for (int r = 0; r < 4; ++r) { const long i = i0 + r * gn; if (i < 8L * PAST * 64) v[r] = *(const f32x4*)(P->c_ckv + i * 4); }
#pragma unroll
        for (int r = 0; r < 4; ++r) { const long i = i0 + r * gn; if (i < 8L * PAST * 64) { const long row = i >> 6; const int c = (int)(i & 63) * 4; const int bb = (int)(row >> 12), sq = (int)(row & 4095);
            store_bf4(P->latent + (long)(MP + bb * SKEYS + sq) * 256 + c, v[r]); } } }
    for (long i0 = gt; i0 < 8L * PAST * 8; i0 += 4 * gn) { f32x4 v[4];
#pragma unroll
        for (int r = 0; r < 4; ++r) { const long i = i0 + r * gn; if (i < 8L * PAST * 8) v[r] = *(const f32x4*)(P->c_kr + i * 4); }
#pragma unroll
        for (int r = 0; r < 4; ++r) { const long i = i0 + r * gn; if (i < 8L * PAST * 8) { const long row = i >> 3; const int c = (int)(i & 7) * 4; const int bb = (int)(row >> 12), sq = (int)(row & 4095);
            store_bf4(P->krope + (long)(MP + bb * SKEYS + sq) * 32 + c, v[r]); } } }
    for (long i = gt; i < 8L * 512 * 8; i += gn) { const long r = i >> 3; const int c = (int)(i & 7) * 4; const u32x2 z = {0u, 0u};
        *(u32x2*)(P->vaT_s + r * SKP + SKEYS + c) = z; *(u32x2*)(P->vbT_s + r * SKP + SKEYS + c) = z; }
    for (long i = gt; i < (long)TP * 16; i += gn) { const int pos = (int)(i >> 4), fi = (int)(i & 15);
        const float inv = exp2f(-(float)fi * (13.287712379549449f / 16.0f));
        const float ang = (float)pos * inv;
        const double rev = (double)ang * 0.15915494309189535; const float fr_ = (float)(rev - floor(rev));
        P->ropeT[i * 2] = __builtin_amdgcn_cosf(fr_); P->ropeT[i * 2 + 1] = __builtin_amdgcn_sinf(fr_); }
}

DI void phase_h(KP P) {
    const int tid_ = otid(), lane = tid_ & 63, gw = obid() * 8 + (tid_ >> 6), nw = ogrid() * 8;
    for (int row = gw; row < MT; row += nw) {
        const float* xr = row < MP ? P->x_p + (long)row * DM : P->x_s + (long)(row - MP) * DM;
        const float* ad = P->ada + ada_b(row) * 6144;
        f32x4 v[4]; float s = 0.f;
#pragma unroll
        for (int i = 0; i < 4; ++i) { v[i] = *(const f32x4*)(xr + i * 256 + lane * 4); s += v[i][0] * v[i][0] + v[i][1] * v[i][1] + v[i][2] * v[i][2] + v[i][3] * v[i][3]; }
#pragma unroll
        for (int o = 1; o < 64; o <<= 1) s += __shfl_xor(s, o);
        const float rstd = rsqrtf(s * (1.0f / DM) + EPS);
#pragma unroll
        for (int i = 0; i < 4; ++i) { const int c = i * 256 + lane * 4;
            const f32x4 g = *(const f32x4*)(P->g_pre_mix + c), sh = *(const f32x4*)(ad + c), scl = *(const f32x4*)(ad + 1024 + c);
            store_bf4(P->h + (long)row * DM + c, v[i] * rstd * g * (1.0f + scl) + sh); }
    }
}

DI void phase_mid(KP P) {
    const int tid_ = otid(), lane = tid_ & 63, gw = obid() * 8 + (tid_ >> 6), nw = ogrid() * 8;
    for (int row = gw; row < MT; row += nw) {
        const float* xr = row < MP ? P->x_p + (long)row * DM : P->x_s + (long)(row - MP) * DM;
        const float* ad = P->ada + ada_b(row) * 6144;
        f32x4 mv[4]; float s = 0.f;
#pragma unroll
        for (int i = 0; i < 4; ++i) { const u32x2 wv = *(const u32x2*)(P->m2 + (long)row * DM + i * 256 + lane * 4);
            mv[i] = (f32x4){bf_lo(wv.x), bf_hi(wv.x), bf_lo(wv.y), bf_hi(wv.y)}; s += mv[i][0] * mv[i][0] + mv[i][1] * mv[i][1] + mv[i][2] * mv[i][2] + mv[i][3] * mv[i][3]; }
#pragma unroll
        for (int o = 1; o < 64; o <<= 1) s += __shfl_xor(s, o);
        const float rstd = rsqrtf(s * (1.0f / DM) + EPS);
        float s2 = 0.f;
#pragma unroll
        for (int i = 0; i < 4; ++i) { const int c = i * 256 + lane * 4;
            const f32x4 xv = *(const f32x4*)(xr + c), g = *(const f32x4*)(P->g_post_mix + c), gt = *(const f32x4*)(ad + 2048 + c);
            mv[i] = xv + gt * (mv[i] * rstd * g);
            *(f32x4*)(P->out + O_Y + (long)row * DM + c) = mv[i];
            s2 += mv[i][0] * mv[i][0] + mv[i][1] * mv[i][1] + mv[i][2] * mv[i][2] + mv[i][3] * mv[i][3]; }
#pragma unroll
        for (int o = 1; o < 64; o <<= 1) s2 += __shfl_xor(s2, o);
        const float rstd2 = rsqrtf(s2 * (1.0f / DM) + EPS);
#pragma unroll
        for (int i = 0; i < 4; ++i) { const int c = i * 256 + lane * 4;
            const f32x4 g = *(const f32x4*)(P->g_pre_ffn + c), sh = *(const f32x4*)(ad + 3072 + c), scl = *(const f32x4*)(ad + 4096 + c);
            store_bf4(P->h2 + (long)row * DM + c, mv[i] * rstd2 * g * (1.0f + scl) + sh); }
    }
}

DI void phase_final(KP P) {
    const int tid_ = otid(), lane = tid_ & 63, gw = obid() * 8 + (tid_ >> 6), nw = ogrid() * 8;
    for (int row = gw; row < MT; row += nw) {
        const float* ad = P->ada + ada_b(row) * 6144;
        f32x4 fv[4]; float s = 0.f;
#pragma unroll
        for (int i = 0; i < 4; ++i) { const u32x2 wv = *(const u32x2*)(P->f + (long)row * DM + i * 256 + lane * 4);
            fv[i] = (f32x4){bf_lo(wv.x), bf_hi(wv.x), bf_lo(wv.y), bf_hi(wv.y)}; s += fv[i][0] * fv[i][0] + fv[i][1] * fv[i][1] + fv[i][2] * fv[i][2] + fv[i][3] * fv[i][3]; }
#pragma unroll
        for (int o = 1; o < 64; o <<= 1) s += __shfl_xor(s, o);
        const float rstd = rsqrtf(s * (1.0f / DM) + EPS);
#pragma unroll
        for (int i = 0; i < 4; ++i) { const int c = i * 256 + lane * 4; float* yp = P->out + O_Y + (long)row * DM + c;
            const f32x4 xv = *(const f32x4*)yp, g = *(const f32x4*)(P->g_post_ffn + c), gt = *(const f32x4*)(ad + 5120 + c);
            *(f32x4*)yp = xv + gt * (fv[i] * rstd * g); }
    }
}


DI void load8(const bf16_t* p, float (&o)[8]) { const u32x4 w = *(const u32x4*)p;
#pragma unroll
    for (int e = 0; e < 4; ++e) { o[2 * e] = bf_lo(w[e]); o[2 * e + 1] = bf_hi(w[e]); } }
DI void phase_convfix(KP P) {
    const long gt = (long)obid() * NTHREADS + otid(), gn = (long)ogrid() * NTHREADS;
    for (long i = gt; i < 768L * 352; i += gn) {
        const int ri = (int)(i / 352), c = (int)(i % 352) * 8;
        float u0[2][8], u1[2][8], u2[2][8];
        long grow;
        if (ri < 512) {
            const int B = ri >> 1, rsel = ri & 1; const bool first = ((B * 64) & (TP - 1)) == 0; grow = (long)B * 64 + rsel;
            const bf16_t* cur = P->ub + (long)(B * 4) * DFF2 + c; const bf16_t* prv = P->ub + (long)((B > 0 ? B - 1 : 0) * 4) * DFF2 + c;
#pragma unroll
            for (int hf = 0; hf < 2; ++hf) {
                load8(cur + (long)(2 + rsel) * DFF2 + hf * DFF, u2[hf]);
                if (rsel == 0) { if (first) { for (int e = 0; e < 8; ++e) { u1[hf][e] = 0.f; u0[hf][e] = 0.f; } } else { load8(prv + (long)1 * DFF2 + hf * DFF, u1[hf]); load8(prv + hf * DFF, u0[hf]); } }
                else { load8(cur + (long)2 * DFF2 + hf * DFF, u1[hf]); if (first) { for (int e = 0; e < 8; ++e) u0[hf][e] = 0.f; } else load8(prv + (long)1 * DFF2 + hf * DFF, u0[hf]); }
            }
        } else {
            const int r = ri - 512, t = r & 31, bs = r >> 5; grow = (long)MP + r;
            const float* st = P->c_conv + (long)bs * 2 * DFF2 + c;
#pragma unroll
            for (int hf = 0; hf < 2; ++hf) {
                load8(P->u + (long)r * DFF2 + hf * DFF + c, u2[hf]);
                if (t >= 1) load8(P->u + (long)(r - 1) * DFF2 + hf * DFF + c, u1[hf]); else { for (int e = 0; e < 8; ++e) u1[hf][e] = st[DFF2 + hf * DFF + e]; }
                if (t >= 2) load8(P->u + (long)(r - 2) * DFF2 + hf * DFF + c, u0[hf]); else { for (int e = 0; e < 8; ++e) u0[hf][e] = st[(long)t * DFF2 + hf * DFF + e]; }
            }
        }
        float y[2][8];
#pragma unroll
        for (int hf = 0; hf < 2; ++hf)
#pragma unroll
            for (int e = 0; e < 8; ++e) { const int cc = hf * DFF + c + e;
                y[hf][e] = P->conv_b[cc] + P->conv_w[cc] * u0[hf][e] + P->conv_w[DFF2 + cc] * u1[hf][e] + P->conv_w[2 * DFF2 + cc] * u2[hf][e]; }
        u32x4 ov;
#pragma unroll
        for (int e = 0; e < 4; ++e) ov[e] = pk2(gelu_tanh(y[0][2 * e]) * y[1][2 * e], gelu_tanh(y[0][2 * e + 1]) * y[1][2 * e + 1]);
        *(u32x4*)(P->g + grow * DFF + c) = ov;
    }
}

#define XB_TMO      128
#define XB_XCNT(j)  (256  + 64 * (j))
#define XB_XSUB(j)  (1280 + 64 * (j))
#define XB_XGEN(j)  (2304 + 64 * (j))
#define XB_TOP      3328
#define XB_TOPGEN   3392
#define XCD_BAR_WORDS 3456
#define XB_SPIN_CAP (1u << 18)
DI unsigned xb_ld(unsigned* p)              { return __hip_atomic_load(p, __ATOMIC_RELAXED, __HIP_MEMORY_SCOPE_AGENT); }
DI unsigned xb_add(unsigned* p, unsigned v) { return __hip_atomic_fetch_add(p, v, __ATOMIC_RELAXED, __HIP_MEMORY_SCOPE_AGENT); }
DI unsigned xb_xcc_id() { return (unsigned)__builtin_amdgcn_s_getreg((3 << 11) | 20) & 0xFu; }
#define XB_SPIN(cond, bar) do { unsigned _sp = 0; while (cond) { __builtin_amdgcn_s_sleep(1); \
    if ((++_sp & 255u) == 0u) { if (xb_ld(&(bar)[XB_TMO])) break; if (_sp > XB_SPIN_CAP) { atomicAdd(&(bar)[XB_TMO], 1u); break; } } } } while (0)
DI void xcd_barrier_complete(unsigned* bar, unsigned x, unsigned& nloc, unsigned& nx) {
    const unsigned G = gridDim.x;
    unsigned sum, cnt, mine, sp = 0u;
    for (;;) {
        sum = 0u; cnt = 0u; mine = 0u;
#pragma unroll
        for (unsigned j = 0; j < 16; ++j) { const unsigned c = xb_ld(&bar[XB_XCNT(j)]); sum += c; cnt += (c > 0u) ? 1u : 0u; mine = (j == x) ? c : mine; }
        if (sum == G) break;
        __builtin_amdgcn_s_sleep(1);
        if ((++sp & 255u) == 0u) { if (xb_ld(&bar[XB_TMO])) break; if (sp > XB_SPIN_CAP) { atomicAdd(&bar[XB_TMO], 1u); break; } }
    }
    nloc = mine > 0u ? mine : 1u; nx = cnt > 0u ? cnt : 1u;
}
DI void grid_barrier(char* lds) {
    asm volatile("s_waitcnt vmcnt(0)" ::: "memory");
    __syncthreads();
    if (threadIdx.x == 0) {
        unsigned* bar = kparams()->bar; const unsigned x = xb_xcc_id();
        volatile LAS unsigned* st = (volatile LAS unsigned*)(lds + 131072 + 2048);
        __builtin_amdgcn_s_waitcnt(0);
        unsigned nloc = st[0], nx = st[1];
        if (nloc == 0u) { xcd_barrier_complete(bar, x, nloc, nx); st[0] = nloc; st[1] = nx; }
        const unsigned old = xb_add(&bar[XB_XSUB(x)], 1u);
        const unsigned gen = old / nloc;
        if (old + 1u == (gen + 1u) * nloc) {
            __builtin_amdgcn_fence(__ATOMIC_RELEASE, "agent");
            asm volatile("s_waitcnt vmcnt(0)" ::: "memory");
            const unsigned og = xb_add(&bar[XB_TOP], 1u);
            const unsigned tg = og / nx;
            if (og + 1u == (tg + 1u) * nx) xb_add(&bar[XB_TOPGEN], 1u);
            else XB_SPIN(xb_ld(&bar[XB_TOPGEN]) == tg, bar);
            __builtin_amdgcn_fence(__ATOMIC_ACQUIRE, "agent");
            xb_add(&bar[XB_XGEN(x)], 1u);
            asm volatile("s_waitcnt vmcnt(0)" ::: "memory");
        } else {
            XB_SPIN(xb_ld(&bar[XB_XGEN(x)]) == gen, bar);
            __builtin_amdgcn_fence(__ATOMIC_ACQUIRE, "agent");
            asm volatile("s_waitcnt vmcnt(0)" ::: "memory");
        }
    }
    __syncthreads();
}

__global__ void __launch_bounds__(NTHREADS) fwd_megakernel(Params Pval) {
    extern __shared__ __attribute__((aligned(16))) char lds[];
    cg::grid_group grid = cg::this_grid();
    const int lo = kparams()->phase_lo, hi = kparams()->phase_hi;
#define PH(n) if (lo <= (n) && (n) < hi)
#define SYNC(n) if (lo <= (n) && (n) + 1 < hi) grid_barrier(lds)
    if (hi > 1000) grid.sync();
    { volatile LAS unsigned* st = (volatile LAS unsigned*)(lds + 131072 + 2048);
      if (threadIdx.x == 0) { st[0] = 0u; st[1] = 0u; }
      __syncthreads();
      if (threadIdx.x == 0) (void)xb_add(&kparams()->bar[XB_XCNT(xb_xcc_id())], 1u); }
    PH(0) phase0(kparams(), lds);
#ifdef PROBE_P0
    __syncthreads(); phase0(kparams(), lds);
#endif
#ifdef PROBE_SYNC
    for (int i = 0; i < 24; ++i) grid_barrier(lds);
#endif
    SYNC(0);
    PH(1) phase_h(kparams());
#ifdef PROBE_ROWS
    phase_h(kparams());
#endif
    SYNC(1);
    for (int ph = 2; ph <= 12; ++ph) {
        if (ph == 4) { PH(4) attn_phase(kparams(), lds, 0);
#ifdef PROBE_ATTN2
            __syncthreads(); attn_phase(kparams(), lds, 1);
#endif
            SYNC(4); continue; }
        if (ph == 8) { PH(8) phase_mid(kparams());
#ifdef PROBE_ROWS
            phase_mid(kparams());
#endif
            SYNC(8); continue; }
        if (ph == 10) { PH(10) phase_convfix(kparams());

            SYNC(10); continue; }
        if (ph == 12) { PH(12) phase_final(kparams()); continue; }
        if (lo <= ph && ph < hi) {
            const int npass = (ph == 3 || ph == 6) ? 2 : 1;
            for (int pass = 0; pass < npass; ++pass) {
                GemmDesc d; d.C = nullptr; d.ldc = 0; d.start = 0; KP P = kparams();
                switch (ph) {
                case 2: d.A = P->h; d.lda = DM; d.Bt = P->WinT; d.ldb = DM; d.K = DM; d.nM = 65; d.nN = 9; d.epi = E_INPROJ; break;
                case 3: if (pass == 0) { d.A = P->qlat; d.lda = 384; d.Bt = P->WuqT; d.ldb = 384; d.K = 384; d.nM = 65; d.nN = 3; d.epi = E_UQ; }
                        else { d.A = P->latent; d.lda = 256; d.Bt = P->WukvT; d.ldb = 256; d.K = 256; d.nM = 193; d.nN = 4; d.epi = E_UKV; d.start = 195; } break;
                case 5: d.A = P->h; d.lda = DM; d.Bt = P->WgT; d.ldb = DM; d.K = DM; d.nM = 64; d.nN = 8; d.epi = E_GATE; break;
                case 6: d.A = P->o + pass * 512; d.lda = DM; d.Bt = pass ? P->WpbT : P->WpaT; d.ldb = 512; d.K = 512; d.nM = 64; d.nN = 4; d.epi = pass ? E_PROJB : E_PROJA; break;
                case 7: d.A = P->merged; d.lda = DM; d.Bt = P->WoutT; d.ldb = DM; d.K = DM; d.nM = 64; d.nN = 4; d.epi = E_PLAIN; d.C = P->m2; d.ldc = DM; break;
                case 9: d.A = P->h2; d.lda = DM; d.Bt = P->WupT; d.ldb = DM; d.K = DM; d.nM = 65; d.nN = 22; d.epi = E_UP; break;
                default: d.A = P->g; d.lda = DFF; d.Bt = P->WdownT; d.ldb = DFF; d.K = DFF; d.nM = 64; d.nN = 4; d.epi = E_PLAIN; d.C = P->f; d.ldc = DM; break;
                }
                gemm_run(d, lds);
                if (ph == 2) {
                    const int G_ = ogrid(), b_ = obid(); int wi = b_, nW = G_;
                    if (G_ == 256) { const int l_ = b_ >> 3; wi = l_ >= 10 ? (l_ - 10) * 8 + (b_ & 7) : -1; nW = 176; }
                    if (wi >= 0) tconv_tiles(P, lds, P->ntj_early + wi, nW, P->ntj_tiles);
                }
#ifdef PROBE_GEMM2
                if (ph == PROBE_GEMM2 && !(ph == 6 && pass == 0)) { __syncthreads(); if (ph == 6) { GemmDesc d0 = d; d0.A = P->o; d0.Bt = P->WpaT; d0.epi = E_PROJA; gemm_run(d0, lds); } gemm_run(d, lds); }
#endif
            }
        }
        if (lo <= ph && ph < hi) {
            KP P = kparams();
            if (ph == 5) gemm_small<1, 8>(P, P->h, DM, P->WgT, DM, 2048, P->gates, 2048, lds);
            else if (ph == 6) gemm_small<2, 4>(P, P->o, DM, P->WpaT, 512, 1024, P->merged, DM, lds);
            else if (ph == 7) gemm_small<0, 8>(P, P->merged, DM, P->WoutT, DM, 1024, P->m2, DM, lds);
            else if (ph == 11) gemm_small<0, 22>(P, P->g, DFF, P->WdownT, DFF, 1024, P->f, DM, lds);
#ifdef PROBE_SMALL
            if (ph == 5) gemm_small<1, 8>(P, P->h, DM, P->WgT, DM, 2048, P->gates, 2048, lds);
            else if (ph == 6) gemm_small<2, 4>(P, P->o, DM, P->WpaT, 512, 1024, P->merged, DM, lds);
            else if (ph == 7) gemm_small<0, 8>(P, P->merged, DM, P->WoutT, DM, 1024, P->m2, DM, lds);
            else if (ph == 11) gemm_small<0, 22>(P, P->g, DFF, P->WdownT, DFF, 1024, P->f, DM, lds);
#endif
        }
        SYNC(ph);
    }
}

static size_t bump(size_t& off, size_t bytes) { size_t r = off; off += (bytes + 255) & ~(size_t)255; return r; }

extern "C" void kernel_launch(void* const* d_in, const int* in_sizes, int n_in, void* d_out, int out_size, void* d_ws, size_t ws_size, hipStream_t stream) {
    Params P; memset(&P, 0, sizeof(P));
    const float* const* in = (const float* const*)d_in;
    P.x_p = in[0]; P.x_s = in[1]; P.c_ckv = in[2]; P.c_kr = in[3]; P.c_sbk = in[4]; P.c_sbv = in[5]; P.c_conv = in[6]; P.c_p = in[7]; P.c_s = in[8];
    P.w_ada = in[9]; P.b_ada = in[10]; P.g_pre_mix = in[11]; P.g_post_mix = in[12]; P.g_pre_ffn = in[13]; P.g_post_ffn = in[14];
    const float* w_in = in[15]; const float* g_q = in[16]; const float* w_uq = in[17]; P.g_kv = in[18]; const float* w_uk = in[19]; const float* w_uv = in[20];
    const float* w_pa = in[21]; const float* w_pb = in[22]; const float* w_out = in[23]; const float* w_up = in[24]; P.conv_w = in[25]; P.conv_b = in[26]; const float* w_down = in[27];
    P.out = (float*)d_out;
    char* ws = (char*)d_ws; size_t off = 0;
    P.WupT = (bf16_t*)(ws + bump(off, (size_t)DFF2 * DM * 2));
    P.WdownT = (bf16_t*)(ws + bump(off, (size_t)DM * DFF * 2));
    P.ropeT = (float*)(ws + bump(off, (size_t)TP * 32 * 4));
    P.ada = (float*)(ws + bump(off, 10 * 6144 * 4));
    P.ctr = (unsigned*)(ws + bump(off, 256));
    P.bar = (unsigned*)(ws + bump(off, XCD_BAR_WORDS * 4));
    const size_t R0 = off;
    P.WinT = (bf16_t*)(ws + bump(off, (size_t)2304 * DM * 2));
    P.WgT = (bf16_t*)(ws + bump(off, (size_t)2048 * DM * 2));
    P.WuqT = (bf16_t*)(ws + bump(off, (size_t)768 * 384 * 2));
    P.WukvT = (bf16_t*)(ws + bump(off, (size_t)1024 * 256 * 2));
    P.WpaT = (bf16_t*)(ws + bump(off, (size_t)1024 * 512 * 2));
    P.WpbT = (bf16_t*)(ws + bump(off, (size_t)1024 * 512 * 2));
    P.WoutT = (bf16_t*)(ws + bump(off, (size_t)1024 * 1024 * 2));
    const size_t o_kva = off;
    P.kva = (bf16_t*)(ws + bump(off, (size_t)KVROWS_PAD * 512 * 2));
    P.vaT_p = (bf16_t*)(ws + bump(off, (size_t)2 * 512 * TP * 2));
    P.vaT_s = (bf16_t*)(ws + bump(off, (size_t)8 * 512 * SKP * 2));
    const size_t o_kb = off;
    P.kb = (bf16_t*)(ws + bump(off, (size_t)KVROWS_PAD * 512 * 2));
    const size_t o_vbT = off;
    P.vbT_p = (bf16_t*)(ws + bump(off, (size_t)2 * 512 * TP * 2));
    P.vbT_s = (bf16_t*)(ws + bump(off, (size_t)8 * 512 * SKP * 2));
    const size_t o_kr = off;
    P.krope = (bf16_t*)(ws + bump(off, (size_t)KVROWS_PAD * 32 * 2));
    P.qb = (bf16_t*)(ws + bump(off, (size_t)MT * 512 * 2));
    P.q = (bf16_t*)(ws + bump(off, (size_t)MT * 768 * 2));
    P.latent = (bf16_t*)(ws + bump(off, (size_t)KVROWS_PAD * 256 * 2));
    size_t need = off;
    P.gates = (bf16_t*)(ws + o_kva);
    P.merged = (bf16_t*)(ws + o_kb);
    P.m2 = (bf16_t*)(ws + o_vbT);
    const size_t o_g = R0 + (size_t)MT * DFF2 * 2;
    P.g = (bf16_t*)(ws + R0);
    P.f = (bf16_t*)(ws + R0 + (size_t)100 * 1024 * 1024);
    P.ub = (bf16_t*)(ws + R0 + (size_t)140 * 1024 * 1024);
    P.u = (bf16_t*)(ws + R0 + (size_t)155 * 1024 * 1024);
    size_t o_h2 = o_kr > o_g ? o_kr : o_g;
    P.h2 = (bf16_t*)(ws + o_h2);
    if (o_h2 + (size_t)MT * DM * 2 > need) need = o_h2 + (size_t)MT * DM * 2;
    P.h = (bf16_t*)d_out;
    P.o = (bf16_t*)d_out + (size_t)MT * DM;
    P.qlat = P.o;
    if (need > ws_size) { fprintf(stderr, "workspace too small: need %zu have %zu\n", need, ws_size); return; }

    int nj = 0, tiles = 0;
    auto job = [&](const float* src, int lds, int coff, bf16_t* dst, int ldd, int Klen, int Nlen, const float* ks, int zero) {
        TJob& J = P.tj[nj++]; J.src = src; J.kscale = ks; J.dst = dst; J.lds = lds; J.coff = coff; J.ldd = ldd; J.Klen = Klen; J.Nlen = Nlen; J.zero = zero; J.tile0 = tiles; J.pad = 0;
        tiles += (Klen / 64) * ((Nlen + 255) / 256); };
    job(w_in, 4256, 0, P.WinT, DM, DM, 384, nullptr, 0);
    job(w_in, 4256, 640, P.WinT + (size_t)384 * DM, DM, DM, 32, nullptr, 0);
    job(w_in, 4256, 0, P.WinT + (size_t)416 * DM, DM, DM, 96, nullptr, 1);
    job(w_in, 4256, 384, P.WinT + (size_t)512 * DM, DM, DM, 256, nullptr, 0);
    job(w_in, 4256, 672, P.WinT + (size_t)768 * DM, DM, DM, 1536, nullptr, 0);
    job(w_uq, 768, 0, P.WuqT, 384, 384, 768, g_q, 0);
    job(w_uk, 512, 0, P.WukvT, 256, 256, 512, nullptr, 0);
    job(w_uv, 512, 0, P.WukvT + (size_t)512 * 256, 256, 256, 512, nullptr, 0);
    P.ntj_early = tiles;
    job(w_in, 4256, 2208, P.WgT, DM, DM, 2048, nullptr, 0);
    job(w_pa, DM, 0, P.WpaT, 512, 512, DM, nullptr, 0);
    job(w_pb, DM, 0, P.WpbT, 512, 512, DM, nullptr, 0);
    job(w_out, DM, 0, P.WoutT, DM, DM, DM, nullptr, 0);
    job(w_up, DFF2, 0, P.WupT, DM, DM, DFF2, nullptr, 2);
    job(w_down, DM, 0, P.WdownT, DFF, DFF, DM, nullptr, 0);
    P.ntj_tiles = tiles; P.pad0 = nj;
    for (int q = nj; q < NTJ; ++q) P.tj[q].tile0 = 0x7fffffff;
    P.phase_lo = 0; P.phase_hi = 13;

    static int grid_blocks = 0;
    if (!grid_blocks) {
        (void)hipFuncSetAttribute((const void*)fwd_megakernel, hipFuncAttributeMaxDynamicSharedMemorySize, LDS_BYTES);
        int dev = 0, cus = 0, per_cu = 0;
        (void)hipGetDevice(&dev);
        (void)hipDeviceGetAttribute(&cus, hipDeviceAttributeMultiprocessorCount, dev);
        (void)hipOccupancyMaxActiveBlocksPerMultiprocessor(&per_cu, fwd_megakernel, NTHREADS, LDS_BYTES);
        if (per_cu > 1) per_cu = 1;
        grid_blocks = cus * per_cu;
    }
    (void)hipMemsetAsync(P.ctr, 0, 256 + XCD_BAR_WORDS * 4, stream);
    void* args[] = {&P};
    hipError_t e = hipLaunchCooperativeKernel((const void*)fwd_megakernel, dim3(grid_blocks), dim3(NTHREADS), args, LDS_BYTES, stream);
    if (e != hipSuccess) fprintf(stderr, "cooperative launch failed: %s (grid %d)\n", hipGetErrorString(e), grid_blocks);
}
```
